# Optimizing an MI355X kernel written in HIP

```python
import math
import jax, jax.numpy as jnp
from jax import lax
import numpy as np

D_MODEL = 1024
BATCH = 8
SEQ = 2048
DEPTH = 4
DEC_BATCH = 128
DEC_SEQ = 1
PAST_LEN = 16384
PAGE_SIZE = 128

N_MIXERS = 4
MIX_W = D_MODEL
GROUP_W = MIX_W // N_MIXERS
HEAD_DIM = 64
HG_HEADS = GROUP_W // HEAD_DIM
GDN_HEADS = GROUP_W // HEAD_DIM
SSD_HEADS = GROUP_W // HEAD_DIM
RET_HEADS = GROUP_W // HEAD_DIM
SSD_GROUPS = 2
SSD_STATE = 128
CONV_W = 4
GDN_CONV_DIM = 3 * GROUP_W
SSD_CONV_DIM = GROUP_W + 2 * SSD_GROUPS * SSD_STATE
N_META = 16
CHUNK = 64
ROPE_BASE = 10000.0
EPS = 1e-6
TINY = 1e-30
DT_MIN = 1e-3
DT_MAX = 1e-1
QK_SCALE = HEAD_DIM ** -0.5
IN_SIZES = (GROUP_W, GROUP_W, GROUP_W, GROUP_W,
            GDN_CONV_DIM, GROUP_W, GDN_HEADS, GDN_HEADS,
            SSD_CONV_DIM, GROUP_W, SSD_HEADS,
            GROUP_W, GROUP_W, GROUP_W, GROUP_W)
IN_DIM = sum(IN_SIZES)
F32 = jnp.float32

kernel_name = 'hymba_style_hgrn2_gdn_ssd_retention_step'


def group_rms_norm(x, w, groups):
    b, t, width = x.shape
    xg = x.astype(F32).reshape(b, t, groups, width // groups)
    xg = xg * lax.rsqrt(jnp.mean(xg * xg, axis=-1, keepdims=True) + EPS)
    return xg.reshape(b, t, width) * w


def rms_norm(x, w):
    return group_rms_norm(x, w, 1)


def group_norm(x, w, bias, groups):
    b, t, width = x.shape
    xg = x.astype(F32).reshape(b, t, groups, width // groups)
    mu = jnp.mean(xg, axis=-1, keepdims=True)
    xc = xg - mu
    xg = xc * lax.rsqrt(jnp.mean(xc * xc, axis=-1, keepdims=True) + EPS)
    return xg.reshape(b, t, width) * w + bias


def l2_normalize(x):
    return x * lax.rsqrt(jnp.sum(x * x, axis=-1, keepdims=True) + EPS)


def to_heads(x, n):
    b, t, w = x.shape
    return x.reshape(b, t, n, w // n).transpose(0, 2, 1, 3)


def from_heads(o):
    b, h, t, d = o.shape
    return o.transpose(0, 2, 1, 3).reshape(b, t, h * d)


def to_chunks(a):
    b, h, t = a.shape[:3]
    return jnp.moveaxis(a.reshape(b, h, t // CHUNK, CHUNK, *a.shape[3:]), 2, 0)


def from_chunks(o):
    o = jnp.moveaxis(o, 0, 2)
    return o.reshape(o.shape[0], o.shape[1], -1, o.shape[-1])


def masked_exp(diff, mask):
    return jnp.where(mask, jnp.exp(jnp.where(mask, diff, 0.0)), 0.0)


def causal_conv(u, ctx, w, b=None):
    full = jnp.concatenate([ctx.astype(u.dtype), u], axis=1)
    y = lax.conv_general_dilated(full, w[:, None, :].astype(u.dtype), window_strides=(1,), padding='VALID',
                                 dimension_numbers=('NWC', 'WIO', 'NWC'), feature_group_count=u.shape[-1])
    if b is not None:
        y = y + b
    return y, full[:, full.shape[1] - (CONV_W - 1):]


def rotary(x, pos):
    half = x.shape[-1] // 2
    inv_freq = 1.0 / (ROPE_BASE ** jnp.linspace(0.0, 1.0, half, dtype=F32))
    ang = pos[:, None] * inv_freq[None, :]
    cos, sin = jnp.cos(ang), jnp.sin(ang)
    x1, x2 = x[..., :half], x[..., half:]
    return jnp.concatenate([x1 * cos - x2 * sin, x2 * cos + x1 * sin], axis=-1)


def chunk_scalar_decay(S, xs):
    q, k, v, g = xs
    c = g.shape[-1]
    G = jnp.cumsum(g, axis=-1)
    causal = jnp.tril(jnp.ones((c, c), bool))
    decay = masked_exp(G[..., :, None] - G[..., None, :], causal)
    scores = jnp.einsum('bhik,bhjk->bhij', q, k) * decay
    o = (jnp.einsum('bhij,bhjv->bhiv', scores, v)
         + jnp.einsum('bhik,bhkv->bhiv', q * jnp.exp(G)[..., None], S))
    g_last = G[..., -1:]
    S_new = (jnp.exp(g_last)[..., None] * S
             + jnp.einsum('bhjk,bhjv->bhkv', k * jnp.exp(g_last - G)[..., None], v))
    return S_new, o


def step_scalar_decay(S, xs):
    q, k, v, g = xs
    S = jnp.exp(g)[..., None, None] * S + k[..., :, None] * v[..., None, :]
    return S, jnp.einsum('bhk,bhkv->bhv', q, S)


def chunk_vector_decay(S, xs):
    q, k, v, g = xs
    c = g.shape[2]
    G = jnp.cumsum(g, axis=2)
    causal = jnp.tril(jnp.ones((c, c), bool))
    diff = G[:, :, :, None, :] - G[:, :, None, :, :]
    decay = masked_exp(diff, causal[:, :, None])
    scores = jnp.einsum('bhik,bhjk,bhijk->bhij', q, k, decay)
    o = (jnp.einsum('bhij,bhjv->bhiv', scores, v)
         + jnp.einsum('bhik,bhkv->bhiv', q * jnp.exp(G), S))
    g_last = G[:, :, -1]
    S_new = (jnp.exp(g_last)[..., None] * S
             + jnp.einsum('bhjk,bhjv->bhkv', k * jnp.exp(g_last[:, :, None] - G), v))
    return S_new, o


def step_vector_decay(S, xs):
    q, k, v, g = xs
    S = jnp.exp(g)[..., None] * S + k[..., :, None] * v[..., None, :]
    return S, jnp.einsum('bhk,bhkv->bhv', q, S)


def chunk_gated_delta(S, xs):
    q, k, v, g, beta = xs
    c = g.shape[-1]
    G = jnp.cumsum(g, axis=-1)
    causal = jnp.tril(jnp.ones((c, c), bool))
    strict = jnp.tril(jnp.ones((c, c), bool), -1)
    decay = masked_exp(G[..., :, None] - G[..., None, :], causal)
    m = jnp.where(strict, jnp.einsum('bhik,bhjk->bhij', k, k) * decay * beta[..., :, None], 0.0)
    lhs = jnp.eye(c, dtype=m.dtype) + m
    rhs = jnp.concatenate([v * beta[..., None], k * (beta * jnp.exp(G))[..., None]], axis=-1)
    sol = lax.linalg.triangular_solve(lhs, rhs, left_side=True, lower=True, unit_diagonal=True)
    dv = v.shape[-1]
    u = sol[..., :dv] - jnp.einsum('bhik,bhkv->bhiv', sol[..., dv:], S)
    qk = jnp.einsum('bhik,bhjk->bhij', q, k) * decay
    o = (jnp.einsum('bhik,bhkv->bhiv', q * jnp.exp(G)[..., None], S)
         + jnp.einsum('bhij,bhjv->bhiv', qk, u))
    g_last = G[..., -1:]
    S_new = (jnp.exp(g_last)[..., None] * S
             + jnp.einsum('bhjk,bhjv->bhkv', k * jnp.exp(g_last - G)[..., None], u))
    return S_new, o


def step_gated_delta(S, xs):
    q, k, v, g, beta = xs
    S = jnp.exp(g)[..., None, None] * S
    u = beta[..., None] * (v - jnp.einsum('bhk,bhkv->bhv', k, S))
    S = S + k[..., :, None] * u[..., None, :]
    return S, jnp.einsum('bhk,bhkv->bhv', q, S)


def run_mixer(chunk_fn, step_fn, args, S0, prompt):
    if prompt:
        S, o_meta = chunk_fn(S0, tuple(a[:, :, :N_META] for a in args))
        S, o = lax.scan(chunk_fn, S, tuple(to_chunks(a[:, :, N_META:]) for a in args))
        return S, jnp.concatenate([o_meta, from_chunks(o)], axis=2)
    S, o = lax.scan(step_fn, S0, tuple(jnp.moveaxis(a, 2, 0) for a in args))
    return S, jnp.moveaxis(o, 0, 2)


def mixer(hn, pos, w_in_l, lb, hgrn_norm_w_l, gdn_conv_w_l, gdn_a_log_l, gdn_dt_bias_l, gdn_norm_w_l,
          ssd_conv_w_l, ssd_conv_b_l, ssd_a_log_l, ssd_dt_bias_l, ssd_d_l, ssd_norm_w_l,
          ret_norm_w_l, ret_norm_b_l, w_out_l,
          s_hgrn, s_gdn, gdn_ctx, s_ssd, ssd_ctx, s_ret, prompt):
    bsz, t, _ = hn.shape
    proj = jnp.einsum('btd,de->bte', hn, w_in_l)
    offsets = [int(o) for o in np.cumsum(IN_SIZES)[:-1]]
    (a_q, a_f, a_i, a_z, b_qkv, b_z, b_a, b_b, c_xbc, c_z, c_dt,
     d_q, d_k, d_v, d_z) = jnp.split(proj, offsets, axis=-1)

    a_k = (1.0 - lb) * jax.nn.sigmoid(-a_f)
    log_f = jnp.log(jnp.maximum(lb + (1.0 - lb) * jax.nn.sigmoid(a_f), TINY))
    s_hgrn, o_a = run_mixer(chunk_vector_decay, step_vector_decay,
                            (to_heads(jax.nn.silu(a_q), HG_HEADS) * QK_SCALE, to_heads(a_k, HG_HEADS),
                             to_heads(a_i, HG_HEADS), to_heads(log_f, HG_HEADS)), s_hgrn, prompt)
    y_a = group_rms_norm(from_heads(o_a), hgrn_norm_w_l, HG_HEADS) * jax.nn.silu(a_z)

    b_conv, gdn_ctx = causal_conv(b_qkv, gdn_ctx, gdn_conv_w_l)
    b_q, b_k, b_v = jnp.split(jax.nn.silu(b_conv), 3, axis=-1)
    b_g = jnp.swapaxes(-jnp.exp(gdn_a_log_l) * jax.nn.softplus(b_a + gdn_dt_bias_l), 1, 2)
    b_beta = jnp.swapaxes(jax.nn.sigmoid(b_b), 1, 2)
    s_gdn, o_b = run_mixer(chunk_gated_delta, step_gated_delta,
                           (l2_normalize(to_heads(b_q, GDN_HEADS)) * QK_SCALE, l2_normalize(to_heads(b_k, GDN_HEADS)),
                            to_heads(b_v, GDN_HEADS), b_g, b_beta), s_gdn, prompt)
    y_b = group_rms_norm(from_heads(o_b), gdn_norm_w_l, GDN_HEADS) * jax.nn.silu(b_z)

    c_conv, ssd_ctx = causal_conv(c_xbc, ssd_ctx, ssd_conv_w_l, ssd_conv_b_l)
    c_x, c_b, c_c = jnp.split(jax.nn.silu(c_conv), [GROUP_W, GROUP_W + SSD_GROUPS * SSD_STATE], axis=-1)
    dt_h = jnp.swapaxes(jax.nn.softplus(c_dt + ssd_dt_bias_l), 1, 2)
    x_h = to_heads(c_x, SSD_HEADS)
    b_h = jnp.repeat(to_heads(c_b, SSD_GROUPS), SSD_HEADS // SSD_GROUPS, axis=1)
    c_h = jnp.repeat(to_heads(c_c, SSD_GROUPS), SSD_HEADS // SSD_GROUPS, axis=1)
    s_ssd, o_c = run_mixer(chunk_scalar_decay, step_scalar_decay,
                           (c_h, b_h, x_h * dt_h[..., None], dt_h * (-jnp.exp(ssd_a_log_l))[:, None]),
                           s_ssd, prompt)
    o_c = o_c + ssd_d_l[:, None, None] * x_h
    y_c = group_rms_norm(from_heads(o_c) * jax.nn.silu(c_z), ssd_norm_w_l, SSD_GROUPS)

    ret_log_decay = jnp.log1p(-jnp.exp2(-5.0 - jnp.arange(RET_HEADS, dtype=F32)))
    ret_g = jnp.broadcast_to(ret_log_decay[None, :, None], (bsz, RET_HEADS, t))
    s_ret, o_d = run_mixer(chunk_scalar_decay, step_scalar_decay,
                           (rotary(to_heads(d_q, RET_HEADS), pos), rotary(to_heads(d_k, RET_HEADS), pos) * QK_SCALE,
                            to_heads(d_v, RET_HEADS), ret_g), s_ret, prompt)
    y_d = group_norm(from_heads(o_d), ret_norm_w_l, ret_norm_b_l, RET_HEADS) * jax.nn.silu(d_z)

    y = jnp.concatenate([y_a, y_b, y_c, y_d], axis=-1)
    out = jnp.einsum('bte,ed->btd', y, w_out_l)
    return out, (s_hgrn, s_gdn, gdn_ctx, s_ssd, ssd_ctx, s_ret)


def zero_states(bsz):
    return (jnp.zeros((bsz, HG_HEADS, HEAD_DIM, HEAD_DIM), F32),
            jnp.zeros((bsz, GDN_HEADS, HEAD_DIM, HEAD_DIM), F32),
            jnp.zeros((bsz, CONV_W - 1, GDN_CONV_DIM), F32),
            jnp.zeros((bsz, SSD_HEADS, SSD_STATE, HEAD_DIM), F32),
            jnp.zeros((bsz, CONV_W - 1, SSD_CONV_DIM), F32),
            jnp.zeros((bsz, RET_HEADS, HEAD_DIM, HEAD_DIM), F32))


def stack_states(states, i, like):
    return jnp.stack([s[i] for s in states]).astype(like.dtype)


def setup_inputs(seed: int = 0) -> dict:
    key = jax.random.key(seed)
    ks = jax.random.split(key, 28)

    def nrm(k, shape, scale):
        return scale * jax.random.normal(k, shape, F32)

    def gain(k, shape):
        return 1.0 + 0.05 * jax.random.normal(k, shape, F32)

    def a_log(k, n):
        return jnp.log(jax.random.uniform(k, (DEPTH, n), F32, 1.0, 16.0))

    def dt_bias(k, n):
        dt = jnp.exp(jax.random.uniform(k, (DEPTH, n), F32, math.log(DT_MIN), math.log(DT_MAX)))
        return dt + jnp.log(-jnp.expm1(-dt))

    return {
        'x_prompt': nrm(ks[0], (BATCH, SEQ, D_MODEL), 1.0),
        'x_sample': nrm(ks[1], (DEC_BATCH, DEC_SEQ, D_MODEL), 1.0),
        'state_hgrn': nrm(ks[2], (DEPTH, DEC_BATCH, HG_HEADS, HEAD_DIM, HEAD_DIM), 0.5),
        'state_gdn': nrm(ks[3], (DEPTH, DEC_BATCH, GDN_HEADS, HEAD_DIM, HEAD_DIM), 0.5),
        'state_gdn_conv': nrm(ks[4], (DEPTH, DEC_BATCH, CONV_W - 1, GDN_CONV_DIM), 1.0),
        'state_ssd': nrm(ks[5], (DEPTH, DEC_BATCH, SSD_HEADS, SSD_STATE, HEAD_DIM), 0.5),
        'state_ssd_conv': nrm(ks[6], (DEPTH, DEC_BATCH, CONV_W - 1, SSD_CONV_DIM), 1.0),
        'state_ret': nrm(ks[7], (DEPTH, DEC_BATCH, RET_HEADS, HEAD_DIM, HEAD_DIM), 2.0),
        'meta_tokens': nrm(ks[8], (N_META, D_MODEL), 1.0),
        'norm_w': gain(ks[9], (DEPTH, D_MODEL)),
        'w_in': nrm(ks[10], (DEPTH, D_MODEL, IN_DIM), D_MODEL ** -0.5),
        'hgrn_lb_logits': nrm(ks[11], (DEPTH, GROUP_W), 0.5),
        'hgrn_norm_w': gain(ks[12], (DEPTH, GROUP_W)),
        'gdn_conv_w': nrm(ks[13], (DEPTH, CONV_W, GDN_CONV_DIM), CONV_W ** -0.5),
        'gdn_a_log': a_log(ks[14], GDN_HEADS),
        'gdn_dt_bias': dt_bias(ks[15], GDN_HEADS),
        'gdn_norm_w': gain(ks[16], (DEPTH, GROUP_W)),
        'ssd_conv_w': nrm(ks[17], (DEPTH, CONV_W, SSD_CONV_DIM), CONV_W ** -0.5),
        'ssd_conv_b': nrm(ks[18], (DEPTH, SSD_CONV_DIM), 0.02),
        'ssd_a_log': a_log(ks[19], SSD_HEADS),
        'ssd_dt_bias': dt_bias(ks[20], SSD_HEADS),
        'ssd_d': gain(ks[21], (DEPTH, SSD_HEADS)),
        'ssd_norm_w': gain(ks[22], (DEPTH, GROUP_W)),
        'ret_norm_w': gain(ks[23], (DEPTH, GROUP_W)),
        'ret_norm_b': nrm(ks[24], (DEPTH, GROUP_W), 0.02),
        'w_out': nrm(ks[25], (DEPTH, MIX_W, D_MODEL), MIX_W ** -0.5),
        'final_norm_w': gain(ks[26], (D_MODEL,)),
    }


def reference(x_prompt, x_sample, state_hgrn, state_gdn, state_gdn_conv, state_ssd, state_ssd_conv, state_ret,
              meta_tokens, norm_w, w_in, hgrn_lb_logits, hgrn_norm_w, gdn_conv_w, gdn_a_log, gdn_dt_bias, gdn_norm_w,
              ssd_conv_w, ssd_conv_b, ssd_a_log, ssd_dt_bias, ssd_d, ssd_norm_w, ret_norm_w, ret_norm_b,
              w_out, final_norm_w):
    bsz = x_prompt.shape[0]
    lb_w = jax.nn.softmax(hgrn_lb_logits.astype(F32), axis=0)
    lb_all = jnp.maximum(jnp.cumsum(lb_w, axis=0) - lb_w[0], 0.0)

    meta = jnp.broadcast_to(meta_tokens.astype(F32)[None], (bsz, N_META, D_MODEL))
    hp = jnp.concatenate([meta, x_prompt.astype(F32)], axis=1)
    hs = x_sample.astype(F32)
    pos_p = jnp.arange(hp.shape[1], dtype=F32)
    pos_s = PAST_LEN + jnp.arange(hs.shape[1], dtype=F32)

    st_p, st_s = [], []
    for l in range(DEPTH):
        lw = (w_in[l], lb_all[l], hgrn_norm_w[l], gdn_conv_w[l], gdn_a_log[l], gdn_dt_bias[l], gdn_norm_w[l],
              ssd_conv_w[l], ssd_conv_b[l], ssd_a_log[l], ssd_dt_bias[l], ssd_d[l], ssd_norm_w[l],
              ret_norm_w[l], ret_norm_b[l], w_out[l])
        dp, sp = mixer(rms_norm(hp, norm_w[l]), pos_p, *lw, *zero_states(bsz), True)
        hp = hp + dp
        past = tuple(a[l].astype(F32) for a in (state_hgrn, state_gdn, state_gdn_conv,
                                                 state_ssd, state_ssd_conv, state_ret))
        ds, ss = mixer(rms_norm(hs, norm_w[l]), pos_s, *lw, *past, False)
        hs = hs + ds
        st_p.append(sp)
        st_s.append(ss)

    y_prompt = rms_norm(hp[:, N_META:], final_norm_w).astype(x_prompt.dtype)
    y_sample = rms_norm(hs, final_norm_w).astype(x_sample.dtype)
    return (y_prompt, y_sample,
            stack_states(st_p, 0, state_hgrn), stack_states(st_p, 1, state_gdn),
            stack_states(st_p, 2, state_gdn_conv), stack_states(st_p, 3, state_ssd),
            stack_states(st_p, 4, state_ssd_conv), stack_states(st_p, 5, state_ret),
            stack_states(st_s, 0, state_hgrn), stack_states(st_s, 1, state_gdn),
            stack_states(st_s, 2, state_gdn_conv), stack_states(st_s, 3, state_ssd),
            stack_states(st_s, 4, state_ssd_conv), stack_states(st_s, 5, state_ret))
```

```cpp
#include <hip/hip_runtime.h>
#include <cstdio>
#include <cstdint>

#define LAS __attribute__((address_space(3)))
typedef unsigned short bf16_t;
typedef short bf16x8 __attribute__((ext_vector_type(8)));
typedef float f32x4 __attribute__((ext_vector_type(4)));
typedef unsigned u32x4 __attribute__((ext_vector_type(4)));
typedef unsigned u32x2 __attribute__((ext_vector_type(2)));

constexpr int DM = 1024, NB = 8, SEQ = 2048, DEPTH = 4, DECB = 128, NMETA = 16, TP = SEQ + NMETA;
constexpr int MP = NB * TP;
constexpr int MROWS = MP + DECB;
constexpr int IN_DIM = 4108, NBIG = 4096, NSM = 12;
constexpr int PASTLEN = 16384;
constexpr float EPSF = 1e-6f;
constexpr int PC_AQ = 0, PC_AF = 256, PC_AI = 512, PC_AZ = 768, PC_BQKV = 1024, PC_BZ = 1792, PC_CXBC = 2048, PC_CZ = 2816, PC_DQ = 3072, PC_DK = 3328, PC_DV = 3584, PC_DZ = 3840;

constexpr size_t WS_BAR = 0;
constexpr size_t WS_WINT = 16384;
constexpr size_t WS_WOUTT = WS_WINT + (size_t)DEPTH * NBIG * DM * 2;
constexpr size_t WS_WSM = WS_WOUTT + (size_t)DEPTH * DM * DM * 2;
constexpr size_t WS_LB = WS_WSM + (size_t)DEPTH * NSM * DM * 4;
constexpr size_t WS_ROT = WS_LB + (size_t)DEPTH * 256 * 4;
constexpr size_t ROT_BYTES = ((size_t)(TP + 1) * 64 * 4 + 255) / 256 * 256;
constexpr size_t WS_H = WS_ROT + ROT_BYTES;
constexpr size_t WS_HB = WS_H + (size_t)MROWS * DM * 4;
constexpr size_t WS_RS = WS_HB + (size_t)MROWS * DM * 2;
constexpr size_t WS_PSM = WS_RS + (size_t)MROWS * 4;
constexpr size_t WS_PROJ = WS_PSM + (size_t)MROWS * NSM * 4;
constexpr size_t WS_Y = WS_PROJ + (size_t)MROWS * NBIG * 2;
constexpr size_t WS_END = WS_Y + (size_t)MROWS * DM * 2;

constexpr size_t O_YP = 0;
constexpr size_t O_YS = O_YP + (size_t)NB * SEQ * DM;
constexpr size_t O_HGRN_P = O_YS + (size_t)DECB * DM;
constexpr size_t O_GDN_P = O_HGRN_P + (size_t)DEPTH * NB * 4 * 64 * 64;
constexpr size_t O_GCONV_P = O_GDN_P + (size_t)DEPTH * NB * 4 * 64 * 64;
constexpr size_t O_SSD_P = O_GCONV_P + (size_t)DEPTH * NB * 3 * 768;
constexpr size_t O_SCONV_P = O_SSD_P + (size_t)DEPTH * NB * 4 * 128 * 64;
constexpr size_t O_RET_P = O_SCONV_P + (size_t)DEPTH * NB * 3 * 768;
constexpr size_t O_HGRN_S = O_RET_P + (size_t)DEPTH * NB * 4 * 64 * 64;
constexpr size_t O_GDN_S = O_HGRN_S + (size_t)DEPTH * DECB * 4 * 64 * 64;
constexpr size_t O_GCONV_S = O_GDN_S + (size_t)DEPTH * DECB * 4 * 64 * 64;
constexpr size_t O_SSD_S = O_GCONV_S + (size_t)DEPTH * DECB * 3 * 768;
constexpr size_t O_SCONV_S = O_SSD_S + (size_t)DEPTH * DECB * 4 * 128 * 64;
constexpr size_t O_RET_S = O_SCONV_S + (size_t)DEPTH * DECB * 3 * 768;
constexpr size_t O_END = O_RET_S + (size_t)DEPTH * DECB * 4 * 64 * 64;

struct Params {
    const float* x_prompt; const float* x_sample;
    const float* st_hgrn; const float* st_gdn; const float* st_gconv; const float* st_ssd; const float* st_sconv; const float* st_ret;
    const float* meta; const float* norm_w; const float* w_in; const float* lb_logits; const float* hgrn_norm_w;
    const float* gdn_conv_w; const float* gdn_a_log; const float* gdn_dt_bias; const float* gdn_norm_w;
    const float* ssd_conv_w; const float* ssd_conv_b; const float* ssd_a_log; const float* ssd_dt_bias; const float* ssd_d; const float* ssd_norm_w;
    const float* ret_norm_w; const float* ret_norm_b; const float* w_out; const float* final_norm_w;
    float* out; unsigned char* ws;
};

__device__ __forceinline__ float bf2f(bf16_t b) { return __uint_as_float(((unsigned)b) << 16); }
__device__ __forceinline__ bf16_t f2bf(float f) { unsigned u = __float_as_uint(f); u += 0x7FFFu + ((u >> 16) & 1u); return (bf16_t)(u >> 16); }
__device__ __forceinline__ unsigned pack_bf2(float lo, float hi) { return (unsigned)f2bf(lo) | ((unsigned)f2bf(hi) << 16); }
__device__ __forceinline__ float sigmoid_f(float x) { return 1.0f / (1.0f + __expf(-x)); }
__device__ __forceinline__ float silu_f(float x) { return x / (1.0f + __expf(-x)); }
__device__ __forceinline__ float softplus_f(float x) { return x > 20.0f ? x : log1pf(__expf(x)); }
__device__ __forceinline__ float wave_sum(float v) {
#pragma unroll
    for (int o = 32; o > 0; o >>= 1) v += __shfl_xor(v, o);
    return v;
}

namespace pg8 {
constexpr int BM = 256, BK = 64, HALF = 128, HTB = HALF * BK * 2, STAGE_BYTES = 8 * HTB, NXCD = 8, WGM = 8;
__host__ __device__ __forceinline__ int lds_byte(int r, int c) { const int st = (r >> 4) * 2 + (c >> 5), rr = r & 15, cc = c & 31, ob = rr * 64 + cc * 2; return st * 1024 + (ob ^ (((ob >> 9) & 1) << 5)); }
__host__ __device__ __forceinline__ void stage_rc(int b, int& R, int& C) { const int st = b / 1024, sb = b % 1024, swz = sb ^ (((sb >> 9) & 1) << 5); R = (st >> 1) * 16 + swz / 64; C = (st & 1) * 32 + (swz % 64) / 2; }
__host__ __device__ __forceinline__ int perm32(int rho) { const int n = rho >> 4, i = rho & 15; return 8 * (i >> 2) + 4 * n + (i & 3); }
struct Unit { int pm, pn; };
struct Gemm { const bf16_t* A; const bf16_t* Bt; int M, N, K; };
struct StaticOrder {
    int nM, nN, nwg, G, c;
    __host__ __device__ void init(int M, int N, int G_, int c_) { nM = M / BM; nN = N / BM; nwg = nM * nN; G = G_; c = c_; }
    __host__ __device__ bool next(int i, Unit& u) const {
        const long L = (long)i * G + c; if (L >= nwg) return false;
        int wgid = (int)L; { const int q = nwg / NXCD, r = nwg % NXCD, xcd = wgid % NXCD, off = wgid / NXCD; wgid = (xcd < r ? xcd * (q + 1) : r * (q + 1) + (xcd - r) * q) + off; }
        const int nig = WGM * nN, gid = wgid / nig, fm = gid * WGM, gsz = (nM - fm) < WGM ? (nM - fm) : WGM;
        u.pm = fm + ((wgid % nig) % gsz); u.pn = (wgid % nig) / gsz; return true;
    }
    __device__ __forceinline__ void a_ready(const Unit&) const {}
    __device__ __forceinline__ void done(const Unit&) const {}
};
__device__ __forceinline__ unsigned cvt_pk_bf16(float lo, float hi) { unsigned r; asm volatile("v_cvt_pk_bf16_f32 %0, %1, %2" : "=v"(r) : "v"(lo), "v"(hi)); return r; }

struct EpiProj {
    static constexpr bool PERM = true, AFTER_DRAIN = false;
    bf16_t* O; int ldc; const float* rs;
    __device__ __forceinline__ void operator()(const f32x4 (&acc)[2][2][4][2], const Unit& u, int wr, int wc, int fr, int fq) const {
        const int row0 = u.pm * BM + wr * 64 + fr; const int col0 = u.pn * BM + wc * 32 + 8 * fq;
#pragma unroll
        for (int ai = 0; ai < 2; ++ai)
#pragma unroll
            for (int m = 0; m < 4; ++m) { const int row = row0 + ai * HALF + m * 16; const float s = rs[row]; bf16_t* rowp = O + (size_t)row * ldc + col0;
#pragma unroll
                for (int bj = 0; bj < 2; ++bj) { const f32x4 v0 = acc[ai][bj][m][0] * s, v1 = acc[ai][bj][m][1] * s;
                    u32x4 w; w.x = cvt_pk_bf16(v0[0], v0[1]); w.y = cvt_pk_bf16(v0[2], v0[3]); w.z = cvt_pk_bf16(v1[0], v1[1]); w.w = cvt_pk_bf16(v1[2], v1[3]);
                    *(u32x4*)(rowp + bj * HALF) = w; } }
    }
};
struct EpiResid {
    static constexpr bool PERM = false, AFTER_DRAIN = false;
    float* C; int ldc;
    __device__ __forceinline__ void operator()(const f32x4 (&acc)[2][2][4][2], const Unit& u, int wr, int wc, int fr, int fq) const {
        const int row0 = u.pm * BM + wr * 64 + fr, col0 = u.pn * BM + wc * 32 + 4 * fq;
#pragma unroll
        for (int ai = 0; ai < 2; ++ai)
#pragma unroll
            for (int m = 0; m < 4; ++m) { float* rowp = C + (size_t)(row0 + ai * HALF + m * 16) * ldc + col0;
#pragma unroll
                for (int bj = 0; bj < 2; ++bj)
#pragma unroll
                    for (int n = 0; n < 2; ++n) { f32x4* p = (f32x4*)(rowp + bj * HALF + n * 16); *p = *p + acc[ai][bj][m][n]; } }
    }
};

template <class Epi, class Sched>
__device__ __forceinline__ void gemm_phase(LAS unsigned char* lds, const Gemm g, const Sched& S, const Epi& E) {
    const int tid = threadIdx.x, wid = __builtin_amdgcn_readfirstlane(tid >> 6), lane = tid & 63, wr = wid >> 2, wc = wid & 3, fr = lane & 15, fq = lane >> 4;
    const int K = g.K, nt = K / BK;
    unsigned voffA[2], voffB[2];
#pragma unroll
    for (int i = 0; i < 2; ++i) { int R, C; stage_rc(tid * 16 + i * 8192, R, C); const int Rb = Epi::PERM ? ((R & ~31) + perm32(R & 31)) : R;
        voffA[i] = (unsigned)(R * K + C) * 2u; voffB[i] = (unsigned)(Rb * K + C) * 2u; }
    const size_t kstep = (size_t)(BK * 2);
    const size_t hstep = (size_t)HALF * K * 2;
    const size_t tstep = 2 * hstep;
    const unsigned ldsw = (unsigned)wid * 1024u;
    const int aoff = lds_byte(wr * 64 + fr, fq * 8), boff = lds_byte(wc * 32 + fr, fq * 8);
#define PG8_SA(b, h) (((b) * 2 + (h)) * HTB)
#define PG8_SB(b, h) ((4 + (b) * 2 + (h)) * HTB)
#define PG8_STAGE(bufoff, gbase, voff) do { _Pragma("unroll") for (int _i = 0; _i < 2; ++_i) \
        __builtin_amdgcn_global_load_lds((const unsigned*)((const char*)(gbase) + (voff)[_i]), (LAS unsigned*)(lds + (bufoff) + ldsw + _i * 8192), 16, 0, 0); } while (0)
#define PG8_LDA(dst, b, h) do { _Pragma("unroll") for (int m = 0; m < 4; ++m) _Pragma("unroll") for (int k = 0; k < 2; ++k) dst[m][k] = *(const LAS bf16x8*)(lds + PG8_SA(b, h) + aoff + m * 2048 + k * 1024); } while (0)
#define PG8_LDB(dst, b, h) do { _Pragma("unroll") for (int n = 0; n < 2; ++n) _Pragma("unroll") for (int k = 0; k < 2; ++k) dst[n][k] = *(const LAS bf16x8*)(lds + PG8_SB(b, h) + boff + n * 2048 + k * 1024); } while (0)
#define PG8_MMA(ai, bj, At, Bt) do { __builtin_amdgcn_s_setprio(1); _Pragma("unroll") for (int m = 0; m < 4; ++m) _Pragma("unroll") for (int n = 0; n < 2; ++n) _Pragma("unroll") for (int k = 0; k < 2; ++k) \
        acc[ai][bj][m][n] = __builtin_amdgcn_mfma_f32_16x16x32_bf16(Bt[n][k], At[m][k], acc[ai][bj][m][n], 0, 0, 0); __builtin_amdgcn_s_setprio(0); } while (0)
#define PG8_WAIT_V(n) asm volatile("s_waitcnt vmcnt(" #n ")" ::: "memory")
#define PG8_WAIT_L(n) asm volatile("s_waitcnt lgkmcnt(" #n ")" ::: "memory")
#define PG8_BAR __builtin_amdgcn_s_barrier()
#define PG8_SCHED __builtin_amdgcn_sched_barrier(0)
    Unit cur, nxt; int ui = 0;
    if (!S.next(0, cur)) return;
    f32x4 acc[2][2][4][2];
#pragma unroll
    for (int a = 0; a < 2; ++a)
#pragma unroll
        for (int b = 0; b < 2; ++b)
#pragma unroll
            for (int m = 0; m < 4; ++m)
#pragma unroll
                for (int n = 0; n < 2; ++n) acc[a][b][m][n] = (f32x4){0.f, 0.f, 0.f, 0.f};
    bf16x8 At[4][2], B0[2][2], B1[2][2];
    const char* cA = (const char*)g.A + (size_t)cur.pm * tstep; const char* cB = (const char*)g.Bt + (size_t)cur.pn * tstep;
    S.a_ready(cur);
    PG8_STAGE(PG8_SB(0, 0), cB, voffB); PG8_STAGE(PG8_SA(0, 0), cA, voffA); PG8_STAGE(PG8_SB(0, 1), cB + hstep, voffB); PG8_STAGE(PG8_SA(0, 1), cA + hstep, voffA);
    if (wr == 1) PG8_BAR;
    PG8_WAIT_V(4); PG8_BAR;
    PG8_STAGE(PG8_SB(1, 0), cB + kstep, voffB); PG8_STAGE(PG8_SA(1, 0), cA + kstep, voffA); PG8_STAGE(PG8_SB(1, 1), cB + hstep + kstep, voffB);
    PG8_WAIT_V(6); PG8_BAR;
    for (;;) {
        const bool has_next = S.next(ui + 1, nxt);
        const char* nA = has_next ? (const char*)g.A + (size_t)nxt.pm * tstep : cA; const char* nB = has_next ? (const char*)g.Bt + (size_t)nxt.pn * tstep : cB;
        for (int t = 0; t < nt; t += 2) {
            const bool last = (t == nt - 2);
            const char* a1 = cA + (size_t)(t + 1) * kstep;
            const char* a2 = last ? nA : cA + (size_t)(t + 2) * kstep; const char* b2 = last ? nB : cB + (size_t)(t + 2) * kstep;
            const char* a3 = a2 + kstep; const char* b3 = b2 + kstep;
            if (last && has_next) S.a_ready(nxt);
            PG8_LDB(B0, 0, 0); PG8_SCHED; PG8_LDA(At, 0, 0); PG8_STAGE(PG8_SA(1, 1), a1 + hstep, voffA);
            PG8_WAIT_L(8); PG8_BAR; PG8_WAIT_L(0); PG8_MMA(0, 0, At, B0); PG8_BAR; PG8_SCHED;
            PG8_LDB(B1, 0, 1); PG8_STAGE(PG8_SB(0, 0), b2, voffB);
            PG8_BAR; PG8_WAIT_L(0); PG8_MMA(0, 1, At, B1); PG8_BAR;
            PG8_LDA(At, 0, 1); PG8_STAGE(PG8_SA(0, 0), a2, voffA);
            PG8_BAR; PG8_WAIT_L(0); PG8_MMA(1, 0, At, B0); PG8_BAR; PG8_SCHED;
            PG8_STAGE(PG8_SB(0, 1), b2 + hstep, voffB);
            PG8_WAIT_V(6); PG8_BAR; PG8_MMA(1, 1, At, B1); PG8_BAR;
            PG8_LDB(B0, 1, 0); PG8_SCHED; PG8_LDA(At, 1, 0); PG8_STAGE(PG8_SA(0, 1), a2 + hstep, voffA);
            PG8_WAIT_L(8); PG8_BAR; PG8_WAIT_L(0); PG8_MMA(0, 0, At, B0); PG8_BAR; PG8_SCHED;
            PG8_LDB(B1, 1, 1); PG8_STAGE(PG8_SB(1, 0), b3, voffB);
            PG8_BAR; PG8_WAIT_L(0); PG8_MMA(0, 1, At, B1); PG8_BAR;
            PG8_LDA(At, 1, 1); PG8_STAGE(PG8_SA(1, 0), a3, voffA);
            PG8_BAR; PG8_WAIT_L(0); PG8_MMA(1, 0, At, B0); PG8_BAR; PG8_SCHED;
            PG8_STAGE(PG8_SB(1, 1), b3 + hstep, voffB);
            PG8_WAIT_V(6); PG8_BAR; PG8_MMA(1, 1, At, B1); PG8_BAR;
        }
        if constexpr (!Epi::AFTER_DRAIN) { E(acc, cur, wr, wc, fr, fq); S.done(cur); }
        if (!has_next) break;
#pragma unroll
        for (int a = 0; a < 2; ++a)
#pragma unroll
            for (int b = 0; b < 2; ++b)
#pragma unroll
                for (int m = 0; m < 4; ++m)
#pragma unroll
                    for (int n = 0; n < 2; ++n) acc[a][b][m][n] = (f32x4){0.f, 0.f, 0.f, 0.f};
        cur = nxt; cA = nA; cB = nB; ++ui;
    }
    PG8_WAIT_V(0);
    if (wr == 0) PG8_BAR;
    PG8_BAR;
#undef PG8_SA
#undef PG8_SB
#undef PG8_STAGE
#undef PG8_LDA
#undef PG8_LDB
#undef PG8_MMA
#undef PG8_WAIT_V
#undef PG8_WAIT_L
#undef PG8_BAR
#undef PG8_SCHED
}
}

__device__ __forceinline__ int win_col(int n) { return n < 2048 ? n : (n < 3072 ? n + 8 : n + 12); }
__device__ __forceinline__ int win_smcol(int j) { return j < 8 ? 2048 + j : 3080 + (j - 8); }

__device__ void ph_prep(const Params& p, LAS unsigned char* lds, int blk, int nblk) {
    const int tid = threadIdx.x;
    LAS float* tile = (LAS float*)lds;
    const int tiles_in = DEPTH * 64 * 16, tiles_out = DEPTH * 16 * 16;
    for (int t = blk; t < tiles_in + tiles_out; t += nblk) {
        const float* src; bf16_t* dst; int ld, n0, k0, l; const float* scale;
        if (t < tiles_in) { l = t / 1024; const int r = t % 1024; n0 = (r / 16) * 64; k0 = (r % 16) * 64; src = p.w_in + (size_t)l * DM * IN_DIM + win_col(n0); ld = IN_DIM;
            dst = (bf16_t*)(p.ws + WS_WINT) + (size_t)l * NBIG * DM; scale = p.norm_w + l * DM; }
        else { const int tt = t - tiles_in; l = tt / 256; const int r = tt % 256; n0 = (r / 16) * 64; k0 = (r % 16) * 64; src = p.w_out + (size_t)l * DM * DM + n0; ld = DM;
            dst = (bf16_t*)(p.ws + WS_WOUTT) + (size_t)l * DM * DM; scale = nullptr; }
        __syncthreads();
        for (int e = tid; e < 64 * 64; e += 512) { const int kk = e >> 6, nn = e & 63; float v = src[(size_t)(k0 + kk) * ld + nn]; if (scale) v *= scale[k0 + kk]; tile[kk * 65 + nn] = v; }
        __syncthreads();
        for (int e = tid; e < 64 * 32; e += 512) { const int nn = e >> 5, kp = (e & 31) * 2; const unsigned w = pack_bf2(tile[kp * 65 + nn], tile[(kp + 1) * 65 + nn]);
            *(unsigned*)(dst + (size_t)(n0 + nn) * DM + k0 + kp) = w; }
    }
    for (int e = blk * 512 + tid; e < DEPTH * NSM * DM; e += nblk * 512) { const int l = e / (NSM * DM), r = e % (NSM * DM), j = r / DM, k = r % DM;
        ((float*)(p.ws + WS_WSM))[e] = p.w_in[(size_t)l * DM * IN_DIM + (size_t)k * IN_DIM + win_smcol(j)] * p.norm_w[l * DM + k]; }
    for (int c = blk * 512 + tid; c < 256; c += nblk * 512) { float lg[DEPTH], mx = -1e30f;
#pragma unroll
        for (int l = 0; l < DEPTH; ++l) { lg[l] = p.lb_logits[l * 256 + c]; mx = fmaxf(mx, lg[l]); }
        float s = 0.f;
#pragma unroll
        for (int l = 0; l < DEPTH; ++l) { lg[l] = expf(lg[l] - mx); s += lg[l]; }
        float cum = 0.f; const float w0 = lg[0] / s;
#pragma unroll
        for (int l = 0; l < DEPTH; ++l) { cum += lg[l] / s; ((float*)(p.ws + WS_LB))[l * 256 + c] = fmaxf(cum - w0, 0.f); } }
    for (int e = blk * 512 + tid; e < (TP + 1) * 32; e += nblk * 512) { const int pi = e >> 5, i = e & 31; const double pos = pi < TP ? (double)pi : (double)PASTLEN;
        const float invf = (float)(1.0 / pow(10000.0, (double)((float)i / 31.0f)));
        const double rev = pos * (double)invf * 0.15915494309189535; const float fr = (float)(rev - rint(rev));
        ((float*)(p.ws + WS_ROT))[e * 2 + 0] = __builtin_amdgcn_cosf(fr); ((float*)(p.ws + WS_ROT))[e * 2 + 1] = __builtin_amdgcn_sinf(fr); }
    float* h = (float*)(p.ws + WS_H);
    for (int e = blk * 512 + tid; e < MROWS * (DM / 4); e += nblk * 512) { const int row = e >> 8, c4 = (e & 255) * 4; const float* src;
        if (row < MP) { const int b = row / TP, t = row % TP; src = t < NMETA ? p.meta + t * DM : p.x_prompt + ((size_t)b * SEQ + (t - NMETA)) * DM; } else src = p.x_sample + (size_t)(row - MP) * DM;
        *(f32x4*)(h + (size_t)row * DM + c4) = *(const f32x4*)(src + c4); }
}

__device__ void ph_rownorm(const Params& p, int layer, int blk, int nblk) {
    const int tid = threadIdx.x, wid = tid >> 6, lane = tid & 63;
    const float* h = (const float*)(p.ws + WS_H); bf16_t* hb = (bf16_t*)(p.ws + WS_HB); float* rs = (float*)(p.ws + WS_RS); float* psm = (float*)(p.ws + WS_PSM);
    const float* wsm = (const float*)(p.ws + WS_WSM) + (size_t)layer * NSM * DM;
    for (int row = blk * 8 + wid; row < MROWS; row += nblk * 8) {
        f32x4 v[4]; float ss = 0.f;
#pragma unroll
        for (int j = 0; j < 4; ++j) { v[j] = *(const f32x4*)(h + (size_t)row * DM + j * 256 + lane * 4); ss += v[j][0] * v[j][0] + v[j][1] * v[j][1] + v[j][2] * v[j][2] + v[j][3] * v[j][3]; }
        ss = wave_sum(ss); const float r = rsqrtf(ss * (1.0f / DM) + EPSF);
#pragma unroll
        for (int j = 0; j < 4; ++j) { u32x2 w; w.x = pack_bf2(v[j][0], v[j][1]); w.y = pack_bf2(v[j][2], v[j][3]); *(u32x2*)(hb + (size_t)row * DM + j * 256 + lane * 4) = w; }
        float mine = 0.f;
        for (int q = 0; q < NSM; ++q) { float d = 0.f;
#pragma unroll
            for (int j = 0; j < 4; ++j) { const f32x4 w = *(const f32x4*)(wsm + q * DM + j * 256 + lane * 4); d += v[j][0] * w[0] + v[j][1] * w[1] + v[j][2] * w[2] + v[j][3] * w[3]; }
            d = wave_sum(d); if (lane == q) mine = d * r; }
        if (lane < NSM) psm[(size_t)row * NSM + lane] = mine;
        if (lane == 0) rs[row] = r;
    }
}

__device__ void ph_gemm_in(const Params& p, int layer, LAS unsigned char* lds, int blk, int nblk) {
    pg8::Gemm g{(const bf16_t*)(p.ws + WS_HB), (const bf16_t*)(p.ws + WS_WINT) + (size_t)layer * NBIG * DM, MROWS, NBIG, DM};
    pg8::StaticOrder S; S.init(MROWS, NBIG, nblk, blk);
    pg8::EpiProj E{(bf16_t*)(p.ws + WS_PROJ), NBIG, (const float*)(p.ws + WS_RS)};
    pg8::gemm_phase<pg8::EpiProj, pg8::StaticOrder>(lds, g, S, E);
}
__device__ void ph_gemm_out(const Params& p, int layer, LAS unsigned char* lds, int blk, int nblk) {
    pg8::Gemm g{(const bf16_t*)(p.ws + WS_Y), (const bf16_t*)(p.ws + WS_WOUTT) + (size_t)layer * DM * DM, MROWS, DM, DM};
    pg8::StaticOrder S; S.init(MROWS, DM, nblk, blk);
    pg8::EpiResid E{(float*)(p.ws + WS_H), DM};
    pg8::gemm_phase<pg8::EpiResid, pg8::StaticOrder>(lds, g, S, E);
}

constexpr int TB = 16;
struct MixLds {
    static constexpr int QS = 0, KS = QS + TB * 128, VS = KS + TB * 128, DS = VS + TB * 128, ZS = DS + TB * 128, XS = ZS + TB * 128, OS = XS + TB * 128, BS = OS + TB * 128, SC = BS + TB * 2, END = SC + TB * 2;
};

struct SeqInfo { int row0, T, dec, b; };
__device__ __forceinline__ SeqInfo seq_info(int s) { SeqInfo q; if (s < NB) { q.row0 = s * TP; q.T = TP; q.dec = 0; q.b = s; } else { q.row0 = MP + (s - NB); q.T = 1; q.dec = 1; q.b = s - NB; } return q; }

__device__ __forceinline__ float preconv(const bf16_t* proj, const SeqInfo& q, int t, int col, const float* ctx  , int ch) {
    if (t >= 0) return bf2f(proj[(size_t)(q.row0 + t) * NBIG + col]);
    return ctx ? ctx[(3 + t) * 768 + ch] : 0.f;
}

template <int DK, int NV, bool DELTA, bool VECDEC>
__device__ __forceinline__ void recur_batch(float (&S)[DK / (64 / NV)], LAS float* L, int nb, int wid, int lane) {
    constexpr int KQ = 64 / NV, KR = DK / KQ, DVT = 8 * NV;
    const int kq = lane / NV, vv = lane % NV, vcol = wid * NV + vv, hh = vcol >> 6;
    for (int t = 0; t < nb; ++t) {
        float kk[KR], qq[KR];
#pragma unroll
        for (int i = 0; i < KR; ++i) { kk[i] = L[MixLds::KS + t * 128 + kq * KR + i]; qq[i] = L[MixLds::QS + t * 128 + kq * KR + i]; }
        const float v = L[MixLds::VS + t * 128 + vcol];
        if (DELTA) {
            const float dec = L[MixLds::DS + t * 128 + hh]; float pk = 0.f;
#pragma unroll
            for (int i = 0; i < KR; ++i) { S[i] *= dec; pk += kk[i] * S[i]; }
#pragma unroll
            for (int o = NV; o < 64; o <<= 1) pk += __shfl_xor(pk, o);
            const float u = L[MixLds::BS + t] * (v - pk);
#pragma unroll
            for (int i = 0; i < KR; ++i) S[i] += kk[i] * u;
        } else if (VECDEC) {
#pragma unroll
            for (int i = 0; i < KR; ++i) S[i] = L[MixLds::DS + t * 128 + kq * KR + i] * S[i] + kk[i] * v;
        } else {
            const float dec = L[MixLds::DS + t * 128 + hh];
#pragma unroll
            for (int i = 0; i < KR; ++i) S[i] = dec * S[i] + kk[i] * v;
        }
        float po = 0.f;
#pragma unroll
        for (int i = 0; i < KR; ++i) po += qq[i] * S[i];
#pragma unroll
        for (int o = NV; o < 64; o <<= 1) po += __shfl_xor(po, o);
        if (kq == 0) L[MixLds::OS + t * 128 + vcol] = po;
    }
    (void)DVT;
}

template <int MIX>
__device__ void mixer_item(const Params& p, int layer, int s, int hu  , LAS float* L) {
    constexpr int DK = MIX == 2 ? 128 : 64, NV = MIX == 2 ? 16 : 8, KQ = 64 / NV, KR = DK / KQ, DVT = 8 * NV;
    const int tid = threadIdx.x, wid = tid >> 6, lane = tid & 63;
    const SeqInfo q = seq_info(s);
    const bf16_t* proj = (const bf16_t*)(p.ws + WS_PROJ); const float* psm = (const float*)(p.ws + WS_PSM); bf16_t* y = (bf16_t*)(p.ws + WS_Y);
    const float* lb = (const float*)(p.ws + WS_LB) + layer * 256; const float* rot = (const float*)(p.ws + WS_ROT);
    const int kq = lane / NV, vv = lane % NV, vcol = wid * NV + vv, hh = vcol >> 6;
    const int head = MIX == 2 ? hu * 2 + hh : hu;
    const float* ctx = nullptr; const float* cw = nullptr;
    if (MIX == 1) { cw = p.gdn_conv_w + (size_t)layer * 4 * 768; if (q.dec) ctx = p.st_gconv + ((size_t)layer * DECB + q.b) * 3 * 768; }
    if (MIX == 2) { cw = p.ssd_conv_w + (size_t)layer * 4 * 768; if (q.dec) ctx = p.st_sconv + ((size_t)layer * DECB + q.b) * 3 * 768; }
    float S[KR];
    {
        const float* st = MIX == 0 ? p.st_hgrn : MIX == 1 ? p.st_gdn : MIX == 2 ? p.st_ssd : p.st_ret;
#pragma unroll
        for (int i = 0; i < KR; ++i) S[i] = q.dec ? st[(((size_t)layer * DECB + q.b) * 4 + head) * DK * 64 + (size_t)(kq * KR + i) * 64 + (vcol & 63)] : 0.f;
    }
    float hc0 = 0.f, hc1 = 0.f;
    if (MIX == 1) { hc0 = -__expf(p.gdn_a_log[layer * 4 + hu]); hc1 = p.gdn_dt_bias[layer * 4 + hu]; }
    if (MIX == 3) { hc0 = 1.0f - exp2f(-5.0f - (float)hu); }

    for (int t0 = 0; t0 < q.T; t0 += TB) {
        const int nb = min(TB, q.T - t0);
        __syncthreads();
        if (MIX == 0) {
            for (int e = tid; e < nb * 64; e += 512) { const int t = e >> 6, d = e & 63, c = hu * 64 + d; const bf16_t* pr = proj + (size_t)(q.row0 + t0 + t) * NBIG;
                const float aq = bf2f(pr[PC_AQ + c]), af = bf2f(pr[PC_AF + c]), ai = bf2f(pr[PC_AI + c]), az = bf2f(pr[PC_AZ + c]), l_ = lb[c];
                L[MixLds::QS + t * 128 + d] = silu_f(aq) * 0.125f; L[MixLds::KS + t * 128 + d] = (1.0f - l_) * sigmoid_f(-af); L[MixLds::DS + t * 128 + d] = l_ + (1.0f - l_) * sigmoid_f(af);
                L[MixLds::VS + t * 128 + d] = ai; L[MixLds::ZS + t * 128 + d] = az; }
        } else if (MIX == 1) {
            for (int e = tid; e < nb * 192; e += 512) { const int t = e / 192, r = e % 192, part = r >> 6, d = r & 63, ch = part * 256 + hu * 64 + d, col = PC_BQKV + ch; const int tt = t0 + t;
                float a = 0.f;
#pragma unroll
                for (int j = 0; j < 4; ++j) a += cw[j * 768 + ch] * preconv(proj, q, tt - 3 + j, col, ctx, ch);
                a = silu_f(a);
                L[(part == 0 ? MixLds::QS : part == 1 ? MixLds::KS : MixLds::VS) + t * 128 + d] = a; }
            for (int e = tid; e < nb * 64; e += 512) { const int t = e >> 6, d = e & 63; L[MixLds::ZS + t * 128 + d] = bf2f(proj[(size_t)(q.row0 + t0 + t) * NBIG + PC_BZ + hu * 64 + d]); }
            if (tid < nb) { const float* ps = psm + (size_t)(q.row0 + t0 + tid) * NSM; const float g = hc0 * softplus_f(ps[hu] + hc1);
                L[MixLds::DS + tid * 128 + 0] = __expf(g); L[MixLds::BS + tid] = sigmoid_f(ps[4 + hu]); }
            __syncthreads();
            if (tid < nb * 2) { const int t = tid >> 1, which = tid & 1; const LAS float* src = L + (which ? MixLds::KS : MixLds::QS) + t * 128; float ss = 0.f;
                for (int d = 0; d < 64; ++d) ss += src[d] * src[d];
                L[MixLds::SC + tid] = rsqrtf(ss + EPSF) * (which ? 1.0f : 0.125f); }
            __syncthreads();
            for (int e = tid; e < nb * 128; e += 512) { const int t = e >> 7, r = e & 127, which = r >> 6, d = r & 63; L[(which ? MixLds::KS : MixLds::QS) + t * 128 + d] *= L[MixLds::SC + t * 2 + which]; }
        } else if (MIX == 2) {
            if (tid < nb * 2) { const int t = tid >> 1, h2 = tid & 1, hd = hu * 2 + h2; const float dt = softplus_f(psm[(size_t)(q.row0 + t0 + t) * NSM + 8 + hd] + p.ssd_dt_bias[layer * 4 + hd]);
                L[MixLds::BS + tid] = dt; L[MixLds::DS + t * 128 + h2] = __expf(-dt * __expf(p.ssd_a_log[layer * 4 + hd])); }
            __syncthreads();
            for (int e = tid; e < nb * 384; e += 512) { const int t = e / 384, r = e % 384, part = r >> 7, j = r & 127, ch = part * 256 + hu * 128 + j, col = PC_CXBC + ch; const int tt = t0 + t;
                float a = p.ssd_conv_b[layer * 768 + ch];
#pragma unroll
                for (int jj = 0; jj < 4; ++jj) a += cw[jj * 768 + ch] * preconv(proj, q, tt - 3 + jj, col, ctx, ch);
                a = silu_f(a);
                if (part == 0) { L[MixLds::XS + t * 128 + j] = a; L[MixLds::VS + t * 128 + j] = a * L[MixLds::BS + t * 2 + (j >> 6)]; }
                else if (part == 1) L[MixLds::KS + t * 128 + j] = a; else L[MixLds::QS + t * 128 + j] = a; }
            for (int e = tid; e < nb * 128; e += 512) { const int t = e >> 7, j = e & 127; L[MixLds::ZS + t * 128 + j] = bf2f(proj[(size_t)(q.row0 + t0 + t) * NBIG + PC_CZ + hu * 128 + j]); }
        } else {
            for (int e = tid; e < nb * 32; e += 512) { const int t = e >> 5, i = e & 31; const bf16_t* pr = proj + (size_t)(q.row0 + t0 + t) * NBIG; const int pidx = q.dec ? TP : (t0 + t);
                const float cs = rot[(pidx * 32 + i) * 2], sn = rot[(pidx * 32 + i) * 2 + 1];
                const float q1 = bf2f(pr[PC_DQ + hu * 64 + i]), q2 = bf2f(pr[PC_DQ + hu * 64 + 32 + i]), k1 = bf2f(pr[PC_DK + hu * 64 + i]), k2 = bf2f(pr[PC_DK + hu * 64 + 32 + i]);
                L[MixLds::QS + t * 128 + i] = q1 * cs - q2 * sn; L[MixLds::QS + t * 128 + 32 + i] = q2 * cs + q1 * sn;
                L[MixLds::KS + t * 128 + i] = (k1 * cs - k2 * sn) * 0.125f; L[MixLds::KS + t * 128 + 32 + i] = (k2 * cs + k1 * sn) * 0.125f; }
            for (int e = tid; e < nb * 64; e += 512) { const int t = e >> 6, d = e & 63; const bf16_t* pr = proj + (size_t)(q.row0 + t0 + t) * NBIG;
                L[MixLds::VS + t * 128 + d] = bf2f(pr[PC_DV + hu * 64 + d]); L[MixLds::ZS + t * 128 + d] = bf2f(pr[PC_DZ + hu * 64 + d]); }
            if (tid < nb) L[MixLds::DS + tid * 128] = hc0;
        }
        __syncthreads();
        recur_batch<DK, NV, MIX == 1, MIX == 0>(S, L, nb, wid, lane);
        __syncthreads();
        for (int t = wid; t < nb; t += 8) {
            const size_t yrow = (size_t)(q.row0 + t0 + t) * DM;
            if (MIX == 0 || MIX == 1) { const float o = L[MixLds::OS + t * 128 + lane]; const float ms = wave_sum(o * o) * (1.0f / 64.0f);
                const float w = (MIX == 0 ? p.hgrn_norm_w : p.gdn_norm_w)[layer * 256 + hu * 64 + lane];
                y[yrow + (MIX == 0 ? 0 : 256) + hu * 64 + lane] = f2bf(o * rsqrtf(ms + EPSF) * w * silu_f(L[MixLds::ZS + t * 128 + lane])); }
            else if (MIX == 2) { float u[2]; float ss = 0.f;
#pragma unroll
                for (int r = 0; r < 2; ++r) { const int j = lane + 64 * r; const float o = L[MixLds::OS + t * 128 + j] + p.ssd_d[layer * 4 + hu * 2 + r] * L[MixLds::XS + t * 128 + j]; u[r] = o * silu_f(L[MixLds::ZS + t * 128 + j]); ss += u[r] * u[r]; }
                const float sc = rsqrtf(wave_sum(ss) * (1.0f / 128.0f) + EPSF);
#pragma unroll
                for (int r = 0; r < 2; ++r) { const int j = lane + 64 * r; y[yrow + 512 + hu * 128 + j] = f2bf(u[r] * sc * p.ssd_norm_w[layer * 256 + hu * 128 + j]); } }
            else { const float o = L[MixLds::OS + t * 128 + lane]; const float mu = wave_sum(o) * (1.0f / 64.0f); const float dv = o - mu; const float var = wave_sum(dv * dv) * (1.0f / 64.0f);
                const int c = hu * 64 + lane;
                y[yrow + 768 + c] = f2bf((dv * rsqrtf(var + EPSF) * p.ret_norm_w[layer * 256 + c] + p.ret_norm_b[layer * 256 + c]) * silu_f(L[MixLds::ZS + t * 128 + lane])); }
        }
    }
    {
        float* so = p.out + (q.dec ? (MIX == 0 ? O_HGRN_S : MIX == 1 ? O_GDN_S : MIX == 2 ? O_SSD_S : O_RET_S) : (MIX == 0 ? O_HGRN_P : MIX == 1 ? O_GDN_P : MIX == 2 ? O_SSD_P : O_RET_P));
        const int nbt = q.dec ? DECB : NB;
#pragma unroll
        for (int i = 0; i < KR; ++i) so[(((size_t)layer * nbt + q.b) * 4 + head) * DK * 64 + (size_t)(kq * KR + i) * 64 + (vcol & 63)] = S[i];
    }
    if (MIX == 1 || MIX == 2) {
        float* co = p.out + (q.dec ? (MIX == 1 ? O_GCONV_S : O_SCONV_S) : (MIX == 1 ? O_GCONV_P : O_SCONV_P)) + ((size_t)layer * (q.dec ? DECB : NB) + q.b) * 3 * 768;
        const int nch = MIX == 1 ? 192 : 384;
        for (int e = tid; e < 3 * nch; e += 512) { const int r = e / nch, c = e % nch; int ch;
            if (MIX == 1) ch = (c >> 6) * 256 + hu * 64 + (c & 63); else ch = (c >> 7) * 256 + hu * 128 + (c & 127);
            co[r * 768 + ch] = preconv(proj, q, q.T - 3 + r, (MIX == 1 ? PC_BQKV : PC_CXBC) + ch, ctx, ch); }
    }
    (void)DVT;
}

constexpr int N_SEQ = NB + DECB, N_MU = 14, N_ITEMS = N_SEQ * N_MU;
__device__ void ph_mixer(const Params& p, int layer, LAS unsigned char* lds, int blk, int nblk) {
    LAS float* L = (LAS float*)lds;
    for (int it = blk; it < N_ITEMS; it += nblk) {
        const int s = it / N_MU, mu = it % N_MU;
        if (mu < 4) mixer_item<0>(p, layer, s, mu, L);
        else if (mu < 8) mixer_item<1>(p, layer, s, mu - 4, L);
        else if (mu < 10) mixer_item<2>(p, layer, s, mu - 8, L);
        else mixer_item<3>(p, layer, s, mu - 10, L);
    }
}

__device__ void ph_final(const Params& p, int blk, int nblk) {
    const int tid = threadIdx.x, wid = tid >> 6, lane = tid & 63;
    const float* h = (const float*)(p.ws + WS_H);
    for (int row = blk * 8 + wid; row < MROWS; row += nblk * 8) {
        float* dst;
        if (row < MP) { const int b = row / TP, t = row % TP; if (t < NMETA) continue; dst = p.out + O_YP + ((size_t)b * SEQ + (t - NMETA)) * DM; } else dst = p.out + O_YS + (size_t)(row - MP) * DM;
        f32x4 v[4]; float ss = 0.f;
#pragma unroll
        for (int j = 0; j < 4; ++j) { v[j] = *(const f32x4*)(h + (size_t)row * DM + j * 256 + lane * 4); ss += v[j][0] * v[j][0] + v[j][1] * v[j][1] + v[j][2] * v[j][2] + v[j][3] * v[j][3]; }
        const float r = rsqrtf(wave_sum(ss) * (1.0f / DM) + EPSF);
#pragma unroll
        for (int j = 0; j < 4; ++j) { const f32x4 w = *(const f32x4*)(p.final_norm_w + j * 256 + lane * 4); *(f32x4*)(dst + j * 256 + lane * 4) = v[j] * r * w; }
    }
}

constexpr int LDS_BYTES = pg8::STAGE_BYTES;
static_assert(MixLds::END * 4 <= LDS_BYTES, "mixer LDS");

__global__ void __launch_bounds__(512, 2) k_phase(Params p, int phase, int layer) {
    extern __shared__ __attribute__((aligned(16))) unsigned char smem[];
    LAS unsigned char* lds = (LAS unsigned char*)smem;
    const int blk = blockIdx.x, nblk = gridDim.x;
    switch (phase) {
        case 0: ph_prep(p, lds, blk, nblk); break;
        case 1: ph_rownorm(p, layer, blk, nblk); break;
        case 2: ph_gemm_in(p, layer, lds, blk, nblk); break;
        case 3: ph_mixer(p, layer, lds, blk, nblk); break;
        case 4: ph_gemm_out(p, layer, lds, blk, nblk); break;
        default: ph_final(p, blk, nblk); break;
    }
}

extern "C" void kernel_launch(void* const* d_in, const int* in_sizes, int n_in, void* d_out, int out_size, void* d_ws, size_t ws_size, hipStream_t stream) {
    static int ready = 0;
    if (!ready) {
        if (n_in != 27 || (size_t)out_size != O_END || ws_size < WS_END) { fprintf(stderr, "kernel_launch: unexpected shapes: n_in %d out %d (want %zu) ws %zu (want %zu)\n", n_in, out_size, (size_t)O_END, ws_size, (size_t)WS_END); ready = -1; return; }
        if (hipFuncSetAttribute((const void*)k_phase, hipFuncAttributeMaxDynamicSharedMemorySize, LDS_BYTES) != hipSuccess) { fprintf(stderr, "kernel_launch: hipFuncSetAttribute failed\n"); ready = -1; return; }
        ready = 1;
    }
    if (ready < 0) return;
    Params p{};
    const float** pp = (const float**)&p;
    for (int i = 0; i < 27; ++i) pp[i] = (const float*)d_in[i];
    p.out = (float*)d_out; p.ws = (unsigned char*)d_ws;
    const int grid = 256;
    auto launch = [&](int phase, int layer) { hipLaunchKernelGGL(k_phase, dim3(grid), dim3(512), LDS_BYTES, stream, p, phase, layer); };
    launch(0, 0);
    for (int l = 0; l < DEPTH; ++l) { launch(1, l); launch(2, l); launch(3, l); launch(4, l); }
    launch(5, 0);
}
```

```cpp
#include <hip/hip_runtime.h>
#include <hip/hip_cooperative_groups.h>
#include <cstdio>
#include <cstdint>

#define LAS __attribute__((address_space(3)))
typedef unsigned short bf16_t;
typedef short bf16x8 __attribute__((ext_vector_type(8)));
typedef float f32x4 __attribute__((ext_vector_type(4)));
typedef unsigned u32x4 __attribute__((ext_vector_type(4)));
typedef unsigned u32x2 __attribute__((ext_vector_type(2)));

constexpr int DM = 1024, NB = 8, SEQ = 2048, DEPTH = 4, DECB = 128, NMETA = 16, TP = SEQ + NMETA;
constexpr int MP = NB * TP;
constexpr int MROWS = MP + DECB;
constexpr int IN_DIM = 4108, NBIG = 4096, NSM = 12;
constexpr int PASTLEN = 16384;
constexpr float EPSF = 1e-6f;
constexpr int PC_AQ = 0, PC_AF = 256, PC_AI = 512, PC_AZ = 768, PC_BQKV = 1024, PC_BZ = 1792, PC_CXBC = 2048, PC_CZ = 2816, PC_DQ = 3072, PC_DK = 3328, PC_DV = 3584, PC_DZ = 3840;

constexpr size_t WS_BAR = 0;
constexpr size_t WS_WINT = 16384;
constexpr size_t WS_WOUTT = WS_WINT + (size_t)DEPTH * NBIG * DM * 2;
constexpr size_t WS_WSM = WS_WOUTT + (size_t)DEPTH * DM * DM * 2;
constexpr size_t WS_LB = WS_WSM + (size_t)DEPTH * NSM * DM * 4;
constexpr size_t WS_ROT = WS_LB + (size_t)DEPTH * 256 * 4;
constexpr size_t ROT_BYTES = ((size_t)(TP + 1) * 64 * 4 + 255) / 256 * 256;
constexpr size_t WS_H = WS_ROT + ROT_BYTES;
constexpr size_t WS_HB = WS_H + (size_t)MROWS * DM * 4;
constexpr size_t WS_RS = WS_HB + (size_t)MROWS * DM * 2;
constexpr size_t WS_PSM = WS_RS + (size_t)MROWS * 4;
constexpr size_t WS_PROJ = WS_PSM + (size_t)MROWS * NSM * 4;
constexpr size_t WS_Y = WS_PROJ + (size_t)MROWS * NBIG * 2;
constexpr size_t WS_END = WS_Y + (size_t)MROWS * DM * 2;

constexpr size_t O_YP = 0;
constexpr size_t O_YS = O_YP + (size_t)NB * SEQ * DM;
constexpr size_t O_HGRN_P = O_YS + (size_t)DECB * DM;
constexpr size_t O_GDN_P = O_HGRN_P + (size_t)DEPTH * NB * 4 * 64 * 64;
constexpr size_t O_GCONV_P = O_GDN_P + (size_t)DEPTH * NB * 4 * 64 * 64;
constexpr size_t O_SSD_P = O_GCONV_P + (size_t)DEPTH * NB * 3 * 768;
constexpr size_t O_SCONV_P = O_SSD_P + (size_t)DEPTH * NB * 4 * 128 * 64;
constexpr size_t O_RET_P = O_SCONV_P + (size_t)DEPTH * NB * 3 * 768;
constexpr size_t O_HGRN_S = O_RET_P + (size_t)DEPTH * NB * 4 * 64 * 64;
constexpr size_t O_GDN_S = O_HGRN_S + (size_t)DEPTH * DECB * 4 * 64 * 64;
constexpr size_t O_GCONV_S = O_GDN_S + (size_t)DEPTH * DECB * 4 * 64 * 64;
constexpr size_t O_SSD_S = O_GCONV_S + (size_t)DEPTH * DECB * 3 * 768;
constexpr size_t O_SCONV_S = O_SSD_S + (size_t)DEPTH * DECB * 4 * 128 * 64;
constexpr size_t O_RET_S = O_SCONV_S + (size_t)DEPTH * DECB * 3 * 768;
constexpr size_t O_END = O_RET_S + (size_t)DEPTH * DECB * 4 * 64 * 64;

struct Params {
    const float* x_prompt; const float* x_sample;
    const float* st_hgrn; const float* st_gdn; const float* st_gconv; const float* st_ssd; const float* st_sconv; const float* st_ret;
    const float* meta; const float* norm_w; const float* w_in; const float* lb_logits; const float* hgrn_norm_w;
    const float* gdn_conv_w; const float* gdn_a_log; const float* gdn_dt_bias; const float* gdn_norm_w;
    const float* ssd_conv_w; const float* ssd_conv_b; const float* ssd_a_log; const float* ssd_dt_bias; const float* ssd_d; const float* ssd_norm_w;
    const float* ret_norm_w; const float* ret_norm_b; const float* w_out; const float* final_norm_w;
    float* out; unsigned char* ws;
};

__device__ __forceinline__ float bf2f(bf16_t b) { return __uint_as_float(((unsigned)b) << 16); }
__device__ __forceinline__ bf16_t f2bf(float f) { unsigned u = __float_as_uint(f); u += 0x7FFFu + ((u >> 16) & 1u); return (bf16_t)(u >> 16); }
__device__ __forceinline__ unsigned pack_bf2(float lo, float hi) { return (unsigned)f2bf(lo) | ((unsigned)f2bf(hi) << 16); }
__device__ __forceinline__ float sigmoid_f(float x) { return 1.0f / (1.0f + __expf(-x)); }
__device__ __forceinline__ float silu_f(float x) { return x / (1.0f + __expf(-x)); }
__device__ __forceinline__ float softplus_f(float x) { return x > 20.0f ? x : log1pf(__expf(x)); }
__device__ __forceinline__ int opaque_tid() { int t = threadIdx.x; asm volatile("" : "+v"(t)); return t; }
__device__ __forceinline__ float wave_sum(float v) {
#pragma unroll
    for (int o = 32; o > 0; o >>= 1) v += __shfl_xor(v, o);
    return v;
}


#define XB_TMO      128
#define XB_XCNT(j)  (256  + 64 * (j))
#define XB_XSUB(j)  (1280 + 64 * (j))
#define XB_XGEN(j)  (2304 + 64 * (j))
#define XB_TOP      3328
#define XB_TOPGEN   3392
#define XCD_BAR_WORDS 3456
#define XB_SPIN_CAP (1u << 22)
__device__ __forceinline__ unsigned xb_ld(unsigned* p)              { return __hip_atomic_load(p, __ATOMIC_RELAXED, __HIP_MEMORY_SCOPE_AGENT); }
__device__ __forceinline__ unsigned xb_add(unsigned* p, unsigned v) { return __hip_atomic_fetch_add(p, v, __ATOMIC_RELAXED, __HIP_MEMORY_SCOPE_AGENT); }
__device__ __forceinline__ unsigned xb_xcc_id() { return (unsigned)__builtin_amdgcn_s_getreg((3 << 11) | 20) & 0xFu; }
#define XB_SPIN(cond, bar) do { unsigned _sp = 0; while (cond) { __builtin_amdgcn_s_sleep(1); \
    if ((++_sp & 255u) == 0u) { if (xb_ld(&(bar)[XB_TMO])) break; if (_sp > XB_SPIN_CAP) { atomicAdd(&(bar)[XB_TMO], 1u); break; } } } } while (0)
struct XcdBarrier { unsigned* bar; unsigned x; volatile LAS unsigned* st; };
__device__ __forceinline__ XcdBarrier xcd_barrier_post(unsigned* bar, volatile LAS unsigned* st) {
    XcdBarrier b; b.bar = bar; b.x = xb_xcc_id(); b.st = st;
    if (threadIdx.x == 0) (void)xb_add(&bar[XB_XCNT(b.x)], 1u);
    return b;
}
__device__ __forceinline__ void xcd_barrier_complete(unsigned* bar, unsigned x, unsigned& nloc, unsigned& nx) {
    const unsigned G = gridDim.x * gridDim.y * gridDim.z;
    unsigned sum, cnt, mine, sp = 0u;
    for (;;) {
        sum = 0u; cnt = 0u; mine = 0u;
#pragma unroll
        for (unsigned j = 0; j < 16; ++j) { const unsigned c = xb_ld(&bar[XB_XCNT(j)]); sum += c; cnt += (c > 0u) ? 1u : 0u; mine = (j == x) ? c : mine; }
        if (sum == G) break;
        __builtin_amdgcn_s_sleep(1);
        if ((++sp & 255u) == 0u) { if (xb_ld(&bar[XB_TMO])) break; if (sp > XB_SPIN_CAP) { atomicAdd(&bar[XB_TMO], 1u); break; } }
    }
    nloc = mine > 0u ? mine : 1u; nx = cnt > 0u ? cnt : 1u;
}
__device__ __forceinline__ void xcd_barrier(const XcdBarrier& b) {
    asm volatile("s_waitcnt vmcnt(0)" ::: "memory");
    __syncthreads();
    if (threadIdx.x == 0) {
        unsigned* bar = b.bar;
        __builtin_amdgcn_s_waitcnt(0);
        unsigned nloc = b.st[0], nx = b.st[1];
        if (nloc == 0u) { xcd_barrier_complete(bar, b.x, nloc, nx); b.st[0] = nloc; b.st[1] = nx; }
        const unsigned old = xb_add(&bar[XB_XSUB(b.x)], 1u);
        const unsigned gen = old / nloc;
        if (old + 1u == (gen + 1u) * nloc) {
            __builtin_amdgcn_fence(__ATOMIC_RELEASE, "agent");
            asm volatile("s_waitcnt vmcnt(0)" ::: "memory");
            const unsigned og = xb_add(&bar[XB_TOP], 1u);
            const unsigned tg = og / nx;
            if (og + 1u == (tg + 1u) * nx) xb_add(&bar[XB_TOPGEN], 1u);
            else XB_SPIN(xb_ld(&bar[XB_TOPGEN]) == tg, bar);
            __builtin_amdgcn_fence(__ATOMIC_ACQUIRE, "agent");
            xb_add(&bar[XB_XGEN(b.x)], 1u);
            asm volatile("s_waitcnt vmcnt(0)" ::: "memory");
        } else {
            XB_SPIN(xb_ld(&bar[XB_XGEN(b.x)]) == gen, bar);
            __builtin_amdgcn_fence(__ATOMIC_ACQUIRE, "agent");
            asm volatile("s_waitcnt vmcnt(0)" ::: "memory");
        }
    }
    __syncthreads();
}

namespace pg8 {
constexpr int BM = 256, BK = 64, HALF = 128, HTB = HALF * BK * 2, STAGE_BYTES = 8 * HTB, NXCD = 8, WGM = 8;
__host__ __device__ __forceinline__ int lds_byte(int r, int c) { const int st = (r >> 4) * 2 + (c >> 5), rr = r & 15, cc = c & 31, ob = rr * 64 + cc * 2; return st * 1024 + (ob ^ (((ob >> 9) & 1) << 5)); }
__host__ __device__ __forceinline__ void stage_rc(int b, int& R, int& C) { const int st = b / 1024, sb = b % 1024, swz = sb ^ (((sb >> 9) & 1) << 5); R = (st >> 1) * 16 + swz / 64; C = (st & 1) * 32 + (swz % 64) / 2; }
__host__ __device__ __forceinline__ int perm32(int rho) { const int n = rho >> 4, i = rho & 15; return 8 * (i >> 2) + 4 * n + (i & 3); }
struct Unit { int pm, pn; };
struct Gemm { const bf16_t* A; const bf16_t* Bt; int M, N, K; };
struct StaticOrder {
    int nM, nN, nwg, G, c;
    __host__ __device__ void init(int M, int N, int G_, int c_) { nM = M / BM; nN = N / BM; nwg = nM * nN; G = G_; c = c_; }
    __host__ __device__ bool next(int i, Unit& u) const {
        const long L = (long)i * G + c; if (L >= nwg) return false;
        int wgid = (int)L; { const int q = nwg / NXCD, r = nwg % NXCD, xcd = wgid % NXCD, off = wgid / NXCD; wgid = (xcd < r ? xcd * (q + 1) : r * (q + 1) + (xcd - r) * q) + off; }
        const int nig = WGM * nN, gid = wgid / nig, fm = gid * WGM, gsz = (nM - fm) < WGM ? (nM - fm) : WGM;
        u.pm = fm + ((wgid % nig) % gsz); u.pn = (wgid % nig) / gsz; return true;
    }
    __device__ __forceinline__ void a_ready(const Unit&) const {}
    __device__ __forceinline__ void done(const Unit&) const {}
};
__device__ __forceinline__ unsigned cvt_pk_bf16(float lo, float hi) { unsigned r; asm volatile("v_cvt_pk_bf16_f32 %0, %1, %2" : "=v"(r) : "v"(lo), "v"(hi)); return r; }

struct EpiProj {
    static constexpr bool PERM = true, AFTER_DRAIN = false;
    bf16_t* O; int ldc; const float* rs;
    __device__ __forceinline__ void operator()(const f32x4 (&acc)[2][2][4][2], const Unit& u, int wr, int wc, int fr, int fq) const {
        const int row0 = u.pm * BM + wr * 64 + fr; const int col0 = u.pn * BM + wc * 32 + 8 * fq;
#pragma unroll
        for (int ai = 0; ai < 2; ++ai)
#pragma unroll
            for (int m = 0; m < 4; ++m) { const int row = row0 + ai * HALF + m * 16; const float s = rs[row]; bf16_t* rowp = O + (size_t)row * ldc + col0;
#pragma unroll
                for (int bj = 0; bj < 2; ++bj) { const f32x4 v0 = acc[ai][bj][m][0] * s, v1 = acc[ai][bj][m][1] * s;
                    u32x4 w; w.x = cvt_pk_bf16(v0[0], v0[1]); w.y = cvt_pk_bf16(v0[2], v0[3]); w.z = cvt_pk_bf16(v1[0], v1[1]); w.w = cvt_pk_bf16(v1[2], v1[3]);
                    *(u32x4*)(rowp + bj * HALF) = w; } }
    }
};
struct EpiResid {
    static constexpr bool PERM = false, AFTER_DRAIN = false;
    float* C; int ldc;
    __device__ __forceinline__ void operator()(const f32x4 (&acc)[2][2][4][2], const Unit& u, int wr, int wc, int fr, int fq) const {
        const int row0 = u.pm * BM + wr * 64 + fr, col0 = u.pn * BM + wc * 32 + 4 * fq;
#pragma unroll
        for (int ai = 0; ai < 2; ++ai)
#pragma unroll
            for (int m = 0; m < 4; ++m) { float* rowp = C + (size_t)(row0 + ai * HALF + m * 16) * ldc + col0;
#pragma unroll
                for (int bj = 0; bj < 2; ++bj)
#pragma unroll
                    for (int n = 0; n < 2; ++n) { f32x4* p = (f32x4*)(rowp + bj * HALF + n * 16); *p = *p + acc[ai][bj][m][n]; } }
    }
};

template <class Epi, class Sched>
__device__ __forceinline__ void gemm_phase(LAS unsigned char* lds, const Gemm g, const Sched& S, const Epi& E) {
    const int tid = opaque_tid(), wid = __builtin_amdgcn_readfirstlane(tid >> 6), lane = tid & 63, wr = wid >> 2, wc = wid & 3, fr = lane & 15, fq = lane >> 4;
    const int K = g.K, nt = K / BK;
    unsigned voffA[2], voffB[2];
#pragma unroll
    for (int i = 0; i < 2; ++i) { int R, C; stage_rc(tid * 16 + i * 8192, R, C); const int Rb = Epi::PERM ? ((R & ~31) + perm32(R & 31)) : R;
        voffA[i] = (unsigned)(R * K + C) * 2u; voffB[i] = (unsigned)(Rb * K + C) * 2u; }
    const size_t kstep = (size_t)(BK * 2);
    const size_t hstep = (size_t)HALF * K * 2;
    const size_t tstep = 2 * hstep;
    const unsigned ldsw = (unsigned)wid * 1024u;
    const int aoff = lds_byte(wr * 64 + fr, fq * 8), boff = lds_byte(wc * 32 + fr, fq * 8);
#define PG8_SA(b, h) (((b) * 2 + (h)) * HTB)
#define PG8_SB(b, h) ((4 + (b) * 2 + (h)) * HTB)
#define PG8_STAGE(bufoff, gbase, voff) do { _Pragma("unroll") for (int _i = 0; _i < 2; ++_i) \
        __builtin_amdgcn_global_load_lds((const unsigned*)((const char*)(gbase) + (voff)[_i]), (LAS unsigned*)(lds + (bufoff) + ldsw + _i * 8192), 16, 0, 0); } while (0)
#define PG8_LDA(dst, b, h) do { _Pragma("unroll") for (int m = 0; m < 4; ++m) _Pragma("unroll") for (int k = 0; k < 2; ++k) dst[m][k] = *(const LAS bf16x8*)(lds + PG8_SA(b, h) + aoff + m * 2048 + k * 1024); } while (0)
#define PG8_LDB(dst, b, h) do { _Pragma("unroll") for (int n = 0; n < 2; ++n) _Pragma("unroll") for (int k = 0; k < 2; ++k) dst[n][k] = *(const LAS bf16x8*)(lds + PG8_SB(b, h) + boff + n * 2048 + k * 1024); } while (0)
#define PG8_MMA(ai, bj, At, Bt) do { __builtin_amdgcn_s_setprio(1); _Pragma("unroll") for (int m = 0; m < 4; ++m) _Pragma("unroll") for (int n = 0; n < 2; ++n) _Pragma("unroll") for (int k = 0; k < 2; ++k) \
        acc[ai][bj][m][n] = __builtin_amdgcn_mfma_f32_16x16x32_bf16(Bt[n][k], At[m][k], acc[ai][bj][m][n], 0, 0, 0); __builtin_amdgcn_s_setprio(0); } while (0)
#define PG8_WAIT_V(n) asm volatile("s_waitcnt vmcnt(" #n ")" ::: "memory")
#define PG8_WAIT_L(n) asm volatile("s_waitcnt lgkmcnt(" #n ")" ::: "memory")
#define PG8_BAR __builtin_amdgcn_s_barrier()
#define PG8_SCHED __builtin_amdgcn_sched_barrier(0)
    Unit cur, nxt; int ui = 0;
    if (!S.next(0, cur)) return;
    f32x4 acc[2][2][4][2];
#pragma unroll
    for (int a = 0; a < 2; ++a)
#pragma unroll
        for (int b = 0; b < 2; ++b)
#pragma unroll
            for (int m = 0; m < 4; ++m)
#pragma unroll
                for (int n = 0; n < 2; ++n) acc[a][b][m][n] = (f32x4){0.f, 0.f, 0.f, 0.f};
    bf16x8 At[4][2], B0[2][2], B1[2][2];
    const char* cA = (const char*)g.A + (size_t)cur.pm * tstep; const char* cB = (const char*)g.Bt + (size_t)cur.pn * tstep;
    S.a_ready(cur);
    PG8_STAGE(PG8_SB(0, 0), cB, voffB); PG8_STAGE(PG8_SA(0, 0), cA, voffA); PG8_STAGE(PG8_SB(0, 1), cB + hstep, voffB); PG8_STAGE(PG8_SA(0, 1), cA + hstep, voffA);
    if (wr == 1) PG8_BAR;
    PG8_WAIT_V(4); PG8_BAR;
    PG8_STAGE(PG8_SB(1, 0), cB + kstep, voffB); PG8_STAGE(PG8_SA(1, 0), cA + kstep, voffA); PG8_STAGE(PG8_SB(1, 1), cB + hstep + kstep, voffB);
    PG8_WAIT_V(6); PG8_BAR;
    for (;;) {
        const bool has_next = S.next(ui + 1, nxt);
        const char* nA = has_next ? (const char*)g.A + (size_t)nxt.pm * tstep : cA; const char* nB = has_next ? (const char*)g.Bt + (size_t)nxt.pn * tstep : cB;
        for (int t = 0; t < nt; t += 2) {
            const bool last = (t == nt - 2);
            const char* a1 = cA + (size_t)(t + 1) * kstep;
            const char* a2 = last ? nA : cA + (size_t)(t + 2) * kstep; const char* b2 = last ? nB : cB + (size_t)(t + 2) * kstep;
            const char* a3 = a2 + kstep; const char* b3 = b2 + kstep;
            if (last && has_next) S.a_ready(nxt);
            PG8_LDB(B0, 0, 0); PG8_SCHED; PG8_LDA(At, 0, 0); PG8_STAGE(PG8_SA(1, 1), a1 + hstep, voffA);
            PG8_WAIT_L(8); PG8_BAR; PG8_WAIT_L(0); PG8_MMA(0, 0, At, B0); PG8_BAR; PG8_SCHED;
            PG8_LDB(B1, 0, 1); PG8_STAGE(PG8_SB(0, 0), b2, voffB);
            PG8_BAR; PG8_WAIT_L(0); PG8_MMA(0, 1, At, B1); PG8_BAR;
            PG8_LDA(At, 0, 1); PG8_STAGE(PG8_SA(0, 0), a2, voffA);
            PG8_BAR; PG8_WAIT_L(0); PG8_MMA(1, 0, At, B0); PG8_BAR; PG8_SCHED;
            PG8_STAGE(PG8_SB(0, 1), b2 + hstep, voffB);
            PG8_WAIT_V(6); PG8_BAR; PG8_MMA(1, 1, At, B1); PG8_BAR;
            PG8_LDB(B0, 1, 0); PG8_SCHED; PG8_LDA(At, 1, 0); PG8_STAGE(PG8_SA(0, 1), a2 + hstep, voffA);
            PG8_WAIT_L(8); PG8_BAR; PG8_WAIT_L(0); PG8_MMA(0, 0, At, B0); PG8_BAR; PG8_SCHED;
            PG8_LDB(B1, 1, 1); PG8_STAGE(PG8_SB(1, 0), b3, voffB);
            PG8_BAR; PG8_WAIT_L(0); PG8_MMA(0, 1, At, B1); PG8_BAR;
            PG8_LDA(At, 1, 1); PG8_STAGE(PG8_SA(1, 0), a3, voffA);
            PG8_BAR; PG8_WAIT_L(0); PG8_MMA(1, 0, At, B0); PG8_BAR; PG8_SCHED;
            PG8_STAGE(PG8_SB(1, 1), b3 + hstep, voffB);
            PG8_WAIT_V(6); PG8_BAR; PG8_MMA(1, 1, At, B1); PG8_BAR;
        }
        if constexpr (!Epi::AFTER_DRAIN) { E(acc, cur, wr, wc, fr, fq); S.done(cur); }
        if (!has_next) break;
#pragma unroll
        for (int a = 0; a < 2; ++a)
#pragma unroll
            for (int b = 0; b < 2; ++b)
#pragma unroll
                for (int m = 0; m < 4; ++m)
#pragma unroll
                    for (int n = 0; n < 2; ++n) acc[a][b][m][n] = (f32x4){0.f, 0.f, 0.f, 0.f};
        cur = nxt; cA = nA; cB = nB; ++ui;
    }
    PG8_WAIT_V(0);
    if (wr == 0) PG8_BAR;
    PG8_BAR;
#undef PG8_SA
#undef PG8_SB
#undef PG8_STAGE
#undef PG8_LDA
#undef PG8_LDB
#undef PG8_MMA
#undef PG8_WAIT_V
#undef PG8_WAIT_L
#undef PG8_BAR
#undef PG8_SCHED
}
}

__device__ __forceinline__ int win_col(int n) { return n < 2048 ? n : (n < 3072 ? n + 8 : n + 12); }
__device__ __forceinline__ int win_smcol(int j) { return j < 8 ? 2048 + j : 3080 + (j - 8); }

__device__ void ph_prep(const Params& p, LAS unsigned char* lds, int blk, int nblk) {
    const int tid = opaque_tid();
    LAS float* tile = (LAS float*)lds;
    const int tiles_in = DEPTH * 64 * 16, tiles_out = DEPTH * 16 * 16;
    for (int t = blk; t < tiles_in + tiles_out; t += nblk) {
        const float* src; bf16_t* dst; int ld, n0, k0, l; const float* scale;
        if (t < tiles_in) { l = t / 1024; const int r = t % 1024; n0 = (r / 16) * 64; k0 = (r % 16) * 64; src = p.w_in + (size_t)l * DM * IN_DIM + win_col(n0); ld = IN_DIM;
            dst = (bf16_t*)(p.ws + WS_WINT) + (size_t)l * NBIG * DM; scale = p.norm_w + l * DM; }
        else { const int tt = t - tiles_in; l = tt / 256; const int r = tt % 256; n0 = (r / 16) * 64; k0 = (r % 16) * 64; src = p.w_out + (size_t)l * DM * DM + n0; ld = DM;
            dst = (bf16_t*)(p.ws + WS_WOUTT) + (size_t)l * DM * DM; scale = nullptr; }
        __syncthreads();
        for (int e = tid; e < 64 * 64; e += 512) { const int kk = e >> 6, nn = e & 63; float v = src[(size_t)(k0 + kk) * ld + nn]; if (scale) v *= scale[k0 + kk]; tile[kk * 65 + nn] = v; }
        __syncthreads();
        for (int e = tid; e < 64 * 32; e += 512) { const int nn = e >> 5, kp = (e & 31) * 2; const unsigned w = pack_bf2(tile[kp * 65 + nn], tile[(kp + 1) * 65 + nn]);
            *(unsigned*)(dst + (size_t)(n0 + nn) * DM + k0 + kp) = w; }
    }
    for (int e = blk * 512 + tid; e < DEPTH * NSM * DM; e += nblk * 512) { const int l = e / (NSM * DM), r = e % (NSM * DM), j = r / DM, k = r % DM;
        ((float*)(p.ws + WS_WSM))[e] = p.w_in[(size_t)l * DM * IN_DIM + (size_t)k * IN_DIM + win_smcol(j)] * p.norm_w[l * DM + k]; }
    for (int c = blk * 512 + tid; c < 256; c += nblk * 512) { float lg[DEPTH], mx = -1e30f;
#pragma unroll
        for (int l = 0; l < DEPTH; ++l) { lg[l] = p.lb_logits[l * 256 + c]; mx = fmaxf(mx, lg[l]); }
        float s = 0.f;
#pragma unroll
        for (int l = 0; l < DEPTH; ++l) { lg[l] = expf(lg[l] - mx); s += lg[l]; }
        float cum = 0.f; const float w0 = lg[0] / s;
#pragma unroll
        for (int l = 0; l < DEPTH; ++l) { cum += lg[l] / s; ((float*)(p.ws + WS_LB))[l * 256 + c] = fmaxf(cum - w0, 0.f); } }
    for (int e = blk * 512 + tid; e < (TP + 1) * 32; e += nblk * 512) { const int pi = e >> 5, i = e & 31; const double pos = pi < TP ? (double)pi : (double)PASTLEN;
        const float invf = (float)(1.0 / pow(10000.0, (double)((float)i / 31.0f)));
        const double rev = pos * (double)invf * 0.15915494309189535; const float fr = (float)(rev - rint(rev));
        ((float*)(p.ws + WS_ROT))[e * 2 + 0] = __builtin_amdgcn_cosf(fr); ((float*)(p.ws + WS_ROT))[e * 2 + 1] = __builtin_amdgcn_sinf(fr); }
    float* h = (float*)(p.ws + WS_H);
    for (int e = blk * 512 + tid; e < MROWS * (DM / 4); e += nblk * 512) { const int row = e >> 8, c4 = (e & 255) * 4; const float* src;
        if (row < MP) { const int b = row / TP, t = row % TP; src = t < NMETA ? p.meta + t * DM : p.x_prompt + ((size_t)b * SEQ + (t - NMETA)) * DM; } else src = p.x_sample + (size_t)(row - MP) * DM;
        *(f32x4*)(h + (size_t)row * DM + c4) = *(const f32x4*)(src + c4); }
}

__device__ void ph_rownorm(const Params& p, int layer, int blk, int nblk) {
    const int tid = opaque_tid(), wid = tid >> 6, lane = tid & 63;
    const float* h = (const float*)(p.ws + WS_H); bf16_t* hb = (bf16_t*)(p.ws + WS_HB); float* rs = (float*)(p.ws + WS_RS); float* psm = (float*)(p.ws + WS_PSM);
    const float* wsm = (const float*)(p.ws + WS_WSM) + (size_t)layer * NSM * DM;
    for (int row = blk * 8 + wid; row < MROWS; row += nblk * 8) {
        f32x4 v[4]; float ss = 0.f;
#pragma unroll
        for (int j = 0; j < 4; ++j) { v[j] = *(const f32x4*)(h + (size_t)row * DM + j * 256 + lane * 4); ss += v[j][0] * v[j][0] + v[j][1] * v[j][1] + v[j][2] * v[j][2] + v[j][3] * v[j][3]; }
        ss = wave_sum(ss); const float r = rsqrtf(ss * (1.0f / DM) + EPSF);
#pragma unroll
        for (int j = 0; j < 4; ++j) { u32x2 w; w.x = pack_bf2(v[j][0], v[j][1]); w.y = pack_bf2(v[j][2], v[j][3]); *(u32x2*)(hb + (size_t)row * DM + j * 256 + lane * 4) = w; }
        float mine = 0.f;
        for (int q = 0; q < NSM; ++q) { float d = 0.f;
#pragma unroll
            for (int j = 0; j < 4; ++j) { const f32x4 w = *(const f32x4*)(wsm + q * DM + j * 256 + lane * 4); d += v[j][0] * w[0] + v[j][1] * w[1] + v[j][2] * w[2] + v[j][3] * w[3]; }
            d = wave_sum(d); if (lane == q) mine = d * r; }
        if (lane < NSM) psm[(size_t)row * NSM + lane] = mine;
        if (lane == 0) rs[row] = r;
    }
}

__device__ void ph_gemm_in(const Params& p, int layer, LAS unsigned char* lds, int blk, int nblk) {
    pg8::Gemm g{(const bf16_t*)(p.ws + WS_HB), (const bf16_t*)(p.ws + WS_WINT) + (size_t)layer * NBIG * DM, MROWS, NBIG, DM};
    pg8::StaticOrder S; S.init(MROWS, NBIG, nblk, blk);
    pg8::EpiProj E{(bf16_t*)(p.ws + WS_PROJ), NBIG, (const float*)(p.ws + WS_RS)};
    pg8::gemm_phase<pg8::EpiProj, pg8::StaticOrder>(lds, g, S, E);
}
__device__ void ph_gemm_out(const Params& p, int layer, LAS unsigned char* lds, int blk, int nblk) {
    pg8::Gemm g{(const bf16_t*)(p.ws + WS_Y), (const bf16_t*)(p.ws + WS_WOUTT) + (size_t)layer * DM * DM, MROWS, DM, DM};
    pg8::StaticOrder S; S.init(MROWS, DM, nblk, blk);
    pg8::EpiResid E{(float*)(p.ws + WS_H), DM};
    pg8::gemm_phase<pg8::EpiResid, pg8::StaticOrder>(lds, g, S, E);
}

constexpr int TB = 16;
struct MixLds {
    static constexpr int QS = 0, KS = QS + TB * 128, VS = KS + TB * 128, DS = VS + TB * 128, ZS = DS + TB * 128, XS = ZS + TB * 128, OS = XS + TB * 128, BS = OS + TB * 128, SC = BS + TB * 2, END = SC + TB * 2;
};

struct SeqInfo { int row0, T, dec, b; };
__device__ __forceinline__ SeqInfo seq_info(int s) { SeqInfo q; if (s < NB) { q.row0 = s * TP; q.T = TP; q.dec = 0; q.b = s; } else { q.row0 = MP + (s - NB); q.T = 1; q.dec = 1; q.b = s - NB; } return q; }

__device__ __forceinline__ float preconv(const bf16_t* proj, const SeqInfo& q, int t, int col, const float* ctx  , int ch) {
    if (t >= 0) return bf2f(proj[(size_t)(q.row0 + t) * NBIG + col]);
    return ctx ? ctx[(3 + t) * 768 + ch] : 0.f;
}

template <int DK, int NV, bool DELTA, bool VECDEC>
__device__ __forceinline__ void recur_batch(float (&S)[DK / (64 / NV)], LAS float* L, int nb, int wid, int lane) {
    constexpr int KQ = 64 / NV, KR = DK / KQ, DVT = 8 * NV;
    const int kq = lane / NV, vv = lane % NV, vcol = wid * NV + vv, hh = vcol >> 6;
    for (int t = 0; t < nb; ++t) {
        float kk[KR], qq[KR];
#pragma unroll
        for (int i = 0; i < KR; ++i) { kk[i] = L[MixLds::KS + t * 128 + kq * KR + i]; qq[i] = L[MixLds::QS + t * 128 + kq * KR + i]; }
        const float v = L[MixLds::VS + t * 128 + vcol];
        if (DELTA) {
            const float dec = L[MixLds::DS + t * 128 + hh]; float pk = 0.f;
#pragma unroll
            for (int i = 0; i < KR; ++i) { S[i] *= dec; pk += kk[i] * S[i]; }
#pragma unroll
            for (int o = NV; o < 64; o <<= 1) pk += __shfl_xor(pk, o);
            const float u = L[MixLds::BS + t] * (v - pk);
#pragma unroll
            for (int i = 0; i < KR; ++i) S[i] += kk[i] * u;
        } else if (VECDEC) {
#pragma unroll
            for (int i = 0; i < KR; ++i) S[i] = L[MixLds::DS + t * 128 + kq * KR + i] * S[i] + kk[i] * v;
        } else {
            const float dec = L[MixLds::DS + t * 128 + hh];
#pragma unroll
            for (int i = 0; i < KR; ++i) S[i] = dec * S[i] + kk[i] * v;
        }
        float po = 0.f;
#pragma unroll
        for (int i = 0; i < KR; ++i) po += qq[i] * S[i];
#pragma unroll
        for (int o = NV; o < 64; o <<= 1) po += __shfl_xor(po, o);
        if (kq == 0) L[MixLds::OS + t * 128 + vcol] = po;
    }
    (void)DVT;
}

template <int MIX>
__device__ void mixer_item(const Params& p, int layer, int s, int hu  , LAS float* L) {
    constexpr int DK = MIX == 2 ? 128 : 64, NV = MIX == 2 ? 16 : 8, KQ = 64 / NV, KR = DK / KQ, DVT = 8 * NV;
    const int tid = opaque_tid(), wid = tid >> 6, lane = tid & 63;
    const SeqInfo q = seq_info(s);
    const bf16_t* proj = (const bf16_t*)(p.ws + WS_PROJ); const float* psm = (const float*)(p.ws + WS_PSM); bf16_t* y = (bf16_t*)(p.ws + WS_Y);
    const float* lb = (const float*)(p.ws + WS_LB) + layer * 256; const float* rot = (const float*)(p.ws + WS_ROT);
    const int kq = lane / NV, vv = lane % NV, vcol = wid * NV + vv, hh = vcol >> 6;
    const int head = MIX == 2 ? hu * 2 + hh : hu;
    const float* ctx = nullptr; const float* cw = nullptr;
    if (MIX == 1) { cw = p.gdn_conv_w + (size_t)layer * 4 * 768; if (q.dec) ctx = p.st_gconv + ((size_t)layer * DECB + q.b) * 3 * 768; }
    if (MIX == 2) { cw = p.ssd_conv_w + (size_t)layer * 4 * 768; if (q.dec) ctx = p.st_sconv + ((size_t)layer * DECB + q.b) * 3 * 768; }
    float S[KR];
    {
        const float* st = MIX == 0 ? p.st_hgrn : MIX == 1 ? p.st_gdn : MIX == 2 ? p.st_ssd : p.st_ret;
#pragma unroll
        for (int i = 0; i < KR; ++i) S[i] = q.dec ? st[(((size_t)layer * DECB + q.b) * 4 + head) * DK * 64 + (size_t)(kq * KR + i) * 64 + (vcol & 63)] : 0.f;
    }
    float hc0 = 0.f, hc1 = 0.f;
    if (MIX == 1) { hc0 = -__expf(p.gdn_a_log[layer * 4 + hu]); hc1 = p.gdn_dt_bias[layer * 4 + hu]; }
    if (MIX == 3) { hc0 = 1.0f - exp2f(-5.0f - (float)hu); }

    for (int t0 = 0; t0 < q.T; t0 += TB) {
        const int nb = min(TB, q.T - t0);
        __syncthreads();
        if (MIX == 0) {
            for (int e = tid; e < nb * 64; e += 512) { const int t = e >> 6, d = e & 63, c = hu * 64 + d; const bf16_t* pr = proj + (size_t)(q.row0 + t0 + t) * NBIG;
                const float aq = bf2f(pr[PC_AQ + c]), af = bf2f(pr[PC_AF + c]), ai = bf2f(pr[PC_AI + c]), az = bf2f(pr[PC_AZ + c]), l_ = lb[c];
                L[MixLds::QS + t * 128 + d] = silu_f(aq) * 0.125f; L[MixLds::KS + t * 128 + d] = (1.0f - l_) * sigmoid_f(-af); L[MixLds::DS + t * 128 + d] = l_ + (1.0f - l_) * sigmoid_f(af);
                L[MixLds::VS + t * 128 + d] = ai; L[MixLds::ZS + t * 128 + d] = az; }
        } else if (MIX == 1) {
            for (int e = tid; e < nb * 192; e += 512) { const int t = e / 192, r = e % 192, part = r >> 6, d = r & 63, ch = part * 256 + hu * 64 + d, col = PC_BQKV + ch; const int tt = t0 + t;
                float a = 0.f;
#pragma unroll
                for (int j = 0; j < 4; ++j) a += cw[j * 768 + ch] * preconv(proj, q, tt - 3 + j, col, ctx, ch);
                a = silu_f(a);
                L[(part == 0 ? MixLds::QS : part == 1 ? MixLds::KS : MixLds::VS) + t * 128 + d] = a; }
            for (int e = tid; e < nb * 64; e += 512) { const int t = e >> 6, d = e & 63; L[MixLds::ZS + t * 128 + d] = bf2f(proj[(size_t)(q.row0 + t0 + t) * NBIG + PC_BZ + hu * 64 + d]); }
            if (tid < nb) { const float* ps = psm + (size_t)(q.row0 + t0 + tid) * NSM; const float g = hc0 * softplus_f(ps[hu] + hc1);
                L[MixLds::DS + tid * 128 + 0] = __expf(g); L[MixLds::BS + tid] = sigmoid_f(ps[4 + hu]); }
            __syncthreads();
            if (tid < nb * 2) { const int t = tid >> 1, which = tid & 1; const LAS float* src = L + (which ? MixLds::KS : MixLds::QS) + t * 128; float ss = 0.f;
                for (int d = 0; d < 64; ++d) ss += src[d] * src[d];
                L[MixLds::SC + tid] = rsqrtf(ss + EPSF) * (which ? 1.0f : 0.125f); }
            __syncthreads();
            for (int e = tid; e < nb * 128; e += 512) { const int t = e >> 7, r = e & 127, which = r >> 6, d = r & 63; L[(which ? MixLds::KS : MixLds::QS) + t * 128 + d] *= L[MixLds::SC + t * 2 + which]; }
        } else if (MIX == 2) {
            if (tid < nb * 2) { const int t = tid >> 1, h2 = tid & 1, hd = hu * 2 + h2; const float dt = softplus_f(psm[(size_t)(q.row0 + t0 + t) * NSM + 8 + hd] + p.ssd_dt_bias[layer * 4 + hd]);
                L[MixLds::BS + tid] = dt; L[MixLds::DS + t * 128 + h2] = __expf(-dt * __expf(p.ssd_a_log[layer * 4 + hd])); }
            __syncthreads();
            for (int e = tid; e < nb * 384; e += 512) { const int t = e / 384, r = e % 384, part = r >> 7, j = r & 127, ch = part * 256 + hu * 128 + j, col = PC_CXBC + ch; const int tt = t0 + t;
                float a = p.ssd_conv_b[layer * 768 + ch];
#pragma unroll
                for (int jj = 0; jj < 4; ++jj) a += cw[jj * 768 + ch] * preconv(proj, q, tt - 3 + jj, col, ctx, ch);
                a = silu_f(a);
                if (part == 0) { L[MixLds::XS + t * 128 + j] = a; L[MixLds::VS + t * 128 + j] = a * L[MixLds::BS + t * 2 + (j >> 6)]; }
                else if (part == 1) L[MixLds::KS + t * 128 + j] = a; else L[MixLds::QS + t * 128 + j] = a; }
            for (int e = tid; e < nb * 128; e += 512) { const int t = e >> 7, j = e & 127; L[MixLds::ZS + t * 128 + j] = bf2f(proj[(size_t)(q.row0 + t0 + t) * NBIG + PC_CZ + hu * 128 + j]); }
        } else {
            for (int e = tid; e < nb * 32; e += 512) { const int t = e >> 5, i = e & 31; const bf16_t* pr = proj + (size_t)(q.row0 + t0 + t) * NBIG; const int pidx = q.dec ? TP : (t0 + t);
                const float cs = rot[(pidx * 32 + i) * 2], sn = rot[(pidx * 32 + i) * 2 + 1];
                const float q1 = bf2f(pr[PC_DQ + hu * 64 + i]), q2 = bf2f(pr[PC_DQ + hu * 64 + 32 + i]), k1 = bf2f(pr[PC_DK + hu * 64 + i]), k2 = bf2f(pr[PC_DK + hu * 64 + 32 + i]);
                L[MixLds::QS + t * 128 + i] = q1 * cs - q2 * sn; L[MixLds::QS + t * 128 + 32 + i] = q2 * cs + q1 * sn;
                L[MixLds::KS + t * 128 + i] = (k1 * cs - k2 * sn) * 0.125f; L[MixLds::KS + t * 128 + 32 + i] = (k2 * cs + k1 * sn) * 0.125f; }
            for (int e = tid; e < nb * 64; e += 512) { const int t = e >> 6, d = e & 63; const bf16_t* pr = proj + (size_t)(q.row0 + t0 + t) * NBIG;
                L[MixLds::VS + t * 128 + d] = bf2f(pr[PC_DV + hu * 64 + d]); L[MixLds::ZS + t * 128 + d] = bf2f(pr[PC_DZ + hu * 64 + d]); }
            if (tid < nb) L[MixLds::DS + tid * 128] = hc0;
        }
        __syncthreads();
        recur_batch<DK, NV, MIX == 1, MIX == 0>(S, L, nb, wid, lane);
        __syncthreads();
        for (int t = wid; t < nb; t += 8) {
            const size_t yrow = (size_t)(q.row0 + t0 + t) * DM;
            if (MIX == 0 || MIX == 1) { const float o = L[MixLds::OS + t * 128 + lane]; const float ms = wave_sum(o * o) * (1.0f / 64.0f);
                const float w = (MIX == 0 ? p.hgrn_norm_w : p.gdn_norm_w)[layer * 256 + hu * 64 + lane];
                y[yrow + (MIX == 0 ? 0 : 256) + hu * 64 + lane] = f2bf(o * rsqrtf(ms + EPSF) * w * silu_f(L[MixLds::ZS + t * 128 + lane])); }
            else if (MIX == 2) { float u[2]; float ss = 0.f;
#pragma unroll
                for (int r = 0; r < 2; ++r) { const int j = lane + 64 * r; const float o = L[MixLds::OS + t * 128 + j] + p.ssd_d[layer * 4 + hu * 2 + r] * L[MixLds::XS + t * 128 + j]; u[r] = o * silu_f(L[MixLds::ZS + t * 128 + j]); ss += u[r] * u[r]; }
                const float sc = rsqrtf(wave_sum(ss) * (1.0f / 128.0f) + EPSF);
#pragma unroll
                for (int r = 0; r < 2; ++r) { const int j = lane + 64 * r; y[yrow + 512 + hu * 128 + j] = f2bf(u[r] * sc * p.ssd_norm_w[layer * 256 + hu * 128 + j]); } }
            else { const float o = L[MixLds::OS + t * 128 + lane]; const float mu = wave_sum(o) * (1.0f / 64.0f); const float dv = o - mu; const float var = wave_sum(dv * dv) * (1.0f / 64.0f);
                const int c = hu * 64 + lane;
                y[yrow + 768 + c] = f2bf((dv * rsqrtf(var + EPSF) * p.ret_norm_w[layer * 256 + c] + p.ret_norm_b[layer * 256 + c]) * silu_f(L[MixLds::ZS + t * 128 + lane])); }
        }
    }
    {
        float* so = p.out + (q.dec ? (MIX == 0 ? O_HGRN_S : MIX == 1 ? O_GDN_S : MIX == 2 ? O_SSD_S : O_RET_S) : (MIX == 0 ? O_HGRN_P : MIX == 1 ? O_GDN_P : MIX == 2 ? O_SSD_P : O_RET_P));
        const int nbt = q.dec ? DECB : NB;
#pragma unroll
        for (int i = 0; i < KR; ++i) so[(((size_t)layer * nbt + q.b) * 4 + head) * DK * 64 + (size_t)(kq * KR + i) * 64 + (vcol & 63)] = S[i];
    }
    if (MIX == 1 || MIX == 2) {
        float* co = p.out + (q.dec ? (MIX == 1 ? O_GCONV_S : O_SCONV_S) : (MIX == 1 ? O_GCONV_P : O_SCONV_P)) + ((size_t)layer * (q.dec ? DECB : NB) + q.b) * 3 * 768;
        const int nch = MIX == 1 ? 192 : 384;
        for (int e = tid; e < 3 * nch; e += 512) { const int r = e / nch, c = e % nch; int ch;
            if (MIX == 1) ch = (c >> 6) * 256 + hu * 64 + (c & 63); else ch = (c >> 7) * 256 + hu * 128 + (c & 127);
            co[r * 768 + ch] = preconv(proj, q, q.T - 3 + r, (MIX == 1 ? PC_BQKV : PC_CXBC) + ch, ctx, ch); }
    }
    (void)DVT;
}

constexpr int N_SEQ = NB + DECB, N_MU = 14, N_ITEMS = N_SEQ * N_MU;
__device__ void ph_mixer(const Params& p, int layer, LAS unsigned char* lds, int blk, int nblk) {
    LAS float* L = (LAS float*)lds;
    for (int it = blk; it < N_ITEMS; it += nblk) {
        const int s = it / N_MU, mu = it % N_MU;
        if (mu < 4) mixer_item<0>(p, layer, s, mu, L);
        else if (mu < 8) mixer_item<1>(p, layer, s, mu - 4, L);
        else if (mu < 10) mixer_item<2>(p, layer, s, mu - 8, L);
        else mixer_item<3>(p, layer, s, mu - 10, L);
    }
}

__device__ void ph_final(const Params& p, int blk, int nblk) {
    const int tid = opaque_tid(), wid = tid >> 6, lane = tid & 63;
    const float* h = (const float*)(p.ws + WS_H);
    for (int row = blk * 8 + wid; row < MROWS; row += nblk * 8) {
        float* dst;
        if (row < MP) { const int b = row / TP, t = row % TP; if (t < NMETA) continue; dst = p.out + O_YP + ((size_t)b * SEQ + (t - NMETA)) * DM; } else dst = p.out + O_YS + (size_t)(row - MP) * DM;
        f32x4 v[4]; float ss = 0.f;
#pragma unroll
        for (int j = 0; j < 4; ++j) { v[j] = *(const f32x4*)(h + (size_t)row * DM + j * 256 + lane * 4); ss += v[j][0] * v[j][0] + v[j][1] * v[j][1] + v[j][2] * v[j][2] + v[j][3] * v[j][3]; }
        const float r = rsqrtf(wave_sum(ss) * (1.0f / DM) + EPSF);
#pragma unroll
        for (int j = 0; j < 4; ++j) { const f32x4 w = *(const f32x4*)(p.final_norm_w + j * 256 + lane * 4); *(f32x4*)(dst + j * 256 + lane * 4) = v[j] * r * w; }
    }
}

constexpr int LDS_STAGE = pg8::STAGE_BYTES;
constexpr int LDS_BYTES = LDS_STAGE + 16;
static_assert(MixLds::END * 4 <= LDS_STAGE, "mixer LDS");

__global__ void __launch_bounds__(512, 2) k_mega(Params p) {
    extern __shared__ __attribute__((aligned(16))) unsigned char smem[];
    LAS unsigned char* lds = (LAS unsigned char*)smem;
    const int blk = blockIdx.x, nblk = gridDim.x;
    volatile LAS unsigned* xbw = (volatile LAS unsigned*)(lds + LDS_STAGE);
    if (threadIdx.x < 4) xbw[threadIdx.x] = 0u;
    __syncthreads();
    XcdBarrier xb = xcd_barrier_post((unsigned*)(p.ws + WS_BAR), xbw);
    ph_prep(p, lds, blk, nblk);
    cooperative_groups::this_grid().sync();
    xcd_barrier(xb);
#pragma unroll 1
    for (int l = 0; l < DEPTH; ++l) {
        ph_rownorm(p, l, blk, nblk);
        xcd_barrier(xb);
        ph_gemm_in(p, l, lds, blk, nblk);
        xcd_barrier(xb);
        ph_mixer(p, l, lds, blk, nblk);
        xcd_barrier(xb);
        ph_gemm_out(p, l, lds, blk, nblk);
        xcd_barrier(xb);
    }
    ph_final(p, blk, nblk);
}

extern "C" void kernel_launch(void* const* d_in, const int* in_sizes, int n_in, void* d_out, int out_size, void* d_ws, size_t ws_size, hipStream_t stream) {
    static int grid = 0;
    if (grid == 0) {
        if (n_in != 27 || (size_t)out_size != O_END || ws_size < WS_END) { fprintf(stderr, "kernel_launch: unexpected shapes: n_in %d out %d (want %zu) ws %zu (want %zu)\n", n_in, out_size, (size_t)O_END, ws_size, (size_t)WS_END); grid = -1; return; }
        if (hipFuncSetAttribute((const void*)k_mega, hipFuncAttributeMaxDynamicSharedMemorySize, LDS_BYTES) != hipSuccess) { fprintf(stderr, "kernel_launch: hipFuncSetAttribute failed\n"); grid = -1; return; }
        int dev = 0, cus = 0, per_cu = 0;
        if (hipGetDevice(&dev) != hipSuccess || hipDeviceGetAttribute(&cus, hipDeviceAttributeMultiprocessorCount, dev) != hipSuccess) { fprintf(stderr, "kernel_launch: device query failed\n"); grid = -1; return; }
        if (hipOccupancyMaxActiveBlocksPerMultiprocessor(&per_cu, (const void*)k_mega, 512, LDS_BYTES) != hipSuccess || per_cu < 1) { fprintf(stderr, "kernel_launch: occupancy query says %d blocks per CU\n", per_cu); grid = -1; return; }
        grid = cus;
    }
    if (grid < 0) return;
    Params p{};
    const float** pp = (const float**)&p;
    for (int i = 0; i < 27; ++i) pp[i] = (const float*)d_in[i];
    p.out = (float*)d_out; p.ws = (unsigned char*)d_ws;
    (void)hipMemsetAsync((unsigned char*)d_ws + WS_BAR, 0, 16384, stream);
    void* args[] = {&p};
    const hipError_t e = hipLaunchCooperativeKernel((const void*)k_mega, dim3(grid), dim3(512), args, LDS_BYTES, stream);
    if (e != hipSuccess) fprintf(stderr, "kernel_launch: cooperative launch failed: %s (grid %d)\n", hipGetErrorString(e), grid);
}
```

```cpp
#include <hip/hip_runtime.h>
#include <hip/hip_cooperative_groups.h>
#include <cstdio>
#include <cstdint>

#define LAS __attribute__((address_space(3)))
typedef unsigned short bf16_t;
typedef short bf16x8 __attribute__((ext_vector_type(8)));
typedef float f32x4 __attribute__((ext_vector_type(4)));
typedef unsigned u32x4 __attribute__((ext_vector_type(4)));
typedef unsigned u32x2 __attribute__((ext_vector_type(2)));

constexpr int DM = 1024, NB = 8, SEQ = 2048, DEPTH = 4, DECB = 128, NMETA = 16, TP = SEQ + NMETA;
constexpr int MP = NB * TP;
constexpr int MROWS = MP + DECB;
constexpr int IN_DIM = 4108, NBIG = 4096, NSM = 12;
constexpr int PASTLEN = 16384;
constexpr float EPSF = 1e-6f;
constexpr int PC_AQ = 0, PC_AF = 256, PC_AI = 512, PC_AZ = 768, PC_BQKV = 1024, PC_BZ = 1792, PC_CXBC = 2048, PC_CZ = 2816, PC_DQ = 3072, PC_DK = 3328, PC_DV = 3584, PC_DZ = 3840;

constexpr size_t WS_BAR = 0;
constexpr size_t WS_WINT = 16384;
constexpr size_t WS_WOUTT = WS_WINT + (size_t)DEPTH * NBIG * DM * 2;
constexpr size_t WS_WSM = WS_WOUTT + (size_t)DEPTH * DM * DM * 2;
constexpr size_t WS_LB = WS_WSM + (size_t)DEPTH * NSM * DM * 4;
constexpr size_t WS_ROT = WS_LB + (size_t)DEPTH * 256 * 4;
constexpr size_t ROT_BYTES = ((size_t)(TP + 1) * 64 * 4 + 255) / 256 * 256;
constexpr size_t WS_H = WS_ROT + ROT_BYTES;
constexpr size_t WS_HB = WS_H + (size_t)MROWS * DM * 4;
constexpr size_t WS_RS = WS_HB + (size_t)MROWS * DM * 2;
constexpr size_t WS_PSM = WS_RS + (size_t)MROWS * 4;
constexpr size_t WS_PROJ = WS_PSM + (size_t)MROWS * NSM * 4;
constexpr size_t WS_Y = WS_PROJ + (size_t)MROWS * NBIG * 2;
constexpr size_t WS_END = WS_Y + (size_t)MROWS * DM * 2;

constexpr size_t O_YP = 0;
constexpr size_t O_YS = O_YP + (size_t)NB * SEQ * DM;
constexpr size_t O_HGRN_P = O_YS + (size_t)DECB * DM;
constexpr size_t O_GDN_P = O_HGRN_P + (size_t)DEPTH * NB * 4 * 64 * 64;
constexpr size_t O_GCONV_P = O_GDN_P + (size_t)DEPTH * NB * 4 * 64 * 64;
constexpr size_t O_SSD_P = O_GCONV_P + (size_t)DEPTH * NB * 3 * 768;
constexpr size_t O_SCONV_P = O_SSD_P + (size_t)DEPTH * NB * 4 * 128 * 64;
constexpr size_t O_RET_P = O_SCONV_P + (size_t)DEPTH * NB * 3 * 768;
constexpr size_t O_HGRN_S = O_RET_P + (size_t)DEPTH * NB * 4 * 64 * 64;
constexpr size_t O_GDN_S = O_HGRN_S + (size_t)DEPTH * DECB * 4 * 64 * 64;
constexpr size_t O_GCONV_S = O_GDN_S + (size_t)DEPTH * DECB * 4 * 64 * 64;
constexpr size_t O_SSD_S = O_GCONV_S + (size_t)DEPTH * DECB * 3 * 768;
constexpr size_t O_SCONV_S = O_SSD_S + (size_t)DEPTH * DECB * 4 * 128 * 64;
constexpr size_t O_RET_S = O_SCONV_S + (size_t)DEPTH * DECB * 3 * 768;
constexpr size_t O_END = O_RET_S + (size_t)DEPTH * DECB * 4 * 64 * 64;

struct Params {
    const float* x_prompt; const float* x_sample;
    const float* st_hgrn; const float* st_gdn; const float* st_gconv; const float* st_ssd; const float* st_sconv; const float* st_ret;
    const float* meta; const float* norm_w; const float* w_in; const float* lb_logits; const float* hgrn_norm_w;
    const float* gdn_conv_w; const float* gdn_a_log; const float* gdn_dt_bias; const float* gdn_norm_w;
    const float* ssd_conv_w; const float* ssd_conv_b; const float* ssd_a_log; const float* ssd_dt_bias; const float* ssd_d; const float* ssd_norm_w;
    const float* ret_norm_w; const float* ret_norm_b; const float* w_out; const float* final_norm_w;
    float* out; unsigned char* ws;
};

__device__ __forceinline__ float bf2f(bf16_t b) { return __uint_as_float(((unsigned)b) << 16); }
__device__ __forceinline__ bf16_t f2bf(float f) { unsigned u = __float_as_uint(f); u += 0x7FFFu + ((u >> 16) & 1u); return (bf16_t)(u >> 16); }
__device__ __forceinline__ unsigned pack_bf2(float lo, float hi) { return (unsigned)f2bf(lo) | ((unsigned)f2bf(hi) << 16); }
__device__ __forceinline__ float sigmoid_f(float x) { return 1.0f / (1.0f + __expf(-x)); }
__device__ __forceinline__ float silu_f(float x) { return x / (1.0f + __expf(-x)); }
__device__ __forceinline__ float softplus_f(float x) { return x > 20.0f ? x : log1pf(__expf(x)); }
__device__ __forceinline__ int opaque_tid() { int t = threadIdx.x; asm volatile("" : "+v"(t)); return t; }
__device__ __forceinline__ float wave_sum(float v) {
#pragma unroll
    for (int o = 32; o > 0; o >>= 1) v += __shfl_xor(v, o);
    return v;
}


#define XB_TMO      128
#define XB_XCNT(j)  (256  + 64 * (j))
#define XB_XSUB(j)  (1280 + 64 * (j))
#define XB_XGEN(j)  (2304 + 64 * (j))
#define XB_TOP      3328
#define XB_TOPGEN   3392
#define XCD_BAR_WORDS 3456
#define XB_SPIN_CAP (1u << 22)
__device__ __forceinline__ unsigned xb_ld(unsigned* p)              { return __hip_atomic_load(p, __ATOMIC_RELAXED, __HIP_MEMORY_SCOPE_AGENT); }
__device__ __forceinline__ unsigned xb_add(unsigned* p, unsigned v) { return __hip_atomic_fetch_add(p, v, __ATOMIC_RELAXED, __HIP_MEMORY_SCOPE_AGENT); }
__device__ __forceinline__ unsigned xb_xcc_id() { return (unsigned)__builtin_amdgcn_s_getreg((3 << 11) | 20) & 0xFu; }
#define XB_SPIN(cond, bar) do { unsigned _sp = 0; while (cond) { __builtin_amdgcn_s_sleep(1); \
    if ((++_sp & 255u) == 0u) { if (xb_ld(&(bar)[XB_TMO])) break; if (_sp > XB_SPIN_CAP) { atomicAdd(&(bar)[XB_TMO], 1u); break; } } } } while (0)
struct XcdBarrier { unsigned* bar; unsigned x; volatile LAS unsigned* st; };
__device__ __forceinline__ XcdBarrier xcd_barrier_post(unsigned* bar, volatile LAS unsigned* st) {
    XcdBarrier b; b.bar = bar; b.x = xb_xcc_id(); b.st = st;
    if (threadIdx.x == 0) (void)xb_add(&bar[XB_XCNT(b.x)], 1u);
    return b;
}
__device__ __forceinline__ void xcd_barrier_complete(unsigned* bar, unsigned x, unsigned& nloc, unsigned& nx) {
    const unsigned G = gridDim.x * gridDim.y * gridDim.z;
    unsigned sum, cnt, mine, sp = 0u;
    for (;;) {
        sum = 0u; cnt = 0u; mine = 0u;
#pragma unroll
        for (unsigned j = 0; j < 16; ++j) { const unsigned c = xb_ld(&bar[XB_XCNT(j)]); sum += c; cnt += (c > 0u) ? 1u : 0u; mine = (j == x) ? c : mine; }
        if (sum == G) break;
        __builtin_amdgcn_s_sleep(1);
        if ((++sp & 255u) == 0u) { if (xb_ld(&bar[XB_TMO])) break; if (sp > XB_SPIN_CAP) { atomicAdd(&bar[XB_TMO], 1u); break; } }
    }
    nloc = mine > 0u ? mine : 1u; nx = cnt > 0u ? cnt : 1u;
}
__device__ __forceinline__ void xcd_barrier(const XcdBarrier& b) {
    asm volatile("s_waitcnt vmcnt(0)" ::: "memory");
    __syncthreads();
    if (threadIdx.x == 0) {
        unsigned* bar = b.bar;
        __builtin_amdgcn_s_waitcnt(0);
        unsigned nloc = b.st[0], nx = b.st[1];
        if (nloc == 0u) { xcd_barrier_complete(bar, b.x, nloc, nx); b.st[0] = nloc; b.st[1] = nx; }
        const unsigned old = xb_add(&bar[XB_XSUB(b.x)], 1u);
        const unsigned gen = old / nloc;
        if (old + 1u == (gen + 1u) * nloc) {
            __builtin_amdgcn_fence(__ATOMIC_RELEASE, "agent");
            asm volatile("s_waitcnt vmcnt(0)" ::: "memory");
            const unsigned og = xb_add(&bar[XB_TOP], 1u);
            const unsigned tg = og / nx;
            if (og + 1u == (tg + 1u) * nx) xb_add(&bar[XB_TOPGEN], 1u);
            else XB_SPIN(xb_ld(&bar[XB_TOPGEN]) == tg, bar);
            __builtin_amdgcn_fence(__ATOMIC_ACQUIRE, "agent");
            xb_add(&bar[XB_XGEN(b.x)], 1u);
            asm volatile("s_waitcnt vmcnt(0)" ::: "memory");
        } else {
            XB_SPIN(xb_ld(&bar[XB_XGEN(b.x)]) == gen, bar);
            __builtin_amdgcn_fence(__ATOMIC_ACQUIRE, "agent");
            asm volatile("s_waitcnt vmcnt(0)" ::: "memory");
        }
    }
    __syncthreads();
}

namespace pg8 {
constexpr int BM = 256, BK = 64, HALF = 128, HTB = HALF * BK * 2, STAGE_BYTES = 8 * HTB, NXCD = 8, WGM = 8;
__host__ __device__ __forceinline__ int lds_byte(int r, int c) { const int st = (r >> 4) * 2 + (c >> 5), rr = r & 15, cc = c & 31, ob = rr * 64 + cc * 2; return st * 1024 + (ob ^ (((ob >> 9) & 1) << 5)); }
__host__ __device__ __forceinline__ void stage_rc(int b, int& R, int& C) { const int st = b / 1024, sb = b % 1024, swz = sb ^ (((sb >> 9) & 1) << 5); R = (st >> 1) * 16 + swz / 64; C = (st & 1) * 32 + (swz % 64) / 2; }
__host__ __device__ __forceinline__ int perm32(int rho) { const int n = rho >> 4, i = rho & 15; return 8 * (i >> 2) + 4 * n + (i & 3); }
struct Unit { int pm, pn; };
struct Gemm { const bf16_t* A; const bf16_t* Bt; int M, N, K; };
struct StaticOrder {
    int nM, nN, nwg, G, c;
    __host__ __device__ void init(int M, int N, int G_, int c_) { nM = M / BM; nN = N / BM; nwg = nM * nN; G = G_; c = c_; }
    __host__ __device__ bool next(int i, Unit& u) const {
        const long L = (long)i * G + c; if (L >= nwg) return false;
        int wgid = (int)L; { const int q = nwg / NXCD, r = nwg % NXCD, xcd = wgid % NXCD, off = wgid / NXCD; wgid = (xcd < r ? xcd * (q + 1) : r * (q + 1) + (xcd - r) * q) + off; }
        const int nig = WGM * nN, gid = wgid / nig, fm = gid * WGM, gsz = (nM - fm) < WGM ? (nM - fm) : WGM;
        u.pm = fm + ((wgid % nig) % gsz); u.pn = (wgid % nig) / gsz; return true;
    }
    __device__ __forceinline__ void a_ready(const Unit&) const {}
    __device__ __forceinline__ void done(const Unit&) const {}
};
typedef float f32x2_t __attribute__((ext_vector_type(2)));
typedef __bf16 bf16x2n_t __attribute__((ext_vector_type(2)));
__device__ __forceinline__ unsigned cvt_pk_bf16(float lo, float hi) { const f32x2_t f = {lo, hi}; return __builtin_bit_cast(unsigned, __builtin_convertvector(f, bf16x2n_t)); }

struct EpiProj {
    static constexpr bool PERM = true, AFTER_DRAIN = false;
    bf16_t* O; int ldc; const float* rs;
    __device__ __forceinline__ void operator()(const f32x4 (&acc)[2][2][4][2], const Unit& u, int wr, int wc, int fr, int fq) const {
        const int row0 = u.pm * BM + wr * 64 + fr; const int col0 = u.pn * BM + wc * 32 + 8 * fq;
#pragma unroll
        for (int ai = 0; ai < 2; ++ai)
#pragma unroll
            for (int m = 0; m < 4; ++m) { const int row = row0 + ai * HALF + m * 16; const float s = rs[row]; bf16_t* rowp = O + (size_t)row * ldc + col0;
#pragma unroll
                for (int bj = 0; bj < 2; ++bj) { const f32x4 v0 = acc[ai][bj][m][0] * s, v1 = acc[ai][bj][m][1] * s;
                    u32x4 w; w.x = cvt_pk_bf16(v0[0], v0[1]); w.y = cvt_pk_bf16(v0[2], v0[3]); w.z = cvt_pk_bf16(v1[0], v1[1]); w.w = cvt_pk_bf16(v1[2], v1[3]);
                    *(u32x4*)(rowp + bj * HALF) = w; } }
    }
};
struct EpiResid {
    static constexpr bool PERM = false, AFTER_DRAIN = false;
    float* C; int ldc;
    __device__ __forceinline__ void operator()(const f32x4 (&acc)[2][2][4][2], const Unit& u, int wr, int wc, int fr, int fq) const {
        const int row0 = u.pm * BM + wr * 64 + fr, col0 = u.pn * BM + wc * 32 + 4 * fq;
#pragma unroll
        for (int ai = 0; ai < 2; ++ai)
#pragma unroll
            for (int m = 0; m < 4; ++m) { float* rowp = C + (size_t)(row0 + ai * HALF + m * 16) * ldc + col0;
#pragma unroll
                for (int bj = 0; bj < 2; ++bj)
#pragma unroll
                    for (int n = 0; n < 2; ++n) { f32x4* p = (f32x4*)(rowp + bj * HALF + n * 16); *p = *p + acc[ai][bj][m][n]; } }
    }
};

template <class Epi, class Sched>
__device__ __forceinline__ void gemm_phase(LAS unsigned char* lds, const Gemm g, const Sched& S, const Epi& E) {
    const int tid = opaque_tid(), wid = __builtin_amdgcn_readfirstlane(tid >> 6), lane = tid & 63, wr = wid >> 2, wc = wid & 3, fr = lane & 15, fq = lane >> 4;
    const int K = g.K, nt = K / BK;
    unsigned voffA[2], voffB[2];
#pragma unroll
    for (int i = 0; i < 2; ++i) { int R, C; stage_rc(tid * 16 + i * 8192, R, C); const int Rb = Epi::PERM ? ((R & ~31) + perm32(R & 31)) : R;
        voffA[i] = (unsigned)(R * K + C) * 2u; voffB[i] = (unsigned)(Rb * K + C) * 2u; }
    const size_t kstep = (size_t)(BK * 2);
    const size_t hstep = (size_t)HALF * K * 2;
    const size_t tstep = 2 * hstep;
    const unsigned ldsw = (unsigned)wid * 1024u;
    const int aoff = lds_byte(wr * 64 + fr, fq * 8), boff = lds_byte(wc * 32 + fr, fq * 8);
#define PG8_SA(b, h) (((b) * 2 + (h)) * HTB)
#define PG8_SB(b, h) ((4 + (b) * 2 + (h)) * HTB)
#define PG8_STAGE(bufoff, gbase, voff) do { _Pragma("unroll") for (int _i = 0; _i < 2; ++_i) \
        __builtin_amdgcn_global_load_lds((const unsigned*)((const char*)(gbase) + (voff)[_i]), (LAS unsigned*)(lds + (bufoff) + ldsw + _i * 8192), 16, 0, 0); } while (0)
#define PG8_LDA(dst, b, h) do { _Pragma("unroll") for (int m = 0; m < 4; ++m) _Pragma("unroll") for (int k = 0; k < 2; ++k) dst[m][k] = *(const LAS bf16x8*)(lds + PG8_SA(b, h) + aoff + m * 2048 + k * 1024); } while (0)
#define PG8_LDB(dst, b, h) do { _Pragma("unroll") for (int n = 0; n < 2; ++n) _Pragma("unroll") for (int k = 0; k < 2; ++k) dst[n][k] = *(const LAS bf16x8*)(lds + PG8_SB(b, h) + boff + n * 2048 + k * 1024); } while (0)
#define PG8_MMA(ai, bj, At, Bt) do { __builtin_amdgcn_s_setprio(1); _Pragma("unroll") for (int m = 0; m < 4; ++m) _Pragma("unroll") for (int n = 0; n < 2; ++n) _Pragma("unroll") for (int k = 0; k < 2; ++k) \
        acc[ai][bj][m][n] = __builtin_amdgcn_mfma_f32_16x16x32_bf16(Bt[n][k], At[m][k], acc[ai][bj][m][n], 0, 0, 0); __builtin_amdgcn_s_setprio(0); } while (0)
#define PG8_WAIT_V(n) asm volatile("s_waitcnt vmcnt(" #n ")" ::: "memory")
#define PG8_WAIT_L(n) asm volatile("s_waitcnt lgkmcnt(" #n ")" ::: "memory")
#define PG8_BAR __builtin_amdgcn_s_barrier()
#define PG8_SCHED __builtin_amdgcn_sched_barrier(0)
    Unit cur, nxt; int ui = 0;
    if (!S.next(0, cur)) return;
    f32x4 acc[2][2][4][2];
#pragma unroll
    for (int a = 0; a < 2; ++a)
#pragma unroll
        for (int b = 0; b < 2; ++b)
#pragma unroll
            for (int m = 0; m < 4; ++m)
#pragma unroll
                for (int n = 0; n < 2; ++n) acc[a][b][m][n] = (f32x4){0.f, 0.f, 0.f, 0.f};
    bf16x8 At[4][2], B0[2][2], B1[2][2];
    const char* cA = (const char*)g.A + (size_t)cur.pm * tstep; const char* cB = (const char*)g.Bt + (size_t)cur.pn * tstep;
    S.a_ready(cur);
    PG8_STAGE(PG8_SB(0, 0), cB, voffB); PG8_STAGE(PG8_SA(0, 0), cA, voffA); PG8_STAGE(PG8_SB(0, 1), cB + hstep, voffB); PG8_STAGE(PG8_SA(0, 1), cA + hstep, voffA);
    if (wr == 1) PG8_BAR;
    PG8_WAIT_V(4); PG8_BAR;
    PG8_STAGE(PG8_SB(1, 0), cB + kstep, voffB); PG8_STAGE(PG8_SA(1, 0), cA + kstep, voffA); PG8_STAGE(PG8_SB(1, 1), cB + hstep + kstep, voffB);
    PG8_WAIT_V(6); PG8_BAR;
    for (;;) {
        const bool has_next = S.next(ui + 1, nxt);
        const char* nA = has_next ? (const char*)g.A + (size_t)nxt.pm * tstep : cA; const char* nB = has_next ? (const char*)g.Bt + (size_t)nxt.pn * tstep : cB;
        for (int t = 0; t < nt; t += 2) {
            const bool last = (t == nt - 2);
            const char* a1 = cA + (size_t)(t + 1) * kstep;
            const char* a2 = last ? nA : cA + (size_t)(t + 2) * kstep; const char* b2 = last ? nB : cB + (size_t)(t + 2) * kstep;
            const char* a3 = a2 + kstep; const char* b3 = b2 + kstep;
            if (last && has_next) S.a_ready(nxt);
            PG8_LDB(B0, 0, 0); PG8_SCHED; PG8_LDA(At, 0, 0); PG8_STAGE(PG8_SA(1, 1), a1 + hstep, voffA);
            PG8_WAIT_L(8); PG8_BAR; PG8_WAIT_L(0); PG8_MMA(0, 0, At, B0); PG8_BAR; PG8_SCHED;
            PG8_LDB(B1, 0, 1); PG8_STAGE(PG8_SB(0, 0), b2, voffB);
            PG8_BAR; PG8_WAIT_L(0); PG8_MMA(0, 1, At, B1); PG8_BAR;
            PG8_LDA(At, 0, 1); PG8_STAGE(PG8_SA(0, 0), a2, voffA);
            PG8_BAR; PG8_WAIT_L(0); PG8_MMA(1, 0, At, B0); PG8_BAR; PG8_SCHED;
            PG8_STAGE(PG8_SB(0, 1), b2 + hstep, voffB);
            PG8_WAIT_V(6); PG8_BAR; PG8_MMA(1, 1, At, B1); PG8_BAR;
            PG8_LDB(B0, 1, 0); PG8_SCHED; PG8_LDA(At, 1, 0); PG8_STAGE(PG8_SA(0, 1), a2 + hstep, voffA);
            PG8_WAIT_L(8); PG8_BAR; PG8_WAIT_L(0); PG8_MMA(0, 0, At, B0); PG8_BAR; PG8_SCHED;
            PG8_LDB(B1, 1, 1); PG8_STAGE(PG8_SB(1, 0), b3, voffB);
            PG8_BAR; PG8_WAIT_L(0); PG8_MMA(0, 1, At, B1); PG8_BAR;
            PG8_LDA(At, 1, 1); PG8_STAGE(PG8_SA(1, 0), a3, voffA);
            PG8_BAR; PG8_WAIT_L(0); PG8_MMA(1, 0, At, B0); PG8_BAR; PG8_SCHED;
            PG8_STAGE(PG8_SB(1, 1), b3 + hstep, voffB);
            PG8_WAIT_V(6); PG8_BAR; PG8_MMA(1, 1, At, B1); PG8_BAR;
        }
        if constexpr (!Epi::AFTER_DRAIN) { E(acc, cur, wr, wc, fr, fq); S.done(cur); }
        if (!has_next) break;
#pragma unroll
        for (int a = 0; a < 2; ++a)
#pragma unroll
            for (int b = 0; b < 2; ++b)
#pragma unroll
                for (int m = 0; m < 4; ++m)
#pragma unroll
                    for (int n = 0; n < 2; ++n) acc[a][b][m][n] = (f32x4){0.f, 0.f, 0.f, 0.f};
        cur = nxt; cA = nA; cB = nB; ++ui;
    }
    PG8_WAIT_V(0);
    if (wr == 0) PG8_BAR;
    PG8_BAR;
#undef PG8_SA
#undef PG8_SB
#undef PG8_STAGE
#undef PG8_LDA
#undef PG8_LDB
#undef PG8_MMA
#undef PG8_WAIT_V
#undef PG8_WAIT_L
#undef PG8_BAR
#undef PG8_SCHED
}
}

__device__ __forceinline__ int win_col(int n) { return n < 2048 ? n : (n < 3072 ? n + 8 : n + 12); }
__device__ __forceinline__ int win_smcol(int j) { return j < 8 ? 2048 + j : 3080 + (j - 8); }

__device__ void ph_prep(const Params& p, LAS unsigned char* lds, int blk, int nblk) {
    const int tid = opaque_tid();
    LAS float* tile = (LAS float*)lds;
    const int tiles_in = DEPTH * 64 * 16, tiles_out = DEPTH * 16 * 16;
    for (int t = blk; t < tiles_in + tiles_out; t += nblk) {
        const float* src; bf16_t* dst; int ld, n0, k0, l; const float* scale;
        if (t < tiles_in) { l = t / 1024; const int r = t % 1024; n0 = (r / 16) * 64; k0 = (r % 16) * 64; src = p.w_in + (size_t)l * DM * IN_DIM + win_col(n0); ld = IN_DIM;
            dst = (bf16_t*)(p.ws + WS_WINT) + (size_t)l * NBIG * DM; scale = p.norm_w + l * DM; }
        else { const int tt = t - tiles_in; l = tt / 256; const int r = tt % 256; n0 = (r / 16) * 64; k0 = (r % 16) * 64; src = p.w_out + (size_t)l * DM * DM + n0; ld = DM;
            dst = (bf16_t*)(p.ws + WS_WOUTT) + (size_t)l * DM * DM; scale = nullptr; }
        __syncthreads();
        for (int e = tid; e < 64 * 64; e += 512) { const int kk = e >> 6, nn = e & 63; float v = src[(size_t)(k0 + kk) * ld + nn]; if (scale) v *= scale[k0 + kk]; tile[kk * 65 + nn] = v; }
        __syncthreads();
        for (int e = tid; e < 64 * 32; e += 512) { const int nn = e >> 5, kp = (e & 31) * 2; const unsigned w = pack_bf2(tile[kp * 65 + nn], tile[(kp + 1) * 65 + nn]);
            *(unsigned*)(dst + (size_t)(n0 + nn) * DM + k0 + kp) = w; }
    }
    for (int e = blk * 512 + tid; e < DEPTH * NSM * DM; e += nblk * 512) { const int l = e / (NSM * DM), r = e % (NSM * DM), j = r / DM, k = r % DM;
        ((float*)(p.ws + WS_WSM))[e] = p.w_in[(size_t)l * DM * IN_DIM + (size_t)k * IN_DIM + win_smcol(j)] * p.norm_w[l * DM + k]; }
    for (int c = blk * 512 + tid; c < 256; c += nblk * 512) { float lg[DEPTH], mx = -1e30f;
#pragma unroll
        for (int l = 0; l < DEPTH; ++l) { lg[l] = p.lb_logits[l * 256 + c]; mx = fmaxf(mx, lg[l]); }
        float s = 0.f;
#pragma unroll
        for (int l = 0; l < DEPTH; ++l) { lg[l] = expf(lg[l] - mx); s += lg[l]; }
        float cum = 0.f; const float w0 = lg[0] / s;
#pragma unroll
        for (int l = 0; l < DEPTH; ++l) { cum += lg[l] / s; ((float*)(p.ws + WS_LB))[l * 256 + c] = fmaxf(cum - w0, 0.f); } }
    for (int e = blk * 512 + tid; e < (TP + 1) * 32; e += nblk * 512) { const int pi = e >> 5, i = e & 31; const double pos = pi < TP ? (double)pi : (double)PASTLEN;
        const float invf = (float)(1.0 / pow(10000.0, (double)((float)i / 31.0f)));
        const double rev = pos * (double)invf * 0.15915494309189535; const float fr = (float)(rev - rint(rev));
        ((float*)(p.ws + WS_ROT))[e * 2 + 0] = __builtin_amdgcn_cosf(fr); ((float*)(p.ws + WS_ROT))[e * 2 + 1] = __builtin_amdgcn_sinf(fr); }
    float* h = (float*)(p.ws + WS_H);
    for (int e = blk * 512 + tid; e < MROWS * (DM / 4); e += nblk * 512) { const int row = e >> 8, c4 = (e & 255) * 4; const float* src;
        if (row < MP) { const int b = row / TP, t = row % TP; src = t < NMETA ? p.meta + t * DM : p.x_prompt + ((size_t)b * SEQ + (t - NMETA)) * DM; } else src = p.x_sample + (size_t)(row - MP) * DM;
        *(f32x4*)(h + (size_t)row * DM + c4) = *(const f32x4*)(src + c4); }
}

__device__ void ph_rownorm(const Params& p, int layer, int blk, int nblk) {
    const int tid = opaque_tid(), wid = tid >> 6, lane = tid & 63;
    const float* h = (const float*)(p.ws + WS_H); bf16_t* hb = (bf16_t*)(p.ws + WS_HB); float* rs = (float*)(p.ws + WS_RS); float* psm = (float*)(p.ws + WS_PSM);
    const float* wsm = (const float*)(p.ws + WS_WSM) + (size_t)layer * NSM * DM;
    for (int row = blk * 8 + wid; row < MROWS; row += nblk * 8) {
        f32x4 v[4]; float ss = 0.f;
#pragma unroll
        for (int j = 0; j < 4; ++j) { v[j] = *(const f32x4*)(h + (size_t)row * DM + j * 256 + lane * 4); ss += v[j][0] * v[j][0] + v[j][1] * v[j][1] + v[j][2] * v[j][2] + v[j][3] * v[j][3]; }
        ss = wave_sum(ss); const float r = rsqrtf(ss * (1.0f / DM) + EPSF);
#pragma unroll
        for (int j = 0; j < 4; ++j) { u32x2 w; w.x = pack_bf2(v[j][0], v[j][1]); w.y = pack_bf2(v[j][2], v[j][3]); *(u32x2*)(hb + (size_t)row * DM + j * 256 + lane * 4) = w; }
        float mine = 0.f;
        for (int q = 0; q < NSM; ++q) { float d = 0.f;
#pragma unroll
            for (int j = 0; j < 4; ++j) { const f32x4 w = *(const f32x4*)(wsm + q * DM + j * 256 + lane * 4); d += v[j][0] * w[0] + v[j][1] * w[1] + v[j][2] * w[2] + v[j][3] * w[3]; }
            d = wave_sum(d); if (lane == q) mine = d * r; }
        if (lane < NSM) psm[(size_t)row * NSM + lane] = mine;
        if (lane == 0) rs[row] = r;
    }
}

__device__ void ph_gemm_in(const Params& p, int layer, LAS unsigned char* lds, int blk, int nblk) {
    pg8::Gemm g{(const bf16_t*)(p.ws + WS_HB), (const bf16_t*)(p.ws + WS_WINT) + (size_t)layer * NBIG * DM, MROWS, NBIG, DM};
    pg8::StaticOrder S; S.init(MROWS, NBIG, nblk, blk);
    pg8::EpiProj E{(bf16_t*)(p.ws + WS_PROJ), NBIG, (const float*)(p.ws + WS_RS)};
    pg8::gemm_phase<pg8::EpiProj, pg8::StaticOrder>(lds, g, S, E);
}
__device__ void ph_gemm_out(const Params& p, int layer, LAS unsigned char* lds, int blk, int nblk) {
    pg8::Gemm g{(const bf16_t*)(p.ws + WS_Y), (const bf16_t*)(p.ws + WS_WOUTT) + (size_t)layer * DM * DM, MROWS, DM, DM};
    pg8::StaticOrder S; S.init(MROWS, DM, nblk, blk);
    pg8::EpiResid E{(float*)(p.ws + WS_H), DM};
    pg8::gemm_phase<pg8::EpiResid, pg8::StaticOrder>(lds, g, S, E);
}

constexpr int TB = 16;
struct MixLds {
    static constexpr int QS = 0, KS = QS + TB * 128, VS = KS + TB * 128, DS = VS + TB * 128, ZS = DS + TB * 128, XS = ZS + TB * 128, OS = XS + TB * 128, BS = OS + TB * 128, SC = BS + TB * 2, END = SC + TB * 2;
};

struct SeqInfo { int row0, T, dec, b; };
__device__ __forceinline__ SeqInfo seq_info(int s) { SeqInfo q; if (s < NB) { q.row0 = s * TP; q.T = TP; q.dec = 0; q.b = s; } else { q.row0 = MP + (s - NB); q.T = 1; q.dec = 1; q.b = s - NB; } return q; }

__device__ __forceinline__ float preconv(const bf16_t* proj, const SeqInfo& q, int t, int col, const float* ctx  , int ch) {
    if (t >= 0) return bf2f(proj[(size_t)(q.row0 + t) * NBIG + col]);
    return ctx ? ctx[(3 + t) * 768 + ch] : 0.f;
}

template <int DK, int NV, bool DELTA, bool VECDEC>
__device__ __forceinline__ void recur_batch(float (&S)[DK / (64 / NV)], LAS float* L, int nb, int wid, int lane) {
    constexpr int KQ = 64 / NV, KR = DK / KQ, DVT = 8 * NV;
    const int kq = lane / NV, vv = lane % NV, vcol = wid * NV + vv, hh = vcol >> 6;
    for (int t = 0; t < nb; ++t) {
        float kk[KR], qq[KR];
#pragma unroll
        for (int i = 0; i < KR; ++i) { kk[i] = L[MixLds::KS + t * 128 + kq * KR + i]; qq[i] = L[MixLds::QS + t * 128 + kq * KR + i]; }
        const float v = L[MixLds::VS + t * 128 + vcol];
        if (DELTA) {
            const float dec = L[MixLds::DS + t * 128 + hh]; float pk = 0.f;
#pragma unroll
            for (int i = 0; i < KR; ++i) { S[i] *= dec; pk += kk[i] * S[i]; }
#pragma unroll
            for (int o = NV; o < 64; o <<= 1) pk += __shfl_xor(pk, o);
            const float u = L[MixLds::BS + t] * (v - pk);
#pragma unroll
            for (int i = 0; i < KR; ++i) S[i] += kk[i] * u;
        } else if (VECDEC) {
#pragma unroll
            for (int i = 0; i < KR; ++i) S[i] = L[MixLds::DS + t * 128 + kq * KR + i] * S[i] + kk[i] * v;
        } else {
            const float dec = L[MixLds::DS + t * 128 + hh];
#pragma unroll
            for (int i = 0; i < KR; ++i) S[i] = dec * S[i] + kk[i] * v;
        }
        float po = 0.f;
#pragma unroll
        for (int i = 0; i < KR; ++i) po += qq[i] * S[i];
#pragma unroll
        for (int o = NV; o < 64; o <<= 1) po += __shfl_xor(po, o);
        if (kq == 0) L[MixLds::OS + t * 128 + vcol] = po;
    }
    (void)DVT;
}

template <int MIX>
__device__ void mixer_item(const Params& p, int layer, int s, int hu  , LAS float* L) {
    constexpr int DK = MIX == 2 ? 128 : 64, NV = MIX == 2 ? 16 : 8, KQ = 64 / NV, KR = DK / KQ, DVT = 8 * NV;
    const int tid = opaque_tid(), wid = tid >> 6, lane = tid & 63;
    const SeqInfo q = seq_info(s);
    const bf16_t* proj = (const bf16_t*)(p.ws + WS_PROJ); const float* psm = (const float*)(p.ws + WS_PSM); bf16_t* y = (bf16_t*)(p.ws + WS_Y);
    const float* lb = (const float*)(p.ws + WS_LB) + layer * 256; const float* rot = (const float*)(p.ws + WS_ROT);
    const int kq = lane / NV, vv = lane % NV, vcol = wid * NV + vv, hh = vcol >> 6;
    const int head = MIX == 2 ? hu * 2 + hh : hu;
    const float* ctx = nullptr; const float* cw = nullptr;
    if (MIX == 1) { cw = p.gdn_conv_w + (size_t)layer * 4 * 768; if (q.dec) ctx = p.st_gconv + ((size_t)layer * DECB + q.b) * 3 * 768; }
    if (MIX == 2) { cw = p.ssd_conv_w + (size_t)layer * 4 * 768; if (q.dec) ctx = p.st_sconv + ((size_t)layer * DECB + q.b) * 3 * 768; }
    float S[KR];
    {
        const float* st = MIX == 0 ? p.st_hgrn : MIX == 1 ? p.st_gdn : MIX == 2 ? p.st_ssd : p.st_ret;
#pragma unroll
        for (int i = 0; i < KR; ++i) S[i] = q.dec ? st[(((size_t)layer * DECB + q.b) * 4 + head) * DK * 64 + (size_t)(kq * KR + i) * 64 + (vcol & 63)] : 0.f;
    }
    float hc0 = 0.f, hc1 = 0.f;
    if (MIX == 1) { hc0 = -__expf(p.gdn_a_log[layer * 4 + hu]); hc1 = p.gdn_dt_bias[layer * 4 + hu]; }
    if (MIX == 3) { hc0 = 1.0f - exp2f(-5.0f - (float)hu); }

    for (int t0 = 0; t0 < q.T; t0 += TB) {
        const int nb = min(TB, q.T - t0);
        __syncthreads();
        if (MIX == 0) {
            for (int e = tid; e < nb * 64; e += 512) { const int t = e >> 6, d = e & 63, c = hu * 64 + d; const bf16_t* pr = proj + (size_t)(q.row0 + t0 + t) * NBIG;
                const float aq = bf2f(pr[PC_AQ + c]), af = bf2f(pr[PC_AF + c]), ai = bf2f(pr[PC_AI + c]), az = bf2f(pr[PC_AZ + c]), l_ = lb[c];
                L[MixLds::QS + t * 128 + d] = silu_f(aq) * 0.125f; L[MixLds::KS + t * 128 + d] = (1.0f - l_) * sigmoid_f(-af); L[MixLds::DS + t * 128 + d] = l_ + (1.0f - l_) * sigmoid_f(af);
                L[MixLds::VS + t * 128 + d] = ai; L[MixLds::ZS + t * 128 + d] = az; }
        } else if (MIX == 1) {
            for (int e = tid; e < nb * 192; e += 512) { const int t = e / 192, r = e % 192, part = r >> 6, d = r & 63, ch = part * 256 + hu * 64 + d, col = PC_BQKV + ch; const int tt = t0 + t;
                float a = 0.f;
#pragma unroll
                for (int j = 0; j < 4; ++j) a += cw[j * 768 + ch] * preconv(proj, q, tt - 3 + j, col, ctx, ch);
                a = silu_f(a);
                L[(part == 0 ? MixLds::QS : part == 1 ? MixLds::KS : MixLds::VS) + t * 128 + d] = a; }
            for (int e = tid; e < nb * 64; e += 512) { const int t = e >> 6, d = e & 63; L[MixLds::ZS + t * 128 + d] = bf2f(proj[(size_t)(q.row0 + t0 + t) * NBIG + PC_BZ + hu * 64 + d]); }
            if (tid < nb) { const float* ps = psm + (size_t)(q.row0 + t0 + tid) * NSM; const float g = hc0 * softplus_f(ps[hu] + hc1);
                L[MixLds::DS + tid * 128 + 0] = __expf(g); L[MixLds::BS + tid] = sigmoid_f(ps[4 + hu]); }
            __syncthreads();
            if (tid < nb * 2) { const int t = tid >> 1, which = tid & 1; const LAS float* src = L + (which ? MixLds::KS : MixLds::QS) + t * 128; float ss = 0.f;
                for (int d = 0; d < 64; ++d) ss += src[d] * src[d];
                L[MixLds::SC + tid] = rsqrtf(ss + EPSF) * (which ? 1.0f : 0.125f); }
            __syncthreads();
            for (int e = tid; e < nb * 128; e += 512) { const int t = e >> 7, r = e & 127, which = r >> 6, d = r & 63; L[(which ? MixLds::KS : MixLds::QS) + t * 128 + d] *= L[MixLds::SC + t * 2 + which]; }
        } else if (MIX == 2) {
            if (tid < nb * 2) { const int t = tid >> 1, h2 = tid & 1, hd = hu * 2 + h2; const float dt = softplus_f(psm[(size_t)(q.row0 + t0 + t) * NSM + 8 + hd] + p.ssd_dt_bias[layer * 4 + hd]);
                L[MixLds::BS + tid] = dt; L[MixLds::DS + t * 128 + h2] = __expf(-dt * __expf(p.ssd_a_log[layer * 4 + hd])); }
            __syncthreads();
            for (int e = tid; e < nb * 384; e += 512) { const int t = e / 384, r = e % 384, part = r >> 7, j = r & 127, ch = part * 256 + hu * 128 + j, col = PC_CXBC + ch; const int tt = t0 + t;
                float a = p.ssd_conv_b[layer * 768 + ch];
#pragma unroll
                for (int jj = 0; jj < 4; ++jj) a += cw[jj * 768 + ch] * preconv(proj, q, tt - 3 + jj, col, ctx, ch);
                a = silu_f(a);
                if (part == 0) { L[MixLds::XS + t * 128 + j] = a; L[MixLds::VS + t * 128 + j] = a * L[MixLds::BS + t * 2 + (j >> 6)]; }
                else if (part == 1) L[MixLds::KS + t * 128 + j] = a; else L[MixLds::QS + t * 128 + j] = a; }
            for (int e = tid; e < nb * 128; e += 512) { const int t = e >> 7, j = e & 127; L[MixLds::ZS + t * 128 + j] = bf2f(proj[(size_t)(q.row0 + t0 + t) * NBIG + PC_CZ + hu * 128 + j]); }
        } else {
            for (int e = tid; e < nb * 32; e += 512) { const int t = e >> 5, i = e & 31; const bf16_t* pr = proj + (size_t)(q.row0 + t0 + t) * NBIG; const int pidx = q.dec ? TP : (t0 + t);
                const float cs = rot[(pidx * 32 + i) * 2], sn = rot[(pidx * 32 + i) * 2 + 1];
                const float q1 = bf2f(pr[PC_DQ + hu * 64 + i]), q2 = bf2f(pr[PC_DQ + hu * 64 + 32 + i]), k1 = bf2f(pr[PC_DK + hu * 64 + i]), k2 = bf2f(pr[PC_DK + hu * 64 + 32 + i]);
                L[MixLds::QS + t * 128 + i] = q1 * cs - q2 * sn; L[MixLds::QS + t * 128 + 32 + i] = q2 * cs + q1 * sn;
                L[MixLds::KS + t * 128 + i] = (k1 * cs - k2 * sn) * 0.125f; L[MixLds::KS + t * 128 + 32 + i] = (k2 * cs + k1 * sn) * 0.125f; }
            for (int e = tid; e < nb * 64; e += 512) { const int t = e >> 6, d = e & 63; const bf16_t* pr = proj + (size_t)(q.row0 + t0 + t) * NBIG;
                L[MixLds::VS + t * 128 + d] = bf2f(pr[PC_DV + hu * 64 + d]); L[MixLds::ZS + t * 128 + d] = bf2f(pr[PC_DZ + hu * 64 + d]); }
            if (tid < nb) L[MixLds::DS + tid * 128] = hc0;
        }
        __syncthreads();
        recur_batch<DK, NV, MIX == 1, MIX == 0>(S, L, nb, wid, lane);
        __syncthreads();
        for (int t = wid; t < nb; t += 8) {
            const size_t yrow = (size_t)(q.row0 + t0 + t) * DM;
            if (MIX == 0 || MIX == 1) { const float o = L[MixLds::OS + t * 128 + lane]; const float ms = wave_sum(o * o) * (1.0f / 64.0f);
                const float w = (MIX == 0 ? p.hgrn_norm_w : p.gdn_norm_w)[layer * 256 + hu * 64 + lane];
                y[yrow + (MIX == 0 ? 0 : 256) + hu * 64 + lane] = f2bf(o * rsqrtf(ms + EPSF) * w * silu_f(L[MixLds::ZS + t * 128 + lane])); }
            else if (MIX == 2) { float u[2]; float ss = 0.f;
#pragma unroll
                for (int r = 0; r < 2; ++r) { const int j = lane + 64 * r; const float o = L[MixLds::OS + t * 128 + j] + p.ssd_d[layer * 4 + hu * 2 + r] * L[MixLds::XS + t * 128 + j]; u[r] = o * silu_f(L[MixLds::ZS + t * 128 + j]); ss += u[r] * u[r]; }
                const float sc = rsqrtf(wave_sum(ss) * (1.0f / 128.0f) + EPSF);
#pragma unroll
                for (int r = 0; r < 2; ++r) { const int j = lane + 64 * r; y[yrow + 512 + hu * 128 + j] = f2bf(u[r] * sc * p.ssd_norm_w[layer * 256 + hu * 128 + j]); } }
            else { const float o = L[MixLds::OS + t * 128 + lane]; const float mu = wave_sum(o) * (1.0f / 64.0f); const float dv = o - mu; const float var = wave_sum(dv * dv) * (1.0f / 64.0f);
                const int c = hu * 64 + lane;
                y[yrow + 768 + c] = f2bf((dv * rsqrtf(var + EPSF) * p.ret_norm_w[layer * 256 + c] + p.ret_norm_b[layer * 256 + c]) * silu_f(L[MixLds::ZS + t * 128 + lane])); }
        }
    }
    {
        float* so = p.out + (q.dec ? (MIX == 0 ? O_HGRN_S : MIX == 1 ? O_GDN_S : MIX == 2 ? O_SSD_S : O_RET_S) : (MIX == 0 ? O_HGRN_P : MIX == 1 ? O_GDN_P : MIX == 2 ? O_SSD_P : O_RET_P));
        const int nbt = q.dec ? DECB : NB;
#pragma unroll
        for (int i = 0; i < KR; ++i) so[(((size_t)layer * nbt + q.b) * 4 + head) * DK * 64 + (size_t)(kq * KR + i) * 64 + (vcol & 63)] = S[i];
    }
    if (MIX == 1 || MIX == 2) {
        float* co = p.out + (q.dec ? (MIX == 1 ? O_GCONV_S : O_SCONV_S) : (MIX == 1 ? O_GCONV_P : O_SCONV_P)) + ((size_t)layer * (q.dec ? DECB : NB) + q.b) * 3 * 768;
        const int nch = MIX == 1 ? 192 : 384;
        for (int e = tid; e < 3 * nch; e += 512) { const int r = e / nch, c = e % nch; int ch;
            if (MIX == 1) ch = (c >> 6) * 256 + hu * 64 + (c & 63); else ch = (c >> 7) * 256 + hu * 128 + (c & 127);
            co[r * 768 + ch] = preconv(proj, q, q.T - 3 + r, (MIX == 1 ? PC_BQKV : PC_CXBC) + ch, ctx, ch); }
    }
    (void)DVT;
}

constexpr int NCHUNK = 33;
constexpr int LDP = 72;
constexpr int LDP2 = 136;
constexpr int OSP = 68;
typedef short bf16x4 __attribute__((ext_vector_type(4)));
__device__ __forceinline__ f32x4 mfma16(bf16x8 a, bf16x8 b, f32x4 c) { return __builtin_amdgcn_mfma_f32_16x16x32_bf16(a, b, c, 0, 0, 0); }
__device__ __forceinline__ float fexp2(float x) { return __builtin_amdgcn_exp2f(x); }
__device__ __forceinline__ bf16x8 frag_ld(const LAS bf16_t* t, int pitch, int row, int col) { return *(const LAS bf16x8*)(t + row * pitch + col); }
__device__ __forceinline__ bf16x8 frag_ld_perm(const LAS bf16_t* t, int pitch, int row, int k0, int q) {
    const bf16x4 lo = *(const LAS bf16x4*)(t + row * pitch + k0 + 4 * q), hi = *(const LAS bf16x4*)(t + row * pitch + k0 + 16 + 4 * q);
    return __builtin_shufflevector(lo, hi, 0, 1, 2, 3, 4, 5, 6, 7);
}
__device__ __forceinline__ bf16x8 pack_acc2(const f32x4& a, const f32x4& b) {
    u32x4 w; w.x = pg8::cvt_pk_bf16(a[0], a[1]); w.y = pg8::cvt_pk_bf16(a[2], a[3]); w.z = pg8::cvt_pk_bf16(b[0], b[1]); w.w = pg8::cvt_pk_bf16(b[2], b[3]);
    return __builtin_bit_cast(bf16x8, w);
}
__device__ __forceinline__ void st_bf4(LAS bf16_t* dst, const f32x4& v) { u32x2 w; w.x = pg8::cvt_pk_bf16(v[0], v[1]); w.y = pg8::cvt_pk_bf16(v[2], v[3]); *(LAS u32x2*)dst = w; }

struct RetLds { static constexpr int QS = 0, KS = QS + 64 * LDP * 2, KT = KS + 64 * LDP * 2, VT = KT + 64 * LDP * 2, VH = VT + 64 * LDP * 2, PS = VH + 64 * LDP * 2, OS = PS + 64 * LDP * 2, END = OS + 64 * OSP * 4; };
__device__ void ret_prompt_item(const Params& p, int layer, int b, int hu, LAS unsigned char* lds) {
    const int tid = opaque_tid(), wid = tid >> 6, lane = tid & 63, fq = lane >> 4, fc = lane & 15;
    LAS bf16_t* Qs = (LAS bf16_t*)(lds + RetLds::QS); LAS bf16_t* Ks = (LAS bf16_t*)(lds + RetLds::KS); LAS bf16_t* KT = (LAS bf16_t*)(lds + RetLds::KT);
    LAS bf16_t* VT = (LAS bf16_t*)(lds + RetLds::VT); LAS bf16_t* VH = (LAS bf16_t*)(lds + RetLds::VH); LAS bf16_t* Ps = (LAS bf16_t*)(lds + RetLds::PS); LAS float* Os = (LAS float*)(lds + RetLds::OS);
    const bf16_t* proj = (const bf16_t*)(p.ws + WS_PROJ); bf16_t* y = (bf16_t*)(p.ws + WS_Y); const float* rot = (const float*)(p.ws + WS_ROT);
    const float lg2 = log2f(1.0f - exp2f(-5.0f - (float)hu));
    f32x4 S[4];
#pragma unroll
    for (int m = 0; m < 4; ++m) S[m] = (f32x4){0.f, 0.f, 0.f, 0.f};
    __syncthreads();
    for (int c = 0; c < NCHUNK; ++c) {
        const int i0 = c == 0 ? 48 : 0, t0 = 64 * c - 48, row0 = b * TP + t0, nlast = 64 - i0;
        for (int e = tid; e < 64 * 32; e += 512) { const int i = e >> 5, d = e & 31; float qa = 0.f, qb = 0.f, ka = 0.f, kb = 0.f;
            if (i >= i0) { const bf16_t* pr = proj + (size_t)(row0 + i) * NBIG; const float cs = rot[((t0 + i) * 32 + d) * 2], sn = rot[((t0 + i) * 32 + d) * 2 + 1];
                const float q1 = bf2f(pr[PC_DQ + hu * 64 + d]), q2 = bf2f(pr[PC_DQ + hu * 64 + 32 + d]), k1 = bf2f(pr[PC_DK + hu * 64 + d]), k2 = bf2f(pr[PC_DK + hu * 64 + 32 + d]);
                qa = q1 * cs - q2 * sn; qb = q2 * cs + q1 * sn; ka = (k1 * cs - k2 * sn) * 0.125f; kb = (k2 * cs + k1 * sn) * 0.125f; }
            Qs[i * LDP + d] = f2bf(qa); Qs[i * LDP + 32 + d] = f2bf(qb); Ks[i * LDP + d] = f2bf(ka); Ks[i * LDP + 32 + d] = f2bf(kb);
            KT[d * LDP + i] = f2bf(ka); KT[(d + 32) * LDP + i] = f2bf(kb); }
        for (int e = tid; e < 64 * 64; e += 512) { const int i = e >> 6, d = e & 63; float v = 0.f, vh = 0.f;
            if (i >= i0) { v = bf2f(proj[(size_t)(row0 + i) * NBIG + PC_DV + hu * 64 + d]); vh = v * fexp2((float)(63 - i) * lg2); }
            VT[d * LDP + i] = f2bf(v); VH[d * LDP + i] = f2bf(vh); }
        __syncthreads();
#pragma unroll
        for (int tt = 0; tt < 2; ++tt) { const int t = wid * 2 + tt, I = t >> 2, J = t & 3; f32x4 acc = (f32x4){0.f, 0.f, 0.f, 0.f};
            if (J <= I) {
#pragma unroll
                for (int s = 0; s < 2; ++s) acc = mfma16(frag_ld(Ks, LDP, 16 * J + fc, 32 * s + 8 * fq), frag_ld(Qs, LDP, 16 * I + fc, 32 * s + 8 * fq), acc); }
            const int i = 16 * I + fc;
#pragma unroll
            for (int r = 0; r < 4; ++r) { const int j = 16 * J + 4 * fq + r; acc[r] = (j <= i && j >= i0) ? acc[r] * fexp2((float)(i - j) * lg2) : 0.f; }
            st_bf4(Ps + i * LDP + 16 * J + 4 * fq, acc); }
        __syncthreads();
        if (wid < 4) {
            bf16x8 bv[2], bh[2], Sb[2];
#pragma unroll
            for (int s = 0; s < 2; ++s) { bv[s] = frag_ld(VT, LDP, 16 * wid + fc, 32 * s + 8 * fq); bh[s] = frag_ld(VH, LDP, 16 * wid + fc, 32 * s + 8 * fq); Sb[s] = pack_acc2(S[2 * s], S[2 * s + 1]); }
#pragma unroll
            for (int mi = 0; mi < 4; ++mi) { f32x4 o1 = (f32x4){0.f, 0.f, 0.f, 0.f}, o2 = (f32x4){0.f, 0.f, 0.f, 0.f};
#pragma unroll
                for (int s = 0; s < 2; ++s) { o1 = mfma16(frag_ld(Ps, LDP, 16 * mi + fc, 32 * s + 8 * fq), bv[s], o1); o2 = mfma16(frag_ld_perm(Qs, LDP, 16 * mi + fc, 32 * s, fq), Sb[s], o2); }
#pragma unroll
                for (int r = 0; r < 4; ++r) { const int i = 16 * mi + 4 * fq + r; Os[i * OSP + 16 * wid + fc] = o1[r] + fexp2((float)max(i - i0 + 1, 0) * lg2) * o2[r]; } }
            const float al = fexp2((float)nlast * lg2);
#pragma unroll
            for (int m = 0; m < 4; ++m) { S[m] = S[m] * al;
#pragma unroll
                for (int s = 0; s < 2; ++s) S[m] = mfma16(frag_ld(KT, LDP, 16 * m + fc, 32 * s + 8 * fq), bh[s], S[m]); }
        }
        __syncthreads();
        for (int i = wid + (i0 ? 48 : 0); i < 64; i += 8) { const size_t row = (size_t)(row0 + i); const float o = Os[i * OSP + lane]; const float mu = wave_sum(o) * (1.0f / 64.0f); const float dv = o - mu;
            const float var = wave_sum(dv * dv) * (1.0f / 64.0f); const int cc = hu * 64 + lane;
            y[row * DM + 768 + cc] = f2bf((dv * rsqrtf(var + EPSF) * p.ret_norm_w[layer * 256 + cc] + p.ret_norm_b[layer * 256 + cc]) * silu_f(bf2f(proj[row * NBIG + PC_DZ + cc]))); }
    }
    if (wid < 4) { float* so = p.out + O_RET_P + (((size_t)layer * NB + b) * 4 + hu) * 4096;
#pragma unroll
        for (int m = 0; m < 4; ++m)
#pragma unroll
            for (int r = 0; r < 4; ++r) so[(16 * m + 4 * fq + r) * 64 + 16 * wid + fc] = S[m][r]; }
}

struct SsdLds { static constexpr int CS = 0, BS = CS + 64 * LDP2 * 2, BT = BS + 64 * LDP2 * 2, XS = BT + 128 * LDP * 2, VT = XS + 64 * LDP2 * 2  , VH = VT + 2 * 64 * LDP * 2, PS = VH + 2 * 64 * LDP * 2,
    OS = PS + 2 * 64 * LDP * 2  , DT = OS + 64 * 132 * 4  , GV = DT + 512, END = GV + 512; };
__device__ void ssd_prompt_item(const Params& p, int layer, int b, int gg, LAS unsigned char* lds) {
    const int tid = opaque_tid(), wid = tid >> 6, lane = tid & 63, fq = lane >> 4, fc = lane & 15;
    LAS bf16_t* Cs = (LAS bf16_t*)(lds + SsdLds::CS); LAS bf16_t* Bs = (LAS bf16_t*)(lds + SsdLds::BS); LAS bf16_t* BT = (LAS bf16_t*)(lds + SsdLds::BT); LAS bf16_t* Xs = (LAS bf16_t*)(lds + SsdLds::XS);
    LAS bf16_t* VT = (LAS bf16_t*)(lds + SsdLds::VT); LAS bf16_t* VH = (LAS bf16_t*)(lds + SsdLds::VH); LAS bf16_t* Ps = (LAS bf16_t*)(lds + SsdLds::PS);
    LAS float* Os = (LAS float*)(lds + SsdLds::OS); LAS float* DTv = (LAS float*)(lds + SsdLds::DT); LAS float* Gv = (LAS float*)(lds + SsdLds::GV);
    const bf16_t* proj = (const bf16_t*)(p.ws + WS_PROJ); bf16_t* y = (bf16_t*)(p.ws + WS_Y); const float* psm = (const float*)(p.ws + WS_PSM);
    const float* cw = p.ssd_conv_w + (size_t)layer * 4 * 768; const float* cb = p.ssd_conv_b + (size_t)layer * 768;
    constexpr float L2E = 1.4426950408889634f;
    const int hh = wid >> 2, ws = wid & 3;
    f32x4 S[8];
#pragma unroll
    for (int m = 0; m < 8; ++m) S[m] = (f32x4){0.f, 0.f, 0.f, 0.f};
    __syncthreads();
    for (int c = 0; c < NCHUNK; ++c) {
        const int i0 = c == 0 ? 48 : 0, t0 = 64 * c - 48, row0 = b * TP + t0;
        if (wid < 2) { const int hd = gg * 2 + wid; float dt = 0.f;
            if (lane >= i0) dt = softplus_f(psm[(size_t)(row0 + lane) * NSM + 8 + hd] + p.ssd_dt_bias[layer * 4 + hd]);
            float G = -dt * __expf(p.ssd_a_log[layer * 4 + hd]) * L2E;
#pragma unroll
            for (int o = 1; o < 64; o <<= 1) { const float t = __shfl_up(G, o); if (lane >= o) G += t; }
            DTv[wid * 64 + lane] = dt; Gv[wid * 64 + lane] = G; }
        __syncthreads();
        for (int e = tid; e < 384 * 4; e += 512) { const int ch = e % 384, tr = e / 384, part = ch >> 7, j = ch & 127, chf = part * 256 + gg * 128 + j;
            const bf16_t* col = proj + (size_t)(b * TP) * NBIG + PC_CXBC + chf;
            const float w0 = cw[chf], w1 = cw[768 + chf], w2 = cw[2 * 768 + chf], w3 = cw[3 * 768 + chf], bias = cb[chf];
            const int ts = t0 + 16 * tr;
            float p0 = ts - 3 >= 0 ? bf2f(col[(size_t)(ts - 3) * NBIG]) : 0.f, p1 = ts - 2 >= 0 ? bf2f(col[(size_t)(ts - 2) * NBIG]) : 0.f, p2 = ts - 1 >= 0 ? bf2f(col[(size_t)(ts - 1) * NBIG]) : 0.f;
            const int h2 = j >> 6, d = j & 63; const float gl = Gv[h2 * 64 + 63];
#pragma unroll 4
            for (int ii = 0; ii < 16; ++ii) { const int i = 16 * tr + ii, t = ts + ii; const float cur = t >= 0 ? bf2f(col[(size_t)t * NBIG]) : 0.f;
                float a = silu_f(bias + w0 * p0 + w1 * p1 + w2 * p2 + w3 * cur); if (i < i0) a = 0.f;
                p0 = p1; p1 = p2; p2 = cur;
                if (part == 0) { const float xd = a * DTv[h2 * 64 + i]; Xs[i * LDP2 + j] = f2bf(a); VT[(h2 * 64 + d) * LDP + i] = f2bf(xd); VH[(h2 * 64 + d) * LDP + i] = f2bf(xd * fexp2(gl - Gv[h2 * 64 + i])); }
                else if (part == 1) { const bf16_t v = f2bf(a); Bs[i * LDP2 + j] = v; BT[j * LDP + i] = v; }
                else Cs[i * LDP2 + j] = f2bf(a); } }
        __syncthreads();
#pragma unroll
        for (int tt = 0; tt < 2; ++tt) { const int t = wid * 2 + tt, I = t >> 2, J = t & 3; f32x4 acc = (f32x4){0.f, 0.f, 0.f, 0.f};
            if (J <= I) {
#pragma unroll
                for (int s = 0; s < 4; ++s) acc = mfma16(frag_ld(Bs, LDP2, 16 * J + fc, 32 * s + 8 * fq), frag_ld(Cs, LDP2, 16 * I + fc, 32 * s + 8 * fq), acc); }
            const int i = 16 * I + fc;
#pragma unroll
            for (int h2 = 0; h2 < 2; ++h2) { f32x4 pv; const float gi = Gv[h2 * 64 + i];
#pragma unroll
                for (int r = 0; r < 4; ++r) { const int j = 16 * J + 4 * fq + r; pv[r] = (j <= i && j >= i0) ? acc[r] * fexp2(gi - Gv[h2 * 64 + j]) : 0.f; }
                st_bf4(Ps + (h2 * 64 + i) * LDP + 16 * J + 4 * fq, pv); } }
        __syncthreads();
        {
            bf16x8 bv[2], bh[2], Sb[4];
#pragma unroll
            for (int s = 0; s < 2; ++s) { bv[s] = frag_ld(VT, LDP, hh * 64 + 16 * ws + fc, 32 * s + 8 * fq); bh[s] = frag_ld(VH, LDP, hh * 64 + 16 * ws + fc, 32 * s + 8 * fq); }
#pragma unroll
            for (int s = 0; s < 4; ++s) Sb[s] = pack_acc2(S[2 * s], S[2 * s + 1]);
#pragma unroll
            for (int mi = 0; mi < 4; ++mi) { f32x4 o1 = (f32x4){0.f, 0.f, 0.f, 0.f}, o2 = (f32x4){0.f, 0.f, 0.f, 0.f};
#pragma unroll
                for (int s = 0; s < 2; ++s) o1 = mfma16(frag_ld(Ps, LDP, hh * 64 + 16 * mi + fc, 32 * s + 8 * fq), bv[s], o1);
#pragma unroll
                for (int s = 0; s < 4; ++s) o2 = mfma16(frag_ld_perm(Cs, LDP2, 16 * mi + fc, 32 * s, fq), Sb[s], o2);
#pragma unroll
                for (int r = 0; r < 4; ++r) { const int i = 16 * mi + 4 * fq + r; Os[i * 132 + hh * 64 + 16 * ws + fc] = o1[r] + fexp2(Gv[hh * 64 + i]) * o2[r]; } }
            const float al = fexp2(Gv[hh * 64 + 63]);
#pragma unroll
            for (int m = 0; m < 8; ++m) { S[m] = S[m] * al;
#pragma unroll
                for (int s = 0; s < 2; ++s) S[m] = mfma16(frag_ld(BT, LDP, 16 * m + fc, 32 * s + 8 * fq), bh[s], S[m]); }
        }
        __syncthreads();
        for (int i = wid + (i0 ? 48 : 0); i < 64; i += 8) { const size_t row = (size_t)(row0 + i); float u[2]; float ss = 0.f;
#pragma unroll
            for (int r = 0; r < 2; ++r) { const int j = lane + 64 * r; const float o = Os[i * 132 + j] + p.ssd_d[layer * 4 + gg * 2 + r] * bf2f(Xs[i * LDP2 + j]);
                u[r] = o * silu_f(bf2f(proj[row * NBIG + PC_CZ + gg * 128 + j])); ss += u[r] * u[r]; }
            const float sc = rsqrtf(wave_sum(ss) * (1.0f / 128.0f) + EPSF);
#pragma unroll
            for (int r = 0; r < 2; ++r) { const int j = lane + 64 * r; y[row * DM + 512 + gg * 128 + j] = f2bf(u[r] * sc * p.ssd_norm_w[layer * 256 + gg * 128 + j]); } }
    }
    { float* so = p.out + O_SSD_P + (((size_t)layer * NB + b) * 4 + gg * 2 + hh) * 8192;
#pragma unroll
        for (int m = 0; m < 8; ++m)
#pragma unroll
            for (int r = 0; r < 4; ++r) so[(16 * m + 4 * fq + r) * 64 + 16 * ws + fc] = S[m][r]; }
    { float* co = p.out + O_SCONV_P + ((size_t)layer * NB + b) * 3 * 768;
        for (int e = tid; e < 3 * 384; e += 512) { const int r = e / 384, ch = e % 384, chf = (ch >> 7) * 256 + gg * 128 + (ch & 127);
            co[r * 768 + chf] = bf2f(proj[(size_t)(b * TP + TP - 3 + r) * NBIG + PC_CXBC + chf]); } }
}

struct HgLds { static constexpr int LS = 0  , KR = LS + 16384  , QR = KR + 16384  , QT = QR + 16384, QH = QT + 64 * LDP * 2, KT = QH + 64 * LDP * 2  ,
    KHT = KT + 160 * LDP * 2, VT = KHT + 64 * LDP * 2, PS = VT + 64 * LDP * 2, OS = PS + 64 * LDP * 2, AV = OS + 64 * OSP * 4, END = AV + 256; };
__device__ void hgrn_prompt_item(const Params& p, int layer, int b, int hu, LAS unsigned char* lds) {
    const int tid = opaque_tid(), wid = tid >> 6, lane = tid & 63, fq = lane >> 4, fc = lane & 15;
    LAS float* Ls = (LAS float*)(lds + HgLds::LS); LAS float* Kr = (LAS float*)(lds + HgLds::KR); LAS float* Qr = (LAS float*)(lds + HgLds::QR);
    LAS bf16_t* Qt = (LAS bf16_t*)(lds + HgLds::QT); LAS bf16_t* Qh = (LAS bf16_t*)(lds + HgLds::QH); LAS bf16_t* Kt = (LAS bf16_t*)(lds + HgLds::KT); LAS bf16_t* KhT = (LAS bf16_t*)(lds + HgLds::KHT);
    LAS bf16_t* VT = (LAS bf16_t*)(lds + HgLds::VT); LAS bf16_t* Ps = (LAS bf16_t*)(lds + HgLds::PS); LAS float* Os = (LAS float*)(lds + HgLds::OS); LAS float* Av = (LAS float*)(lds + HgLds::AV);
    const bf16_t* proj = (const bf16_t*)(p.ws + WS_PROJ); bf16_t* y = (bf16_t*)(p.ws + WS_Y);
    const float lbv = ((const float*)(p.ws + WS_LB))[layer * 256 + hu * 64 + lane];
    f32x4 S[4];
#pragma unroll
    for (int m = 0; m < 4; ++m) S[m] = (f32x4){0.f, 0.f, 0.f, 0.f};
    __syncthreads();
    for (int c = 0; c < NCHUNK; ++c) {
        const int i0 = c == 0 ? 48 : 0, t0 = 64 * c - 48, row0 = b * TP + t0;
        if (wid < 4) { float acc = 0.f;
            for (int ii = 0; ii < 16; ++ii) { const int i = 16 * wid + ii; float kk = 0.f;
                if (i >= i0) { float af = bf2f(proj[(size_t)(row0 + i) * NBIG + PC_AF + hu * 64 + lane]); af = fminf(fmaxf(af, -30.f), 30.f);
                    const float e = __expf(-af), sg = 1.0f / (1.0f + e); const float f = lbv + (1.0f - lbv) * sg; kk = (1.0f - lbv) * e * sg; acc += __log2f(fmaxf(f, 1e-30f)); }
                Ls[i * 64 + lane] = acc; Kr[i * 64 + lane] = kk; } }
        else { for (int e = tid - 256; e < 64 * 64; e += 256) { const int i = e >> 6, d = e & 63; float q = 0.f, v = 0.f;
                if (i >= i0) { const bf16_t* pr = proj + (size_t)(row0 + i) * NBIG; q = silu_f(bf2f(pr[PC_AQ + hu * 64 + d])) * 0.125f; v = bf2f(pr[PC_AI + hu * 64 + d]); }
                Qr[i * 64 + d] = q; VT[d * LDP + i] = f2bf(v); } }
        __syncthreads();
        for (int e = tid; e < 64 * 64; e += 512) { const int i = e >> 6, d = e & 63, I = i >> 4;
            const float T0 = Ls[15 * 64 + d], T1 = Ls[31 * 64 + d], T2 = Ls[47 * 64 + d], T3 = Ls[63 * 64 + d];
            const float Bi = I == 0 ? 0.f : I == 1 ? T0 : I == 2 ? T0 + T1 : T0 + T1 + T2; const float Li = Ls[i * 64 + d], Gi = Bi + Li, Gl = T0 + T1 + T2 + T3;
            const float q = Qr[i * 64 + d], k = Kr[i * 64 + d];
            Qt[i * LDP + d] = f2bf(q * fexp2(Li)); Qh[i * LDP + d] = f2bf(q * fexp2(Gi)); KhT[d * LDP + i] = f2bf(k * fexp2(Gl - Gi));
            float Bp = Bi;
            Kt[((I == 0 ? 0 : I == 1 ? 16 : I == 2 ? 48 : 96) + i) * LDP + d] = f2bf(k * fexp2(Bp - Gi));
            if (I <= 0) { Bp = T0; Kt[(16 + i) * LDP + d] = f2bf(k * fexp2(Bp - Gi)); }
            if (I <= 1) { Bp = T0 + T1; Kt[(48 + i) * LDP + d] = f2bf(k * fexp2(Bp - Gi)); }
            if (I <= 2) { Bp = T0 + T1 + T2; Kt[(96 + i) * LDP + d] = f2bf(k * fexp2(Bp - Gi)); }
            if (i == 0) Av[d] = fexp2(Gl); }
        __syncthreads();
#pragma unroll
        for (int tt = 0; tt < 2; ++tt) { const int t = wid * 2 + tt, I = t >> 2, J = t & 3; f32x4 acc = (f32x4){0.f, 0.f, 0.f, 0.f};
            if (J <= I) { const int kb = (I == 0 ? 0 : I == 1 ? 16 : I == 2 ? 48 : 96) + 16 * J;
#pragma unroll
                for (int s = 0; s < 2; ++s) acc = mfma16(frag_ld(Kt, LDP, kb + fc, 32 * s + 8 * fq), frag_ld(Qt, LDP, 16 * I + fc, 32 * s + 8 * fq), acc); }
            const int i = 16 * I + fc;
#pragma unroll
            for (int r = 0; r < 4; ++r) { const int j = 16 * J + 4 * fq + r; acc[r] = (j <= i) ? acc[r] : 0.f; }
            st_bf4(Ps + i * LDP + 16 * J + 4 * fq, acc); }
        __syncthreads();
        if (wid < 4) {
            bf16x8 bv[2], Sb[2];
#pragma unroll
            for (int s = 0; s < 2; ++s) { bv[s] = frag_ld(VT, LDP, 16 * wid + fc, 32 * s + 8 * fq); Sb[s] = pack_acc2(S[2 * s], S[2 * s + 1]); }
#pragma unroll
            for (int mi = 0; mi < 4; ++mi) { f32x4 o = (f32x4){0.f, 0.f, 0.f, 0.f};
#pragma unroll
                for (int s = 0; s < 2; ++s) { o = mfma16(frag_ld(Ps, LDP, 16 * mi + fc, 32 * s + 8 * fq), bv[s], o); o = mfma16(frag_ld_perm(Qh, LDP, 16 * mi + fc, 32 * s, fq), Sb[s], o); }
#pragma unroll
                for (int r = 0; r < 4; ++r) Os[(16 * mi + 4 * fq + r) * OSP + 16 * wid + fc] = o[r]; }
#pragma unroll
            for (int m = 0; m < 4; ++m) {
#pragma unroll
                for (int r = 0; r < 4; ++r) S[m][r] *= Av[16 * m + 4 * fq + r];
#pragma unroll
                for (int s = 0; s < 2; ++s) S[m] = mfma16(frag_ld(KhT, LDP, 16 * m + fc, 32 * s + 8 * fq), bv[s], S[m]); }
        }
        __syncthreads();
        for (int i = wid + (i0 ? 48 : 0); i < 64; i += 8) { const size_t row = (size_t)(row0 + i); const float o = Os[i * OSP + lane]; const float ms = wave_sum(o * o) * (1.0f / 64.0f); const int cc = hu * 64 + lane;
            y[row * DM + cc] = f2bf(o * rsqrtf(ms + EPSF) * p.hgrn_norm_w[layer * 256 + cc] * silu_f(bf2f(proj[row * NBIG + PC_AZ + cc]))); }
    }
    if (wid < 4) { float* so = p.out + O_HGRN_P + (((size_t)layer * NB + b) * 4 + hu) * 4096;
#pragma unroll
        for (int m = 0; m < 4; ++m)
#pragma unroll
            for (int r = 0; r < 4; ++r) so[(16 * m + 4 * fq + r) * 64 + 16 * wid + fc] = S[m][r]; }
}

constexpr size_t GD_U = 0, GD_W = 16384, GD_Q = 24576, GD_P = 32768, GD_K = 40960, GD_VEC = 49152, GD_UNIT = 49920;
static_assert((size_t)NB * NCHUNK * 4 * GD_UNIT <= (size_t)NB * SEQ * DM * 4, "GDN scratch lives in the y_prompt region of d_out until the final phase");
struct GdLds { static constexpr int QF = 0, KF = 16384, VF = 32768, QN = 49152, KN = QN + 64 * LDP * 2, KNT = KN + 64 * LDP * 2, NM = KNT + 64 * LDP * 2, QK = NM + 64 * LDP * 2, WT = QK + 64 * LDP * 2,
    MD = WT + 64 * LDP * 2  , TD = MD + 4096  , GV = TD + 2048, BV = GV + 256, END = BV + 256; };

__device__ void gdn_pre_unit(const Params& p, int layer, int b, int c, int hu, LAS unsigned char* lds) {
    const int tid = opaque_tid(), wid = tid >> 6, lane = tid & 63, fq = lane >> 4, fc = lane & 15;
    LAS float* Qf = (LAS float*)(lds + GdLds::QF); LAS float* Kf = (LAS float*)(lds + GdLds::KF); LAS float* Vf = (LAS float*)(lds + GdLds::VF);
    LAS bf16_t* Qn = (LAS bf16_t*)(lds + GdLds::QN); LAS bf16_t* Kn = (LAS bf16_t*)(lds + GdLds::KN); LAS bf16_t* KnT = (LAS bf16_t*)(lds + GdLds::KNT);
    LAS bf16_t* NM = (LAS bf16_t*)(lds + GdLds::NM); LAS bf16_t* QK = (LAS bf16_t*)(lds + GdLds::QK); LAS bf16_t* Wt = (LAS bf16_t*)(lds + GdLds::WT);
    LAS float* MD = (LAS float*)(lds + GdLds::MD); LAS bf16_t* TD = (LAS bf16_t*)(lds + GdLds::TD); LAS float* Gv = (LAS float*)(lds + GdLds::GV); LAS float* Bv = (LAS float*)(lds + GdLds::BV);
    const bf16_t* proj = (const bf16_t*)(p.ws + WS_PROJ); const float* psm = (const float*)(p.ws + WS_PSM);
    const float* cw = p.gdn_conv_w + (size_t)layer * 4 * 768;
    unsigned char* gd = (unsigned char*)(p.out + O_YP) + (size_t)((b * NCHUNK + c) * 4 + hu) * GD_UNIT;
    constexpr float L2E = 1.4426950408889634f;
    const int i0 = c == 0 ? 48 : 0, t0 = 64 * c - 48, row0 = b * TP + t0;
    __syncthreads();
    if (wid == 0) { float g = 0.f, be = 0.f;
        if (lane >= i0) { const float* ps = psm + (size_t)(row0 + lane) * NSM; g = -__expf(p.gdn_a_log[layer * 4 + hu]) * softplus_f(ps[hu] + p.gdn_dt_bias[layer * 4 + hu]) * L2E; be = sigmoid_f(ps[4 + hu]); }
#pragma unroll
        for (int o = 1; o < 64; o <<= 1) { const float t = __shfl_up(g, o); if (lane >= o) g += t; }
        Gv[lane] = g; Bv[lane] = be; }
    for (int e = tid; e < 192 * 8; e += 512) { const int ch = e % 192, tr = e / 192, part = ch >> 6, d = ch & 63, chf = part * 256 + hu * 64 + d;
        const bf16_t* col = proj + (size_t)(b * TP) * NBIG + PC_BQKV + chf;
        const float w0 = cw[chf], w1 = cw[768 + chf], w2 = cw[2 * 768 + chf], w3 = cw[3 * 768 + chf];
        const int ts = t0 + 8 * tr;
        float p0 = ts - 3 >= 0 ? bf2f(col[(size_t)(ts - 3) * NBIG]) : 0.f, p1 = ts - 2 >= 0 ? bf2f(col[(size_t)(ts - 2) * NBIG]) : 0.f, p2 = ts - 1 >= 0 ? bf2f(col[(size_t)(ts - 1) * NBIG]) : 0.f;
        LAS float* dst = part == 0 ? Qf : part == 1 ? Kf : Vf;
#pragma unroll
        for (int ii = 0; ii < 8; ++ii) { const int i = 8 * tr + ii, t = ts + ii; const float cur = t >= 0 ? bf2f(col[(size_t)t * NBIG]) : 0.f;
            float a = silu_f(w0 * p0 + w1 * p1 + w2 * p2 + w3 * cur); if (i < i0) a = 0.f;
            p0 = p1; p1 = p2; p2 = cur; dst[i * 64 + d] = a; } }
    __syncthreads();
    for (int ii = 0; ii < 8; ++ii) { const int i = wid * 8 + ii; const float q = Qf[i * 64 + lane], k = Kf[i * 64 + lane];
        const float sq = rsqrtf(wave_sum(q * q) + EPSF) * 0.125f, sk = rsqrtf(wave_sum(k * k) + EPSF); const float kn = k * sk;
        Qn[i * LDP + lane] = f2bf(q * sq); const bf16_t kb = f2bf(kn); Kn[i * LDP + lane] = kb; KnT[lane * LDP + i] = kb; Kf[i * 64 + lane] = kn; }
    __syncthreads();
#pragma unroll
    for (int tt = 0; tt < 2; ++tt) { const int t = wid * 2 + tt, I = t >> 2, J = t & 3; f32x4 a1 = (f32x4){0.f, 0.f, 0.f, 0.f}, a2 = (f32x4){0.f, 0.f, 0.f, 0.f};
        if (J <= I) {
#pragma unroll
            for (int s = 0; s < 2; ++s) { const bf16x8 kj = frag_ld(Kn, LDP, 16 * J + fc, 32 * s + 8 * fq); a1 = mfma16(kj, frag_ld(Kn, LDP, 16 * I + fc, 32 * s + 8 * fq), a1); a2 = mfma16(kj, frag_ld(Qn, LDP, 16 * I + fc, 32 * s + 8 * fq), a2); } }
        const int i = 16 * I + fc; const float gi = Gv[i], bi = Bv[i]; f32x4 nm, qk;
#pragma unroll
        for (int r = 0; r < 4; ++r) { const int j = 16 * J + 4 * fq + r; const float dec = j <= i ? fexp2(gi - Gv[j]) : 0.f; const float mm = j < i ? a1[r] * dec * bi : 0.f; nm[r] = -mm; qk[r] = a2[r] * dec;
            if (J == I) MD[(I * 16 + fc) * 16 + 4 * fq + r] = mm; }
        st_bf4(NM + i * LDP + 16 * J + 4 * fq, nm); st_bf4(QK + i * LDP + 16 * J + 4 * fq, qk); }
    __syncthreads();
    if (wid == 0) { const int I = fq, cc = fc; float x[16];
#pragma unroll
        for (int i = 0; i < 16; ++i) { float acc = (i == cc) ? 1.0f : 0.0f;
#pragma unroll
            for (int j = 0; j < i; ++j) acc -= MD[(I * 16 + i) * 16 + j] * x[j];
            x[i] = acc; TD[(I * 16 + i) * 16 + cc] = f2bf(acc); } }
    __syncthreads();
    const int isW = wid >> 2, ws = wid & 3, colx = 16 * ws + fc;
    f32x4 X[4];
    const f32x4 zero4 = (f32x4){0.f, 0.f, 0.f, 0.f};
#pragma unroll
    for (int I = 0; I < 4; ++I) { f32x4 acc;
#pragma unroll
        for (int r = 0; r < 4; ++r) { const int j = 16 * I + 4 * fq + r; acc[r] = isW ? Bv[j] * fexp2(Gv[j]) * Kf[j * 64 + colx] : Bv[j] * Vf[j * 64 + colx]; }
        if (I >= 1) acc = mfma16(frag_ld_perm(NM, LDP, 16 * I + fc, 0, fq), pack_acc2(X[0], I > 1 ? X[1] : zero4), acc);
        if (I == 3) acc = mfma16(frag_ld_perm(NM, LDP, 48 + fc, 32, fq), pack_acc2(X[2], zero4), acc);
        const bf16x4 tlo = *(const LAS bf16x4*)(TD + (I * 16 + fc) * 16 + 4 * fq); const bf16x4 z4 = (bf16x4){0, 0, 0, 0};
        X[I] = mfma16(__builtin_shufflevector(tlo, z4, 0, 1, 2, 3, 4, 5, 6, 7), pack_acc2(acc, zero4), zero4); }
    if (!isW) {
#pragma unroll
        for (int m = 0; m < 4; ++m) *(f32x4*)(gd + GD_U + ((size_t)(ws * 4 + m) * 64 + lane) * 16) = X[m]; }
    else {
#pragma unroll
        for (int m = 0; m < 4; ++m)
#pragma unroll
            for (int r = 0; r < 4; ++r) Wt[(16 * m + 4 * fq + r) * LDP + colx] = f2bf(-X[m][r]); }
    __syncthreads();
    { const int tsel = wid >> 1; const LAS bf16_t* tile = tsel == 0 ? Wt : tsel == 1 ? Qn : tsel == 2 ? QK : KnT; unsigned char* dst = gd + (tsel == 0 ? GD_W : tsel == 1 ? GD_Q : tsel == 2 ? GD_P : GD_K);
#pragma unroll
        for (int x = 0; x < 4; ++x) { const int sl = (wid & 1) * 4 + x, m = sl >> 1, s = sl & 1; *(bf16x8*)(dst + ((size_t)sl * 64 + lane) * 16) = frag_ld_perm(tile, LDP, 16 * m + fc, 32 * s, fq); } }
    if (tid < 64) { float* gv = (float*)(gd + GD_VEC); gv[tid] = fexp2(Gv[tid]); gv[64 + tid] = fexp2(Gv[63] - Gv[tid]); if (tid == 0) gv[128] = fexp2(Gv[63]); }
}

__device__ void ph_gdn_pre(const Params& p, int layer, LAS unsigned char* lds, int blk, int nblk) {
    for (int u = blk; u < NB * NCHUNK * 4; u += nblk) gdn_pre_unit(p, layer, u / (NCHUNK * 4), (u / 4) % NCHUNK, u & 3, lds);
}

__device__ void gdn_prompt_pair(const Params& p, int layer, int b, int hp, LAS unsigned char* lds) {
    const int tid = opaque_tid(), wid = tid >> 6, lane = tid & 63, fq = lane >> 4, fc = lane & 15;
    const int hsel = wid >> 2, hd = hp * 2 + hsel, ws = wid & 3;
    LAS float* Os = (LAS float*)lds;
    const bf16_t* proj = (const bf16_t*)(p.ws + WS_PROJ); bf16_t* y = (bf16_t*)(p.ws + WS_Y);
    f32x4 S[4];
#pragma unroll
    for (int m = 0; m < 4; ++m) S[m] = (f32x4){0.f, 0.f, 0.f, 0.f};
    const f32x4 zero4 = (f32x4){0.f, 0.f, 0.f, 0.f};
    __syncthreads();
    for (int c = 0; c < NCHUNK; ++c) {
        const int i0 = c == 0 ? 48 : 0, row0 = b * TP + 64 * c - 48;
        const unsigned char* gd = (const unsigned char*)(p.out + O_YP) + (size_t)((b * NCHUNK + c) * 4 + hd) * GD_UNIT;
        const float* gv = (const float*)(gd + GD_VEC);
        LAS float* Ob = Os + ((c & 1) * 2 + hsel) * 64 * OSP;
        bf16x8 Sb[2], ub[2], uh[2]; f32x4 u[4];
#pragma unroll
        for (int s = 0; s < 2; ++s) Sb[s] = pack_acc2(S[2 * s], S[2 * s + 1]);
#pragma unroll
        for (int m = 0; m < 4; ++m) { u[m] = *(const f32x4*)(gd + GD_U + ((size_t)(ws * 4 + m) * 64 + lane) * 16);
#pragma unroll
            for (int s = 0; s < 2; ++s) u[m] = mfma16(*(const bf16x8*)(gd + GD_W + ((size_t)(m * 2 + s) * 64 + lane) * 16), Sb[s], u[m]); }
#pragma unroll
        for (int s = 0; s < 2; ++s) { ub[s] = pack_acc2(u[2 * s], u[2 * s + 1]); f32x4 a = u[2 * s], bb = u[2 * s + 1];
#pragma unroll
            for (int r = 0; r < 4; ++r) { a[r] *= gv[64 + 16 * (2 * s) + 4 * fq + r]; bb[r] *= gv[64 + 16 * (2 * s + 1) + 4 * fq + r]; }
            uh[s] = pack_acc2(a, bb); }
#pragma unroll
        for (int mi = 0; mi < 4; ++mi) { f32x4 o1 = zero4, o2 = zero4;
#pragma unroll
            for (int s = 0; s < 2; ++s) { o1 = mfma16(*(const bf16x8*)(gd + GD_P + ((size_t)(mi * 2 + s) * 64 + lane) * 16), ub[s], o1); o2 = mfma16(*(const bf16x8*)(gd + GD_Q + ((size_t)(mi * 2 + s) * 64 + lane) * 16), Sb[s], o2); }
#pragma unroll
            for (int r = 0; r < 4; ++r) { const int i = 16 * mi + 4 * fq + r; Ob[i * OSP + 16 * ws + fc] = o1[r] + gv[i] * o2[r]; } }
        const float al = gv[128];
#pragma unroll
        for (int m = 0; m < 4; ++m) { S[m] = S[m] * al;
#pragma unroll
            for (int s = 0; s < 2; ++s) S[m] = mfma16(*(const bf16x8*)(gd + GD_K + ((size_t)(m * 2 + s) * 64 + lane) * 16), uh[s], S[m]); }
        __syncthreads();
        for (int i = ws * 16; i < ws * 16 + 16; ++i) { if (i < i0) continue; const size_t row = (size_t)(row0 + i); const float o = Ob[i * OSP + lane]; const float ms = wave_sum(o * o) * (1.0f / 64.0f); const int cc = hd * 64 + lane;
            y[row * DM + 256 + cc] = f2bf(o * rsqrtf(ms + EPSF) * p.gdn_norm_w[layer * 256 + cc] * silu_f(bf2f(proj[row * NBIG + PC_BZ + cc]))); }
    }
    { float* so = p.out + O_GDN_P + (((size_t)layer * NB + b) * 4 + hd) * 4096;
#pragma unroll
        for (int m = 0; m < 4; ++m)
#pragma unroll
            for (int r = 0; r < 4; ++r) so[(16 * m + 4 * fq + r) * 64 + 16 * ws + fc] = S[m][r]; }
    { float* co = p.out + O_GCONV_P + ((size_t)layer * NB + b) * 3 * 768;
        for (int e = tid; e < 3 * 384; e += 512) { const int r = e / 384, ch = e % 384, chf = (ch / 128) * 256 + hp * 128 + (ch & 127);
            co[r * 768 + chf] = bf2f(proj[(size_t)(b * TP + TP - 3 + r) * NBIG + PC_BQKV + chf]); } }
}

constexpr int N_SEQ = NB + DECB, N_MU = 14, N_ITEMS = N_SEQ * N_MU;
__device__ void ph_mixer(const Params& p, int layer, LAS unsigned char* lds, int blk, int nblk) {
    LAS float* L = (LAS float*)lds;
    for (int it = blk; it < N_ITEMS; it += nblk) {
        const int s = it / N_MU, mu = it % N_MU;
        if (mu < 4) { if (s < NB) hgrn_prompt_item(p, layer, s, mu, lds); else mixer_item<0>(p, layer, s, mu, L); }
        else if (mu < 8) { if (s < NB) { if (mu < 6) gdn_prompt_pair(p, layer, s, mu - 4, lds); } else mixer_item<1>(p, layer, s, mu - 4, L); }
        else if (mu < 10) { if (s < NB) ssd_prompt_item(p, layer, s, mu - 8, lds); else mixer_item<2>(p, layer, s, mu - 8, L); }
        else if (s < NB) ret_prompt_item(p, layer, s, mu - 10, lds);
        else mixer_item<3>(p, layer, s, mu - 10, L);
    }
}

__device__ void ph_final(const Params& p, int blk, int nblk) {
    const int tid = opaque_tid(), wid = tid >> 6, lane = tid & 63;
    const float* h = (const float*)(p.ws + WS_H);
    for (int row = blk * 8 + wid; row < MROWS; row += nblk * 8) {
        float* dst;
        if (row < MP) { const int b = row / TP, t = row % TP; if (t < NMETA) continue; dst = p.out + O_YP + ((size_t)b * SEQ + (t - NMETA)) * DM; } else dst = p.out + O_YS + (size_t)(row - MP) * DM;
        f32x4 v[4]; float ss = 0.f;
#pragma unroll
        for (int j = 0; j < 4; ++j) { v[j] = *(const f32x4*)(h + (size_t)row * DM + j * 256 + lane * 4); ss += v[j][0] * v[j][0] + v[j][1] * v[j][1] + v[j][2] * v[j][2] + v[j][3] * v[j][3]; }
        const float r = rsqrtf(wave_sum(ss) * (1.0f / DM) + EPSF);
#pragma unroll
        for (int j = 0; j < 4; ++j) { const f32x4 w = *(const f32x4*)(p.final_norm_w + j * 256 + lane * 4); *(f32x4*)(dst + j * 256 + lane * 4) = v[j] * r * w; }
    }
}

constexpr int LDS_STAGE = 160 * 1024 - 256;
constexpr int LDS_BYTES = LDS_STAGE + 16;
static_assert(MixLds::END * 4 <= LDS_STAGE && RetLds::END <= LDS_STAGE && SsdLds::END <= LDS_STAGE && HgLds::END <= LDS_STAGE && GdLds::END <= LDS_STAGE && pg8::STAGE_BYTES <= LDS_STAGE, "LDS carve");

__global__ void __launch_bounds__(512, 2) k_mega(Params p) {
    extern __shared__ __attribute__((aligned(16))) unsigned char smem[];
    LAS unsigned char* lds = (LAS unsigned char*)smem;
    const int blk = blockIdx.x, nblk = gridDim.x;
    volatile LAS unsigned* xbw = (volatile LAS unsigned*)(lds + LDS_STAGE);
    if (threadIdx.x < 4) xbw[threadIdx.x] = 0u;
    __syncthreads();
    XcdBarrier xb = xcd_barrier_post((unsigned*)(p.ws + WS_BAR), xbw);
    ph_prep(p, lds, blk, nblk);
    cooperative_groups::this_grid().sync();
    xcd_barrier(xb);
#pragma unroll 1
    for (int l = 0; l < DEPTH; ++l) {
        ph_rownorm(p, l, blk, nblk);
        xcd_barrier(xb);
        ph_gemm_in(p, l, lds, blk, nblk);
        xcd_barrier(xb);
        ph_gdn_pre(p, l, lds, blk, nblk);
        xcd_barrier(xb);
        ph_mixer(p, l, lds, blk, nblk);
        xcd_barrier(xb);
        ph_gemm_out(p, l, lds, blk, nblk);
        xcd_barrier(xb);
    }
    ph_final(p, blk, nblk);
}

extern "C" void kernel_launch(void* const* d_in, const int* in_sizes, int n_in, void* d_out, int out_size, void* d_ws, size_t ws_size, hipStream_t stream) {
    static int grid = 0;
    if (grid == 0) {
        if (n_in != 27 || (size_t)out_size != O_END || ws_size < WS_END) { fprintf(stderr, "kernel_launch: unexpected shapes: n_in %d out %d (want %zu) ws %zu (want %zu)\n", n_in, out_size, (size_t)O_END, ws_size, (size_t)WS_END); grid = -1; return; }
        if (hipFuncSetAttribute((const void*)k_mega, hipFuncAttributeMaxDynamicSharedMemorySize, LDS_BYTES) != hipSuccess) { fprintf(stderr, "kernel_launch: hipFuncSetAttribute failed\n"); grid = -1; return; }
        int dev = 0, cus = 0, per_cu = 0;
        if (hipGetDevice(&dev) != hipSuccess || hipDeviceGetAttribute(&cus, hipDeviceAttributeMultiprocessorCount, dev) != hipSuccess) { fprintf(stderr, "kernel_launch: device query failed\n"); grid = -1; return; }
        if (hipOccupancyMaxActiveBlocksPerMultiprocessor(&per_cu, (const void*)k_mega, 512, LDS_BYTES) != hipSuccess || per_cu < 1) { fprintf(stderr, "kernel_launch: occupancy query says %d blocks per CU\n", per_cu); grid = -1; return; }
        grid = cus;
    }
    if (grid < 0) return;
    Params p{};
    const float** pp = (const float**)&p;
    for (int i = 0; i < 27; ++i) pp[i] = (const float*)d_in[i];
    p.out = (float*)d_out; p.ws = (unsigned char*)d_ws;
    (void)hipMemsetAsync((unsigned char*)d_ws + WS_BAR, 0, 16384, stream);
    void* args[] = {&p};
    const hipError_t e = hipLaunchCooperativeKernel((const void*)k_mega, dim3(grid), dim3(512), args, LDS_BYTES, stream);
    if (e != hipSuccess) fprintf(stderr, "kernel_launch: cooperative launch failed: %s (grid %d)\n", hipGetErrorString(e), grid);
}
```

```cpp
#include <hip/hip_runtime.h>
#include <hip/hip_cooperative_groups.h>
#include <cstdio>
#include <cstdint>

#define LAS __attribute__((address_space(3)))
typedef unsigned short bf16_t;
typedef short bf16x8 __attribute__((ext_vector_type(8)));
typedef float f32x4 __attribute__((ext_vector_type(4)));
typedef unsigned u32x4 __attribute__((ext_vector_type(4)));
typedef unsigned u32x2 __attribute__((ext_vector_type(2)));

constexpr int DM = 1024, NB = 8, SEQ = 2048, DEPTH = 4, DECB = 128, NMETA = 16, TP = SEQ + NMETA;
constexpr int MP = NB * TP;
constexpr int MROWS = MP + DECB;
constexpr int IN_DIM = 4108, NBIG = 4096, NSM = 12;
constexpr int PASTLEN = 16384;
constexpr float EPSF = 1e-6f;
constexpr int PC_AQ = 0, PC_AF = 256, PC_AI = 512, PC_AZ = 768, PC_BQKV = 1024, PC_BZ = 1792, PC_CXBC = 2048, PC_CZ = 2816, PC_DQ = 3072, PC_DK = 3328, PC_DV = 3584, PC_DZ = 3840;

constexpr size_t WS_BAR = 0;
constexpr size_t WS_WINT = 16384;
constexpr size_t WS_WOUTT = WS_WINT + (size_t)DEPTH * NBIG * DM * 2;
constexpr size_t WS_WSM = WS_WOUTT + (size_t)DEPTH * DM * DM * 2;
constexpr size_t WS_LB = WS_WSM + (size_t)DEPTH * NSM * DM * 4;
constexpr size_t WS_ROT = WS_LB + (size_t)DEPTH * 256 * 4;
constexpr size_t ROT_BYTES = ((size_t)(TP + 1) * 64 * 4 + 255) / 256 * 256;
constexpr size_t WS_H = WS_ROT + ROT_BYTES;
constexpr size_t WS_HB = WS_H + (size_t)MROWS * DM * 4;
constexpr size_t WS_RS = WS_HB + (size_t)MROWS * DM * 2;
constexpr size_t WS_PSM = WS_RS + (size_t)MROWS * 4;
constexpr size_t WS_PROJ = WS_PSM + (size_t)MROWS * NSM * 4;
constexpr size_t WS_Y = WS_PROJ + (size_t)MROWS * NBIG * 2;
constexpr size_t WS_END = WS_Y + (size_t)MROWS * DM * 2;

constexpr size_t O_YP = 0;
constexpr size_t O_YS = O_YP + (size_t)NB * SEQ * DM;
constexpr size_t O_HGRN_P = O_YS + (size_t)DECB * DM;
constexpr size_t O_GDN_P = O_HGRN_P + (size_t)DEPTH * NB * 4 * 64 * 64;
constexpr size_t O_GCONV_P = O_GDN_P + (size_t)DEPTH * NB * 4 * 64 * 64;
constexpr size_t O_SSD_P = O_GCONV_P + (size_t)DEPTH * NB * 3 * 768;
constexpr size_t O_SCONV_P = O_SSD_P + (size_t)DEPTH * NB * 4 * 128 * 64;
constexpr size_t O_RET_P = O_SCONV_P + (size_t)DEPTH * NB * 3 * 768;
constexpr size_t O_HGRN_S = O_RET_P + (size_t)DEPTH * NB * 4 * 64 * 64;
constexpr size_t O_GDN_S = O_HGRN_S + (size_t)DEPTH * DECB * 4 * 64 * 64;
constexpr size_t O_GCONV_S = O_GDN_S + (size_t)DEPTH * DECB * 4 * 64 * 64;
constexpr size_t O_SSD_S = O_GCONV_S + (size_t)DEPTH * DECB * 3 * 768;
constexpr size_t O_SCONV_S = O_SSD_S + (size_t)DEPTH * DECB * 4 * 128 * 64;
constexpr size_t O_RET_S = O_SCONV_S + (size_t)DEPTH * DECB * 3 * 768;
constexpr size_t O_END = O_RET_S + (size_t)DEPTH * DECB * 4 * 64 * 64;

struct Params {
    const float* x_prompt; const float* x_sample;
    const float* st_hgrn; const float* st_gdn; const float* st_gconv; const float* st_ssd; const float* st_sconv; const float* st_ret;
    const float* meta; const float* norm_w; const float* w_in; const float* lb_logits; const float* hgrn_norm_w;
    const float* gdn_conv_w; const float* gdn_a_log; const float* gdn_dt_bias; const float* gdn_norm_w;
    const float* ssd_conv_w; const float* ssd_conv_b; const float* ssd_a_log; const float* ssd_dt_bias; const float* ssd_d; const float* ssd_norm_w;
    const float* ret_norm_w; const float* ret_norm_b; const float* w_out; const float* final_norm_w;
    float* out; unsigned char* ws;
};

__device__ __forceinline__ float bf2f(bf16_t b) { return __uint_as_float(((unsigned)b) << 16); }
__device__ __forceinline__ bf16_t f2bf(float f) { unsigned u = __float_as_uint(f); u += 0x7FFFu + ((u >> 16) & 1u); return (bf16_t)(u >> 16); }
__device__ __forceinline__ unsigned pack_bf2(float lo, float hi) { return (unsigned)f2bf(lo) | ((unsigned)f2bf(hi) << 16); }
__device__ __forceinline__ float sigmoid_f(float x) { return 1.0f / (1.0f + __expf(-x)); }
__device__ __forceinline__ float silu_f(float x) { return x / (1.0f + __expf(-x)); }
__device__ __forceinline__ float softplus_f(float x) { return x > 20.0f ? x : log1pf(__expf(x)); }
__device__ __forceinline__ int opaque_tid() { int t = threadIdx.x; asm volatile("" : "+v"(t)); return t; }
__device__ __forceinline__ float wave_sum(float v) {
#pragma unroll
    for (int o = 32; o > 0; o >>= 1) v += __shfl_xor(v, o);
    return v;
}


#define XB_TMO      128
#define XB_XCNT(j)  (256  + 64 * (j))
#define XB_XSUB(j)  (1280 + 64 * (j))
#define XB_XGEN(j)  (2304 + 64 * (j))
#define XB_TOP      3328
#define XB_TOPGEN   3392
#define XCD_BAR_WORDS 3456
#define XB_SPIN_CAP (1u << 22)
__device__ __forceinline__ unsigned xb_ld(unsigned* p)              { return __hip_atomic_load(p, __ATOMIC_RELAXED, __HIP_MEMORY_SCOPE_AGENT); }
__device__ __forceinline__ unsigned xb_add(unsigned* p, unsigned v) { return __hip_atomic_fetch_add(p, v, __ATOMIC_RELAXED, __HIP_MEMORY_SCOPE_AGENT); }
__device__ __forceinline__ unsigned xb_xcc_id() { return (unsigned)__builtin_amdgcn_s_getreg((3 << 11) | 20) & 0xFu; }
#define XB_SPIN(cond, bar) do { unsigned _sp = 0; while (cond) { __builtin_amdgcn_s_sleep(1); \
    if ((++_sp & 255u) == 0u) { if (xb_ld(&(bar)[XB_TMO])) break; if (_sp > XB_SPIN_CAP) { atomicAdd(&(bar)[XB_TMO], 1u); break; } } } } while (0)
struct XcdBarrier { unsigned* bar; unsigned x; volatile LAS unsigned* st; };
__device__ __forceinline__ XcdBarrier xcd_barrier_post(unsigned* bar, volatile LAS unsigned* st) {
    XcdBarrier b; b.bar = bar; b.x = xb_xcc_id(); b.st = st;
    if (threadIdx.x == 0) (void)xb_add(&bar[XB_XCNT(b.x)], 1u);
    return b;
}
__device__ __forceinline__ void xcd_barrier_complete(unsigned* bar, unsigned x, unsigned& nloc, unsigned& nx) {
    const unsigned G = gridDim.x * gridDim.y * gridDim.z;
    unsigned sum, cnt, mine, sp = 0u;
    for (;;) {
        sum = 0u; cnt = 0u; mine = 0u;
#pragma unroll
        for (unsigned j = 0; j < 16; ++j) { const unsigned c = xb_ld(&bar[XB_XCNT(j)]); sum += c; cnt += (c > 0u) ? 1u : 0u; mine = (j == x) ? c : mine; }
        if (sum == G) break;
        __builtin_amdgcn_s_sleep(1);
        if ((++sp & 255u) == 0u) { if (xb_ld(&bar[XB_TMO])) break; if (sp > XB_SPIN_CAP) { atomicAdd(&bar[XB_TMO], 1u); break; } }
    }
    nloc = mine > 0u ? mine : 1u; nx = cnt > 0u ? cnt : 1u;
}
__device__ __forceinline__ void xcd_barrier(const XcdBarrier& b) {
    asm volatile("s_waitcnt vmcnt(0)" ::: "memory");
    __syncthreads();
    if (threadIdx.x == 0) {
        unsigned* bar = b.bar;
        __builtin_amdgcn_s_waitcnt(0);
        unsigned nloc = b.st[0], nx = b.st[1];
        if (nloc == 0u) { xcd_barrier_complete(bar, b.x, nloc, nx); b.st[0] = nloc; b.st[1] = nx; }
        const unsigned old = xb_add(&bar[XB_XSUB(b.x)], 1u);
        const unsigned gen = old / nloc;
        if (old + 1u == (gen + 1u) * nloc) {
            __builtin_amdgcn_fence(__ATOMIC_RELEASE, "agent");
            asm volatile("s_waitcnt vmcnt(0)" ::: "memory");
            const unsigned og = xb_add(&bar[XB_TOP], 1u);
            const unsigned tg = og / nx;
            if (og + 1u == (tg + 1u) * nx) xb_add(&bar[XB_TOPGEN], 1u);
            else XB_SPIN(xb_ld(&bar[XB_TOPGEN]) == tg, bar);
            __builtin_amdgcn_fence(__ATOMIC_ACQUIRE, "agent");
            xb_add(&bar[XB_XGEN(b.x)], 1u);
            asm volatile("s_waitcnt vmcnt(0)" ::: "memory");
        } else {
            XB_SPIN(xb_ld(&bar[XB_XGEN(b.x)]) == gen, bar);
            __builtin_amdgcn_fence(__ATOMIC_ACQUIRE, "agent");
            asm volatile("s_waitcnt vmcnt(0)" ::: "memory");
        }
    }
    __syncthreads();
}

namespace pg8 {
constexpr int BM = 256, BK = 64, HALF = 128, HTB = HALF * BK * 2, STAGE_BYTES = 8 * HTB, NXCD = 8, WGM = 8;
__host__ __device__ __forceinline__ int lds_byte(int r, int c) { const int st = (r >> 4) * 2 + (c >> 5), rr = r & 15, cc = c & 31, ob = rr * 64 + cc * 2; return st * 1024 + (ob ^ (((ob >> 9) & 1) << 5)); }
__host__ __device__ __forceinline__ void stage_rc(int b, int& R, int& C) { const int st = b / 1024, sb = b % 1024, swz = sb ^ (((sb >> 9) & 1) << 5); R = (st >> 1) * 16 + swz / 64; C = (st & 1) * 32 + (swz % 64) / 2; }
__host__ __device__ __forceinline__ int perm32(int rho) { const int n = rho >> 4, i = rho & 15; return 8 * (i >> 2) + 4 * n + (i & 3); }
struct Unit { int pm, pn; };
struct Gemm { const bf16_t* A; const bf16_t* Bt; int M, N, K; };
struct StaticOrder {
    int nM, nN, nwg, G, c;
    __host__ __device__ void init(int M, int N, int G_, int c_) { nM = M / BM; nN = N / BM; nwg = nM * nN; G = G_; c = c_; }
    __host__ __device__ bool next(int i, Unit& u) const {
        const long L = (long)i * G + c; if (L >= nwg) return false;
        int wgid = (int)L; { const int q = nwg / NXCD, r = nwg % NXCD, xcd = wgid % NXCD, off = wgid / NXCD; wgid = (xcd < r ? xcd * (q + 1) : r * (q + 1) + (xcd - r) * q) + off; }
        const int nig = WGM * nN, gid = wgid / nig, fm = gid * WGM, gsz = (nM - fm) < WGM ? (nM - fm) : WGM;
        u.pm = fm + ((wgid % nig) % gsz); u.pn = (wgid % nig) / gsz; return true;
    }
    __device__ __forceinline__ void a_ready(const Unit&) const {}
    __device__ __forceinline__ void done(const Unit&) const {}
};
typedef float f32x2_t __attribute__((ext_vector_type(2)));
typedef __bf16 bf16x2n_t __attribute__((ext_vector_type(2)));
__device__ __forceinline__ unsigned cvt_pk_bf16(float lo, float hi) { const f32x2_t f = {lo, hi}; return __builtin_bit_cast(unsigned, __builtin_convertvector(f, bf16x2n_t)); }

struct EpiProj {
    static constexpr bool PERM = true, AFTER_DRAIN = false;
    bf16_t* O; int ldc; const float* rs;
    __device__ __forceinline__ void operator()(const f32x4 (&acc)[2][2][4][2], const Unit& u, int wr, int wc, int fr, int fq) const {
        const int row0 = u.pm * BM + wr * 64 + fr; const int col0 = u.pn * BM + wc * 32 + 8 * fq;
#pragma unroll
        for (int ai = 0; ai < 2; ++ai)
#pragma unroll
            for (int m = 0; m < 4; ++m) { const int row = row0 + ai * HALF + m * 16; const float s = rs[row]; bf16_t* rowp = O + (size_t)row * ldc + col0;
#pragma unroll
                for (int bj = 0; bj < 2; ++bj) { const f32x4 v0 = acc[ai][bj][m][0] * s, v1 = acc[ai][bj][m][1] * s;
                    u32x4 w; w.x = cvt_pk_bf16(v0[0], v0[1]); w.y = cvt_pk_bf16(v0[2], v0[3]); w.z = cvt_pk_bf16(v1[0], v1[1]); w.w = cvt_pk_bf16(v1[2], v1[3]);
                    *(u32x4*)(rowp + bj * HALF) = w; } }
    }
};
struct EpiResid {
    static constexpr bool PERM = false, AFTER_DRAIN = false;
    float* C; int ldc;
    __device__ __forceinline__ void operator()(const f32x4 (&acc)[2][2][4][2], const Unit& u, int wr, int wc, int fr, int fq) const {
        const int row0 = u.pm * BM + wr * 64 + fr, col0 = u.pn * BM + wc * 32 + 4 * fq;
#pragma unroll
        for (int ai = 0; ai < 2; ++ai)
#pragma unroll
            for (int m = 0; m < 4; ++m) { float* rowp = C + (size_t)(row0 + ai * HALF + m * 16) * ldc + col0;
#pragma unroll
                for (int bj = 0; bj < 2; ++bj)
#pragma unroll
                    for (int n = 0; n < 2; ++n) { f32x4* p = (f32x4*)(rowp + bj * HALF + n * 16); *p = *p + acc[ai][bj][m][n]; } }
    }
};

template <class Epi, class Sched>
__device__ __forceinline__ void gemm_phase(LAS unsigned char* lds, const Gemm g, const Sched& S, const Epi& E) {
    const int tid = opaque_tid(), wid = __builtin_amdgcn_readfirstlane(tid >> 6), lane = tid & 63, wr = wid >> 2, wc = wid & 3, fr = lane & 15, fq = lane >> 4;
    const int K = g.K, nt = K / BK;
    unsigned voffA[2], voffB[2];
#pragma unroll
    for (int i = 0; i < 2; ++i) { int R, C; stage_rc(tid * 16 + i * 8192, R, C); const int Rb = Epi::PERM ? ((R & ~31) + perm32(R & 31)) : R;
        voffA[i] = (unsigned)(R * K + C) * 2u; voffB[i] = (unsigned)(Rb * K + C) * 2u; }
    const size_t kstep = (size_t)(BK * 2);
    const size_t hstep = (size_t)HALF * K * 2;
    const size_t tstep = 2 * hstep;
    const unsigned ldsw = (unsigned)wid * 1024u;
    const int aoff = lds_byte(wr * 64 + fr, fq * 8), boff = lds_byte(wc * 32 + fr, fq * 8);
#define PG8_SA(b, h) (((b) * 2 + (h)) * HTB)
#define PG8_SB(b, h) ((4 + (b) * 2 + (h)) * HTB)
#define PG8_STAGE(bufoff, gbase, voff) do { _Pragma("unroll") for (int _i = 0; _i < 2; ++_i) \
        __builtin_amdgcn_global_load_lds((const unsigned*)((const char*)(gbase) + (voff)[_i]), (LAS unsigned*)(lds + (bufoff) + ldsw + _i * 8192), 16, 0, 0); } while (0)
#define PG8_LDA(dst, b, h) do { _Pragma("unroll") for (int m = 0; m < 4; ++m) _Pragma("unroll") for (int k = 0; k < 2; ++k) dst[m][k] = *(const LAS bf16x8*)(lds + PG8_SA(b, h) + aoff + m * 2048 + k * 1024); } while (0)
#define PG8_LDB(dst, b, h) do { _Pragma("unroll") for (int n = 0; n < 2; ++n) _Pragma("unroll") for (int k = 0; k < 2; ++k) dst[n][k] = *(const LAS bf16x8*)(lds + PG8_SB(b, h) + boff + n * 2048 + k * 1024); } while (0)
#define PG8_MMA(ai, bj, At, Bt) do { __builtin_amdgcn_s_setprio(1); _Pragma("unroll") for (int m = 0; m < 4; ++m) _Pragma("unroll") for (int n = 0; n < 2; ++n) _Pragma("unroll") for (int k = 0; k < 2; ++k) \
        acc[ai][bj][m][n] = __builtin_amdgcn_mfma_f32_16x16x32_bf16(Bt[n][k], At[m][k], acc[ai][bj][m][n], 0, 0, 0); __builtin_amdgcn_s_setprio(0); } while (0)
#define PG8_WAIT_V(n) asm volatile("s_waitcnt vmcnt(" #n ")" ::: "memory")
#define PG8_WAIT_L(n) asm volatile("s_waitcnt lgkmcnt(" #n ")" ::: "memory")
#define PG8_BAR __builtin_amdgcn_s_barrier()
#define PG8_SCHED __builtin_amdgcn_sched_barrier(0)
    Unit cur, nxt; int ui = 0;
    if (!S.next(0, cur)) return;
    f32x4 acc[2][2][4][2];
#pragma unroll
    for (int a = 0; a < 2; ++a)
#pragma unroll
        for (int b = 0; b < 2; ++b)
#pragma unroll
            for (int m = 0; m < 4; ++m)
#pragma unroll
                for (int n = 0; n < 2; ++n) acc[a][b][m][n] = (f32x4){0.f, 0.f, 0.f, 0.f};
    bf16x8 At[4][2], B0[2][2], B1[2][2];
    const char* cA = (const char*)g.A + (size_t)cur.pm * tstep; const char* cB = (const char*)g.Bt + (size_t)cur.pn * tstep;
    S.a_ready(cur);
    PG8_STAGE(PG8_SB(0, 0), cB, voffB); PG8_STAGE(PG8_SA(0, 0), cA, voffA); PG8_STAGE(PG8_SB(0, 1), cB + hstep, voffB); PG8_STAGE(PG8_SA(0, 1), cA + hstep, voffA);
    if (wr == 1) PG8_BAR;
    PG8_WAIT_V(4); PG8_BAR;
    PG8_STAGE(PG8_SB(1, 0), cB + kstep, voffB); PG8_STAGE(PG8_SA(1, 0), cA + kstep, voffA); PG8_STAGE(PG8_SB(1, 1), cB + hstep + kstep, voffB);
    PG8_WAIT_V(6); PG8_BAR;
    for (;;) {
        const bool has_next = S.next(ui + 1, nxt);
        const char* nA = has_next ? (const char*)g.A + (size_t)nxt.pm * tstep : cA; const char* nB = has_next ? (const char*)g.Bt + (size_t)nxt.pn * tstep : cB;
        for (int t = 0; t < nt; t += 2) {
            const bool last = (t == nt - 2);
            const char* a1 = cA + (size_t)(t + 1) * kstep;
            const char* a2 = last ? nA : cA + (size_t)(t + 2) * kstep; const char* b2 = last ? nB : cB + (size_t)(t + 2) * kstep;
            const char* a3 = a2 + kstep; const char* b3 = b2 + kstep;
            if (last && has_next) S.a_ready(nxt);
            PG8_LDB(B0, 0, 0); PG8_SCHED; PG8_LDA(At, 0, 0); PG8_STAGE(PG8_SA(1, 1), a1 + hstep, voffA);
            PG8_WAIT_L(8); PG8_BAR; PG8_WAIT_L(0); PG8_MMA(0, 0, At, B0); PG8_BAR; PG8_SCHED;
            PG8_LDB(B1, 0, 1); PG8_STAGE(PG8_SB(0, 0), b2, voffB);
            PG8_BAR; PG8_WAIT_L(0); PG8_MMA(0, 1, At, B1); PG8_BAR;
            PG8_LDA(At, 0, 1); PG8_STAGE(PG8_SA(0, 0), a2, voffA);
            PG8_BAR; PG8_WAIT_L(0); PG8_MMA(1, 0, At, B0); PG8_BAR; PG8_SCHED;
            PG8_STAGE(PG8_SB(0, 1), b2 + hstep, voffB);
            PG8_WAIT_V(6); PG8_BAR; PG8_MMA(1, 1, At, B1); PG8_BAR;
            PG8_LDB(B0, 1, 0); PG8_SCHED; PG8_LDA(At, 1, 0); PG8_STAGE(PG8_SA(0, 1), a2 + hstep, voffA);
            PG8_WAIT_L(8); PG8_BAR; PG8_WAIT_L(0); PG8_MMA(0, 0, At, B0); PG8_BAR; PG8_SCHED;
            PG8_LDB(B1, 1, 1); PG8_STAGE(PG8_SB(1, 0), b3, voffB);
            PG8_BAR; PG8_WAIT_L(0); PG8_MMA(0, 1, At, B1); PG8_BAR;
            PG8_LDA(At, 1, 1); PG8_STAGE(PG8_SA(1, 0), a3, voffA);
            PG8_BAR; PG8_WAIT_L(0); PG8_MMA(1, 0, At, B0); PG8_BAR; PG8_SCHED;
            PG8_STAGE(PG8_SB(1, 1), b3 + hstep, voffB);
            PG8_WAIT_V(6); PG8_BAR; PG8_MMA(1, 1, At, B1); PG8_BAR;
        }
        if constexpr (!Epi::AFTER_DRAIN) { E(acc, cur, wr, wc, fr, fq); S.done(cur); }
        if (!has_next) break;
#pragma unroll
        for (int a = 0; a < 2; ++a)
#pragma unroll
            for (int b = 0; b < 2; ++b)
#pragma unroll
                for (int m = 0; m < 4; ++m)
#pragma unroll
                    for (int n = 0; n < 2; ++n) acc[a][b][m][n] = (f32x4){0.f, 0.f, 0.f, 0.f};
        cur = nxt; cA = nA; cB = nB; ++ui;
    }
    PG8_WAIT_V(0);
    if (wr == 0) PG8_BAR;
    PG8_BAR;
#undef PG8_SA
#undef PG8_SB
#undef PG8_STAGE
#undef PG8_LDA
#undef PG8_LDB
#undef PG8_MMA
#undef PG8_WAIT_V
#undef PG8_WAIT_L
#undef PG8_BAR
#undef PG8_SCHED
}
}

__device__ __forceinline__ int win_col(int n) { return n < 2048 ? n : (n < 3072 ? n + 8 : n + 12); }
__device__ __forceinline__ int win_smcol(int j) { return j < 8 ? 2048 + j : 3080 + (j - 8); }

__device__ void ph_prep(const Params& p, LAS unsigned char* lds, int blk, int nblk) {
    const int tid = opaque_tid();
    LAS float* tile = (LAS float*)lds;
    const int tiles_in = DEPTH * 64 * 16, tiles_out = DEPTH * 16 * 16;
    for (int t = blk; t < tiles_in + tiles_out; t += nblk) {
        const float* src; bf16_t* dst; int ld, n0, k0, l; const float* scale;
        if (t < tiles_in) { l = t / 1024; const int r = t % 1024; n0 = (r / 16) * 64; k0 = (r % 16) * 64; src = p.w_in + (size_t)l * DM * IN_DIM + win_col(n0); ld = IN_DIM;
            dst = (bf16_t*)(p.ws + WS_WINT) + (size_t)l * NBIG * DM; scale = p.norm_w + l * DM; }
        else { const int tt = t - tiles_in; l = tt / 256; const int r = tt % 256; n0 = (r / 16) * 64; k0 = (r % 16) * 64; src = p.w_out + (size_t)l * DM * DM + n0; ld = DM;
            dst = (bf16_t*)(p.ws + WS_WOUTT) + (size_t)l * DM * DM; scale = nullptr; }
        __syncthreads();
        for (int e = tid; e < 64 * 64; e += 512) { const int kk = e >> 6, nn = e & 63; float v = src[(size_t)(k0 + kk) * ld + nn]; if (scale) v *= scale[k0 + kk]; tile[kk * 65 + nn] = v; }
        __syncthreads();
        for (int e = tid; e < 64 * 32; e += 512) { const int nn = e >> 5, kp = (e & 31) * 2; const unsigned w = pack_bf2(tile[kp * 65 + nn], tile[(kp + 1) * 65 + nn]);
            *(unsigned*)(dst + (size_t)(n0 + nn) * DM + k0 + kp) = w; }
    }
    for (int e = blk * 512 + tid; e < DEPTH * NSM * DM; e += nblk * 512) { const int l = e / (NSM * DM), r = e % (NSM * DM), j = r / DM, k = r % DM;
        ((float*)(p.ws + WS_WSM))[e] = p.w_in[(size_t)l * DM * IN_DIM + (size_t)k * IN_DIM + win_smcol(j)] * p.norm_w[l * DM + k]; }
    for (int c = blk * 512 + tid; c < 256; c += nblk * 512) { float lg[DEPTH], mx = -1e30f;
#pragma unroll
        for (int l = 0; l < DEPTH; ++l) { lg[l] = p.lb_logits[l * 256 + c]; mx = fmaxf(mx, lg[l]); }
        float s = 0.f;
#pragma unroll
        for (int l = 0; l < DEPTH; ++l) { lg[l] = expf(lg[l] - mx); s += lg[l]; }
        float cum = 0.f; const float w0 = lg[0] / s;
#pragma unroll
        for (int l = 0; l < DEPTH; ++l) { cum += lg[l] / s; ((float*)(p.ws + WS_LB))[l * 256 + c] = fmaxf(cum - w0, 0.f); } }
    for (int e = blk * 512 + tid; e < (TP + 1) * 32; e += nblk * 512) { const int pi = e >> 5, i = e & 31; const double pos = pi < TP ? (double)pi : (double)PASTLEN;
        const float invf = (float)(1.0 / pow(10000.0, (double)((float)i / 31.0f)));
        const double rev = pos * (double)invf * 0.15915494309189535; const float fr = (float)(rev - rint(rev));
        ((float*)(p.ws + WS_ROT))[e * 2 + 0] = __builtin_amdgcn_cosf(fr); ((float*)(p.ws + WS_ROT))[e * 2 + 1] = __builtin_amdgcn_sinf(fr); }
    float* h = (float*)(p.ws + WS_H);
    for (int e = blk * 512 + tid; e < MROWS * (DM / 4); e += nblk * 512) { const int row = e >> 8, c4 = (e & 255) * 4; const float* src;
        if (row < MP) { const int b = row / TP, t = row % TP; src = t < NMETA ? p.meta + t * DM : p.x_prompt + ((size_t)b * SEQ + (t - NMETA)) * DM; } else src = p.x_sample + (size_t)(row - MP) * DM;
        *(f32x4*)(h + (size_t)row * DM + c4) = *(const f32x4*)(src + c4); }
}

__device__ void ph_rownorm(const Params& p, int layer, int blk, int nblk) {
    const int tid = opaque_tid(), wid = tid >> 6, lane = tid & 63;
    const float* h = (const float*)(p.ws + WS_H); bf16_t* hb = (bf16_t*)(p.ws + WS_HB); float* rs = (float*)(p.ws + WS_RS); float* psm = (float*)(p.ws + WS_PSM);
    const float* wsm = (const float*)(p.ws + WS_WSM) + (size_t)layer * NSM * DM;
    for (int row = blk * 8 + wid; row < MROWS; row += nblk * 8) {
        f32x4 v[4]; float ss = 0.f;
#pragma unroll
        for (int j = 0; j < 4; ++j) { v[j] = *(const f32x4*)(h + (size_t)row * DM + j * 256 + lane * 4); ss += v[j][0] * v[j][0] + v[j][1] * v[j][1] + v[j][2] * v[j][2] + v[j][3] * v[j][3]; }
        ss = wave_sum(ss); const float r = rsqrtf(ss * (1.0f / DM) + EPSF);
#pragma unroll
        for (int j = 0; j < 4; ++j) { u32x2 w; w.x = pack_bf2(v[j][0], v[j][1]); w.y = pack_bf2(v[j][2], v[j][3]); *(u32x2*)(hb + (size_t)row * DM + j * 256 + lane * 4) = w; }
        float mine = 0.f;
        for (int q = 0; q < NSM; ++q) { float d = 0.f;
#pragma unroll
            for (int j = 0; j < 4; ++j) { const f32x4 w = *(const f32x4*)(wsm + q * DM + j * 256 + lane * 4); d += v[j][0] * w[0] + v[j][1] * w[1] + v[j][2] * w[2] + v[j][3] * w[3]; }
            d = wave_sum(d); if (lane == q) mine = d * r; }
        if (lane < NSM) psm[(size_t)row * NSM + lane] = mine;
        if (lane == 0) rs[row] = r;
    }
}

__device__ void ph_gemm_in(const Params& p, int layer, LAS unsigned char* lds, int blk, int nblk) {
    pg8::Gemm g{(const bf16_t*)(p.ws + WS_HB), (const bf16_t*)(p.ws + WS_WINT) + (size_t)layer * NBIG * DM, MROWS, NBIG, DM};
    pg8::StaticOrder S; S.init(MROWS, NBIG, nblk, blk);
    pg8::EpiProj E{(bf16_t*)(p.ws + WS_PROJ), NBIG, (const float*)(p.ws + WS_RS)};
    pg8::gemm_phase<pg8::EpiProj, pg8::StaticOrder>(lds, g, S, E);
}
__device__ void ph_gemm_out(const Params& p, int layer, LAS unsigned char* lds, int blk, int nblk) {
    pg8::Gemm g{(const bf16_t*)(p.ws + WS_Y), (const bf16_t*)(p.ws + WS_WOUTT) + (size_t)layer * DM * DM, MROWS, DM, DM};
    pg8::StaticOrder S; S.init(MROWS, DM, nblk, blk);
    pg8::EpiResid E{(float*)(p.ws + WS_H), DM};
    pg8::gemm_phase<pg8::EpiResid, pg8::StaticOrder>(lds, g, S, E);
}

constexpr int TB = 16;
struct MixLds {
    static constexpr int QS = 0, KS = QS + TB * 128, VS = KS + TB * 128, DS = VS + TB * 128, ZS = DS + TB * 128, XS = ZS + TB * 128, OS = XS + TB * 128, BS = OS + TB * 128, SC = BS + TB * 2, END = SC + TB * 2;
};

struct SeqInfo { int row0, T, dec, b; };
__device__ __forceinline__ SeqInfo seq_info(int s) { SeqInfo q; if (s < NB) { q.row0 = s * TP; q.T = TP; q.dec = 0; q.b = s; } else { q.row0 = MP + (s - NB); q.T = 1; q.dec = 1; q.b = s - NB; } return q; }

__device__ __forceinline__ float preconv(const bf16_t* proj, const SeqInfo& q, int t, int col, const float* ctx  , int ch) {
    if (t >= 0) return bf2f(proj[(size_t)(q.row0 + t) * NBIG + col]);
    return ctx ? ctx[(3 + t) * 768 + ch] : 0.f;
}

template <int DK, int NV, bool DELTA, bool VECDEC>
__device__ __forceinline__ void recur_batch(float (&S)[DK / (64 / NV)], LAS float* L, int nb, int wid, int lane) {
    constexpr int KQ = 64 / NV, KR = DK / KQ, DVT = 8 * NV;
    const int kq = lane / NV, vv = lane % NV, vcol = wid * NV + vv, hh = vcol >> 6;
    for (int t = 0; t < nb; ++t) {
        float kk[KR], qq[KR];
#pragma unroll
        for (int i = 0; i < KR; ++i) { kk[i] = L[MixLds::KS + t * 128 + kq * KR + i]; qq[i] = L[MixLds::QS + t * 128 + kq * KR + i]; }
        const float v = L[MixLds::VS + t * 128 + vcol];
        if (DELTA) {
            const float dec = L[MixLds::DS + t * 128 + hh]; float pk = 0.f;
#pragma unroll
            for (int i = 0; i < KR; ++i) { S[i] *= dec; pk += kk[i] * S[i]; }
#pragma unroll
            for (int o = NV; o < 64; o <<= 1) pk += __shfl_xor(pk, o);
            const float u = L[MixLds::BS + t] * (v - pk);
#pragma unroll
            for (int i = 0; i < KR; ++i) S[i] += kk[i] * u;
        } else if (VECDEC) {
#pragma unroll
            for (int i = 0; i < KR; ++i) S[i] = L[MixLds::DS + t * 128 + kq * KR + i] * S[i] + kk[i] * v;
        } else {
            const float dec = L[MixLds::DS + t * 128 + hh];
#pragma unroll
            for (int i = 0; i < KR; ++i) S[i] = dec * S[i] + kk[i] * v;
        }
        float po = 0.f;
#pragma unroll
        for (int i = 0; i < KR; ++i) po += qq[i] * S[i];
#pragma unroll
        for (int o = NV; o < 64; o <<= 1) po += __shfl_xor(po, o);
        if (kq == 0) L[MixLds::OS + t * 128 + vcol] = po;
    }
    (void)DVT;
}

template <int MIX>
__device__ void mixer_item(const Params& p, int layer, int s, int hu  , LAS float* L) {
    constexpr int DK = MIX == 2 ? 128 : 64, NV = MIX == 2 ? 16 : 8, KQ = 64 / NV, KR = DK / KQ, DVT = 8 * NV;
    const int tid = opaque_tid(), wid = tid >> 6, lane = tid & 63;
    const SeqInfo q = seq_info(s);
    const bf16_t* proj = (const bf16_t*)(p.ws + WS_PROJ); const float* psm = (const float*)(p.ws + WS_PSM); bf16_t* y = (bf16_t*)(p.ws + WS_Y);
    const float* lb = (const float*)(p.ws + WS_LB) + layer * 256; const float* rot = (const float*)(p.ws + WS_ROT);
    const int kq = lane / NV, vv = lane % NV, vcol = wid * NV + vv, hh = vcol >> 6;
    const int head = MIX == 2 ? hu * 2 + hh : hu;
    const float* ctx = nullptr; const float* cw = nullptr;
    if (MIX == 1) { cw = p.gdn_conv_w + (size_t)layer * 4 * 768; if (q.dec) ctx = p.st_gconv + ((size_t)layer * DECB + q.b) * 3 * 768; }
    if (MIX == 2) { cw = p.ssd_conv_w + (size_t)layer * 4 * 768; if (q.dec) ctx = p.st_sconv + ((size_t)layer * DECB + q.b) * 3 * 768; }
    float S[KR];
    {
        const float* st = MIX == 0 ? p.st_hgrn : MIX == 1 ? p.st_gdn : MIX == 2 ? p.st_ssd : p.st_ret;
#pragma unroll
        for (int i = 0; i < KR; ++i) S[i] = q.dec ? st[(((size_t)layer * DECB + q.b) * 4 + head) * DK * 64 + (size_t)(kq * KR + i) * 64 + (vcol & 63)] : 0.f;
    }
    float hc0 = 0.f, hc1 = 0.f;
    if (MIX == 1) { hc0 = -__expf(p.gdn_a_log[layer * 4 + hu]); hc1 = p.gdn_dt_bias[layer * 4 + hu]; }
    if (MIX == 3) { hc0 = 1.0f - exp2f(-5.0f - (float)hu); }

    for (int t0 = 0; t0 < q.T; t0 += TB) {
        const int nb = min(TB, q.T - t0);
        __syncthreads();
        if (MIX == 0) {
            for (int e = tid; e < nb * 64; e += 512) { const int t = e >> 6, d = e & 63, c = hu * 64 + d; const bf16_t* pr = proj + (size_t)(q.row0 + t0 + t) * NBIG;
                const float aq = bf2f(pr[PC_AQ + c]), af = bf2f(pr[PC_AF + c]), ai = bf2f(pr[PC_AI + c]), az = bf2f(pr[PC_AZ + c]), l_ = lb[c];
                L[MixLds::QS + t * 128 + d] = silu_f(aq) * 0.125f; L[MixLds::KS + t * 128 + d] = (1.0f - l_) * sigmoid_f(-af); L[MixLds::DS + t * 128 + d] = l_ + (1.0f - l_) * sigmoid_f(af);
                L[MixLds::VS + t * 128 + d] = ai; L[MixLds::ZS + t * 128 + d] = az; }
        } else if (MIX == 1) {
            for (int e = tid; e < nb * 192; e += 512) { const int t = e / 192, r = e % 192, part = r >> 6, d = r & 63, ch = part * 256 + hu * 64 + d, col = PC_BQKV + ch; const int tt = t0 + t;
                float a = 0.f;
#pragma unroll
                for (int j = 0; j < 4; ++j) a += cw[j * 768 + ch] * preconv(proj, q, tt - 3 + j, col, ctx, ch);
                a = silu_f(a);
                L[(part == 0 ? MixLds::QS : part == 1 ? MixLds::KS : MixLds::VS) + t * 128 + d] = a; }
            for (int e = tid; e < nb * 64; e += 512) { const int t = e >> 6, d = e & 63; L[MixLds::ZS + t * 128 + d] = bf2f(proj[(size_t)(q.row0 + t0 + t) * NBIG + PC_BZ + hu * 64 + d]); }
            if (tid < nb) { const float* ps = psm + (size_t)(q.row0 + t0 + tid) * NSM; const float g = hc0 * softplus_f(ps[hu] + hc1);
                L[MixLds::DS + tid * 128 + 0] = __expf(g); L[MixLds::BS + tid] = sigmoid_f(ps[4 + hu]); }
            __syncthreads();
            if (tid < nb * 2) { const int t = tid >> 1, which = tid & 1; const LAS float* src = L + (which ? MixLds::KS : MixLds::QS) + t * 128; float ss = 0.f;
                for (int d = 0; d < 64; ++d) ss += src[d] * src[d];
                L[MixLds::SC + tid] = rsqrtf(ss + EPSF) * (which ? 1.0f : 0.125f); }
            __syncthreads();
            for (int e = tid; e < nb * 128; e += 512) { const int t = e >> 7, r = e & 127, which = r >> 6, d = r & 63; L[(which ? MixLds::KS : MixLds::QS) + t * 128 + d] *= L[MixLds::SC + t * 2 + which]; }
        } else if (MIX == 2) {
            if (tid < nb * 2) { const int t = tid >> 1, h2 = tid & 1, hd = hu * 2 + h2; const float dt = softplus_f(psm[(size_t)(q.row0 + t0 + t) * NSM + 8 + hd] + p.ssd_dt_bias[layer * 4 + hd]);
                L[MixLds::BS + tid] = dt; L[MixLds::DS + t * 128 + h2] = __expf(-dt * __expf(p.ssd_a_log[layer * 4 + hd])); }
            __syncthreads();
            for (int e = tid; e < nb * 384; e += 512) { const int t = e / 384, r = e % 384, part = r >> 7, j = r & 127, ch = part * 256 + hu * 128 + j, col = PC_CXBC + ch; const int tt = t0 + t;
                float a = p.ssd_conv_b[layer * 768 + ch];
#pragma unroll
                for (int jj = 0; jj < 4; ++jj) a += cw[jj * 768 + ch] * preconv(proj, q, tt - 3 + jj, col, ctx, ch);
                a = silu_f(a);
                if (part == 0) { L[MixLds::XS + t * 128 + j] = a; L[MixLds::VS + t * 128 + j] = a * L[MixLds::BS + t * 2 + (j >> 6)]; }
                else if (part == 1) L[MixLds::KS + t * 128 + j] = a; else L[MixLds::QS + t * 128 + j] = a; }
            for (int e = tid; e < nb * 128; e += 512) { const int t = e >> 7, j = e & 127; L[MixLds::ZS + t * 128 + j] = bf2f(proj[(size_t)(q.row0 + t0 + t) * NBIG + PC_CZ + hu * 128 + j]); }
        } else {
            for (int e = tid; e < nb * 32; e += 512) { const int t = e >> 5, i = e & 31; const bf16_t* pr = proj + (size_t)(q.row0 + t0 + t) * NBIG; const int pidx = q.dec ? TP : (t0 + t);
                const float cs = rot[(pidx * 32 + i) * 2], sn = rot[(pidx * 32 + i) * 2 + 1];
                const float q1 = bf2f(pr[PC_DQ + hu * 64 + i]), q2 = bf2f(pr[PC_DQ + hu * 64 + 32 + i]), k1 = bf2f(pr[PC_DK + hu * 64 + i]), k2 = bf2f(pr[PC_DK + hu * 64 + 32 + i]);
                L[MixLds::QS + t * 128 + i] = q1 * cs - q2 * sn; L[MixLds::QS + t * 128 + 32 + i] = q2 * cs + q1 * sn;
                L[MixLds::KS + t * 128 + i] = (k1 * cs - k2 * sn) * 0.125f; L[MixLds::KS + t * 128 + 32 + i] = (k2 * cs + k1 * sn) * 0.125f; }
            for (int e = tid; e < nb * 64; e += 512) { const int t = e >> 6, d = e & 63; const bf16_t* pr = proj + (size_t)(q.row0 + t0 + t) * NBIG;
                L[MixLds::VS + t * 128 + d] = bf2f(pr[PC_DV + hu * 64 + d]); L[MixLds::ZS + t * 128 + d] = bf2f(pr[PC_DZ + hu * 64 + d]); }
            if (tid < nb) L[MixLds::DS + tid * 128] = hc0;
        }
        __syncthreads();
        recur_batch<DK, NV, MIX == 1, MIX == 0>(S, L, nb, wid, lane);
        __syncthreads();
        for (int t = wid; t < nb; t += 8) {
            const size_t yrow = (size_t)(q.row0 + t0 + t) * DM;
            if (MIX == 0 || MIX == 1) { const float o = L[MixLds::OS + t * 128 + lane]; const float ms = wave_sum(o * o) * (1.0f / 64.0f);
                const float w = (MIX == 0 ? p.hgrn_norm_w : p.gdn_norm_w)[layer * 256 + hu * 64 + lane];
                y[yrow + (MIX == 0 ? 0 : 256) + hu * 64 + lane] = f2bf(o * rsqrtf(ms + EPSF) * w * silu_f(L[MixLds::ZS + t * 128 + lane])); }
            else if (MIX == 2) { float u[2]; float ss = 0.f;
#pragma unroll
                for (int r = 0; r < 2; ++r) { const int j = lane + 64 * r; const float o = L[MixLds::OS + t * 128 + j] + p.ssd_d[layer * 4 + hu * 2 + r] * L[MixLds::XS + t * 128 + j]; u[r] = o * silu_f(L[MixLds::ZS + t * 128 + j]); ss += u[r] * u[r]; }
                const float sc = rsqrtf(wave_sum(ss) * (1.0f / 128.0f) + EPSF);
#pragma unroll
                for (int r = 0; r < 2; ++r) { const int j = lane + 64 * r; y[yrow + 512 + hu * 128 + j] = f2bf(u[r] * sc * p.ssd_norm_w[layer * 256 + hu * 128 + j]); } }
            else { const float o = L[MixLds::OS + t * 128 + lane]; const float mu = wave_sum(o) * (1.0f / 64.0f); const float dv = o - mu; const float var = wave_sum(dv * dv) * (1.0f / 64.0f);
                const int c = hu * 64 + lane;
                y[yrow + 768 + c] = f2bf((dv * rsqrtf(var + EPSF) * p.ret_norm_w[layer * 256 + c] + p.ret_norm_b[layer * 256 + c]) * silu_f(L[MixLds::ZS + t * 128 + lane])); }
        }
    }
    {
        float* so = p.out + (q.dec ? (MIX == 0 ? O_HGRN_S : MIX == 1 ? O_GDN_S : MIX == 2 ? O_SSD_S : O_RET_S) : (MIX == 0 ? O_HGRN_P : MIX == 1 ? O_GDN_P : MIX == 2 ? O_SSD_P : O_RET_P));
        const int nbt = q.dec ? DECB : NB;
#pragma unroll
        for (int i = 0; i < KR; ++i) so[(((size_t)layer * nbt + q.b) * 4 + head) * DK * 64 + (size_t)(kq * KR + i) * 64 + (vcol & 63)] = S[i];
    }
    if (MIX == 1 || MIX == 2) {
        float* co = p.out + (q.dec ? (MIX == 1 ? O_GCONV_S : O_SCONV_S) : (MIX == 1 ? O_GCONV_P : O_SCONV_P)) + ((size_t)layer * (q.dec ? DECB : NB) + q.b) * 3 * 768;
        const int nch = MIX == 1 ? 192 : 384;
        for (int e = tid; e < 3 * nch; e += 512) { const int r = e / nch, c = e % nch; int ch;
            if (MIX == 1) ch = (c >> 6) * 256 + hu * 64 + (c & 63); else ch = (c >> 7) * 256 + hu * 128 + (c & 127);
            co[r * 768 + ch] = preconv(proj, q, q.T - 3 + r, (MIX == 1 ? PC_BQKV : PC_CXBC) + ch, ctx, ch); }
    }
    (void)DVT;
}

constexpr int NCHUNK = 33;
constexpr int LDP = 72;
constexpr int LDP2 = 136;
constexpr int OSP = 68;
typedef short bf16x4 __attribute__((ext_vector_type(4)));
__device__ __forceinline__ f32x4 mfma16(bf16x8 a, bf16x8 b, f32x4 c) { return __builtin_amdgcn_mfma_f32_16x16x32_bf16(a, b, c, 0, 0, 0); }
__device__ __forceinline__ float fexp2(float x) { return __builtin_amdgcn_exp2f(x); }
__device__ __forceinline__ bf16x8 frag_ld(const LAS bf16_t* t, int pitch, int row, int col) { return *(const LAS bf16x8*)(t + row * pitch + col); }
__device__ __forceinline__ bf16x8 frag_ld_perm(const LAS bf16_t* t, int pitch, int row, int k0, int q) {
    const bf16x4 lo = *(const LAS bf16x4*)(t + row * pitch + k0 + 4 * q), hi = *(const LAS bf16x4*)(t + row * pitch + k0 + 16 + 4 * q);
    return __builtin_shufflevector(lo, hi, 0, 1, 2, 3, 4, 5, 6, 7);
}
__device__ __forceinline__ bf16x8 pack_acc2(const f32x4& a, const f32x4& b) {
    u32x4 w; w.x = pg8::cvt_pk_bf16(a[0], a[1]); w.y = pg8::cvt_pk_bf16(a[2], a[3]); w.z = pg8::cvt_pk_bf16(b[0], b[1]); w.w = pg8::cvt_pk_bf16(b[2], b[3]);
    return __builtin_bit_cast(bf16x8, w);
}
__device__ __forceinline__ void st_bf4(LAS bf16_t* dst, const f32x4& v) { u32x2 w; w.x = pg8::cvt_pk_bf16(v[0], v[1]); w.y = pg8::cvt_pk_bf16(v[2], v[3]); *(LAS u32x2*)dst = w; }

struct RetLds { static constexpr int QS = 0, KS = QS + 64 * LDP * 2, KT = KS + 64 * LDP * 2, VT = KT + 64 * LDP * 2, VH = VT + 64 * LDP * 2, PS = VH + 64 * LDP * 2, OS = PS + 64 * LDP * 2, END = OS + 64 * OSP * 4; };
__device__ void ret_prompt_item(const Params& p, int layer, int b, int hu, LAS unsigned char* lds) {
    const int tid = opaque_tid(), wid = tid >> 6, lane = tid & 63, fq = lane >> 4, fc = lane & 15;
    LAS bf16_t* Qs = (LAS bf16_t*)(lds + RetLds::QS); LAS bf16_t* Ks = (LAS bf16_t*)(lds + RetLds::KS); LAS bf16_t* KT = (LAS bf16_t*)(lds + RetLds::KT);
    LAS bf16_t* VT = (LAS bf16_t*)(lds + RetLds::VT); LAS bf16_t* VH = (LAS bf16_t*)(lds + RetLds::VH); LAS bf16_t* Ps = (LAS bf16_t*)(lds + RetLds::PS); LAS float* Os = (LAS float*)(lds + RetLds::OS);
    const bf16_t* proj = (const bf16_t*)(p.ws + WS_PROJ); bf16_t* y = (bf16_t*)(p.ws + WS_Y); const float* rot = (const float*)(p.ws + WS_ROT);
    const float lg2 = log2f(1.0f - exp2f(-5.0f - (float)hu));
    f32x4 S[4];
#pragma unroll
    for (int m = 0; m < 4; ++m) S[m] = (f32x4){0.f, 0.f, 0.f, 0.f};
    __syncthreads();
    for (int c = 0; c < NCHUNK; ++c) {
        const int i0 = c == 0 ? 48 : 0, t0 = 64 * c - 48, row0 = b * TP + t0, nlast = 64 - i0;
        for (int e = tid; e < 64 * 32; e += 512) { const int i = e >> 5, d = e & 31; float qa, qb, ka, kb;
            { const int tc = max(t0 + i, 0); const bf16_t* pr = proj + (size_t)(b * TP + tc) * NBIG; const float cs = rot[(tc * 32 + d) * 2], sn = rot[(tc * 32 + d) * 2 + 1];
                const float q1 = bf2f(pr[PC_DQ + hu * 64 + d]), q2 = bf2f(pr[PC_DQ + hu * 64 + 32 + d]), k1 = bf2f(pr[PC_DK + hu * 64 + d]), k2 = bf2f(pr[PC_DK + hu * 64 + 32 + d]);
                const float mk = i >= i0 ? 1.0f : 0.0f;
                qa = (q1 * cs - q2 * sn) * mk; qb = (q2 * cs + q1 * sn) * mk; ka = (k1 * cs - k2 * sn) * (0.125f * mk); kb = (k2 * cs + k1 * sn) * (0.125f * mk); }
            Qs[i * LDP + d] = f2bf(qa); Qs[i * LDP + 32 + d] = f2bf(qb); Ks[i * LDP + d] = f2bf(ka); Ks[i * LDP + 32 + d] = f2bf(kb);
            KT[d * LDP + i] = f2bf(ka); KT[(d + 32) * LDP + i] = f2bf(kb); }
        for (int e = tid; e < 64 * 64; e += 512) { const int i = e >> 6, d = e & 63;
            float v = bf2f(proj[(size_t)(b * TP + max(t0 + i, 0)) * NBIG + PC_DV + hu * 64 + d]); v = i >= i0 ? v : 0.f; const float vh = v * fexp2((float)(63 - i) * lg2);
            VT[d * LDP + i] = f2bf(v); VH[d * LDP + i] = f2bf(vh); }
        __syncthreads();
#pragma unroll
        for (int tt = 0; tt < 2; ++tt) { const int t = wid * 2 + tt, I = t >> 2, J = t & 3; f32x4 acc = (f32x4){0.f, 0.f, 0.f, 0.f};
            if (J <= I) {
#pragma unroll
                for (int s = 0; s < 2; ++s) acc = mfma16(frag_ld(Ks, LDP, 16 * J + fc, 32 * s + 8 * fq), frag_ld(Qs, LDP, 16 * I + fc, 32 * s + 8 * fq), acc); }
            const int i = 16 * I + fc;
#pragma unroll
            for (int r = 0; r < 4; ++r) { const int j = 16 * J + 4 * fq + r; acc[r] = (j <= i && j >= i0) ? acc[r] * fexp2((float)(i - j) * lg2) : 0.f; }
            st_bf4(Ps + i * LDP + 16 * J + 4 * fq, acc); }
        __syncthreads();
        if (wid < 4) {
            bf16x8 bv[2], bh[2], Sb[2];
#pragma unroll
            for (int s = 0; s < 2; ++s) { bv[s] = frag_ld(VT, LDP, 16 * wid + fc, 32 * s + 8 * fq); bh[s] = frag_ld(VH, LDP, 16 * wid + fc, 32 * s + 8 * fq); Sb[s] = pack_acc2(S[2 * s], S[2 * s + 1]); }
#pragma unroll
            for (int mi = 0; mi < 4; ++mi) { f32x4 o1 = (f32x4){0.f, 0.f, 0.f, 0.f}, o2 = (f32x4){0.f, 0.f, 0.f, 0.f};
#pragma unroll
                for (int s = 0; s < 2; ++s) { o1 = mfma16(frag_ld(Ps, LDP, 16 * mi + fc, 32 * s + 8 * fq), bv[s], o1); o2 = mfma16(frag_ld_perm(Qs, LDP, 16 * mi + fc, 32 * s, fq), Sb[s], o2); }
#pragma unroll
                for (int r = 0; r < 4; ++r) { const int i = 16 * mi + 4 * fq + r; Os[i * OSP + 16 * wid + fc] = o1[r] + fexp2((float)max(i - i0 + 1, 0) * lg2) * o2[r]; } }
            const float al = fexp2((float)nlast * lg2);
#pragma unroll
            for (int m = 0; m < 4; ++m) { S[m] = S[m] * al;
#pragma unroll
                for (int s = 0; s < 2; ++s) S[m] = mfma16(frag_ld(KT, LDP, 16 * m + fc, 32 * s + 8 * fq), bh[s], S[m]); }
        }
        __syncthreads();
        for (int i = wid + (i0 ? 48 : 0); i < 64; i += 8) { const size_t row = (size_t)(row0 + i); const float o = Os[i * OSP + lane]; const float mu = wave_sum(o) * (1.0f / 64.0f); const float dv = o - mu;
            const float var = wave_sum(dv * dv) * (1.0f / 64.0f); const int cc = hu * 64 + lane;
            y[row * DM + 768 + cc] = f2bf((dv * rsqrtf(var + EPSF) * p.ret_norm_w[layer * 256 + cc] + p.ret_norm_b[layer * 256 + cc]) * silu_f(bf2f(proj[row * NBIG + PC_DZ + cc]))); }
    }
    if (wid < 4) { float* so = p.out + O_RET_P + (((size_t)layer * NB + b) * 4 + hu) * 4096;
#pragma unroll
        for (int m = 0; m < 4; ++m)
#pragma unroll
            for (int r = 0; r < 4; ++r) so[(16 * m + 4 * fq + r) * 64 + 16 * wid + fc] = S[m][r]; }
}

struct SsdLds { static constexpr int CS = 0, BS = CS + 64 * LDP2 * 2, BT = BS + 64 * LDP2 * 2, XS = BT + 128 * LDP * 2, VT = XS + 64 * LDP2 * 2  , VH = VT + 2 * 64 * LDP * 2, PS = VH + 2 * 64 * LDP * 2,
    OS = PS + 2 * 64 * LDP * 2  , DT = OS + 64 * 132 * 4  , GV = DT + 512, END = GV + 512; };
__device__ void ssd_prompt_item(const Params& p, int layer, int b, int gg, LAS unsigned char* lds) {
    const int tid = opaque_tid(), wid = tid >> 6, lane = tid & 63, fq = lane >> 4, fc = lane & 15;
    LAS bf16_t* Cs = (LAS bf16_t*)(lds + SsdLds::CS); LAS bf16_t* Bs = (LAS bf16_t*)(lds + SsdLds::BS); LAS bf16_t* BT = (LAS bf16_t*)(lds + SsdLds::BT); LAS bf16_t* Xs = (LAS bf16_t*)(lds + SsdLds::XS);
    LAS bf16_t* VT = (LAS bf16_t*)(lds + SsdLds::VT); LAS bf16_t* VH = (LAS bf16_t*)(lds + SsdLds::VH); LAS bf16_t* Ps = (LAS bf16_t*)(lds + SsdLds::PS);
    LAS float* Os = (LAS float*)(lds + SsdLds::OS); LAS float* DTv = (LAS float*)(lds + SsdLds::DT); LAS float* Gv = (LAS float*)(lds + SsdLds::GV);
    const bf16_t* proj = (const bf16_t*)(p.ws + WS_PROJ); bf16_t* y = (bf16_t*)(p.ws + WS_Y); const float* psm = (const float*)(p.ws + WS_PSM);
    const float* cw = p.ssd_conv_w + (size_t)layer * 4 * 768; const float* cb = p.ssd_conv_b + (size_t)layer * 768;
    constexpr float L2E = 1.4426950408889634f;
    const int hh = wid >> 2, ws = wid & 3;
    f32x4 S[8];
#pragma unroll
    for (int m = 0; m < 8; ++m) S[m] = (f32x4){0.f, 0.f, 0.f, 0.f};
    __syncthreads();
    for (int c = 0; c < NCHUNK; ++c) {
        const int i0 = c == 0 ? 48 : 0, t0 = 64 * c - 48, row0 = b * TP + t0;
        if (wid < 2) { const int hd = gg * 2 + wid;
            float dt = softplus_f(psm[(size_t)(b * TP + max(t0 + lane, 0)) * NSM + 8 + hd] + p.ssd_dt_bias[layer * 4 + hd]); dt = lane >= i0 ? dt : 0.f;
            float G = -dt * __expf(p.ssd_a_log[layer * 4 + hd]) * L2E;
#pragma unroll
            for (int o = 1; o < 64; o <<= 1) { const float t = __shfl_up(G, o); if (lane >= o) G += t; }
            DTv[wid * 64 + lane] = dt; Gv[wid * 64 + lane] = G; }
        __syncthreads();
        for (int e = tid; e < 384 * 4; e += 512) { const int ch = e % 384, tr = e / 384, part = ch >> 7, j = ch & 127, chf = part * 256 + gg * 128 + j;
            const bf16_t* col = proj + (size_t)(b * TP) * NBIG + PC_CXBC + chf;
            const float w0 = cw[chf], w1 = cw[768 + chf], w2 = cw[2 * 768 + chf], w3 = cw[3 * 768 + chf], bias = cb[chf];
            const int ts = t0 + 16 * tr;
            float raw[19];
#pragma unroll
            for (int ii = 0; ii < 19; ++ii) { const int t = ts - 3 + ii; const float v = bf2f(col[(size_t)max(t, 0) * NBIG]); raw[ii] = t >= 0 ? v : 0.f; }
            const int h2 = j >> 6, d = j & 63; const float gl = Gv[h2 * 64 + 63];
#pragma unroll
            for (int ii = 0; ii < 16; ++ii) { const int i = 16 * tr + ii;
                float a = silu_f(bias + w0 * raw[ii] + w1 * raw[ii + 1] + w2 * raw[ii + 2] + w3 * raw[ii + 3]); if (i < i0) a = 0.f;
                if (part == 0) { const float xd = a * DTv[h2 * 64 + i]; Xs[i * LDP2 + j] = f2bf(a); VT[(h2 * 64 + d) * LDP + i] = f2bf(xd); VH[(h2 * 64 + d) * LDP + i] = f2bf(xd * fexp2(gl - Gv[h2 * 64 + i])); }
                else if (part == 1) { const bf16_t v = f2bf(a); Bs[i * LDP2 + j] = v; BT[j * LDP + i] = v; }
                else Cs[i * LDP2 + j] = f2bf(a); } }
        __syncthreads();
#pragma unroll
        for (int tt = 0; tt < 2; ++tt) { const int t = wid * 2 + tt, I = t >> 2, J = t & 3; f32x4 acc = (f32x4){0.f, 0.f, 0.f, 0.f};
            if (J <= I) {
#pragma unroll
                for (int s = 0; s < 4; ++s) acc = mfma16(frag_ld(Bs, LDP2, 16 * J + fc, 32 * s + 8 * fq), frag_ld(Cs, LDP2, 16 * I + fc, 32 * s + 8 * fq), acc); }
            const int i = 16 * I + fc;
#pragma unroll
            for (int h2 = 0; h2 < 2; ++h2) { f32x4 pv; const float gi = Gv[h2 * 64 + i];
#pragma unroll
                for (int r = 0; r < 4; ++r) { const int j = 16 * J + 4 * fq + r; pv[r] = (j <= i && j >= i0) ? acc[r] * fexp2(gi - Gv[h2 * 64 + j]) : 0.f; }
                st_bf4(Ps + (h2 * 64 + i) * LDP + 16 * J + 4 * fq, pv); } }
        __syncthreads();
        {
            bf16x8 bv[2], bh[2], Sb[4];
#pragma unroll
            for (int s = 0; s < 2; ++s) { bv[s] = frag_ld(VT, LDP, hh * 64 + 16 * ws + fc, 32 * s + 8 * fq); bh[s] = frag_ld(VH, LDP, hh * 64 + 16 * ws + fc, 32 * s + 8 * fq); }
#pragma unroll
            for (int s = 0; s < 4; ++s) Sb[s] = pack_acc2(S[2 * s], S[2 * s + 1]);
#pragma unroll
            for (int mi = 0; mi < 4; ++mi) { f32x4 o1 = (f32x4){0.f, 0.f, 0.f, 0.f}, o2 = (f32x4){0.f, 0.f, 0.f, 0.f};
#pragma unroll
                for (int s = 0; s < 2; ++s) o1 = mfma16(frag_ld(Ps, LDP, hh * 64 + 16 * mi + fc, 32 * s + 8 * fq), bv[s], o1);
#pragma unroll
                for (int s = 0; s < 4; ++s) o2 = mfma16(frag_ld_perm(Cs, LDP2, 16 * mi + fc, 32 * s, fq), Sb[s], o2);
#pragma unroll
                for (int r = 0; r < 4; ++r) { const int i = 16 * mi + 4 * fq + r; Os[i * 132 + hh * 64 + 16 * ws + fc] = o1[r] + fexp2(Gv[hh * 64 + i]) * o2[r]; } }
            const float al = fexp2(Gv[hh * 64 + 63]);
#pragma unroll
            for (int m = 0; m < 8; ++m) { S[m] = S[m] * al;
#pragma unroll
                for (int s = 0; s < 2; ++s) S[m] = mfma16(frag_ld(BT, LDP, 16 * m + fc, 32 * s + 8 * fq), bh[s], S[m]); }
        }
        __syncthreads();
        for (int i = wid + (i0 ? 48 : 0); i < 64; i += 8) { const size_t row = (size_t)(row0 + i); float u[2]; float ss = 0.f;
#pragma unroll
            for (int r = 0; r < 2; ++r) { const int j = lane + 64 * r; const float o = Os[i * 132 + j] + p.ssd_d[layer * 4 + gg * 2 + r] * bf2f(Xs[i * LDP2 + j]);
                u[r] = o * silu_f(bf2f(proj[row * NBIG + PC_CZ + gg * 128 + j])); ss += u[r] * u[r]; }
            const float sc = rsqrtf(wave_sum(ss) * (1.0f / 128.0f) + EPSF);
#pragma unroll
            for (int r = 0; r < 2; ++r) { const int j = lane + 64 * r; y[row * DM + 512 + gg * 128 + j] = f2bf(u[r] * sc * p.ssd_norm_w[layer * 256 + gg * 128 + j]); } }
    }
    { float* so = p.out + O_SSD_P + (((size_t)layer * NB + b) * 4 + gg * 2 + hh) * 8192;
#pragma unroll
        for (int m = 0; m < 8; ++m)
#pragma unroll
            for (int r = 0; r < 4; ++r) so[(16 * m + 4 * fq + r) * 64 + 16 * ws + fc] = S[m][r]; }
    { float* co = p.out + O_SCONV_P + ((size_t)layer * NB + b) * 3 * 768;
        for (int e = tid; e < 3 * 384; e += 512) { const int r = e / 384, ch = e % 384, chf = (ch >> 7) * 256 + gg * 128 + (ch & 127);
            co[r * 768 + chf] = bf2f(proj[(size_t)(b * TP + TP - 3 + r) * NBIG + PC_CXBC + chf]); } }
}

struct HgLds { static constexpr int LS = 0  , KR = LS + 16384  , QR = KR + 16384  , QT = QR + 16384, QH = QT + 64 * LDP * 2, KT = QH + 64 * LDP * 2  ,
    KHT = KT + 160 * LDP * 2, VT = KHT + 64 * LDP * 2, PS = VT + 64 * LDP * 2, OS = PS + 64 * LDP * 2, AV = OS + 64 * OSP * 4, END = AV + 256; };
__device__ void hgrn_prompt_item(const Params& p, int layer, int b, int hu, LAS unsigned char* lds) {
    const int tid = opaque_tid(), wid = tid >> 6, lane = tid & 63, fq = lane >> 4, fc = lane & 15;
    LAS float* Ls = (LAS float*)(lds + HgLds::LS); LAS float* Kr = (LAS float*)(lds + HgLds::KR); LAS float* Qr = (LAS float*)(lds + HgLds::QR);
    LAS bf16_t* Qt = (LAS bf16_t*)(lds + HgLds::QT); LAS bf16_t* Qh = (LAS bf16_t*)(lds + HgLds::QH); LAS bf16_t* Kt = (LAS bf16_t*)(lds + HgLds::KT); LAS bf16_t* KhT = (LAS bf16_t*)(lds + HgLds::KHT);
    LAS bf16_t* VT = (LAS bf16_t*)(lds + HgLds::VT); LAS bf16_t* Ps = (LAS bf16_t*)(lds + HgLds::PS); LAS float* Os = (LAS float*)(lds + HgLds::OS); LAS float* Av = (LAS float*)(lds + HgLds::AV);
    const bf16_t* proj = (const bf16_t*)(p.ws + WS_PROJ); bf16_t* y = (bf16_t*)(p.ws + WS_Y);
    const float lbv = ((const float*)(p.ws + WS_LB))[layer * 256 + hu * 64 + lane];
    f32x4 S[4];
#pragma unroll
    for (int m = 0; m < 4; ++m) S[m] = (f32x4){0.f, 0.f, 0.f, 0.f};
    __syncthreads();
    for (int c = 0; c < NCHUNK; ++c) {
        const int i0 = c == 0 ? 48 : 0, t0 = 64 * c - 48, row0 = b * TP + t0;
        if (wid < 4) { float acc = 0.f; float afr[16];
#pragma unroll
            for (int ii = 0; ii < 16; ++ii) { const int i = 16 * wid + ii; afr[ii] = bf2f(proj[(size_t)(b * TP + max(t0 + i, 0)) * NBIG + PC_AF + hu * 64 + lane]); }
#pragma unroll
            for (int ii = 0; ii < 16; ++ii) { const int i = 16 * wid + ii; float kk = 0.f;
                { float af = afr[ii]; af = fminf(fmaxf(af, -30.f), 30.f);
                    const float e = __expf(-af), sg = 1.0f / (1.0f + e); const float f = lbv + (1.0f - lbv) * sg; const bool ok = i >= i0; kk = ok ? (1.0f - lbv) * e * sg : 0.f; acc += ok ? __log2f(fmaxf(f, 1e-30f)) : 0.f; }
                Ls[i * 64 + lane] = acc; Kr[i * 64 + lane] = kk; } }
        else { for (int e = tid - 256; e < 64 * 64; e += 256) { const int i = e >> 6, d = e & 63;
                const bf16_t* pr = proj + (size_t)(b * TP + max(t0 + i, 0)) * NBIG; float q = silu_f(bf2f(pr[PC_AQ + hu * 64 + d])) * 0.125f, v = bf2f(pr[PC_AI + hu * 64 + d]); if (i < i0) { q = 0.f; v = 0.f; }
                Qr[i * 64 + d] = q; VT[d * LDP + i] = f2bf(v); } }
        __syncthreads();
        for (int e = tid; e < 64 * 64; e += 512) { const int i = e >> 6, d = e & 63, I = i >> 4;
            const float T0 = Ls[15 * 64 + d], T1 = Ls[31 * 64 + d], T2 = Ls[47 * 64 + d], T3 = Ls[63 * 64 + d];
            const float Bi = I == 0 ? 0.f : I == 1 ? T0 : I == 2 ? T0 + T1 : T0 + T1 + T2; const float Li = Ls[i * 64 + d], Gi = Bi + Li, Gl = T0 + T1 + T2 + T3;
            const float q = Qr[i * 64 + d], k = Kr[i * 64 + d];
            Qt[i * LDP + d] = f2bf(q * fexp2(Li)); Qh[i * LDP + d] = f2bf(q * fexp2(Gi)); KhT[d * LDP + i] = f2bf(k * fexp2(Gl - Gi));
            float Bp = Bi;
            Kt[((I == 0 ? 0 : I == 1 ? 16 : I == 2 ? 48 : 96) + i) * LDP + d] = f2bf(k * fexp2(Bp - Gi));
            if (I <= 0) { Bp = T0; Kt[(16 + i) * LDP + d] = f2bf(k * fexp2(Bp - Gi)); }
            if (I <= 1) { Bp = T0 + T1; Kt[(48 + i) * LDP + d] = f2bf(k * fexp2(Bp - Gi)); }
            if (I <= 2) { Bp = T0 + T1 + T2; Kt[(96 + i) * LDP + d] = f2bf(k * fexp2(Bp - Gi)); }
            if (i == 0) Av[d] = fexp2(Gl); }
        __syncthreads();
#pragma unroll
        for (int tt = 0; tt < 2; ++tt) { const int t = wid * 2 + tt, I = t >> 2, J = t & 3; f32x4 acc = (f32x4){0.f, 0.f, 0.f, 0.f};
            if (J <= I) { const int kb = (I == 0 ? 0 : I == 1 ? 16 : I == 2 ? 48 : 96) + 16 * J;
#pragma unroll
                for (int s = 0; s < 2; ++s) acc = mfma16(frag_ld(Kt, LDP, kb + fc, 32 * s + 8 * fq), frag_ld(Qt, LDP, 16 * I + fc, 32 * s + 8 * fq), acc); }
            const int i = 16 * I + fc;
#pragma unroll
            for (int r = 0; r < 4; ++r) { const int j = 16 * J + 4 * fq + r; acc[r] = (j <= i) ? acc[r] : 0.f; }
            st_bf4(Ps + i * LDP + 16 * J + 4 * fq, acc); }
        __syncthreads();
        if (wid < 4) {
            bf16x8 bv[2], Sb[2];
#pragma unroll
            for (int s = 0; s < 2; ++s) { bv[s] = frag_ld(VT, LDP, 16 * wid + fc, 32 * s + 8 * fq); Sb[s] = pack_acc2(S[2 * s], S[2 * s + 1]); }
#pragma unroll
            for (int mi = 0; mi < 4; ++mi) { f32x4 o = (f32x4){0.f, 0.f, 0.f, 0.f};
#pragma unroll
                for (int s = 0; s < 2; ++s) { o = mfma16(frag_ld(Ps, LDP, 16 * mi + fc, 32 * s + 8 * fq), bv[s], o); o = mfma16(frag_ld_perm(Qh, LDP, 16 * mi + fc, 32 * s, fq), Sb[s], o); }
#pragma unroll
                for (int r = 0; r < 4; ++r) Os[(16 * mi + 4 * fq + r) * OSP + 16 * wid + fc] = o[r]; }
#pragma unroll
            for (int m = 0; m < 4; ++m) {
#pragma unroll
                for (int r = 0; r < 4; ++r) S[m][r] *= Av[16 * m + 4 * fq + r];
#pragma unroll
                for (int s = 0; s < 2; ++s) S[m] = mfma16(frag_ld(KhT, LDP, 16 * m + fc, 32 * s + 8 * fq), bv[s], S[m]); }
        }
        __syncthreads();
        for (int i = wid + (i0 ? 48 : 0); i < 64; i += 8) { const size_t row = (size_t)(row0 + i); const float o = Os[i * OSP + lane]; const float ms = wave_sum(o * o) * (1.0f / 64.0f); const int cc = hu * 64 + lane;
            y[row * DM + cc] = f2bf(o * rsqrtf(ms + EPSF) * p.hgrn_norm_w[layer * 256 + cc] * silu_f(bf2f(proj[row * NBIG + PC_AZ + cc]))); }
    }
    if (wid < 4) { float* so = p.out + O_HGRN_P + (((size_t)layer * NB + b) * 4 + hu) * 4096;
#pragma unroll
        for (int m = 0; m < 4; ++m)
#pragma unroll
            for (int r = 0; r < 4; ++r) so[(16 * m + 4 * fq + r) * 64 + 16 * wid + fc] = S[m][r]; }
}

constexpr size_t GD_U = 0, GD_W = 16384, GD_Q = 24576, GD_P = 32768, GD_K = 40960, GD_VEC = 49152, GD_UNIT = 49920;
static_assert((size_t)NB * NCHUNK * 4 * GD_UNIT <= (size_t)NB * SEQ * DM * 4, "GDN scratch lives in the y_prompt region of d_out until the final phase");
struct GdLds { static constexpr int QF = 0, KF = 16384, VF = 32768, QN = 49152, KN = QN + 64 * LDP * 2, KNT = KN + 64 * LDP * 2, NM = KNT + 64 * LDP * 2, QK = NM + 64 * LDP * 2, WT = QK + 64 * LDP * 2,
    MD = WT + 64 * LDP * 2  , TD = MD + 4096  , GV = TD + 2048, BV = GV + 256, END = BV + 256; };

__device__ void gdn_pre_unit(const Params& p, int layer, int b, int c, int hu, LAS unsigned char* lds) {
    const int tid = opaque_tid(), wid = tid >> 6, lane = tid & 63, fq = lane >> 4, fc = lane & 15;
    LAS float* Qf = (LAS float*)(lds + GdLds::QF); LAS float* Kf = (LAS float*)(lds + GdLds::KF); LAS float* Vf = (LAS float*)(lds + GdLds::VF);
    LAS bf16_t* Qn = (LAS bf16_t*)(lds + GdLds::QN); LAS bf16_t* Kn = (LAS bf16_t*)(lds + GdLds::KN); LAS bf16_t* KnT = (LAS bf16_t*)(lds + GdLds::KNT);
    LAS bf16_t* NM = (LAS bf16_t*)(lds + GdLds::NM); LAS bf16_t* QK = (LAS bf16_t*)(lds + GdLds::QK); LAS bf16_t* Wt = (LAS bf16_t*)(lds + GdLds::WT);
    LAS float* MD = (LAS float*)(lds + GdLds::MD); LAS bf16_t* TD = (LAS bf16_t*)(lds + GdLds::TD); LAS float* Gv = (LAS float*)(lds + GdLds::GV); LAS float* Bv = (LAS float*)(lds + GdLds::BV);
    const bf16_t* proj = (const bf16_t*)(p.ws + WS_PROJ); const float* psm = (const float*)(p.ws + WS_PSM);
    const float* cw = p.gdn_conv_w + (size_t)layer * 4 * 768;
    unsigned char* gd = (unsigned char*)(p.out + O_YP) + (size_t)((b * NCHUNK + c) * 4 + hu) * GD_UNIT;
    constexpr float L2E = 1.4426950408889634f;
    const int i0 = c == 0 ? 48 : 0, t0 = 64 * c - 48, row0 = b * TP + t0;
    __syncthreads();
    if (wid == 0) { const float* ps = psm + (size_t)(b * TP + max(t0 + lane, 0)) * NSM;
        float g = -__expf(p.gdn_a_log[layer * 4 + hu]) * softplus_f(ps[hu] + p.gdn_dt_bias[layer * 4 + hu]) * L2E, be = sigmoid_f(ps[4 + hu]); if (lane < i0) { g = 0.f; be = 0.f; }
#pragma unroll
        for (int o = 1; o < 64; o <<= 1) { const float t = __shfl_up(g, o); if (lane >= o) g += t; }
        Gv[lane] = g; Bv[lane] = be; }
    for (int e = tid; e < 192 * 8; e += 512) { const int ch = e % 192, tr = e / 192, part = ch >> 6, d = ch & 63, chf = part * 256 + hu * 64 + d;
        const bf16_t* col = proj + (size_t)(b * TP) * NBIG + PC_BQKV + chf;
        const float w0 = cw[chf], w1 = cw[768 + chf], w2 = cw[2 * 768 + chf], w3 = cw[3 * 768 + chf];
        const int ts = t0 + 8 * tr;
        float raw[11];
#pragma unroll
        for (int ii = 0; ii < 11; ++ii) { const int t = ts - 3 + ii; const float v = bf2f(col[(size_t)max(t, 0) * NBIG]); raw[ii] = t >= 0 ? v : 0.f; }
        LAS float* dst = part == 0 ? Qf : part == 1 ? Kf : Vf;
#pragma unroll
        for (int ii = 0; ii < 8; ++ii) { const int i = 8 * tr + ii;
            float a = silu_f(w0 * raw[ii] + w1 * raw[ii + 1] + w2 * raw[ii + 2] + w3 * raw[ii + 3]); if (i < i0) a = 0.f;
            dst[i * 64 + d] = a; } }
    __syncthreads();
    for (int ii = 0; ii < 8; ++ii) { const int i = wid * 8 + ii; const float q = Qf[i * 64 + lane], k = Kf[i * 64 + lane];
        const float sq = rsqrtf(wave_sum(q * q) + EPSF) * 0.125f, sk = rsqrtf(wave_sum(k * k) + EPSF); const float kn = k * sk;
        Qn[i * LDP + lane] = f2bf(q * sq); const bf16_t kb = f2bf(kn); Kn[i * LDP + lane] = kb; KnT[lane * LDP + i] = kb; Kf[i * 64 + lane] = kn; }
    __syncthreads();
#pragma unroll
    for (int tt = 0; tt < 2; ++tt) { const int t = wid * 2 + tt, I = t >> 2, J = t & 3; f32x4 a1 = (f32x4){0.f, 0.f, 0.f, 0.f}, a2 = (f32x4){0.f, 0.f, 0.f, 0.f};
        if (J <= I) {
#pragma unroll
            for (int s = 0; s < 2; ++s) { const bf16x8 kj = frag_ld(Kn, LDP, 16 * J + fc, 32 * s + 8 * fq); a1 = mfma16(kj, frag_ld(Kn, LDP, 16 * I + fc, 32 * s + 8 * fq), a1); a2 = mfma16(kj, frag_ld(Qn, LDP, 16 * I + fc, 32 * s + 8 * fq), a2); } }
        const int i = 16 * I + fc; const float gi = Gv[i], bi = Bv[i]; f32x4 nm, qk;
#pragma unroll
        for (int r = 0; r < 4; ++r) { const int j = 16 * J + 4 * fq + r; const float dec = j <= i ? fexp2(gi - Gv[j]) : 0.f; const float mm = j < i ? a1[r] * dec * bi : 0.f; nm[r] = -mm; qk[r] = a2[r] * dec;
            if (J == I) MD[(I * 16 + fc) * 16 + 4 * fq + r] = mm; }
        st_bf4(NM + i * LDP + 16 * J + 4 * fq, nm); st_bf4(QK + i * LDP + 16 * J + 4 * fq, qk); }
    __syncthreads();
    if (wid == 0) { const int I = fq, cc = fc; float x[16];
#pragma unroll
        for (int i = 0; i < 16; ++i) { float acc = (i == cc) ? 1.0f : 0.0f;
#pragma unroll
            for (int j = 0; j < i; ++j) acc -= MD[(I * 16 + i) * 16 + j] * x[j];
            x[i] = acc; TD[(I * 16 + i) * 16 + cc] = f2bf(acc); } }
    __syncthreads();
    const int isW = wid >> 2, ws = wid & 3, colx = 16 * ws + fc;
    f32x4 X[4];
    const f32x4 zero4 = (f32x4){0.f, 0.f, 0.f, 0.f};
#pragma unroll
    for (int I = 0; I < 4; ++I) { f32x4 acc;
#pragma unroll
        for (int r = 0; r < 4; ++r) { const int j = 16 * I + 4 * fq + r; acc[r] = isW ? Bv[j] * fexp2(Gv[j]) * Kf[j * 64 + colx] : Bv[j] * Vf[j * 64 + colx]; }
        if (I >= 1) acc = mfma16(frag_ld_perm(NM, LDP, 16 * I + fc, 0, fq), pack_acc2(X[0], I > 1 ? X[1] : zero4), acc);
        if (I == 3) acc = mfma16(frag_ld_perm(NM, LDP, 48 + fc, 32, fq), pack_acc2(X[2], zero4), acc);
        const bf16x4 tlo = *(const LAS bf16x4*)(TD + (I * 16 + fc) * 16 + 4 * fq); const bf16x4 z4 = (bf16x4){0, 0, 0, 0};
        X[I] = mfma16(__builtin_shufflevector(tlo, z4, 0, 1, 2, 3, 4, 5, 6, 7), pack_acc2(acc, zero4), zero4); }
    if (!isW) {
#pragma unroll
        for (int m = 0; m < 4; ++m) *(f32x4*)(gd + GD_U + ((size_t)(ws * 4 + m) * 64 + lane) * 16) = X[m]; }
    else {
#pragma unroll
        for (int m = 0; m < 4; ++m)
#pragma unroll
            for (int r = 0; r < 4; ++r) Wt[(16 * m + 4 * fq + r) * LDP + colx] = f2bf(-X[m][r]); }
    __syncthreads();
    { const int tsel = wid >> 1; const LAS bf16_t* tile = tsel == 0 ? Wt : tsel == 1 ? Qn : tsel == 2 ? QK : KnT; unsigned char* dst = gd + (tsel == 0 ? GD_W : tsel == 1 ? GD_Q : tsel == 2 ? GD_P : GD_K);
#pragma unroll
        for (int x = 0; x < 4; ++x) { const int sl = (wid & 1) * 4 + x, m = sl >> 1, s = sl & 1; *(bf16x8*)(dst + ((size_t)sl * 64 + lane) * 16) = frag_ld_perm(tile, LDP, 16 * m + fc, 32 * s, fq); } }
    if (tid < 64) { float* gv = (float*)(gd + GD_VEC); gv[tid] = fexp2(Gv[tid]); gv[64 + tid] = fexp2(Gv[63] - Gv[tid]); if (tid == 0) gv[128] = fexp2(Gv[63]); }
}

__device__ void ph_gdn_pre(const Params& p, int layer, LAS unsigned char* lds, int blk, int nblk) {
    for (int u = blk; u < NB * NCHUNK * 4; u += nblk) gdn_pre_unit(p, layer, u / (NCHUNK * 4), (u / 4) % NCHUNK, u & 3, lds);
}

__device__ void gdn_prompt_pair(const Params& p, int layer, int b, int hp, LAS unsigned char* lds) {
    const int tid = opaque_tid(), wid = tid >> 6, lane = tid & 63, fq = lane >> 4, fc = lane & 15;
    const int hsel = wid >> 2, hd = hp * 2 + hsel, ws = wid & 3;
    LAS float* Os = (LAS float*)lds;
    const bf16_t* proj = (const bf16_t*)(p.ws + WS_PROJ); bf16_t* y = (bf16_t*)(p.ws + WS_Y);
    f32x4 S[4];
#pragma unroll
    for (int m = 0; m < 4; ++m) S[m] = (f32x4){0.f, 0.f, 0.f, 0.f};
    const f32x4 zero4 = (f32x4){0.f, 0.f, 0.f, 0.f};
    __syncthreads();
    for (int c = 0; c < NCHUNK; ++c) {
        const int i0 = c == 0 ? 48 : 0, row0 = b * TP + 64 * c - 48;
        const unsigned char* gd = (const unsigned char*)(p.out + O_YP) + (size_t)((b * NCHUNK + c) * 4 + hd) * GD_UNIT;
        const float* gv = (const float*)(gd + GD_VEC);
        LAS float* Ob = Os + ((c & 1) * 2 + hsel) * 64 * OSP;
        bf16x8 Sb[2], ub[2], uh[2]; f32x4 u[4];
#pragma unroll
        for (int s = 0; s < 2; ++s) Sb[s] = pack_acc2(S[2 * s], S[2 * s + 1]);
#pragma unroll
        for (int m = 0; m < 4; ++m) { u[m] = *(const f32x4*)(gd + GD_U + ((size_t)(ws * 4 + m) * 64 + lane) * 16);
#pragma unroll
            for (int s = 0; s < 2; ++s) u[m] = mfma16(*(const bf16x8*)(gd + GD_W + ((size_t)(m * 2 + s) * 64 + lane) * 16), Sb[s], u[m]); }
#pragma unroll
        for (int s = 0; s < 2; ++s) { ub[s] = pack_acc2(u[2 * s], u[2 * s + 1]); f32x4 a = u[2 * s], bb = u[2 * s + 1];
#pragma unroll
            for (int r = 0; r < 4; ++r) { a[r] *= gv[64 + 16 * (2 * s) + 4 * fq + r]; bb[r] *= gv[64 + 16 * (2 * s + 1) + 4 * fq + r]; }
            uh[s] = pack_acc2(a, bb); }
#pragma unroll
        for (int mi = 0; mi < 4; ++mi) { f32x4 o1 = zero4, o2 = zero4;
#pragma unroll
            for (int s = 0; s < 2; ++s) { o1 = mfma16(*(const bf16x8*)(gd + GD_P + ((size_t)(mi * 2 + s) * 64 + lane) * 16), ub[s], o1); o2 = mfma16(*(const bf16x8*)(gd + GD_Q + ((size_t)(mi * 2 + s) * 64 + lane) * 16), Sb[s], o2); }
#pragma unroll
            for (int r = 0; r < 4; ++r) { const int i = 16 * mi + 4 * fq + r; Ob[i * OSP + 16 * ws + fc] = o1[r] + gv[i] * o2[r]; } }
        const float al = gv[128];
#pragma unroll
        for (int m = 0; m < 4; ++m) { S[m] = S[m] * al;
#pragma unroll
            for (int s = 0; s < 2; ++s) S[m] = mfma16(*(const bf16x8*)(gd + GD_K + ((size_t)(m * 2 + s) * 64 + lane) * 16), uh[s], S[m]); }
        __syncthreads();
        for (int i = ws * 16; i < ws * 16 + 16; ++i) { if (i < i0) continue; const size_t row = (size_t)(row0 + i); const float o = Ob[i * OSP + lane]; const float ms = wave_sum(o * o) * (1.0f / 64.0f); const int cc = hd * 64 + lane;
            y[row * DM + 256 + cc] = f2bf(o * rsqrtf(ms + EPSF) * p.gdn_norm_w[layer * 256 + cc] * silu_f(bf2f(proj[row * NBIG + PC_BZ + cc]))); }
    }
    { float* so = p.out + O_GDN_P + (((size_t)layer * NB + b) * 4 + hd) * 4096;
#pragma unroll
        for (int m = 0; m < 4; ++m)
#pragma unroll
            for (int r = 0; r < 4; ++r) so[(16 * m + 4 * fq + r) * 64 + 16 * ws + fc] = S[m][r]; }
    { float* co = p.out + O_GCONV_P + ((size_t)layer * NB + b) * 3 * 768;
        for (int e = tid; e < 3 * 384; e += 512) { const int r = e / 384, ch = e % 384, chf = (ch / 128) * 256 + hp * 128 + (ch & 127);
            co[r * 768 + chf] = bf2f(proj[(size_t)(b * TP + TP - 3 + r) * NBIG + PC_BQKV + chf]); } }
}

constexpr int N_SEQ = NB + DECB, N_MU = 14, N_ITEMS = N_SEQ * N_MU;
__device__ void ph_mixer(const Params& p, int layer, LAS unsigned char* lds, int blk, int nblk) {
    LAS float* L = (LAS float*)lds;
#ifndef REP_PROMPT
#define REP_PROMPT 1
#endif
#ifndef REP_DEC
#define REP_DEC 1
#endif
    for (int it = blk; it < N_ITEMS; it += nblk) {
        const int s = it / N_MU, mu = it % N_MU;
#ifndef REP_P0
#define REP_P0 1
#define REP_P1 1
#define REP_P2 1
#define REP_P3 1
#endif
        for (int rep = 0; rep < (s < NB ? (mu < 4 ? REP_P0 : mu < 8 ? REP_P1 : mu < 10 ? REP_P2 : REP_P3) : REP_DEC); ++rep)
        if (mu < 4) { if (s < NB) hgrn_prompt_item(p, layer, s, mu, lds); else mixer_item<0>(p, layer, s, mu, L); }
        else if (mu < 8) { if (s < NB) { if (mu < 6) gdn_prompt_pair(p, layer, s, mu - 4, lds); } else mixer_item<1>(p, layer, s, mu - 4, L); }
        else if (mu < 10) { if (s < NB) ssd_prompt_item(p, layer, s, mu - 8, lds); else mixer_item<2>(p, layer, s, mu - 8, L); }
        else if (s < NB) ret_prompt_item(p, layer, s, mu - 10, lds);
        else mixer_item<3>(p, layer, s, mu - 10, L);
    }
}

__device__ void ph_final(const Params& p, int blk, int nblk) {
    const int tid = opaque_tid(), wid = tid >> 6, lane = tid & 63;
    const float* h = (const float*)(p.ws + WS_H);
    for (int row = blk * 8 + wid; row < MROWS; row += nblk * 8) {
        float* dst;
        if (row < MP) { const int b = row / TP, t = row % TP; if (t < NMETA) continue; dst = p.out + O_YP + ((size_t)b * SEQ + (t - NMETA)) * DM; } else dst = p.out + O_YS + (size_t)(row - MP) * DM;
        f32x4 v[4]; float ss = 0.f;
#pragma unroll
        for (int j = 0; j < 4; ++j) { v[j] = *(const f32x4*)(h + (size_t)row * DM + j * 256 + lane * 4); ss += v[j][0] * v[j][0] + v[j][1] * v[j][1] + v[j][2] * v[j][2] + v[j][3] * v[j][3]; }
        const float r = rsqrtf(wave_sum(ss) * (1.0f / DM) + EPSF);
#pragma unroll
        for (int j = 0; j < 4; ++j) { const f32x4 w = *(const f32x4*)(p.final_norm_w + j * 256 + lane * 4); *(f32x4*)(dst + j * 256 + lane * 4) = v[j] * r * w; }
    }
}

constexpr int LDS_STAGE = 160 * 1024 - 256;
constexpr int LDS_BYTES = LDS_STAGE + 16;
static_assert(MixLds::END * 4 <= LDS_STAGE && RetLds::END <= LDS_STAGE && SsdLds::END <= LDS_STAGE && HgLds::END <= LDS_STAGE && GdLds::END <= LDS_STAGE && pg8::STAGE_BYTES <= LDS_STAGE, "LDS carve");

__global__ void __launch_bounds__(512, 2) k_mega(Params p) {
    extern __shared__ __attribute__((aligned(16))) unsigned char smem[];
    LAS unsigned char* lds = (LAS unsigned char*)smem;
    const int blk = blockIdx.x, nblk = gridDim.x;
    volatile LAS unsigned* xbw = (volatile LAS unsigned*)(lds + LDS_STAGE);
    if (threadIdx.x < 4) xbw[threadIdx.x] = 0u;
    __syncthreads();
    XcdBarrier xb = xcd_barrier_post((unsigned*)(p.ws + WS_BAR), xbw);
#ifndef REP_PREP
#define REP_PREP 1
#endif
#ifndef REP_ROWNORM
#define REP_ROWNORM 1
#endif
#ifndef REP_GEMMIN
#define REP_GEMMIN 1
#endif
#ifndef REP_GDNPRE
#define REP_GDNPRE 1
#endif
#ifndef REP_MIXER
#define REP_MIXER 1
#endif
    for (int r = 0; r < REP_PREP; ++r) { ph_prep(p, lds, blk, nblk); if (r + 1 < REP_PREP) xcd_barrier(xb); }
    cooperative_groups::this_grid().sync();
    xcd_barrier(xb);
#pragma unroll 1
    for (int l = 0; l < DEPTH; ++l) {
        for (int r = 0; r < REP_ROWNORM; ++r) { ph_rownorm(p, l, blk, nblk); xcd_barrier(xb); }
        for (int r = 0; r < REP_GEMMIN; ++r) { ph_gemm_in(p, l, lds, blk, nblk); xcd_barrier(xb); }
        for (int r = 0; r < REP_GDNPRE; ++r) { ph_gdn_pre(p, l, lds, blk, nblk); xcd_barrier(xb); }
        for (int r = 0; r < REP_MIXER; ++r) { ph_mixer(p, l, lds, blk, nblk); xcd_barrier(xb); }
        ph_gemm_out(p, l, lds, blk, nblk);
        xcd_barrier(xb);
    }
    ph_final(p, blk, nblk);
}

extern "C" void kernel_launch(void* const* d_in, const int* in_sizes, int n_in, void* d_out, int out_size, void* d_ws, size_t ws_size, hipStream_t stream) {
    static int grid = 0;
    if (grid == 0) {
        if (n_in != 27 || (size_t)out_size != O_END || ws_size < WS_END) { fprintf(stderr, "kernel_launch: unexpected shapes: n_in %d out %d (want %zu) ws %zu (want %zu)\n", n_in, out_size, (size_t)O_END, ws_size, (size_t)WS_END); grid = -1; return; }
        if (hipFuncSetAttribute((const void*)k_mega, hipFuncAttributeMaxDynamicSharedMemorySize, LDS_BYTES) != hipSuccess) { fprintf(stderr, "kernel_launch: hipFuncSetAttribute failed\n"); grid = -1; return; }
        int dev = 0, cus = 0, per_cu = 0;
        if (hipGetDevice(&dev) != hipSuccess || hipDeviceGetAttribute(&cus, hipDeviceAttributeMultiprocessorCount, dev) != hipSuccess) { fprintf(stderr, "kernel_launch: device query failed\n"); grid = -1; return; }
        if (hipOccupancyMaxActiveBlocksPerMultiprocessor(&per_cu, (const void*)k_mega, 512, LDS_BYTES) != hipSuccess || per_cu < 1) { fprintf(stderr, "kernel_launch: occupancy query says %d blocks per CU\n", per_cu); grid = -1; return; }
        grid = cus;
    }
    if (grid < 0) return;
    Params p{};
    const float** pp = (const float**)&p;
    for (int i = 0; i < 27; ++i) pp[i] = (const float*)d_in[i];
    p.out = (float*)d_out; p.ws = (unsigned char*)d_ws;
    (void)hipMemsetAsync((unsigned char*)d_ws + WS_BAR, 0, 16384, stream);
    void* args[] = {&p};
    const hipError_t e = hipLaunchCooperativeKernel((const void*)k_mega, dim3(grid), dim3(512), args, LDS_BYTES, stream);
    if (e != hipSuccess) fprintf(stderr, "kernel_launch: cooperative launch failed: %s (grid %d)\n", hipGetErrorString(e), grid);
}
```

```cpp
#include <hip/hip_runtime.h>
#include <hip/hip_cooperative_groups.h>
#include <cstdio>
#include <cstdint>

#define LAS __attribute__((address_space(3)))
typedef unsigned short bf16_t;
typedef short bf16x8 __attribute__((ext_vector_type(8)));
typedef float f32x4 __attribute__((ext_vector_type(4)));
typedef unsigned u32x4 __attribute__((ext_vector_type(4)));
typedef unsigned u32x2 __attribute__((ext_vector_type(2)));

constexpr int DM = 1024, NB = 8, SEQ = 2048, DEPTH = 4, DECB = 128, NMETA = 16, TP = SEQ + NMETA;
constexpr int MP = NB * TP;
constexpr int MROWS = MP + DECB;
constexpr int IN_DIM = 4108, NBIG = 4096, NSM = 12;
constexpr int PASTLEN = 16384;
constexpr float EPSF = 1e-6f;
constexpr int PC_AQ = 0, PC_AF = 256, PC_AI = 512, PC_AZ = 768, PC_BQKV = 1024, PC_BZ = 1792, PC_CXBC = 2048, PC_CZ = 2816, PC_DQ = 3072, PC_DK = 3328, PC_DV = 3584, PC_DZ = 3840;

constexpr size_t WS_BAR = 0;
constexpr size_t WS_WINT = 16384;
constexpr size_t WS_WOUTT = WS_WINT + (size_t)DEPTH * NBIG * DM * 2;
constexpr size_t WS_WSM = WS_WOUTT + (size_t)DEPTH * DM * DM * 2;
constexpr size_t WS_LB = WS_WSM + (size_t)DEPTH * NSM * DM * 4;
constexpr size_t WS_ROT = WS_LB + (size_t)DEPTH * 256 * 4;
constexpr size_t ROT_BYTES = ((size_t)(TP + 1) * 64 * 4 + 255) / 256 * 256;
constexpr size_t WS_H = WS_ROT + ROT_BYTES;
constexpr size_t WS_HB = WS_H + (size_t)MROWS * DM * 4;
constexpr size_t WS_RS = WS_HB + (size_t)MROWS * DM * 2;
constexpr size_t WS_PSM = WS_RS + (size_t)MROWS * 4;
constexpr size_t WS_PROJ = WS_PSM + (size_t)MROWS * NSM * 4;
constexpr size_t WS_Y = WS_PROJ + (size_t)MROWS * NBIG * 2;
constexpr size_t WS_END = WS_Y + (size_t)MROWS * DM * 2;

constexpr size_t O_YP = 0;
constexpr size_t O_YS = O_YP + (size_t)NB * SEQ * DM;
constexpr size_t O_HGRN_P = O_YS + (size_t)DECB * DM;
constexpr size_t O_GDN_P = O_HGRN_P + (size_t)DEPTH * NB * 4 * 64 * 64;
constexpr size_t O_GCONV_P = O_GDN_P + (size_t)DEPTH * NB * 4 * 64 * 64;
constexpr size_t O_SSD_P = O_GCONV_P + (size_t)DEPTH * NB * 3 * 768;
constexpr size_t O_SCONV_P = O_SSD_P + (size_t)DEPTH * NB * 4 * 128 * 64;
constexpr size_t O_RET_P = O_SCONV_P + (size_t)DEPTH * NB * 3 * 768;
constexpr size_t O_HGRN_S = O_RET_P + (size_t)DEPTH * NB * 4 * 64 * 64;
constexpr size_t O_GDN_S = O_HGRN_S + (size_t)DEPTH * DECB * 4 * 64 * 64;
constexpr size_t O_GCONV_S = O_GDN_S + (size_t)DEPTH * DECB * 4 * 64 * 64;
constexpr size_t O_SSD_S = O_GCONV_S + (size_t)DEPTH * DECB * 3 * 768;
constexpr size_t O_SCONV_S = O_SSD_S + (size_t)DEPTH * DECB * 4 * 128 * 64;
constexpr size_t O_RET_S = O_SCONV_S + (size_t)DEPTH * DECB * 3 * 768;
constexpr size_t O_END = O_RET_S + (size_t)DEPTH * DECB * 4 * 64 * 64;

struct Params {
    const float* x_prompt; const float* x_sample;
    const float* st_hgrn; const float* st_gdn; const float* st_gconv; const float* st_ssd; const float* st_sconv; const float* st_ret;
    const float* meta; const float* norm_w; const float* w_in; const float* lb_logits; const float* hgrn_norm_w;
    const float* gdn_conv_w; const float* gdn_a_log; const float* gdn_dt_bias; const float* gdn_norm_w;
    const float* ssd_conv_w; const float* ssd_conv_b; const float* ssd_a_log; const float* ssd_dt_bias; const float* ssd_d; const float* ssd_norm_w;
    const float* ret_norm_w; const float* ret_norm_b; const float* w_out; const float* final_norm_w;
    float* out; unsigned char* ws;
};

__device__ __forceinline__ float bf2f(bf16_t b) { return __uint_as_float(((unsigned)b) << 16); }
__device__ __forceinline__ bf16_t f2bf(float f) { unsigned u = __float_as_uint(f); u += 0x7FFFu + ((u >> 16) & 1u); return (bf16_t)(u >> 16); }
__device__ __forceinline__ unsigned pack_bf2(float lo, float hi) { return (unsigned)f2bf(lo) | ((unsigned)f2bf(hi) << 16); }
__device__ __forceinline__ float sigmoid_f(float x) { return 1.0f / (1.0f + __expf(-x)); }
__device__ __forceinline__ float silu_f(float x) { return x / (1.0f + __expf(-x)); }
__device__ __forceinline__ float softplus_f(float x) { return x > 20.0f ? x : log1pf(__expf(x)); }
__device__ __forceinline__ int opaque_tid() { int t = threadIdx.x; asm volatile("" : "+v"(t)); return t; }
__device__ __forceinline__ float lane_xor(float v, int k, int lane) { return __int_as_float(__builtin_amdgcn_ds_bpermute((lane ^ k) << 2, __float_as_int(v))); }
__device__ __forceinline__ float lane_up(float v, int k, int lane) { return __int_as_float(__builtin_amdgcn_ds_bpermute(((lane - k) & 63) << 2, __float_as_int(v))); }
__device__ __forceinline__ float wave_sum(float v, int lane) {
#pragma unroll
    for (int o = 32; o > 0; o >>= 1) v += lane_xor(v, o, lane);
    return v;
}


#define XB_TMO      128
#define XB_XCNT(j)  (256  + 64 * (j))
#define XB_XSUB(j)  (1280 + 64 * (j))
#define XB_XGEN(j)  (2304 + 64 * (j))
#define XB_TOP      3328
#define XB_TOPGEN   3392
#define XCD_BAR_WORDS 3456
#define XB_SPIN_CAP (1u << 22)
__device__ __forceinline__ unsigned xb_ld(unsigned* p)              { return __hip_atomic_load(p, __ATOMIC_RELAXED, __HIP_MEMORY_SCOPE_AGENT); }
__device__ __forceinline__ unsigned xb_add(unsigned* p, unsigned v) { return __hip_atomic_fetch_add(p, v, __ATOMIC_RELAXED, __HIP_MEMORY_SCOPE_AGENT); }
__device__ __forceinline__ unsigned xb_xcc_id() { return (unsigned)__builtin_amdgcn_s_getreg((3 << 11) | 20) & 0xFu; }
#define XB_SPIN(cond, bar) do { unsigned _sp = 0; while (cond) { __builtin_amdgcn_s_sleep(1); \
    if ((++_sp & 255u) == 0u) { if (xb_ld(&(bar)[XB_TMO])) break; if (_sp > XB_SPIN_CAP) { atomicAdd(&(bar)[XB_TMO], 1u); break; } } } } while (0)
struct XcdBarrier { unsigned* bar; unsigned x; volatile LAS unsigned* st; };
__device__ __forceinline__ XcdBarrier xcd_barrier_post(unsigned* bar, volatile LAS unsigned* st) {
    XcdBarrier b; b.bar = bar; b.x = xb_xcc_id(); b.st = st;
    if (threadIdx.x == 0) (void)xb_add(&bar[XB_XCNT(b.x)], 1u);
    return b;
}
__device__ __forceinline__ void xcd_barrier_complete(unsigned* bar, unsigned x, unsigned& nloc, unsigned& nx) {
    const unsigned G = gridDim.x * gridDim.y * gridDim.z;
    unsigned sum, cnt, mine, sp = 0u;
    for (;;) {
        sum = 0u; cnt = 0u; mine = 0u;
#pragma unroll
        for (unsigned j = 0; j < 16; ++j) { const unsigned c = xb_ld(&bar[XB_XCNT(j)]); sum += c; cnt += (c > 0u) ? 1u : 0u; mine = (j == x) ? c : mine; }
        if (sum == G) break;
        __builtin_amdgcn_s_sleep(1);
        if ((++sp & 255u) == 0u) { if (xb_ld(&bar[XB_TMO])) break; if (sp > XB_SPIN_CAP) { atomicAdd(&bar[XB_TMO], 1u); break; } }
    }
    nloc = mine > 0u ? mine : 1u; nx = cnt > 0u ? cnt : 1u;
}
__device__ __forceinline__ void xcd_barrier(const XcdBarrier& b0) {
    asm volatile("s_waitcnt vmcnt(0)" ::: "memory");
    __syncthreads();
    if (threadIdx.x == 0) {
        XcdBarrier b = b0; { unsigned x = xb_xcc_id(); asm volatile("" : "+s"(x)); b.x = x; }
        unsigned* bar = b.bar;
        __builtin_amdgcn_s_waitcnt(0);
        unsigned nloc = b.st[0], nx = b.st[1];
        if (nloc == 0u) { xcd_barrier_complete(bar, b.x, nloc, nx); b.st[0] = nloc; b.st[1] = nx; }
        const unsigned old = xb_add(&bar[XB_XSUB(b.x)], 1u);
        const unsigned gen = old / nloc;
        if (old + 1u == (gen + 1u) * nloc) {
            __builtin_amdgcn_fence(__ATOMIC_RELEASE, "agent");
            asm volatile("s_waitcnt vmcnt(0)" ::: "memory");
            const unsigned og = xb_add(&bar[XB_TOP], 1u);
            const unsigned tg = og / nx;
            if (og + 1u == (tg + 1u) * nx) xb_add(&bar[XB_TOPGEN], 1u);
            else XB_SPIN(xb_ld(&bar[XB_TOPGEN]) == tg, bar);
            __builtin_amdgcn_fence(__ATOMIC_ACQUIRE, "agent");
            xb_add(&bar[XB_XGEN(b.x)], 1u);
            asm volatile("s_waitcnt vmcnt(0)" ::: "memory");
        } else {
            XB_SPIN(xb_ld(&bar[XB_XGEN(b.x)]) == gen, bar);
            __builtin_amdgcn_fence(__ATOMIC_ACQUIRE, "agent");
            asm volatile("s_waitcnt vmcnt(0)" ::: "memory");
        }
    }
    __syncthreads();
}

namespace pg8 {
constexpr int BM = 256, BK = 64, HALF = 128, HTB = HALF * BK * 2, STAGE_BYTES = 8 * HTB, NXCD = 8, WGM = 8;
__host__ __device__ __forceinline__ int lds_byte(int r, int c) { const int st = (r >> 4) * 2 + (c >> 5), rr = r & 15, cc = c & 31, ob = rr * 64 + cc * 2; return st * 1024 + (ob ^ (((ob >> 9) & 1) << 5)); }
__host__ __device__ __forceinline__ void stage_rc(int b, int& R, int& C) { const int st = b / 1024, sb = b % 1024, swz = sb ^ (((sb >> 9) & 1) << 5); R = (st >> 1) * 16 + swz / 64; C = (st & 1) * 32 + (swz % 64) / 2; }
__host__ __device__ __forceinline__ int perm32(int rho) { const int n = rho >> 4, i = rho & 15; return 8 * (i >> 2) + 4 * n + (i & 3); }
struct Unit { int pm, pn; };
struct Gemm { const bf16_t* A; const bf16_t* Bt; int M, N, K; };
struct StaticOrder {
    int nM, nN, nwg, G, c;
    __host__ __device__ void init(int M, int N, int G_, int c_) { nM = M / BM; nN = N / BM; nwg = nM * nN; G = G_; c = c_; }
    __host__ __device__ bool next(int i, Unit& u) const {
        const long L = (long)i * G + c; if (L >= nwg) return false;
        int wgid = (int)L; { const int q = nwg / NXCD, r = nwg % NXCD, xcd = wgid % NXCD, off = wgid / NXCD; wgid = (xcd < r ? xcd * (q + 1) : r * (q + 1) + (xcd - r) * q) + off; }
        const int nig = WGM * nN, gid = wgid / nig, fm = gid * WGM, gsz = (nM - fm) < WGM ? (nM - fm) : WGM;
        u.pm = fm + ((wgid % nig) % gsz); u.pn = (wgid % nig) / gsz; return true;
    }
    __device__ __forceinline__ void a_ready(const Unit&) const {}
    __device__ __forceinline__ void done(const Unit&) const {}
};
typedef float f32x2_t __attribute__((ext_vector_type(2)));
typedef __bf16 bf16x2n_t __attribute__((ext_vector_type(2)));
__device__ __forceinline__ unsigned cvt_pk_bf16(float lo, float hi) { const f32x2_t f = {lo, hi}; return __builtin_bit_cast(unsigned, __builtin_convertvector(f, bf16x2n_t)); }

struct EpiProj {
    static constexpr bool PERM = true, AFTER_DRAIN = false;
    bf16_t* O; int ldc; const float* rs;
    __device__ __forceinline__ void operator()(const f32x4 (&acc)[2][2][4][2], const Unit& u, int wr, int wc, int fr, int fq) const {
        const int row0 = u.pm * BM + wr * 64 + fr; const int col0 = u.pn * BM + wc * 32 + 8 * fq;
#pragma unroll
        for (int ai = 0; ai < 2; ++ai)
#pragma unroll
            for (int m = 0; m < 4; ++m) { const int row = row0 + ai * HALF + m * 16; const float s = rs[row]; bf16_t* rowp = O + (size_t)row * ldc + col0;
#pragma unroll
                for (int bj = 0; bj < 2; ++bj) { const f32x4 v0 = acc[ai][bj][m][0] * s, v1 = acc[ai][bj][m][1] * s;
                    u32x4 w; w.x = cvt_pk_bf16(v0[0], v0[1]); w.y = cvt_pk_bf16(v0[2], v0[3]); w.z = cvt_pk_bf16(v1[0], v1[1]); w.w = cvt_pk_bf16(v1[2], v1[3]);
                    *(u32x4*)(rowp + bj * HALF) = w; } }
    }
};
struct EpiResid {
    static constexpr bool PERM = false, AFTER_DRAIN = false;
    float* C; int ldc;
    __device__ __forceinline__ void operator()(const f32x4 (&acc)[2][2][4][2], const Unit& u, int wr, int wc, int fr, int fq) const {
        const int row0 = u.pm * BM + wr * 64 + fr, col0 = u.pn * BM + wc * 32 + 4 * fq;
#pragma unroll
        for (int ai = 0; ai < 2; ++ai)
#pragma unroll
            for (int m = 0; m < 4; ++m) { float* rowp = C + (size_t)(row0 + ai * HALF + m * 16) * ldc + col0;
#pragma unroll
                for (int bj = 0; bj < 2; ++bj)
#pragma unroll
                    for (int n = 0; n < 2; ++n) { f32x4* p = (f32x4*)(rowp + bj * HALF + n * 16); *p = *p + acc[ai][bj][m][n]; } }
    }
};

template <class Epi, class Sched>
__device__ __forceinline__ void gemm_phase(LAS unsigned char* lds, const Gemm g, const Sched& S, const Epi& E) {
    const int tid = opaque_tid(), wid = __builtin_amdgcn_readfirstlane(tid >> 6), lane = tid & 63, wr = wid >> 2, wc = wid & 3, fr = lane & 15, fq = lane >> 4;
    const int K = g.K, nt = K / BK;
    unsigned voffA[2], voffB[2];
#pragma unroll
    for (int i = 0; i < 2; ++i) { int R, C; stage_rc(tid * 16 + i * 8192, R, C); const int Rb = Epi::PERM ? ((R & ~31) + perm32(R & 31)) : R;
        voffA[i] = (unsigned)(R * K + C) * 2u; voffB[i] = (unsigned)(Rb * K + C) * 2u; }
    const size_t kstep = (size_t)(BK * 2);
    const size_t hstep = (size_t)HALF * K * 2;
    const size_t tstep = 2 * hstep;
    const unsigned ldsw = (unsigned)wid * 1024u;
    const int aoff = lds_byte(wr * 64 + fr, fq * 8), boff = lds_byte(wc * 32 + fr, fq * 8);
#define PG8_SA(b, h) (((b) * 2 + (h)) * HTB)
#define PG8_SB(b, h) ((4 + (b) * 2 + (h)) * HTB)
#define PG8_STAGE(bufoff, gbase, voff) do { _Pragma("unroll") for (int _i = 0; _i < 2; ++_i) \
        __builtin_amdgcn_global_load_lds((const unsigned*)((const char*)(gbase) + (voff)[_i]), (LAS unsigned*)(lds + (bufoff) + ldsw + _i * 8192), 16, 0, 0); } while (0)
#define PG8_LDA(dst, b, h) do { _Pragma("unroll") for (int m = 0; m < 4; ++m) _Pragma("unroll") for (int k = 0; k < 2; ++k) dst[m][k] = *(const LAS bf16x8*)(lds + PG8_SA(b, h) + aoff + m * 2048 + k * 1024); } while (0)
#define PG8_LDB(dst, b, h) do { _Pragma("unroll") for (int n = 0; n < 2; ++n) _Pragma("unroll") for (int k = 0; k < 2; ++k) dst[n][k] = *(const LAS bf16x8*)(lds + PG8_SB(b, h) + boff + n * 2048 + k * 1024); } while (0)
#define PG8_MMA(ai, bj, At, Bt) do { __builtin_amdgcn_s_setprio(1); _Pragma("unroll") for (int m = 0; m < 4; ++m) _Pragma("unroll") for (int n = 0; n < 2; ++n) _Pragma("unroll") for (int k = 0; k < 2; ++k) \
        acc[ai][bj][m][n] = __builtin_amdgcn_mfma_f32_16x16x32_bf16(Bt[n][k], At[m][k], acc[ai][bj][m][n], 0, 0, 0); __builtin_amdgcn_s_setprio(0); } while (0)
#define PG8_WAIT_V(n) asm volatile("s_waitcnt vmcnt(" #n ")" ::: "memory")
#define PG8_WAIT_L(n) asm volatile("s_waitcnt lgkmcnt(" #n ")" ::: "memory")
#define PG8_BAR __builtin_amdgcn_s_barrier()
#define PG8_SCHED __builtin_amdgcn_sched_barrier(0)
    Unit cur, nxt; int ui = 0;
    if (!S.next(0, cur)) return;
    f32x4 acc[2][2][4][2];
#pragma unroll
    for (int a = 0; a < 2; ++a)
#pragma unroll
        for (int b = 0; b < 2; ++b)
#pragma unroll
            for (int m = 0; m < 4; ++m)
#pragma unroll
                for (int n = 0; n < 2; ++n) acc[a][b][m][n] = (f32x4){0.f, 0.f, 0.f, 0.f};
    bf16x8 At[4][2], B0[2][2], B1[2][2];
    const char* cA = (const char*)g.A + (size_t)cur.pm * tstep; const char* cB = (const char*)g.Bt + (size_t)cur.pn * tstep;
    S.a_ready(cur);
    PG8_STAGE(PG8_SB(0, 0), cB, voffB); PG8_STAGE(PG8_SA(0, 0), cA, voffA); PG8_STAGE(PG8_SB(0, 1), cB + hstep, voffB); PG8_STAGE(PG8_SA(0, 1), cA + hstep, voffA);
    if (wr == 1) PG8_BAR;
    PG8_WAIT_V(4); PG8_BAR;
    PG8_STAGE(PG8_SB(1, 0), cB + kstep, voffB); PG8_STAGE(PG8_SA(1, 0), cA + kstep, voffA); PG8_STAGE(PG8_SB(1, 1), cB + hstep + kstep, voffB);
    PG8_WAIT_V(6); PG8_BAR;
    for (;;) {
        const bool has_next = S.next(ui + 1, nxt);
        const char* nA = has_next ? (const char*)g.A + (size_t)nxt.pm * tstep : cA; const char* nB = has_next ? (const char*)g.Bt + (size_t)nxt.pn * tstep : cB;
        for (int t = 0; t < nt; t += 2) {
            const bool last = (t == nt - 2);
            const char* a1 = cA + (size_t)(t + 1) * kstep;
            const char* a2 = last ? nA : cA + (size_t)(t + 2) * kstep; const char* b2 = last ? nB : cB + (size_t)(t + 2) * kstep;
            const char* a3 = a2 + kstep; const char* b3 = b2 + kstep;
            if (last && has_next) S.a_ready(nxt);
            PG8_LDB(B0, 0, 0); PG8_SCHED; PG8_LDA(At, 0, 0); PG8_STAGE(PG8_SA(1, 1), a1 + hstep, voffA);
            PG8_WAIT_L(8); PG8_BAR; PG8_WAIT_L(0); PG8_MMA(0, 0, At, B0); PG8_BAR; PG8_SCHED;
            PG8_LDB(B1, 0, 1); PG8_STAGE(PG8_SB(0, 0), b2, voffB);
            PG8_BAR; PG8_WAIT_L(0); PG8_MMA(0, 1, At, B1); PG8_BAR;
            PG8_LDA(At, 0, 1); PG8_STAGE(PG8_SA(0, 0), a2, voffA);
            PG8_BAR; PG8_WAIT_L(0); PG8_MMA(1, 0, At, B0); PG8_BAR; PG8_SCHED;
            PG8_STAGE(PG8_SB(0, 1), b2 + hstep, voffB);
            PG8_WAIT_V(6); PG8_BAR; PG8_MMA(1, 1, At, B1); PG8_BAR;
            PG8_LDB(B0, 1, 0); PG8_SCHED; PG8_LDA(At, 1, 0); PG8_STAGE(PG8_SA(0, 1), a2 + hstep, voffA);
            PG8_WAIT_L(8); PG8_BAR; PG8_WAIT_L(0); PG8_MMA(0, 0, At, B0); PG8_BAR; PG8_SCHED;
            PG8_LDB(B1, 1, 1); PG8_STAGE(PG8_SB(1, 0), b3, voffB);
            PG8_BAR; PG8_WAIT_L(0); PG8_MMA(0, 1, At, B1); PG8_BAR;
            PG8_LDA(At, 1, 1); PG8_STAGE(PG8_SA(1, 0), a3, voffA);
            PG8_BAR; PG8_WAIT_L(0); PG8_MMA(1, 0, At, B0); PG8_BAR; PG8_SCHED;
            PG8_STAGE(PG8_SB(1, 1), b3 + hstep, voffB);
            PG8_WAIT_V(6); PG8_BAR; PG8_MMA(1, 1, At, B1); PG8_BAR;
        }
        if constexpr (!Epi::AFTER_DRAIN) { E(acc, cur, wr, wc, fr, fq); S.done(cur); }
        if (!has_next) break;
#pragma unroll
        for (int a = 0; a < 2; ++a)
#pragma unroll
            for (int b = 0; b < 2; ++b)
#pragma unroll
                for (int m = 0; m < 4; ++m)
#pragma unroll
                    for (int n = 0; n < 2; ++n) acc[a][b][m][n] = (f32x4){0.f, 0.f, 0.f, 0.f};
        cur = nxt; cA = nA; cB = nB; ++ui;
    }
    PG8_WAIT_V(0);
    if (wr == 0) PG8_BAR;
    PG8_BAR;
#undef PG8_SA
#undef PG8_SB
#undef PG8_STAGE
#undef PG8_LDA
#undef PG8_LDB
#undef PG8_MMA
#undef PG8_WAIT_V
#undef PG8_WAIT_L
#undef PG8_BAR
#undef PG8_SCHED
}
}

__device__ __forceinline__ int win_col(int n) { return n < 2048 ? n : (n < 3072 ? n + 8 : n + 12); }
__device__ __forceinline__ int win_smcol(int j) { return j < 8 ? 2048 + j : 3080 + (j - 8); }

__device__ void ph_prep(const Params& p_in, LAS unsigned char* lds_in, int blk, int nblk) {
    Params p = p_in; asm volatile("" : "+s"(p.ws), "+s"(p.out));
    LAS unsigned char* lds = lds_in; asm volatile("" : "+s"(lds));

    const int tid = opaque_tid();
    LAS float* tile = (LAS float*)lds;
    const int tiles_in = DEPTH * 64 * 16, tiles_out = DEPTH * 16 * 16;
    for (int t = blk; t < tiles_in + tiles_out; t += nblk) {
        const float* src; bf16_t* dst; int ld, n0, k0, l; const float* scale;
        if (t < tiles_in) { l = t / 1024; const int r = t % 1024; n0 = (r / 16) * 64; k0 = (r % 16) * 64; src = p.w_in + (size_t)l * DM * IN_DIM + win_col(n0); ld = IN_DIM;
            dst = (bf16_t*)(p.ws + WS_WINT) + (size_t)l * NBIG * DM; scale = p.norm_w + l * DM; }
        else { const int tt = t - tiles_in; l = tt / 256; const int r = tt % 256; n0 = (r / 16) * 64; k0 = (r % 16) * 64; src = p.w_out + (size_t)l * DM * DM + n0; ld = DM;
            dst = (bf16_t*)(p.ws + WS_WOUTT) + (size_t)l * DM * DM; scale = nullptr; }
        __syncthreads();
        for (int e = tid; e < 64 * 64; e += 512) { const int kk = e >> 6, nn = e & 63; float v = src[(size_t)(k0 + kk) * ld + nn]; if (scale) v *= scale[k0 + kk]; tile[kk * 65 + nn] = v; }
        __syncthreads();
        for (int e = tid; e < 64 * 32; e += 512) { const int nn = e >> 5, kp = (e & 31) * 2; const unsigned w = pack_bf2(tile[kp * 65 + nn], tile[(kp + 1) * 65 + nn]);
            *(unsigned*)(dst + (size_t)(n0 + nn) * DM + k0 + kp) = w; }
    }
    for (int e = blk * 512 + tid; e < DEPTH * NSM * DM; e += nblk * 512) { const int l = e / (NSM * DM), r = e % (NSM * DM), j = r / DM, k = r % DM;
        ((float*)(p.ws + WS_WSM))[e] = p.w_in[(size_t)l * DM * IN_DIM + (size_t)k * IN_DIM + win_smcol(j)] * p.norm_w[l * DM + k]; }
    for (int c = blk * 512 + tid; c < 256; c += nblk * 512) { float lg[DEPTH], mx = -1e30f;
#pragma unroll
        for (int l = 0; l < DEPTH; ++l) { lg[l] = p.lb_logits[l * 256 + c]; mx = fmaxf(mx, lg[l]); }
        float s = 0.f;
#pragma unroll
        for (int l = 0; l < DEPTH; ++l) { lg[l] = expf(lg[l] - mx); s += lg[l]; }
        float cum = 0.f; const float w0 = lg[0] / s;
#pragma unroll
        for (int l = 0; l < DEPTH; ++l) { cum += lg[l] / s; ((float*)(p.ws + WS_LB))[l * 256 + c] = fmaxf(cum - w0, 0.f); } }
    for (int e = blk * 512 + tid; e < (TP + 1) * 32; e += nblk * 512) { const int pi = e >> 5, i = e & 31; const double pos = pi < TP ? (double)pi : (double)PASTLEN;
        const float invf = (float)(1.0 / pow(10000.0, (double)((float)i / 31.0f)));
        const double rev = pos * (double)invf * 0.15915494309189535; const float fr = (float)(rev - rint(rev));
        ((float*)(p.ws + WS_ROT))[e * 2 + 0] = __builtin_amdgcn_cosf(fr); ((float*)(p.ws + WS_ROT))[e * 2 + 1] = __builtin_amdgcn_sinf(fr); }
    float* h = (float*)(p.ws + WS_H);
    for (int e = blk * 512 + tid; e < MROWS * (DM / 4); e += nblk * 512) { const int row = e >> 8, c4 = (e & 255) * 4; const float* src;
        if (row < MP) { const int b = row / TP, t = row % TP; src = t < NMETA ? p.meta + t * DM : p.x_prompt + ((size_t)b * SEQ + (t - NMETA)) * DM; } else src = p.x_sample + (size_t)(row - MP) * DM;
        *(f32x4*)(h + (size_t)row * DM + c4) = *(const f32x4*)(src + c4); }
}

__device__ void ph_rownorm(const Params& p_in, int layer, int blk, int nblk) {
    Params p = p_in; asm volatile("" : "+s"(p.ws), "+s"(p.out));

    const int tid = opaque_tid(), wid = tid >> 6, lane = tid & 63;
    const float* h = (const float*)(p.ws + WS_H); bf16_t* hb = (bf16_t*)(p.ws + WS_HB); float* rs = (float*)(p.ws + WS_RS); float* psm = (float*)(p.ws + WS_PSM);
    const float* wsm = (const float*)(p.ws + WS_WSM) + (size_t)layer * NSM * DM;
    for (int row = blk * 8 + wid; row < MROWS; row += nblk * 8) {
        f32x4 v[4]; float ss = 0.f;
#pragma unroll
        for (int j = 0; j < 4; ++j) { v[j] = *(const f32x4*)(h + (size_t)row * DM + j * 256 + lane * 4); ss += v[j][0] * v[j][0] + v[j][1] * v[j][1] + v[j][2] * v[j][2] + v[j][3] * v[j][3]; }
        ss = wave_sum(ss, lane); const float r = rsqrtf(ss * (1.0f / DM) + EPSF);
#pragma unroll
        for (int j = 0; j < 4; ++j) { u32x2 w; w.x = pack_bf2(v[j][0], v[j][1]); w.y = pack_bf2(v[j][2], v[j][3]); *(u32x2*)(hb + (size_t)row * DM + j * 256 + lane * 4) = w; }
        float mine = 0.f;
        for (int q = 0; q < NSM; ++q) { float d = 0.f;
#pragma unroll
            for (int j = 0; j < 4; ++j) { const f32x4 w = *(const f32x4*)(wsm + q * DM + j * 256 + lane * 4); d += v[j][0] * w[0] + v[j][1] * w[1] + v[j][2] * w[2] + v[j][3] * w[3]; }
            d = wave_sum(d, lane); if (lane == q) mine = d * r; }
        if (lane < NSM) psm[(size_t)row * NSM + lane] = mine;
        if (lane == 0) rs[row] = r;
    }
}

__device__ void ph_gemm_in(const Params& p_in, int layer, LAS unsigned char* lds_in, int blk, int nblk) {
    Params p = p_in; asm volatile("" : "+s"(p.ws), "+s"(p.out));
    LAS unsigned char* lds = lds_in; asm volatile("" : "+s"(lds));

    pg8::Gemm g{(const bf16_t*)(p.ws + WS_HB), (const bf16_t*)(p.ws + WS_WINT) + (size_t)layer * NBIG * DM, MROWS, NBIG, DM};
    pg8::StaticOrder S; S.init(MROWS, NBIG, nblk, blk);
    pg8::EpiProj E{(bf16_t*)(p.ws + WS_PROJ), NBIG, (const float*)(p.ws + WS_RS)};
    pg8::gemm_phase<pg8::EpiProj, pg8::StaticOrder>(lds, g, S, E);
}
__device__ void ph_gemm_out(const Params& p_in, int layer, LAS unsigned char* lds_in, int blk, int nblk) {
    Params p = p_in; asm volatile("" : "+s"(p.ws), "+s"(p.out));
    LAS unsigned char* lds = lds_in; asm volatile("" : "+s"(lds));

    pg8::Gemm g{(const bf16_t*)(p.ws + WS_Y), (const bf16_t*)(p.ws + WS_WOUTT) + (size_t)layer * DM * DM, MROWS, DM, DM};
    pg8::StaticOrder S; S.init(MROWS, DM, nblk, blk);
    pg8::EpiResid E{(float*)(p.ws + WS_H), DM};
    pg8::gemm_phase<pg8::EpiResid, pg8::StaticOrder>(lds, g, S, E);
}

constexpr int TB = 16;
struct MixLds {
    static constexpr int QS = 0, KS = QS + TB * 128, VS = KS + TB * 128, DS = VS + TB * 128, ZS = DS + TB * 128, XS = ZS + TB * 128, OS = XS + TB * 128, BS = OS + TB * 128, SC = BS + TB * 2, END = SC + TB * 2;
};

struct SeqInfo { int row0, T, dec, b; };
__device__ __forceinline__ SeqInfo seq_info(int s) { SeqInfo q; if (s < NB) { q.row0 = s * TP; q.T = TP; q.dec = 0; q.b = s; } else { q.row0 = MP + (s - NB); q.T = 1; q.dec = 1; q.b = s - NB; } return q; }

__device__ __forceinline__ float preconv(const bf16_t* proj, const SeqInfo& q, int t, int col, const float* ctx  , int ch) {
    if (t >= 0) return bf2f(proj[(size_t)(q.row0 + t) * NBIG + col]);
    return ctx ? ctx[(3 + t) * 768 + ch] : 0.f;
}

template <int DK, int NV, bool DELTA, bool VECDEC>
__device__ __forceinline__ void recur_batch(float (&S)[DK / (64 / NV)], LAS float* L, int nb, int wid, int lane) {
    constexpr int KQ = 64 / NV, KR = DK / KQ, DVT = 8 * NV;
    const int kq = lane / NV, vv = lane % NV, vcol = wid * NV + vv, hh = vcol >> 6;
    for (int t = 0; t < nb; ++t) {
        float kk[KR], qq[KR];
#pragma unroll
        for (int i = 0; i < KR; ++i) { kk[i] = L[MixLds::KS + t * 128 + kq * KR + i]; qq[i] = L[MixLds::QS + t * 128 + kq * KR + i]; }
        const float v = L[MixLds::VS + t * 128 + vcol];
        if (DELTA) {
            const float dec = L[MixLds::DS + t * 128 + hh]; float pk = 0.f;
#pragma unroll
            for (int i = 0; i < KR; ++i) { S[i] *= dec; pk += kk[i] * S[i]; }
#pragma unroll
            for (int o = NV; o < 64; o <<= 1) pk += lane_xor(pk, o, lane);
            const float u = L[MixLds::BS + t] * (v - pk);
#pragma unroll
            for (int i = 0; i < KR; ++i) S[i] += kk[i] * u;
        } else if (VECDEC) {
#pragma unroll
            for (int i = 0; i < KR; ++i) S[i] = L[MixLds::DS + t * 128 + kq * KR + i] * S[i] + kk[i] * v;
        } else {
            const float dec = L[MixLds::DS + t * 128 + hh];
#pragma unroll
            for (int i = 0; i < KR; ++i) S[i] = dec * S[i] + kk[i] * v;
        }
        float po = 0.f;
#pragma unroll
        for (int i = 0; i < KR; ++i) po += qq[i] * S[i];
#pragma unroll
        for (int o = NV; o < 64; o <<= 1) po += lane_xor(po, o, lane);
        if (kq == 0) L[MixLds::OS + t * 128 + vcol] = po;
    }
    (void)DVT;
}

template <int MIX>
__device__ void mixer_item(const Params& p, int layer, int s, int hu  , LAS float* L) {
    constexpr int DK = MIX == 2 ? 128 : 64, NV = MIX == 2 ? 16 : 8, KQ = 64 / NV, KR = DK / KQ, DVT = 8 * NV;
    const int tid = opaque_tid(), wid = tid >> 6, lane = tid & 63;
    const SeqInfo q = seq_info(s);
    const bf16_t* proj = (const bf16_t*)(p.ws + WS_PROJ); const float* psm = (const float*)(p.ws + WS_PSM); bf16_t* y = (bf16_t*)(p.ws + WS_Y);
    const float* lb = (const float*)(p.ws + WS_LB) + layer * 256; const float* rot = (const float*)(p.ws + WS_ROT);
    const int kq = lane / NV, vv = lane % NV, vcol = wid * NV + vv, hh = vcol >> 6;
    const int head = MIX == 2 ? hu * 2 + hh : hu;
    const float* ctx = nullptr; const float* cw = nullptr;
    if (MIX == 1) { cw = p.gdn_conv_w + (size_t)layer * 4 * 768; if (q.dec) ctx = p.st_gconv + ((size_t)layer * DECB + q.b) * 3 * 768; }
    if (MIX == 2) { cw = p.ssd_conv_w + (size_t)layer * 4 * 768; if (q.dec) ctx = p.st_sconv + ((size_t)layer * DECB + q.b) * 3 * 768; }
    float S[KR];
    {
        const float* st = MIX == 0 ? p.st_hgrn : MIX == 1 ? p.st_gdn : MIX == 2 ? p.st_ssd : p.st_ret;
#pragma unroll
        for (int i = 0; i < KR; ++i) S[i] = q.dec ? st[(((size_t)layer * DECB + q.b) * 4 + head) * DK * 64 + (size_t)(kq * KR + i) * 64 + (vcol & 63)] : 0.f;
    }
    float hc0 = 0.f, hc1 = 0.f;
    if (MIX == 1) { hc0 = -__expf(p.gdn_a_log[layer * 4 + hu]); hc1 = p.gdn_dt_bias[layer * 4 + hu]; }
    if (MIX == 3) { hc0 = 1.0f - exp2f(-5.0f - (float)hu); }

    for (int t0 = 0; t0 < q.T; t0 += TB) {
        const int nb = min(TB, q.T - t0);
        __syncthreads();
        if (MIX == 0) {
            for (int e = tid; e < nb * 64; e += 512) { const int t = e >> 6, d = e & 63, c = hu * 64 + d; const bf16_t* pr = proj + (size_t)(q.row0 + t0 + t) * NBIG;
                const float aq = bf2f(pr[PC_AQ + c]), af = bf2f(pr[PC_AF + c]), ai = bf2f(pr[PC_AI + c]), az = bf2f(pr[PC_AZ + c]), l_ = lb[c];
                L[MixLds::QS + t * 128 + d] = silu_f(aq) * 0.125f; L[MixLds::KS + t * 128 + d] = (1.0f - l_) * sigmoid_f(-af); L[MixLds::DS + t * 128 + d] = l_ + (1.0f - l_) * sigmoid_f(af);
                L[MixLds::VS + t * 128 + d] = ai; L[MixLds::ZS + t * 128 + d] = az; }
        } else if (MIX == 1) {
            for (int e = tid; e < nb * 192; e += 512) { const int t = e / 192, r = e % 192, part = r >> 6, d = r & 63, ch = part * 256 + hu * 64 + d, col = PC_BQKV + ch; const int tt = t0 + t;
                float a = 0.f;
#pragma unroll
                for (int j = 0; j < 4; ++j) a += cw[j * 768 + ch] * preconv(proj, q, tt - 3 + j, col, ctx, ch);
                a = silu_f(a);
                L[(part == 0 ? MixLds::QS : part == 1 ? MixLds::KS : MixLds::VS) + t * 128 + d] = a; }
            for (int e = tid; e < nb * 64; e += 512) { const int t = e >> 6, d = e & 63; L[MixLds::ZS + t * 128 + d] = bf2f(proj[(size_t)(q.row0 + t0 + t) * NBIG + PC_BZ + hu * 64 + d]); }
            if (tid < nb) { const float* ps = psm + (size_t)(q.row0 + t0 + tid) * NSM; const float g = hc0 * softplus_f(ps[hu] + hc1);
                L[MixLds::DS + tid * 128 + 0] = __expf(g); L[MixLds::BS + tid] = sigmoid_f(ps[4 + hu]); }
            __syncthreads();
            if (tid < nb * 2) { const int t = tid >> 1, which = tid & 1; const LAS float* src = L + (which ? MixLds::KS : MixLds::QS) + t * 128; float ss = 0.f;
                for (int d = 0; d < 64; ++d) ss += src[d] * src[d];
                L[MixLds::SC + tid] = rsqrtf(ss + EPSF) * (which ? 1.0f : 0.125f); }
            __syncthreads();
            for (int e = tid; e < nb * 128; e += 512) { const int t = e >> 7, r = e & 127, which = r >> 6, d = r & 63; L[(which ? MixLds::KS : MixLds::QS) + t * 128 + d] *= L[MixLds::SC + t * 2 + which]; }
        } else if (MIX == 2) {
            if (tid < nb * 2) { const int t = tid >> 1, h2 = tid & 1, hd = hu * 2 + h2; const float dt = softplus_f(psm[(size_t)(q.row0 + t0 + t) * NSM + 8 + hd] + p.ssd_dt_bias[layer * 4 + hd]);
                L[MixLds::BS + tid] = dt; L[MixLds::DS + t * 128 + h2] = __expf(-dt * __expf(p.ssd_a_log[layer * 4 + hd])); }
            __syncthreads();
            for (int e = tid; e < nb * 384; e += 512) { const int t = e / 384, r = e % 384, part = r >> 7, j = r & 127, ch = part * 256 + hu * 128 + j, col = PC_CXBC + ch; const int tt = t0 + t;
                float a = p.ssd_conv_b[layer * 768 + ch];
#pragma unroll
                for (int jj = 0; jj < 4; ++jj) a += cw[jj * 768 + ch] * preconv(proj, q, tt - 3 + jj, col, ctx, ch);
                a = silu_f(a);
                if (part == 0) { L[MixLds::XS + t * 128 + j] = a; L[MixLds::VS + t * 128 + j] = a * L[MixLds::BS + t * 2 + (j >> 6)]; }
                else if (part == 1) L[MixLds::KS + t * 128 + j] = a; else L[MixLds::QS + t * 128 + j] = a; }
            for (int e = tid; e < nb * 128; e += 512) { const int t = e >> 7, j = e & 127; L[MixLds::ZS + t * 128 + j] = bf2f(proj[(size_t)(q.row0 + t0 + t) * NBIG + PC_CZ + hu * 128 + j]); }
        } else {
            for (int e = tid; e < nb * 32; e += 512) { const int t = e >> 5, i = e & 31; const bf16_t* pr = proj + (size_t)(q.row0 + t0 + t) * NBIG; const int pidx = q.dec ? TP : (t0 + t);
                const float cs = rot[(pidx * 32 + i) * 2], sn = rot[(pidx * 32 + i) * 2 + 1];
                const float q1 = bf2f(pr[PC_DQ + hu * 64 + i]), q2 = bf2f(pr[PC_DQ + hu * 64 + 32 + i]), k1 = bf2f(pr[PC_DK + hu * 64 + i]), k2 = bf2f(pr[PC_DK + hu * 64 + 32 + i]);
                L[MixLds::QS + t * 128 + i] = q1 * cs - q2 * sn; L[MixLds::QS + t * 128 + 32 + i] = q2 * cs + q1 * sn;
                L[MixLds::KS + t * 128 + i] = (k1 * cs - k2 * sn) * 0.125f; L[MixLds::KS + t * 128 + 32 + i] = (k2 * cs + k1 * sn) * 0.125f; }
            for (int e = tid; e < nb * 64; e += 512) { const int t = e >> 6, d = e & 63; const bf16_t* pr = proj + (size_t)(q.row0 + t0 + t) * NBIG;
                L[MixLds::VS + t * 128 + d] = bf2f(pr[PC_DV + hu * 64 + d]); L[MixLds::ZS + t * 128 + d] = bf2f(pr[PC_DZ + hu * 64 + d]); }
            if (tid < nb) L[MixLds::DS + tid * 128] = hc0;
        }
        __syncthreads();
        recur_batch<DK, NV, MIX == 1, MIX == 0>(S, L, nb, wid, lane);
        __syncthreads();
        for (int t = wid; t < nb; t += 8) {
            const size_t yrow = (size_t)(q.row0 + t0 + t) * DM;
            if (MIX == 0 || MIX == 1) { const float o = L[MixLds::OS + t * 128 + lane]; const float ms = wave_sum(o * o, lane) * (1.0f / 64.0f);
                const float w = (MIX == 0 ? p.hgrn_norm_w : p.gdn_norm_w)[layer * 256 + hu * 64 + lane];
                y[yrow + (MIX == 0 ? 0 : 256) + hu * 64 + lane] = f2bf(o * rsqrtf(ms + EPSF) * w * silu_f(L[MixLds::ZS + t * 128 + lane])); }
            else if (MIX == 2) { float u[2]; float ss = 0.f;
#pragma unroll
                for (int r = 0; r < 2; ++r) { const int j = lane + 64 * r; const float o = L[MixLds::OS + t * 128 + j] + p.ssd_d[layer * 4 + hu * 2 + r] * L[MixLds::XS + t * 128 + j]; u[r] = o * silu_f(L[MixLds::ZS + t * 128 + j]); ss += u[r] * u[r]; }
                const float sc = rsqrtf(wave_sum(ss, lane) * (1.0f / 128.0f) + EPSF);
#pragma unroll
                for (int r = 0; r < 2; ++r) { const int j = lane + 64 * r; y[yrow + 512 + hu * 128 + j] = f2bf(u[r] * sc * p.ssd_norm_w[layer * 256 + hu * 128 + j]); } }
            else { const float o = L[MixLds::OS + t * 128 + lane]; const float mu = wave_sum(o, lane) * (1.0f / 64.0f); const float dv = o - mu; const float var = wave_sum(dv * dv, lane) * (1.0f / 64.0f);
                const int c = hu * 64 + lane;
                y[yrow + 768 + c] = f2bf((dv * rsqrtf(var + EPSF) * p.ret_norm_w[layer * 256 + c] + p.ret_norm_b[layer * 256 + c]) * silu_f(L[MixLds::ZS + t * 128 + lane])); }
        }
    }
    {
        float* so = p.out + (q.dec ? (MIX == 0 ? O_HGRN_S : MIX == 1 ? O_GDN_S : MIX == 2 ? O_SSD_S : O_RET_S) : (MIX == 0 ? O_HGRN_P : MIX == 1 ? O_GDN_P : MIX == 2 ? O_SSD_P : O_RET_P));
        const int nbt = q.dec ? DECB : NB;
#pragma unroll
        for (int i = 0; i < KR; ++i) so[(((size_t)layer * nbt + q.b) * 4 + head) * DK * 64 + (size_t)(kq * KR + i) * 64 + (vcol & 63)] = S[i];
    }
    if (MIX == 1 || MIX == 2) {
        float* co = p.out + (q.dec ? (MIX == 1 ? O_GCONV_S : O_SCONV_S) : (MIX == 1 ? O_GCONV_P : O_SCONV_P)) + ((size_t)layer * (q.dec ? DECB : NB) + q.b) * 3 * 768;
        const int nch = MIX == 1 ? 192 : 384;
        for (int e = tid; e < 3 * nch; e += 512) { const int r = e / nch, c = e % nch; int ch;
            if (MIX == 1) ch = (c >> 6) * 256 + hu * 64 + (c & 63); else ch = (c >> 7) * 256 + hu * 128 + (c & 127);
            co[r * 768 + ch] = preconv(proj, q, q.T - 3 + r, (MIX == 1 ? PC_BQKV : PC_CXBC) + ch, ctx, ch); }
    }
    (void)DVT;
}

constexpr int NCHUNK = 33;
constexpr int LDP = 72;
constexpr int LDP2 = 136;
constexpr int OSP = 68;
typedef short bf16x4 __attribute__((ext_vector_type(4)));
__device__ __forceinline__ f32x4 mfma16(bf16x8 a, bf16x8 b, f32x4 c) { return __builtin_amdgcn_mfma_f32_16x16x32_bf16(a, b, c, 0, 0, 0); }
__device__ __forceinline__ float fexp2(float x) { return __builtin_amdgcn_exp2f(x); }
__device__ __forceinline__ bf16x8 frag_ld(const LAS bf16_t* t, int pitch, int row, int col) { return *(const LAS bf16x8*)(t + row * pitch + col); }
__device__ __forceinline__ bf16x8 frag_ld_perm(const LAS bf16_t* t, int pitch, int row, int k0, int q) {
    const bf16x4 lo = *(const LAS bf16x4*)(t + row * pitch + k0 + 4 * q), hi = *(const LAS bf16x4*)(t + row * pitch + k0 + 16 + 4 * q);
    return __builtin_shufflevector(lo, hi, 0, 1, 2, 3, 4, 5, 6, 7);
}
__device__ __forceinline__ bf16x8 pack_acc2(const f32x4& a, const f32x4& b) {
    u32x4 w; w.x = pg8::cvt_pk_bf16(a[0], a[1]); w.y = pg8::cvt_pk_bf16(a[2], a[3]); w.z = pg8::cvt_pk_bf16(b[0], b[1]); w.w = pg8::cvt_pk_bf16(b[2], b[3]);
    return __builtin_bit_cast(bf16x8, w);
}
__device__ __forceinline__ void st_bf4(LAS bf16_t* dst, const f32x4& v) { u32x2 w; w.x = pg8::cvt_pk_bf16(v[0], v[1]); w.y = pg8::cvt_pk_bf16(v[2], v[3]); *(LAS u32x2*)dst = w; }
__device__ __forceinline__ void unpack_bf8(const u32x4& w, float* a) { const unsigned x[4] = {w.x, w.y, w.z, w.w};
#pragma unroll
    for (int k = 0; k < 4; ++k) { a[2 * k] = __uint_as_float(x[k] << 16); a[2 * k + 1] = __uint_as_float(x[k] & 0xffff0000u); } }
__device__ __forceinline__ u32x4 pack_bf8(const float* a) { u32x4 w; w.x = pg8::cvt_pk_bf16(a[0], a[1]); w.y = pg8::cvt_pk_bf16(a[2], a[3]); w.z = pg8::cvt_pk_bf16(a[4], a[5]); w.w = pg8::cvt_pk_bf16(a[6], a[7]); return w; }

constexpr size_t HR_QF = 0, HR_OI = 8192, HR_DS = 16384, HR_VEC = 24576, HR_UNIT = 25088;
constexpr size_t SS_QF = 0, SS_HEAD = 16384  , SS_VEC = 65536  , SS_UNIT = 66560;
constexpr size_t GD_U = 0, GD_W = 8192, GD_Q = 16384, GD_P = 24576, GD_K = 32768, GD_VEC = 40960, GD_UNIT = 41728;
constexpr size_t YOFF_S0 = 46661632;
static_assert((size_t)NB * NCHUNK * 4 * GD_UNIT <= YOFF_S0 && YOFF_S0 + (size_t)NB * NCHUNK * SS_UNIT <= (size_t)NB * SEQ * DM * 4 && (size_t)NB * NCHUNK * 4 * HR_UNIT <= (size_t)MROWS * DM * 2, "scratch map");
__device__ __forceinline__ unsigned char* rec_hgrn(const Params& p, int b, int c, int h) { return p.ws + WS_HB + (size_t)((b * NCHUNK + c) * 4 + h) * HR_UNIT; }
__device__ __forceinline__ unsigned char* rec_ret(const Params& p, int b, int c, int h) { return (unsigned char*)(p.out + O_YP) + (size_t)((b * NCHUNK + c) * 4 + h) * HR_UNIT; }
__device__ __forceinline__ unsigned char* rec_gdn(const Params& p, int b, int c, int h) { return (unsigned char*)(p.out + O_YP) + (size_t)((b * NCHUNK + c) * 4 + h) * GD_UNIT; }
__device__ __forceinline__ unsigned char* rec_ssd(const Params& p, int b, int c, int g) { return (g == 0 ? (unsigned char*)(p.out + O_YP) + YOFF_S0 : p.ws + WS_HB) + (size_t)(b * NCHUNK + c) * SS_UNIT; }
__device__ __forceinline__ bf16x8 frag_scale(const bf16x8& f, const float (&sc)[8]) { const u32x4 w = __builtin_bit_cast(u32x4, f); float a[8]; unpack_bf8(w, a);
#pragma unroll
    for (int e = 0; e < 8; ++e) a[e] *= sc[e];
    return __builtin_bit_cast(bf16x8, pack_bf8(a)); }
__device__ __forceinline__ void st_acc_bf4(unsigned char* dst, const f32x4& v) { u32x2 w; w.x = pg8::cvt_pk_bf16(v[0], v[1]); w.y = pg8::cvt_pk_bf16(v[2], v[3]); *(u32x2*)dst = w; }
__device__ __forceinline__ f32x4 ld_acc_bf4(const unsigned char* src) { const u32x2 w = *(const u32x2*)src; return (f32x4){__uint_as_float(w.x << 16), __uint_as_float(w.x & 0xffff0000u), __uint_as_float(w.y << 16), __uint_as_float(w.y & 0xffff0000u)}; }

struct RetLds { static constexpr int QS = 0, KS = QS + 64 * LDP * 2, KT = KS + 64 * LDP * 2, VT = KT + 64 * LDP * 2, VH = VT + 64 * LDP * 2, PS = VH + 64 * LDP * 2, END = PS + 64 * LDP * 2; };
__device__ void ret_pre_unit(const Params& p, int layer, int b, int c, int hu, LAS unsigned char* lds) {
    const int tid = opaque_tid(), wid = tid >> 6, lane = tid & 63, fq = lane >> 4, fc = lane & 15;
    LAS bf16_t* Qs = (LAS bf16_t*)(lds + RetLds::QS); LAS bf16_t* Ks = (LAS bf16_t*)(lds + RetLds::KS); LAS bf16_t* KT = (LAS bf16_t*)(lds + RetLds::KT);
    LAS bf16_t* VT = (LAS bf16_t*)(lds + RetLds::VT); LAS bf16_t* VH = (LAS bf16_t*)(lds + RetLds::VH); LAS bf16_t* Ps = (LAS bf16_t*)(lds + RetLds::PS);
    const bf16_t* proj = (const bf16_t*)(p.ws + WS_PROJ); const float* rot = (const float*)(p.ws + WS_ROT);
    const float lg2 = log2f(1.0f - exp2f(-5.0f - (float)hu));
    const int i0 = c == 0 ? 48 : 0, t0 = 64 * c - 48, nlast = 64 - i0;
    unsigned char* rec = rec_ret(p, b, c, hu);
    __syncthreads();
#pragma unroll
    for (int e = tid; e < 64 * 32; e += 512) { const int i = e >> 5, d = e & 31; float qa, qb, ka, kb;
        { const int tc = max(t0 + i, 0); const bf16_t* pr = proj + (size_t)(b * TP + tc) * NBIG; const float cs = rot[(tc * 32 + d) * 2], sn = rot[(tc * 32 + d) * 2 + 1];
            const float q1 = bf2f(pr[PC_DQ + hu * 64 + d]), q2 = bf2f(pr[PC_DQ + hu * 64 + 32 + d]), k1 = bf2f(pr[PC_DK + hu * 64 + d]), k2 = bf2f(pr[PC_DK + hu * 64 + 32 + d]);
            const float mk = i >= i0 ? 1.0f : 0.0f;
            qa = (q1 * cs - q2 * sn) * mk; qb = (q2 * cs + q1 * sn) * mk; ka = (k1 * cs - k2 * sn) * (0.125f * mk); kb = (k2 * cs + k1 * sn) * (0.125f * mk); }
        Qs[i * LDP + d] = f2bf(qa); Qs[i * LDP + 32 + d] = f2bf(qb); Ks[i * LDP + d] = f2bf(ka); Ks[i * LDP + 32 + d] = f2bf(kb);
        KT[d * LDP + i] = f2bf(ka); KT[(d + 32) * LDP + i] = f2bf(kb); }
#pragma unroll
    for (int e = tid; e < 64 * 64; e += 512) { const int i = e >> 6, d = e & 63;
        float v = bf2f(proj[(size_t)(b * TP + max(t0 + i, 0)) * NBIG + PC_DV + hu * 64 + d]); v = i >= i0 ? v : 0.f; const float vh = v * fexp2((float)(63 - i) * lg2);
        VT[d * LDP + i] = f2bf(v); VH[d * LDP + i] = f2bf(vh); }
    __syncthreads();
#pragma unroll
    for (int tt = 0; tt < 2; ++tt) { const int t = wid * 2 + tt, I = t >> 2, J = t & 3; f32x4 acc = (f32x4){0.f, 0.f, 0.f, 0.f};
        if (J <= I) {
#pragma unroll
            for (int s = 0; s < 2; ++s) acc = mfma16(frag_ld(Ks, LDP, 16 * J + fc, 32 * s + 8 * fq), frag_ld(Qs, LDP, 16 * I + fc, 32 * s + 8 * fq), acc); }
        const int i = 16 * I + fc;
#pragma unroll
        for (int r = 0; r < 4; ++r) { const int j = 16 * J + 4 * fq + r; acc[r] = (j <= i && j >= i0) ? acc[r] * fexp2((float)(i - j) * lg2) : 0.f; }
        st_bf4(Ps + i * LDP + 16 * J + 4 * fq, acc); }
    __syncthreads();
    { const int w = wid & 3; bf16x8 bb[2];
#pragma unroll
        for (int s = 0; s < 2; ++s) bb[s] = frag_ld(wid < 4 ? VT : VH, LDP, 16 * w + fc, 32 * s + 8 * fq);
        const LAS bf16_t* At = wid < 4 ? Ps : KT; unsigned char* dst = rec + (wid < 4 ? HR_OI : HR_DS);
#pragma unroll
        for (int m = 0; m < 4; ++m) { f32x4 acc = (f32x4){0.f, 0.f, 0.f, 0.f};
#pragma unroll
            for (int s = 0; s < 2; ++s) acc = mfma16(frag_ld(At, LDP, 16 * m + fc, 32 * s + 8 * fq), bb[s], acc);
            st_acc_bf4(dst + ((size_t)(w * 4 + m) * 64 + lane) * 8, acc); }
        { const float eg = fexp2((float)max(16 * (wid >> 1) + fc - i0 + 1, 0) * lg2); const float sc[8] = {eg, eg, eg, eg, eg, eg, eg, eg};
            *(bf16x8*)(rec + HR_QF + ((size_t)wid * 64 + lane) * 16) = frag_scale(frag_ld_perm(Qs, LDP, 16 * (wid >> 1) + fc, 32 * (wid & 1), fq), sc); }
        if (tid < 64) { float* gv = (float*)(rec + HR_VEC); gv[64 + tid] = fexp2((float)nlast * lg2); } }
}

struct HgLds { static constexpr int LS = 0  , KR = LS + 16384  , QR = KR + 16384  , QT = QR + 16384, QH = QT + 64 * LDP * 2, KT = QH + 64 * LDP * 2  ,
    KHT = KT + 160 * LDP * 2, VT = KHT + 64 * LDP * 2, PS = VT + 64 * LDP * 2, AV = PS + 64 * LDP * 2, END = AV + 256; };
__device__ void hgrn_pre_unit(const Params& p, int layer, int b, int c, int hu, LAS unsigned char* lds) {
    const int tid = opaque_tid(), wid = tid >> 6, lane = tid & 63, fq = lane >> 4, fc = lane & 15;
    LAS float* Ls = (LAS float*)(lds + HgLds::LS); LAS float* Kr = (LAS float*)(lds + HgLds::KR); LAS float* Qr = (LAS float*)(lds + HgLds::QR);
    LAS bf16_t* Qt = (LAS bf16_t*)(lds + HgLds::QT); LAS bf16_t* Qh = (LAS bf16_t*)(lds + HgLds::QH); LAS bf16_t* Kt = (LAS bf16_t*)(lds + HgLds::KT); LAS bf16_t* KhT = (LAS bf16_t*)(lds + HgLds::KHT);
    LAS bf16_t* VT = (LAS bf16_t*)(lds + HgLds::VT); LAS bf16_t* Ps = (LAS bf16_t*)(lds + HgLds::PS); LAS float* Av = (LAS float*)(lds + HgLds::AV);
    const bf16_t* proj = (const bf16_t*)(p.ws + WS_PROJ);
    const float lbv = ((const float*)(p.ws + WS_LB))[layer * 256 + hu * 64 + lane];
    const int i0 = c == 0 ? 48 : 0, t0 = 64 * c - 48;
    unsigned char* rec = rec_hgrn(p, b, c, hu);
    __syncthreads();
    if (wid < 4) { float acc = 0.f; float afr[16];
#pragma unroll
        for (int ii = 0; ii < 16; ++ii) { const int i = 16 * wid + ii; afr[ii] = bf2f(proj[(size_t)(b * TP + max(t0 + i, 0)) * NBIG + PC_AF + hu * 64 + lane]); }
#pragma unroll
        for (int ii = 0; ii < 16; ++ii) { const int i = 16 * wid + ii; float kk;
            { float af = afr[ii]; af = fminf(fmaxf(af, -30.f), 30.f);
                const float e = __expf(-af), sg = __builtin_amdgcn_rcpf(1.0f + e); const float f = lbv + (1.0f - lbv) * sg; const bool ok = i >= i0; kk = ok ? (1.0f - lbv) * e * sg : 0.f; acc += ok ? __log2f(fmaxf(f, 1e-30f)) : 0.f; }
            Ls[i * 64 + lane] = acc; Kr[i * 64 + lane] = kk; } }
    else {
#pragma unroll
        for (int e = tid - 256; e < 64 * 64; e += 256) { const int i = e >> 6, d = e & 63;
            const bf16_t* pr = proj + (size_t)(b * TP + max(t0 + i, 0)) * NBIG; float q = silu_f(bf2f(pr[PC_AQ + hu * 64 + d])) * 0.125f, v = bf2f(pr[PC_AI + hu * 64 + d]); if (i < i0) { q = 0.f; v = 0.f; }
            Qr[i * 64 + d] = q; VT[d * LDP + i] = f2bf(v); } }
    __syncthreads();
#pragma unroll 2
    for (int e = tid; e < 64 * 64; e += 512) { const int i = e >> 6, d = e & 63, I = i >> 4;
        const float T0 = Ls[15 * 64 + d], T1 = Ls[31 * 64 + d], T2 = Ls[47 * 64 + d], T3 = Ls[63 * 64 + d];
        const float Bi = I == 0 ? 0.f : I == 1 ? T0 : I == 2 ? T0 + T1 : T0 + T1 + T2; const float Li = Ls[i * 64 + d], Gi = Bi + Li, Gl = T0 + T1 + T2 + T3;
        const float q = Qr[i * 64 + d], k = Kr[i * 64 + d];
        Qt[i * LDP + d] = f2bf(q * fexp2(Li)); Qh[i * LDP + d] = f2bf(q * fexp2(Gi)); KhT[d * LDP + i] = f2bf(k * fexp2(Gl - Gi));
        float Bp = Bi;
        Kt[((I == 0 ? 0 : I == 1 ? 16 : I == 2 ? 48 : 96) + i) * LDP + d] = f2bf(k * fexp2(Bp - Gi));
        if (I <= 0) { Bp = T0; Kt[(16 + i) * LDP + d] = f2bf(k * fexp2(Bp - Gi)); }
        if (I <= 1) { Bp = T0 + T1; Kt[(48 + i) * LDP + d] = f2bf(k * fexp2(Bp - Gi)); }
        if (I <= 2) { Bp = T0 + T1 + T2; Kt[(96 + i) * LDP + d] = f2bf(k * fexp2(Bp - Gi)); }
        if (i == 0) Av[d] = fexp2(Gl); }
    __syncthreads();
#pragma unroll
    for (int tt = 0; tt < 2; ++tt) { const int t = wid * 2 + tt, I = t >> 2, J = t & 3; f32x4 acc = (f32x4){0.f, 0.f, 0.f, 0.f};
        if (J <= I) { const int kb = (I == 0 ? 0 : I == 1 ? 16 : I == 2 ? 48 : 96) + 16 * J;
#pragma unroll
            for (int s = 0; s < 2; ++s) acc = mfma16(frag_ld(Kt, LDP, kb + fc, 32 * s + 8 * fq), frag_ld(Qt, LDP, 16 * I + fc, 32 * s + 8 * fq), acc); }
        const int i = 16 * I + fc;
#pragma unroll
        for (int r = 0; r < 4; ++r) { const int j = 16 * J + 4 * fq + r; acc[r] = (j <= i) ? acc[r] : 0.f; }
        st_bf4(Ps + i * LDP + 16 * J + 4 * fq, acc); }
    __syncthreads();
    { const int w = wid & 3; bf16x8 bb[2];
#pragma unroll
        for (int s = 0; s < 2; ++s) bb[s] = frag_ld(VT, LDP, 16 * w + fc, 32 * s + 8 * fq);
        const LAS bf16_t* At = wid < 4 ? Ps : KhT; unsigned char* dst = rec + (wid < 4 ? HR_OI : HR_DS);
#pragma unroll
        for (int m = 0; m < 4; ++m) { f32x4 acc = (f32x4){0.f, 0.f, 0.f, 0.f};
#pragma unroll
            for (int s = 0; s < 2; ++s) acc = mfma16(frag_ld(At, LDP, 16 * m + fc, 32 * s + 8 * fq), bb[s], acc);
            st_acc_bf4(dst + ((size_t)(w * 4 + m) * 64 + lane) * 8, acc); }
        *(bf16x8*)(rec + HR_QF + ((size_t)wid * 64 + lane) * 16) = frag_ld_perm(Qh, LDP, 16 * (wid >> 1) + fc, 32 * (wid & 1), fq);
        if (tid < 64) { float* gv = (float*)(rec + HR_VEC); gv[64 + tid] = Av[tid]; } }
}

struct SsdLds { static constexpr int CS = 0, BS = CS + 64 * LDP2 * 2, BT = BS + 64 * LDP2 * 2, XS = BT + 128 * LDP * 2, VT = XS + 64 * LDP2 * 2  , VH = VT + 2 * 64 * LDP * 2, PS = VH + 2 * 64 * LDP * 2  ,
    DT = PS + 67 * 384 * 2  , GV = DT + 512, END = GV + 512; };
constexpr int SSD_NPIECE = 67 * 48;
__device__ void ssd_pre_unit(const Params& p, int layer, int b, int c, int gg, LAS unsigned char* lds) {
    const int tid = opaque_tid(), wid = tid >> 6, lane = tid & 63, fq = lane >> 4, fc = lane & 15;
    LAS bf16_t* Cs = (LAS bf16_t*)(lds + SsdLds::CS); LAS bf16_t* Bs = (LAS bf16_t*)(lds + SsdLds::BS); LAS bf16_t* BT = (LAS bf16_t*)(lds + SsdLds::BT); LAS bf16_t* Xs = (LAS bf16_t*)(lds + SsdLds::XS);
    LAS bf16_t* VT = (LAS bf16_t*)(lds + SsdLds::VT); LAS bf16_t* VH = (LAS bf16_t*)(lds + SsdLds::VH); LAS bf16_t* Ps = (LAS bf16_t*)(lds + SsdLds::PS); LAS bf16_t* RawT = Ps;
    LAS float* DTv = (LAS float*)(lds + SsdLds::DT); LAS float* Gv = (LAS float*)(lds + SsdLds::GV);
    const bf16_t* projb = (const bf16_t*)(p.ws + WS_PROJ) + (size_t)(b * TP) * NBIG; const float* psmb = (const float*)(p.ws + WS_PSM) + (size_t)(b * TP) * NSM;
    const float* cw = p.ssd_conv_w + (size_t)layer * 4 * 768; const float* cb = p.ssd_conv_b + (size_t)layer * 768;
    constexpr float L2E = 1.4426950408889634f;
    const int hh = wid >> 2, ws = wid & 3;
    const int i0 = c == 0 ? 48 : 0, t0 = 64 * c - 48;
    unsigned char* rec = rec_ssd(p, b, c, gg);
    u32x4 raw[7];
#pragma unroll
    for (int k = 0; k < 7; ++k) { const int id = min(tid + 512 * k, SSD_NPIECE - 1), row = id / 48, seg = id % 48, t = t0 - 3 + row;
        const u32x4 v = *(const u32x4*)(projb + (size_t)max(t, 0) * NBIG + PC_CXBC + (seg >> 4) * 256 + gg * 128 + (seg & 15) * 8);
        raw[k] = t >= 0 ? v : (u32x4){0u, 0u, 0u, 0u}; }
    const float psmv = psmb[(size_t)max(t0 + lane, 0) * NSM + 8 + gg * 2 + (wid & 1)];
    __syncthreads();
    if (wid < 2) { const int hd = gg * 2 + wid;
        float dt = softplus_f(psmv + p.ssd_dt_bias[layer * 4 + hd]); dt = lane >= i0 ? dt : 0.f;
        float G = -dt * __expf(p.ssd_a_log[layer * 4 + hd]) * L2E;
#pragma unroll
        for (int o = 1; o < 64; o <<= 1) { const float t = lane_up(G, o, lane); if (lane >= o) G += t; }
        DTv[wid * 64 + lane] = dt; Gv[wid * 64 + lane] = G; }
#pragma unroll
    for (int k = 0; k < 7; ++k) { const int id = tid + 512 * k; if (id < SSD_NPIECE) *(LAS u32x4*)(RawT + (id / 48) * 384 + (id % 48) * 8) = raw[k]; }
    __syncthreads();
#pragma unroll 1
    for (int n = 0; n < 3; ++n) { const int e = tid + 512 * n, ch = e % 384, tr = e / 384, part = ch >> 7, j = ch & 127, chf = part * 256 + gg * 128 + j;
        const float w0 = cw[chf], w1 = cw[768 + chf], w2 = cw[2 * 768 + chf], w3 = cw[3 * 768 + chf], bias = cb[chf];
#pragma unroll
        for (int hf = 0; hf < 2; ++hf) { const int ib = 16 * tr + 8 * hf; float a[8], rw[11];
#pragma unroll
            for (int ii = 0; ii < 11; ++ii) rw[ii] = bf2f(RawT[(ib + ii) * 384 + ch]);
#pragma unroll
            for (int ii = 0; ii < 8; ++ii) { a[ii] = silu_f(bias + w0 * rw[ii] + w1 * rw[ii + 1] + w2 * rw[ii + 2] + w3 * rw[ii + 3]); if (ib + ii < i0) a[ii] = 0.f; }
            if (part == 0) { const int h2 = j >> 6, d = j & 63; const float gl = Gv[h2 * 64 + 63]; float xh[8];
#pragma unroll
                for (int ii = 0; ii < 8; ++ii) { const int i = ib + ii; Xs[i * LDP2 + j] = f2bf(a[ii]); a[ii] *= DTv[h2 * 64 + i]; xh[ii] = a[ii] * fexp2(gl - Gv[h2 * 64 + i]); }
                *(LAS u32x4*)(VT + (h2 * 64 + d) * LDP + ib) = pack_bf8(a); *(LAS u32x4*)(VH + (h2 * 64 + d) * LDP + ib) = pack_bf8(xh); }
            else if (part == 1) {
#pragma unroll
                for (int ii = 0; ii < 8; ++ii) Bs[(ib + ii) * LDP2 + j] = f2bf(a[ii]);
                *(LAS u32x4*)(BT + j * LDP + ib) = pack_bf8(a); }
            else {
#pragma unroll
                for (int ii = 0; ii < 8; ++ii) Cs[(ib + ii) * LDP2 + j] = f2bf(a[ii]); } } }
    __syncthreads();
#pragma unroll
    for (int tt = 0; tt < 2; ++tt) { const int t = wid * 2 + tt, I = t >> 2, J = t & 3; f32x4 acc = (f32x4){0.f, 0.f, 0.f, 0.f};
        if (J <= I) {
#pragma unroll
            for (int s = 0; s < 4; ++s) acc = mfma16(frag_ld(Bs, LDP2, 16 * J + fc, 32 * s + 8 * fq), frag_ld(Cs, LDP2, 16 * I + fc, 32 * s + 8 * fq), acc); }
        const int i = 16 * I + fc;
#pragma unroll
        for (int h2 = 0; h2 < 2; ++h2) { f32x4 pv; const float gi = Gv[h2 * 64 + i];
#pragma unroll
            for (int r = 0; r < 4; ++r) { const int j = 16 * J + 4 * fq + r; pv[r] = (j <= i && j >= i0) ? acc[r] * fexp2(gi - Gv[h2 * 64 + j]) : 0.f; }
            st_bf4(Ps + (h2 * 64 + i) * LDP + 16 * J + 4 * fq, pv); } }
    __syncthreads();
    { bf16x8 bv[2], bh[2]; unsigned char* hrec = rec + SS_HEAD + (size_t)hh * 24576; const float dsk = p.ssd_d[layer * 4 + gg * 2 + hh];
#pragma unroll
        for (int s = 0; s < 2; ++s) { bv[s] = frag_ld(VT, LDP, hh * 64 + 16 * ws + fc, 32 * s + 8 * fq); bh[s] = frag_ld(VH, LDP, hh * 64 + 16 * ws + fc, 32 * s + 8 * fq); }
#pragma unroll
        for (int mi = 0; mi < 4; ++mi) { f32x4 o1 = (f32x4){0.f, 0.f, 0.f, 0.f};
#pragma unroll
            for (int s = 0; s < 2; ++s) o1 = mfma16(frag_ld(Ps, LDP, hh * 64 + 16 * mi + fc, 32 * s + 8 * fq), bv[s], o1);
#pragma unroll
            for (int r = 0; r < 4; ++r) o1[r] += dsk * bf2f(Xs[(16 * mi + 4 * fq + r) * LDP2 + hh * 64 + 16 * ws + fc]);
            st_acc_bf4(hrec + ((size_t)(ws * 4 + mi) * 64 + lane) * 8, o1); }
#pragma unroll
        for (int m = 0; m < 8; ++m) { f32x4 d = (f32x4){0.f, 0.f, 0.f, 0.f};
#pragma unroll
            for (int s = 0; s < 2; ++s) d = mfma16(frag_ld(BT, LDP, 16 * m + fc, 32 * s + 8 * fq), bh[s], d);
            st_acc_bf4(hrec + 8192 + ((size_t)(ws * 8 + m) * 64 + lane) * 8, d); }
#pragma unroll
        for (int x = 0; x < 2; ++x) { const int sl = wid * 2 + x; *(bf16x8*)(rec + SS_QF + ((size_t)sl * 64 + lane) * 16) = frag_ld_perm(Cs, LDP2, 16 * (sl >> 2) + fc, 32 * (sl & 3), fq); }
        if (tid < 128) { float* gv = (float*)(rec + SS_VEC + (size_t)(tid >> 6) * 512); gv[tid & 63] = fexp2(Gv[tid]); if ((tid & 63) == 0) gv[64] = fexp2(Gv[(tid >> 6) * 64 + 63]); } }
}

struct GdLds { static constexpr int QF = 0, KF = 16384, VF = 32768, QN = 49152, KN = QN + 64 * LDP * 2, KNT = KN + 64 * LDP * 2, NM = KNT + 64 * LDP * 2, QK = NM + 64 * LDP * 2, WT = QK + 64 * LDP * 2,
    MD = WT + 64 * LDP * 2  , TD = MD + 4096  , GV = TD + 2048, BV = GV + 256, END = BV + 256; };
__device__ void gdn_pre_unit(const Params& p, int layer, int b, int c, int hu, LAS unsigned char* lds) {
    const int tid = opaque_tid(), wid = tid >> 6, lane = tid & 63, fq = lane >> 4, fc = lane & 15;
    LAS float* Qf = (LAS float*)(lds + GdLds::QF); LAS float* Kf = (LAS float*)(lds + GdLds::KF); LAS float* Vf = (LAS float*)(lds + GdLds::VF);
    LAS bf16_t* Qn = (LAS bf16_t*)(lds + GdLds::QN); LAS bf16_t* Kn = (LAS bf16_t*)(lds + GdLds::KN); LAS bf16_t* KnT = (LAS bf16_t*)(lds + GdLds::KNT);
    LAS bf16_t* NM = (LAS bf16_t*)(lds + GdLds::NM); LAS bf16_t* QK = (LAS bf16_t*)(lds + GdLds::QK); LAS bf16_t* Wt = (LAS bf16_t*)(lds + GdLds::WT);
    LAS float* MD = (LAS float*)(lds + GdLds::MD); LAS bf16_t* TD = (LAS bf16_t*)(lds + GdLds::TD); LAS float* Gv = (LAS float*)(lds + GdLds::GV); LAS float* Bv = (LAS float*)(lds + GdLds::BV);
    const bf16_t* proj = (const bf16_t*)(p.ws + WS_PROJ); const float* psm = (const float*)(p.ws + WS_PSM);
    const float* cw = p.gdn_conv_w + (size_t)layer * 4 * 768;
    unsigned char* gd = rec_gdn(p, b, c, hu);
    constexpr float L2E = 1.4426950408889634f;
    const int i0 = c == 0 ? 48 : 0, t0 = 64 * c - 48;
    __syncthreads();
    if (wid == 0) { const float* ps = psm + (size_t)(b * TP + max(t0 + lane, 0)) * NSM;
        float g = -__expf(p.gdn_a_log[layer * 4 + hu]) * softplus_f(ps[hu] + p.gdn_dt_bias[layer * 4 + hu]) * L2E, be = sigmoid_f(ps[4 + hu]); if (lane < i0) { g = 0.f; be = 0.f; }
#pragma unroll
        for (int o = 1; o < 64; o <<= 1) { const float t = lane_up(g, o, lane); if (lane >= o) g += t; }
        Gv[lane] = g; Bv[lane] = be; }
#pragma unroll
    for (int e = tid; e < 192 * 8; e += 512) { const int ch = e % 192, tr = e / 192, part = ch >> 6, d = ch & 63, chf = part * 256 + hu * 64 + d;
        const bf16_t* col = proj + (size_t)(b * TP) * NBIG + PC_BQKV + chf;
        const float w0 = cw[chf], w1 = cw[768 + chf], w2 = cw[2 * 768 + chf], w3 = cw[3 * 768 + chf];
        const int ts = t0 + 8 * tr;
        float raw[11];
#pragma unroll
        for (int ii = 0; ii < 11; ++ii) { const int t = ts - 3 + ii; const float v = bf2f(col[(size_t)max(t, 0) * NBIG]); raw[ii] = t >= 0 ? v : 0.f; }
        LAS float* dst = part == 0 ? Qf : part == 1 ? Kf : Vf;
#pragma unroll
        for (int ii = 0; ii < 8; ++ii) { const int i = 8 * tr + ii;
            float a = silu_f(w0 * raw[ii] + w1 * raw[ii + 1] + w2 * raw[ii + 2] + w3 * raw[ii + 3]); if (i < i0) a = 0.f;
            dst[i * 64 + d] = a; } }
    __syncthreads();
    { const int ri = tid >> 3, sg = tid & 7; float q[8], k[8], sq = 0.f, sk = 0.f;
#pragma unroll
        for (int x = 0; x < 8; ++x) { q[x] = Qf[ri * 64 + sg * 8 + x]; k[x] = Kf[ri * 64 + sg * 8 + x]; sq += q[x] * q[x]; sk += k[x] * k[x]; }
        sq += lane_xor(sq, 1, lane); sq += lane_xor(sq, 2, lane); sq += lane_xor(sq, 4, lane); sk += lane_xor(sk, 1, lane); sk += lane_xor(sk, 2, lane); sk += lane_xor(sk, 4, lane);
        const float rq = rsqrtf(sq + EPSF) * 0.125f, rk = rsqrtf(sk + EPSF);
#pragma unroll
        for (int x = 0; x < 8; ++x) { q[x] *= rq; k[x] *= rk; Kf[ri * 64 + sg * 8 + x] = k[x]; KnT[(sg * 8 + x) * LDP + ri] = f2bf(k[x]); }
        *(LAS u32x4*)(Qn + ri * LDP + sg * 8) = pack_bf8(q); *(LAS u32x4*)(Kn + ri * LDP + sg * 8) = pack_bf8(k); }
    __syncthreads();
#pragma unroll
    for (int tt = 0; tt < 2; ++tt) { const int t = wid * 2 + tt, I = t >> 2, J = t & 3; f32x4 a1 = (f32x4){0.f, 0.f, 0.f, 0.f}, a2 = (f32x4){0.f, 0.f, 0.f, 0.f};
        if (J <= I) {
#pragma unroll
            for (int s = 0; s < 2; ++s) { const bf16x8 kj = frag_ld(Kn, LDP, 16 * J + fc, 32 * s + 8 * fq); a1 = mfma16(kj, frag_ld(Kn, LDP, 16 * I + fc, 32 * s + 8 * fq), a1); a2 = mfma16(kj, frag_ld(Qn, LDP, 16 * I + fc, 32 * s + 8 * fq), a2); } }
        const int i = 16 * I + fc; const float gi = Gv[i], bi = Bv[i]; f32x4 nm, qk;
#pragma unroll
        for (int r = 0; r < 4; ++r) { const int j = 16 * J + 4 * fq + r; const float dec = j <= i ? fexp2(gi - Gv[j]) : 0.f; const float mm = j < i ? a1[r] * dec * bi : 0.f; nm[r] = -mm; qk[r] = a2[r] * dec;
            if (J == I) MD[(I * 16 + fc) * 16 + 4 * fq + r] = mm; }
        st_bf4(NM + i * LDP + 16 * J + 4 * fq, nm); st_bf4(QK + i * LDP + 16 * J + 4 * fq, qk); }
    __syncthreads();
    if (wid == 0) { const int I = fq, cc = fc; float x[16];
#pragma unroll
        for (int i = 0; i < 16; ++i) { float acc = (i == cc) ? 1.0f : 0.0f;
#pragma unroll
            for (int j = 0; j < i; ++j) acc -= MD[(I * 16 + i) * 16 + j] * x[j];
            x[i] = acc; TD[(I * 16 + i) * 16 + cc] = f2bf(acc); } }
    __syncthreads();
    const int isW = wid >> 2, ws = wid & 3, colx = 16 * ws + fc;
    f32x4 X[4];
    const f32x4 zero4 = (f32x4){0.f, 0.f, 0.f, 0.f};
#pragma unroll
    for (int I = 0; I < 4; ++I) { f32x4 acc;
#pragma unroll
        for (int r = 0; r < 4; ++r) { const int j = 16 * I + 4 * fq + r; acc[r] = isW ? Bv[j] * fexp2(Gv[j]) * Kf[j * 64 + colx] : Bv[j] * Vf[j * 64 + colx]; }
        if (I >= 1) acc = mfma16(frag_ld_perm(NM, LDP, 16 * I + fc, 0, fq), pack_acc2(X[0], I > 1 ? X[1] : zero4), acc);
        if (I == 3) acc = mfma16(frag_ld_perm(NM, LDP, 48 + fc, 32, fq), pack_acc2(X[2], zero4), acc);
        const bf16x4 tlo = *(const LAS bf16x4*)(TD + (I * 16 + fc) * 16 + 4 * fq); const bf16x4 z4 = (bf16x4){0, 0, 0, 0};
        X[I] = mfma16(__builtin_shufflevector(tlo, z4, 0, 1, 2, 3, 4, 5, 6, 7), pack_acc2(acc, zero4), zero4); }
    if (!isW) {
#pragma unroll
        for (int m = 0; m < 4; ++m) st_acc_bf4(gd + GD_U + ((size_t)(ws * 4 + m) * 64 + lane) * 8, X[m]); }
    else {
#pragma unroll
        for (int m = 0; m < 4; ++m)
#pragma unroll
            for (int r = 0; r < 4; ++r) Wt[(16 * m + 4 * fq + r) * LDP + colx] = f2bf(-X[m][r]); }
    __syncthreads();
    { const int tsel = wid >> 1; const LAS bf16_t* tile = tsel == 0 ? Wt : tsel == 1 ? Qn : tsel == 2 ? QK : KnT; unsigned char* dst = gd + (tsel == 0 ? GD_W : tsel == 1 ? GD_Q : tsel == 2 ? GD_P : GD_K);
#pragma unroll
        for (int x = 0; x < 4; ++x) { const int sl = (wid & 1) * 4 + x, m = sl >> 1, s = sl & 1; bf16x8 f = frag_ld_perm(tile, LDP, 16 * m + fc, 32 * s, fq);
            if (tsel == 1) { const float eg = fexp2(Gv[16 * m + fc]); const float sc[8] = {eg, eg, eg, eg, eg, eg, eg, eg}; f = frag_scale(f, sc); }
            if (tsel == 3) { float sc[8];
#pragma unroll
                for (int e = 0; e < 8; ++e) sc[e] = fexp2(Gv[63] - Gv[32 * s + 16 * (e >> 2) + 4 * fq + (e & 3)]);
                f = frag_scale(f, sc); }
            *(bf16x8*)(dst + ((size_t)sl * 64 + lane) * 16) = f; } }
    if (tid == 0) { float* gv = (float*)(gd + GD_VEC); gv[128] = fexp2(Gv[63]); }
}

template <int MIX> struct SeqRegs {
    static constexpr int DK = MIX == 2 ? 128 : 64, NT = DK / 16, NS = DK / 32;
    bf16x8 qf[4 * NS]; u32x2 oi[4]; u32x2 ds[NT]; f32x4 eg[MIX == 2 ? 4 : 1]; f32x4 al[MIX == 0 ? 4 : 1];
    __device__ __forceinline__ void load(const Params& p, int b, int c, int hp, int hsel, int hd, int ws, int lane, int fq) {
        const unsigned char* base = MIX == 2 ? rec_ssd(p, b, c, hp) : MIX == 0 ? rec_hgrn(p, b, c, hd) : rec_ret(p, b, c, hd);
        const unsigned char* q = base + (MIX == 2 ? SS_QF : HR_QF); const unsigned char* o = MIX == 2 ? base + SS_HEAD + (size_t)hsel * 24576 : base + HR_OI;
        const unsigned char* d = MIX == 2 ? o + 8192 : base + HR_DS; const float* gv = (const float*)(MIX == 2 ? base + SS_VEC + (size_t)hsel * 512 : base + HR_VEC);
#pragma unroll
        for (int x = 0; x < 4 * NS; ++x) qf[x] = *(const bf16x8*)(q + ((size_t)x * 64 + lane) * 16);
#pragma unroll
        for (int mi = 0; mi < 4; ++mi) { oi[mi] = *(const u32x2*)(o + ((size_t)(ws * 4 + mi) * 64 + lane) * 8); if (MIX == 2) eg[mi] = *(const f32x4*)(gv + 16 * mi + 4 * fq); }
#pragma unroll
        for (int m = 0; m < NT; ++m) ds[m] = *(const u32x2*)(d + ((size_t)(ws * NT + m) * 64 + lane) * 8);
#pragma unroll
        for (int m = 0; m < (MIX == 0 ? 4 : 1); ++m) al[m] = MIX == 0 ? *(const f32x4*)(gv + 64 + 16 * m + 4 * fq) : (f32x4){gv[64], 0.f, 0.f, 0.f};
    }
};
__device__ __forceinline__ f32x4 unpack_acc(const u32x2& w) { return (f32x4){__uint_as_float(w.x << 16), __uint_as_float(w.x & 0xffff0000u), __uint_as_float(w.y << 16), __uint_as_float(w.y & 0xffff0000u)}; }
struct GdRegs { bf16x8 w[8], pq[8], qq[8], kk[8]; u32x2 u0[4]; float al;
    __device__ __forceinline__ void load_a(const unsigned char* gd, int ws, int lane) {
#pragma unroll
        for (int x = 0; x < 8; ++x) w[x] = *(const bf16x8*)(gd + GD_W + ((size_t)x * 64 + lane) * 16);
#pragma unroll
        for (int m = 0; m < 4; ++m) u0[m] = *(const u32x2*)(gd + GD_U + ((size_t)(ws * 4 + m) * 64 + lane) * 8); }
    __device__ __forceinline__ void load_b(const unsigned char* gd, int lane, int fq) {
        const float* gv = (const float*)(gd + GD_VEC);
#pragma unroll
        for (int x = 0; x < 8; ++x) { pq[x] = *(const bf16x8*)(gd + GD_P + ((size_t)x * 64 + lane) * 16); qq[x] = *(const bf16x8*)(gd + GD_Q + ((size_t)x * 64 + lane) * 16); }
        al = gv[128]; }
    __device__ __forceinline__ void load_k(const unsigned char* gd, int lane) {
#pragma unroll
        for (int x = 0; x < 8; ++x) kk[x] = *(const bf16x8*)(gd + GD_K + ((size_t)x * 64 + lane) * 16); }
};
template <int MIX>
__device__ void seq_item(const Params& p, int layer, int b_in, int hp_in, LAS unsigned char* lds) {
    constexpr int DK = MIX == 2 ? 128 : 64, NT = DK / 16, NS = DK / 32;
    const int b = __builtin_amdgcn_readfirstlane(b_in), hp = __builtin_amdgcn_readfirstlane(hp_in);
    const int tid = opaque_tid(), wid = tid >> 6, lane = tid & 63, fq = lane >> 4, fc = lane & 15;
    const int hsel = wid >> 2, hd = hp * 2 + hsel, ws = wid & 3;
    LAS float* Os = (LAS float*)lds;
    const bf16_t* projb = (const bf16_t*)(p.ws + WS_PROJ) + (size_t)(b * TP) * NBIG; bf16_t* yb = (bf16_t*)(p.ws + WS_Y) + (size_t)(b * TP) * DM;
    f32x4 S[NT];
#pragma unroll
    for (int m = 0; m < NT; ++m) S[m] = (f32x4){0.f, 0.f, 0.f, 0.f};
    const f32x4 zero4 = (f32x4){0.f, 0.f, 0.f, 0.f};
    SeqRegs<MIX == 1 ? 0 : MIX> R; GdRegs G;
    if (MIX != 1) R.load(p, b, 0, hp, hsel, hd, ws, lane, fq);
    __syncthreads();
    for (int c = 0; c < NCHUNK; ++c) {
        const int i0 = c == 0 ? 48 : 0, t0 = 64 * c - 48, cn = min(c + 1, NCHUNK - 1);
        LAS float* Ob = Os + ((c & 1) * 2 + hsel) * 64 * OSP;
        bf16x8 Sb[NS];
#pragma unroll
        for (int s = 0; s < NS; ++s) Sb[s] = pack_acc2(S[2 * s], S[2 * s + 1]);
        if (MIX == 1) {
            const unsigned char* gn = rec_gdn(p, b, cn, hd);
            G.load_a(rec_gdn(p, b, c, hd), ws, lane);
            bf16x8 ub[2]; f32x4 u[4];
#pragma unroll
            for (int m = 0; m < 4; ++m) { u[m] = unpack_acc(G.u0[m]);
#pragma unroll
                for (int s = 0; s < 2; ++s) u[m] = mfma16(G.w[m * 2 + s], Sb[s], u[m]); }
            __builtin_amdgcn_sched_barrier(0);
            G.load_b(rec_gdn(p, b, c, hd), lane, fq);
#pragma unroll
            for (int s = 0; s < 2; ++s) ub[s] = pack_acc2(u[2 * s], u[2 * s + 1]);
#pragma unroll
            for (int mi = 0; mi < 4; ++mi) { f32x4 o1 = zero4, o2 = zero4;
#pragma unroll
                for (int s = 0; s < 2; ++s) { o1 = mfma16(G.pq[mi * 2 + s], ub[s], o1); o2 = mfma16(G.qq[mi * 2 + s], Sb[s], o2); }
#pragma unroll
                for (int r = 0; r < 4; ++r) Ob[(16 * mi + 4 * fq + r) * OSP + 16 * ws + fc] = o1[r] + o2[r]; }
            __builtin_amdgcn_sched_barrier(0);
            G.load_k(rec_gdn(p, b, c, hd), lane);
#pragma unroll
            for (int m = 0; m < 4; ++m) { S[m] = S[m] * G.al;
#pragma unroll
                for (int s = 0; s < 2; ++s) S[m] = mfma16(G.kk[m * 2 + s], ub[s], S[m]); }
            (void)gn;
        } else {
#pragma unroll
            for (int mi = 0; mi < 4; ++mi) { f32x4 o2 = zero4;
#pragma unroll
                for (int s = 0; s < NS; ++s) o2 = mfma16(R.qf[mi * NS + s], Sb[s], o2);
                const f32x4 o1 = unpack_acc(R.oi[mi]);
#pragma unroll
                for (int r = 0; r < 4; ++r) Ob[(16 * mi + 4 * fq + r) * OSP + 16 * ws + fc] = o1[r] + (MIX == 2 ? R.eg[MIX == 2 ? mi : 0][r] : 1.0f) * o2[r]; }
#pragma unroll
            for (int m = 0; m < NT; ++m) { const f32x4 d = unpack_acc(R.ds[m]);
#pragma unroll
                for (int r = 0; r < 4; ++r) S[m][r] = (MIX == 0 ? R.al[MIX == 0 ? (m & 3) : 0][r] : R.al[0][0]) * S[m][r] + d[r]; }
            R.load(p, b, cn, hp, hsel, hd, ws, lane, fq);
        }
        if (MIX == 2) {
            const int ri = tid >> 3, sg = tid & 7;
            const bf16_t* zp = projb + (size_t)max(t0 + ri, 0) * NBIG + PC_CZ + hp * 128 + sg * 16; const u32x4 zr0 = *(const u32x4*)zp, zr1 = *(const u32x4*)(zp + 8);
            __syncthreads();
            float o[16], z[16]; unpack_bf8(zr0, z); unpack_bf8(zr1, z + 8); float q = 0.f; const LAS float* Oh = Os + ((c & 1) * 2 + (sg >> 2)) * 64 * OSP + ri * OSP + (sg & 3) * 16;
#pragma unroll
            for (int k4 = 0; k4 < 4; ++k4) { const f32x4 v = *(const LAS f32x4*)(Oh + 4 * k4); o[4 * k4] = v[0]; o[4 * k4 + 1] = v[1]; o[4 * k4 + 2] = v[2]; o[4 * k4 + 3] = v[3]; }
#pragma unroll
            for (int k = 0; k < 16; ++k) { o[k] *= silu_f(z[k]); q += o[k] * o[k]; }
            q += lane_xor(q, 1, lane); q += lane_xor(q, 2, lane); q += lane_xor(q, 4, lane);
            const float rstd = rsqrtf(q * (1.0f / 128.0f) + EPSF); const float* nw = p.ssd_norm_w + layer * 256 + hp * 128 + sg * 16;
#pragma unroll
            for (int k = 0; k < 16; ++k) o[k] *= rstd * nw[k];
            if (ri >= i0) { u32x4* yp = (u32x4*)(yb + (size_t)(t0 + ri) * DM + 512 + hp * 128 + sg * 16); yp[0] = pack_bf8(o); yp[1] = pack_bf8(o + 8); }
        } else {
            const int ri = (tid & 255) >> 2, sg = tid & 3;
            constexpr int ZC = MIX == 0 ? PC_AZ : MIX == 1 ? PC_BZ : PC_DZ, YC = MIX == 0 ? 0 : MIX == 1 ? 256 : 768;
            const bf16_t* zp = projb + (size_t)max(t0 + ri, 0) * NBIG + ZC + hd * 64 + sg * 16; const u32x4 zr0 = *(const u32x4*)zp, zr1 = *(const u32x4*)(zp + 8);
            __syncthreads();
            float o[16], z[16]; unpack_bf8(zr0, z); unpack_bf8(zr1, z + 8);
#pragma unroll
            for (int k4 = 0; k4 < 4; ++k4) { const f32x4 v = *(const LAS f32x4*)(Ob + ri * OSP + sg * 16 + 4 * k4); o[4 * k4] = v[0]; o[4 * k4 + 1] = v[1]; o[4 * k4 + 2] = v[2]; o[4 * k4 + 3] = v[3]; }
            const float* nw = (MIX == 0 ? p.hgrn_norm_w : MIX == 1 ? p.gdn_norm_w : p.ret_norm_w) + layer * 256 + hd * 64 + sg * 16;
            if (MIX == 3) { float s = 0.f;
#pragma unroll
                for (int k = 0; k < 16; ++k) s += o[k];
                s += lane_xor(s, 1, lane); s += lane_xor(s, 2, lane); const float mu = s * (1.0f / 64.0f); float q = 0.f;
#pragma unroll
                for (int k = 0; k < 16; ++k) { o[k] -= mu; q += o[k] * o[k]; }
                q += lane_xor(q, 1, lane); q += lane_xor(q, 2, lane); const float rstd = rsqrtf(q * (1.0f / 64.0f) + EPSF); const float* nb = p.ret_norm_b + layer * 256 + hd * 64 + sg * 16;
#pragma unroll
                for (int k = 0; k < 16; ++k) o[k] = (o[k] * rstd * nw[k] + nb[k]) * silu_f(z[k]);
            } else { float q = 0.f;
#pragma unroll
                for (int k = 0; k < 16; ++k) q += o[k] * o[k];
                q += lane_xor(q, 1, lane); q += lane_xor(q, 2, lane); const float rstd = rsqrtf(q * (1.0f / 64.0f) + EPSF);
#pragma unroll
                for (int k = 0; k < 16; ++k) o[k] = o[k] * rstd * nw[k] * silu_f(z[k]); }
            if (ri >= i0) { u32x4* yp = (u32x4*)(yb + (size_t)(t0 + ri) * DM + YC + hd * 64 + sg * 16); yp[0] = pack_bf8(o); yp[1] = pack_bf8(o + 8); }
        }
    }
    { float* so = p.out + (MIX == 0 ? O_HGRN_P : MIX == 1 ? O_GDN_P : MIX == 2 ? O_SSD_P : O_RET_P) + (((size_t)layer * NB + b) * 4 + hd) * (DK * 64);
#pragma unroll
        for (int m = 0; m < NT; ++m)
#pragma unroll
            for (int r = 0; r < 4; ++r) so[(16 * m + 4 * fq + r) * 64 + 16 * ws + fc] = S[m][r]; }
    if (MIX == 1 || MIX == 2) { float* co = p.out + (MIX == 1 ? O_GCONV_P : O_SCONV_P) + ((size_t)layer * NB + b) * 3 * 768;
        for (int e = tid; e < 3 * 384; e += 512) { const int r = e / 384, ch = e % 384, chf = (ch >> 7) * 256 + hp * 128 + (ch & 127);
            co[r * 768 + chf] = bf2f(projb[(size_t)(TP - 3 + r) * NBIG + (MIX == 1 ? PC_BQKV : PC_CXBC) + chf]); } }
}

constexpr int N_U1 = 2 * NB * NCHUNK * 4, N_U2 = NB * NCHUNK * 4 + NB * NCHUNK * 2;
__device__ void ph_pre1(const Params& p_in, int layer, LAS unsigned char* lds_in, int blk, int nblk) {
    Params p = p_in; asm volatile("" : "+s"(p.ws), "+s"(p.out));
    LAS unsigned char* lds = lds_in; asm volatile("" : "+s"(lds));
    for (int u = blk; u < N_U1; u += nblk) { const int v = u >> 1, b = v / (NCHUNK * 4), c = (v >> 2) % NCHUNK, h = v & 3;
        if (u & 1) ret_pre_unit(p, layer, b, c, h, lds); else hgrn_pre_unit(p, layer, b, c, h, lds); }
}
__device__ void ph_pre2(const Params& p_in, int layer, LAS unsigned char* lds_in, int blk, int nblk) {
    Params p = p_in; asm volatile("" : "+s"(p.ws), "+s"(p.out));
    LAS unsigned char* lds = lds_in; asm volatile("" : "+s"(lds));
    for (int u = blk; u < N_U2; u += nblk) { const int t = u / 3, k = u % 3;
        if (k < 2) { const int v = t * 2 + k; gdn_pre_unit(p, layer, v / (NCHUNK * 4), (v >> 2) % NCHUNK, v & 3, lds); }
        else ssd_pre_unit(p, layer, t / (NCHUNK * 2), (t >> 1) % NCHUNK, t & 1, lds); }
}
__device__ void ph_seq1(const Params& p_in, int layer, LAS unsigned char* lds_in, int blk, int nblk) {
    Params p = p_in; asm volatile("" : "+s"(p.ws), "+s"(p.out));
    LAS unsigned char* lds = lds_in; asm volatile("" : "+s"(lds));
    LAS float* L = (LAS float*)lds;
    if (blk < 32) { const int b = blk >> 2, k = blk & 3; if (k < 2) seq_item<0>(p, layer, b, k, lds); else seq_item<3>(p, layer, b, k - 2, lds); }
    else for (int d = blk - 32; d < DECB * 8; d += nblk - 32) { const int s = NB + (d >> 3), mu = d & 7; if (mu < 4) mixer_item<0>(p, layer, s, mu, L); else mixer_item<3>(p, layer, s, mu - 4, L); }
}
__device__ void ph_seq2(const Params& p_in, int layer, LAS unsigned char* lds_in, int blk, int nblk) {
    Params p = p_in; asm volatile("" : "+s"(p.ws), "+s"(p.out));
    LAS unsigned char* lds = lds_in; asm volatile("" : "+s"(lds));
    LAS float* L = (LAS float*)lds;
    if (blk < 32) { const int b = blk >> 2, k = blk & 3; if (k < 2) seq_item<2>(p, layer, b, k, lds); else seq_item<1>(p, layer, b, k - 2, lds); }
    else for (int d = blk - 32; d < DECB * 6; d += nblk - 32) { const int s = NB + d / 6, mu = d % 6; if (mu < 4) mixer_item<1>(p, layer, s, mu, L); else mixer_item<2>(p, layer, s, mu - 4, L); }
}

__device__ void ph_final(const Params& p_in, int blk, int nblk) {
    Params p = p_in; asm volatile("" : "+s"(p.ws), "+s"(p.out));

    const int tid = opaque_tid(), wid = tid >> 6, lane = tid & 63;
    const float* h = (const float*)(p.ws + WS_H);
    for (int row = blk * 8 + wid; row < MROWS; row += nblk * 8) {
        float* dst;
        if (row < MP) { const int b = row / TP, t = row % TP; if (t < NMETA) continue; dst = p.out + O_YP + ((size_t)b * SEQ + (t - NMETA)) * DM; } else dst = p.out + O_YS + (size_t)(row - MP) * DM;
        f32x4 v[4]; float ss = 0.f;
#pragma unroll
        for (int j = 0; j < 4; ++j) { v[j] = *(const f32x4*)(h + (size_t)row * DM + j * 256 + lane * 4); ss += v[j][0] * v[j][0] + v[j][1] * v[j][1] + v[j][2] * v[j][2] + v[j][3] * v[j][3]; }
        const float r = rsqrtf(wave_sum(ss, lane) * (1.0f / DM) + EPSF);
#pragma unroll
        for (int j = 0; j < 4; ++j) { const f32x4 w = *(const f32x4*)(p.final_norm_w + j * 256 + lane * 4); *(f32x4*)(dst + j * 256 + lane * 4) = v[j] * r * w; }
    }
}

constexpr int LDS_STAGE = 160 * 1024 - 256;
constexpr int LDS_BYTES = LDS_STAGE + 16;
static_assert(MixLds::END * 4 <= LDS_STAGE && RetLds::END <= LDS_STAGE && SsdLds::END <= LDS_STAGE && 2 * 64 * LDP * 2 <= SsdLds::DT - SsdLds::PS && HgLds::END <= LDS_STAGE && GdLds::END <= LDS_STAGE && pg8::STAGE_BYTES <= LDS_STAGE && 4 * 64 * OSP * 4 <= LDS_STAGE, "LDS carve");

__global__ void __launch_bounds__(512, 2) k_mega(Params p) {
    extern __shared__ __attribute__((aligned(16))) unsigned char smem[];
    LAS unsigned char* lds = (LAS unsigned char*)smem;
    const int blk = blockIdx.x, nblk = gridDim.x;
    volatile LAS unsigned* xbw = (volatile LAS unsigned*)(lds + LDS_STAGE);
    if (threadIdx.x < 4) xbw[threadIdx.x] = 0u;
    __syncthreads();
    XcdBarrier xb = xcd_barrier_post((unsigned*)(p.ws + WS_BAR), xbw);
#ifndef REP_PREP
#define REP_PREP 1
#endif
#ifndef REP_ROWNORM
#define REP_ROWNORM 1
#endif
#ifndef REP_GEMMIN
#define REP_GEMMIN 1
#endif
#ifndef REP_GDNPRE
#define REP_GDNPRE 1
#endif
#ifndef REP_MIXER
#define REP_MIXER 1
#endif
    for (int r = 0; r < REP_PREP; ++r) { ph_prep(p, lds, blk, nblk); if (r + 1 < REP_PREP) xcd_barrier(xb); }
    cooperative_groups::this_grid().sync();
    xcd_barrier(xb);
#pragma unroll 1
    for (int l = 0; l < DEPTH; ++l) {
        for (int r = 0; r < REP_ROWNORM; ++r) { ph_rownorm(p, l, blk, nblk); xcd_barrier(xb); }
        for (int r = 0; r < REP_GEMMIN; ++r) { ph_gemm_in(p, l, lds, blk, nblk); xcd_barrier(xb); }
#ifndef REP_A
#define REP_A 1
#define REP_B 1
#define REP_C 1
#define REP_D 1
#endif
        for (int r = 0; r < REP_A; ++r) { ph_pre1(p, l, lds, blk, nblk); xcd_barrier(xb); }
        for (int r = 0; r < REP_B; ++r) { ph_seq1(p, l, lds, blk, nblk); xcd_barrier(xb); }
        for (int r = 0; r < REP_C; ++r) { ph_pre2(p, l, lds, blk, nblk); xcd_barrier(xb); }
        for (int r = 0; r < REP_D; ++r) { ph_seq2(p, l, lds, blk, nblk); xcd_barrier(xb); }
        ph_gemm_out(p, l, lds, blk, nblk);
        xcd_barrier(xb);
    }
    ph_final(p, blk, nblk);
}

extern "C" void kernel_launch(void* const* d_in, const int* in_sizes, int n_in, void* d_out, int out_size, void* d_ws, size_t ws_size, hipStream_t stream) {
    static int grid = 0;
    if (grid == 0) {
        if (n_in != 27 || (size_t)out_size != O_END || ws_size < WS_END) { fprintf(stderr, "kernel_launch: unexpected shapes: n_in %d out %d (want %zu) ws %zu (want %zu)\n", n_in, out_size, (size_t)O_END, ws_size, (size_t)WS_END); grid = -1; return; }
        if (hipFuncSetAttribute((const void*)k_mega, hipFuncAttributeMaxDynamicSharedMemorySize, LDS_BYTES) != hipSuccess) { fprintf(stderr, "kernel_launch: hipFuncSetAttribute failed\n"); grid = -1; return; }
        int dev = 0, cus = 0, per_cu = 0;
        if (hipGetDevice(&dev) != hipSuccess || hipDeviceGetAttribute(&cus, hipDeviceAttributeMultiprocessorCount, dev) != hipSuccess) { fprintf(stderr, "kernel_launch: device query failed\n"); grid = -1; return; }
        if (hipOccupancyMaxActiveBlocksPerMultiprocessor(&per_cu, (const void*)k_mega, 512, LDS_BYTES) != hipSuccess || per_cu < 1) { fprintf(stderr, "kernel_launch: occupancy query says %d blocks per CU\n", per_cu); grid = -1; return; }
        grid = cus;
    }
    if (grid < 0) return;
    Params p{};
    const float** pp = (const float**)&p;
    for (int i = 0; i < 27; ++i) pp[i] = (const float*)d_in[i];
    p.out = (float*)d_out; p.ws = (unsigned char*)d_ws;
    (void)hipMemsetAsync((unsigned char*)d_ws + WS_BAR, 0, 16384, stream);
    void* args[] = {&p};
    const hipError_t e = hipLaunchCooperativeKernel((const void*)k_mega, dim3(grid), dim3(512), args, LDS_BYTES, stream);
    if (e != hipSuccess) fprintf(stderr, "kernel_launch: cooperative launch failed: %s (grid %d)\n", hipGetErrorString(e), grid);
}
```

```cpp
#include <hip/hip_runtime.h>
#include <hip/hip_cooperative_groups.h>
#include <cstdio>
#include <cstdint>

#define LAS __attribute__((address_space(3)))
typedef unsigned short bf16_t;
typedef short bf16x8 __attribute__((ext_vector_type(8)));
typedef float f32x4 __attribute__((ext_vector_type(4)));
typedef unsigned u32x4 __attribute__((ext_vector_type(4)));
typedef unsigned u32x2 __attribute__((ext_vector_type(2)));

constexpr int DM = 1024, NB = 8, SEQ = 2048, DEPTH = 4, DECB = 128, NMETA = 16, TP = SEQ + NMETA;
constexpr int MP = NB * TP;
constexpr int MROWS = MP + DECB;
constexpr int IN_DIM = 4108, NBIG = 4096, NSM = 12;
constexpr int PASTLEN = 16384;
constexpr float EPSF = 1e-6f;
constexpr int PC_AQ = 0, PC_AF = 256, PC_AI = 512, PC_AZ = 768, PC_BQKV = 1024, PC_BZ = 1792, PC_CXBC = 2048, PC_CZ = 2816, PC_DQ = 3072, PC_DK = 3328, PC_DV = 3584, PC_DZ = 3840;

constexpr size_t WS_BAR = 0;
constexpr size_t WS_WINT = 16384;
constexpr size_t WS_WOUTT = WS_WINT + (size_t)NBIG * DM * 2;
constexpr size_t WS_WSM = WS_WOUTT + (size_t)DM * DM * 2;
constexpr size_t WS_LB = WS_WSM + (size_t)DEPTH * NSM * DM * 4;
constexpr size_t WS_ROT = WS_LB + (size_t)DEPTH * 256 * 4;
constexpr size_t ROT_BYTES = ((size_t)(TP + 1) * 64 * 4 + 255) / 256 * 256;
constexpr size_t WS_H = WS_ROT + ROT_BYTES;
constexpr size_t WS_HB = WS_H + (size_t)MROWS * DM * 4;
constexpr size_t WS_RS = WS_HB + (size_t)MROWS * DM * 2;
constexpr size_t WS_PSM = WS_RS + (size_t)MROWS * 4;
constexpr size_t WS_PROJ = WS_PSM + (size_t)MROWS * NSM * 4;
constexpr size_t WS_Y = WS_PROJ + (size_t)MROWS * NBIG * 2;
constexpr size_t WS_E = WS_Y + (size_t)MROWS * DM * 2;
constexpr size_t WS_END = WS_E + (size_t)NB * 33 * 4 * 41728;

constexpr size_t O_YP = 0;
constexpr size_t O_YS = O_YP + (size_t)NB * SEQ * DM;
constexpr size_t O_HGRN_P = O_YS + (size_t)DECB * DM;
constexpr size_t O_GDN_P = O_HGRN_P + (size_t)DEPTH * NB * 4 * 64 * 64;
constexpr size_t O_GCONV_P = O_GDN_P + (size_t)DEPTH * NB * 4 * 64 * 64;
constexpr size_t O_SSD_P = O_GCONV_P + (size_t)DEPTH * NB * 3 * 768;
constexpr size_t O_SCONV_P = O_SSD_P + (size_t)DEPTH * NB * 4 * 128 * 64;
constexpr size_t O_RET_P = O_SCONV_P + (size_t)DEPTH * NB * 3 * 768;
constexpr size_t O_HGRN_S = O_RET_P + (size_t)DEPTH * NB * 4 * 64 * 64;
constexpr size_t O_GDN_S = O_HGRN_S + (size_t)DEPTH * DECB * 4 * 64 * 64;
constexpr size_t O_GCONV_S = O_GDN_S + (size_t)DEPTH * DECB * 4 * 64 * 64;
constexpr size_t O_SSD_S = O_GCONV_S + (size_t)DEPTH * DECB * 3 * 768;
constexpr size_t O_SCONV_S = O_SSD_S + (size_t)DEPTH * DECB * 4 * 128 * 64;
constexpr size_t O_RET_S = O_SCONV_S + (size_t)DEPTH * DECB * 3 * 768;
constexpr size_t O_END = O_RET_S + (size_t)DEPTH * DECB * 4 * 64 * 64;

struct Params {
    const float* x_prompt; const float* x_sample;
    const float* st_hgrn; const float* st_gdn; const float* st_gconv; const float* st_ssd; const float* st_sconv; const float* st_ret;
    const float* meta; const float* norm_w; const float* w_in; const float* lb_logits; const float* hgrn_norm_w;
    const float* gdn_conv_w; const float* gdn_a_log; const float* gdn_dt_bias; const float* gdn_norm_w;
    const float* ssd_conv_w; const float* ssd_conv_b; const float* ssd_a_log; const float* ssd_dt_bias; const float* ssd_d; const float* ssd_norm_w;
    const float* ret_norm_w; const float* ret_norm_b; const float* w_out; const float* final_norm_w;
    float* out; unsigned char* ws;
};

__device__ __forceinline__ float bf2f(bf16_t b) { return __uint_as_float(((unsigned)b) << 16); }
__device__ __forceinline__ bf16_t f2bf(float f) { unsigned u = __float_as_uint(f); u += 0x7FFFu + ((u >> 16) & 1u); return (bf16_t)(u >> 16); }
__device__ __forceinline__ unsigned pack_bf2(float lo, float hi) { return (unsigned)f2bf(lo) | ((unsigned)f2bf(hi) << 16); }
__device__ __forceinline__ float sigmoid_f(float x) { return 1.0f / (1.0f + __expf(-x)); }
__device__ __forceinline__ float silu_f(float x) { return x / (1.0f + __expf(-x)); }
__device__ __forceinline__ float softplus_f(float x) { return x > 20.0f ? x : log1pf(__expf(x)); }
__device__ __forceinline__ int opaque_tid() { int t = threadIdx.x; asm volatile("" : "+v"(t)); return t; }
__device__ __forceinline__ float lane_xor(float v, int k, int lane) { return __int_as_float(__builtin_amdgcn_ds_bpermute((lane ^ k) << 2, __float_as_int(v))); }
__device__ __forceinline__ float lane_up(float v, int k, int lane) { return __int_as_float(__builtin_amdgcn_ds_bpermute(((lane - k) & 63) << 2, __float_as_int(v))); }
__device__ __forceinline__ float wave_sum(float v, int lane) {
#pragma unroll
    for (int o = 32; o > 0; o >>= 1) v += lane_xor(v, o, lane);
    return v;
}


#define XB_TMO      128
#define XB_XCNT(j)  (256  + 64 * (j))
#define XB_XSUB(j)  (1280 + 64 * (j))
#define XB_XGEN(j)  (2304 + 64 * (j))
#define XB_TOP      3328
#define XB_TOPGEN   3392
#define XCD_BAR_WORDS 3456
#define XB_SPIN_CAP (1u << 22)
__device__ __forceinline__ unsigned xb_ld(unsigned* p)              { return __hip_atomic_load(p, __ATOMIC_RELAXED, __HIP_MEMORY_SCOPE_AGENT); }
__device__ __forceinline__ unsigned xb_add(unsigned* p, unsigned v) { return __hip_atomic_fetch_add(p, v, __ATOMIC_RELAXED, __HIP_MEMORY_SCOPE_AGENT); }
__device__ __forceinline__ unsigned xb_xcc_id() { return (unsigned)__builtin_amdgcn_s_getreg((3 << 11) | 20) & 0xFu; }
#define XB_SPIN(cond, bar) do { unsigned _sp = 0; while (cond) { __builtin_amdgcn_s_sleep(1); \
    if ((++_sp & 255u) == 0u) { if (xb_ld(&(bar)[XB_TMO])) break; if (_sp > XB_SPIN_CAP) { atomicAdd(&(bar)[XB_TMO], 1u); break; } } } } while (0)
struct XcdBarrier { unsigned* bar; unsigned x; volatile LAS unsigned* st; };
__device__ __forceinline__ XcdBarrier xcd_barrier_post(unsigned* bar, volatile LAS unsigned* st) {
    XcdBarrier b; b.bar = bar; b.x = xb_xcc_id(); b.st = st;
    if (threadIdx.x == 0) (void)xb_add(&bar[XB_XCNT(b.x)], 1u);
    return b;
}
__device__ __forceinline__ void xcd_barrier_complete(unsigned* bar, unsigned x, unsigned& nloc, unsigned& nx) {
    const unsigned G = gridDim.x * gridDim.y * gridDim.z;
    unsigned sum, cnt, mine, sp = 0u;
    for (;;) {
        sum = 0u; cnt = 0u; mine = 0u;
#pragma unroll
        for (unsigned j = 0; j < 16; ++j) { const unsigned c = xb_ld(&bar[XB_XCNT(j)]); sum += c; cnt += (c > 0u) ? 1u : 0u; mine = (j == x) ? c : mine; }
        if (sum == G) break;
        __builtin_amdgcn_s_sleep(1);
        if ((++sp & 255u) == 0u) { if (xb_ld(&bar[XB_TMO])) break; if (sp > XB_SPIN_CAP) { atomicAdd(&bar[XB_TMO], 1u); break; } }
    }
    nloc = mine > 0u ? mine : 1u; nx = cnt > 0u ? cnt : 1u;
}
__device__ __forceinline__ void xcd_barrier(const XcdBarrier& b0) {
    asm volatile("s_waitcnt vmcnt(0)" ::: "memory");
    __syncthreads();
    if (threadIdx.x == 0) {
        XcdBarrier b = b0; { unsigned x = xb_xcc_id(); asm volatile("" : "+s"(x)); b.x = x; }
        unsigned* bar = b.bar;
        __builtin_amdgcn_s_waitcnt(0);
        unsigned nloc = b.st[0], nx = b.st[1];
        if (nloc == 0u) { xcd_barrier_complete(bar, b.x, nloc, nx); b.st[0] = nloc; b.st[1] = nx; }
        const unsigned old = xb_add(&bar[XB_XSUB(b.x)], 1u);
        const unsigned gen = old / nloc;
        if (old + 1u == (gen + 1u) * nloc) {
            __builtin_amdgcn_fence(__ATOMIC_RELEASE, "agent");
            asm volatile("s_waitcnt vmcnt(0)" ::: "memory");
            const unsigned og = xb_add(&bar[XB_TOP], 1u);
            const unsigned tg = og / nx;
            if (og + 1u == (tg + 1u) * nx) xb_add(&bar[XB_TOPGEN], 1u);
            else XB_SPIN(xb_ld(&bar[XB_TOPGEN]) == tg, bar);
            __builtin_amdgcn_fence(__ATOMIC_ACQUIRE, "agent");
            xb_add(&bar[XB_XGEN(b.x)], 1u);
            asm volatile("s_waitcnt vmcnt(0)" ::: "memory");
        } else {
            XB_SPIN(xb_ld(&bar[XB_XGEN(b.x)]) == gen, bar);
            __builtin_amdgcn_fence(__ATOMIC_ACQUIRE, "agent");
            asm volatile("s_waitcnt vmcnt(0)" ::: "memory");
        }
    }
    __syncthreads();
}

namespace pg8 {
constexpr int BM = 256, BK = 64, HALF = 128, HTB = HALF * BK * 2, STAGE_BYTES = 8 * HTB, NXCD = 8, WGM = 8;
__host__ __device__ __forceinline__ int lds_byte(int r, int c) { const int st = (r >> 4) * 2 + (c >> 5), rr = r & 15, cc = c & 31, ob = rr * 64 + cc * 2; return st * 1024 + (ob ^ (((ob >> 9) & 1) << 5)); }
__host__ __device__ __forceinline__ void stage_rc(int b, int& R, int& C) { const int st = b / 1024, sb = b % 1024, swz = sb ^ (((sb >> 9) & 1) << 5); R = (st >> 1) * 16 + swz / 64; C = (st & 1) * 32 + (swz % 64) / 2; }
__host__ __device__ __forceinline__ int perm32(int rho) { const int n = rho >> 4, i = rho & 15; return 8 * (i >> 2) + 4 * n + (i & 3); }
struct Unit { int pm, pn; };
struct Gemm { const bf16_t* A; const bf16_t* Bt; int M, N, K; };
struct StaticOrder {
    int nM, nN, nwg, G, c;
    __host__ __device__ void init(int M, int N, int G_, int c_) { nM = M / BM; nN = N / BM; nwg = nM * nN; G = G_; c = c_; }
    __host__ __device__ bool next(int i, Unit& u) const {
        const long L = (long)i * G + c; if (L >= nwg) return false;
        int wgid = (int)L; { const int q = nwg / NXCD, r = nwg % NXCD, xcd = wgid % NXCD, off = wgid / NXCD; wgid = (xcd < r ? xcd * (q + 1) : r * (q + 1) + (xcd - r) * q) + off; }
        const int nig = WGM * nN, gid = wgid / nig, fm = gid * WGM, gsz = (nM - fm) < WGM ? (nM - fm) : WGM;
        u.pm = fm + ((wgid % nig) % gsz); u.pn = (wgid % nig) / gsz; return true;
    }
    __device__ __forceinline__ void a_ready(const Unit&) const {}
    __device__ __forceinline__ void done(const Unit&) const {}
};
typedef float f32x2_t __attribute__((ext_vector_type(2)));
typedef __bf16 bf16x2n_t __attribute__((ext_vector_type(2)));
__device__ __forceinline__ unsigned cvt_pk_bf16(float lo, float hi) { const f32x2_t f = {lo, hi}; return __builtin_bit_cast(unsigned, __builtin_convertvector(f, bf16x2n_t)); }

struct EpiProj {
    static constexpr bool PERM = true, AFTER_DRAIN = false;
    bf16_t* O; int ldc; const float* rs;
    __device__ __forceinline__ void operator()(const f32x4 (&acc)[2][2][4][2], const Unit& u, int wr, int wc, int fr, int fq) const {
        const int row0 = u.pm * BM + wr * 64 + fr; const int col0 = u.pn * BM + wc * 32 + 8 * fq;
#pragma unroll
        for (int ai = 0; ai < 2; ++ai)
#pragma unroll
            for (int m = 0; m < 4; ++m) { const int row = row0 + ai * HALF + m * 16; const float s = rs[row]; bf16_t* rowp = O + (size_t)row * ldc + col0;
#pragma unroll
                for (int bj = 0; bj < 2; ++bj) { const f32x4 v0 = acc[ai][bj][m][0] * s, v1 = acc[ai][bj][m][1] * s;
                    u32x4 w; w.x = cvt_pk_bf16(v0[0], v0[1]); w.y = cvt_pk_bf16(v0[2], v0[3]); w.z = cvt_pk_bf16(v1[0], v1[1]); w.w = cvt_pk_bf16(v1[2], v1[3]);
                    *(u32x4*)(rowp + bj * HALF) = w; } }
    }
};
struct EpiResid {
    static constexpr bool PERM = false, AFTER_DRAIN = false;
    float* C; int ldc;
    __device__ __forceinline__ void operator()(const f32x4 (&acc)[2][2][4][2], const Unit& u, int wr, int wc, int fr, int fq) const {
        const int row0 = u.pm * BM + wr * 64 + fr, col0 = u.pn * BM + wc * 32 + 4 * fq;
#pragma unroll
        for (int ai = 0; ai < 2; ++ai)
#pragma unroll
            for (int m = 0; m < 4; ++m) { float* rowp = C + (size_t)(row0 + ai * HALF + m * 16) * ldc + col0;
#pragma unroll
                for (int bj = 0; bj < 2; ++bj)
#pragma unroll
                    for (int n = 0; n < 2; ++n) { f32x4* p = (f32x4*)(rowp + bj * HALF + n * 16); *p = *p + acc[ai][bj][m][n]; } }
    }
};

template <class Epi, class Sched>
__device__ __forceinline__ void gemm_phase(LAS unsigned char* lds, const Gemm g, const Sched& S, const Epi& E) {
    const int tid = opaque_tid(), wid = __builtin_amdgcn_readfirstlane(tid >> 6), lane = tid & 63, wr = wid >> 2, wc = wid & 3, fr = lane & 15, fq = lane >> 4;
    const int K = g.K, nt = K / BK;
    unsigned voffA[2], voffB[2];
#pragma unroll
    for (int i = 0; i < 2; ++i) { int R, C; stage_rc(tid * 16 + i * 8192, R, C); const int Rb = Epi::PERM ? ((R & ~31) + perm32(R & 31)) : R;
        voffA[i] = (unsigned)(R * K + C) * 2u; voffB[i] = (unsigned)(Rb * K + C) * 2u; }
    const size_t kstep = (size_t)(BK * 2);
    const size_t hstep = (size_t)HALF * K * 2;
    const size_t tstep = 2 * hstep;
    const unsigned ldsw = (unsigned)wid * 1024u;
    const int aoff = lds_byte(wr * 64 + fr, fq * 8), boff = lds_byte(wc * 32 + fr, fq * 8);
#define PG8_SA(b, h) (((b) * 2 + (h)) * HTB)
#define PG8_SB(b, h) ((4 + (b) * 2 + (h)) * HTB)
#define PG8_STAGE(bufoff, gbase, voff) do { _Pragma("unroll") for (int _i = 0; _i < 2; ++_i) \
        __builtin_amdgcn_global_load_lds((const unsigned*)((const char*)(gbase) + (voff)[_i]), (LAS unsigned*)(lds + (bufoff) + ldsw + _i * 8192), 16, 0, 0); } while (0)
#define PG8_LDA(dst, b, h) do { _Pragma("unroll") for (int m = 0; m < 4; ++m) _Pragma("unroll") for (int k = 0; k < 2; ++k) dst[m][k] = *(const LAS bf16x8*)(lds + PG8_SA(b, h) + aoff + m * 2048 + k * 1024); } while (0)
#define PG8_LDB(dst, b, h) do { _Pragma("unroll") for (int n = 0; n < 2; ++n) _Pragma("unroll") for (int k = 0; k < 2; ++k) dst[n][k] = *(const LAS bf16x8*)(lds + PG8_SB(b, h) + boff + n * 2048 + k * 1024); } while (0)
#define PG8_MMA(ai, bj, At, Bt) do { __builtin_amdgcn_s_setprio(1); _Pragma("unroll") for (int m = 0; m < 4; ++m) _Pragma("unroll") for (int n = 0; n < 2; ++n) _Pragma("unroll") for (int k = 0; k < 2; ++k) \
        acc[ai][bj][m][n] = __builtin_amdgcn_mfma_f32_16x16x32_bf16(Bt[n][k], At[m][k], acc[ai][bj][m][n], 0, 0, 0); __builtin_amdgcn_s_setprio(0); } while (0)
#define PG8_WAIT_V(n) asm volatile("s_waitcnt vmcnt(" #n ")" ::: "memory")
#define PG8_WAIT_L(n) asm volatile("s_waitcnt lgkmcnt(" #n ")" ::: "memory")
#define PG8_BAR __builtin_amdgcn_s_barrier()
#define PG8_SCHED __builtin_amdgcn_sched_barrier(0)
    Unit cur, nxt; int ui = 0;
    if (!S.next(0, cur)) return;
    f32x4 acc[2][2][4][2];
#pragma unroll
    for (int a = 0; a < 2; ++a)
#pragma unroll
        for (int b = 0; b < 2; ++b)
#pragma unroll
            for (int m = 0; m < 4; ++m)
#pragma unroll
                for (int n = 0; n < 2; ++n) acc[a][b][m][n] = (f32x4){0.f, 0.f, 0.f, 0.f};
    bf16x8 At[4][2], B0[2][2], B1[2][2];
    const char* cA = (const char*)g.A + (size_t)cur.pm * tstep; const char* cB = (const char*)g.Bt + (size_t)cur.pn * tstep;
    S.a_ready(cur);
    PG8_STAGE(PG8_SB(0, 0), cB, voffB); PG8_STAGE(PG8_SA(0, 0), cA, voffA); PG8_STAGE(PG8_SB(0, 1), cB + hstep, voffB); PG8_STAGE(PG8_SA(0, 1), cA + hstep, voffA);
    if (wr == 1) PG8_BAR;
    PG8_WAIT_V(4); PG8_BAR;
    PG8_STAGE(PG8_SB(1, 0), cB + kstep, voffB); PG8_STAGE(PG8_SA(1, 0), cA + kstep, voffA); PG8_STAGE(PG8_SB(1, 1), cB + hstep + kstep, voffB);
    PG8_WAIT_V(6); PG8_BAR;
    for (;;) {
        const bool has_next = S.next(ui + 1, nxt);
        const char* nA = has_next ? (const char*)g.A + (size_t)nxt.pm * tstep : cA; const char* nB = has_next ? (const char*)g.Bt + (size_t)nxt.pn * tstep : cB;
        for (int t = 0; t < nt; t += 2) {
            const bool last = (t == nt - 2);
            const char* a1 = cA + (size_t)(t + 1) * kstep;
            const char* a2 = last ? nA : cA + (size_t)(t + 2) * kstep; const char* b2 = last ? nB : cB + (size_t)(t + 2) * kstep;
            const char* a3 = a2 + kstep; const char* b3 = b2 + kstep;
            if (last && has_next) S.a_ready(nxt);
            PG8_LDB(B0, 0, 0); PG8_SCHED; PG8_LDA(At, 0, 0); PG8_STAGE(PG8_SA(1, 1), a1 + hstep, voffA);
            PG8_WAIT_L(8); PG8_BAR; PG8_WAIT_L(0); PG8_MMA(0, 0, At, B0); PG8_BAR; PG8_SCHED;
            PG8_LDB(B1, 0, 1); PG8_STAGE(PG8_SB(0, 0), b2, voffB);
            PG8_BAR; PG8_WAIT_L(0); PG8_MMA(0, 1, At, B1); PG8_BAR;
            PG8_LDA(At, 0, 1); PG8_STAGE(PG8_SA(0, 0), a2, voffA);
            PG8_BAR; PG8_WAIT_L(0); PG8_MMA(1, 0, At, B0); PG8_BAR; PG8_SCHED;
            PG8_STAGE(PG8_SB(0, 1), b2 + hstep, voffB);
            PG8_WAIT_V(6); PG8_BAR; PG8_MMA(1, 1, At, B1); PG8_BAR;
            PG8_LDB(B0, 1, 0); PG8_SCHED; PG8_LDA(At, 1, 0); PG8_STAGE(PG8_SA(0, 1), a2 + hstep, voffA);
            PG8_WAIT_L(8); PG8_BAR; PG8_WAIT_L(0); PG8_MMA(0, 0, At, B0); PG8_BAR; PG8_SCHED;
            PG8_LDB(B1, 1, 1); PG8_STAGE(PG8_SB(1, 0), b3, voffB);
            PG8_BAR; PG8_WAIT_L(0); PG8_MMA(0, 1, At, B1); PG8_BAR;
            PG8_LDA(At, 1, 1); PG8_STAGE(PG8_SA(1, 0), a3, voffA);
            PG8_BAR; PG8_WAIT_L(0); PG8_MMA(1, 0, At, B0); PG8_BAR; PG8_SCHED;
            PG8_STAGE(PG8_SB(1, 1), b3 + hstep, voffB);
            PG8_WAIT_V(6); PG8_BAR; PG8_MMA(1, 1, At, B1); PG8_BAR;
        }
        if constexpr (!Epi::AFTER_DRAIN) { E(acc, cur, wr, wc, fr, fq); S.done(cur); }
        if (!has_next) break;
#pragma unroll
        for (int a = 0; a < 2; ++a)
#pragma unroll
            for (int b = 0; b < 2; ++b)
#pragma unroll
                for (int m = 0; m < 4; ++m)
#pragma unroll
                    for (int n = 0; n < 2; ++n) acc[a][b][m][n] = (f32x4){0.f, 0.f, 0.f, 0.f};
        cur = nxt; cA = nA; cB = nB; ++ui;
    }
    PG8_WAIT_V(0);
    if (wr == 0) PG8_BAR;
    PG8_BAR;
#undef PG8_SA
#undef PG8_SB
#undef PG8_STAGE
#undef PG8_LDA
#undef PG8_LDB
#undef PG8_MMA
#undef PG8_WAIT_V
#undef PG8_WAIT_L
#undef PG8_BAR
#undef PG8_SCHED
}
}

__device__ __forceinline__ int win_col(int n) { return n < 2048 ? n : (n < 3072 ? n + 8 : n + 12); }
__device__ __forceinline__ int win_smcol(int j) { return j < 8 ? 2048 + j : 3080 + (j - 8); }

__device__ __forceinline__ void convert_weights(const Params& p, int l_in, int l_out, LAS float* tile  , int tid, int blk, int nblk) {
    const int tiles_in = l_in >= 0 ? 64 * 16 : 0, tiles_out = l_out >= 0 ? 16 * 16 : 0;
    for (int t = blk; t < tiles_in + tiles_out; t += nblk) {
        const float* src; bf16_t* dst; int ld, n0, k0; const float* scale;
        if (t < tiles_in) { n0 = (t / 16) * 64; k0 = (t % 16) * 64; src = p.w_in + (size_t)l_in * DM * IN_DIM + win_col(n0); ld = IN_DIM; dst = (bf16_t*)(p.ws + WS_WINT); scale = p.norm_w + l_in * DM; }
        else { const int r = t - tiles_in; n0 = (r / 16) * 64; k0 = (r % 16) * 64; src = p.w_out + (size_t)l_out * DM * DM + n0; ld = DM; dst = (bf16_t*)(p.ws + WS_WOUTT); scale = nullptr; }
        __syncthreads();
#pragma unroll
        for (int e = tid; e < 64 * 64; e += 512) { const int kk = e >> 6, nn = e & 63; float v = src[(size_t)(k0 + kk) * ld + nn]; if (scale) v *= scale[k0 + kk]; tile[kk * 65 + nn] = v; }
        __syncthreads();
#pragma unroll
        for (int e = tid; e < 64 * 32; e += 512) { const int nn = e >> 5, kp = (e & 31) * 2; const unsigned w = pack_bf2(tile[kp * 65 + nn], tile[(kp + 1) * 65 + nn]);
            *(unsigned*)(dst + (size_t)(n0 + nn) * DM + k0 + kp) = w; }
    }
    __syncthreads();
}

__device__ void ph_prep(const Params& p_in, LAS unsigned char* lds_in, int blk, int nblk) {
    Params p = p_in; asm volatile("" : "+s"(p.ws), "+s"(p.out));
    LAS unsigned char* lds = lds_in; asm volatile("" : "+s"(lds));

    const int tid = opaque_tid();
    LAS float* tile = (LAS float*)lds;
    convert_weights(p, 0, 0, tile, tid, blk, nblk);
    for (int e = blk * 512 + tid; e < DEPTH * NSM * DM; e += nblk * 512) { const int l = e / (NSM * DM), r = e % (NSM * DM), j = r / DM, k = r % DM;
        ((float*)(p.ws + WS_WSM))[e] = p.w_in[(size_t)l * DM * IN_DIM + (size_t)k * IN_DIM + win_smcol(j)] * p.norm_w[l * DM + k]; }
    for (int c = blk * 512 + tid; c < 256; c += nblk * 512) { float lg[DEPTH], mx = -1e30f;
#pragma unroll
        for (int l = 0; l < DEPTH; ++l) { lg[l] = p.lb_logits[l * 256 + c]; mx = fmaxf(mx, lg[l]); }
        float s = 0.f;
#pragma unroll
        for (int l = 0; l < DEPTH; ++l) { lg[l] = expf(lg[l] - mx); s += lg[l]; }
        float cum = 0.f; const float w0 = lg[0] / s;
#pragma unroll
        for (int l = 0; l < DEPTH; ++l) { cum += lg[l] / s; ((float*)(p.ws + WS_LB))[l * 256 + c] = fmaxf(cum - w0, 0.f); } }
    for (int e = blk * 512 + tid; e < (TP + 1) * 32; e += nblk * 512) { const int pi = e >> 5, i = e & 31; const double pos = pi < TP ? (double)pi : (double)PASTLEN;
        const float invf = (float)(1.0 / pow(10000.0, (double)((float)i / 31.0f)));
        const double rev = pos * (double)invf * 0.15915494309189535; const float fr = (float)(rev - rint(rev));
        ((float*)(p.ws + WS_ROT))[e * 2 + 0] = __builtin_amdgcn_cosf(fr); ((float*)(p.ws + WS_ROT))[e * 2 + 1] = __builtin_amdgcn_sinf(fr); }
    float* h = (float*)(p.ws + WS_H);
    for (int e = blk * 512 + tid; e < MROWS * (DM / 4); e += nblk * 512) { const int row = e >> 8, c4 = (e & 255) * 4; const float* src;
        if (row < MP) { const int b = row / TP, t = row % TP; src = t < NMETA ? p.meta + t * DM : p.x_prompt + ((size_t)b * SEQ + (t - NMETA)) * DM; } else src = p.x_sample + (size_t)(row - MP) * DM;
        *(f32x4*)(h + (size_t)row * DM + c4) = *(const f32x4*)(src + c4); }
}

__device__ void ph_rownorm(const Params& p_in, int layer, int blk, int nblk) {
    Params p = p_in; asm volatile("" : "+s"(p.ws), "+s"(p.out));

    const int tid = opaque_tid(), wid = tid >> 6, lane = tid & 63;
    const float* h = (const float*)(p.ws + WS_H); bf16_t* hb = (bf16_t*)(p.ws + WS_HB); float* rs = (float*)(p.ws + WS_RS); float* psm = (float*)(p.ws + WS_PSM);
    const float* wsm = (const float*)(p.ws + WS_WSM) + (size_t)layer * NSM * DM;
    for (int row = blk * 8 + wid; row < MROWS; row += nblk * 8) {
        f32x4 v[4]; float ss = 0.f;
#pragma unroll
        for (int j = 0; j < 4; ++j) { v[j] = *(const f32x4*)(h + (size_t)row * DM + j * 256 + lane * 4); ss += v[j][0] * v[j][0] + v[j][1] * v[j][1] + v[j][2] * v[j][2] + v[j][3] * v[j][3]; }
        ss = wave_sum(ss, lane); const float r = rsqrtf(ss * (1.0f / DM) + EPSF);
#pragma unroll
        for (int j = 0; j < 4; ++j) { u32x2 w; w.x = pack_bf2(v[j][0], v[j][1]); w.y = pack_bf2(v[j][2], v[j][3]); *(u32x2*)(hb + (size_t)row * DM + j * 256 + lane * 4) = w; }
        float mine = 0.f;
        for (int q = 0; q < NSM; ++q) { float d = 0.f;
#pragma unroll
            for (int j = 0; j < 4; ++j) { const f32x4 w = *(const f32x4*)(wsm + q * DM + j * 256 + lane * 4); d += v[j][0] * w[0] + v[j][1] * w[1] + v[j][2] * w[2] + v[j][3] * w[3]; }
            d = wave_sum(d, lane); if (lane == q) mine = d * r; }
        if (lane < NSM) psm[(size_t)row * NSM + lane] = mine;
        if (lane == 0) rs[row] = r;
    }
}

__device__ void ph_gemm_in(const Params& p_in, int layer, LAS unsigned char* lds_in, int blk, int nblk) {
    Params p = p_in; asm volatile("" : "+s"(p.ws), "+s"(p.out));
    LAS unsigned char* lds = lds_in; asm volatile("" : "+s"(lds));

    pg8::Gemm g{(const bf16_t*)(p.ws + WS_HB), (const bf16_t*)(p.ws + WS_WINT), MROWS, NBIG, DM};
    pg8::StaticOrder S; S.init(MROWS, NBIG, nblk, blk);
    pg8::EpiProj E{(bf16_t*)(p.ws + WS_PROJ), NBIG, (const float*)(p.ws + WS_RS)};
    pg8::gemm_phase<pg8::EpiProj, pg8::StaticOrder>(lds, g, S, E);
}
__device__ void ph_gemm_out(const Params& p_in, int layer, LAS unsigned char* lds_in, int blk, int nblk) {
    Params p = p_in; asm volatile("" : "+s"(p.ws), "+s"(p.out));
    LAS unsigned char* lds = lds_in; asm volatile("" : "+s"(lds));

    pg8::Gemm g{(const bf16_t*)(p.ws + WS_Y), (const bf16_t*)(p.ws + WS_WOUTT), MROWS, DM, DM};
    pg8::StaticOrder S; S.init(MROWS, DM, nblk, blk);
    pg8::EpiResid E{(float*)(p.ws + WS_H), DM};
    pg8::gemm_phase<pg8::EpiResid, pg8::StaticOrder>(lds, g, S, E);
}

constexpr int TB = 16;
struct MixLds {
    static constexpr int QS = 0, KS = QS + TB * 128, VS = KS + TB * 128, DS = VS + TB * 128, ZS = DS + TB * 128, XS = ZS + TB * 128, OS = XS + TB * 128, BS = OS + TB * 128, SC = BS + TB * 2, END = SC + TB * 2;
};

struct SeqInfo { int row0, T, dec, b; };
__device__ __forceinline__ SeqInfo seq_info(int s) { SeqInfo q; if (s < NB) { q.row0 = s * TP; q.T = TP; q.dec = 0; q.b = s; } else { q.row0 = MP + (s - NB); q.T = 1; q.dec = 1; q.b = s - NB; } return q; }

__device__ __forceinline__ float preconv(const bf16_t* proj, const SeqInfo& q, int t, int col, const float* ctx  , int ch) {
    if (t >= 0) return bf2f(proj[(size_t)(q.row0 + t) * NBIG + col]);
    return ctx ? ctx[(3 + t) * 768 + ch] : 0.f;
}

template <int DK, int NV, bool DELTA, bool VECDEC>
__device__ __forceinline__ void recur_batch(float (&S)[DK / (64 / NV)], LAS float* L, int nb, int wid, int lane) {
    constexpr int KQ = 64 / NV, KR = DK / KQ, DVT = 8 * NV;
    const int kq = lane / NV, vv = lane % NV, vcol = wid * NV + vv, hh = vcol >> 6;
    for (int t = 0; t < nb; ++t) {
        float kk[KR], qq[KR];
#pragma unroll
        for (int i = 0; i < KR; ++i) { kk[i] = L[MixLds::KS + t * 128 + kq * KR + i]; qq[i] = L[MixLds::QS + t * 128 + kq * KR + i]; }
        const float v = L[MixLds::VS + t * 128 + vcol];
        if (DELTA) {
            const float dec = L[MixLds::DS + t * 128 + hh]; float pk = 0.f;
#pragma unroll
            for (int i = 0; i < KR; ++i) { S[i] *= dec; pk += kk[i] * S[i]; }
#pragma unroll
            for (int o = NV; o < 64; o <<= 1) pk += lane_xor(pk, o, lane);
            const float u = L[MixLds::BS + t] * (v - pk);
#pragma unroll
            for (int i = 0; i < KR; ++i) S[i] += kk[i] * u;
        } else if (VECDEC) {
#pragma unroll
            for (int i = 0; i < KR; ++i) S[i] = L[MixLds::DS + t * 128 + kq * KR + i] * S[i] + kk[i] * v;
        } else {
            const float dec = L[MixLds::DS + t * 128 + hh];
#pragma unroll
            for (int i = 0; i < KR; ++i) S[i] = dec * S[i] + kk[i] * v;
        }
        float po = 0.f;
#pragma unroll
        for (int i = 0; i < KR; ++i) po += qq[i] * S[i];
#pragma unroll
        for (int o = NV; o < 64; o <<= 1) po += lane_xor(po, o, lane);
        if (kq == 0) L[MixLds::OS + t * 128 + vcol] = po;
    }
    (void)DVT;
}

template <int MIX>
__device__ void mixer_item(const Params& p, int layer, int s, int hu  , LAS float* L) {
    constexpr int DK = MIX == 2 ? 128 : 64, NV = MIX == 2 ? 16 : 8, KQ = 64 / NV, KR = DK / KQ, DVT = 8 * NV;
    const int tid = opaque_tid(), wid = tid >> 6, lane = tid & 63;
    const SeqInfo q = seq_info(s);
    const bf16_t* proj = (const bf16_t*)(p.ws + WS_PROJ); const float* psm = (const float*)(p.ws + WS_PSM); bf16_t* y = (bf16_t*)(p.ws + WS_Y);
    const float* lb = (const float*)(p.ws + WS_LB) + layer * 256; const float* rot = (const float*)(p.ws + WS_ROT);
    const int kq = lane / NV, vv = lane % NV, vcol = wid * NV + vv, hh = vcol >> 6;
    const int head = MIX == 2 ? hu * 2 + hh : hu;
    const float* ctx = nullptr; const float* cw = nullptr;
    if (MIX == 1) { cw = p.gdn_conv_w + (size_t)layer * 4 * 768; if (q.dec) ctx = p.st_gconv + ((size_t)layer * DECB + q.b) * 3 * 768; }
    if (MIX == 2) { cw = p.ssd_conv_w + (size_t)layer * 4 * 768; if (q.dec) ctx = p.st_sconv + ((size_t)layer * DECB + q.b) * 3 * 768; }
    float S[KR];
    {
        const float* st = MIX == 0 ? p.st_hgrn : MIX == 1 ? p.st_gdn : MIX == 2 ? p.st_ssd : p.st_ret;
#pragma unroll
        for (int i = 0; i < KR; ++i) S[i] = q.dec ? st[(((size_t)layer * DECB + q.b) * 4 + head) * DK * 64 + (size_t)(kq * KR + i) * 64 + (vcol & 63)] : 0.f;
    }
    float hc0 = 0.f, hc1 = 0.f;
    if (MIX == 1) { hc0 = -__expf(p.gdn_a_log[layer * 4 + hu]); hc1 = p.gdn_dt_bias[layer * 4 + hu]; }
    if (MIX == 3) { hc0 = 1.0f - exp2f(-5.0f - (float)hu); }

    for (int t0 = 0; t0 < q.T; t0 += TB) {
        const int nb = min(TB, q.T - t0);
        __syncthreads();
        if (MIX == 0) {
            for (int e = tid; e < nb * 64; e += 512) { const int t = e >> 6, d = e & 63, c = hu * 64 + d; const bf16_t* pr = proj + (size_t)(q.row0 + t0 + t) * NBIG;
                const float aq = bf2f(pr[PC_AQ + c]), af = bf2f(pr[PC_AF + c]), ai = bf2f(pr[PC_AI + c]), az = bf2f(pr[PC_AZ + c]), l_ = lb[c];
                L[MixLds::QS + t * 128 + d] = silu_f(aq) * 0.125f; L[MixLds::KS + t * 128 + d] = (1.0f - l_) * sigmoid_f(-af); L[MixLds::DS + t * 128 + d] = l_ + (1.0f - l_) * sigmoid_f(af);
                L[MixLds::VS + t * 128 + d] = ai; L[MixLds::ZS + t * 128 + d] = az; }
        } else if (MIX == 1) {
            for (int e = tid; e < nb * 192; e += 512) { const int t = e / 192, r = e % 192, part = r >> 6, d = r & 63, ch = part * 256 + hu * 64 + d, col = PC_BQKV + ch; const int tt = t0 + t;
                float a = 0.f;
#pragma unroll
                for (int j = 0; j < 4; ++j) a += cw[j * 768 + ch] * preconv(proj, q, tt - 3 + j, col, ctx, ch);
                a = silu_f(a);
                L[(part == 0 ? MixLds::QS : part == 1 ? MixLds::KS : MixLds::VS) + t * 128 + d] = a; }
            for (int e = tid; e < nb * 64; e += 512) { const int t = e >> 6, d = e & 63; L[MixLds::ZS + t * 128 + d] = bf2f(proj[(size_t)(q.row0 + t0 + t) * NBIG + PC_BZ + hu * 64 + d]); }
            if (tid < nb) { const float* ps = psm + (size_t)(q.row0 + t0 + tid) * NSM; const float g = hc0 * softplus_f(ps[hu] + hc1);
                L[MixLds::DS + tid * 128 + 0] = __expf(g); L[MixLds::BS + tid] = sigmoid_f(ps[4 + hu]); }
            __syncthreads();
            if (tid < nb * 2) { const int t = tid >> 1, which = tid & 1; const LAS float* src = L + (which ? MixLds::KS : MixLds::QS) + t * 128; float ss = 0.f;
                for (int d = 0; d < 64; ++d) ss += src[d] * src[d];
                L[MixLds::SC + tid] = rsqrtf(ss + EPSF) * (which ? 1.0f : 0.125f); }
            __syncthreads();
            for (int e = tid; e < nb * 128; e += 512) { const int t = e >> 7, r = e & 127, which = r >> 6, d = r & 63; L[(which ? MixLds::KS : MixLds::QS) + t * 128 + d] *= L[MixLds::SC + t * 2 + which]; }
        } else if (MIX == 2) {
            if (tid < nb * 2) { const int t = tid >> 1, h2 = tid & 1, hd = hu * 2 + h2; const float dt = softplus_f(psm[(size_t)(q.row0 + t0 + t) * NSM + 8 + hd] + p.ssd_dt_bias[layer * 4 + hd]);
                L[MixLds::BS + tid] = dt; L[MixLds::DS + t * 128 + h2] = __expf(-dt * __expf(p.ssd_a_log[layer * 4 + hd])); }
            __syncthreads();
            for (int e = tid; e < nb * 384; e += 512) { const int t = e / 384, r = e % 384, part = r >> 7, j = r & 127, ch = part * 256 + hu * 128 + j, col = PC_CXBC + ch; const int tt = t0 + t;
                float a = p.ssd_conv_b[layer * 768 + ch];
#pragma unroll
                for (int jj = 0; jj < 4; ++jj) a += cw[jj * 768 + ch] * preconv(proj, q, tt - 3 + jj, col, ctx, ch);
                a = silu_f(a);
                if (part == 0) { L[MixLds::XS + t * 128 + j] = a; L[MixLds::VS + t * 128 + j] = a * L[MixLds::BS + t * 2 + (j >> 6)]; }
                else if (part == 1) L[MixLds::KS + t * 128 + j] = a; else L[MixLds::QS + t * 128 + j] = a; }
            for (int e = tid; e < nb * 128; e += 512) { const int t = e >> 7, j = e & 127; L[MixLds::ZS + t * 128 + j] = bf2f(proj[(size_t)(q.row0 + t0 + t) * NBIG + PC_CZ + hu * 128 + j]); }
        } else {
            for (int e = tid; e < nb * 32; e += 512) { const int t = e >> 5, i = e & 31; const bf16_t* pr = proj + (size_t)(q.row0 + t0 + t) * NBIG; const int pidx = q.dec ? TP : (t0 + t);
                const float cs = rot[(pidx * 32 + i) * 2], sn = rot[(pidx * 32 + i) * 2 + 1];
                const float q1 = bf2f(pr[PC_DQ + hu * 64 + i]), q2 = bf2f(pr[PC_DQ + hu * 64 + 32 + i]), k1 = bf2f(pr[PC_DK + hu * 64 + i]), k2 = bf2f(pr[PC_DK + hu * 64 + 32 + i]);
                L[MixLds::QS + t * 128 + i] = q1 * cs - q2 * sn; L[MixLds::QS + t * 128 + 32 + i] = q2 * cs + q1 * sn;
                L[MixLds::KS + t * 128 + i] = (k1 * cs - k2 * sn) * 0.125f; L[MixLds::KS + t * 128 + 32 + i] = (k2 * cs + k1 * sn) * 0.125f; }
            for (int e = tid; e < nb * 64; e += 512) { const int t = e >> 6, d = e & 63; const bf16_t* pr = proj + (size_t)(q.row0 + t0 + t) * NBIG;
                L[MixLds::VS + t * 128 + d] = bf2f(pr[PC_DV + hu * 64 + d]); L[MixLds::ZS + t * 128 + d] = bf2f(pr[PC_DZ + hu * 64 + d]); }
            if (tid < nb) L[MixLds::DS + tid * 128] = hc0;
        }
        __syncthreads();
        recur_batch<DK, NV, MIX == 1, MIX == 0>(S, L, nb, wid, lane);
        __syncthreads();
        for (int t = wid; t < nb; t += 8) {
            const size_t yrow = (size_t)(q.row0 + t0 + t) * DM;
            if (MIX == 0 || MIX == 1) { const float o = L[MixLds::OS + t * 128 + lane]; const float ms = wave_sum(o * o, lane) * (1.0f / 64.0f);
                const float w = (MIX == 0 ? p.hgrn_norm_w : p.gdn_norm_w)[layer * 256 + hu * 64 + lane];
                y[yrow + (MIX == 0 ? 0 : 256) + hu * 64 + lane] = f2bf(o * rsqrtf(ms + EPSF) * w * silu_f(L[MixLds::ZS + t * 128 + lane])); }
            else if (MIX == 2) { float u[2]; float ss = 0.f;
#pragma unroll
                for (int r = 0; r < 2; ++r) { const int j = lane + 64 * r; const float o = L[MixLds::OS + t * 128 + j] + p.ssd_d[layer * 4 + hu * 2 + r] * L[MixLds::XS + t * 128 + j]; u[r] = o * silu_f(L[MixLds::ZS + t * 128 + j]); ss += u[r] * u[r]; }
                const float sc = rsqrtf(wave_sum(ss, lane) * (1.0f / 128.0f) + EPSF);
#pragma unroll
                for (int r = 0; r < 2; ++r) { const int j = lane + 64 * r; y[yrow + 512 + hu * 128 + j] = f2bf(u[r] * sc * p.ssd_norm_w[layer * 256 + hu * 128 + j]); } }
            else { const float o = L[MixLds::OS + t * 128 + lane]; const float mu = wave_sum(o, lane) * (1.0f / 64.0f); const float dv = o - mu; const float var = wave_sum(dv * dv, lane) * (1.0f / 64.0f);
                const int c = hu * 64 + lane;
                y[yrow + 768 + c] = f2bf((dv * rsqrtf(var + EPSF) * p.ret_norm_w[layer * 256 + c] + p.ret_norm_b[layer * 256 + c]) * silu_f(L[MixLds::ZS + t * 128 + lane])); }
        }
    }
    {
        float* so = p.out + (q.dec ? (MIX == 0 ? O_HGRN_S : MIX == 1 ? O_GDN_S : MIX == 2 ? O_SSD_S : O_RET_S) : (MIX == 0 ? O_HGRN_P : MIX == 1 ? O_GDN_P : MIX == 2 ? O_SSD_P : O_RET_P));
        const int nbt = q.dec ? DECB : NB;
#pragma unroll
        for (int i = 0; i < KR; ++i) so[(((size_t)layer * nbt + q.b) * 4 + head) * DK * 64 + (size_t)(kq * KR + i) * 64 + (vcol & 63)] = S[i];
    }
    if (MIX == 1 || MIX == 2) {
        float* co = p.out + (q.dec ? (MIX == 1 ? O_GCONV_S : O_SCONV_S) : (MIX == 1 ? O_GCONV_P : O_SCONV_P)) + ((size_t)layer * (q.dec ? DECB : NB) + q.b) * 3 * 768;
        const int nch = MIX == 1 ? 192 : 384;
        for (int e = tid; e < 3 * nch; e += 512) { const int r = e / nch, c = e % nch; int ch;
            if (MIX == 1) ch = (c >> 6) * 256 + hu * 64 + (c & 63); else ch = (c >> 7) * 256 + hu * 128 + (c & 127);
            co[r * 768 + ch] = preconv(proj, q, q.T - 3 + r, (MIX == 1 ? PC_BQKV : PC_CXBC) + ch, ctx, ch); }
    }
    (void)DVT;
}

constexpr int NCHUNK = 33;
constexpr int LDP = 72;
constexpr int LDP2 = 136;
constexpr int OSP = 68;
typedef short bf16x4 __attribute__((ext_vector_type(4)));
__device__ __forceinline__ f32x4 mfma16(bf16x8 a, bf16x8 b, f32x4 c) { return __builtin_amdgcn_mfma_f32_16x16x32_bf16(a, b, c, 0, 0, 0); }
__device__ __forceinline__ float fexp2(float x) { return __builtin_amdgcn_exp2f(x); }
__device__ __forceinline__ bf16x8 frag_ld(const LAS bf16_t* t, int pitch, int row, int col) { return *(const LAS bf16x8*)(t + row * pitch + col); }
__device__ __forceinline__ bf16x8 frag_ld_perm(const LAS bf16_t* t, int pitch, int row, int k0, int q) {
    const bf16x4 lo = *(const LAS bf16x4*)(t + row * pitch + k0 + 4 * q), hi = *(const LAS bf16x4*)(t + row * pitch + k0 + 16 + 4 * q);
    return __builtin_shufflevector(lo, hi, 0, 1, 2, 3, 4, 5, 6, 7);
}
__device__ __forceinline__ bf16x8 pack_acc2(const f32x4& a, const f32x4& b) {
    u32x4 w; w.x = pg8::cvt_pk_bf16(a[0], a[1]); w.y = pg8::cvt_pk_bf16(a[2], a[3]); w.z = pg8::cvt_pk_bf16(b[0], b[1]); w.w = pg8::cvt_pk_bf16(b[2], b[3]);
    return __builtin_bit_cast(bf16x8, w);
}
__device__ __forceinline__ void st_bf4(LAS bf16_t* dst, const f32x4& v) { u32x2 w; w.x = pg8::cvt_pk_bf16(v[0], v[1]); w.y = pg8::cvt_pk_bf16(v[2], v[3]); *(LAS u32x2*)dst = w; }
__device__ __forceinline__ void unpack_bf8(const u32x4& w, float* a) { const unsigned x[4] = {w.x, w.y, w.z, w.w};
#pragma unroll
    for (int k = 0; k < 4; ++k) { a[2 * k] = __uint_as_float(x[k] << 16); a[2 * k + 1] = __uint_as_float(x[k] & 0xffff0000u); } }
__device__ __forceinline__ u32x4 pack_bf8(const float* a) { u32x4 w; w.x = pg8::cvt_pk_bf16(a[0], a[1]); w.y = pg8::cvt_pk_bf16(a[2], a[3]); w.z = pg8::cvt_pk_bf16(a[4], a[5]); w.w = pg8::cvt_pk_bf16(a[6], a[7]); return w; }

constexpr size_t HR_QF = 0, HR_OI = 8192, HR_DS = 16384, HR_VEC = 24576, HR_UNIT = 25088;
constexpr size_t SS_QF = 0, SS_HEAD = 16384  , SS_VEC = 65536  , SS_UNIT = 66560;
constexpr size_t GD_U = 0, GD_W = 8192, GD_Q = 16384, GD_P = 24576, GD_K = 32768, GD_VEC = 40960, GD_UNIT = 41728;
constexpr size_t YOFF_R = 37748736;
static_assert((size_t)NB * NCHUNK * 2 * SS_UNIT <= YOFF_R && YOFF_R + (size_t)NB * NCHUNK * 4 * HR_UNIT <= (size_t)NB * SEQ * DM * 4 && (size_t)NB * NCHUNK * 4 * HR_UNIT <= (size_t)MROWS * DM * 2 && (size_t)NB * NCHUNK * 4 * GD_UNIT == WS_END - WS_E, "scratch map");
__device__ __forceinline__ unsigned char* rec_hgrn(const Params& p, int b, int c, int h) { return p.ws + WS_HB + (size_t)((b * NCHUNK + c) * 4 + h) * HR_UNIT; }
__device__ __forceinline__ unsigned char* rec_ret(const Params& p, int b, int c, int h) { return (unsigned char*)(p.out + O_YP) + YOFF_R + (size_t)((b * NCHUNK + c) * 4 + h) * HR_UNIT; }
__device__ __forceinline__ unsigned char* rec_gdn(const Params& p, int b, int c, int h) { return p.ws + WS_E + (size_t)((b * NCHUNK + c) * 4 + h) * GD_UNIT; }
__device__ __forceinline__ unsigned char* rec_ssd(const Params& p, int b, int c, int g) { return (unsigned char*)(p.out + O_YP) + (size_t)((b * NCHUNK + c) * 2 + g) * SS_UNIT; }
__device__ __forceinline__ bf16x8 frag_scale(const bf16x8& f, const float (&sc)[8]) { const u32x4 w = __builtin_bit_cast(u32x4, f); float a[8]; unpack_bf8(w, a);
#pragma unroll
    for (int e = 0; e < 8; ++e) a[e] *= sc[e];
    return __builtin_bit_cast(bf16x8, pack_bf8(a)); }
__device__ __forceinline__ void st_acc_bf4(unsigned char* dst, const f32x4& v) { u32x2 w; w.x = pg8::cvt_pk_bf16(v[0], v[1]); w.y = pg8::cvt_pk_bf16(v[2], v[3]); *(u32x2*)dst = w; }
__device__ __forceinline__ f32x4 ld_acc_bf4(const unsigned char* src) { const u32x2 w = *(const u32x2*)src; return (f32x4){__uint_as_float(w.x << 16), __uint_as_float(w.x & 0xffff0000u), __uint_as_float(w.y << 16), __uint_as_float(w.y & 0xffff0000u)}; }

struct RetLds { static constexpr int QS = 0, KS = QS + 64 * LDP * 2, KT = KS + 64 * LDP * 2, VT = KT + 64 * LDP * 2, VH = VT + 64 * LDP * 2, PS = VH + 64 * LDP * 2, END = PS + 64 * LDP * 2; };
__device__ void ret_pre_unit(const Params& p, int layer, int b, int c, int hu, LAS unsigned char* lds) {
    const int tid = opaque_tid(), wid = tid >> 6, lane = tid & 63, fq = lane >> 4, fc = lane & 15;
    LAS bf16_t* Qs = (LAS bf16_t*)(lds + RetLds::QS); LAS bf16_t* Ks = (LAS bf16_t*)(lds + RetLds::KS); LAS bf16_t* KT = (LAS bf16_t*)(lds + RetLds::KT);
    LAS bf16_t* VT = (LAS bf16_t*)(lds + RetLds::VT); LAS bf16_t* VH = (LAS bf16_t*)(lds + RetLds::VH); LAS bf16_t* Ps = (LAS bf16_t*)(lds + RetLds::PS);
    const bf16_t* proj = (const bf16_t*)(p.ws + WS_PROJ); const float* rot = (const float*)(p.ws + WS_ROT);
    const float lg2 = log2f(1.0f - exp2f(-5.0f - (float)hu));
    const int i0 = c == 0 ? 48 : 0, t0 = 64 * c - 48, nlast = 64 - i0;
    unsigned char* rec = rec_ret(p, b, c, hu);
    __syncthreads();
#pragma unroll
    for (int e = tid; e < 64 * 32; e += 512) { const int i = e >> 5, d = e & 31; float qa, qb, ka, kb;
        { const int tc = max(t0 + i, 0); const bf16_t* pr = proj + (size_t)(b * TP + tc) * NBIG; const float cs = rot[(tc * 32 + d) * 2], sn = rot[(tc * 32 + d) * 2 + 1];
            const float q1 = bf2f(pr[PC_DQ + hu * 64 + d]), q2 = bf2f(pr[PC_DQ + hu * 64 + 32 + d]), k1 = bf2f(pr[PC_DK + hu * 64 + d]), k2 = bf2f(pr[PC_DK + hu * 64 + 32 + d]);
            const float mk = i >= i0 ? 1.0f : 0.0f;
            qa = (q1 * cs - q2 * sn) * mk; qb = (q2 * cs + q1 * sn) * mk; ka = (k1 * cs - k2 * sn) * (0.125f * mk); kb = (k2 * cs + k1 * sn) * (0.125f * mk); }
        Qs[i * LDP + d] = f2bf(qa); Qs[i * LDP + 32 + d] = f2bf(qb); Ks[i * LDP + d] = f2bf(ka); Ks[i * LDP + 32 + d] = f2bf(kb);
        KT[d * LDP + i] = f2bf(ka); KT[(d + 32) * LDP + i] = f2bf(kb); }
#pragma unroll
    for (int e = tid; e < 64 * 64; e += 512) { const int i = e >> 6, d = e & 63;
        float v = bf2f(proj[(size_t)(b * TP + max(t0 + i, 0)) * NBIG + PC_DV + hu * 64 + d]); v = i >= i0 ? v : 0.f; const float vh = v * fexp2((float)(63 - i) * lg2);
        VT[d * LDP + i] = f2bf(v); VH[d * LDP + i] = f2bf(vh); }
    __syncthreads();
#pragma unroll
    for (int tt = 0; tt < 2; ++tt) { const int t = wid * 2 + tt, I = t >> 2, J = t & 3; f32x4 acc = (f32x4){0.f, 0.f, 0.f, 0.f};
        if (J <= I) {
#pragma unroll
            for (int s = 0; s < 2; ++s) acc = mfma16(frag_ld(Ks, LDP, 16 * J + fc, 32 * s + 8 * fq), frag_ld(Qs, LDP, 16 * I + fc, 32 * s + 8 * fq), acc); }
        const int i = 16 * I + fc;
#pragma unroll
        for (int r = 0; r < 4; ++r) { const int j = 16 * J + 4 * fq + r; acc[r] = (j <= i && j >= i0) ? acc[r] * fexp2((float)(i - j) * lg2) : 0.f; }
        st_bf4(Ps + i * LDP + 16 * J + 4 * fq, acc); }
    __syncthreads();
    { const int w = wid & 3; bf16x8 bb[2];
#pragma unroll
        for (int s = 0; s < 2; ++s) bb[s] = frag_ld(wid < 4 ? VT : VH, LDP, 16 * w + fc, 32 * s + 8 * fq);
        const LAS bf16_t* At = wid < 4 ? Ps : KT; unsigned char* dst = rec + (wid < 4 ? HR_OI : HR_DS);
#pragma unroll
        for (int m = 0; m < 4; ++m) { f32x4 acc = (f32x4){0.f, 0.f, 0.f, 0.f};
#pragma unroll
            for (int s = 0; s < 2; ++s) acc = mfma16(frag_ld(At, LDP, 16 * m + fc, 32 * s + 8 * fq), bb[s], acc);
            st_acc_bf4(dst + ((size_t)(w * 4 + m) * 64 + lane) * 8, acc); }
        { const float eg = fexp2((float)max(16 * (wid >> 1) + fc - i0 + 1, 0) * lg2); const float sc[8] = {eg, eg, eg, eg, eg, eg, eg, eg};
            *(bf16x8*)(rec + HR_QF + ((size_t)wid * 64 + lane) * 16) = frag_scale(frag_ld_perm(Qs, LDP, 16 * (wid >> 1) + fc, 32 * (wid & 1), fq), sc); }
        if (tid < 64) { float* gv = (float*)(rec + HR_VEC); gv[64 + tid] = fexp2((float)nlast * lg2); } }
}

struct HgLds { static constexpr int LS = 0  , KR = LS + 16384  , QR = KR + 16384  , QT = QR + 16384, QH = QT + 64 * LDP * 2, KT = QH + 64 * LDP * 2  ,
    KHT = KT + 160 * LDP * 2, VT = KHT + 64 * LDP * 2, PS = VT + 64 * LDP * 2, AV = PS + 64 * LDP * 2, END = AV + 256; };
__device__ void hgrn_pre_unit(const Params& p, int layer, int b, int c, int hu, LAS unsigned char* lds) {
    const int tid = opaque_tid(), wid = tid >> 6, lane = tid & 63, fq = lane >> 4, fc = lane & 15;
    LAS float* Ls = (LAS float*)(lds + HgLds::LS); LAS float* Kr = (LAS float*)(lds + HgLds::KR); LAS float* Qr = (LAS float*)(lds + HgLds::QR);
    LAS bf16_t* Qt = (LAS bf16_t*)(lds + HgLds::QT); LAS bf16_t* Qh = (LAS bf16_t*)(lds + HgLds::QH); LAS bf16_t* Kt = (LAS bf16_t*)(lds + HgLds::KT); LAS bf16_t* KhT = (LAS bf16_t*)(lds + HgLds::KHT);
    LAS bf16_t* VT = (LAS bf16_t*)(lds + HgLds::VT); LAS bf16_t* Ps = (LAS bf16_t*)(lds + HgLds::PS); LAS float* Av = (LAS float*)(lds + HgLds::AV);
    const bf16_t* proj = (const bf16_t*)(p.ws + WS_PROJ);
    const float lbv = ((const float*)(p.ws + WS_LB))[layer * 256 + hu * 64 + lane];
    const int i0 = c == 0 ? 48 : 0, t0 = 64 * c - 48;
    unsigned char* rec = rec_hgrn(p, b, c, hu);
    __syncthreads();
    if (wid < 4) { float acc = 0.f; float afr[16];
#pragma unroll
        for (int ii = 0; ii < 16; ++ii) { const int i = 16 * wid + ii; afr[ii] = bf2f(proj[(size_t)(b * TP + max(t0 + i, 0)) * NBIG + PC_AF + hu * 64 + lane]); }
#pragma unroll
        for (int ii = 0; ii < 16; ++ii) { const int i = 16 * wid + ii; float kk;
            { float af = afr[ii]; af = fminf(fmaxf(af, -30.f), 30.f);
                const float e = __expf(-af), sg = __builtin_amdgcn_rcpf(1.0f + e); const float f = lbv + (1.0f - lbv) * sg; const bool ok = i >= i0; kk = ok ? (1.0f - lbv) * e * sg : 0.f; acc += ok ? __log2f(fmaxf(f, 1e-30f)) : 0.f; }
            Ls[i * 64 + lane] = acc; Kr[i * 64 + lane] = kk; } }
    else {
#pragma unroll
        for (int e = tid - 256; e < 64 * 64; e += 256) { const int i = e >> 6, d = e & 63;
            const bf16_t* pr = proj + (size_t)(b * TP + max(t0 + i, 0)) * NBIG; float q = silu_f(bf2f(pr[PC_AQ + hu * 64 + d])) * 0.125f, v = bf2f(pr[PC_AI + hu * 64 + d]); if (i < i0) { q = 0.f; v = 0.f; }
            Qr[i * 64 + d] = q; VT[d * LDP + i] = f2bf(v); } }
    __syncthreads();
#pragma unroll 2
    for (int e = tid; e < 64 * 64; e += 512) { const int i = e >> 6, d = e & 63, I = i >> 4;
        const float T0 = Ls[15 * 64 + d], T1 = Ls[31 * 64 + d], T2 = Ls[47 * 64 + d], T3 = Ls[63 * 64 + d];
        const float Bi = I == 0 ? 0.f : I == 1 ? T0 : I == 2 ? T0 + T1 : T0 + T1 + T2; const float Li = Ls[i * 64 + d], Gi = Bi + Li, Gl = T0 + T1 + T2 + T3;
        const float q = Qr[i * 64 + d], k = Kr[i * 64 + d];
        Qt[i * LDP + d] = f2bf(q * fexp2(Li)); Qh[i * LDP + d] = f2bf(q * fexp2(Gi)); KhT[d * LDP + i] = f2bf(k * fexp2(Gl - Gi));
        float Bp = Bi;
        Kt[((I == 0 ? 0 : I == 1 ? 16 : I == 2 ? 48 : 96) + i) * LDP + d] = f2bf(k * fexp2(Bp - Gi));
        if (I <= 0) { Bp = T0; Kt[(16 + i) * LDP + d] = f2bf(k * fexp2(Bp - Gi)); }
        if (I <= 1) { Bp = T0 + T1; Kt[(48 + i) * LDP + d] = f2bf(k * fexp2(Bp - Gi)); }
        if (I <= 2) { Bp = T0 + T1 + T2; Kt[(96 + i) * LDP + d] = f2bf(k * fexp2(Bp - Gi)); }
        if (i == 0) Av[d] = fexp2(Gl); }
    __syncthreads();
#pragma unroll
    for (int tt = 0; tt < 2; ++tt) { const int t = wid * 2 + tt, I = t >> 2, J = t & 3; f32x4 acc = (f32x4){0.f, 0.f, 0.f, 0.f};
        if (J <= I) { const int kb = (I == 0 ? 0 : I == 1 ? 16 : I == 2 ? 48 : 96) + 16 * J;
#pragma unroll
            for (int s = 0; s < 2; ++s) acc = mfma16(frag_ld(Kt, LDP, kb + fc, 32 * s + 8 * fq), frag_ld(Qt, LDP, 16 * I + fc, 32 * s + 8 * fq), acc); }
        const int i = 16 * I + fc;
#pragma unroll
        for (int r = 0; r < 4; ++r) { const int j = 16 * J + 4 * fq + r; acc[r] = (j <= i) ? acc[r] : 0.f; }
        st_bf4(Ps + i * LDP + 16 * J + 4 * fq, acc); }
    __syncthreads();
    { const int w = wid & 3; bf16x8 bb[2];
#pragma unroll
        for (int s = 0; s < 2; ++s) bb[s] = frag_ld(VT, LDP, 16 * w + fc, 32 * s + 8 * fq);
        const LAS bf16_t* At = wid < 4 ? Ps : KhT; unsigned char* dst = rec + (wid < 4 ? HR_OI : HR_DS);
#pragma unroll
        for (int m = 0; m < 4; ++m) { f32x4 acc = (f32x4){0.f, 0.f, 0.f, 0.f};
#pragma unroll
            for (int s = 0; s < 2; ++s) acc = mfma16(frag_ld(At, LDP, 16 * m + fc, 32 * s + 8 * fq), bb[s], acc);
            st_acc_bf4(dst + ((size_t)(w * 4 + m) * 64 + lane) * 8, acc); }
        *(bf16x8*)(rec + HR_QF + ((size_t)wid * 64 + lane) * 16) = frag_ld_perm(Qh, LDP, 16 * (wid >> 1) + fc, 32 * (wid & 1), fq);
        if (tid < 64) { float* gv = (float*)(rec + HR_VEC); gv[64 + tid] = Av[tid]; } }
}

struct SsdLds { static constexpr int CS = 0, BS = CS + 64 * LDP2 * 2, BT = BS + 64 * LDP2 * 2, XS = BT + 128 * LDP * 2, VT = XS + 64 * LDP2 * 2  , VH = VT + 2 * 64 * LDP * 2, PS = VH + 2 * 64 * LDP * 2  ,
    DT = PS + 67 * 384 * 2  , GV = DT + 512, END = GV + 512; };
constexpr int SSD_NPIECE = 67 * 48;
__device__ void ssd_pre_unit(const Params& p, int layer, int b, int c, int gg, LAS unsigned char* lds) {
    const int tid = opaque_tid(), wid = tid >> 6, lane = tid & 63, fq = lane >> 4, fc = lane & 15;
    LAS bf16_t* Cs = (LAS bf16_t*)(lds + SsdLds::CS); LAS bf16_t* Bs = (LAS bf16_t*)(lds + SsdLds::BS); LAS bf16_t* BT = (LAS bf16_t*)(lds + SsdLds::BT); LAS bf16_t* Xs = (LAS bf16_t*)(lds + SsdLds::XS);
    LAS bf16_t* VT = (LAS bf16_t*)(lds + SsdLds::VT); LAS bf16_t* VH = (LAS bf16_t*)(lds + SsdLds::VH); LAS bf16_t* Ps = (LAS bf16_t*)(lds + SsdLds::PS); LAS bf16_t* RawT = Ps;
    LAS float* DTv = (LAS float*)(lds + SsdLds::DT); LAS float* Gv = (LAS float*)(lds + SsdLds::GV);
    const bf16_t* projb = (const bf16_t*)(p.ws + WS_PROJ) + (size_t)(b * TP) * NBIG; const float* psmb = (const float*)(p.ws + WS_PSM) + (size_t)(b * TP) * NSM;
    const float* cw = p.ssd_conv_w + (size_t)layer * 4 * 768; const float* cb = p.ssd_conv_b + (size_t)layer * 768;
    constexpr float L2E = 1.4426950408889634f;
    const int hh = wid >> 2, ws = wid & 3;
    const int i0 = c == 0 ? 48 : 0, t0 = 64 * c - 48;
    unsigned char* rec = rec_ssd(p, b, c, gg);
    u32x4 raw[7];
#pragma unroll
    for (int k = 0; k < 7; ++k) { const int id = min(tid + 512 * k, SSD_NPIECE - 1), row = id / 48, seg = id % 48, t = t0 - 3 + row;
        const u32x4 v = *(const u32x4*)(projb + (size_t)max(t, 0) * NBIG + PC_CXBC + (seg >> 4) * 256 + gg * 128 + (seg & 15) * 8);
        raw[k] = t >= 0 ? v : (u32x4){0u, 0u, 0u, 0u}; }
    const float psmv = psmb[(size_t)max(t0 + lane, 0) * NSM + 8 + gg * 2 + (wid & 1)];
    __syncthreads();
    if (wid < 2) { const int hd = gg * 2 + wid;
        float dt = softplus_f(psmv + p.ssd_dt_bias[layer * 4 + hd]); dt = lane >= i0 ? dt : 0.f;
        float G = -dt * __expf(p.ssd_a_log[layer * 4 + hd]) * L2E;
#pragma unroll
        for (int o = 1; o < 64; o <<= 1) { const float t = lane_up(G, o, lane); if (lane >= o) G += t; }
        DTv[wid * 64 + lane] = dt; Gv[wid * 64 + lane] = G; }
#pragma unroll
    for (int k = 0; k < 7; ++k) { const int id = tid + 512 * k; if (id < SSD_NPIECE) *(LAS u32x4*)(RawT + (id / 48) * 384 + (id % 48) * 8) = raw[k]; }
    __syncthreads();
#pragma unroll 1
    for (int n = 0; n < 3; ++n) { const int e = tid + 512 * n, ch = e % 384, tr = e / 384, part = ch >> 7, j = ch & 127, chf = part * 256 + gg * 128 + j;
        const float w0 = cw[chf], w1 = cw[768 + chf], w2 = cw[2 * 768 + chf], w3 = cw[3 * 768 + chf], bias = cb[chf];
#pragma unroll
        for (int hf = 0; hf < 2; ++hf) { const int ib = 16 * tr + 8 * hf; float a[8], rw[11];
#pragma unroll
            for (int ii = 0; ii < 11; ++ii) rw[ii] = bf2f(RawT[(ib + ii) * 384 + ch]);
#pragma unroll
            for (int ii = 0; ii < 8; ++ii) { a[ii] = silu_f(bias + w0 * rw[ii] + w1 * rw[ii + 1] + w2 * rw[ii + 2] + w3 * rw[ii + 3]); if (ib + ii < i0) a[ii] = 0.f; }
            if (part == 0) { const int h2 = j >> 6, d = j & 63; const float gl = Gv[h2 * 64 + 63]; float xh[8];
#pragma unroll
                for (int ii = 0; ii < 8; ++ii) { const int i = ib + ii; Xs[i * LDP2 + j] = f2bf(a[ii]); a[ii] *= DTv[h2 * 64 + i]; xh[ii] = a[ii] * fexp2(gl - Gv[h2 * 64 + i]); }
                *(LAS u32x4*)(VT + (h2 * 64 + d) * LDP + ib) = pack_bf8(a); *(LAS u32x4*)(VH + (h2 * 64 + d) * LDP + ib) = pack_bf8(xh); }
            else if (part == 1) {
#pragma unroll
                for (int ii = 0; ii < 8; ++ii) Bs[(ib + ii) * LDP2 + j] = f2bf(a[ii]);
                *(LAS u32x4*)(BT + j * LDP + ib) = pack_bf8(a); }
            else {
#pragma unroll
                for (int ii = 0; ii < 8; ++ii) Cs[(ib + ii) * LDP2 + j] = f2bf(a[ii]); } } }
    __syncthreads();
#pragma unroll
    for (int tt = 0; tt < 2; ++tt) { const int t = wid * 2 + tt, I = t >> 2, J = t & 3; f32x4 acc = (f32x4){0.f, 0.f, 0.f, 0.f};
        if (J <= I) {
#pragma unroll
            for (int s = 0; s < 4; ++s) acc = mfma16(frag_ld(Bs, LDP2, 16 * J + fc, 32 * s + 8 * fq), frag_ld(Cs, LDP2, 16 * I + fc, 32 * s + 8 * fq), acc); }
        const int i = 16 * I + fc;
#pragma unroll
        for (int h2 = 0; h2 < 2; ++h2) { f32x4 pv; const float gi = Gv[h2 * 64 + i];
#pragma unroll
            for (int r = 0; r < 4; ++r) { const int j = 16 * J + 4 * fq + r; pv[r] = (j <= i && j >= i0) ? acc[r] * fexp2(gi - Gv[h2 * 64 + j]) : 0.f; }
            st_bf4(Ps + (h2 * 64 + i) * LDP + 16 * J + 4 * fq, pv); } }
    __syncthreads();
    { bf16x8 bv[2], bh[2]; unsigned char* hrec = rec + SS_HEAD + (size_t)hh * 24576; const float dsk = p.ssd_d[layer * 4 + gg * 2 + hh];
#pragma unroll
        for (int s = 0; s < 2; ++s) { bv[s] = frag_ld(VT, LDP, hh * 64 + 16 * ws + fc, 32 * s + 8 * fq); bh[s] = frag_ld(VH, LDP, hh * 64 + 16 * ws + fc, 32 * s + 8 * fq); }
#pragma unroll
        for (int mi = 0; mi < 4; ++mi) { f32x4 o1 = (f32x4){0.f, 0.f, 0.f, 0.f};
#pragma unroll
            for (int s = 0; s < 2; ++s) o1 = mfma16(frag_ld(Ps, LDP, hh * 64 + 16 * mi + fc, 32 * s + 8 * fq), bv[s], o1);
#pragma unroll
            for (int r = 0; r < 4; ++r) o1[r] += dsk * bf2f(Xs[(16 * mi + 4 * fq + r) * LDP2 + hh * 64 + 16 * ws + fc]);
            st_acc_bf4(hrec + ((size_t)(ws * 4 + mi) * 64 + lane) * 8, o1); }
#pragma unroll
        for (int m = 0; m < 8; ++m) { f32x4 d = (f32x4){0.f, 0.f, 0.f, 0.f};
#pragma unroll
            for (int s = 0; s < 2; ++s) d = mfma16(frag_ld(BT, LDP, 16 * m + fc, 32 * s + 8 * fq), bh[s], d);
            st_acc_bf4(hrec + 8192 + ((size_t)(ws * 8 + m) * 64 + lane) * 8, d); }
#pragma unroll
        for (int x = 0; x < 2; ++x) { const int sl = wid * 2 + x; *(bf16x8*)(rec + SS_QF + ((size_t)sl * 64 + lane) * 16) = frag_ld_perm(Cs, LDP2, 16 * (sl >> 2) + fc, 32 * (sl & 3), fq); }
        if (tid < 128) { float* gv = (float*)(rec + SS_VEC + (size_t)(tid >> 6) * 512); gv[tid & 63] = fexp2(Gv[tid]); if ((tid & 63) == 0) gv[64] = fexp2(Gv[(tid >> 6) * 64 + 63]); } }
}

struct GdLds { static constexpr int QF = 0, KF = 16384, VF = 32768, QN = 49152, KN = QN + 64 * LDP * 2, KNT = KN + 64 * LDP * 2, NM = KNT + 64 * LDP * 2, QK = NM + 64 * LDP * 2, WT = QK + 64 * LDP * 2,
    MD = WT + 64 * LDP * 2  , TD = MD + 4096  , GV = TD + 2048, BV = GV + 256, END = BV + 256; };
__device__ void gdn_pre_unit(const Params& p, int layer, int b, int c, int hu, LAS unsigned char* lds) {
    const int tid = opaque_tid(), wid = tid >> 6, lane = tid & 63, fq = lane >> 4, fc = lane & 15;
    LAS float* Qf = (LAS float*)(lds + GdLds::QF); LAS float* Kf = (LAS float*)(lds + GdLds::KF); LAS float* Vf = (LAS float*)(lds + GdLds::VF);
    LAS bf16_t* Qn = (LAS bf16_t*)(lds + GdLds::QN); LAS bf16_t* Kn = (LAS bf16_t*)(lds + GdLds::KN); LAS bf16_t* KnT = (LAS bf16_t*)(lds + GdLds::KNT);
    LAS bf16_t* NM = (LAS bf16_t*)(lds + GdLds::NM); LAS bf16_t* QK = (LAS bf16_t*)(lds + GdLds::QK); LAS bf16_t* Wt = (LAS bf16_t*)(lds + GdLds::WT);
    LAS float* MD = (LAS float*)(lds + GdLds::MD); LAS bf16_t* TD = (LAS bf16_t*)(lds + GdLds::TD); LAS float* Gv = (LAS float*)(lds + GdLds::GV); LAS float* Bv = (LAS float*)(lds + GdLds::BV);
    const bf16_t* proj = (const bf16_t*)(p.ws + WS_PROJ); const float* psm = (const float*)(p.ws + WS_PSM);
    const float* cw = p.gdn_conv_w + (size_t)layer * 4 * 768;
    unsigned char* gd = rec_gdn(p, b, c, hu);
    constexpr float L2E = 1.4426950408889634f;
    const int i0 = c == 0 ? 48 : 0, t0 = 64 * c - 48;
    __syncthreads();
    if (wid == 0) { const float* ps = psm + (size_t)(b * TP + max(t0 + lane, 0)) * NSM;
        float g = -__expf(p.gdn_a_log[layer * 4 + hu]) * softplus_f(ps[hu] + p.gdn_dt_bias[layer * 4 + hu]) * L2E, be = sigmoid_f(ps[4 + hu]); if (lane < i0) { g = 0.f; be = 0.f; }
#pragma unroll
        for (int o = 1; o < 64; o <<= 1) { const float t = lane_up(g, o, lane); if (lane >= o) g += t; }
        Gv[lane] = g; Bv[lane] = be; }
#pragma unroll
    for (int e = tid; e < 192 * 8; e += 512) { const int ch = e % 192, tr = e / 192, part = ch >> 6, d = ch & 63, chf = part * 256 + hu * 64 + d;
        const bf16_t* col = proj + (size_t)(b * TP) * NBIG + PC_BQKV + chf;
        const float w0 = cw[chf], w1 = cw[768 + chf], w2 = cw[2 * 768 + chf], w3 = cw[3 * 768 + chf];
        const int ts = t0 + 8 * tr;
        float raw[11];
#pragma unroll
        for (int ii = 0; ii < 11; ++ii) { const int t = ts - 3 + ii; const float v = bf2f(col[(size_t)max(t, 0) * NBIG]); raw[ii] = t >= 0 ? v : 0.f; }
        LAS float* dst = part == 0 ? Qf : part == 1 ? Kf : Vf;
#pragma unroll
        for (int ii = 0; ii < 8; ++ii) { const int i = 8 * tr + ii;
            float a = silu_f(w0 * raw[ii] + w1 * raw[ii + 1] + w2 * raw[ii + 2] + w3 * raw[ii + 3]); if (i < i0) a = 0.f;
            dst[i * 64 + d] = a; } }
    __syncthreads();
    { const int ri = tid >> 3, sg = tid & 7; float q[8], k[8], sq = 0.f, sk = 0.f;
#pragma unroll
        for (int x = 0; x < 8; ++x) { q[x] = Qf[ri * 64 + sg * 8 + x]; k[x] = Kf[ri * 64 + sg * 8 + x]; sq += q[x] * q[x]; sk += k[x] * k[x]; }
        sq += lane_xor(sq, 1, lane); sq += lane_xor(sq, 2, lane); sq += lane_xor(sq, 4, lane); sk += lane_xor(sk, 1, lane); sk += lane_xor(sk, 2, lane); sk += lane_xor(sk, 4, lane);
        const float rq = rsqrtf(sq + EPSF) * 0.125f, rk = rsqrtf(sk + EPSF);
#pragma unroll
        for (int x = 0; x < 8; ++x) { q[x] *= rq; k[x] *= rk; Kf[ri * 64 + sg * 8 + x] = k[x]; KnT[(sg * 8 + x) * LDP + ri] = f2bf(k[x]); }
        *(LAS u32x4*)(Qn + ri * LDP + sg * 8) = pack_bf8(q); *(LAS u32x4*)(Kn + ri * LDP + sg * 8) = pack_bf8(k); }
    __syncthreads();
#pragma unroll
    for (int tt = 0; tt < 2; ++tt) { const int t = wid * 2 + tt, I = t >> 2, J = t & 3; f32x4 a1 = (f32x4){0.f, 0.f, 0.f, 0.f}, a2 = (f32x4){0.f, 0.f, 0.f, 0.f};
        if (J <= I) {
#pragma unroll
            for (int s = 0; s < 2; ++s) { const bf16x8 kj = frag_ld(Kn, LDP, 16 * J + fc, 32 * s + 8 * fq); a1 = mfma16(kj, frag_ld(Kn, LDP, 16 * I + fc, 32 * s + 8 * fq), a1); a2 = mfma16(kj, frag_ld(Qn, LDP, 16 * I + fc, 32 * s + 8 * fq), a2); } }
        const int i = 16 * I + fc; const float gi = Gv[i], bi = Bv[i]; f32x4 nm, qk;
#pragma unroll
        for (int r = 0; r < 4; ++r) { const int j = 16 * J + 4 * fq + r; const float dec = j <= i ? fexp2(gi - Gv[j]) : 0.f; const float mm = j < i ? a1[r] * dec * bi : 0.f; nm[r] = -mm; qk[r] = a2[r] * dec;
            if (J == I) MD[(I * 16 + fc) * 16 + 4 * fq + r] = mm; }
        st_bf4(NM + i * LDP + 16 * J + 4 * fq, nm); st_bf4(QK + i * LDP + 16 * J + 4 * fq, qk); }
    __syncthreads();
    if (wid == 0) { const int I = fq, cc = fc; float x[16];
#pragma unroll
        for (int i = 0; i < 16; ++i) { float acc = (i == cc) ? 1.0f : 0.0f;
#pragma unroll
            for (int j = 0; j < i; ++j) acc -= MD[(I * 16 + i) * 16 + j] * x[j];
            x[i] = acc; TD[(I * 16 + i) * 16 + cc] = f2bf(acc); } }
    __syncthreads();
    const int isW = wid >> 2, ws = wid & 3, colx = 16 * ws + fc;
    f32x4 X[4];
    const f32x4 zero4 = (f32x4){0.f, 0.f, 0.f, 0.f};
#pragma unroll
    for (int I = 0; I < 4; ++I) { f32x4 acc;
#pragma unroll
        for (int r = 0; r < 4; ++r) { const int j = 16 * I + 4 * fq + r; acc[r] = isW ? Bv[j] * fexp2(Gv[j]) * Kf[j * 64 + colx] : Bv[j] * Vf[j * 64 + colx]; }
        if (I >= 1) acc = mfma16(frag_ld_perm(NM, LDP, 16 * I + fc, 0, fq), pack_acc2(X[0], I > 1 ? X[1] : zero4), acc);
        if (I == 3) acc = mfma16(frag_ld_perm(NM, LDP, 48 + fc, 32, fq), pack_acc2(X[2], zero4), acc);
        const bf16x4 tlo = *(const LAS bf16x4*)(TD + (I * 16 + fc) * 16 + 4 * fq); const bf16x4 z4 = (bf16x4){0, 0, 0, 0};
        X[I] = mfma16(__builtin_shufflevector(tlo, z4, 0, 1, 2, 3, 4, 5, 6, 7), pack_acc2(acc, zero4), zero4); }
    if (!isW) {
#pragma unroll
        for (int m = 0; m < 4; ++m) st_acc_bf4(gd + GD_U + ((size_t)(ws * 4 + m) * 64 + lane) * 8, X[m]); }
    else {
#pragma unroll
        for (int m = 0; m < 4; ++m)
#pragma unroll
            for (int r = 0; r < 4; ++r) Wt[(16 * m + 4 * fq + r) * LDP + colx] = f2bf(-X[m][r]); }
    __syncthreads();
    { const int tsel = wid >> 1; const LAS bf16_t* tile = tsel == 0 ? Wt : tsel == 1 ? Qn : tsel == 2 ? QK : KnT; unsigned char* dst = gd + (tsel == 0 ? GD_W : tsel == 1 ? GD_Q : tsel == 2 ? GD_P : GD_K);
#pragma unroll
        for (int x = 0; x < 4; ++x) { const int sl = (wid & 1) * 4 + x, m = sl >> 1, s = sl & 1; bf16x8 f = frag_ld_perm(tile, LDP, 16 * m + fc, 32 * s, fq);
            if (tsel == 1) { const float eg = fexp2(Gv[16 * m + fc]); const float sc[8] = {eg, eg, eg, eg, eg, eg, eg, eg}; f = frag_scale(f, sc); }
            if (tsel == 3) { float sc[8];
#pragma unroll
                for (int e = 0; e < 8; ++e) sc[e] = fexp2(Gv[63] - Gv[32 * s + 16 * (e >> 2) + 4 * fq + (e & 3)]);
                f = frag_scale(f, sc); }
            *(bf16x8*)(dst + ((size_t)sl * 64 + lane) * 16) = f; } }
    if (tid == 0) { float* gv = (float*)(gd + GD_VEC); gv[128] = fexp2(Gv[63]); }
}

template <int MIX> struct SeqRegs {
    static constexpr int DK = MIX == 2 ? 128 : 64, NT = DK / 16, NS = DK / 32;
    bf16x8 qf[4 * NS]; u32x2 oi[4]; u32x2 ds[NT]; f32x4 eg[MIX == 2 ? 4 : 1]; f32x4 al[MIX == 0 ? 4 : 1];
    __device__ __forceinline__ void load(const Params& p, int b, int c, int hp, int hsel, int hd, int ws, int lane, int fq) {
        const unsigned char* base = MIX == 2 ? rec_ssd(p, b, c, hp) : MIX == 0 ? rec_hgrn(p, b, c, hd) : rec_ret(p, b, c, hd);
        const unsigned char* q = base + (MIX == 2 ? SS_QF : HR_QF); const unsigned char* o = MIX == 2 ? base + SS_HEAD + (size_t)hsel * 24576 : base + HR_OI;
        const unsigned char* d = MIX == 2 ? o + 8192 : base + HR_DS; const float* gv = (const float*)(MIX == 2 ? base + SS_VEC + (size_t)hsel * 512 : base + HR_VEC);
#pragma unroll
        for (int x = 0; x < 4 * NS; ++x) qf[x] = *(const bf16x8*)(q + ((size_t)x * 64 + lane) * 16);
#pragma unroll
        for (int mi = 0; mi < 4; ++mi) { oi[mi] = *(const u32x2*)(o + ((size_t)(ws * 4 + mi) * 64 + lane) * 8); if (MIX == 2) eg[mi] = *(const f32x4*)(gv + 16 * mi + 4 * fq); }
#pragma unroll
        for (int m = 0; m < NT; ++m) ds[m] = *(const u32x2*)(d + ((size_t)(ws * NT + m) * 64 + lane) * 8);
#pragma unroll
        for (int m = 0; m < (MIX == 0 ? 4 : 1); ++m) al[m] = MIX == 0 ? *(const f32x4*)(gv + 64 + 16 * m + 4 * fq) : (f32x4){gv[64], 0.f, 0.f, 0.f};
    }
};
__device__ __forceinline__ f32x4 unpack_acc(const u32x2& w) { return (f32x4){__uint_as_float(w.x << 16), __uint_as_float(w.x & 0xffff0000u), __uint_as_float(w.y << 16), __uint_as_float(w.y & 0xffff0000u)}; }
struct GdRegs { bf16x8 w[8], pq[8], qq[8], kk[8]; u32x2 u0[4]; float al;
    __device__ __forceinline__ void load_a(const unsigned char* gd, int ws, int lane) {
#pragma unroll
        for (int x = 0; x < 8; ++x) w[x] = *(const bf16x8*)(gd + GD_W + ((size_t)x * 64 + lane) * 16);
#pragma unroll
        for (int m = 0; m < 4; ++m) u0[m] = *(const u32x2*)(gd + GD_U + ((size_t)(ws * 4 + m) * 64 + lane) * 8); }
    __device__ __forceinline__ void load_b(const unsigned char* gd, int lane, int fq) {
        const float* gv = (const float*)(gd + GD_VEC);
#pragma unroll
        for (int x = 0; x < 8; ++x) { pq[x] = *(const bf16x8*)(gd + GD_P + ((size_t)x * 64 + lane) * 16); qq[x] = *(const bf16x8*)(gd + GD_Q + ((size_t)x * 64 + lane) * 16); }
        al = gv[128]; }
    __device__ __forceinline__ void load_k(const unsigned char* gd, int lane) {
#pragma unroll
        for (int x = 0; x < 8; ++x) kk[x] = *(const bf16x8*)(gd + GD_K + ((size_t)x * 64 + lane) * 16); }
};
template <int MIX>
__device__ void seq_item(const Params& p, int layer, int b_in, int hp_in, LAS unsigned char* lds) {
    constexpr int DK = MIX == 2 ? 128 : 64, NT = DK / 16, NS = DK / 32;
    const int b = __builtin_amdgcn_readfirstlane(b_in), hp = __builtin_amdgcn_readfirstlane(hp_in);
    const int tid = opaque_tid(), wid = tid >> 6, lane = tid & 63, fq = lane >> 4, fc = lane & 15;
    const int hsel = wid >> 2, hd = hp * 2 + hsel, ws = wid & 3;
    LAS float* Os = (LAS float*)lds;
    const bf16_t* projb = (const bf16_t*)(p.ws + WS_PROJ) + (size_t)(b * TP) * NBIG; bf16_t* yb = (bf16_t*)(p.ws + WS_Y) + (size_t)(b * TP) * DM;
    f32x4 S[NT];
#pragma unroll
    for (int m = 0; m < NT; ++m) S[m] = (f32x4){0.f, 0.f, 0.f, 0.f};
    const f32x4 zero4 = (f32x4){0.f, 0.f, 0.f, 0.f};
    SeqRegs<MIX == 1 ? 0 : MIX> R; GdRegs G;
    if (MIX != 1) R.load(p, b, 0, hp, hsel, hd, ws, lane, fq);
    __syncthreads();
    for (int c = 0; c < NCHUNK; ++c) {
        const int i0 = c == 0 ? 48 : 0, t0 = 64 * c - 48, cn = min(c + 1, NCHUNK - 1);
        LAS float* Ob = Os + ((c & 1) * 2 + hsel) * 64 * OSP;
        bf16x8 Sb[NS];
#pragma unroll
        for (int s = 0; s < NS; ++s) Sb[s] = pack_acc2(S[2 * s], S[2 * s + 1]);
        if (MIX == 1) {
            const unsigned char* gn = rec_gdn(p, b, cn, hd);
            G.load_a(rec_gdn(p, b, c, hd), ws, lane);
            bf16x8 ub[2]; f32x4 u[4];
#pragma unroll
            for (int m = 0; m < 4; ++m) { u[m] = unpack_acc(G.u0[m]);
#pragma unroll
                for (int s = 0; s < 2; ++s) u[m] = mfma16(G.w[m * 2 + s], Sb[s], u[m]); }
            __builtin_amdgcn_sched_barrier(0);
            G.load_b(rec_gdn(p, b, c, hd), lane, fq);
#pragma unroll
            for (int s = 0; s < 2; ++s) ub[s] = pack_acc2(u[2 * s], u[2 * s + 1]);
#pragma unroll
            for (int mi = 0; mi < 4; ++mi) { f32x4 o1 = zero4, o2 = zero4;
#pragma unroll
                for (int s = 0; s < 2; ++s) { o1 = mfma16(G.pq[mi * 2 + s], ub[s], o1); o2 = mfma16(G.qq[mi * 2 + s], Sb[s], o2); }
#pragma unroll
                for (int r = 0; r < 4; ++r) Ob[(16 * mi + 4 * fq + r) * OSP + 16 * ws + fc] = o1[r] + o2[r]; }
            __builtin_amdgcn_sched_barrier(0);
            G.load_k(rec_gdn(p, b, c, hd), lane);
#pragma unroll
            for (int m = 0; m < 4; ++m) { S[m] = S[m] * G.al;
#pragma unroll
                for (int s = 0; s < 2; ++s) S[m] = mfma16(G.kk[m * 2 + s], ub[s], S[m]); }
            (void)gn;
        } else {
#pragma unroll
            for (int mi = 0; mi < 4; ++mi) { f32x4 o2 = zero4;
#pragma unroll
                for (int s = 0; s < NS; ++s) o2 = mfma16(R.qf[mi * NS + s], Sb[s], o2);
                const f32x4 o1 = unpack_acc(R.oi[mi]);
#pragma unroll
                for (int r = 0; r < 4; ++r) Ob[(16 * mi + 4 * fq + r) * OSP + 16 * ws + fc] = o1[r] + (MIX == 2 ? R.eg[MIX == 2 ? mi : 0][r] : 1.0f) * o2[r]; }
#pragma unroll
            for (int m = 0; m < NT; ++m) { const f32x4 d = unpack_acc(R.ds[m]);
#pragma unroll
                for (int r = 0; r < 4; ++r) S[m][r] = (MIX == 0 ? R.al[MIX == 0 ? (m & 3) : 0][r] : R.al[0][0]) * S[m][r] + d[r]; }
            R.load(p, b, cn, hp, hsel, hd, ws, lane, fq);
        }
        if (MIX == 2) {
            const int ri = tid >> 3, sg = tid & 7;
            const bf16_t* zp = projb + (size_t)max(t0 + ri, 0) * NBIG + PC_CZ + hp * 128 + sg * 16; const u32x4 zr0 = *(const u32x4*)zp, zr1 = *(const u32x4*)(zp + 8);
            __syncthreads();
            float o[16], z[16]; unpack_bf8(zr0, z); unpack_bf8(zr1, z + 8); float q = 0.f; const LAS float* Oh = Os + ((c & 1) * 2 + (sg >> 2)) * 64 * OSP + ri * OSP + (sg & 3) * 16;
#pragma unroll
            for (int k4 = 0; k4 < 4; ++k4) { const f32x4 v = *(const LAS f32x4*)(Oh + 4 * k4); o[4 * k4] = v[0]; o[4 * k4 + 1] = v[1]; o[4 * k4 + 2] = v[2]; o[4 * k4 + 3] = v[3]; }
#pragma unroll
            for (int k = 0; k < 16; ++k) { o[k] *= silu_f(z[k]); q += o[k] * o[k]; }
            q += lane_xor(q, 1, lane); q += lane_xor(q, 2, lane); q += lane_xor(q, 4, lane);
            const float rstd = rsqrtf(q * (1.0f / 128.0f) + EPSF); const float* nw = p.ssd_norm_w + layer * 256 + hp * 128 + sg * 16;
#pragma unroll
            for (int k = 0; k < 16; ++k) o[k] *= rstd * nw[k];
            if (ri >= i0) { u32x4* yp = (u32x4*)(yb + (size_t)(t0 + ri) * DM + 512 + hp * 128 + sg * 16); yp[0] = pack_bf8(o); yp[1] = pack_bf8(o + 8); }
        } else {
            const int ri = (tid & 255) >> 2, sg = tid & 3;
            constexpr int ZC = MIX == 0 ? PC_AZ : MIX == 1 ? PC_BZ : PC_DZ, YC = MIX == 0 ? 0 : MIX == 1 ? 256 : 768;
            const bf16_t* zp = projb + (size_t)max(t0 + ri, 0) * NBIG + ZC + hd * 64 + sg * 16; const u32x4 zr0 = *(const u32x4*)zp, zr1 = *(const u32x4*)(zp + 8);
            __syncthreads();
            float o[16], z[16]; unpack_bf8(zr0, z); unpack_bf8(zr1, z + 8);
#pragma unroll
            for (int k4 = 0; k4 < 4; ++k4) { const f32x4 v = *(const LAS f32x4*)(Ob + ri * OSP + sg * 16 + 4 * k4); o[4 * k4] = v[0]; o[4 * k4 + 1] = v[1]; o[4 * k4 + 2] = v[2]; o[4 * k4 + 3] = v[3]; }
            const float* nw = (MIX == 0 ? p.hgrn_norm_w : MIX == 1 ? p.gdn_norm_w : p.ret_norm_w) + layer * 256 + hd * 64 + sg * 16;
            if (MIX == 3) { float s = 0.f;
#pragma unroll
                for (int k = 0; k < 16; ++k) s += o[k];
                s += lane_xor(s, 1, lane); s += lane_xor(s, 2, lane); const float mu = s * (1.0f / 64.0f); float q = 0.f;
#pragma unroll
                for (int k = 0; k < 16; ++k) { o[k] -= mu; q += o[k] * o[k]; }
                q += lane_xor(q, 1, lane); q += lane_xor(q, 2, lane); const float rstd = rsqrtf(q * (1.0f / 64.0f) + EPSF); const float* nb = p.ret_norm_b + layer * 256 + hd * 64 + sg * 16;
#pragma unroll
                for (int k = 0; k < 16; ++k) o[k] = (o[k] * rstd * nw[k] + nb[k]) * silu_f(z[k]);
            } else { float q = 0.f;
#pragma unroll
                for (int k = 0; k < 16; ++k) q += o[k] * o[k];
                q += lane_xor(q, 1, lane); q += lane_xor(q, 2, lane); const float rstd = rsqrtf(q * (1.0f / 64.0f) + EPSF);
#pragma unroll
                for (int k = 0; k < 16; ++k) o[k] = o[k] * rstd * nw[k] * silu_f(z[k]); }
            if (ri >= i0) { u32x4* yp = (u32x4*)(yb + (size_t)(t0 + ri) * DM + YC + hd * 64 + sg * 16); yp[0] = pack_bf8(o); yp[1] = pack_bf8(o + 8); }
        }
    }
    { float* so = p.out + (MIX == 0 ? O_HGRN_P : MIX == 1 ? O_GDN_P : MIX == 2 ? O_SSD_P : O_RET_P) + (((size_t)layer * NB + b) * 4 + hd) * (DK * 64);
#pragma unroll
        for (int m = 0; m < NT; ++m)
#pragma unroll
            for (int r = 0; r < 4; ++r) so[(16 * m + 4 * fq + r) * 64 + 16 * ws + fc] = S[m][r]; }
    if (MIX == 1 || MIX == 2) { float* co = p.out + (MIX == 1 ? O_GCONV_P : O_SCONV_P) + ((size_t)layer * NB + b) * 3 * 768;
        for (int e = tid; e < 3 * 384; e += 512) { const int r = e / 384, ch = e % 384, chf = (ch >> 7) * 256 + hp * 128 + (ch & 127);
            co[r * 768 + chf] = bf2f(projb[(size_t)(TP - 3 + r) * NBIG + (MIX == 1 ? PC_BQKV : PC_CXBC) + chf]); } }
}

constexpr int N_MU = 14;
__device__ void ph_pre(const Params& p_in, int layer, LAS unsigned char* lds_in, int blk, int nblk) {
    Params p = p_in; asm volatile("" : "+s"(p.ws), "+s"(p.out));
    LAS unsigned char* lds = lds_in; asm volatile("" : "+s"(lds));
    convert_weights(p, layer + 1 < DEPTH ? layer + 1 : -1, layer, (LAS float*)lds, opaque_tid(), blk, nblk);
    for (int u = blk; u < NB * NCHUNK * 14; u += nblk) { const int t = u / 7, k = u % 7, v = t * 2 + (k & 1), b4 = v / (NCHUNK * 4), c4 = (v >> 2) % NCHUNK, h4 = v & 3;
        if (k < 2) hgrn_pre_unit(p, layer, b4, c4, h4, lds);
        else if (k < 4) ret_pre_unit(p, layer, b4, c4, h4, lds);
        else if (k < 6) gdn_pre_unit(p, layer, b4, c4, h4, lds);
        else ssd_pre_unit(p, layer, t / (NCHUNK * 2), (t >> 1) % NCHUNK, t & 1, lds); }
}
__device__ void ph_seq(const Params& p_in, int layer, LAS unsigned char* lds_in, int blk, int nblk) {
    Params p = p_in; asm volatile("" : "+s"(p.ws), "+s"(p.out));
    LAS unsigned char* lds = lds_in; asm volatile("" : "+s"(lds));
    LAS float* L = (LAS float*)lds;
    if (blk < 64) { const int b = blk >> 3, k = blk & 7;
        if (k < 2) seq_item<2>(p, layer, b, k, lds); else if (k < 4) seq_item<1>(p, layer, b, k - 2, lds); else if (k < 6) seq_item<0>(p, layer, b, k - 4, lds); else seq_item<3>(p, layer, b, k - 6, lds); }
    else for (int d = blk - 64; d < DECB * N_MU; d += nblk - 64) { const int s = NB + d / N_MU, mu = d % N_MU;
        if (mu < 4) mixer_item<0>(p, layer, s, mu, L); else if (mu < 8) mixer_item<1>(p, layer, s, mu - 4, L); else if (mu < 10) mixer_item<2>(p, layer, s, mu - 8, L); else mixer_item<3>(p, layer, s, mu - 10, L); }
}

__device__ void ph_final(const Params& p_in, int blk, int nblk) {
    Params p = p_in; asm volatile("" : "+s"(p.ws), "+s"(p.out));

    const int tid = opaque_tid(), wid = tid >> 6, lane = tid & 63;
    const float* h = (const float*)(p.ws + WS_H);
    for (int row = blk * 8 + wid; row < MROWS; row += nblk * 8) {
        float* dst;
        if (row < MP) { const int b = row / TP, t = row % TP; if (t < NMETA) continue; dst = p.out + O_YP + ((size_t)b * SEQ + (t - NMETA)) * DM; } else dst = p.out + O_YS + (size_t)(row - MP) * DM;
        f32x4 v[4]; float ss = 0.f;
#pragma unroll
        for (int j = 0; j < 4; ++j) { v[j] = *(const f32x4*)(h + (size_t)row * DM + j * 256 + lane * 4); ss += v[j][0] * v[j][0] + v[j][1] * v[j][1] + v[j][2] * v[j][2] + v[j][3] * v[j][3]; }
        const float r = rsqrtf(wave_sum(ss, lane) * (1.0f / DM) + EPSF);
#pragma unroll
        for (int j = 0; j < 4; ++j) { const f32x4 w = *(const f32x4*)(p.final_norm_w + j * 256 + lane * 4); *(f32x4*)(dst + j * 256 + lane * 4) = v[j] * r * w; }
    }
}

constexpr int LDS_STAGE = 160 * 1024 - 256;
constexpr int LDS_BYTES = LDS_STAGE + 16;
static_assert(MixLds::END * 4 <= LDS_STAGE && RetLds::END <= LDS_STAGE && SsdLds::END <= LDS_STAGE && 2 * 64 * LDP * 2 <= SsdLds::DT - SsdLds::PS && HgLds::END <= LDS_STAGE && GdLds::END <= LDS_STAGE && pg8::STAGE_BYTES <= LDS_STAGE && 4 * 64 * OSP * 4 <= LDS_STAGE, "LDS carve");

__global__ void __launch_bounds__(512, 2) k_mega(Params p) {
    extern __shared__ __attribute__((aligned(16))) unsigned char smem[];
    LAS unsigned char* lds = (LAS unsigned char*)smem;
    const int blk = blockIdx.x, nblk = gridDim.x;
    volatile LAS unsigned* xbw = (volatile LAS unsigned*)(lds + LDS_STAGE);
    if (threadIdx.x < 4) xbw[threadIdx.x] = 0u;
    __syncthreads();
    XcdBarrier xb = xcd_barrier_post((unsigned*)(p.ws + WS_BAR), xbw);
#ifndef REP_PREP
#define REP_PREP 1
#endif
#ifndef REP_ROWNORM
#define REP_ROWNORM 1
#endif
#ifndef REP_GEMMIN
#define REP_GEMMIN 1
#endif
#ifndef REP_GDNPRE
#define REP_GDNPRE 1
#endif
#ifndef REP_MIXER
#define REP_MIXER 1
#endif
    for (int r = 0; r < REP_PREP; ++r) { ph_prep(p, lds, blk, nblk); if (r + 1 < REP_PREP) xcd_barrier(xb); }
    cooperative_groups::this_grid().sync();
    xcd_barrier(xb);
#pragma unroll 1
    for (int l = 0; l < DEPTH; ++l) {
        for (int r = 0; r < REP_ROWNORM; ++r) { ph_rownorm(p, l, blk, nblk); xcd_barrier(xb); }
        for (int r = 0; r < REP_GEMMIN; ++r) { ph_gemm_in(p, l, lds, blk, nblk); xcd_barrier(xb); }
#ifndef REP_A
#define REP_A 1
#define REP_B 1
#endif
        for (int r = 0; r < REP_A; ++r) { ph_pre(p, l, lds, blk, nblk); xcd_barrier(xb); }
        for (int r = 0; r < REP_B; ++r) { ph_seq(p, l, lds, blk, nblk); xcd_barrier(xb); }
        ph_gemm_out(p, l, lds, blk, nblk);
        xcd_barrier(xb);
    }
    ph_final(p, blk, nblk);
}

extern "C" void kernel_launch(void* const* d_in, const int* in_sizes, int n_in, void* d_out, int out_size, void* d_ws, size_t ws_size, hipStream_t stream) {
    static int grid = 0;
    if (grid == 0) {
        if (n_in != 27 || (size_t)out_size != O_END || ws_size < WS_END) { fprintf(stderr, "kernel_launch: unexpected shapes: n_in %d out %d (want %zu) ws %zu (want %zu)\n", n_in, out_size, (size_t)O_END, ws_size, (size_t)WS_END); grid = -1; return; }
        if (hipFuncSetAttribute((const void*)k_mega, hipFuncAttributeMaxDynamicSharedMemorySize, LDS_BYTES) != hipSuccess) { fprintf(stderr, "kernel_launch: hipFuncSetAttribute failed\n"); grid = -1; return; }
        int dev = 0, cus = 0, per_cu = 0;
        if (hipGetDevice(&dev) != hipSuccess || hipDeviceGetAttribute(&cus, hipDeviceAttributeMultiprocessorCount, dev) != hipSuccess) { fprintf(stderr, "kernel_launch: device query failed\n"); grid = -1; return; }
        if (hipOccupancyMaxActiveBlocksPerMultiprocessor(&per_cu, (const void*)k_mega, 512, LDS_BYTES) != hipSuccess || per_cu < 1) { fprintf(stderr, "kernel_launch: occupancy query says %d blocks per CU\n", per_cu); grid = -1; return; }
        grid = cus;
    }
    if (grid < 0) return;
    Params p{};
    const float** pp = (const float**)&p;
    for (int i = 0; i < 27; ++i) pp[i] = (const float*)d_in[i];
    p.out = (float*)d_out; p.ws = (unsigned char*)d_ws;
    (void)hipMemsetAsync((unsigned char*)d_ws + WS_BAR, 0, 16384, stream);
    void* args[] = {&p};
    const hipError_t e = hipLaunchCooperativeKernel((const void*)k_mega, dim3(grid), dim3(512), args, LDS_BYTES, stream);
    if (e != hipSuccess) fprintf(stderr, "kernel_launch: cooperative launch failed: %s (grid %d)\n", hipGetErrorString(e), grid);
}
```

```cpp
#include <hip/hip_runtime.h>
#include <hip/hip_cooperative_groups.h>
#include <cstdio>
#include <cstdint>

#define LAS __attribute__((address_space(3)))
typedef unsigned short bf16_t;
typedef short bf16x8 __attribute__((ext_vector_type(8)));
typedef float f32x4 __attribute__((ext_vector_type(4)));
typedef unsigned u32x4 __attribute__((ext_vector_type(4)));
typedef unsigned u32x2 __attribute__((ext_vector_type(2)));

constexpr int DM = 1024, NB = 8, SEQ = 2048, DEPTH = 4, DECB = 128, NMETA = 16, TP = SEQ + NMETA;
constexpr int MP = NB * TP;
constexpr int MROWS = MP + DECB;
constexpr int IN_DIM = 4108, NBIG = 4096, NSM = 12;
constexpr int PASTLEN = 16384;
constexpr float EPSF = 1e-6f;
constexpr int PC_AQ = 0, PC_AF = 256, PC_AI = 512, PC_AZ = 768, PC_BQKV = 1024, PC_BZ = 1792, PC_CXBC = 2048, PC_CZ = 2816, PC_DQ = 3072, PC_DK = 3328, PC_DV = 3584, PC_DZ = 3840;

constexpr size_t WS_BAR = 0;
constexpr size_t WS_WINT = 16384;
constexpr size_t WS_WOUTT = WS_WINT + (size_t)NBIG * DM * 2;
constexpr size_t WS_WSM = WS_WOUTT + (size_t)DM * DM * 2;
constexpr size_t WS_LB = WS_WSM + (size_t)DEPTH * NSM * DM * 4;
constexpr size_t WS_ROT = WS_LB + (size_t)DEPTH * 256 * 4;
constexpr size_t ROT_BYTES = ((size_t)(TP + 1) * 64 * 4 + 255) / 256 * 256;
constexpr size_t WS_H = WS_ROT + ROT_BYTES;
constexpr size_t WS_HB = WS_H + (size_t)MROWS * DM * 4;
constexpr size_t WS_RS = WS_HB + (size_t)MROWS * DM * 2;
constexpr size_t WS_PSM = WS_RS + (size_t)MROWS * 4;
constexpr size_t WS_PROJ = WS_PSM + (size_t)MROWS * NSM * 4;
constexpr size_t WS_Y = WS_PROJ + (size_t)MROWS * NBIG * 2;
constexpr size_t WS_E = WS_Y + (size_t)MROWS * DM * 2;
constexpr size_t WS_END = WS_E + (size_t)NB * 33 * 4 * 41728;

constexpr size_t O_YP = 0;
constexpr size_t O_YS = O_YP + (size_t)NB * SEQ * DM;
constexpr size_t O_HGRN_P = O_YS + (size_t)DECB * DM;
constexpr size_t O_GDN_P = O_HGRN_P + (size_t)DEPTH * NB * 4 * 64 * 64;
constexpr size_t O_GCONV_P = O_GDN_P + (size_t)DEPTH * NB * 4 * 64 * 64;
constexpr size_t O_SSD_P = O_GCONV_P + (size_t)DEPTH * NB * 3 * 768;
constexpr size_t O_SCONV_P = O_SSD_P + (size_t)DEPTH * NB * 4 * 128 * 64;
constexpr size_t O_RET_P = O_SCONV_P + (size_t)DEPTH * NB * 3 * 768;
constexpr size_t O_HGRN_S = O_RET_P + (size_t)DEPTH * NB * 4 * 64 * 64;
constexpr size_t O_GDN_S = O_HGRN_S + (size_t)DEPTH * DECB * 4 * 64 * 64;
constexpr size_t O_GCONV_S = O_GDN_S + (size_t)DEPTH * DECB * 4 * 64 * 64;
constexpr size_t O_SSD_S = O_GCONV_S + (size_t)DEPTH * DECB * 3 * 768;
constexpr size_t O_SCONV_S = O_SSD_S + (size_t)DEPTH * DECB * 4 * 128 * 64;
constexpr size_t O_RET_S = O_SCONV_S + (size_t)DEPTH * DECB * 3 * 768;
constexpr size_t O_END = O_RET_S + (size_t)DEPTH * DECB * 4 * 64 * 64;

struct Params {
    const float* x_prompt; const float* x_sample;
    const float* st_hgrn; const float* st_gdn; const float* st_gconv; const float* st_ssd; const float* st_sconv; const float* st_ret;
    const float* meta; const float* norm_w; const float* w_in; const float* lb_logits; const float* hgrn_norm_w;
    const float* gdn_conv_w; const float* gdn_a_log; const float* gdn_dt_bias; const float* gdn_norm_w;
    const float* ssd_conv_w; const float* ssd_conv_b; const float* ssd_a_log; const float* ssd_dt_bias; const float* ssd_d; const float* ssd_norm_w;
    const float* ret_norm_w; const float* ret_norm_b; const float* w_out; const float* final_norm_w;
    float* out; unsigned char* ws;
};

__device__ __forceinline__ float bf2f(bf16_t b) { return __uint_as_float(((unsigned)b) << 16); }
__device__ __forceinline__ bf16_t f2bf(float f) { unsigned u = __float_as_uint(f); u += 0x7FFFu + ((u >> 16) & 1u); return (bf16_t)(u >> 16); }
__device__ __forceinline__ unsigned pack_bf2(float lo, float hi) { return (unsigned)f2bf(lo) | ((unsigned)f2bf(hi) << 16); }
__device__ __forceinline__ float sigmoid_f(float x) { return 1.0f / (1.0f + __expf(-x)); }
__device__ __forceinline__ float silu_f(float x) { return x / (1.0f + __expf(-x)); }
__device__ __forceinline__ float softplus_f(float x) { return x > 20.0f ? x : log1pf(__expf(x)); }
__device__ __forceinline__ int opaque_tid() { int t = threadIdx.x; asm volatile("" : "+v"(t)); return t; }
__device__ __forceinline__ float lane_xor(float v, int k, int lane) { return __int_as_float(__builtin_amdgcn_ds_bpermute((lane ^ k) << 2, __float_as_int(v))); }
__device__ __forceinline__ float lane_up(float v, int k, int lane) { return __int_as_float(__builtin_amdgcn_ds_bpermute(((lane - k) & 63) << 2, __float_as_int(v))); }
__device__ __forceinline__ float wave_sum(float v, int lane) {
#pragma unroll
    for (int o = 32; o > 0; o >>= 1) v += lane_xor(v, o, lane);
    return v;
}


#define XB_TMO      128
#define XB_XCNT(j)  (256  + 64 * (j))
#define XB_XSUB(j)  (1280 + 64 * (j))
#define XB_XGEN(j)  (2304 + 64 * (j))
#define XB_TOP      3328
#define XB_TOPGEN   3392
#define XCD_BAR_WORDS 3456
#define XB_SPIN_CAP (1u << 22)
__device__ __forceinline__ unsigned xb_ld(unsigned* p)              { return __hip_atomic_load(p, __ATOMIC_RELAXED, __HIP_MEMORY_SCOPE_AGENT); }
__device__ __forceinline__ unsigned xb_add(unsigned* p, unsigned v) { return __hip_atomic_fetch_add(p, v, __ATOMIC_RELAXED, __HIP_MEMORY_SCOPE_AGENT); }
__device__ __forceinline__ unsigned xb_xcc_id() { return (unsigned)__builtin_amdgcn_s_getreg((3 << 11) | 20) & 0xFu; }
#define XB_SPIN(cond, bar) do { unsigned _sp = 0; while (cond) { __builtin_amdgcn_s_sleep(1); \
    if ((++_sp & 255u) == 0u) { if (xb_ld(&(bar)[XB_TMO])) break; if (_sp > XB_SPIN_CAP) { atomicAdd(&(bar)[XB_TMO], 1u); break; } } } } while (0)
struct XcdBarrier { unsigned* bar; unsigned x; volatile LAS unsigned* st; };
__device__ __forceinline__ XcdBarrier xcd_barrier_post(unsigned* bar, volatile LAS unsigned* st) {
    XcdBarrier b; b.bar = bar; b.x = xb_xcc_id(); b.st = st;
    if (threadIdx.x == 0) (void)xb_add(&bar[XB_XCNT(b.x)], 1u);
    return b;
}
__device__ __forceinline__ void xcd_barrier_complete(unsigned* bar, unsigned x, unsigned& nloc, unsigned& nx) {
    const unsigned G = gridDim.x * gridDim.y * gridDim.z;
    unsigned sum, cnt, mine, sp = 0u;
    for (;;) {
        sum = 0u; cnt = 0u; mine = 0u;
#pragma unroll
        for (unsigned j = 0; j < 16; ++j) { const unsigned c = xb_ld(&bar[XB_XCNT(j)]); sum += c; cnt += (c > 0u) ? 1u : 0u; mine = (j == x) ? c : mine; }
        if (sum == G) break;
        __builtin_amdgcn_s_sleep(1);
        if ((++sp & 255u) == 0u) { if (xb_ld(&bar[XB_TMO])) break; if (sp > XB_SPIN_CAP) { atomicAdd(&bar[XB_TMO], 1u); break; } }
    }
    nloc = mine > 0u ? mine : 1u; nx = cnt > 0u ? cnt : 1u;
}
__device__ __forceinline__ void xcd_barrier(const XcdBarrier& b0) {
    asm volatile("s_waitcnt vmcnt(0)" ::: "memory");
    __syncthreads();
    if (threadIdx.x == 0) {
        XcdBarrier b = b0; { unsigned x = xb_xcc_id(); asm volatile("" : "+s"(x)); b.x = x; }
        unsigned* bar = b.bar;
        __builtin_amdgcn_s_waitcnt(0);
        unsigned nloc = b.st[0], nx = b.st[1];
        if (nloc == 0u) { xcd_barrier_complete(bar, b.x, nloc, nx); b.st[0] = nloc; b.st[1] = nx; }
        const unsigned old = xb_add(&bar[XB_XSUB(b.x)], 1u);
        const unsigned gen = old / nloc;
        if (old + 1u == (gen + 1u) * nloc) {
            __builtin_amdgcn_fence(__ATOMIC_RELEASE, "agent");
            asm volatile("s_waitcnt vmcnt(0)" ::: "memory");
            const unsigned og = xb_add(&bar[XB_TOP], 1u);
            const unsigned tg = og / nx;
            if (og + 1u == (tg + 1u) * nx) xb_add(&bar[XB_TOPGEN], 1u);
            else XB_SPIN(xb_ld(&bar[XB_TOPGEN]) == tg, bar);
            __builtin_amdgcn_fence(__ATOMIC_ACQUIRE, "agent");
            xb_add(&bar[XB_XGEN(b.x)], 1u);
            asm volatile("s_waitcnt vmcnt(0)" ::: "memory");
        } else {
            XB_SPIN(xb_ld(&bar[XB_XGEN(b.x)]) == gen, bar);
            __builtin_amdgcn_fence(__ATOMIC_ACQUIRE, "agent");
            asm volatile("s_waitcnt vmcnt(0)" ::: "memory");
        }
    }
    __syncthreads();
}

namespace pg8 {
constexpr int BM = 256, BK = 64, HALF = 128, HTB = HALF * BK * 2, STAGE_BYTES = 8 * HTB, NXCD = 8, WGM = 8;
__host__ __device__ __forceinline__ int lds_byte(int r, int c) { const int st = (r >> 4) * 2 + (c >> 5), rr = r & 15, cc = c & 31, ob = rr * 64 + cc * 2; return st * 1024 + (ob ^ (((ob >> 9) & 1) << 5)); }
__host__ __device__ __forceinline__ void stage_rc(int b, int& R, int& C) { const int st = b / 1024, sb = b % 1024, swz = sb ^ (((sb >> 9) & 1) << 5); R = (st >> 1) * 16 + swz / 64; C = (st & 1) * 32 + (swz % 64) / 2; }
__host__ __device__ __forceinline__ int perm32(int rho) { const int n = rho >> 4, i = rho & 15; return 8 * (i >> 2) + 4 * n + (i & 3); }
struct Unit { int pm, pn; };
struct Gemm { const bf16_t* A; const bf16_t* Bt; int M, N, K; };
struct StaticOrder {
    int nM, nN, nwg, G, c;
    __host__ __device__ void init(int M, int N, int G_, int c_) { nM = M / BM; nN = N / BM; nwg = nM * nN; G = G_; c = c_; }
    __host__ __device__ bool next(int i, Unit& u) const {
        const long L = (long)i * G + c; if (L >= nwg) return false;
        int wgid = (int)L; { const int q = nwg / NXCD, r = nwg % NXCD, xcd = wgid % NXCD, off = wgid / NXCD; wgid = (xcd < r ? xcd * (q + 1) : r * (q + 1) + (xcd - r) * q) + off; }
        const int nig = WGM * nN, gid = wgid / nig, fm = gid * WGM, gsz = (nM - fm) < WGM ? (nM - fm) : WGM;
        u.pm = fm + ((wgid % nig) % gsz); u.pn = (wgid % nig) / gsz; return true;
    }
    __device__ __forceinline__ void a_ready(const Unit&) const {}
    __device__ __forceinline__ void done(const Unit&) const {}
};
typedef float f32x2_t __attribute__((ext_vector_type(2)));
typedef __bf16 bf16x2n_t __attribute__((ext_vector_type(2)));
__device__ __forceinline__ unsigned cvt_pk_bf16(float lo, float hi) { const f32x2_t f = {lo, hi}; return __builtin_bit_cast(unsigned, __builtin_convertvector(f, bf16x2n_t)); }

struct EpiProj {
    static constexpr bool PERM = true, AFTER_DRAIN = false;
    bf16_t* O; int ldc; const float* rs;
    __device__ __forceinline__ void operator()(const f32x4 (&acc)[2][2][4][2], const Unit& u, int wr, int wc, int fr, int fq) const {
        const int row0 = u.pm * BM + wr * 64 + fr; const int col0 = u.pn * BM + wc * 32 + 8 * fq;
#pragma unroll
        for (int ai = 0; ai < 2; ++ai)
#pragma unroll
            for (int m = 0; m < 4; ++m) { const int row = row0 + ai * HALF + m * 16; const float s = rs[row]; bf16_t* rowp = O + (size_t)row * ldc + col0;
#pragma unroll
                for (int bj = 0; bj < 2; ++bj) { const f32x4 v0 = acc[ai][bj][m][0] * s, v1 = acc[ai][bj][m][1] * s;
                    u32x4 w; w.x = cvt_pk_bf16(v0[0], v0[1]); w.y = cvt_pk_bf16(v0[2], v0[3]); w.z = cvt_pk_bf16(v1[0], v1[1]); w.w = cvt_pk_bf16(v1[2], v1[3]);
                    *(u32x4*)(rowp + bj * HALF) = w; } }
    }
};
struct EpiResid {
    static constexpr bool PERM = false, AFTER_DRAIN = false;
    float* C; int ldc;
    __device__ __forceinline__ void operator()(const f32x4 (&acc)[2][2][4][2], const Unit& u, int wr, int wc, int fr, int fq) const {
        const int row0 = u.pm * BM + wr * 64 + fr, col0 = u.pn * BM + wc * 32 + 4 * fq;
#pragma unroll
        for (int ai = 0; ai < 2; ++ai)
#pragma unroll
            for (int m = 0; m < 4; ++m) { float* rowp = C + (size_t)(row0 + ai * HALF + m * 16) * ldc + col0;
#pragma unroll
                for (int bj = 0; bj < 2; ++bj)
#pragma unroll
                    for (int n = 0; n < 2; ++n) { f32x4* p = (f32x4*)(rowp + bj * HALF + n * 16); *p = *p + acc[ai][bj][m][n]; } }
    }
};

template <class Epi, class Sched>
__device__ __forceinline__ void gemm_phase(LAS unsigned char* lds, const Gemm g, const Sched& S, const Epi& E) {
    const int tid = opaque_tid(), wid = __builtin_amdgcn_readfirstlane(tid >> 6), lane = tid & 63, wr = wid >> 2, wc = wid & 3, fr = lane & 15, fq = lane >> 4;
    const int K = g.K, nt = K / BK;
    unsigned voffA[2], voffB[2];
#pragma unroll
    for (int i = 0; i < 2; ++i) { int R, C; stage_rc(tid * 16 + i * 8192, R, C); const int Rb = Epi::PERM ? ((R & ~31) + perm32(R & 31)) : R;
        voffA[i] = (unsigned)(R * K + C) * 2u; voffB[i] = (unsigned)(Rb * K + C) * 2u; }
    const size_t kstep = (size_t)(BK * 2);
    const size_t hstep = (size_t)HALF * K * 2;
    const size_t tstep = 2 * hstep;
    const unsigned ldsw = (unsigned)wid * 1024u;
    const int aoff = lds_byte(wr * 64 + fr, fq * 8), boff = lds_byte(wc * 32 + fr, fq * 8);
#define PG8_SA(b, h) (((b) * 2 + (h)) * HTB)
#define PG8_SB(b, h) ((4 + (b) * 2 + (h)) * HTB)
#define PG8_STAGE(bufoff, gbase, voff) do { _Pragma("unroll") for (int _i = 0; _i < 2; ++_i) \
        __builtin_amdgcn_global_load_lds((const unsigned*)((const char*)(gbase) + (voff)[_i]), (LAS unsigned*)(lds + (bufoff) + ldsw + _i * 8192), 16, 0, 0); } while (0)
#define PG8_LDA(dst, b, h) do { _Pragma("unroll") for (int m = 0; m < 4; ++m) _Pragma("unroll") for (int k = 0; k < 2; ++k) dst[m][k] = *(const LAS bf16x8*)(lds + PG8_SA(b, h) + aoff + m * 2048 + k * 1024); } while (0)
#define PG8_LDB(dst, b, h) do { _Pragma("unroll") for (int n = 0; n < 2; ++n) _Pragma("unroll") for (int k = 0; k < 2; ++k) dst[n][k] = *(const LAS bf16x8*)(lds + PG8_SB(b, h) + boff + n * 2048 + k * 1024); } while (0)
#define PG8_MMA(ai, bj, At, Bt) do { __builtin_amdgcn_s_setprio(1); _Pragma("unroll") for (int m = 0; m < 4; ++m) _Pragma("unroll") for (int n = 0; n < 2; ++n) _Pragma("unroll") for (int k = 0; k < 2; ++k) \
        acc[ai][bj][m][n] = __builtin_amdgcn_mfma_f32_16x16x32_bf16(Bt[n][k], At[m][k], acc[ai][bj][m][n], 0, 0, 0); __builtin_amdgcn_s_setprio(0); } while (0)
#define PG8_WAIT_V(n) asm volatile("s_waitcnt vmcnt(" #n ")" ::: "memory")
#define PG8_WAIT_L(n) asm volatile("s_waitcnt lgkmcnt(" #n ")" ::: "memory")
#define PG8_BAR __builtin_amdgcn_s_barrier()
#define PG8_SCHED __builtin_amdgcn_sched_barrier(0)
    Unit cur, nxt; int ui = 0;
    if (!S.next(0, cur)) return;
    f32x4 acc[2][2][4][2];
#pragma unroll
    for (int a = 0; a < 2; ++a)
#pragma unroll
        for (int b = 0; b < 2; ++b)
#pragma unroll
            for (int m = 0; m < 4; ++m)
#pragma unroll
                for (int n = 0; n < 2; ++n) acc[a][b][m][n] = (f32x4){0.f, 0.f, 0.f, 0.f};
    bf16x8 At[4][2], B0[2][2], B1[2][2];
    const char* cA = (const char*)g.A + (size_t)cur.pm * tstep; const char* cB = (const char*)g.Bt + (size_t)cur.pn * tstep;
    S.a_ready(cur);
    PG8_STAGE(PG8_SB(0, 0), cB, voffB); PG8_STAGE(PG8_SA(0, 0), cA, voffA); PG8_STAGE(PG8_SB(0, 1), cB + hstep, voffB); PG8_STAGE(PG8_SA(0, 1), cA + hstep, voffA);
    if (wr == 1) PG8_BAR;
    PG8_WAIT_V(4); PG8_BAR;
    PG8_STAGE(PG8_SB(1, 0), cB + kstep, voffB); PG8_STAGE(PG8_SA(1, 0), cA + kstep, voffA); PG8_STAGE(PG8_SB(1, 1), cB + hstep + kstep, voffB);
    PG8_WAIT_V(6); PG8_BAR;
    for (;;) {
        const bool has_next = S.next(ui + 1, nxt);
        const char* nA = has_next ? (const char*)g.A + (size_t)nxt.pm * tstep : cA; const char* nB = has_next ? (const char*)g.Bt + (size_t)nxt.pn * tstep : cB;
        for (int t = 0; t < nt; t += 2) {
            const bool last = (t == nt - 2);
            const char* a1 = cA + (size_t)(t + 1) * kstep;
            const char* a2 = last ? nA : cA + (size_t)(t + 2) * kstep; const char* b2 = last ? nB : cB + (size_t)(t + 2) * kstep;
            const char* a3 = a2 + kstep; const char* b3 = b2 + kstep;
            if (last && has_next) S.a_ready(nxt);
            PG8_LDB(B0, 0, 0); PG8_SCHED; PG8_LDA(At, 0, 0); PG8_STAGE(PG8_SA(1, 1), a1 + hstep, voffA);
            PG8_WAIT_L(8); PG8_BAR; PG8_WAIT_L(0); PG8_MMA(0, 0, At, B0); PG8_BAR; PG8_SCHED;
            PG8_LDB(B1, 0, 1); PG8_STAGE(PG8_SB(0, 0), b2, voffB);
            PG8_BAR; PG8_WAIT_L(0); PG8_MMA(0, 1, At, B1); PG8_BAR;
            PG8_LDA(At, 0, 1); PG8_STAGE(PG8_SA(0, 0), a2, voffA);
            PG8_BAR; PG8_WAIT_L(0); PG8_MMA(1, 0, At, B0); PG8_BAR; PG8_SCHED;
            PG8_STAGE(PG8_SB(0, 1), b2 + hstep, voffB);
            PG8_WAIT_V(6); PG8_BAR; PG8_MMA(1, 1, At, B1); PG8_BAR;
            PG8_LDB(B0, 1, 0); PG8_SCHED; PG8_LDA(At, 1, 0); PG8_STAGE(PG8_SA(0, 1), a2 + hstep, voffA);
            PG8_WAIT_L(8); PG8_BAR; PG8_WAIT_L(0); PG8_MMA(0, 0, At, B0); PG8_BAR; PG8_SCHED;
            PG8_LDB(B1, 1, 1); PG8_STAGE(PG8_SB(1, 0), b3, voffB);
            PG8_BAR; PG8_WAIT_L(0); PG8_MMA(0, 1, At, B1); PG8_BAR;
            PG8_LDA(At, 1, 1); PG8_STAGE(PG8_SA(1, 0), a3, voffA);
            PG8_BAR; PG8_WAIT_L(0); PG8_MMA(1, 0, At, B0); PG8_BAR; PG8_SCHED;
            PG8_STAGE(PG8_SB(1, 1), b3 + hstep, voffB);
            PG8_WAIT_V(6); PG8_BAR; PG8_MMA(1, 1, At, B1); PG8_BAR;
        }
        if constexpr (!Epi::AFTER_DRAIN) { E(acc, cur, wr, wc, fr, fq); S.done(cur); }
        if (!has_next) break;
#pragma unroll
        for (int a = 0; a < 2; ++a)
#pragma unroll
            for (int b = 0; b < 2; ++b)
#pragma unroll
                for (int m = 0; m < 4; ++m)
#pragma unroll
                    for (int n = 0; n < 2; ++n) acc[a][b][m][n] = (f32x4){0.f, 0.f, 0.f, 0.f};
        cur = nxt; cA = nA; cB = nB; ++ui;
    }
    PG8_WAIT_V(0);
    if (wr == 0) PG8_BAR;
    PG8_BAR;
#undef PG8_SA
#undef PG8_SB
#undef PG8_STAGE
#undef PG8_LDA
#undef PG8_LDB
#undef PG8_MMA
#undef PG8_WAIT_V
#undef PG8_WAIT_L
#undef PG8_BAR
#undef PG8_SCHED
}
}

__device__ __forceinline__ int win_col(int n) { return n < 2048 ? n : (n < 3072 ? n + 8 : n + 12); }
__device__ __forceinline__ int win_smcol(int j) { return j < 8 ? 2048 + j : 3080 + (j - 8); }

__device__ __forceinline__ void convert_weights(const Params& p, int l_in, int l_out, LAS float* tile  , int tid, int blk, int nblk) {
    const int tiles_in = l_in >= 0 ? 64 * 16 : 0, tiles_out = l_out >= 0 ? 16 * 16 : 0;
    for (int t = blk; t < tiles_in + tiles_out; t += nblk) {
        const float* src; bf16_t* dst; int ld, n0, k0; const float* scale;
        if (t < tiles_in) { n0 = (t / 16) * 64; k0 = (t % 16) * 64; src = p.w_in + (size_t)l_in * DM * IN_DIM + win_col(n0); ld = IN_DIM; dst = (bf16_t*)(p.ws + WS_WINT); scale = p.norm_w + l_in * DM; }
        else { const int r = t - tiles_in; n0 = (r / 16) * 64; k0 = (r % 16) * 64; src = p.w_out + (size_t)l_out * DM * DM + n0; ld = DM; dst = (bf16_t*)(p.ws + WS_WOUTT); scale = nullptr; }
        __syncthreads();
#pragma unroll
        for (int n_ = 0; n_ < 8; ++n_) { const int e = tid + 512 * n_; const int kk = e >> 6, nn = e & 63; float v = src[(size_t)(k0 + kk) * ld + nn]; if (scale) v *= scale[k0 + kk]; tile[kk * 65 + nn] = v; }
        __syncthreads();
#pragma unroll
        for (int n_ = 0; n_ < 4; ++n_) { const int e = tid + 512 * n_; const int nn = e >> 5, kp = (e & 31) * 2; const unsigned w = pack_bf2(tile[kp * 65 + nn], tile[(kp + 1) * 65 + nn]);
            *(unsigned*)(dst + (size_t)(n0 + nn) * DM + k0 + kp) = w; }
    }
    __syncthreads();
}

__device__ void ph_prep(const Params& p_in, LAS unsigned char* lds_in, int blk, int nblk) {
    Params p = p_in; asm volatile("" : "+s"(p.ws), "+s"(p.out));
    LAS unsigned char* lds = lds_in; asm volatile("" : "+s"(lds));

    const int tid = opaque_tid();
    LAS float* tile = (LAS float*)lds;
    convert_weights(p, 0, 0, tile, tid, blk, nblk);
    for (int e = blk * 512 + tid; e < DEPTH * NSM * DM; e += nblk * 512) { const int l = e / (NSM * DM), r = e % (NSM * DM), j = r / DM, k = r % DM;
        ((float*)(p.ws + WS_WSM))[e] = p.w_in[(size_t)l * DM * IN_DIM + (size_t)k * IN_DIM + win_smcol(j)] * p.norm_w[l * DM + k]; }
    for (int c = blk * 512 + tid; c < 256; c += nblk * 512) { float lg[DEPTH], mx = -1e30f;
#pragma unroll
        for (int l = 0; l < DEPTH; ++l) { lg[l] = p.lb_logits[l * 256 + c]; mx = fmaxf(mx, lg[l]); }
        float s = 0.f;
#pragma unroll
        for (int l = 0; l < DEPTH; ++l) { lg[l] = expf(lg[l] - mx); s += lg[l]; }
        float cum = 0.f; const float w0 = lg[0] / s;
#pragma unroll
        for (int l = 0; l < DEPTH; ++l) { cum += lg[l] / s; ((float*)(p.ws + WS_LB))[l * 256 + c] = fmaxf(cum - w0, 0.f); } }
    for (int e = blk * 512 + tid; e < (TP + 1) * 32; e += nblk * 512) { const int pi = e >> 5, i = e & 31; const double pos = pi < TP ? (double)pi : (double)PASTLEN;
        const float invf = (float)(1.0 / pow(10000.0, (double)((float)i / 31.0f)));
        const double rev = pos * (double)invf * 0.15915494309189535; const float fr = (float)(rev - rint(rev));
        ((float*)(p.ws + WS_ROT))[e * 2 + 0] = __builtin_amdgcn_cosf(fr); ((float*)(p.ws + WS_ROT))[e * 2 + 1] = __builtin_amdgcn_sinf(fr); }
    float* h = (float*)(p.ws + WS_H);
    for (int e = blk * 512 + tid; e < MROWS * (DM / 4); e += nblk * 512) { const int row = e >> 8, c4 = (e & 255) * 4; const float* src;
        if (row < MP) { const int b = row / TP, t = row % TP; src = t < NMETA ? p.meta + t * DM : p.x_prompt + ((size_t)b * SEQ + (t - NMETA)) * DM; } else src = p.x_sample + (size_t)(row - MP) * DM;
        *(f32x4*)(h + (size_t)row * DM + c4) = *(const f32x4*)(src + c4); }
}

__device__ void ph_rownorm(const Params& p_in, int layer, int blk, int nblk) {
    Params p = p_in; asm volatile("" : "+s"(p.ws), "+s"(p.out));

    const int tid = opaque_tid(), wid = tid >> 6, lane = tid & 63;
    const float* h = (const float*)(p.ws + WS_H); bf16_t* hb = (bf16_t*)(p.ws + WS_HB); float* rs = (float*)(p.ws + WS_RS); float* psm = (float*)(p.ws + WS_PSM);
    const float* wsm = (const float*)(p.ws + WS_WSM) + (size_t)layer * NSM * DM;
    for (int row = blk * 8 + wid; row < MROWS; row += nblk * 8) {
        f32x4 v[4]; float ss = 0.f;
#pragma unroll
        for (int j = 0; j < 4; ++j) { v[j] = *(const f32x4*)(h + (size_t)row * DM + j * 256 + lane * 4); ss += v[j][0] * v[j][0] + v[j][1] * v[j][1] + v[j][2] * v[j][2] + v[j][3] * v[j][3]; }
        ss = wave_sum(ss, lane); const float r = rsqrtf(ss * (1.0f / DM) + EPSF);
#pragma unroll
        for (int j = 0; j < 4; ++j) { u32x2 w; w.x = pack_bf2(v[j][0], v[j][1]); w.y = pack_bf2(v[j][2], v[j][3]); *(u32x2*)(hb + (size_t)row * DM + j * 256 + lane * 4) = w; }
        float mine = 0.f;
        for (int q = 0; q < NSM; ++q) { float d = 0.f;
#pragma unroll
            for (int j = 0; j < 4; ++j) { const f32x4 w = *(const f32x4*)(wsm + q * DM + j * 256 + lane * 4); d += v[j][0] * w[0] + v[j][1] * w[1] + v[j][2] * w[2] + v[j][3] * w[3]; }
            d = wave_sum(d, lane); if (lane == q) mine = d * r; }
        if (lane < NSM) psm[(size_t)row * NSM + lane] = mine;
        if (lane == 0) rs[row] = r;
    }
}

__device__ void ph_gemm_in(const Params& p_in, int layer, LAS unsigned char* lds_in, int blk, int nblk) {
    Params p = p_in; asm volatile("" : "+s"(p.ws), "+s"(p.out));
    LAS unsigned char* lds = lds_in; asm volatile("" : "+s"(lds));

    pg8::Gemm g{(const bf16_t*)(p.ws + WS_HB), (const bf16_t*)(p.ws + WS_WINT), MROWS, NBIG, DM};
    pg8::StaticOrder S; S.init(MROWS, NBIG, nblk, blk);
    pg8::EpiProj E{(bf16_t*)(p.ws + WS_PROJ), NBIG, (const float*)(p.ws + WS_RS)};
    pg8::gemm_phase<pg8::EpiProj, pg8::StaticOrder>(lds, g, S, E);
}
__device__ void ph_gemm_out(const Params& p_in, int layer, LAS unsigned char* lds_in, int blk, int nblk) {
    Params p = p_in; asm volatile("" : "+s"(p.ws), "+s"(p.out));
    LAS unsigned char* lds = lds_in; asm volatile("" : "+s"(lds));

    pg8::Gemm g{(const bf16_t*)(p.ws + WS_Y), (const bf16_t*)(p.ws + WS_WOUTT), MROWS, DM, DM};
    pg8::StaticOrder S; S.init(MROWS, DM, nblk, blk);
    pg8::EpiResid E{(float*)(p.ws + WS_H), DM};
    pg8::gemm_phase<pg8::EpiResid, pg8::StaticOrder>(lds, g, S, E);
}

constexpr int TB = 16;
struct MixLds {
    static constexpr int QS = 0, KS = QS + TB * 128, VS = KS + TB * 128, DS = VS + TB * 128, ZS = DS + TB * 128, XS = ZS + TB * 128, OS = XS + TB * 128, BS = OS + TB * 128, SC = BS + TB * 2, END = SC + TB * 2;
};

struct SeqInfo { int row0, T, dec, b; };
__device__ __forceinline__ SeqInfo seq_info(int s) { SeqInfo q; if (s < NB) { q.row0 = s * TP; q.T = TP; q.dec = 0; q.b = s; } else { q.row0 = MP + (s - NB); q.T = 1; q.dec = 1; q.b = s - NB; } return q; }

__device__ __forceinline__ float preconv(const bf16_t* proj, const SeqInfo& q, int t, int col, const float* ctx  , int ch) {
    if (t >= 0) return bf2f(proj[(size_t)(q.row0 + t) * NBIG + col]);
    return ctx ? ctx[(3 + t) * 768 + ch] : 0.f;
}

template <int DK, int NV, bool DELTA, bool VECDEC>
__device__ __forceinline__ void recur_batch(float (&S)[DK / (64 / NV)], LAS float* L, int nb, int wid, int lane) {
    constexpr int KQ = 64 / NV, KR = DK / KQ, DVT = 8 * NV;
    const int kq = lane / NV, vv = lane % NV, vcol = wid * NV + vv, hh = vcol >> 6;
    for (int t = 0; t < nb; ++t) {
        float kk[KR], qq[KR];
#pragma unroll
        for (int i = 0; i < KR; ++i) { kk[i] = L[MixLds::KS + t * 128 + kq * KR + i]; qq[i] = L[MixLds::QS + t * 128 + kq * KR + i]; }
        const float v = L[MixLds::VS + t * 128 + vcol];
        if (DELTA) {
            const float dec = L[MixLds::DS + t * 128 + hh]; float pk = 0.f;
#pragma unroll
            for (int i = 0; i < KR; ++i) { S[i] *= dec; pk += kk[i] * S[i]; }
#pragma unroll
            for (int o = NV; o < 64; o <<= 1) pk += lane_xor(pk, o, lane);
            const float u = L[MixLds::BS + t] * (v - pk);
#pragma unroll
            for (int i = 0; i < KR; ++i) S[i] += kk[i] * u;
        } else if (VECDEC) {
#pragma unroll
            for (int i = 0; i < KR; ++i) S[i] = L[MixLds::DS + t * 128 + kq * KR + i] * S[i] + kk[i] * v;
        } else {
            const float dec = L[MixLds::DS + t * 128 + hh];
#pragma unroll
            for (int i = 0; i < KR; ++i) S[i] = dec * S[i] + kk[i] * v;
        }
        float po = 0.f;
#pragma unroll
        for (int i = 0; i < KR; ++i) po += qq[i] * S[i];
#pragma unroll
        for (int o = NV; o < 64; o <<= 1) po += lane_xor(po, o, lane);
        if (kq == 0) L[MixLds::OS + t * 128 + vcol] = po;
    }
    (void)DVT;
}

template <int MIX>
__device__ void mixer_item(const Params& p, int layer, int s, int hu  , LAS float* L) {
    constexpr int DK = MIX == 2 ? 128 : 64, NV = MIX == 2 ? 16 : 8, KQ = 64 / NV, KR = DK / KQ, DVT = 8 * NV;
    const int tid = opaque_tid(), wid = tid >> 6, lane = tid & 63;
    const SeqInfo q = seq_info(s);
    const bf16_t* proj = (const bf16_t*)(p.ws + WS_PROJ); const float* psm = (const float*)(p.ws + WS_PSM); bf16_t* y = (bf16_t*)(p.ws + WS_Y);
    const float* lb = (const float*)(p.ws + WS_LB) + layer * 256; const float* rot = (const float*)(p.ws + WS_ROT);
    const int kq = lane / NV, vv = lane % NV, vcol = wid * NV + vv, hh = vcol >> 6;
    const int head = MIX == 2 ? hu * 2 + hh : hu;
    const float* ctx = nullptr; const float* cw = nullptr;
    if (MIX == 1) { cw = p.gdn_conv_w + (size_t)layer * 4 * 768; if (q.dec) ctx = p.st_gconv + ((size_t)layer * DECB + q.b) * 3 * 768; }
    if (MIX == 2) { cw = p.ssd_conv_w + (size_t)layer * 4 * 768; if (q.dec) ctx = p.st_sconv + ((size_t)layer * DECB + q.b) * 3 * 768; }
    float S[KR];
    {
        const float* st = MIX == 0 ? p.st_hgrn : MIX == 1 ? p.st_gdn : MIX == 2 ? p.st_ssd : p.st_ret;
#pragma unroll
        for (int i = 0; i < KR; ++i) S[i] = q.dec ? st[(((size_t)layer * DECB + q.b) * 4 + head) * DK * 64 + (size_t)(kq * KR + i) * 64 + (vcol & 63)] : 0.f;
    }
    float hc0 = 0.f, hc1 = 0.f;
    if (MIX == 1) { hc0 = -__expf(p.gdn_a_log[layer * 4 + hu]); hc1 = p.gdn_dt_bias[layer * 4 + hu]; }
    if (MIX == 3) { hc0 = 1.0f - exp2f(-5.0f - (float)hu); }

    for (int t0 = 0; t0 < q.T; t0 += TB) {
        const int nb = min(TB, q.T - t0);
        __syncthreads();
        if (MIX == 0) {
            for (int e = tid; e < nb * 64; e += 512) { const int t = e >> 6, d = e & 63, c = hu * 64 + d; const bf16_t* pr = proj + (size_t)(q.row0 + t0 + t) * NBIG;
                const float aq = bf2f(pr[PC_AQ + c]), af = bf2f(pr[PC_AF + c]), ai = bf2f(pr[PC_AI + c]), az = bf2f(pr[PC_AZ + c]), l_ = lb[c];
                L[MixLds::QS + t * 128 + d] = silu_f(aq) * 0.125f; L[MixLds::KS + t * 128 + d] = (1.0f - l_) * sigmoid_f(-af); L[MixLds::DS + t * 128 + d] = l_ + (1.0f - l_) * sigmoid_f(af);
                L[MixLds::VS + t * 128 + d] = ai; L[MixLds::ZS + t * 128 + d] = az; }
        } else if (MIX == 1) {
            for (int e = tid; e < nb * 192; e += 512) { const int t = e / 192, r = e % 192, part = r >> 6, d = r & 63, ch = part * 256 + hu * 64 + d, col = PC_BQKV + ch; const int tt = t0 + t;
                float a = 0.f;
#pragma unroll
                for (int j = 0; j < 4; ++j) a += cw[j * 768 + ch] * preconv(proj, q, tt - 3 + j, col, ctx, ch);
                a = silu_f(a);
                L[(part == 0 ? MixLds::QS : part == 1 ? MixLds::KS : MixLds::VS) + t * 128 + d] = a; }
            for (int e = tid; e < nb * 64; e += 512) { const int t = e >> 6, d = e & 63; L[MixLds::ZS + t * 128 + d] = bf2f(proj[(size_t)(q.row0 + t0 + t) * NBIG + PC_BZ + hu * 64 + d]); }
            if (tid < nb) { const float* ps = psm + (size_t)(q.row0 + t0 + tid) * NSM; const float g = hc0 * softplus_f(ps[hu] + hc1);
                L[MixLds::DS + tid * 128 + 0] = __expf(g); L[MixLds::BS + tid] = sigmoid_f(ps[4 + hu]); }
            __syncthreads();
            if (tid < nb * 2) { const int t = tid >> 1, which = tid & 1; const LAS float* src = L + (which ? MixLds::KS : MixLds::QS) + t * 128; float ss = 0.f;
                for (int d = 0; d < 64; ++d) ss += src[d] * src[d];
                L[MixLds::SC + tid] = rsqrtf(ss + EPSF) * (which ? 1.0f : 0.125f); }
            __syncthreads();
            for (int e = tid; e < nb * 128; e += 512) { const int t = e >> 7, r = e & 127, which = r >> 6, d = r & 63; L[(which ? MixLds::KS : MixLds::QS) + t * 128 + d] *= L[MixLds::SC + t * 2 + which]; }
        } else if (MIX == 2) {
            if (tid < nb * 2) { const int t = tid >> 1, h2 = tid & 1, hd = hu * 2 + h2; const float dt = softplus_f(psm[(size_t)(q.row0 + t0 + t) * NSM + 8 + hd] + p.ssd_dt_bias[layer * 4 + hd]);
                L[MixLds::BS + tid] = dt; L[MixLds::DS + t * 128 + h2] = __expf(-dt * __expf(p.ssd_a_log[layer * 4 + hd])); }
            __syncthreads();
            for (int e = tid; e < nb * 384; e += 512) { const int t = e / 384, r = e % 384, part = r >> 7, j = r & 127, ch = part * 256 + hu * 128 + j, col = PC_CXBC + ch; const int tt = t0 + t;
                float a = p.ssd_conv_b[layer * 768 + ch];
#pragma unroll
                for (int jj = 0; jj < 4; ++jj) a += cw[jj * 768 + ch] * preconv(proj, q, tt - 3 + jj, col, ctx, ch);
                a = silu_f(a);
                if (part == 0) { L[MixLds::XS + t * 128 + j] = a; L[MixLds::VS + t * 128 + j] = a * L[MixLds::BS + t * 2 + (j >> 6)]; }
                else if (part == 1) L[MixLds::KS + t * 128 + j] = a; else L[MixLds::QS + t * 128 + j] = a; }
            for (int e = tid; e < nb * 128; e += 512) { const int t = e >> 7, j = e & 127; L[MixLds::ZS + t * 128 + j] = bf2f(proj[(size_t)(q.row0 + t0 + t) * NBIG + PC_CZ + hu * 128 + j]); }
        } else {
            for (int e = tid; e < nb * 32; e += 512) { const int t = e >> 5, i = e & 31; const bf16_t* pr = proj + (size_t)(q.row0 + t0 + t) * NBIG; const int pidx = q.dec ? TP : (t0 + t);
                const float cs = rot[(pidx * 32 + i) * 2], sn = rot[(pidx * 32 + i) * 2 + 1];
                const float q1 = bf2f(pr[PC_DQ + hu * 64 + i]), q2 = bf2f(pr[PC_DQ + hu * 64 + 32 + i]), k1 = bf2f(pr[PC_DK + hu * 64 + i]), k2 = bf2f(pr[PC_DK + hu * 64 + 32 + i]);
                L[MixLds::QS + t * 128 + i] = q1 * cs - q2 * sn; L[MixLds::QS + t * 128 + 32 + i] = q2 * cs + q1 * sn;
                L[MixLds::KS + t * 128 + i] = (k1 * cs - k2 * sn) * 0.125f; L[MixLds::KS + t * 128 + 32 + i] = (k2 * cs + k1 * sn) * 0.125f; }
            for (int e = tid; e < nb * 64; e += 512) { const int t = e >> 6, d = e & 63; const bf16_t* pr = proj + (size_t)(q.row0 + t0 + t) * NBIG;
                L[MixLds::VS + t * 128 + d] = bf2f(pr[PC_DV + hu * 64 + d]); L[MixLds::ZS + t * 128 + d] = bf2f(pr[PC_DZ + hu * 64 + d]); }
            if (tid < nb) L[MixLds::DS + tid * 128] = hc0;
        }
        __syncthreads();
        recur_batch<DK, NV, MIX == 1, MIX == 0>(S, L, nb, wid, lane);
        __syncthreads();
        for (int t = wid; t < nb; t += 8) {
            const size_t yrow = (size_t)(q.row0 + t0 + t) * DM;
            if (MIX == 0 || MIX == 1) { const float o = L[MixLds::OS + t * 128 + lane]; const float ms = wave_sum(o * o, lane) * (1.0f / 64.0f);
                const float w = (MIX == 0 ? p.hgrn_norm_w : p.gdn_norm_w)[layer * 256 + hu * 64 + lane];
                y[yrow + (MIX == 0 ? 0 : 256) + hu * 64 + lane] = f2bf(o * rsqrtf(ms + EPSF) * w * silu_f(L[MixLds::ZS + t * 128 + lane])); }
            else if (MIX == 2) { float u[2]; float ss = 0.f;
#pragma unroll
                for (int r = 0; r < 2; ++r) { const int j = lane + 64 * r; const float o = L[MixLds::OS + t * 128 + j] + p.ssd_d[layer * 4 + hu * 2 + r] * L[MixLds::XS + t * 128 + j]; u[r] = o * silu_f(L[MixLds::ZS + t * 128 + j]); ss += u[r] * u[r]; }
                const float sc = rsqrtf(wave_sum(ss, lane) * (1.0f / 128.0f) + EPSF);
#pragma unroll
                for (int r = 0; r < 2; ++r) { const int j = lane + 64 * r; y[yrow + 512 + hu * 128 + j] = f2bf(u[r] * sc * p.ssd_norm_w[layer * 256 + hu * 128 + j]); } }
            else { const float o = L[MixLds::OS + t * 128 + lane]; const float mu = wave_sum(o, lane) * (1.0f / 64.0f); const float dv = o - mu; const float var = wave_sum(dv * dv, lane) * (1.0f / 64.0f);
                const int c = hu * 64 + lane;
                y[yrow + 768 + c] = f2bf((dv * rsqrtf(var + EPSF) * p.ret_norm_w[layer * 256 + c] + p.ret_norm_b[layer * 256 + c]) * silu_f(L[MixLds::ZS + t * 128 + lane])); }
        }
    }
    {
        float* so = p.out + (q.dec ? (MIX == 0 ? O_HGRN_S : MIX == 1 ? O_GDN_S : MIX == 2 ? O_SSD_S : O_RET_S) : (MIX == 0 ? O_HGRN_P : MIX == 1 ? O_GDN_P : MIX == 2 ? O_SSD_P : O_RET_P));
        const int nbt = q.dec ? DECB : NB;
#pragma unroll
        for (int i = 0; i < KR; ++i) so[(((size_t)layer * nbt + q.b) * 4 + head) * DK * 64 + (size_t)(kq * KR + i) * 64 + (vcol & 63)] = S[i];
    }
    if (MIX == 1 || MIX == 2) {
        float* co = p.out + (q.dec ? (MIX == 1 ? O_GCONV_S : O_SCONV_S) : (MIX == 1 ? O_GCONV_P : O_SCONV_P)) + ((size_t)layer * (q.dec ? DECB : NB) + q.b) * 3 * 768;
        const int nch = MIX == 1 ? 192 : 384;
        for (int e = tid; e < 3 * nch; e += 512) { const int r = e / nch, c = e % nch; int ch;
            if (MIX == 1) ch = (c >> 6) * 256 + hu * 64 + (c & 63); else ch = (c >> 7) * 256 + hu * 128 + (c & 127);
            co[r * 768 + ch] = preconv(proj, q, q.T - 3 + r, (MIX == 1 ? PC_BQKV : PC_CXBC) + ch, ctx, ch); }
    }
    (void)DVT;
}

constexpr int NCHUNK = 33;
constexpr int LDP = 72;
constexpr int LDP2 = 136;
constexpr int OSP = 68;
typedef short bf16x4 __attribute__((ext_vector_type(4)));
__device__ __forceinline__ f32x4 mfma16(bf16x8 a, bf16x8 b, f32x4 c) { return __builtin_amdgcn_mfma_f32_16x16x32_bf16(a, b, c, 0, 0, 0); }
__device__ __forceinline__ float fexp2(float x) { return __builtin_amdgcn_exp2f(x); }
__device__ __forceinline__ bf16x8 frag_ld(const LAS bf16_t* t, int pitch, int row, int col) { return *(const LAS bf16x8*)(t + row * pitch + col); }
__device__ __forceinline__ bf16x8 frag_ld_perm(const LAS bf16_t* t, int pitch, int row, int k0, int q) {
    const bf16x4 lo = *(const LAS bf16x4*)(t + row * pitch + k0 + 4 * q), hi = *(const LAS bf16x4*)(t + row * pitch + k0 + 16 + 4 * q);
    return __builtin_shufflevector(lo, hi, 0, 1, 2, 3, 4, 5, 6, 7);
}
__device__ __forceinline__ bf16x8 pack_acc2(const f32x4& a, const f32x4& b) {
    u32x4 w; w.x = pg8::cvt_pk_bf16(a[0], a[1]); w.y = pg8::cvt_pk_bf16(a[2], a[3]); w.z = pg8::cvt_pk_bf16(b[0], b[1]); w.w = pg8::cvt_pk_bf16(b[2], b[3]);
    return __builtin_bit_cast(bf16x8, w);
}
__device__ __forceinline__ void st_bf4(LAS bf16_t* dst, const f32x4& v) { u32x2 w; w.x = pg8::cvt_pk_bf16(v[0], v[1]); w.y = pg8::cvt_pk_bf16(v[2], v[3]); *(LAS u32x2*)dst = w; }
__device__ __forceinline__ void unpack_bf8(const u32x4& w, float* a) { const unsigned x[4] = {w.x, w.y, w.z, w.w};
#pragma unroll
    for (int k = 0; k < 4; ++k) { a[2 * k] = __uint_as_float(x[k] << 16); a[2 * k + 1] = __uint_as_float(x[k] & 0xffff0000u); } }
__device__ __forceinline__ u32x4 pack_bf8(const float* a) { u32x4 w; w.x = pg8::cvt_pk_bf16(a[0], a[1]); w.y = pg8::cvt_pk_bf16(a[2], a[3]); w.z = pg8::cvt_pk_bf16(a[4], a[5]); w.w = pg8::cvt_pk_bf16(a[6], a[7]); return w; }

constexpr size_t HR_QF = 0, HR_OI = 8192, HR_DS = 16384, HR_VEC = 24576, HR_UNIT = 25088;
constexpr size_t SS_QF = 0, SS_HEAD = 16384  , SS_VEC = 65536  , SS_UNIT = 66560;
constexpr size_t GD_U = 0, GD_W = 8192, GD_Q = 16384, GD_P = 24576, GD_K = 32768, GD_VEC = 40960, GD_UNIT = 41728;
constexpr size_t YOFF_R = 37748736;
static_assert((size_t)NB * NCHUNK * 2 * SS_UNIT <= YOFF_R && YOFF_R + (size_t)NB * NCHUNK * 4 * HR_UNIT <= (size_t)NB * SEQ * DM * 4 && (size_t)NB * NCHUNK * 4 * HR_UNIT <= (size_t)MROWS * DM * 2 && (size_t)NB * NCHUNK * 4 * GD_UNIT == WS_END - WS_E, "scratch map");
__device__ __forceinline__ unsigned char* rec_hgrn(const Params& p, int b, int c, int h) { return p.ws + WS_HB + (size_t)((b * NCHUNK + c) * 4 + h) * HR_UNIT; }
__device__ __forceinline__ unsigned char* rec_ret(const Params& p, int b, int c, int h) { return (unsigned char*)(p.out + O_YP) + YOFF_R + (size_t)((b * NCHUNK + c) * 4 + h) * HR_UNIT; }
__device__ __forceinline__ unsigned char* rec_gdn(const Params& p, int b, int c, int h) { return p.ws + WS_E + (size_t)((b * NCHUNK + c) * 4 + h) * GD_UNIT; }
__device__ __forceinline__ unsigned char* rec_ssd(const Params& p, int b, int c, int g) { return (unsigned char*)(p.out + O_YP) + (size_t)((b * NCHUNK + c) * 2 + g) * SS_UNIT; }
__device__ __forceinline__ bf16x8 frag_scale(const bf16x8& f, const float (&sc)[8]) { const u32x4 w = __builtin_bit_cast(u32x4, f); float a[8]; unpack_bf8(w, a);
#pragma unroll
    for (int e = 0; e < 8; ++e) a[e] *= sc[e];
    return __builtin_bit_cast(bf16x8, pack_bf8(a)); }
__device__ __forceinline__ void st_acc_bf4(unsigned char* dst, const f32x4& v) { u32x2 w; w.x = pg8::cvt_pk_bf16(v[0], v[1]); w.y = pg8::cvt_pk_bf16(v[2], v[3]); *(u32x2*)dst = w; }
__device__ __forceinline__ f32x4 ld_acc_bf4(const unsigned char* src) { const u32x2 w = *(const u32x2*)src; return (f32x4){__uint_as_float(w.x << 16), __uint_as_float(w.x & 0xffff0000u), __uint_as_float(w.y << 16), __uint_as_float(w.y & 0xffff0000u)}; }

struct RetLds { static constexpr int QS = 0, KS = QS + 64 * LDP * 2, KT = KS + 64 * LDP * 2, VT = KT + 64 * LDP * 2, VH = VT + 64 * LDP * 2, PS = VH + 64 * LDP * 2, END = PS + 64 * LDP * 2; };
__device__ void ret_pre_unit(const Params& p, int layer, int b, int c, int hu, LAS unsigned char* lds) {
    const int tid = opaque_tid(), wid = tid >> 6, lane = tid & 63, fq = lane >> 4, fc = lane & 15;
    LAS bf16_t* Qs = (LAS bf16_t*)(lds + RetLds::QS); LAS bf16_t* Ks = (LAS bf16_t*)(lds + RetLds::KS); LAS bf16_t* KT = (LAS bf16_t*)(lds + RetLds::KT);
    LAS bf16_t* VT = (LAS bf16_t*)(lds + RetLds::VT); LAS bf16_t* VH = (LAS bf16_t*)(lds + RetLds::VH); LAS bf16_t* Ps = (LAS bf16_t*)(lds + RetLds::PS);
    const bf16_t* proj = (const bf16_t*)(p.ws + WS_PROJ); const float* rot = (const float*)(p.ws + WS_ROT);
    const float lg2 = log2f(1.0f - exp2f(-5.0f - (float)hu));
    const int i0 = c == 0 ? 48 : 0, t0 = 64 * c - 48, nlast = 64 - i0;
    unsigned char* rec = rec_ret(p, b, c, hu);
    __syncthreads();
#pragma unroll
    for (int n_ = 0; n_ < 4; ++n_) { const int e = tid + 512 * n_; const int i = e >> 5, d = e & 31; float qa, qb, ka, kb;
        { const int tc = max(t0 + i, 0); const bf16_t* pr = proj + (size_t)(b * TP + tc) * NBIG; const float cs = rot[(tc * 32 + d) * 2], sn = rot[(tc * 32 + d) * 2 + 1];
            const float q1 = bf2f(pr[PC_DQ + hu * 64 + d]), q2 = bf2f(pr[PC_DQ + hu * 64 + 32 + d]), k1 = bf2f(pr[PC_DK + hu * 64 + d]), k2 = bf2f(pr[PC_DK + hu * 64 + 32 + d]);
            const float mk = i >= i0 ? 1.0f : 0.0f;
            qa = (q1 * cs - q2 * sn) * mk; qb = (q2 * cs + q1 * sn) * mk; ka = (k1 * cs - k2 * sn) * (0.125f * mk); kb = (k2 * cs + k1 * sn) * (0.125f * mk); }
        Qs[i * LDP + d] = f2bf(qa); Qs[i * LDP + 32 + d] = f2bf(qb); Ks[i * LDP + d] = f2bf(ka); Ks[i * LDP + 32 + d] = f2bf(kb);
        KT[d * LDP + i] = f2bf(ka); KT[(d + 32) * LDP + i] = f2bf(kb); }
#pragma unroll
    for (int n_ = 0; n_ < 8; ++n_) { const int e = tid + 512 * n_; const int i = e >> 6, d = e & 63;
        float v = bf2f(proj[(size_t)(b * TP + max(t0 + i, 0)) * NBIG + PC_DV + hu * 64 + d]); v = i >= i0 ? v : 0.f; const float vh = v * fexp2((float)(63 - i) * lg2);
        VT[d * LDP + i] = f2bf(v); VH[d * LDP + i] = f2bf(vh); }
    __syncthreads();
#pragma unroll
    for (int tt = 0; tt < 2; ++tt) { const int t = wid * 2 + tt, I = t >> 2, J = t & 3; f32x4 acc = (f32x4){0.f, 0.f, 0.f, 0.f};
        if (J <= I) {
#pragma unroll
            for (int s = 0; s < 2; ++s) acc = mfma16(frag_ld(Ks, LDP, 16 * J + fc, 32 * s + 8 * fq), frag_ld(Qs, LDP, 16 * I + fc, 32 * s + 8 * fq), acc); }
        const int i = 16 * I + fc;
#pragma unroll
        for (int r = 0; r < 4; ++r) { const int j = 16 * J + 4 * fq + r; acc[r] = (j <= i && j >= i0) ? acc[r] * fexp2((float)(i - j) * lg2) : 0.f; }
        st_bf4(Ps + i * LDP + 16 * J + 4 * fq, acc); }
    __syncthreads();
    { const int w = wid & 3; bf16x8 bb[2];
#pragma unroll
        for (int s = 0; s < 2; ++s) bb[s] = frag_ld(wid < 4 ? VT : VH, LDP, 16 * w + fc, 32 * s + 8 * fq);
        const LAS bf16_t* At = wid < 4 ? Ps : KT; unsigned char* dst = rec + (wid < 4 ? HR_OI : HR_DS);
#pragma unroll
        for (int m = 0; m < 4; ++m) { f32x4 acc = (f32x4){0.f, 0.f, 0.f, 0.f};
#pragma unroll
            for (int s = 0; s < 2; ++s) acc = mfma16(frag_ld(At, LDP, 16 * m + fc, 32 * s + 8 * fq), bb[s], acc);
            st_acc_bf4(dst + ((size_t)(w * 4 + m) * 64 + lane) * 8, acc); }
        { const float eg = fexp2((float)max(16 * (wid >> 1) + fc - i0 + 1, 0) * lg2); const float sc[8] = {eg, eg, eg, eg, eg, eg, eg, eg};
            *(bf16x8*)(rec + HR_QF + ((size_t)wid * 64 + lane) * 16) = frag_scale(frag_ld_perm(Qs, LDP, 16 * (wid >> 1) + fc, 32 * (wid & 1), fq), sc); }
        if (tid < 64) { float* gv = (float*)(rec + HR_VEC); gv[64 + tid] = fexp2((float)nlast * lg2); } }
}

struct HgLds { static constexpr int LS = 0  , KR = LS + 16384  , QR = KR + 16384  , QT = QR + 16384, QH = QT + 64 * LDP * 2, KT = QH + 64 * LDP * 2  ,
    KHT = KT + 160 * LDP * 2, VT = KHT + 64 * LDP * 2, PS = VT + 64 * LDP * 2, AV = PS + 64 * LDP * 2, END = AV + 256; };
__device__ void hgrn_pre_unit(const Params& p, int layer, int b, int c, int hu, LAS unsigned char* lds) {
    const int tid = opaque_tid(), wid = tid >> 6, lane = tid & 63, fq = lane >> 4, fc = lane & 15;
    LAS float* Ls = (LAS float*)(lds + HgLds::LS); LAS float* Kr = (LAS float*)(lds + HgLds::KR); LAS float* Qr = (LAS float*)(lds + HgLds::QR);
    LAS bf16_t* Qt = (LAS bf16_t*)(lds + HgLds::QT); LAS bf16_t* Qh = (LAS bf16_t*)(lds + HgLds::QH); LAS bf16_t* Kt = (LAS bf16_t*)(lds + HgLds::KT); LAS bf16_t* KhT = (LAS bf16_t*)(lds + HgLds::KHT);
    LAS bf16_t* VT = (LAS bf16_t*)(lds + HgLds::VT); LAS bf16_t* Ps = (LAS bf16_t*)(lds + HgLds::PS); LAS float* Av = (LAS float*)(lds + HgLds::AV);
    const bf16_t* proj = (const bf16_t*)(p.ws + WS_PROJ);
    const float lbv = ((const float*)(p.ws + WS_LB))[layer * 256 + hu * 64 + lane];
    const int i0 = c == 0 ? 48 : 0, t0 = 64 * c - 48;
    unsigned char* rec = rec_hgrn(p, b, c, hu);
    __syncthreads();
    if (wid < 4) { float acc = 0.f; float afr[16];
#pragma unroll
        for (int ii = 0; ii < 16; ++ii) { const int i = 16 * wid + ii; afr[ii] = bf2f(proj[(size_t)(b * TP + max(t0 + i, 0)) * NBIG + PC_AF + hu * 64 + lane]); }
#pragma unroll
        for (int ii = 0; ii < 16; ++ii) { const int i = 16 * wid + ii; float kk;
            { float af = afr[ii]; af = fminf(fmaxf(af, -30.f), 30.f);
                const float e = __expf(-af), sg = __builtin_amdgcn_rcpf(1.0f + e); const float f = lbv + (1.0f - lbv) * sg; const bool ok = i >= i0; kk = ok ? (1.0f - lbv) * e * sg : 0.f; acc += ok ? __log2f(fmaxf(f, 1e-30f)) : 0.f; }
            Ls[i * 64 + lane] = acc; Kr[i * 64 + lane] = kk; } }
    else {
#pragma unroll
        for (int n_ = 0; n_ < 16; ++n_) { const int e = tid - 256 + 256 * n_; const int i = e >> 6, d = e & 63;
            const bf16_t* pr = proj + (size_t)(b * TP + max(t0 + i, 0)) * NBIG; float q = silu_f(bf2f(pr[PC_AQ + hu * 64 + d])) * 0.125f, v = bf2f(pr[PC_AI + hu * 64 + d]); if (i < i0) { q = 0.f; v = 0.f; }
            Qr[i * 64 + d] = q; VT[d * LDP + i] = f2bf(v); } }
    __syncthreads();
#pragma unroll 2
    for (int n_ = 0; n_ < 8; ++n_) { const int e = tid + 512 * n_; const int i = e >> 6, d = e & 63, I = i >> 4;
        const float T0 = Ls[15 * 64 + d], T1 = Ls[31 * 64 + d], T2 = Ls[47 * 64 + d], T3 = Ls[63 * 64 + d];
        const float Bi = I == 0 ? 0.f : I == 1 ? T0 : I == 2 ? T0 + T1 : T0 + T1 + T2; const float Li = Ls[i * 64 + d], Gi = Bi + Li, Gl = T0 + T1 + T2 + T3;
        const float q = Qr[i * 64 + d], k = Kr[i * 64 + d];
        Qt[i * LDP + d] = f2bf(q * fexp2(Li)); Qh[i * LDP + d] = f2bf(q * fexp2(Gi)); KhT[d * LDP + i] = f2bf(k * fexp2(Gl - Gi));
        float Bp = Bi;
        Kt[((I == 0 ? 0 : I == 1 ? 16 : I == 2 ? 48 : 96) + i) * LDP + d] = f2bf(k * fexp2(Bp - Gi));
        if (I <= 0) { Bp = T0; Kt[(16 + i) * LDP + d] = f2bf(k * fexp2(Bp - Gi)); }
        if (I <= 1) { Bp = T0 + T1; Kt[(48 + i) * LDP + d] = f2bf(k * fexp2(Bp - Gi)); }
        if (I <= 2) { Bp = T0 + T1 + T2; Kt[(96 + i) * LDP + d] = f2bf(k * fexp2(Bp - Gi)); }
        if (i == 0) Av[d] = fexp2(Gl); }
    __syncthreads();
#pragma unroll
    for (int tt = 0; tt < 2; ++tt) { const int t = wid * 2 + tt, I = t >> 2, J = t & 3; f32x4 acc = (f32x4){0.f, 0.f, 0.f, 0.f};
        if (J <= I) { const int kb = (I == 0 ? 0 : I == 1 ? 16 : I == 2 ? 48 : 96) + 16 * J;
#pragma unroll
            for (int s = 0; s < 2; ++s) acc = mfma16(frag_ld(Kt, LDP, kb + fc, 32 * s + 8 * fq), frag_ld(Qt, LDP, 16 * I + fc, 32 * s + 8 * fq), acc); }
        const int i = 16 * I + fc;
#pragma unroll
        for (int r = 0; r < 4; ++r) { const int j = 16 * J + 4 * fq + r; acc[r] = (j <= i) ? acc[r] : 0.f; }
        st_bf4(Ps + i * LDP + 16 * J + 4 * fq, acc); }
    __syncthreads();
    { const int w = wid & 3; bf16x8 bb[2];
#pragma unroll
        for (int s = 0; s < 2; ++s) bb[s] = frag_ld(VT, LDP, 16 * w + fc, 32 * s + 8 * fq);
        const LAS bf16_t* At = wid < 4 ? Ps : KhT; unsigned char* dst = rec + (wid < 4 ? HR_OI : HR_DS);
#pragma unroll
        for (int m = 0; m < 4; ++m) { f32x4 acc = (f32x4){0.f, 0.f, 0.f, 0.f};
#pragma unroll
            for (int s = 0; s < 2; ++s) acc = mfma16(frag_ld(At, LDP, 16 * m + fc, 32 * s + 8 * fq), bb[s], acc);
            st_acc_bf4(dst + ((size_t)(w * 4 + m) * 64 + lane) * 8, acc); }
        *(bf16x8*)(rec + HR_QF + ((size_t)wid * 64 + lane) * 16) = frag_ld_perm(Qh, LDP, 16 * (wid >> 1) + fc, 32 * (wid & 1), fq);
        if (tid < 64) { float* gv = (float*)(rec + HR_VEC); gv[64 + tid] = Av[tid]; } }
}

struct SsdLds { static constexpr int CS = 0, BS = CS + 64 * LDP2 * 2, BT = BS + 64 * LDP2 * 2, XS = BT + 128 * LDP * 2, VT = XS + 64 * LDP2 * 2  , VH = VT + 2 * 64 * LDP * 2, PS = VH + 2 * 64 * LDP * 2  ,
    DT = PS + 67 * 384 * 2  , GV = DT + 512, END = GV + 512; };
constexpr int SSD_NPIECE = 67 * 48;
__device__ void ssd_pre_unit(const Params& p, int layer, int b, int c, int gg, LAS unsigned char* lds) {
    const int tid = opaque_tid(), wid = tid >> 6, lane = tid & 63, fq = lane >> 4, fc = lane & 15;
    LAS bf16_t* Cs = (LAS bf16_t*)(lds + SsdLds::CS); LAS bf16_t* Bs = (LAS bf16_t*)(lds + SsdLds::BS); LAS bf16_t* BT = (LAS bf16_t*)(lds + SsdLds::BT); LAS bf16_t* Xs = (LAS bf16_t*)(lds + SsdLds::XS);
    LAS bf16_t* VT = (LAS bf16_t*)(lds + SsdLds::VT); LAS bf16_t* VH = (LAS bf16_t*)(lds + SsdLds::VH); LAS bf16_t* Ps = (LAS bf16_t*)(lds + SsdLds::PS); LAS bf16_t* RawT = Ps;
    LAS float* DTv = (LAS float*)(lds + SsdLds::DT); LAS float* Gv = (LAS float*)(lds + SsdLds::GV);
    const bf16_t* projb = (const bf16_t*)(p.ws + WS_PROJ) + (size_t)(b * TP) * NBIG; const float* psmb = (const float*)(p.ws + WS_PSM) + (size_t)(b * TP) * NSM;
    const float* cw = p.ssd_conv_w + (size_t)layer * 4 * 768; const float* cb = p.ssd_conv_b + (size_t)layer * 768;
    constexpr float L2E = 1.4426950408889634f;
    const int hh = wid >> 2, ws = wid & 3;
    const int i0 = c == 0 ? 48 : 0, t0 = 64 * c - 48;
    unsigned char* rec = rec_ssd(p, b, c, gg);
    u32x4 raw[7];
#pragma unroll
    for (int k = 0; k < 7; ++k) { const int id = min(tid + 512 * k, SSD_NPIECE - 1), row = id / 48, seg = id % 48, t = t0 - 3 + row;
        const u32x4 v = *(const u32x4*)(projb + (size_t)max(t, 0) * NBIG + PC_CXBC + (seg >> 4) * 256 + gg * 128 + (seg & 15) * 8);
        raw[k] = t >= 0 ? v : (u32x4){0u, 0u, 0u, 0u}; }
    const float psmv = psmb[(size_t)max(t0 + lane, 0) * NSM + 8 + gg * 2 + (wid & 1)];
    __syncthreads();
    if (wid < 2) { const int hd = gg * 2 + wid;
        float dt = softplus_f(psmv + p.ssd_dt_bias[layer * 4 + hd]); dt = lane >= i0 ? dt : 0.f;
        float G = -dt * __expf(p.ssd_a_log[layer * 4 + hd]) * L2E;
#pragma unroll
        for (int o = 1; o < 64; o <<= 1) { const float t = lane_up(G, o, lane); if (lane >= o) G += t; }
        DTv[wid * 64 + lane] = dt; Gv[wid * 64 + lane] = G; }
#pragma unroll
    for (int k = 0; k < 7; ++k) { const int id = tid + 512 * k; if (id < SSD_NPIECE) *(LAS u32x4*)(RawT + (id / 48) * 384 + (id % 48) * 8) = raw[k]; }
    __syncthreads();
#pragma unroll 1
    for (int n = 0; n < 3; ++n) { const int e = tid + 512 * n, ch = e % 384, tr = e / 384, part = ch >> 7, j = ch & 127, chf = part * 256 + gg * 128 + j;
        const float w0 = cw[chf], w1 = cw[768 + chf], w2 = cw[2 * 768 + chf], w3 = cw[3 * 768 + chf], bias = cb[chf];
#pragma unroll
        for (int hf = 0; hf < 2; ++hf) { const int ib = 16 * tr + 8 * hf; float a[8], rw[11];
#pragma unroll
            for (int ii = 0; ii < 11; ++ii) rw[ii] = bf2f(RawT[(ib + ii) * 384 + ch]);
#pragma unroll
            for (int ii = 0; ii < 8; ++ii) { a[ii] = silu_f(bias + w0 * rw[ii] + w1 * rw[ii + 1] + w2 * rw[ii + 2] + w3 * rw[ii + 3]); if (ib + ii < i0) a[ii] = 0.f; }
            if (part == 0) { const int h2 = j >> 6, d = j & 63; const float gl = Gv[h2 * 64 + 63]; float xh[8];
#pragma unroll
                for (int ii = 0; ii < 8; ++ii) { const int i = ib + ii; Xs[i * LDP2 + j] = f2bf(a[ii]); a[ii] *= DTv[h2 * 64 + i]; xh[ii] = a[ii] * fexp2(gl - Gv[h2 * 64 + i]); }
                *(LAS u32x4*)(VT + (h2 * 64 + d) * LDP + ib) = pack_bf8(a); *(LAS u32x4*)(VH + (h2 * 64 + d) * LDP + ib) = pack_bf8(xh); }
            else if (part == 1) {
#pragma unroll
                for (int ii = 0; ii < 8; ++ii) Bs[(ib + ii) * LDP2 + j] = f2bf(a[ii]);
                *(LAS u32x4*)(BT + j * LDP + ib) = pack_bf8(a); }
            else {
#pragma unroll
                for (int ii = 0; ii < 8; ++ii) Cs[(ib + ii) * LDP2 + j] = f2bf(a[ii]); } } }
    __syncthreads();
#pragma unroll
    for (int tt = 0; tt < 2; ++tt) { const int t = wid * 2 + tt, I = t >> 2, J = t & 3; f32x4 acc = (f32x4){0.f, 0.f, 0.f, 0.f};
        if (J <= I) {
#pragma unroll
            for (int s = 0; s < 4; ++s) acc = mfma16(frag_ld(Bs, LDP2, 16 * J + fc, 32 * s + 8 * fq), frag_ld(Cs, LDP2, 16 * I + fc, 32 * s + 8 * fq), acc); }
        const int i = 16 * I + fc;
#pragma unroll
        for (int h2 = 0; h2 < 2; ++h2) { f32x4 pv; const float gi = Gv[h2 * 64 + i];
#pragma unroll
            for (int r = 0; r < 4; ++r) { const int j = 16 * J + 4 * fq + r; pv[r] = (j <= i && j >= i0) ? acc[r] * fexp2(gi - Gv[h2 * 64 + j]) : 0.f; }
            st_bf4(Ps + (h2 * 64 + i) * LDP + 16 * J + 4 * fq, pv); } }
    __syncthreads();
    { bf16x8 bv[2], bh[2]; unsigned char* hrec = rec + SS_HEAD + (size_t)hh * 24576; const float dsk = p.ssd_d[layer * 4 + gg * 2 + hh];
#pragma unroll
        for (int s = 0; s < 2; ++s) { bv[s] = frag_ld(VT, LDP, hh * 64 + 16 * ws + fc, 32 * s + 8 * fq); bh[s] = frag_ld(VH, LDP, hh * 64 + 16 * ws + fc, 32 * s + 8 * fq); }
#pragma unroll
        for (int mi = 0; mi < 4; ++mi) { f32x4 o1 = (f32x4){0.f, 0.f, 0.f, 0.f};
#pragma unroll
            for (int s = 0; s < 2; ++s) o1 = mfma16(frag_ld(Ps, LDP, hh * 64 + 16 * mi + fc, 32 * s + 8 * fq), bv[s], o1);
#pragma unroll
            for (int r = 0; r < 4; ++r) o1[r] += dsk * bf2f(Xs[(16 * mi + 4 * fq + r) * LDP2 + hh * 64 + 16 * ws + fc]);
            st_acc_bf4(hrec + ((size_t)(ws * 4 + mi) * 64 + lane) * 8, o1); }
#pragma unroll
        for (int m = 0; m < 8; ++m) { f32x4 d = (f32x4){0.f, 0.f, 0.f, 0.f};
#pragma unroll
            for (int s = 0; s < 2; ++s) d = mfma16(frag_ld(BT, LDP, 16 * m + fc, 32 * s + 8 * fq), bh[s], d);
            st_acc_bf4(hrec + 8192 + ((size_t)(ws * 8 + m) * 64 + lane) * 8, d); }
#pragma unroll
        for (int x = 0; x < 2; ++x) { const int sl = wid * 2 + x; *(bf16x8*)(rec + SS_QF + ((size_t)sl * 64 + lane) * 16) = frag_ld_perm(Cs, LDP2, 16 * (sl >> 2) + fc, 32 * (sl & 3), fq); }
        if (tid < 128) { float* gv = (float*)(rec + SS_VEC + (size_t)(tid >> 6) * 512); gv[tid & 63] = fexp2(Gv[tid]); if ((tid & 63) == 0) gv[64] = fexp2(Gv[(tid >> 6) * 64 + 63]); } }
}

struct GdLds { static constexpr int QF = 0, KF = 16384, VF = 32768, QN = 49152, KN = QN + 64 * LDP * 2, KNT = KN + 64 * LDP * 2, NM = KNT + 64 * LDP * 2, QK = NM + 64 * LDP * 2, WT = QK + 64 * LDP * 2,
    MD = WT + 64 * LDP * 2  , TD = MD + 4096  , GV = TD + 2048, BV = GV + 256, END = BV + 256; };
__device__ void gdn_pre_unit(const Params& p, int layer, int b, int c, int hu, LAS unsigned char* lds) {
    const int tid = opaque_tid(), wid = tid >> 6, lane = tid & 63, fq = lane >> 4, fc = lane & 15;
    LAS float* Qf = (LAS float*)(lds + GdLds::QF); LAS float* Kf = (LAS float*)(lds + GdLds::KF); LAS float* Vf = (LAS float*)(lds + GdLds::VF);
    LAS bf16_t* Qn = (LAS bf16_t*)(lds + GdLds::QN); LAS bf16_t* Kn = (LAS bf16_t*)(lds + GdLds::KN); LAS bf16_t* KnT = (LAS bf16_t*)(lds + GdLds::KNT);
    LAS bf16_t* NM = (LAS bf16_t*)(lds + GdLds::NM); LAS bf16_t* QK = (LAS bf16_t*)(lds + GdLds::QK); LAS bf16_t* Wt = (LAS bf16_t*)(lds + GdLds::WT);
    LAS float* MD = (LAS float*)(lds + GdLds::MD); LAS bf16_t* TD = (LAS bf16_t*)(lds + GdLds::TD); LAS float* Gv = (LAS float*)(lds + GdLds::GV); LAS float* Bv = (LAS float*)(lds + GdLds::BV);
    const bf16_t* proj = (const bf16_t*)(p.ws + WS_PROJ); const float* psm = (const float*)(p.ws + WS_PSM);
    const float* cw = p.gdn_conv_w + (size_t)layer * 4 * 768;
    unsigned char* gd = rec_gdn(p, b, c, hu);
    constexpr float L2E = 1.4426950408889634f;
    const int i0 = c == 0 ? 48 : 0, t0 = 64 * c - 48;
    __syncthreads();
    if (wid == 0) { const float* ps = psm + (size_t)(b * TP + max(t0 + lane, 0)) * NSM;
        float g = -__expf(p.gdn_a_log[layer * 4 + hu]) * softplus_f(ps[hu] + p.gdn_dt_bias[layer * 4 + hu]) * L2E, be = sigmoid_f(ps[4 + hu]); if (lane < i0) { g = 0.f; be = 0.f; }
#pragma unroll
        for (int o = 1; o < 64; o <<= 1) { const float t = lane_up(g, o, lane); if (lane >= o) g += t; }
        Gv[lane] = g; Bv[lane] = be; }
#pragma unroll
    for (int n_ = 0; n_ < 3; ++n_) { const int e = tid + 512 * n_; const int ch = e % 192, tr = e / 192, part = ch >> 6, d = ch & 63, chf = part * 256 + hu * 64 + d;
        const bf16_t* col = proj + (size_t)(b * TP) * NBIG + PC_BQKV + chf;
        const float w0 = cw[chf], w1 = cw[768 + chf], w2 = cw[2 * 768 + chf], w3 = cw[3 * 768 + chf];
        const int ts = t0 + 8 * tr;
        float raw[11];
#pragma unroll
        for (int ii = 0; ii < 11; ++ii) { const int t = ts - 3 + ii; const float v = bf2f(col[(size_t)max(t, 0) * NBIG]); raw[ii] = t >= 0 ? v : 0.f; }
        LAS float* dst = part == 0 ? Qf : part == 1 ? Kf : Vf;
#pragma unroll
        for (int ii = 0; ii < 8; ++ii) { const int i = 8 * tr + ii;
            float a = silu_f(w0 * raw[ii] + w1 * raw[ii + 1] + w2 * raw[ii + 2] + w3 * raw[ii + 3]); if (i < i0) a = 0.f;
            dst[i * 64 + d] = a; } }
    __syncthreads();
    { const int ri = tid >> 3, sg = tid & 7; float q[8], k[8], sq = 0.f, sk = 0.f;
#pragma unroll
        for (int x = 0; x < 8; ++x) { q[x] = Qf[ri * 64 + sg * 8 + x]; k[x] = Kf[ri * 64 + sg * 8 + x]; sq += q[x] * q[x]; sk += k[x] * k[x]; }
        sq += lane_xor(sq, 1, lane); sq += lane_xor(sq, 2, lane); sq += lane_xor(sq, 4, lane); sk += lane_xor(sk, 1, lane); sk += lane_xor(sk, 2, lane); sk += lane_xor(sk, 4, lane);
        const float rq = rsqrtf(sq + EPSF) * 0.125f, rk = rsqrtf(sk + EPSF);
#pragma unroll
        for (int x = 0; x < 8; ++x) { q[x] *= rq; k[x] *= rk; Kf[ri * 64 + sg * 8 + x] = k[x]; KnT[(sg * 8 + x) * LDP + ri] = f2bf(k[x]); }
        *(LAS u32x4*)(Qn + ri * LDP + sg * 8) = pack_bf8(q); *(LAS u32x4*)(Kn + ri * LDP + sg * 8) = pack_bf8(k); }
    __syncthreads();
#pragma unroll
    for (int tt = 0; tt < 2; ++tt) { const int t = wid * 2 + tt, I = t >> 2, J = t & 3; f32x4 a1 = (f32x4){0.f, 0.f, 0.f, 0.f}, a2 = (f32x4){0.f, 0.f, 0.f, 0.f};
        if (J <= I) {
#pragma unroll
            for (int s = 0; s < 2; ++s) { const bf16x8 kj = frag_ld(Kn, LDP, 16 * J + fc, 32 * s + 8 * fq); a1 = mfma16(kj, frag_ld(Kn, LDP, 16 * I + fc, 32 * s + 8 * fq), a1); a2 = mfma16(kj, frag_ld(Qn, LDP, 16 * I + fc, 32 * s + 8 * fq), a2); } }
        const int i = 16 * I + fc; const float gi = Gv[i], bi = Bv[i]; f32x4 nm, qk;
#pragma unroll
        for (int r = 0; r < 4; ++r) { const int j = 16 * J + 4 * fq + r; const float dec = j <= i ? fexp2(gi - Gv[j]) : 0.f; const float mm = j < i ? a1[r] * dec * bi : 0.f; nm[r] = -mm; qk[r] = a2[r] * dec;
            if (J == I) MD[(I * 16 + fc) * 16 + 4 * fq + r] = mm; }
        st_bf4(NM + i * LDP + 16 * J + 4 * fq, nm); st_bf4(QK + i * LDP + 16 * J + 4 * fq, qk); }
    __syncthreads();
    if (wid == 0) { const int I = fq, cc = fc; float x[16];
#pragma unroll
        for (int i = 0; i < 16; ++i) { float acc = (i == cc) ? 1.0f : 0.0f;
#pragma unroll
            for (int j = 0; j < i; ++j) acc -= MD[(I * 16 + i) * 16 + j] * x[j];
            x[i] = acc; TD[(I * 16 + i) * 16 + cc] = f2bf(acc); } }
    __syncthreads();
    const int isW = wid >> 2, ws = wid & 3, colx = 16 * ws + fc;
    const LAS float* rhs = isW ? Kf : Vf;
    f32x4 X[4];
    const f32x4 zero4 = (f32x4){0.f, 0.f, 0.f, 0.f};
#pragma unroll
    for (int I = 0; I < 4; ++I) { f32x4 acc;
#pragma unroll
        for (int r = 0; r < 4; ++r) { const int j = 16 * I + 4 * fq + r; const float sc = Bv[j] * (isW ? fexp2(Gv[j]) : 1.0f); acc[r] = sc * rhs[j * 64 + colx]; }
        if (I >= 1) acc = mfma16(frag_ld_perm(NM, LDP, 16 * I + fc, 0, fq), pack_acc2(X[0], I > 1 ? X[1] : zero4), acc);
        if (I == 3) acc = mfma16(frag_ld_perm(NM, LDP, 48 + fc, 32, fq), pack_acc2(X[2], zero4), acc);
        const bf16x4 tlo = *(const LAS bf16x4*)(TD + (I * 16 + fc) * 16 + 4 * fq); const bf16x4 z4 = (bf16x4){0, 0, 0, 0};
        X[I] = mfma16(__builtin_shufflevector(tlo, z4, 0, 1, 2, 3, 4, 5, 6, 7), pack_acc2(acc, zero4), zero4); }
    if (!isW) {
#pragma unroll
        for (int m = 0; m < 4; ++m) st_acc_bf4(gd + GD_U + ((size_t)(ws * 4 + m) * 64 + lane) * 8, X[m]); }
    else {
#pragma unroll
        for (int m = 0; m < 4; ++m)
#pragma unroll
            for (int r = 0; r < 4; ++r) Wt[(16 * m + 4 * fq + r) * LDP + colx] = f2bf(-X[m][r]); }
    __syncthreads();
    { const int tsel = wid >> 1; const LAS bf16_t* tile = tsel == 0 ? Wt : tsel == 1 ? Qn : tsel == 2 ? QK : KnT; unsigned char* dst = gd + (tsel == 0 ? GD_W : tsel == 1 ? GD_Q : tsel == 2 ? GD_P : GD_K);
#pragma unroll
        for (int x = 0; x < 4; ++x) { const int sl = (wid & 1) * 4 + x, m = sl >> 1, s = sl & 1; bf16x8 f = frag_ld_perm(tile, LDP, 16 * m + fc, 32 * s, fq);
            if (tsel == 1) { const float eg = fexp2(Gv[16 * m + fc]); const float sc[8] = {eg, eg, eg, eg, eg, eg, eg, eg}; f = frag_scale(f, sc); }
            if (tsel == 3) { float sc[8];
#pragma unroll
                for (int e = 0; e < 8; ++e) sc[e] = fexp2(Gv[63] - Gv[32 * s + 16 * (e >> 2) + 4 * fq + (e & 3)]);
                f = frag_scale(f, sc); }
            *(bf16x8*)(dst + ((size_t)sl * 64 + lane) * 16) = f; } }
    if (tid == 0) { float* gv = (float*)(gd + GD_VEC); gv[128] = fexp2(Gv[63]); }
}

template <int MIX> struct SeqRegs {
    static constexpr int DK = MIX == 2 ? 128 : 64, NT = DK / 16, NS = DK / 32;
    bf16x8 qf[4 * NS]; u32x2 oi[4]; u32x2 ds[NT]; f32x4 eg[MIX == 2 ? 4 : 1]; f32x4 al[MIX == 0 ? 4 : 1];
    __device__ __forceinline__ void load(const Params& p, int b, int c, int hp, int hsel, int hd, int ws, int lane, int fq) {
        const unsigned char* base = MIX == 2 ? rec_ssd(p, b, c, hp) : MIX == 0 ? rec_hgrn(p, b, c, hd) : rec_ret(p, b, c, hd);
        const unsigned char* q = base + (MIX == 2 ? SS_QF : HR_QF); const unsigned char* o = MIX == 2 ? base + SS_HEAD + (size_t)hsel * 24576 : base + HR_OI;
        const unsigned char* d = MIX == 2 ? o + 8192 : base + HR_DS; const float* gv = (const float*)(MIX == 2 ? base + SS_VEC + (size_t)hsel * 512 : base + HR_VEC);
#pragma unroll
        for (int x = 0; x < 4 * NS; ++x) qf[x] = *(const bf16x8*)(q + ((size_t)x * 64 + lane) * 16);
#pragma unroll
        for (int mi = 0; mi < 4; ++mi) { oi[mi] = *(const u32x2*)(o + ((size_t)(ws * 4 + mi) * 64 + lane) * 8); if (MIX == 2) eg[mi] = *(const f32x4*)(gv + 16 * mi + 4 * fq); }
#pragma unroll
        for (int m = 0; m < NT; ++m) ds[m] = *(const u32x2*)(d + ((size_t)(ws * NT + m) * 64 + lane) * 8);
#pragma unroll
        for (int m = 0; m < (MIX == 0 ? 4 : 1); ++m) al[m] = MIX == 0 ? *(const f32x4*)(gv + 64 + 16 * m + 4 * fq) : (f32x4){gv[64], 0.f, 0.f, 0.f};
    }
};
__device__ __forceinline__ f32x4 unpack_acc(const u32x2& w) { return (f32x4){__uint_as_float(w.x << 16), __uint_as_float(w.x & 0xffff0000u), __uint_as_float(w.y << 16), __uint_as_float(w.y & 0xffff0000u)}; }
struct GdRegs { bf16x8 w[8], pq[8], qq[8], kk[8]; u32x2 u0[4]; float al;
    __device__ __forceinline__ void load_a(const unsigned char* gd, int ws, int lane) {
#pragma unroll
        for (int x = 0; x < 8; ++x) w[x] = *(const bf16x8*)(gd + GD_W + ((size_t)x * 64 + lane) * 16);
#pragma unroll
        for (int m = 0; m < 4; ++m) u0[m] = *(const u32x2*)(gd + GD_U + ((size_t)(ws * 4 + m) * 64 + lane) * 8); }
    __device__ __forceinline__ void load_b(const unsigned char* gd, int lane, int fq) {
        const float* gv = (const float*)(gd + GD_VEC);
#pragma unroll
        for (int x = 0; x < 8; ++x) { pq[x] = *(const bf16x8*)(gd + GD_P + ((size_t)x * 64 + lane) * 16); qq[x] = *(const bf16x8*)(gd + GD_Q + ((size_t)x * 64 + lane) * 16); }
        al = gv[128]; }
    __device__ __forceinline__ void load_k(const unsigned char* gd, int lane) {
#pragma unroll
        for (int x = 0; x < 8; ++x) kk[x] = *(const bf16x8*)(gd + GD_K + ((size_t)x * 64 + lane) * 16); }
};
template <int MIX>
__device__ void seq_item(const Params& p, int layer, int b_in, int hp_in, LAS unsigned char* lds) {
    constexpr int DK = MIX == 2 ? 128 : 64, NT = DK / 16, NS = DK / 32;
    const int b = __builtin_amdgcn_readfirstlane(b_in), hp = __builtin_amdgcn_readfirstlane(hp_in);
    const int tid = opaque_tid(), wid = tid >> 6, lane = tid & 63, fq = lane >> 4, fc = lane & 15;
    const int hsel = wid >> 2, hd = hp * 2 + hsel, ws = wid & 3;
    LAS float* Os = (LAS float*)lds;
    const bf16_t* projb = (const bf16_t*)(p.ws + WS_PROJ) + (size_t)(b * TP) * NBIG; bf16_t* yb = (bf16_t*)(p.ws + WS_Y) + (size_t)(b * TP) * DM;
    f32x4 S[NT];
#pragma unroll
    for (int m = 0; m < NT; ++m) S[m] = (f32x4){0.f, 0.f, 0.f, 0.f};
    const f32x4 zero4 = (f32x4){0.f, 0.f, 0.f, 0.f};
    LAS float* NW = Os + 4 * 64 * OSP;
    if (tid < 128) { const int cc = hp * 128 + tid; NW[tid] = (MIX == 0 ? p.hgrn_norm_w : MIX == 1 ? p.gdn_norm_w : MIX == 2 ? p.ssd_norm_w : p.ret_norm_w)[layer * 256 + cc]; if (MIX == 3) NW[128 + tid] = p.ret_norm_b[layer * 256 + cc]; }
    SeqRegs<MIX == 1 ? 0 : MIX> R; GdRegs G;
    if (MIX == 1) { const unsigned char* g0 = rec_gdn(p, b, 0, hd); G.load_a(g0, ws, lane); G.load_b(g0, lane, fq); G.load_k(g0, lane); } else R.load(p, b, 0, hp, hsel, hd, ws, lane, fq);
    __syncthreads();
    for (int c = 0; c < NCHUNK; ++c) {
        const int i0 = c == 0 ? 48 : 0, t0 = 64 * c - 48, cn = min(c + 1, NCHUNK - 1);
        LAS float* Ob = Os + ((c & 1) * 2 + hsel) * 64 * OSP;
        const int zri = MIX == 2 ? tid >> 3 : (tid & 255) >> 2, zsg = MIX == 2 ? tid & 7 : tid & 3;
        const bf16_t* zp = projb + (size_t)max(t0 + zri, 0) * NBIG + (MIX == 0 ? PC_AZ : MIX == 1 ? PC_BZ : MIX == 2 ? PC_CZ : PC_DZ) + (MIX == 2 ? hp * 128 : hd * 64) + zsg * 16;
        const u32x4 zr0 = *(const u32x4*)zp, zr1 = *(const u32x4*)(zp + 8);
        bf16x8 Sb[NS];
#pragma unroll
        for (int s = 0; s < NS; ++s) Sb[s] = pack_acc2(S[2 * s], S[2 * s + 1]);
        if (MIX == 1) {
            const unsigned char* gn = rec_gdn(p, b, cn, hd);
            bf16x8 ub[2]; f32x4 u[4];
#pragma unroll
            for (int m = 0; m < 4; ++m) { u[m] = unpack_acc(G.u0[m]);
#pragma unroll
                for (int s = 0; s < 2; ++s) u[m] = mfma16(G.w[m * 2 + s], Sb[s], u[m]); }
            G.load_a(gn, ws, lane);
#pragma unroll
            for (int s = 0; s < 2; ++s) ub[s] = pack_acc2(u[2 * s], u[2 * s + 1]);
#pragma unroll
            for (int mi = 0; mi < 4; ++mi) { f32x4 o1 = zero4, o2 = zero4;
#pragma unroll
                for (int s = 0; s < 2; ++s) { o1 = mfma16(G.pq[mi * 2 + s], ub[s], o1); o2 = mfma16(G.qq[mi * 2 + s], Sb[s], o2); }
#pragma unroll
                for (int r = 0; r < 4; ++r) Ob[(16 * mi + 4 * fq + r) * OSP + 16 * ws + fc] = o1[r] + o2[r]; }
            const float al = G.al; G.load_b(gn, lane, fq);
#pragma unroll
            for (int m = 0; m < 4; ++m) { S[m] = S[m] * al;
#pragma unroll
                for (int s = 0; s < 2; ++s) S[m] = mfma16(G.kk[m * 2 + s], ub[s], S[m]); }
            G.load_k(gn, lane);
        } else {
#pragma unroll
            for (int mi = 0; mi < 4; ++mi) { f32x4 o2 = zero4;
#pragma unroll
                for (int s = 0; s < NS; ++s) o2 = mfma16(R.qf[mi * NS + s], Sb[s], o2);
                const f32x4 o1 = unpack_acc(R.oi[mi]);
#pragma unroll
                for (int r = 0; r < 4; ++r) Ob[(16 * mi + 4 * fq + r) * OSP + 16 * ws + fc] = o1[r] + (MIX == 2 ? R.eg[MIX == 2 ? mi : 0][r] : 1.0f) * o2[r]; }
#pragma unroll
            for (int m = 0; m < NT; ++m) { const f32x4 d = unpack_acc(R.ds[m]);
#pragma unroll
                for (int r = 0; r < 4; ++r) S[m][r] = (MIX == 0 ? R.al[MIX == 0 ? (m & 3) : 0][r] : R.al[0][0]) * S[m][r] + d[r]; }
            R.load(p, b, cn, hp, hsel, hd, ws, lane, fq);
        }
        if (MIX == 2) {
            const int ri = tid >> 3, sg = tid & 7;
            __syncthreads();
            float o[16], z[16]; unpack_bf8(zr0, z); unpack_bf8(zr1, z + 8); float q = 0.f; const LAS float* Oh = Os + ((c & 1) * 2 + (sg >> 2)) * 64 * OSP + ri * OSP + (sg & 3) * 16;
#pragma unroll
            for (int k4 = 0; k4 < 4; ++k4) { const f32x4 v = *(const LAS f32x4*)(Oh + 4 * k4); o[4 * k4] = v[0]; o[4 * k4 + 1] = v[1]; o[4 * k4 + 2] = v[2]; o[4 * k4 + 3] = v[3]; }
#pragma unroll
            for (int k = 0; k < 16; ++k) { o[k] *= silu_f(z[k]); q += o[k] * o[k]; }
            q += lane_xor(q, 1, lane); q += lane_xor(q, 2, lane); q += lane_xor(q, 4, lane);
            const float rstd = rsqrtf(q * (1.0f / 128.0f) + EPSF); const LAS float* nw = NW + sg * 16;
#pragma unroll
            for (int k = 0; k < 16; ++k) o[k] *= rstd * nw[k];
            if (ri >= i0) { u32x4* yp = (u32x4*)(yb + (size_t)(t0 + ri) * DM + 512 + hp * 128 + sg * 16); yp[0] = pack_bf8(o); yp[1] = pack_bf8(o + 8); }
        } else {
            const int ri = (tid & 255) >> 2, sg = tid & 3;
            constexpr int YC = MIX == 0 ? 0 : MIX == 1 ? 256 : 768;
            __syncthreads();
            float o[16], z[16]; unpack_bf8(zr0, z); unpack_bf8(zr1, z + 8);
#pragma unroll
            for (int k4 = 0; k4 < 4; ++k4) { const f32x4 v = *(const LAS f32x4*)(Ob + ri * OSP + sg * 16 + 4 * k4); o[4 * k4] = v[0]; o[4 * k4 + 1] = v[1]; o[4 * k4 + 2] = v[2]; o[4 * k4 + 3] = v[3]; }
            const LAS float* nw = NW + hsel * 64 + sg * 16;
            if (MIX == 3) { float s = 0.f;
#pragma unroll
                for (int k = 0; k < 16; ++k) s += o[k];
                s += lane_xor(s, 1, lane); s += lane_xor(s, 2, lane); const float mu = s * (1.0f / 64.0f); float q = 0.f;
#pragma unroll
                for (int k = 0; k < 16; ++k) { o[k] -= mu; q += o[k] * o[k]; }
                q += lane_xor(q, 1, lane); q += lane_xor(q, 2, lane); const float rstd = rsqrtf(q * (1.0f / 64.0f) + EPSF); const LAS float* nb = NW + 128 + hsel * 64 + sg * 16;
#pragma unroll
                for (int k = 0; k < 16; ++k) o[k] = (o[k] * rstd * nw[k] + nb[k]) * silu_f(z[k]);
            } else { float q = 0.f;
#pragma unroll
                for (int k = 0; k < 16; ++k) q += o[k] * o[k];
                q += lane_xor(q, 1, lane); q += lane_xor(q, 2, lane); const float rstd = rsqrtf(q * (1.0f / 64.0f) + EPSF);
#pragma unroll
                for (int k = 0; k < 16; ++k) o[k] = o[k] * rstd * nw[k] * silu_f(z[k]); }
            if (ri >= i0) { u32x4* yp = (u32x4*)(yb + (size_t)(t0 + ri) * DM + YC + hd * 64 + sg * 16); yp[0] = pack_bf8(o); yp[1] = pack_bf8(o + 8); }
        }
    }
    { float* so = p.out + (MIX == 0 ? O_HGRN_P : MIX == 1 ? O_GDN_P : MIX == 2 ? O_SSD_P : O_RET_P) + (((size_t)layer * NB + b) * 4 + hd) * (DK * 64);
#pragma unroll
        for (int m = 0; m < NT; ++m)
#pragma unroll
            for (int r = 0; r < 4; ++r) so[(16 * m + 4 * fq + r) * 64 + 16 * ws + fc] = S[m][r]; }
    if (MIX == 1 || MIX == 2) { float* co = p.out + (MIX == 1 ? O_GCONV_P : O_SCONV_P) + ((size_t)layer * NB + b) * 3 * 768;
        for (int e = tid; e < 3 * 384; e += 512) { const int r = e / 384, ch = e % 384, chf = (ch >> 7) * 256 + hp * 128 + (ch & 127);
            co[r * 768 + chf] = bf2f(projb[(size_t)(TP - 3 + r) * NBIG + (MIX == 1 ? PC_BQKV : PC_CXBC) + chf]); } }
}

constexpr int N_MU = 14;
__device__ void ph_pre(const Params& p_in, int layer, LAS unsigned char* lds_in, int blk, int nblk) {
    Params p = p_in; asm volatile("" : "+s"(p.ws), "+s"(p.out));
    LAS unsigned char* lds = lds_in; asm volatile("" : "+s"(lds));
    convert_weights(p, layer + 1 < DEPTH ? layer + 1 : -1, layer, (LAS float*)lds, opaque_tid(), blk, nblk);
    for (int u = blk; u < NB * NCHUNK * 14; u += nblk) { const int t = u / 7, k = u % 7, v = t * 2 + (k & 1), b4 = v / (NCHUNK * 4), c4 = (v >> 2) % NCHUNK, h4 = v & 3;
#ifndef REP_U0
#define REP_U0 1
#define REP_U1 1
#define REP_U2 1
#define REP_U3 1
#endif
        for (int rep = 0; rep < (k < 2 ? REP_U0 : k < 4 ? REP_U1 : k < 6 ? REP_U2 : REP_U3); ++rep)
        if (k < 2) hgrn_pre_unit(p, layer, b4, c4, h4, lds);
        else if (k < 4) ret_pre_unit(p, layer, b4, c4, h4, lds);
        else if (k < 6) gdn_pre_unit(p, layer, b4, c4, h4, lds);
        else ssd_pre_unit(p, layer, t / (NCHUNK * 2), (t >> 1) % NCHUNK, t & 1, lds); }
}
__device__ void ph_seq(const Params& p_in, int layer, LAS unsigned char* lds_in, int blk, int nblk) {
    Params p = p_in; asm volatile("" : "+s"(p.ws), "+s"(p.out));
    LAS unsigned char* lds = lds_in; asm volatile("" : "+s"(lds));
    LAS float* L = (LAS float*)lds;
    if (blk < 64) { const int b = blk >> 3, k = blk & 7;
#ifndef REP_S0
#define REP_S0 1
#define REP_S1 1
#define REP_S2 1
#define REP_S3 1
#endif
        for (int rep = 0; rep < (k < 2 ? REP_S2 : k < 4 ? REP_S1 : k < 6 ? REP_S0 : REP_S3); ++rep)
        if (k < 2) seq_item<2>(p, layer, b, k, lds); else if (k < 4) seq_item<1>(p, layer, b, k - 2, lds); else if (k < 6) seq_item<0>(p, layer, b, k - 4, lds); else seq_item<3>(p, layer, b, k - 6, lds); }
    else for (int d = blk - 64; d < DECB * N_MU; d += nblk - 64) { const int s = NB + d / N_MU, mu = d % N_MU;
#ifndef REP_DEC2
#define REP_DEC2 1
#endif
        for (int rep = 0; rep < REP_DEC2; ++rep)
        if (mu < 4) mixer_item<0>(p, layer, s, mu, L); else if (mu < 8) mixer_item<1>(p, layer, s, mu - 4, L); else if (mu < 10) mixer_item<2>(p, layer, s, mu - 8, L); else mixer_item<3>(p, layer, s, mu - 10, L); }
}

__device__ void ph_final(const Params& p_in, int blk, int nblk) {
    Params p = p_in; asm volatile("" : "+s"(p.ws), "+s"(p.out));

    const int tid = opaque_tid(), wid = tid >> 6, lane = tid & 63;
    const float* h = (const float*)(p.ws + WS_H);
    for (int row = blk * 8 + wid; row < MROWS; row += nblk * 8) {
        float* dst;
        if (row < MP) { const int b = row / TP, t = row % TP; if (t < NMETA) continue; dst = p.out + O_YP + ((size_t)b * SEQ + (t - NMETA)) * DM; } else dst = p.out + O_YS + (size_t)(row - MP) * DM;
        f32x4 v[4]; float ss = 0.f;
#pragma unroll
        for (int j = 0; j < 4; ++j) { v[j] = *(const f32x4*)(h + (size_t)row * DM + j * 256 + lane * 4); ss += v[j][0] * v[j][0] + v[j][1] * v[j][1] + v[j][2] * v[j][2] + v[j][3] * v[j][3]; }
        const float r = rsqrtf(wave_sum(ss, lane) * (1.0f / DM) + EPSF);
#pragma unroll
        for (int j = 0; j < 4; ++j) { const f32x4 w = *(const f32x4*)(p.final_norm_w + j * 256 + lane * 4); *(f32x4*)(dst + j * 256 + lane * 4) = v[j] * r * w; }
    }
}

constexpr int LDS_STAGE = 160 * 1024 - 256;
constexpr int LDS_BYTES = LDS_STAGE + 16;
static_assert(MixLds::END * 4 <= LDS_STAGE && RetLds::END <= LDS_STAGE && SsdLds::END <= LDS_STAGE && 2 * 64 * LDP * 2 <= SsdLds::DT - SsdLds::PS && HgLds::END <= LDS_STAGE && GdLds::END <= LDS_STAGE && pg8::STAGE_BYTES <= LDS_STAGE && 4 * 64 * OSP * 4 + 1024 <= LDS_STAGE, "LDS carve");

__global__ void __launch_bounds__(512, 2) k_mega(Params p) {
    extern __shared__ __attribute__((aligned(16))) unsigned char smem[];
    LAS unsigned char* lds = (LAS unsigned char*)smem;
    const int blk = blockIdx.x, nblk = gridDim.x;
    volatile LAS unsigned* xbw = (volatile LAS unsigned*)(lds + LDS_STAGE);
    if (threadIdx.x < 4) xbw[threadIdx.x] = 0u;
    __syncthreads();
    XcdBarrier xb = xcd_barrier_post((unsigned*)(p.ws + WS_BAR), xbw);
#ifndef REP_PREP
#define REP_PREP 1
#endif
#ifndef REP_ROWNORM
#define REP_ROWNORM 1
#endif
#ifndef REP_GEMMIN
#define REP_GEMMIN 1
#endif
#ifndef REP_GDNPRE
#define REP_GDNPRE 1
#endif
#ifndef REP_MIXER
#define REP_MIXER 1
#endif
    for (int r = 0; r < REP_PREP; ++r) { ph_prep(p, lds, blk, nblk); if (r + 1 < REP_PREP) xcd_barrier(xb); }
    cooperative_groups::this_grid().sync();
    xcd_barrier(xb);
#pragma unroll 1
    for (int l = 0; l < DEPTH; ++l) {
        for (int r = 0; r < REP_ROWNORM; ++r) { ph_rownorm(p, l, blk, nblk); xcd_barrier(xb); }
        for (int r = 0; r < REP_GEMMIN; ++r) { ph_gemm_in(p, l, lds, blk, nblk); xcd_barrier(xb); }
#ifndef REP_A
#define REP_A 1
#define REP_B 1
#endif
        for (int r = 0; r < REP_A; ++r) { ph_pre(p, l, lds, blk, nblk); xcd_barrier(xb); }
        for (int r = 0; r < REP_B; ++r) { ph_seq(p, l, lds, blk, nblk); xcd_barrier(xb); }
        ph_gemm_out(p, l, lds, blk, nblk);
        xcd_barrier(xb);
    }
    ph_final(p, blk, nblk);
}

extern "C" void kernel_launch(void* const* d_in, const int* in_sizes, int n_in, void* d_out, int out_size, void* d_ws, size_t ws_size, hipStream_t stream) {
    static int grid = 0;
    if (grid == 0) {
        if (n_in != 27 || (size_t)out_size != O_END || ws_size < WS_END) { fprintf(stderr, "kernel_launch: unexpected shapes: n_in %d out %d (want %zu) ws %zu (want %zu)\n", n_in, out_size, (size_t)O_END, ws_size, (size_t)WS_END); grid = -1; return; }
        if (hipFuncSetAttribute((const void*)k_mega, hipFuncAttributeMaxDynamicSharedMemorySize, LDS_BYTES) != hipSuccess) { fprintf(stderr, "kernel_launch: hipFuncSetAttribute failed\n"); grid = -1; return; }
        int dev = 0, cus = 0, per_cu = 0;
        if (hipGetDevice(&dev) != hipSuccess || hipDeviceGetAttribute(&cus, hipDeviceAttributeMultiprocessorCount, dev) != hipSuccess) { fprintf(stderr, "kernel_launch: device query failed\n"); grid = -1; return; }
        if (hipOccupancyMaxActiveBlocksPerMultiprocessor(&per_cu, (const void*)k_mega, 512, LDS_BYTES) != hipSuccess || per_cu < 1) { fprintf(stderr, "kernel_launch: occupancy query says %d blocks per CU\n", per_cu); grid = -1; return; }
        grid = cus;
    }
    if (grid < 0) return;
    Params p{};
    const float** pp = (const float**)&p;
    for (int i = 0; i < 27; ++i) pp[i] = (const float*)d_in[i];
    p.out = (float*)d_out; p.ws = (unsigned char*)d_ws;
    (void)hipMemsetAsync((unsigned char*)d_ws + WS_BAR, 0, 16384, stream);
    void* args[] = {&p};
    const hipError_t e = hipLaunchCooperativeKernel((const void*)k_mega, dim3(grid), dim3(512), args, LDS_BYTES, stream);
    if (e != hipSuccess) fprintf(stderr, "kernel_launch: cooperative launch failed: %s (grid %d)\n", hipGetErrorString(e), grid);
}
```

```cpp
#include <hip/hip_runtime.h>
#include <hip/hip_cooperative_groups.h>
#include <cstdio>
#include <cstdint>

#define LAS __attribute__((address_space(3)))
typedef unsigned short bf16_t;
typedef short bf16x8 __attribute__((ext_vector_type(8)));
typedef float f32x4 __attribute__((ext_vector_type(4)));
typedef unsigned u32x4 __attribute__((ext_vector_type(4)));
typedef unsigned u32x2 __attribute__((ext_vector_type(2)));

constexpr int DM = 1024, NB = 8, SEQ = 2048, DEPTH = 4, DECB = 128, NMETA = 16, TP = SEQ + NMETA;
constexpr int MP = NB * TP;
constexpr int MROWS = MP + DECB;
constexpr int IN_DIM = 4108, NBIG = 4096, NSM = 12;
constexpr int PASTLEN = 16384;
constexpr float EPSF = 1e-6f;
constexpr int PC_AQ = 0, PC_AF = 256, PC_AI = 512, PC_AZ = 768, PC_BQKV = 1024, PC_BZ = 1792, PC_CXBC = 2048, PC_CZ = 2816, PC_DQ = 3072, PC_DK = 3328, PC_DV = 3584, PC_DZ = 3840;

constexpr size_t WS_BAR = 0;
constexpr size_t WS_WINT = 16384;
constexpr size_t WS_WOUTT = WS_WINT + (size_t)NBIG * DM * 2;
constexpr size_t WS_WSM = WS_WOUTT + (size_t)DM * DM * 2;
constexpr size_t WS_LB = WS_WSM + (size_t)DEPTH * NSM * DM * 4;
constexpr size_t WS_ROT = WS_LB + (size_t)DEPTH * 256 * 4;
constexpr size_t ROT_BYTES = ((size_t)(TP + 1) * 64 * 4 + 255) / 256 * 256;
constexpr size_t WS_H = WS_ROT + ROT_BYTES;
constexpr size_t WS_HB = WS_H + (size_t)MROWS * DM * 4;
constexpr size_t WS_RS = WS_HB + (size_t)MROWS * DM * 2;
constexpr size_t WS_PSM = WS_RS + (size_t)MROWS * 4;
constexpr size_t WS_PROJ = WS_PSM + (size_t)MROWS * NSM * 4;
constexpr size_t WS_Y = WS_PROJ + (size_t)MROWS * NBIG * 2;
constexpr size_t WS_E = WS_Y + (size_t)MROWS * DM * 2;
constexpr size_t WS_END = WS_E + (size_t)NB * 33 * 4 * 41728;

constexpr size_t O_YP = 0;
constexpr size_t O_YS = O_YP + (size_t)NB * SEQ * DM;
constexpr size_t O_HGRN_P = O_YS + (size_t)DECB * DM;
constexpr size_t O_GDN_P = O_HGRN_P + (size_t)DEPTH * NB * 4 * 64 * 64;
constexpr size_t O_GCONV_P = O_GDN_P + (size_t)DEPTH * NB * 4 * 64 * 64;
constexpr size_t O_SSD_P = O_GCONV_P + (size_t)DEPTH * NB * 3 * 768;
constexpr size_t O_SCONV_P = O_SSD_P + (size_t)DEPTH * NB * 4 * 128 * 64;
constexpr size_t O_RET_P = O_SCONV_P + (size_t)DEPTH * NB * 3 * 768;
constexpr size_t O_HGRN_S = O_RET_P + (size_t)DEPTH * NB * 4 * 64 * 64;
constexpr size_t O_GDN_S = O_HGRN_S + (size_t)DEPTH * DECB * 4 * 64 * 64;
constexpr size_t O_GCONV_S = O_GDN_S + (size_t)DEPTH * DECB * 4 * 64 * 64;
constexpr size_t O_SSD_S = O_GCONV_S + (size_t)DEPTH * DECB * 3 * 768;
constexpr size_t O_SCONV_S = O_SSD_S + (size_t)DEPTH * DECB * 4 * 128 * 64;
constexpr size_t O_RET_S = O_SCONV_S + (size_t)DEPTH * DECB * 3 * 768;
constexpr size_t O_END = O_RET_S + (size_t)DEPTH * DECB * 4 * 64 * 64;

struct Params {
    const float* x_prompt; const float* x_sample;
    const float* st_hgrn; const float* st_gdn; const float* st_gconv; const float* st_ssd; const float* st_sconv; const float* st_ret;
    const float* meta; const float* norm_w; const float* w_in; const float* lb_logits; const float* hgrn_norm_w;
    const float* gdn_conv_w; const float* gdn_a_log; const float* gdn_dt_bias; const float* gdn_norm_w;
    const float* ssd_conv_w; const float* ssd_conv_b; const float* ssd_a_log; const float* ssd_dt_bias; const float* ssd_d; const float* ssd_norm_w;
    const float* ret_norm_w; const float* ret_norm_b; const float* w_out; const float* final_norm_w;
    float* out; unsigned char* ws;
};

__device__ __forceinline__ float bf2f(bf16_t b) { return __uint_as_float(((unsigned)b) << 16); }
__device__ __forceinline__ bf16_t f2bf(float f) { unsigned u = __float_as_uint(f); u += 0x7FFFu + ((u >> 16) & 1u); return (bf16_t)(u >> 16); }
__device__ __forceinline__ unsigned pack_bf2(float lo, float hi) { return (unsigned)f2bf(lo) | ((unsigned)f2bf(hi) << 16); }
__device__ __forceinline__ float sigmoid_f(float x) { return 1.0f / (1.0f + __expf(-x)); }
__device__ __forceinline__ float silu_f(float x) { return x / (1.0f + __expf(-x)); }
__device__ __forceinline__ float softplus_f(float x) { return x > 20.0f ? x : log1pf(__expf(x)); }
__device__ __forceinline__ int opaque_tid() { int t = threadIdx.x; asm volatile("" : "+v"(t)); return t; }
__device__ __forceinline__ float lane_xor(float v, int k, int lane) { return __int_as_float(__builtin_amdgcn_ds_bpermute((lane ^ k) << 2, __float_as_int(v))); }
__device__ __forceinline__ float lane_up(float v, int k, int lane) { return __int_as_float(__builtin_amdgcn_ds_bpermute(((lane - k) & 63) << 2, __float_as_int(v))); }
__device__ __forceinline__ float wave_sum(float v, int lane) {
#pragma unroll
    for (int o = 32; o > 0; o >>= 1) v += lane_xor(v, o, lane);
    return v;
}


#define XB_TMO      128
#define XB_XCNT(j)  (256  + 64 * (j))
#define XB_XSUB(j)  (1280 + 64 * (j))
#define XB_XGEN(j)  (2304 + 64 * (j))
#define XB_TOP      3328
#define XB_TOPGEN   3392
#define XCD_BAR_WORDS 3456
#define XB_SPIN_CAP (1u << 22)
__device__ __forceinline__ unsigned xb_ld(unsigned* p)              { return __hip_atomic_load(p, __ATOMIC_RELAXED, __HIP_MEMORY_SCOPE_AGENT); }
__device__ __forceinline__ unsigned xb_add(unsigned* p, unsigned v) { return __hip_atomic_fetch_add(p, v, __ATOMIC_RELAXED, __HIP_MEMORY_SCOPE_AGENT); }
__device__ __forceinline__ unsigned xb_xcc_id() { return (unsigned)__builtin_amdgcn_s_getreg((3 << 11) | 20) & 0xFu; }
#define XB_SPIN(cond, bar) do { unsigned _sp = 0; while (cond) { __builtin_amdgcn_s_sleep(1); \
    if ((++_sp & 255u) == 0u) { if (xb_ld(&(bar)[XB_TMO])) break; if (_sp > XB_SPIN_CAP) { atomicAdd(&(bar)[XB_TMO], 1u); break; } } } } while (0)
struct XcdBarrier { unsigned* bar; unsigned x; volatile LAS unsigned* st; };
__device__ __forceinline__ XcdBarrier xcd_barrier_post(unsigned* bar, volatile LAS unsigned* st) {
    XcdBarrier b; b.bar = bar; b.x = xb_xcc_id(); b.st = st;
    if (threadIdx.x == 0) (void)xb_add(&bar[XB_XCNT(b.x)], 1u);
    return b;
}
__device__ __forceinline__ void xcd_barrier_complete(unsigned* bar, unsigned x, unsigned& nloc, unsigned& nx) {
    const unsigned G = gridDim.x * gridDim.y * gridDim.z;
    unsigned sum, cnt, mine, sp = 0u;
    for (;;) {
        sum = 0u; cnt = 0u; mine = 0u;
#pragma unroll
        for (unsigned j = 0; j < 16; ++j) { const unsigned c = xb_ld(&bar[XB_XCNT(j)]); sum += c; cnt += (c > 0u) ? 1u : 0u; mine = (j == x) ? c : mine; }
        if (sum == G) break;
        __builtin_amdgcn_s_sleep(1);
        if ((++sp & 255u) == 0u) { if (xb_ld(&bar[XB_TMO])) break; if (sp > XB_SPIN_CAP) { atomicAdd(&bar[XB_TMO], 1u); break; } }
    }
    nloc = mine > 0u ? mine : 1u; nx = cnt > 0u ? cnt : 1u;
}
__device__ __forceinline__ void xcd_barrier(const XcdBarrier& b0) {
    asm volatile("s_waitcnt vmcnt(0)" ::: "memory");
    __syncthreads();
    if (threadIdx.x == 0) {
        XcdBarrier b = b0; { unsigned x = xb_xcc_id(); asm volatile("" : "+s"(x)); b.x = x; }
        unsigned* bar = b.bar;
        __builtin_amdgcn_s_waitcnt(0);
        unsigned nloc = b.st[0], nx = b.st[1];
        if (nloc == 0u) { xcd_barrier_complete(bar, b.x, nloc, nx); b.st[0] = nloc; b.st[1] = nx; }
        const unsigned old = xb_add(&bar[XB_XSUB(b.x)], 1u);
        const unsigned gen = old / nloc;
        if (old + 1u == (gen + 1u) * nloc) {
            __builtin_amdgcn_fence(__ATOMIC_RELEASE, "agent");
            asm volatile("s_waitcnt vmcnt(0)" ::: "memory");
            const unsigned og = xb_add(&bar[XB_TOP], 1u);
            const unsigned tg = og / nx;
            if (og + 1u == (tg + 1u) * nx) xb_add(&bar[XB_TOPGEN], 1u);
            else XB_SPIN(xb_ld(&bar[XB_TOPGEN]) == tg, bar);
            __builtin_amdgcn_fence(__ATOMIC_ACQUIRE, "agent");
            xb_add(&bar[XB_XGEN(b.x)], 1u);
            asm volatile("s_waitcnt vmcnt(0)" ::: "memory");
        } else {
            XB_SPIN(xb_ld(&bar[XB_XGEN(b.x)]) == gen, bar);
            __builtin_amdgcn_fence(__ATOMIC_ACQUIRE, "agent");
            asm volatile("s_waitcnt vmcnt(0)" ::: "memory");
        }
    }
    __syncthreads();
}

namespace pg8 {
constexpr int BM = 256, BK = 64, HALF = 128, HTB = HALF * BK * 2, STAGE_BYTES = 8 * HTB, NXCD = 8, WGM = 8;
__host__ __device__ __forceinline__ int lds_byte(int r, int c) { const int st = (r >> 4) * 2 + (c >> 5), rr = r & 15, cc = c & 31, ob = rr * 64 + cc * 2; return st * 1024 + (ob ^ (((ob >> 9) & 1) << 5)); }
__host__ __device__ __forceinline__ void stage_rc(int b, int& R, int& C) { const int st = b / 1024, sb = b % 1024, swz = sb ^ (((sb >> 9) & 1) << 5); R = (st >> 1) * 16 + swz / 64; C = (st & 1) * 32 + (swz % 64) / 2; }
__host__ __device__ __forceinline__ int perm32(int rho) { const int n = rho >> 4, i = rho & 15; return 8 * (i >> 2) + 4 * n + (i & 3); }
struct Unit { int pm, pn; };
struct Gemm { const bf16_t* A; const bf16_t* Bt; int M, N, K; };
struct StaticOrder {
    int nM, nN, nwg, G, c;
    __host__ __device__ void init(int M, int N, int G_, int c_) { nM = M / BM; nN = N / BM; nwg = nM * nN; G = G_; c = c_; }
    __host__ __device__ bool next(int i, Unit& u) const {
        const long L = (long)i * G + c; if (L >= nwg) return false;
        int wgid = (int)L; { const int q = nwg / NXCD, r = nwg % NXCD, xcd = wgid % NXCD, off = wgid / NXCD; wgid = (xcd < r ? xcd * (q + 1) : r * (q + 1) + (xcd - r) * q) + off; }
        const int nig = WGM * nN, gid = wgid / nig, fm = gid * WGM, gsz = (nM - fm) < WGM ? (nM - fm) : WGM;
        u.pm = fm + ((wgid % nig) % gsz); u.pn = (wgid % nig) / gsz; return true;
    }
    __device__ __forceinline__ void a_ready(const Unit&) const {}
    __device__ __forceinline__ void done(const Unit&) const {}
};
typedef float f32x2_t __attribute__((ext_vector_type(2)));
typedef __bf16 bf16x2n_t __attribute__((ext_vector_type(2)));
__device__ __forceinline__ unsigned cvt_pk_bf16(float lo, float hi) { const f32x2_t f = {lo, hi}; return __builtin_bit_cast(unsigned, __builtin_convertvector(f, bf16x2n_t)); }

struct EpiProj {
    static constexpr bool PERM = true, AFTER_DRAIN = false;
    bf16_t* O; int ldc; const float* rs;
    __device__ __forceinline__ void operator()(const f32x4 (&acc)[2][2][4][2], const Unit& u, int wr, int wc, int fr, int fq) const {
        const int row0 = u.pm * BM + wr * 64 + fr; const int col0 = u.pn * BM + wc * 32 + 8 * fq;
#pragma unroll
        for (int ai = 0; ai < 2; ++ai)
#pragma unroll
            for (int m = 0; m < 4; ++m) { const int row = row0 + ai * HALF + m * 16; const float s = rs[row]; bf16_t* rowp = O + (size_t)row * ldc + col0;
#pragma unroll
                for (int bj = 0; bj < 2; ++bj) { const f32x4 v0 = acc[ai][bj][m][0] * s, v1 = acc[ai][bj][m][1] * s;
                    u32x4 w; w.x = cvt_pk_bf16(v0[0], v0[1]); w.y = cvt_pk_bf16(v0[2], v0[3]); w.z = cvt_pk_bf16(v1[0], v1[1]); w.w = cvt_pk_bf16(v1[2], v1[3]);
                    *(u32x4*)(rowp + bj * HALF) = w; } }
    }
};
struct EpiResid {
    static constexpr bool PERM = false, AFTER_DRAIN = false;
    float* C; int ldc;
    __device__ __forceinline__ void operator()(const f32x4 (&acc)[2][2][4][2], const Unit& u, int wr, int wc, int fr, int fq) const {
        const int row0 = u.pm * BM + wr * 64 + fr, col0 = u.pn * BM + wc * 32 + 4 * fq;
#pragma unroll
        for (int ai = 0; ai < 2; ++ai)
#pragma unroll
            for (int m = 0; m < 4; ++m) { float* rowp = C + (size_t)(row0 + ai * HALF + m * 16) * ldc + col0;
#pragma unroll
                for (int bj = 0; bj < 2; ++bj)
#pragma unroll
                    for (int n = 0; n < 2; ++n) { f32x4* p = (f32x4*)(rowp + bj * HALF + n * 16); *p = *p + acc[ai][bj][m][n]; } }
    }
};

template <class Epi, class Sched>
__device__ __forceinline__ void gemm_phase(LAS unsigned char* lds, const Gemm g, const Sched& S, const Epi& E) {
    const int tid = opaque_tid(), wid = __builtin_amdgcn_readfirstlane(tid >> 6), lane = tid & 63, wr = wid >> 2, wc = wid & 3, fr = lane & 15, fq = lane >> 4;
    const int K = g.K, nt = K / BK;
    unsigned voffA[2], voffB[2];
#pragma unroll
    for (int i = 0; i < 2; ++i) { int R, C; stage_rc(tid * 16 + i * 8192, R, C); const int Rb = Epi::PERM ? ((R & ~31) + perm32(R & 31)) : R;
        voffA[i] = (unsigned)(R * K + C) * 2u; voffB[i] = (unsigned)(Rb * K + C) * 2u; }
    const size_t kstep = (size_t)(BK * 2);
    const size_t hstep = (size_t)HALF * K * 2;
    const size_t tstep = 2 * hstep;
    const unsigned ldsw = (unsigned)wid * 1024u;
    const int aoff = lds_byte(wr * 64 + fr, fq * 8), boff = lds_byte(wc * 32 + fr, fq * 8);
#define PG8_SA(b, h) (((b) * 2 + (h)) * HTB)
#define PG8_SB(b, h) ((4 + (b) * 2 + (h)) * HTB)
#define PG8_STAGE(bufoff, gbase, voff) do { _Pragma("unroll") for (int _i = 0; _i < 2; ++_i) \
        __builtin_amdgcn_global_load_lds((const unsigned*)((const char*)(gbase) + (voff)[_i]), (LAS unsigned*)(lds + (bufoff) + ldsw + _i * 8192), 16, 0, 0); } while (0)
#define PG8_LDA(dst, b, h) do { _Pragma("unroll") for (int m = 0; m < 4; ++m) _Pragma("unroll") for (int k = 0; k < 2; ++k) dst[m][k] = *(const LAS bf16x8*)(lds + PG8_SA(b, h) + aoff + m * 2048 + k * 1024); } while (0)
#define PG8_LDB(dst, b, h) do { _Pragma("unroll") for (int n = 0; n < 2; ++n) _Pragma("unroll") for (int k = 0; k < 2; ++k) dst[n][k] = *(const LAS bf16x8*)(lds + PG8_SB(b, h) + boff + n * 2048 + k * 1024); } while (0)
#define PG8_MMA(ai, bj, At, Bt) do { __builtin_amdgcn_s_setprio(1); _Pragma("unroll") for (int m = 0; m < 4; ++m) _Pragma("unroll") for (int n = 0; n < 2; ++n) _Pragma("unroll") for (int k = 0; k < 2; ++k) \
        acc[ai][bj][m][n] = __builtin_amdgcn_mfma_f32_16x16x32_bf16(Bt[n][k], At[m][k], acc[ai][bj][m][n], 0, 0, 0); __builtin_amdgcn_s_setprio(0); } while (0)
#define PG8_WAIT_V(n) asm volatile("s_waitcnt vmcnt(" #n ")" ::: "memory")
#define PG8_WAIT_L(n) asm volatile("s_waitcnt lgkmcnt(" #n ")" ::: "memory")
#define PG8_BAR __builtin_amdgcn_s_barrier()
#define PG8_SCHED __builtin_amdgcn_sched_barrier(0)
    Unit cur, nxt; int ui = 0;
    if (!S.next(0, cur)) return;
    f32x4 acc[2][2][4][2];
#pragma unroll
    for (int a = 0; a < 2; ++a)
#pragma unroll
        for (int b = 0; b < 2; ++b)
#pragma unroll
            for (int m = 0; m < 4; ++m)
#pragma unroll
                for (int n = 0; n < 2; ++n) acc[a][b][m][n] = (f32x4){0.f, 0.f, 0.f, 0.f};
    bf16x8 At[4][2], B0[2][2], B1[2][2];
    const char* cA = (const char*)g.A + (size_t)cur.pm * tstep; const char* cB = (const char*)g.Bt + (size_t)cur.pn * tstep;
    S.a_ready(cur);
    PG8_STAGE(PG8_SB(0, 0), cB, voffB); PG8_STAGE(PG8_SA(0, 0), cA, voffA); PG8_STAGE(PG8_SB(0, 1), cB + hstep, voffB); PG8_STAGE(PG8_SA(0, 1), cA + hstep, voffA);
    if (wr == 1) PG8_BAR;
    PG8_WAIT_V(4); PG8_BAR;
    PG8_STAGE(PG8_SB(1, 0), cB + kstep, voffB); PG8_STAGE(PG8_SA(1, 0), cA + kstep, voffA); PG8_STAGE(PG8_SB(1, 1), cB + hstep + kstep, voffB);
    PG8_WAIT_V(6); PG8_BAR;
    for (;;) {
        const bool has_next = S.next(ui + 1, nxt);
        const char* nA = has_next ? (const char*)g.A + (size_t)nxt.pm * tstep : cA; const char* nB = has_next ? (const char*)g.Bt + (size_t)nxt.pn * tstep : cB;
        for (int t = 0; t < nt; t += 2) {
            const bool last = (t == nt - 2);
            const char* a1 = cA + (size_t)(t + 1) * kstep;
            const char* a2 = last ? nA : cA + (size_t)(t + 2) * kstep; const char* b2 = last ? nB : cB + (size_t)(t + 2) * kstep;
            const char* a3 = a2 + kstep; const char* b3 = b2 + kstep;
            if (last && has_next) S.a_ready(nxt);
            PG8_LDB(B0, 0, 0); PG8_SCHED; PG8_LDA(At, 0, 0); PG8_STAGE(PG8_SA(1, 1), a1 + hstep, voffA);
            PG8_WAIT_L(8); PG8_BAR; PG8_WAIT_L(0); PG8_MMA(0, 0, At, B0); PG8_BAR; PG8_SCHED;
            PG8_LDB(B1, 0, 1); PG8_STAGE(PG8_SB(0, 0), b2, voffB);
            PG8_BAR; PG8_WAIT_L(0); PG8_MMA(0, 1, At, B1); PG8_BAR;
            PG8_LDA(At, 0, 1); PG8_STAGE(PG8_SA(0, 0), a2, voffA);
            PG8_BAR; PG8_WAIT_L(0); PG8_MMA(1, 0, At, B0); PG8_BAR; PG8_SCHED;
            PG8_STAGE(PG8_SB(0, 1), b2 + hstep, voffB);
            PG8_WAIT_V(6); PG8_BAR; PG8_MMA(1, 1, At, B1); PG8_BAR;
            PG8_LDB(B0, 1, 0); PG8_SCHED; PG8_LDA(At, 1, 0); PG8_STAGE(PG8_SA(0, 1), a2 + hstep, voffA);
            PG8_WAIT_L(8); PG8_BAR; PG8_WAIT_L(0); PG8_MMA(0, 0, At, B0); PG8_BAR; PG8_SCHED;
            PG8_LDB(B1, 1, 1); PG8_STAGE(PG8_SB(1, 0), b3, voffB);
            PG8_BAR; PG8_WAIT_L(0); PG8_MMA(0, 1, At, B1); PG8_BAR;
            PG8_LDA(At, 1, 1); PG8_STAGE(PG8_SA(1, 0), a3, voffA);
            PG8_BAR; PG8_WAIT_L(0); PG8_MMA(1, 0, At, B0); PG8_BAR; PG8_SCHED;
            PG8_STAGE(PG8_SB(1, 1), b3 + hstep, voffB);
            PG8_WAIT_V(6); PG8_BAR; PG8_MMA(1, 1, At, B1); PG8_BAR;
        }
        if constexpr (!Epi::AFTER_DRAIN) { E(acc, cur, wr, wc, fr, fq); S.done(cur); }
        if (!has_next) break;
#pragma unroll
        for (int a = 0; a < 2; ++a)
#pragma unroll
            for (int b = 0; b < 2; ++b)
#pragma unroll
                for (int m = 0; m < 4; ++m)
#pragma unroll
                    for (int n = 0; n < 2; ++n) acc[a][b][m][n] = (f32x4){0.f, 0.f, 0.f, 0.f};
        cur = nxt; cA = nA; cB = nB; ++ui;
    }
    PG8_WAIT_V(0);
    if (wr == 0) PG8_BAR;
    PG8_BAR;
#undef PG8_SA
#undef PG8_SB
#undef PG8_STAGE
#undef PG8_LDA
#undef PG8_LDB
#undef PG8_MMA
#undef PG8_WAIT_V
#undef PG8_WAIT_L
#undef PG8_BAR
#undef PG8_SCHED
}
}

__device__ __forceinline__ int win_col(int n) { return n < 2048 ? n : (n < 3072 ? n + 8 : n + 12); }
__device__ __forceinline__ int win_smcol(int j) { return j < 8 ? 2048 + j : 3080 + (j - 8); }

__device__ __forceinline__ void convert_weights(const Params& p, int l_in, int l_out, LAS float* tile  , int tid, int blk, int nblk) {
    const int tiles_in = l_in >= 0 ? 64 * 16 : 0, tiles_out = l_out >= 0 ? 16 * 16 : 0;
    for (int t = blk; t < tiles_in + tiles_out; t += nblk) {
        const float* src; bf16_t* dst; int ld, n0, k0; const float* scale;
        if (t < tiles_in) { n0 = (t / 16) * 64; k0 = (t % 16) * 64; src = p.w_in + (size_t)l_in * DM * IN_DIM + win_col(n0); ld = IN_DIM; dst = (bf16_t*)(p.ws + WS_WINT); scale = p.norm_w + l_in * DM; }
        else { const int r = t - tiles_in; n0 = (r / 16) * 64; k0 = (r % 16) * 64; src = p.w_out + (size_t)l_out * DM * DM + n0; ld = DM; dst = (bf16_t*)(p.ws + WS_WOUTT); scale = nullptr; }
        __syncthreads();
#pragma unroll
        for (int n_ = 0; n_ < 8; ++n_) { const int e = tid + 512 * n_; const int kk = e >> 6, nn = e & 63; float v = src[(size_t)(k0 + kk) * ld + nn]; if (scale) v *= scale[k0 + kk]; tile[kk * 65 + nn] = v; }
        __syncthreads();
#pragma unroll
        for (int n_ = 0; n_ < 4; ++n_) { const int e = tid + 512 * n_; const int nn = e >> 5, kp = (e & 31) * 2; const unsigned w = pack_bf2(tile[kp * 65 + nn], tile[(kp + 1) * 65 + nn]);
            *(unsigned*)(dst + (size_t)(n0 + nn) * DM + k0 + kp) = w; }
    }
    __syncthreads();
}

__device__ void ph_prep(const Params& p_in, LAS unsigned char* lds_in, int blk, int nblk) {
    Params p = p_in; asm volatile("" : "+s"(p.ws), "+s"(p.out));
    LAS unsigned char* lds = lds_in; asm volatile("" : "+s"(lds));

    const int tid = opaque_tid();
    LAS float* tile = (LAS float*)lds;
    convert_weights(p, 0, 0, tile, tid, blk, nblk);
    for (int e = blk * 512 + tid; e < DEPTH * NSM * DM; e += nblk * 512) { const int l = e / (NSM * DM), r = e % (NSM * DM), j = r / DM, k = r % DM;
        ((float*)(p.ws + WS_WSM))[e] = p.w_in[(size_t)l * DM * IN_DIM + (size_t)k * IN_DIM + win_smcol(j)] * p.norm_w[l * DM + k]; }
    for (int c = blk * 512 + tid; c < 256; c += nblk * 512) { float lg[DEPTH], mx = -1e30f;
#pragma unroll
        for (int l = 0; l < DEPTH; ++l) { lg[l] = p.lb_logits[l * 256 + c]; mx = fmaxf(mx, lg[l]); }
        float s = 0.f;
#pragma unroll
        for (int l = 0; l < DEPTH; ++l) { lg[l] = expf(lg[l] - mx); s += lg[l]; }
        float cum = 0.f; const float w0 = lg[0] / s;
#pragma unroll
        for (int l = 0; l < DEPTH; ++l) { cum += lg[l] / s; ((float*)(p.ws + WS_LB))[l * 256 + c] = fmaxf(cum - w0, 0.f); } }
    for (int e = blk * 512 + tid; e < (TP + 1) * 32; e += nblk * 512) { const int pi = e >> 5, i = e & 31; const double pos = pi < TP ? (double)pi : (double)PASTLEN;
        const float invf = (float)(1.0 / pow(10000.0, (double)((float)i / 31.0f)));
        const double rev = pos * (double)invf * 0.15915494309189535; const float fr = (float)(rev - rint(rev));
        ((float*)(p.ws + WS_ROT))[e * 2 + 0] = __builtin_amdgcn_cosf(fr); ((float*)(p.ws + WS_ROT))[e * 2 + 1] = __builtin_amdgcn_sinf(fr); }
    float* h = (float*)(p.ws + WS_H);
    for (int e = blk * 512 + tid; e < MROWS * (DM / 4); e += nblk * 512) { const int row = e >> 8, c4 = (e & 255) * 4; const float* src;
        if (row < MP) { const int b = row / TP, t = row % TP; src = t < NMETA ? p.meta + t * DM : p.x_prompt + ((size_t)b * SEQ + (t - NMETA)) * DM; } else src = p.x_sample + (size_t)(row - MP) * DM;
        *(f32x4*)(h + (size_t)row * DM + c4) = *(const f32x4*)(src + c4); }
}

__device__ void ph_rownorm(const Params& p_in, int layer, int blk, int nblk) {
    Params p = p_in; asm volatile("" : "+s"(p.ws), "+s"(p.out));

    const int tid = opaque_tid(), wid = tid >> 6, lane = tid & 63;
    const float* h = (const float*)(p.ws + WS_H); bf16_t* hb = (bf16_t*)(p.ws + WS_HB); float* rs = (float*)(p.ws + WS_RS); float* psm = (float*)(p.ws + WS_PSM);
    const float* wsm = (const float*)(p.ws + WS_WSM) + (size_t)layer * NSM * DM;
    for (int row = blk * 8 + wid; row < MROWS; row += nblk * 8) {
        f32x4 v[4]; float ss = 0.f;
#pragma unroll
        for (int j = 0; j < 4; ++j) { v[j] = *(const f32x4*)(h + (size_t)row * DM + j * 256 + lane * 4); ss += v[j][0] * v[j][0] + v[j][1] * v[j][1] + v[j][2] * v[j][2] + v[j][3] * v[j][3]; }
        ss = wave_sum(ss, lane); const float r = rsqrtf(ss * (1.0f / DM) + EPSF);
#pragma unroll
        for (int j = 0; j < 4; ++j) { u32x2 w; w.x = pack_bf2(v[j][0], v[j][1]); w.y = pack_bf2(v[j][2], v[j][3]); *(u32x2*)(hb + (size_t)row * DM + j * 256 + lane * 4) = w; }
        float mine = 0.f;
        for (int q = 0; q < NSM; ++q) { float d = 0.f;
#pragma unroll
            for (int j = 0; j < 4; ++j) { const f32x4 w = *(const f32x4*)(wsm + q * DM + j * 256 + lane * 4); d += v[j][0] * w[0] + v[j][1] * w[1] + v[j][2] * w[2] + v[j][3] * w[3]; }
            d = wave_sum(d, lane); if (lane == q) mine = d * r; }
        if (lane < NSM) psm[(size_t)row * NSM + lane] = mine;
        if (lane == 0) rs[row] = r;
    }
}

__device__ void ph_gemm_in(const Params& p_in, int layer, LAS unsigned char* lds_in, int blk, int nblk) {
    Params p = p_in; asm volatile("" : "+s"(p.ws), "+s"(p.out));
    LAS unsigned char* lds = lds_in; asm volatile("" : "+s"(lds));

    pg8::Gemm g{(const bf16_t*)(p.ws + WS_HB), (const bf16_t*)(p.ws + WS_WINT), MROWS, NBIG, DM};
    pg8::StaticOrder S; S.init(MROWS, NBIG, nblk, blk);
    pg8::EpiProj E{(bf16_t*)(p.ws + WS_PROJ), NBIG, (const float*)(p.ws + WS_RS)};
    pg8::gemm_phase<pg8::EpiProj, pg8::StaticOrder>(lds, g, S, E);
}
__device__ void ph_gemm_out(const Params& p_in, int layer, LAS unsigned char* lds_in, int blk, int nblk) {
    Params p = p_in; asm volatile("" : "+s"(p.ws), "+s"(p.out));
    LAS unsigned char* lds = lds_in; asm volatile("" : "+s"(lds));

    pg8::Gemm g{(const bf16_t*)(p.ws + WS_Y), (const bf16_t*)(p.ws + WS_WOUTT), MROWS, DM, DM};
    pg8::StaticOrder S; S.init(MROWS, DM, nblk, blk);
    pg8::EpiResid E{(float*)(p.ws + WS_H), DM};
    pg8::gemm_phase<pg8::EpiResid, pg8::StaticOrder>(lds, g, S, E);
}

constexpr int TB = 16;
struct MixLds {
    static constexpr int QS = 0, KS = QS + TB * 128, VS = KS + TB * 128, DS = VS + TB * 128, ZS = DS + TB * 128, XS = ZS + TB * 128, OS = XS + TB * 128, BS = OS + TB * 128, SC = BS + TB * 2, END = SC + TB * 2;
};

struct SeqInfo { int row0, T, dec, b; };
__device__ __forceinline__ SeqInfo seq_info(int s) { SeqInfo q; if (s < NB) { q.row0 = s * TP; q.T = TP; q.dec = 0; q.b = s; } else { q.row0 = MP + (s - NB); q.T = 1; q.dec = 1; q.b = s - NB; } return q; }

__device__ __forceinline__ float preconv(const bf16_t* proj, const SeqInfo& q, int t, int col, const float* ctx  , int ch) {
    if (t >= 0) return bf2f(proj[(size_t)(q.row0 + t) * NBIG + col]);
    return ctx ? ctx[(3 + t) * 768 + ch] : 0.f;
}

template <int DK, int NV, bool DELTA, bool VECDEC>
__device__ __forceinline__ void recur_batch(float (&S)[DK / (64 / NV)], LAS float* L, int nb, int wid, int lane) {
    constexpr int KQ = 64 / NV, KR = DK / KQ, DVT = 8 * NV;
    const int kq = lane / NV, vv = lane % NV, vcol = wid * NV + vv, hh = vcol >> 6;
    for (int t = 0; t < nb; ++t) {
        float kk[KR], qq[KR];
#pragma unroll
        for (int i = 0; i < KR; ++i) { kk[i] = L[MixLds::KS + t * 128 + kq * KR + i]; qq[i] = L[MixLds::QS + t * 128 + kq * KR + i]; }
        const float v = L[MixLds::VS + t * 128 + vcol];
        if (DELTA) {
            const float dec = L[MixLds::DS + t * 128 + hh]; float pk = 0.f;
#pragma unroll
            for (int i = 0; i < KR; ++i) { S[i] *= dec; pk += kk[i] * S[i]; }
#pragma unroll
            for (int o = NV; o < 64; o <<= 1) pk += lane_xor(pk, o, lane);
            const float u = L[MixLds::BS + t] * (v - pk);
#pragma unroll
            for (int i = 0; i < KR; ++i) S[i] += kk[i] * u;
        } else if (VECDEC) {
#pragma unroll
            for (int i = 0; i < KR; ++i) S[i] = L[MixLds::DS + t * 128 + kq * KR + i] * S[i] + kk[i] * v;
        } else {
            const float dec = L[MixLds::DS + t * 128 + hh];
#pragma unroll
            for (int i = 0; i < KR; ++i) S[i] = dec * S[i] + kk[i] * v;
        }
        float po = 0.f;
#pragma unroll
        for (int i = 0; i < KR; ++i) po += qq[i] * S[i];
#pragma unroll
        for (int o = NV; o < 64; o <<= 1) po += lane_xor(po, o, lane);
        if (kq == 0) L[MixLds::OS + t * 128 + vcol] = po;
    }
    (void)DVT;
}

template <int MIX>
__device__ void mixer_item(const Params& p, int layer, int s, int hu  , LAS float* L) {
    constexpr int DK = MIX == 2 ? 128 : 64, NV = MIX == 2 ? 16 : 8, KQ = 64 / NV, KR = DK / KQ, DVT = 8 * NV;
    const int tid = opaque_tid(), wid = tid >> 6, lane = tid & 63;
    const SeqInfo q = seq_info(s);
    const bf16_t* proj = (const bf16_t*)(p.ws + WS_PROJ); const float* psm = (const float*)(p.ws + WS_PSM); bf16_t* y = (bf16_t*)(p.ws + WS_Y);
    const float* lb = (const float*)(p.ws + WS_LB) + layer * 256; const float* rot = (const float*)(p.ws + WS_ROT);
    const int kq = lane / NV, vv = lane % NV, vcol = wid * NV + vv, hh = vcol >> 6;
    const int head = MIX == 2 ? hu * 2 + hh : hu;
    const float* ctx = nullptr; const float* cw = nullptr;
    if (MIX == 1) { cw = p.gdn_conv_w + (size_t)layer * 4 * 768; if (q.dec) ctx = p.st_gconv + ((size_t)layer * DECB + q.b) * 3 * 768; }
    if (MIX == 2) { cw = p.ssd_conv_w + (size_t)layer * 4 * 768; if (q.dec) ctx = p.st_sconv + ((size_t)layer * DECB + q.b) * 3 * 768; }
    float S[KR];
    {
        const float* st = MIX == 0 ? p.st_hgrn : MIX == 1 ? p.st_gdn : MIX == 2 ? p.st_ssd : p.st_ret;
#pragma unroll
        for (int i = 0; i < KR; ++i) S[i] = q.dec ? st[(((size_t)layer * DECB + q.b) * 4 + head) * DK * 64 + (size_t)(kq * KR + i) * 64 + (vcol & 63)] : 0.f;
    }
    float hc0 = 0.f, hc1 = 0.f;
    if (MIX == 1) { hc0 = -__expf(p.gdn_a_log[layer * 4 + hu]); hc1 = p.gdn_dt_bias[layer * 4 + hu]; }
    if (MIX == 3) { hc0 = 1.0f - exp2f(-5.0f - (float)hu); }

    for (int t0 = 0; t0 < q.T; t0 += TB) {
        const int nb = min(TB, q.T - t0);
        __syncthreads();
        if (MIX == 0) {
            for (int e = tid; e < nb * 64; e += 512) { const int t = e >> 6, d = e & 63, c = hu * 64 + d; const bf16_t* pr = proj + (size_t)(q.row0 + t0 + t) * NBIG;
                const float aq = bf2f(pr[PC_AQ + c]), af = bf2f(pr[PC_AF + c]), ai = bf2f(pr[PC_AI + c]), az = bf2f(pr[PC_AZ + c]), l_ = lb[c];
                L[MixLds::QS + t * 128 + d] = silu_f(aq) * 0.125f; L[MixLds::KS + t * 128 + d] = (1.0f - l_) * sigmoid_f(-af); L[MixLds::DS + t * 128 + d] = l_ + (1.0f - l_) * sigmoid_f(af);
                L[MixLds::VS + t * 128 + d] = ai; L[MixLds::ZS + t * 128 + d] = az; }
        } else if (MIX == 1) {
            for (int e = tid; e < nb * 192; e += 512) { const int t = e / 192, r = e % 192, part = r >> 6, d = r & 63, ch = part * 256 + hu * 64 + d, col = PC_BQKV + ch; const int tt = t0 + t;
                float a = 0.f;
#pragma unroll
                for (int j = 0; j < 4; ++j) a += cw[j * 768 + ch] * preconv(proj, q, tt - 3 + j, col, ctx, ch);
                a = silu_f(a);
                L[(part == 0 ? MixLds::QS : part == 1 ? MixLds::KS : MixLds::VS) + t * 128 + d] = a; }
            for (int e = tid; e < nb * 64; e += 512) { const int t = e >> 6, d = e & 63; L[MixLds::ZS + t * 128 + d] = bf2f(proj[(size_t)(q.row0 + t0 + t) * NBIG + PC_BZ + hu * 64 + d]); }
            if (tid < nb) { const float* ps = psm + (size_t)(q.row0 + t0 + tid) * NSM; const float g = hc0 * softplus_f(ps[hu] + hc1);
                L[MixLds::DS + tid * 128 + 0] = __expf(g); L[MixLds::BS + tid] = sigmoid_f(ps[4 + hu]); }
            __syncthreads();
            if (tid < nb * 2) { const int t = tid >> 1, which = tid & 1; const LAS float* src = L + (which ? MixLds::KS : MixLds::QS) + t * 128; float ss = 0.f;
                for (int d = 0; d < 64; ++d) ss += src[d] * src[d];
                L[MixLds::SC + tid] = rsqrtf(ss + EPSF) * (which ? 1.0f : 0.125f); }
            __syncthreads();
            for (int e = tid; e < nb * 128; e += 512) { const int t = e >> 7, r = e & 127, which = r >> 6, d = r & 63; L[(which ? MixLds::KS : MixLds::QS) + t * 128 + d] *= L[MixLds::SC + t * 2 + which]; }
        } else if (MIX == 2) {
            if (tid < nb * 2) { const int t = tid >> 1, h2 = tid & 1, hd = hu * 2 + h2; const float dt = softplus_f(psm[(size_t)(q.row0 + t0 + t) * NSM + 8 + hd] + p.ssd_dt_bias[layer * 4 + hd]);
                L[MixLds::BS + tid] = dt; L[MixLds::DS + t * 128 + h2] = __expf(-dt * __expf(p.ssd_a_log[layer * 4 + hd])); }
            __syncthreads();
            for (int e = tid; e < nb * 384; e += 512) { const int t = e / 384, r = e % 384, part = r >> 7, j = r & 127, ch = part * 256 + hu * 128 + j, col = PC_CXBC + ch; const int tt = t0 + t;
                float a = p.ssd_conv_b[layer * 768 + ch];
#pragma unroll
                for (int jj = 0; jj < 4; ++jj) a += cw[jj * 768 + ch] * preconv(proj, q, tt - 3 + jj, col, ctx, ch);
                a = silu_f(a);
                if (part == 0) { L[MixLds::XS + t * 128 + j] = a; L[MixLds::VS + t * 128 + j] = a * L[MixLds::BS + t * 2 + (j >> 6)]; }
                else if (part == 1) L[MixLds::KS + t * 128 + j] = a; else L[MixLds::QS + t * 128 + j] = a; }
            for (int e = tid; e < nb * 128; e += 512) { const int t = e >> 7, j = e & 127; L[MixLds::ZS + t * 128 + j] = bf2f(proj[(size_t)(q.row0 + t0 + t) * NBIG + PC_CZ + hu * 128 + j]); }
        } else {
            for (int e = tid; e < nb * 32; e += 512) { const int t = e >> 5, i = e & 31; const bf16_t* pr = proj + (size_t)(q.row0 + t0 + t) * NBIG; const int pidx = q.dec ? TP : (t0 + t);
                const float cs = rot[(pidx * 32 + i) * 2], sn = rot[(pidx * 32 + i) * 2 + 1];
                const float q1 = bf2f(pr[PC_DQ + hu * 64 + i]), q2 = bf2f(pr[PC_DQ + hu * 64 + 32 + i]), k1 = bf2f(pr[PC_DK + hu * 64 + i]), k2 = bf2f(pr[PC_DK + hu * 64 + 32 + i]);
                L[MixLds::QS + t * 128 + i] = q1 * cs - q2 * sn; L[MixLds::QS + t * 128 + 32 + i] = q2 * cs + q1 * sn;
                L[MixLds::KS + t * 128 + i] = (k1 * cs - k2 * sn) * 0.125f; L[MixLds::KS + t * 128 + 32 + i] = (k2 * cs + k1 * sn) * 0.125f; }
            for (int e = tid; e < nb * 64; e += 512) { const int t = e >> 6, d = e & 63; const bf16_t* pr = proj + (size_t)(q.row0 + t0 + t) * NBIG;
                L[MixLds::VS + t * 128 + d] = bf2f(pr[PC_DV + hu * 64 + d]); L[MixLds::ZS + t * 128 + d] = bf2f(pr[PC_DZ + hu * 64 + d]); }
            if (tid < nb) L[MixLds::DS + tid * 128] = hc0;
        }
        __syncthreads();
        recur_batch<DK, NV, MIX == 1, MIX == 0>(S, L, nb, wid, lane);
        __syncthreads();
        for (int t = wid; t < nb; t += 8) {
            const size_t yrow = (size_t)(q.row0 + t0 + t) * DM;
            if (MIX == 0 || MIX == 1) { const float o = L[MixLds::OS + t * 128 + lane]; const float ms = wave_sum(o * o, lane) * (1.0f / 64.0f);
                const float w = (MIX == 0 ? p.hgrn_norm_w : p.gdn_norm_w)[layer * 256 + hu * 64 + lane];
                y[yrow + (MIX == 0 ? 0 : 256) + hu * 64 + lane] = f2bf(o * rsqrtf(ms + EPSF) * w * silu_f(L[MixLds::ZS + t * 128 + lane])); }
            else if (MIX == 2) { float u[2]; float ss = 0.f;
#pragma unroll
                for (int r = 0; r < 2; ++r) { const int j = lane + 64 * r; const float o = L[MixLds::OS + t * 128 + j] + p.ssd_d[layer * 4 + hu * 2 + r] * L[MixLds::XS + t * 128 + j]; u[r] = o * silu_f(L[MixLds::ZS + t * 128 + j]); ss += u[r] * u[r]; }
                const float sc = rsqrtf(wave_sum(ss, lane) * (1.0f / 128.0f) + EPSF);
#pragma unroll
                for (int r = 0; r < 2; ++r) { const int j = lane + 64 * r; y[yrow + 512 + hu * 128 + j] = f2bf(u[r] * sc * p.ssd_norm_w[layer * 256 + hu * 128 + j]); } }
            else { const float o = L[MixLds::OS + t * 128 + lane]; const float mu = wave_sum(o, lane) * (1.0f / 64.0f); const float dv = o - mu; const float var = wave_sum(dv * dv, lane) * (1.0f / 64.0f);
                const int c = hu * 64 + lane;
                y[yrow + 768 + c] = f2bf((dv * rsqrtf(var + EPSF) * p.ret_norm_w[layer * 256 + c] + p.ret_norm_b[layer * 256 + c]) * silu_f(L[MixLds::ZS + t * 128 + lane])); }
        }
    }
    {
        float* so = p.out + (q.dec ? (MIX == 0 ? O_HGRN_S : MIX == 1 ? O_GDN_S : MIX == 2 ? O_SSD_S : O_RET_S) : (MIX == 0 ? O_HGRN_P : MIX == 1 ? O_GDN_P : MIX == 2 ? O_SSD_P : O_RET_P));
        const int nbt = q.dec ? DECB : NB;
#pragma unroll
        for (int i = 0; i < KR; ++i) so[(((size_t)layer * nbt + q.b) * 4 + head) * DK * 64 + (size_t)(kq * KR + i) * 64 + (vcol & 63)] = S[i];
    }
    if (MIX == 1 || MIX == 2) {
        float* co = p.out + (q.dec ? (MIX == 1 ? O_GCONV_S : O_SCONV_S) : (MIX == 1 ? O_GCONV_P : O_SCONV_P)) + ((size_t)layer * (q.dec ? DECB : NB) + q.b) * 3 * 768;
        const int nch = MIX == 1 ? 192 : 384;
        for (int e = tid; e < 3 * nch; e += 512) { const int r = e / nch, c = e % nch; int ch;
            if (MIX == 1) ch = (c >> 6) * 256 + hu * 64 + (c & 63); else ch = (c >> 7) * 256 + hu * 128 + (c & 127);
            co[r * 768 + ch] = preconv(proj, q, q.T - 3 + r, (MIX == 1 ? PC_BQKV : PC_CXBC) + ch, ctx, ch); }
    }
    (void)DVT;
}

constexpr int NCHUNK = 33;
constexpr int LDP = 72;
constexpr int LDP2 = 136;
constexpr int OSP = 68;
typedef short bf16x4 __attribute__((ext_vector_type(4)));
__device__ __forceinline__ f32x4 mfma16(bf16x8 a, bf16x8 b, f32x4 c) { return __builtin_amdgcn_mfma_f32_16x16x32_bf16(a, b, c, 0, 0, 0); }
__device__ __forceinline__ float fexp2(float x) { return __builtin_amdgcn_exp2f(x); }
__device__ __forceinline__ bf16x8 frag_ld(const LAS bf16_t* t, int pitch, int row, int col) { return *(const LAS bf16x8*)(t + row * pitch + col); }
__device__ __forceinline__ bf16x8 frag_ld_perm(const LAS bf16_t* t, int pitch, int row, int k0, int q) {
    const bf16x4 lo = *(const LAS bf16x4*)(t + row * pitch + k0 + 4 * q), hi = *(const LAS bf16x4*)(t + row * pitch + k0 + 16 + 4 * q);
    return __builtin_shufflevector(lo, hi, 0, 1, 2, 3, 4, 5, 6, 7);
}
__device__ __forceinline__ bf16x8 pack_acc2(const f32x4& a, const f32x4& b) {
    u32x4 w; w.x = pg8::cvt_pk_bf16(a[0], a[1]); w.y = pg8::cvt_pk_bf16(a[2], a[3]); w.z = pg8::cvt_pk_bf16(b[0], b[1]); w.w = pg8::cvt_pk_bf16(b[2], b[3]);
    return __builtin_bit_cast(bf16x8, w);
}
__device__ __forceinline__ void st_bf4(LAS bf16_t* dst, const f32x4& v) { u32x2 w; w.x = pg8::cvt_pk_bf16(v[0], v[1]); w.y = pg8::cvt_pk_bf16(v[2], v[3]); *(LAS u32x2*)dst = w; }
__device__ __forceinline__ void unpack_bf8(const u32x4& w, float* a) { const unsigned x[4] = {w.x, w.y, w.z, w.w};
#pragma unroll
    for (int k = 0; k < 4; ++k) { a[2 * k] = __uint_as_float(x[k] << 16); a[2 * k + 1] = __uint_as_float(x[k] & 0xffff0000u); } }
__device__ __forceinline__ u32x4 pack_bf8(const float* a) { u32x4 w; w.x = pg8::cvt_pk_bf16(a[0], a[1]); w.y = pg8::cvt_pk_bf16(a[2], a[3]); w.z = pg8::cvt_pk_bf16(a[4], a[5]); w.w = pg8::cvt_pk_bf16(a[6], a[7]); return w; }

constexpr size_t HR_QF = 0, HR_OI = 8192, HR_DS = 16384, HR_VEC = 24576, HR_UNIT = 25088;
constexpr size_t SS_QF = 0, SS_HEAD = 16384  , SS_VEC = 65536  , SS_UNIT = 66560;
constexpr size_t GD_U = 0, GD_W = 8192, GD_Q = 16384, GD_P = 24576, GD_K = 32768, GD_VEC = 40960, GD_UNIT = 41728;
constexpr size_t YOFF_R = 37748736;
static_assert((size_t)NB * NCHUNK * 2 * SS_UNIT <= YOFF_R && YOFF_R + (size_t)NB * NCHUNK * 4 * HR_UNIT <= (size_t)NB * SEQ * DM * 4 && (size_t)NB * NCHUNK * 4 * HR_UNIT <= (size_t)MROWS * DM * 2 && (size_t)NB * NCHUNK * 4 * GD_UNIT == WS_END - WS_E, "scratch map");
__device__ __forceinline__ unsigned char* rec_hgrn(const Params& p, int b, int c, int h) { return p.ws + WS_HB + (size_t)((b * NCHUNK + c) * 4 + h) * HR_UNIT; }
__device__ __forceinline__ unsigned char* rec_ret(const Params& p, int b, int c, int h) { return (unsigned char*)(p.out + O_YP) + YOFF_R + (size_t)((b * NCHUNK + c) * 4 + h) * HR_UNIT; }
__device__ __forceinline__ unsigned char* rec_gdn(const Params& p, int b, int c, int h) { return p.ws + WS_E + (size_t)((b * NCHUNK + c) * 4 + h) * GD_UNIT; }
__device__ __forceinline__ unsigned char* rec_ssd(const Params& p, int b, int c, int g) { return (unsigned char*)(p.out + O_YP) + (size_t)((b * NCHUNK + c) * 2 + g) * SS_UNIT; }
__device__ __forceinline__ bf16x8 frag_scale(const bf16x8& f, const float (&sc)[8]) { const u32x4 w = __builtin_bit_cast(u32x4, f); float a[8]; unpack_bf8(w, a);
#pragma unroll
    for (int e = 0; e < 8; ++e) a[e] *= sc[e];
    return __builtin_bit_cast(bf16x8, pack_bf8(a)); }
__device__ __forceinline__ void st_acc_bf4(unsigned char* dst, const f32x4& v) { u32x2 w; w.x = pg8::cvt_pk_bf16(v[0], v[1]); w.y = pg8::cvt_pk_bf16(v[2], v[3]); *(u32x2*)dst = w; }
__device__ __forceinline__ f32x4 ld_acc_bf4(const unsigned char* src) { const u32x2 w = *(const u32x2*)src; return (f32x4){__uint_as_float(w.x << 16), __uint_as_float(w.x & 0xffff0000u), __uint_as_float(w.y << 16), __uint_as_float(w.y & 0xffff0000u)}; }

struct RetLds { static constexpr int QS = 0, KS = QS + 64 * LDP * 2, KT = KS + 64 * LDP * 2, VT = KT + 64 * LDP * 2, VH = VT + 64 * LDP * 2, PS = VH + 64 * LDP * 2, END = PS + 64 * LDP * 2; };
__device__ void ret_pre_unit(const Params& p, int layer, int b, int c, int hu, LAS unsigned char* lds) {
    const int tid = opaque_tid(), wid = tid >> 6, lane = tid & 63, fq = lane >> 4, fc = lane & 15;
    LAS bf16_t* Qs = (LAS bf16_t*)(lds + RetLds::QS); LAS bf16_t* Ks = (LAS bf16_t*)(lds + RetLds::KS); LAS bf16_t* KT = (LAS bf16_t*)(lds + RetLds::KT);
    LAS bf16_t* VT = (LAS bf16_t*)(lds + RetLds::VT); LAS bf16_t* VH = (LAS bf16_t*)(lds + RetLds::VH); LAS bf16_t* Ps = (LAS bf16_t*)(lds + RetLds::PS);
    const bf16_t* proj = (const bf16_t*)(p.ws + WS_PROJ); const float* rot = (const float*)(p.ws + WS_ROT);
    const float lg2 = log2f(1.0f - exp2f(-5.0f - (float)hu));
    const int i0 = c == 0 ? 48 : 0, t0 = 64 * c - 48, nlast = 64 - i0;
    unsigned char* rec = rec_ret(p, b, c, hu);
    __syncthreads();
#pragma unroll
    for (int n_ = 0; n_ < 4; ++n_) { const int e = tid + 512 * n_; const int i = e >> 5, d = e & 31; float qa, qb, ka, kb;
        { const int tc = max(t0 + i, 0); const bf16_t* pr = proj + (size_t)(b * TP + tc) * NBIG; const float cs = rot[(tc * 32 + d) * 2], sn = rot[(tc * 32 + d) * 2 + 1];
            const float q1 = bf2f(pr[PC_DQ + hu * 64 + d]), q2 = bf2f(pr[PC_DQ + hu * 64 + 32 + d]), k1 = bf2f(pr[PC_DK + hu * 64 + d]), k2 = bf2f(pr[PC_DK + hu * 64 + 32 + d]);
            const float mk = i >= i0 ? 1.0f : 0.0f;
            qa = (q1 * cs - q2 * sn) * mk; qb = (q2 * cs + q1 * sn) * mk; ka = (k1 * cs - k2 * sn) * (0.125f * mk); kb = (k2 * cs + k1 * sn) * (0.125f * mk); }
        Qs[i * LDP + d] = f2bf(qa); Qs[i * LDP + 32 + d] = f2bf(qb); Ks[i * LDP + d] = f2bf(ka); Ks[i * LDP + 32 + d] = f2bf(kb);
        KT[d * LDP + i] = f2bf(ka); KT[(d + 32) * LDP + i] = f2bf(kb); }
#pragma unroll
    for (int n_ = 0; n_ < 8; ++n_) { const int e = tid + 512 * n_; const int i = e >> 6, d = e & 63;
        float v = bf2f(proj[(size_t)(b * TP + max(t0 + i, 0)) * NBIG + PC_DV + hu * 64 + d]); v = i >= i0 ? v : 0.f; const float vh = v * fexp2((float)(63 - i) * lg2);
        VT[d * LDP + i] = f2bf(v); VH[d * LDP + i] = f2bf(vh); }
    __syncthreads();
#pragma unroll
    for (int tt = 0; tt < 2; ++tt) { const int t = wid * 2 + tt, I = t >> 2, J = t & 3; f32x4 acc = (f32x4){0.f, 0.f, 0.f, 0.f};
        if (J <= I) {
#pragma unroll
            for (int s = 0; s < 2; ++s) acc = mfma16(frag_ld(Ks, LDP, 16 * J + fc, 32 * s + 8 * fq), frag_ld(Qs, LDP, 16 * I + fc, 32 * s + 8 * fq), acc); }
        const int i = 16 * I + fc;
#pragma unroll
        for (int r = 0; r < 4; ++r) { const int j = 16 * J + 4 * fq + r; acc[r] = (j <= i && j >= i0) ? acc[r] * fexp2((float)(i - j) * lg2) : 0.f; }
        st_bf4(Ps + i * LDP + 16 * J + 4 * fq, acc); }
    __syncthreads();
    { const int w = wid & 3; bf16x8 bb[2];
#pragma unroll
        for (int s = 0; s < 2; ++s) bb[s] = frag_ld(wid < 4 ? VT : VH, LDP, 16 * w + fc, 32 * s + 8 * fq);
        const LAS bf16_t* At = wid < 4 ? Ps : KT; unsigned char* dst = rec + (wid < 4 ? HR_OI : HR_DS);
#pragma unroll
        for (int m = 0; m < 4; ++m) { f32x4 acc = (f32x4){0.f, 0.f, 0.f, 0.f};
#pragma unroll
            for (int s = 0; s < 2; ++s) acc = mfma16(frag_ld(At, LDP, 16 * m + fc, 32 * s + 8 * fq), bb[s], acc);
            st_acc_bf4(dst + ((size_t)(w * 4 + m) * 64 + lane) * 8, acc); }
        { const float eg = fexp2((float)max(16 * (wid >> 1) + fc - i0 + 1, 0) * lg2); const float sc[8] = {eg, eg, eg, eg, eg, eg, eg, eg};
            *(bf16x8*)(rec + HR_QF + ((size_t)wid * 64 + lane) * 16) = frag_scale(frag_ld_perm(Qs, LDP, 16 * (wid >> 1) + fc, 32 * (wid & 1), fq), sc); }
        if (tid < 64) { float* gv = (float*)(rec + HR_VEC); gv[64 + tid] = fexp2((float)nlast * lg2); } }
}

struct HgLds { static constexpr int LS = 0  , KR = LS + 16384  , QR = KR + 16384  , QT = QR + 16384, QH = QT + 64 * LDP * 2, KT = QH + 64 * LDP * 2  ,
    KHT = KT + 160 * LDP * 2, VT = KHT + 64 * LDP * 2, PS = VT + 64 * LDP * 2, AV = PS + 64 * LDP * 2, END = AV + 256; };
__device__ void hgrn_pre_unit(const Params& p, int layer, int b, int c, int hu, LAS unsigned char* lds) {
    const int tid = opaque_tid(), wid = tid >> 6, lane = tid & 63, fq = lane >> 4, fc = lane & 15;
    LAS float* Ls = (LAS float*)(lds + HgLds::LS); LAS float* Kr = (LAS float*)(lds + HgLds::KR); LAS float* Qr = (LAS float*)(lds + HgLds::QR);
    LAS bf16_t* Qt = (LAS bf16_t*)(lds + HgLds::QT); LAS bf16_t* Qh = (LAS bf16_t*)(lds + HgLds::QH); LAS bf16_t* Kt = (LAS bf16_t*)(lds + HgLds::KT); LAS bf16_t* KhT = (LAS bf16_t*)(lds + HgLds::KHT);
    LAS bf16_t* VT = (LAS bf16_t*)(lds + HgLds::VT); LAS bf16_t* Ps = (LAS bf16_t*)(lds + HgLds::PS); LAS float* Av = (LAS float*)(lds + HgLds::AV);
    const bf16_t* proj = (const bf16_t*)(p.ws + WS_PROJ);
    const float lbv = ((const float*)(p.ws + WS_LB))[layer * 256 + hu * 64 + lane];
    const int i0 = c == 0 ? 48 : 0, t0 = 64 * c - 48;
    unsigned char* rec = rec_hgrn(p, b, c, hu);
    __syncthreads();
    if (wid < 4) { float acc = 0.f; float afr[16];
#pragma unroll
        for (int ii = 0; ii < 16; ++ii) { const int i = 16 * wid + ii; afr[ii] = bf2f(proj[(size_t)(b * TP + max(t0 + i, 0)) * NBIG + PC_AF + hu * 64 + lane]); }
#pragma unroll
        for (int ii = 0; ii < 16; ++ii) { const int i = 16 * wid + ii; float kk;
            { float af = afr[ii]; af = fminf(fmaxf(af, -30.f), 30.f);
                const float e = __expf(-af), sg = __builtin_amdgcn_rcpf(1.0f + e); const float f = lbv + (1.0f - lbv) * sg; const bool ok = i >= i0; kk = ok ? (1.0f - lbv) * e * sg : 0.f; acc += ok ? __log2f(fmaxf(f, 1e-30f)) : 0.f; }
            Ls[i * 64 + lane] = acc; Kr[i * 64 + lane] = kk; } }
    else {
#pragma unroll
        for (int n_ = 0; n_ < 16; ++n_) { const int e = tid - 256 + 256 * n_; const int i = e >> 6, d = e & 63;
            const bf16_t* pr = proj + (size_t)(b * TP + max(t0 + i, 0)) * NBIG; float q = silu_f(bf2f(pr[PC_AQ + hu * 64 + d])) * 0.125f, v = bf2f(pr[PC_AI + hu * 64 + d]); if (i < i0) { q = 0.f; v = 0.f; }
            Qr[i * 64 + d] = q; VT[d * LDP + i] = f2bf(v); } }
    __syncthreads();
#pragma unroll 2
    for (int n_ = 0; n_ < 8; ++n_) { const int e = tid + 512 * n_; const int i = e >> 6, d = e & 63, I = i >> 4;
        const float T0 = Ls[15 * 64 + d], T1 = Ls[31 * 64 + d], T2 = Ls[47 * 64 + d], T3 = Ls[63 * 64 + d];
        const float Bi = I == 0 ? 0.f : I == 1 ? T0 : I == 2 ? T0 + T1 : T0 + T1 + T2; const float Li = Ls[i * 64 + d], Gi = Bi + Li, Gl = T0 + T1 + T2 + T3;
        const float q = Qr[i * 64 + d], k = Kr[i * 64 + d];
        Qt[i * LDP + d] = f2bf(q * fexp2(Li)); Qh[i * LDP + d] = f2bf(q * fexp2(Gi)); KhT[d * LDP + i] = f2bf(k * fexp2(Gl - Gi));
        float Bp = Bi;
        Kt[((I == 0 ? 0 : I == 1 ? 16 : I == 2 ? 48 : 96) + i) * LDP + d] = f2bf(k * fexp2(Bp - Gi));
        if (I <= 0) { Bp = T0; Kt[(16 + i) * LDP + d] = f2bf(k * fexp2(Bp - Gi)); }
        if (I <= 1) { Bp = T0 + T1; Kt[(48 + i) * LDP + d] = f2bf(k * fexp2(Bp - Gi)); }
        if (I <= 2) { Bp = T0 + T1 + T2; Kt[(96 + i) * LDP + d] = f2bf(k * fexp2(Bp - Gi)); }
        if (i == 0) Av[d] = fexp2(Gl); }
    __syncthreads();
#pragma unroll
    for (int tt = 0; tt < 2; ++tt) { const int t = wid * 2 + tt, I = t >> 2, J = t & 3; f32x4 acc = (f32x4){0.f, 0.f, 0.f, 0.f};
        if (J <= I) { const int kb = (I == 0 ? 0 : I == 1 ? 16 : I == 2 ? 48 : 96) + 16 * J;
#pragma unroll
            for (int s = 0; s < 2; ++s) acc = mfma16(frag_ld(Kt, LDP, kb + fc, 32 * s + 8 * fq), frag_ld(Qt, LDP, 16 * I + fc, 32 * s + 8 * fq), acc); }
        const int i = 16 * I + fc;
#pragma unroll
        for (int r = 0; r < 4; ++r) { const int j = 16 * J + 4 * fq + r; acc[r] = (j <= i) ? acc[r] : 0.f; }
        st_bf4(Ps + i * LDP + 16 * J + 4 * fq, acc); }
    __syncthreads();
    { const int w = wid & 3; bf16x8 bb[2];
#pragma unroll
        for (int s = 0; s < 2; ++s) bb[s] = frag_ld(VT, LDP, 16 * w + fc, 32 * s + 8 * fq);
        const LAS bf16_t* At = wid < 4 ? Ps : KhT; unsigned char* dst = rec + (wid < 4 ? HR_OI : HR_DS);
#pragma unroll
        for (int m = 0; m < 4; ++m) { f32x4 acc = (f32x4){0.f, 0.f, 0.f, 0.f};
#pragma unroll
            for (int s = 0; s < 2; ++s) acc = mfma16(frag_ld(At, LDP, 16 * m + fc, 32 * s + 8 * fq), bb[s], acc);
            st_acc_bf4(dst + ((size_t)(w * 4 + m) * 64 + lane) * 8, acc); }
        *(bf16x8*)(rec + HR_QF + ((size_t)wid * 64 + lane) * 16) = frag_ld_perm(Qh, LDP, 16 * (wid >> 1) + fc, 32 * (wid & 1), fq);
        if (tid < 64) { float* gv = (float*)(rec + HR_VEC); gv[64 + tid] = Av[tid]; } }
}

struct SsdLds { static constexpr int CS = 0, BS = CS + 64 * LDP2 * 2, BT = BS + 64 * LDP2 * 2, XS = BT + 128 * LDP * 2, VT = XS + 64 * LDP2 * 2  , VH = VT + 2 * 64 * LDP * 2, PS = VH + 2 * 64 * LDP * 2  ,
    DT = PS + 67 * 384 * 2  , GV = DT + 512, END = GV + 512; };
constexpr int SSD_NPIECE = 67 * 48;
__device__ void ssd_pre_unit(const Params& p, int layer, int b, int c, int gg, LAS unsigned char* lds) {
    const int tid = opaque_tid(), wid = tid >> 6, lane = tid & 63, fq = lane >> 4, fc = lane & 15;
    LAS bf16_t* Cs = (LAS bf16_t*)(lds + SsdLds::CS); LAS bf16_t* Bs = (LAS bf16_t*)(lds + SsdLds::BS); LAS bf16_t* BT = (LAS bf16_t*)(lds + SsdLds::BT); LAS bf16_t* Xs = (LAS bf16_t*)(lds + SsdLds::XS);
    LAS bf16_t* VT = (LAS bf16_t*)(lds + SsdLds::VT); LAS bf16_t* VH = (LAS bf16_t*)(lds + SsdLds::VH); LAS bf16_t* Ps = (LAS bf16_t*)(lds + SsdLds::PS); LAS bf16_t* RawT = Ps;
    LAS float* DTv = (LAS float*)(lds + SsdLds::DT); LAS float* Gv = (LAS float*)(lds + SsdLds::GV);
    const bf16_t* projb = (const bf16_t*)(p.ws + WS_PROJ) + (size_t)(b * TP) * NBIG; const float* psmb = (const float*)(p.ws + WS_PSM) + (size_t)(b * TP) * NSM;
    const float* cw = p.ssd_conv_w + (size_t)layer * 4 * 768; const float* cb = p.ssd_conv_b + (size_t)layer * 768;
    constexpr float L2E = 1.4426950408889634f;
    const int hh = wid >> 2, ws = wid & 3;
    const int i0 = c == 0 ? 48 : 0, t0 = 64 * c - 48;
    unsigned char* rec = rec_ssd(p, b, c, gg);
    u32x4 raw[7];
#pragma unroll
    for (int k = 0; k < 7; ++k) { const int id = min(tid + 512 * k, SSD_NPIECE - 1), row = id / 48, seg = id % 48, t = t0 - 3 + row;
        const u32x4 v = *(const u32x4*)(projb + (size_t)max(t, 0) * NBIG + PC_CXBC + (seg >> 4) * 256 + gg * 128 + (seg & 15) * 8);
        raw[k] = t >= 0 ? v : (u32x4){0u, 0u, 0u, 0u}; }
    const float psmv = psmb[(size_t)max(t0 + lane, 0) * NSM + 8 + gg * 2 + (wid & 1)];
    __syncthreads();
    if (wid < 2) { const int hd = gg * 2 + wid;
        float dt = softplus_f(psmv + p.ssd_dt_bias[layer * 4 + hd]); dt = lane >= i0 ? dt : 0.f;
        float G = -dt * __expf(p.ssd_a_log[layer * 4 + hd]) * L2E;
#pragma unroll
        for (int o = 1; o < 64; o <<= 1) { const float t = lane_up(G, o, lane); if (lane >= o) G += t; }
        DTv[wid * 64 + lane] = dt; Gv[wid * 64 + lane] = G; }
#pragma unroll
    for (int k = 0; k < 7; ++k) { const int id = tid + 512 * k; if (id < SSD_NPIECE) *(LAS u32x4*)(RawT + (id / 48) * 384 + (id % 48) * 8) = raw[k]; }
    __syncthreads();
#pragma unroll 1
    for (int n = 0; n < 3; ++n) { const int e = tid + 512 * n, ch = e % 384, tr = e / 384, part = ch >> 7, j = ch & 127, chf = part * 256 + gg * 128 + j;
        const float w0 = cw[chf], w1 = cw[768 + chf], w2 = cw[2 * 768 + chf], w3 = cw[3 * 768 + chf], bias = cb[chf];
#pragma unroll
        for (int hf = 0; hf < 2; ++hf) { const int ib = 16 * tr + 8 * hf; float a[8], rw[11];
#pragma unroll
            for (int ii = 0; ii < 11; ++ii) rw[ii] = bf2f(RawT[(ib + ii) * 384 + ch]);
#pragma unroll
            for (int ii = 0; ii < 8; ++ii) { a[ii] = silu_f(bias + w0 * rw[ii] + w1 * rw[ii + 1] + w2 * rw[ii + 2] + w3 * rw[ii + 3]); if (ib + ii < i0) a[ii] = 0.f; }
            if (part == 0) { const int h2 = j >> 6, d = j & 63; const float gl = Gv[h2 * 64 + 63]; float xh[8];
#pragma unroll
                for (int ii = 0; ii < 8; ++ii) { const int i = ib + ii; Xs[i * LDP2 + j] = f2bf(a[ii]); a[ii] *= DTv[h2 * 64 + i]; xh[ii] = a[ii] * fexp2(gl - Gv[h2 * 64 + i]); }
                *(LAS u32x4*)(VT + (h2 * 64 + d) * LDP + ib) = pack_bf8(a); *(LAS u32x4*)(VH + (h2 * 64 + d) * LDP + ib) = pack_bf8(xh); }
            else if (part == 1) {
#pragma unroll
                for (int ii = 0; ii < 8; ++ii) Bs[(ib + ii) * LDP2 + j] = f2bf(a[ii]);
                *(LAS u32x4*)(BT + j * LDP + ib) = pack_bf8(a); }
            else {
#pragma unroll
                for (int ii = 0; ii < 8; ++ii) Cs[(ib + ii) * LDP2 + j] = f2bf(a[ii]); } } }
    __syncthreads();
#pragma unroll
    for (int tt = 0; tt < 2; ++tt) { const int t = wid * 2 + tt, I = t >> 2, J = t & 3; f32x4 acc = (f32x4){0.f, 0.f, 0.f, 0.f};
        if (J <= I) {
#pragma unroll
            for (int s = 0; s < 4; ++s) acc = mfma16(frag_ld(Bs, LDP2, 16 * J + fc, 32 * s + 8 * fq), frag_ld(Cs, LDP2, 16 * I + fc, 32 * s + 8 * fq), acc); }
        const int i = 16 * I + fc;
#pragma unroll
        for (int h2 = 0; h2 < 2; ++h2) { f32x4 pv; const float gi = Gv[h2 * 64 + i];
#pragma unroll
            for (int r = 0; r < 4; ++r) { const int j = 16 * J + 4 * fq + r; pv[r] = (j <= i && j >= i0) ? acc[r] * fexp2(gi - Gv[h2 * 64 + j]) : 0.f; }
            st_bf4(Ps + (h2 * 64 + i) * LDP + 16 * J + 4 * fq, pv); } }
    __syncthreads();
    { bf16x8 bv[2], bh[2]; unsigned char* hrec = rec + SS_HEAD + (size_t)hh * 24576; const float dsk = p.ssd_d[layer * 4 + gg * 2 + hh];
#pragma unroll
        for (int s = 0; s < 2; ++s) { bv[s] = frag_ld(VT, LDP, hh * 64 + 16 * ws + fc, 32 * s + 8 * fq); bh[s] = frag_ld(VH, LDP, hh * 64 + 16 * ws + fc, 32 * s + 8 * fq); }
#pragma unroll
        for (int mi = 0; mi < 4; ++mi) { f32x4 o1 = (f32x4){0.f, 0.f, 0.f, 0.f};
#pragma unroll
            for (int s = 0; s < 2; ++s) o1 = mfma16(frag_ld(Ps, LDP, hh * 64 + 16 * mi + fc, 32 * s + 8 * fq), bv[s], o1);
#pragma unroll
            for (int r = 0; r < 4; ++r) o1[r] += dsk * bf2f(Xs[(16 * mi + 4 * fq + r) * LDP2 + hh * 64 + 16 * ws + fc]);
            st_acc_bf4(hrec + ((size_t)(ws * 4 + mi) * 64 + lane) * 8, o1); }
#pragma unroll
        for (int m = 0; m < 8; ++m) { f32x4 d = (f32x4){0.f, 0.f, 0.f, 0.f};
#pragma unroll
            for (int s = 0; s < 2; ++s) d = mfma16(frag_ld(BT, LDP, 16 * m + fc, 32 * s + 8 * fq), bh[s], d);
            st_acc_bf4(hrec + 8192 + ((size_t)(ws * 8 + m) * 64 + lane) * 8, d); }
#pragma unroll
        for (int x = 0; x < 2; ++x) { const int sl = wid * 2 + x; *(bf16x8*)(rec + SS_QF + ((size_t)sl * 64 + lane) * 16) = frag_ld_perm(Cs, LDP2, 16 * (sl >> 2) + fc, 32 * (sl & 3), fq); }
        if (tid < 128) { float* gv = (float*)(rec + SS_VEC + (size_t)(tid >> 6) * 512); gv[tid & 63] = fexp2(Gv[tid]); if ((tid & 63) == 0) gv[64] = fexp2(Gv[(tid >> 6) * 64 + 63]); } }
}

struct GdLds { static constexpr int QF = 0, KF = 16384, VF = 32768, QN = 49152, KN = QN + 64 * LDP * 2, KNT = KN + 64 * LDP * 2, NM = KNT + 64 * LDP * 2, QK = NM + 64 * LDP * 2, WT = QK + 64 * LDP * 2,
    MD = WT + 64 * LDP * 2  , TD = MD + 4096  , GV = TD + 2048, BV = GV + 256, END = BV + 256; };
__device__ void gdn_pre_unit(const Params& p, int layer, int b, int c, int hu, LAS unsigned char* lds) {
    const int tid = opaque_tid(), wid = tid >> 6, lane = tid & 63, fq = lane >> 4, fc = lane & 15;
    LAS float* Qf = (LAS float*)(lds + GdLds::QF); LAS float* Kf = (LAS float*)(lds + GdLds::KF); LAS float* Vf = (LAS float*)(lds + GdLds::VF);
    LAS bf16_t* Qn = (LAS bf16_t*)(lds + GdLds::QN); LAS bf16_t* Kn = (LAS bf16_t*)(lds + GdLds::KN); LAS bf16_t* KnT = (LAS bf16_t*)(lds + GdLds::KNT);
    LAS bf16_t* NM = (LAS bf16_t*)(lds + GdLds::NM); LAS bf16_t* QK = (LAS bf16_t*)(lds + GdLds::QK); LAS bf16_t* Wt = (LAS bf16_t*)(lds + GdLds::WT);
    LAS float* MD = (LAS float*)(lds + GdLds::MD); LAS bf16_t* TD = (LAS bf16_t*)(lds + GdLds::TD); LAS float* Gv = (LAS float*)(lds + GdLds::GV); LAS float* Bv = (LAS float*)(lds + GdLds::BV);
    const bf16_t* proj = (const bf16_t*)(p.ws + WS_PROJ); const float* psm = (const float*)(p.ws + WS_PSM);
    const float* cw = p.gdn_conv_w + (size_t)layer * 4 * 768;
    unsigned char* gd = rec_gdn(p, b, c, hu);
    constexpr float L2E = 1.4426950408889634f;
    const int i0 = c == 0 ? 48 : 0, t0 = 64 * c - 48;
    __syncthreads();
    if (wid == 0) { const float* ps = psm + (size_t)(b * TP + max(t0 + lane, 0)) * NSM;
        float g = -__expf(p.gdn_a_log[layer * 4 + hu]) * softplus_f(ps[hu] + p.gdn_dt_bias[layer * 4 + hu]) * L2E, be = sigmoid_f(ps[4 + hu]); if (lane < i0) { g = 0.f; be = 0.f; }
#pragma unroll
        for (int o = 1; o < 64; o <<= 1) { const float t = lane_up(g, o, lane); if (lane >= o) g += t; }
        Gv[lane] = g; Bv[lane] = be; }
#pragma unroll
    for (int n_ = 0; n_ < 3; ++n_) { const int e = tid + 512 * n_; const int ch = e % 192, tr = e / 192, part = ch >> 6, d = ch & 63, chf = part * 256 + hu * 64 + d;
        const bf16_t* col = proj + (size_t)(b * TP) * NBIG + PC_BQKV + chf;
        const float w0 = cw[chf], w1 = cw[768 + chf], w2 = cw[2 * 768 + chf], w3 = cw[3 * 768 + chf];
        const int ts = t0 + 8 * tr;
        float raw[11];
#pragma unroll
        for (int ii = 0; ii < 11; ++ii) { const int t = ts - 3 + ii; const float v = bf2f(col[(size_t)max(t, 0) * NBIG]); raw[ii] = t >= 0 ? v : 0.f; }
        LAS float* dst = part == 0 ? Qf : part == 1 ? Kf : Vf;
#pragma unroll
        for (int ii = 0; ii < 8; ++ii) { const int i = 8 * tr + ii;
            float a = silu_f(w0 * raw[ii] + w1 * raw[ii + 1] + w2 * raw[ii + 2] + w3 * raw[ii + 3]); if (i < i0) a = 0.f;
            dst[i * 64 + d] = a; } }
    __syncthreads();
    { const int ri = tid >> 3, sg = tid & 7; float q[8], k[8], sq = 0.f, sk = 0.f;
#pragma unroll
        for (int x = 0; x < 8; ++x) { q[x] = Qf[ri * 64 + sg * 8 + x]; k[x] = Kf[ri * 64 + sg * 8 + x]; sq += q[x] * q[x]; sk += k[x] * k[x]; }
        sq += lane_xor(sq, 1, lane); sq += lane_xor(sq, 2, lane); sq += lane_xor(sq, 4, lane); sk += lane_xor(sk, 1, lane); sk += lane_xor(sk, 2, lane); sk += lane_xor(sk, 4, lane);
        const float rq = rsqrtf(sq + EPSF) * 0.125f, rk = rsqrtf(sk + EPSF);
#pragma unroll
        for (int x = 0; x < 8; ++x) { q[x] *= rq; k[x] *= rk; Kf[ri * 64 + sg * 8 + x] = k[x]; KnT[(sg * 8 + x) * LDP + ri] = f2bf(k[x]); }
        *(LAS u32x4*)(Qn + ri * LDP + sg * 8) = pack_bf8(q); *(LAS u32x4*)(Kn + ri * LDP + sg * 8) = pack_bf8(k); }
    __syncthreads();
#pragma unroll
    for (int tt = 0; tt < 2; ++tt) { const int t = wid * 2 + tt, I = t >> 2, J = t & 3; f32x4 a1 = (f32x4){0.f, 0.f, 0.f, 0.f}, a2 = (f32x4){0.f, 0.f, 0.f, 0.f};
        if (J <= I) {
#pragma unroll
            for (int s = 0; s < 2; ++s) { const bf16x8 kj = frag_ld(Kn, LDP, 16 * J + fc, 32 * s + 8 * fq); a1 = mfma16(kj, frag_ld(Kn, LDP, 16 * I + fc, 32 * s + 8 * fq), a1); a2 = mfma16(kj, frag_ld(Qn, LDP, 16 * I + fc, 32 * s + 8 * fq), a2); } }
        const int i = 16 * I + fc; const float gi = Gv[i], bi = Bv[i]; f32x4 nm, qk;
#pragma unroll
        for (int r = 0; r < 4; ++r) { const int j = 16 * J + 4 * fq + r; const float dec = j <= i ? fexp2(gi - Gv[j]) : 0.f; const float mm = j < i ? a1[r] * dec * bi : 0.f; nm[r] = -mm; qk[r] = a2[r] * dec;
            if (J == I) MD[(I * 16 + fc) * 16 + 4 * fq + r] = mm; }
        st_bf4(NM + i * LDP + 16 * J + 4 * fq, nm); st_bf4(QK + i * LDP + 16 * J + 4 * fq, qk); }
    __syncthreads();
    if (wid == 0) { const int I = fq, cc = fc; float x[16];
#pragma unroll
        for (int i = 0; i < 16; ++i) { float acc = (i == cc) ? 1.0f : 0.0f;
#pragma unroll
            for (int j = 0; j < i; ++j) acc -= MD[(I * 16 + i) * 16 + j] * x[j];
            x[i] = acc; TD[(I * 16 + i) * 16 + cc] = f2bf(acc); } }
    __syncthreads();
    const int isW = wid >> 2, ws = wid & 3, colx = 16 * ws + fc;
    const LAS float* rhs = isW ? Kf : Vf;
    f32x4 X[4];
    const f32x4 zero4 = (f32x4){0.f, 0.f, 0.f, 0.f};
#pragma unroll
    for (int I = 0; I < 4; ++I) { f32x4 acc;
#pragma unroll
        for (int r = 0; r < 4; ++r) { const int j = 16 * I + 4 * fq + r; const float sc = Bv[j] * (isW ? fexp2(Gv[j]) : 1.0f); acc[r] = sc * rhs[j * 64 + colx]; }
        if (I >= 1) acc = mfma16(frag_ld_perm(NM, LDP, 16 * I + fc, 0, fq), pack_acc2(X[0], I > 1 ? X[1] : zero4), acc);
        if (I == 3) acc = mfma16(frag_ld_perm(NM, LDP, 48 + fc, 32, fq), pack_acc2(X[2], zero4), acc);
        const bf16x4 tlo = *(const LAS bf16x4*)(TD + (I * 16 + fc) * 16 + 4 * fq); const bf16x4 z4 = (bf16x4){0, 0, 0, 0};
        X[I] = mfma16(__builtin_shufflevector(tlo, z4, 0, 1, 2, 3, 4, 5, 6, 7), pack_acc2(acc, zero4), zero4); }
    if (!isW) {
#pragma unroll
        for (int m = 0; m < 4; ++m) st_acc_bf4(gd + GD_U + ((size_t)(ws * 4 + m) * 64 + lane) * 8, X[m]); }
    else {
#pragma unroll
        for (int m = 0; m < 4; ++m)
#pragma unroll
            for (int r = 0; r < 4; ++r) Wt[(16 * m + 4 * fq + r) * LDP + colx] = f2bf(-X[m][r]); }
    __syncthreads();
    { const int tsel = wid >> 1; const LAS bf16_t* tile = tsel == 0 ? Wt : tsel == 1 ? Qn : tsel == 2 ? QK : KnT; unsigned char* dst = gd + (tsel == 0 ? GD_W : tsel == 1 ? GD_Q : tsel == 2 ? GD_P : GD_K);
#pragma unroll
        for (int x = 0; x < 4; ++x) { const int sl = (wid & 1) * 4 + x, m = sl >> 1, s = sl & 1; bf16x8 f = frag_ld_perm(tile, LDP, 16 * m + fc, 32 * s, fq);
            if (tsel == 1) { const float eg = fexp2(Gv[16 * m + fc]); const float sc[8] = {eg, eg, eg, eg, eg, eg, eg, eg}; f = frag_scale(f, sc); }
            if (tsel == 3) { float sc[8];
#pragma unroll
                for (int e = 0; e < 8; ++e) sc[e] = fexp2(Gv[63] - Gv[32 * s + 16 * (e >> 2) + 4 * fq + (e & 3)]);
                f = frag_scale(f, sc); }
            *(bf16x8*)(dst + ((size_t)sl * 64 + lane) * 16) = f; } }
    if (tid == 0) { float* gv = (float*)(gd + GD_VEC); gv[128] = fexp2(Gv[63]); }
}

template <int MIX> struct SeqRegs {
    static constexpr int DK = MIX == 2 ? 128 : 64, NT = DK / 16, NS = DK / 32;
    bf16x8 qf[MIX == 2 ? 2 : 4 * NS]; u32x2 oi[4]; u32x2 ds[NT]; f32x4 eg[MIX == 2 ? 4 : 1]; f32x4 al[MIX == 0 ? 4 : 1];
    __device__ __forceinline__ void load(const Params& p, int b, int c, int hp, int hsel, int hd, int ws, int lane, int fq, int wid = 0, int cq = -1) {
        const unsigned char* base = MIX == 2 ? rec_ssd(p, b, c, hp) : MIX == 0 ? rec_hgrn(p, b, c, hd) : rec_ret(p, b, c, hd);
        const unsigned char* q = (MIX == 2 && cq >= 0 ? rec_ssd(p, b, cq, hp) : base) + (MIX == 2 ? SS_QF : HR_QF); const unsigned char* o = MIX == 2 ? base + SS_HEAD + (size_t)hsel * 24576 : base + HR_OI;
        const unsigned char* d = MIX == 2 ? o + 8192 : base + HR_DS; const float* gv = (const float*)(MIX == 2 ? base + SS_VEC + (size_t)hsel * 512 : base + HR_VEC);
#pragma unroll
        for (int x = 0; x < (MIX == 2 ? 2 : 4 * NS); ++x) qf[x] = *(const bf16x8*)(q + ((size_t)(MIX == 2 ? 2 * wid + x : x) * 64 + lane) * 16);
#pragma unroll
        for (int mi = 0; mi < 4; ++mi) { oi[mi] = *(const u32x2*)(o + ((size_t)(ws * 4 + mi) * 64 + lane) * 8); if (MIX == 2) eg[mi] = *(const f32x4*)(gv + 16 * mi + 4 * fq); }
#pragma unroll
        for (int m = 0; m < NT; ++m) ds[m] = *(const u32x2*)(d + ((size_t)(ws * NT + m) * 64 + lane) * 8);
#pragma unroll
        for (int m = 0; m < (MIX == 0 ? 4 : 1); ++m) al[m] = MIX == 0 ? *(const f32x4*)(gv + 64 + 16 * m + 4 * fq) : (f32x4){gv[64], 0.f, 0.f, 0.f};
    }
};
__device__ __forceinline__ f32x4 unpack_acc(const u32x2& w) { return (f32x4){__uint_as_float(w.x << 16), __uint_as_float(w.x & 0xffff0000u), __uint_as_float(w.y << 16), __uint_as_float(w.y & 0xffff0000u)}; }
struct GdRegs { bf16x8 w[8], pq[8], qq[8], kk[8]; u32x2 u0[4]; float al;
    __device__ __forceinline__ void load_a(const unsigned char* gd, int ws, int lane) {
#pragma unroll
        for (int x = 0; x < 8; ++x) w[x] = *(const bf16x8*)(gd + GD_W + ((size_t)x * 64 + lane) * 16);
#pragma unroll
        for (int m = 0; m < 4; ++m) u0[m] = *(const u32x2*)(gd + GD_U + ((size_t)(ws * 4 + m) * 64 + lane) * 8); }
    __device__ __forceinline__ void load_b(const unsigned char* gd, int lane, int fq) {
        const float* gv = (const float*)(gd + GD_VEC);
#pragma unroll
        for (int x = 0; x < 8; ++x) { pq[x] = *(const bf16x8*)(gd + GD_P + ((size_t)x * 64 + lane) * 16); qq[x] = *(const bf16x8*)(gd + GD_Q + ((size_t)x * 64 + lane) * 16); }
        al = gv[128]; }
    __device__ __forceinline__ void load_k(const unsigned char* gd, int lane) {
#pragma unroll
        for (int x = 0; x < 8; ++x) kk[x] = *(const bf16x8*)(gd + GD_K + ((size_t)x * 64 + lane) * 16); }
};
template <int MIX>
__device__ void seq_item(const Params& p, int layer, int b_in, int hp_in, LAS unsigned char* lds) {
    constexpr int DK = MIX == 2 ? 128 : 64, NT = DK / 16, NS = DK / 32; constexpr bool SINGLE = MIX != 2;
    const int b = __builtin_amdgcn_readfirstlane(b_in), hp = __builtin_amdgcn_readfirstlane(hp_in);
    const int tid = opaque_tid(), wid = tid >> 6, lane = tid & 63, fq = lane >> 4, fc = lane & 15;
    const int hsel = SINGLE ? 0 : wid >> 2, hd = SINGLE ? hp : hp * 2 + hsel, ws = wid & 3; const bool cw = !SINGLE || wid < 4;
    LAS float* Os = (LAS float*)lds;
    const bf16_t* projb = (const bf16_t*)(p.ws + WS_PROJ) + (size_t)(b * TP) * NBIG; bf16_t* yb = (bf16_t*)(p.ws + WS_Y) + (size_t)(b * TP) * DM;
    f32x4 S[NT];
#pragma unroll
    for (int m = 0; m < NT; ++m) S[m] = (f32x4){0.f, 0.f, 0.f, 0.f};
    const f32x4 zero4 = (f32x4){0.f, 0.f, 0.f, 0.f};
    LAS float* NW = Os + 4 * 64 * OSP;
    if (tid < (SINGLE ? 64 : 128)) { const int cc = (SINGLE ? hp * 64 : hp * 128) + tid; NW[tid] = (MIX == 0 ? p.hgrn_norm_w : MIX == 1 ? p.gdn_norm_w : MIX == 2 ? p.ssd_norm_w : p.ret_norm_w)[layer * 256 + cc]; if (MIX == 3) NW[128 + tid] = p.ret_norm_b[layer * 256 + cc]; }
    SeqRegs<MIX == 1 ? 0 : MIX> R; GdRegs G;
    if (cw) { if (MIX == 1) { const unsigned char* g0 = rec_gdn(p, b, 0, hd); G.load_a(g0, ws, lane); G.load_b(g0, lane, fq); G.load_k(g0, lane); } else R.load(p, b, 0, hp, hsel, hd, ws, lane, fq, wid); }
    LAS unsigned char* QFs = (LAS unsigned char*)(NW + 256);
    if (MIX == 2) {
#pragma unroll
        for (int x = 0; x < 2; ++x) *(LAS bf16x8*)(QFs + ((size_t)(2 * wid + x) * 64 + lane) * 16) = R.qf[x];
        R.load(p, b, 0, hp, hsel, hd, ws, lane, fq, wid, 1); }
    __syncthreads();
    for (int c = 0; c < NCHUNK; ++c) {
        const int i0 = c == 0 ? 48 : 0, t0 = 64 * c - 48, cn = min(c + 1, NCHUNK - 1);
        LAS float* Ob = Os + ((c & 1) * 2 + hsel) * 64 * OSP;
        const int zri = tid >> 3, zsg = tid & 7;
        const bf16_t* zp = projb + (size_t)max(t0 + zri, 0) * NBIG + (MIX == 0 ? PC_AZ : MIX == 1 ? PC_BZ : MIX == 2 ? PC_CZ : PC_DZ) + (MIX == 2 ? hp * 128 + zsg * 16 : hd * 64 + zsg * 8);
        const u32x4 zr0 = *(const u32x4*)zp, zr1 = SINGLE ? zr0 : *(const u32x4*)(zp + 8);
        if (cw) {
        bf16x8 Sb[NS];
#pragma unroll
        for (int s = 0; s < NS; ++s) Sb[s] = pack_acc2(S[2 * s], S[2 * s + 1]);
        if (MIX == 1) {
            const unsigned char* gn = rec_gdn(p, b, cn, hd);
            bf16x8 ub[2]; f32x4 u[4];
#pragma unroll
            for (int m = 0; m < 4; ++m) { u[m] = unpack_acc(G.u0[m]);
#pragma unroll
                for (int s = 0; s < 2; ++s) u[m] = mfma16(G.w[m * 2 + s], Sb[s], u[m]); }
            G.load_a(gn, ws, lane);
#pragma unroll
            for (int s = 0; s < 2; ++s) ub[s] = pack_acc2(u[2 * s], u[2 * s + 1]);
#pragma unroll
            for (int mi = 0; mi < 4; ++mi) { f32x4 o1 = zero4, o2 = zero4;
#pragma unroll
                for (int s = 0; s < 2; ++s) { o1 = mfma16(G.pq[mi * 2 + s], ub[s], o1); o2 = mfma16(G.qq[mi * 2 + s], Sb[s], o2); }
#pragma unroll
                for (int r = 0; r < 4; ++r) Ob[(16 * mi + 4 * fq + r) * OSP + 16 * ws + fc] = o1[r] + o2[r]; }
            const float al = G.al; G.load_b(gn, lane, fq);
#pragma unroll
            for (int m = 0; m < 4; ++m) { S[m] = S[m] * al;
#pragma unroll
                for (int s = 0; s < 2; ++s) S[m] = mfma16(G.kk[m * 2 + s], ub[s], S[m]); }
            G.load_k(gn, lane);
        } else {
#pragma unroll
            for (int mi = 0; mi < 4; ++mi) { f32x4 o2 = zero4;
#pragma unroll
                for (int s = 0; s < NS; ++s) o2 = mfma16(MIX == 2 ? *(const LAS bf16x8*)(QFs + ((size_t)((c & 1) * 16 + mi * NS + s) * 64 + lane) * 16) : R.qf[MIX == 2 ? 0 : mi * NS + s], Sb[s], o2);
                const f32x4 o1 = unpack_acc(R.oi[mi]);
#pragma unroll
                for (int r = 0; r < 4; ++r) Ob[(16 * mi + 4 * fq + r) * OSP + 16 * ws + fc] = o1[r] + (MIX == 2 ? R.eg[MIX == 2 ? mi : 0][r] : 1.0f) * o2[r]; }
#pragma unroll
            for (int m = 0; m < NT; ++m) { const f32x4 d = unpack_acc(R.ds[m]);
#pragma unroll
                for (int r = 0; r < 4; ++r) S[m][r] = (MIX == 0 ? R.al[MIX == 0 ? (m & 3) : 0][r] : R.al[0][0]) * S[m][r] + d[r]; }
            if (MIX == 2) {
#pragma unroll
                for (int x = 0; x < 2; ++x) *(LAS bf16x8*)(QFs + ((size_t)(((c + 1) & 1) * 16 + 2 * wid + x) * 64 + lane) * 16) = R.qf[x]; }
            R.load(p, b, cn, hp, hsel, hd, ws, lane, fq, wid, MIX == 2 ? min(c + 2, NCHUNK - 1) : -1);
        }
        }
        if (MIX == 2) {
            const int ri = tid >> 3, sg = tid & 7;
            __syncthreads();
            float o[16], z[16]; unpack_bf8(zr0, z); unpack_bf8(zr1, z + 8); float q = 0.f; const LAS float* Oh = Os + ((c & 1) * 2 + (sg >> 2)) * 64 * OSP + ri * OSP + (sg & 3) * 16;
#pragma unroll
            for (int k4 = 0; k4 < 4; ++k4) { const f32x4 v = *(const LAS f32x4*)(Oh + 4 * k4); o[4 * k4] = v[0]; o[4 * k4 + 1] = v[1]; o[4 * k4 + 2] = v[2]; o[4 * k4 + 3] = v[3]; }
#pragma unroll
            for (int k = 0; k < 16; ++k) { o[k] *= silu_f(z[k]); q += o[k] * o[k]; }
            q += lane_xor(q, 1, lane); q += lane_xor(q, 2, lane); q += lane_xor(q, 4, lane);
            const float rstd = rsqrtf(q * (1.0f / 128.0f) + EPSF); const LAS float* nw = NW + sg * 16;
#pragma unroll
            for (int k = 0; k < 16; ++k) o[k] *= rstd * nw[k];
            if (ri >= i0) { u32x4* yp = (u32x4*)(yb + (size_t)(t0 + ri) * DM + 512 + hp * 128 + sg * 16); yp[0] = pack_bf8(o); yp[1] = pack_bf8(o + 8); }
        } else {
            const int ri = tid >> 3, sg = tid & 7;
            constexpr int YC = MIX == 0 ? 0 : MIX == 1 ? 256 : 768;
            __syncthreads();
            float o[8], z[8]; unpack_bf8(zr0, z);
            { const f32x4 va = *(const LAS f32x4*)(Ob + ri * OSP + sg * 8), vb = *(const LAS f32x4*)(Ob + ri * OSP + sg * 8 + 4); o[0] = va[0]; o[1] = va[1]; o[2] = va[2]; o[3] = va[3]; o[4] = vb[0]; o[5] = vb[1]; o[6] = vb[2]; o[7] = vb[3]; }
            const LAS float* nw = NW + sg * 8;
            if (MIX == 3) { float s = 0.f;
#pragma unroll
                for (int k = 0; k < 8; ++k) s += o[k];
                s += lane_xor(s, 1, lane); s += lane_xor(s, 2, lane); s += lane_xor(s, 4, lane); const float mu = s * (1.0f / 64.0f); float q = 0.f;
#pragma unroll
                for (int k = 0; k < 8; ++k) { o[k] -= mu; q += o[k] * o[k]; }
                q += lane_xor(q, 1, lane); q += lane_xor(q, 2, lane); q += lane_xor(q, 4, lane); const float rstd = rsqrtf(q * (1.0f / 64.0f) + EPSF); const LAS float* nb = NW + 128 + sg * 8;
#pragma unroll
                for (int k = 0; k < 8; ++k) o[k] = (o[k] * rstd * nw[k] + nb[k]) * silu_f(z[k]);
            } else { float q = 0.f;
#pragma unroll
                for (int k = 0; k < 8; ++k) q += o[k] * o[k];
                q += lane_xor(q, 1, lane); q += lane_xor(q, 2, lane); q += lane_xor(q, 4, lane); const float rstd = rsqrtf(q * (1.0f / 64.0f) + EPSF);
#pragma unroll
                for (int k = 0; k < 8; ++k) o[k] = o[k] * rstd * nw[k] * silu_f(z[k]); }
            if (ri >= i0) *(u32x4*)(yb + (size_t)(t0 + ri) * DM + YC + hd * 64 + sg * 8) = pack_bf8(o);
        }
    }
    if (cw) { float* so = p.out + (MIX == 0 ? O_HGRN_P : MIX == 1 ? O_GDN_P : MIX == 2 ? O_SSD_P : O_RET_P) + (((size_t)layer * NB + b) * 4 + hd) * (DK * 64);
#pragma unroll
        for (int m = 0; m < NT; ++m)
#pragma unroll
            for (int r = 0; r < 4; ++r) so[(16 * m + 4 * fq + r) * 64 + 16 * ws + fc] = S[m][r]; }
    if (MIX == 1 || MIX == 2) { float* co = p.out + (MIX == 1 ? O_GCONV_P : O_SCONV_P) + ((size_t)layer * NB + b) * 3 * 768;
        for (int e = tid; e < 3 * (SINGLE ? 192 : 384); e += 512) { const int r = e / (SINGLE ? 192 : 384), ch = e % (SINGLE ? 192 : 384), chf = SINGLE ? (ch >> 6) * 256 + hd * 64 + (ch & 63) : (ch >> 7) * 256 + hp * 128 + (ch & 127);
            co[r * 768 + chf] = bf2f(projb[(size_t)(TP - 3 + r) * NBIG + (MIX == 1 ? PC_BQKV : PC_CXBC) + chf]); } }
}

constexpr int N_MU = 14;
__device__ void ph_pre(const Params& p_in, int layer, LAS unsigned char* lds_in, int blk, int nblk) {
    Params p = p_in; asm volatile("" : "+s"(p.ws), "+s"(p.out));
    LAS unsigned char* lds = lds_in; asm volatile("" : "+s"(lds));
    convert_weights(p, layer + 1 < DEPTH ? layer + 1 : -1, layer, (LAS float*)lds, opaque_tid(), blk, nblk);
    for (int u = blk; u < NB * NCHUNK * 14; u += nblk) { const int t = u / 7, k = u % 7, v = t * 2 + (k & 1), b4 = v / (NCHUNK * 4), c4 = (v >> 2) % NCHUNK, h4 = v & 3;
#ifndef REP_U0
#define REP_U0 1
#define REP_U1 1
#define REP_U2 1
#define REP_U3 1
#endif
        for (int rep = 0; rep < (k < 2 ? REP_U0 : k < 4 ? REP_U1 : k < 6 ? REP_U2 : REP_U3); ++rep)
        if (k < 2) hgrn_pre_unit(p, layer, b4, c4, h4, lds);
        else if (k < 4) ret_pre_unit(p, layer, b4, c4, h4, lds);
        else if (k < 6) gdn_pre_unit(p, layer, b4, c4, h4, lds);
        else ssd_pre_unit(p, layer, t / (NCHUNK * 2), (t >> 1) % NCHUNK, t & 1, lds); }
}
__device__ void ph_seq(const Params& p_in, int layer, LAS unsigned char* lds_in, int blk, int nblk) {
    Params p = p_in; asm volatile("" : "+s"(p.ws), "+s"(p.out));
    LAS unsigned char* lds = lds_in; asm volatile("" : "+s"(lds));
    LAS float* L = (LAS float*)lds;
    if (blk < 112) { const int b = blk / 14, k = blk % 14;
        if (k < 2) seq_item<2>(p, layer, b, k, lds); else if (k < 6) seq_item<1>(p, layer, b, k - 2, lds); else if (k < 10) seq_item<0>(p, layer, b, k - 6, lds); else seq_item<3>(p, layer, b, k - 10, lds); }
    else for (int d = blk - 112; d < DECB * N_MU; d += nblk - 112) { const int s = NB + d / N_MU, mu = d % N_MU;
        if (mu < 4) mixer_item<0>(p, layer, s, mu, L); else if (mu < 8) mixer_item<1>(p, layer, s, mu - 4, L); else if (mu < 10) mixer_item<2>(p, layer, s, mu - 8, L); else mixer_item<3>(p, layer, s, mu - 10, L); }
}

__device__ void ph_final(const Params& p_in, int blk, int nblk) {
    Params p = p_in; asm volatile("" : "+s"(p.ws), "+s"(p.out));

    const int tid = opaque_tid(), wid = tid >> 6, lane = tid & 63;
    const float* h = (const float*)(p.ws + WS_H);
    for (int row = blk * 8 + wid; row < MROWS; row += nblk * 8) {
        float* dst;
        if (row < MP) { const int b = row / TP, t = row % TP; if (t < NMETA) continue; dst = p.out + O_YP + ((size_t)b * SEQ + (t - NMETA)) * DM; } else dst = p.out + O_YS + (size_t)(row - MP) * DM;
        f32x4 v[4]; float ss = 0.f;
#pragma unroll
        for (int j = 0; j < 4; ++j) { v[j] = *(const f32x4*)(h + (size_t)row * DM + j * 256 + lane * 4); ss += v[j][0] * v[j][0] + v[j][1] * v[j][1] + v[j][2] * v[j][2] + v[j][3] * v[j][3]; }
        const float r = rsqrtf(wave_sum(ss, lane) * (1.0f / DM) + EPSF);
#pragma unroll
        for (int j = 0; j < 4; ++j) { const f32x4 w = *(const f32x4*)(p.final_norm_w + j * 256 + lane * 4); *(f32x4*)(dst + j * 256 + lane * 4) = v[j] * r * w; }
    }
}

constexpr int LDS_STAGE = 160 * 1024 - 256;
constexpr int LDS_BYTES = LDS_STAGE + 16;
static_assert(MixLds::END * 4 <= LDS_STAGE && RetLds::END <= LDS_STAGE && SsdLds::END <= LDS_STAGE && 2 * 64 * LDP * 2 <= SsdLds::DT - SsdLds::PS && HgLds::END <= LDS_STAGE && GdLds::END <= LDS_STAGE && pg8::STAGE_BYTES <= LDS_STAGE && 4 * 64 * OSP * 4 + 1024 + 32768 <= LDS_STAGE, "LDS carve");

__global__ void __launch_bounds__(512, 2) k_mega(Params p) {
    extern __shared__ __attribute__((aligned(16))) unsigned char smem[];
    LAS unsigned char* lds = (LAS unsigned char*)smem;
    const int blk = blockIdx.x, nblk = gridDim.x;
    volatile LAS unsigned* xbw = (volatile LAS unsigned*)(lds + LDS_STAGE);
    if (threadIdx.x < 4) xbw[threadIdx.x] = 0u;
    __syncthreads();
    XcdBarrier xb = xcd_barrier_post((unsigned*)(p.ws + WS_BAR), xbw);
#ifndef REP_PREP
#define REP_PREP 1
#endif
#ifndef REP_ROWNORM
#define REP_ROWNORM 1
#endif
#ifndef REP_GEMMIN
#define REP_GEMMIN 1
#endif
#ifndef REP_GDNPRE
#define REP_GDNPRE 1
#endif
#ifndef REP_MIXER
#define REP_MIXER 1
#endif
    for (int r = 0; r < REP_PREP; ++r) { ph_prep(p, lds, blk, nblk); if (r + 1 < REP_PREP) xcd_barrier(xb); }
    cooperative_groups::this_grid().sync();
    xcd_barrier(xb);
#pragma unroll 1
    for (int l = 0; l < DEPTH; ++l) {
        for (int r = 0; r < REP_ROWNORM; ++r) { ph_rownorm(p, l, blk, nblk); xcd_barrier(xb); }
        for (int r = 0; r < REP_GEMMIN; ++r) { ph_gemm_in(p, l, lds, blk, nblk); xcd_barrier(xb); }
#ifndef REP_A
#define REP_A 1
#define REP_B 1
#endif
        for (int r = 0; r < REP_A; ++r) { ph_pre(p, l, lds, blk, nblk); xcd_barrier(xb); }
        for (int r = 0; r < REP_B; ++r) { ph_seq(p, l, lds, blk, nblk); xcd_barrier(xb); }
        ph_gemm_out(p, l, lds, blk, nblk);
        xcd_barrier(xb);
    }
    ph_final(p, blk, nblk);
}

extern "C" void kernel_launch(void* const* d_in, const int* in_sizes, int n_in, void* d_out, int out_size, void* d_ws, size_t ws_size, hipStream_t stream) {
    static int grid = 0;
    if (grid == 0) {
        if (n_in != 27 || (size_t)out_size != O_END || ws_size < WS_END) { fprintf(stderr, "kernel_launch: unexpected shapes: n_in %d out %d (want %zu) ws %zu (want %zu)\n", n_in, out_size, (size_t)O_END, ws_size, (size_t)WS_END); grid = -1; return; }
        if (hipFuncSetAttribute((const void*)k_mega, hipFuncAttributeMaxDynamicSharedMemorySize, LDS_BYTES) != hipSuccess) { fprintf(stderr, "kernel_launch: hipFuncSetAttribute failed\n"); grid = -1; return; }
        int dev = 0, cus = 0, per_cu = 0;
        if (hipGetDevice(&dev) != hipSuccess || hipDeviceGetAttribute(&cus, hipDeviceAttributeMultiprocessorCount, dev) != hipSuccess) { fprintf(stderr, "kernel_launch: device query failed\n"); grid = -1; return; }
        if (hipOccupancyMaxActiveBlocksPerMultiprocessor(&per_cu, (const void*)k_mega, 512, LDS_BYTES) != hipSuccess || per_cu < 1) { fprintf(stderr, "kernel_launch: occupancy query says %d blocks per CU\n", per_cu); grid = -1; return; }
        grid = cus;
    }
    if (grid < 0) return;
    Params p{};
    const float** pp = (const float**)&p;
    for (int i = 0; i < 27; ++i) pp[i] = (const float*)d_in[i];
    p.out = (float*)d_out; p.ws = (unsigned char*)d_ws;
    (void)hipMemsetAsync((unsigned char*)d_ws + WS_BAR, 0, 16384, stream);
    void* args[] = {&p};
    const hipError_t e = hipLaunchCooperativeKernel((const void*)k_mega, dim3(grid), dim3(512), args, LDS_BYTES, stream);
    if (e != hipSuccess) fprintf(stderr, "kernel_launch: cooperative launch failed: %s (grid %d)\n", hipGetErrorString(e), grid);
}
```

```cpp
#include <hip/hip_runtime.h>
#include <hip/hip_cooperative_groups.h>
#include <cstdio>
#include <cstdint>

#define LAS __attribute__((address_space(3)))
typedef unsigned short bf16_t;
typedef short bf16x8 __attribute__((ext_vector_type(8)));
typedef float f32x4 __attribute__((ext_vector_type(4)));
typedef unsigned u32x4 __attribute__((ext_vector_type(4)));
typedef unsigned u32x2 __attribute__((ext_vector_type(2)));

constexpr int DM = 1024, NB = 8, SEQ = 2048, DEPTH = 4, DECB = 128, NMETA = 16, TP = SEQ + NMETA;
constexpr int MP = NB * TP;
constexpr int MROWS = MP + DECB;
constexpr int IN_DIM = 4108, NBIG = 4096, NSM = 12;
constexpr int PASTLEN = 16384;
constexpr float EPSF = 1e-6f;
constexpr int PC_AQ = 0, PC_AF = 256, PC_AI = 512, PC_AZ = 768, PC_BQKV = 1024, PC_BZ = 1792, PC_CXBC = 2048, PC_CZ = 2816, PC_DQ = 3072, PC_DK = 3328, PC_DV = 3584, PC_DZ = 3840;

constexpr size_t WS_BAR = 0;
constexpr size_t WS_WINT = 16384;
constexpr size_t WS_WOUTT = WS_WINT + (size_t)NBIG * DM * 2;
constexpr size_t WS_WSM = WS_WOUTT + (size_t)DM * DM * 2;
constexpr size_t WS_LB = WS_WSM + (size_t)DEPTH * NSM * DM * 4;
constexpr size_t WS_ROT = WS_LB + (size_t)DEPTH * 256 * 4;
constexpr size_t ROT_BYTES = ((size_t)(TP + 1) * 64 * 4 + 255) / 256 * 256;
constexpr size_t WS_H = WS_ROT + ROT_BYTES;
constexpr size_t WS_HB = WS_H + (size_t)MROWS * DM * 4;
constexpr size_t WS_RS = WS_HB + (size_t)MROWS * DM * 2;
constexpr size_t WS_PSM = WS_RS + (size_t)MROWS * 4;
constexpr size_t WS_PROJ = WS_PSM + (size_t)MROWS * NSM * 4;
constexpr size_t WS_Y = WS_PROJ + (size_t)MROWS * NBIG * 2;
constexpr size_t WS_E = WS_Y + (size_t)MROWS * DM * 2;
constexpr size_t WS_END = WS_E + (size_t)NB * 33 * 4 * 41728;

constexpr size_t O_YP = 0;
constexpr size_t O_YS = O_YP + (size_t)NB * SEQ * DM;
constexpr size_t O_HGRN_P = O_YS + (size_t)DECB * DM;
constexpr size_t O_GDN_P = O_HGRN_P + (size_t)DEPTH * NB * 4 * 64 * 64;
constexpr size_t O_GCONV_P = O_GDN_P + (size_t)DEPTH * NB * 4 * 64 * 64;
constexpr size_t O_SSD_P = O_GCONV_P + (size_t)DEPTH * NB * 3 * 768;
constexpr size_t O_SCONV_P = O_SSD_P + (size_t)DEPTH * NB * 4 * 128 * 64;
constexpr size_t O_RET_P = O_SCONV_P + (size_t)DEPTH * NB * 3 * 768;
constexpr size_t O_HGRN_S = O_RET_P + (size_t)DEPTH * NB * 4 * 64 * 64;
constexpr size_t O_GDN_S = O_HGRN_S + (size_t)DEPTH * DECB * 4 * 64 * 64;
constexpr size_t O_GCONV_S = O_GDN_S + (size_t)DEPTH * DECB * 4 * 64 * 64;
constexpr size_t O_SSD_S = O_GCONV_S + (size_t)DEPTH * DECB * 3 * 768;
constexpr size_t O_SCONV_S = O_SSD_S + (size_t)DEPTH * DECB * 4 * 128 * 64;
constexpr size_t O_RET_S = O_SCONV_S + (size_t)DEPTH * DECB * 3 * 768;
constexpr size_t O_END = O_RET_S + (size_t)DEPTH * DECB * 4 * 64 * 64;

struct Params {
    const float* x_prompt; const float* x_sample;
    const float* st_hgrn; const float* st_gdn; const float* st_gconv; const float* st_ssd; const float* st_sconv; const float* st_ret;
    const float* meta; const float* norm_w; const float* w_in; const float* lb_logits; const float* hgrn_norm_w;
    const float* gdn_conv_w; const float* gdn_a_log; const float* gdn_dt_bias; const float* gdn_norm_w;
    const float* ssd_conv_w; const float* ssd_conv_b; const float* ssd_a_log; const float* ssd_dt_bias; const float* ssd_d; const float* ssd_norm_w;
    const float* ret_norm_w; const float* ret_norm_b; const float* w_out; const float* final_norm_w;
    float* out; unsigned char* ws;
};

__device__ __forceinline__ float bf2f(bf16_t b) { return __uint_as_float(((unsigned)b) << 16); }
__device__ __forceinline__ bf16_t f2bf(float f) { unsigned u = __float_as_uint(f); u += 0x7FFFu + ((u >> 16) & 1u); return (bf16_t)(u >> 16); }
__device__ __forceinline__ unsigned pack_bf2(float lo, float hi) { return (unsigned)f2bf(lo) | ((unsigned)f2bf(hi) << 16); }
__device__ __forceinline__ float sigmoid_f(float x) { return 1.0f / (1.0f + __expf(-x)); }
__device__ __forceinline__ float silu_f(float x) { return x / (1.0f + __expf(-x)); }
__device__ __forceinline__ float softplus_f(float x) { return x > 20.0f ? x : log1pf(__expf(x)); }
__device__ __forceinline__ int opaque_tid() { int t = threadIdx.x; asm volatile("" : "+v"(t)); return t; }
__device__ __forceinline__ float lane_xor(float v, int k, int lane) { return __int_as_float(__builtin_amdgcn_ds_bpermute((lane ^ k) << 2, __float_as_int(v))); }
__device__ __forceinline__ float lane_up(float v, int k, int lane) { return __int_as_float(__builtin_amdgcn_ds_bpermute(((lane - k) & 63) << 2, __float_as_int(v))); }
__device__ __forceinline__ float wave_sum(float v, int lane) {
#pragma unroll
    for (int o = 32; o > 0; o >>= 1) v += lane_xor(v, o, lane);
    return v;
}


#define XB_TMO      128
#define XB_XCNT(j)  (256  + 64 * (j))
#define XB_XSUB(j)  (1280 + 64 * (j))
#define XB_XGEN(j)  (2304 + 64 * (j))
#define XB_TOP      3328
#define XB_TOPGEN   3392
#define XCD_BAR_WORDS 3456
#define XB_SPIN_CAP (1u << 22)
__device__ __forceinline__ unsigned xb_ld(unsigned* p)              { return __hip_atomic_load(p, __ATOMIC_RELAXED, __HIP_MEMORY_SCOPE_AGENT); }
__device__ __forceinline__ unsigned xb_add(unsigned* p, unsigned v) { return __hip_atomic_fetch_add(p, v, __ATOMIC_RELAXED, __HIP_MEMORY_SCOPE_AGENT); }
__device__ __forceinline__ unsigned xb_xcc_id() { return (unsigned)__builtin_amdgcn_s_getreg((3 << 11) | 20) & 0xFu; }
#define XB_SPIN(cond, bar) do { unsigned _sp = 0; while (cond) { __builtin_amdgcn_s_sleep(1); \
    if ((++_sp & 255u) == 0u) { if (xb_ld(&(bar)[XB_TMO])) break; if (_sp > XB_SPIN_CAP) { atomicAdd(&(bar)[XB_TMO], 1u); break; } } } } while (0)
struct XcdBarrier { unsigned* bar; unsigned x; volatile LAS unsigned* st; };
__device__ __forceinline__ XcdBarrier xcd_barrier_post(unsigned* bar, volatile LAS unsigned* st) {
    XcdBarrier b; b.bar = bar; b.x = xb_xcc_id(); b.st = st;
    if (threadIdx.x == 0) (void)xb_add(&bar[XB_XCNT(b.x)], 1u);
    return b;
}
__device__ __forceinline__ void xcd_barrier_complete(unsigned* bar, unsigned x, unsigned& nloc, unsigned& nx) {
    const unsigned G = gridDim.x * gridDim.y * gridDim.z;
    unsigned sum, cnt, mine, sp = 0u;
    for (;;) {
        sum = 0u; cnt = 0u; mine = 0u;
#pragma unroll
        for (unsigned j = 0; j < 16; ++j) { const unsigned c = xb_ld(&bar[XB_XCNT(j)]); sum += c; cnt += (c > 0u) ? 1u : 0u; mine = (j == x) ? c : mine; }
        if (sum == G) break;
        __builtin_amdgcn_s_sleep(1);
        if ((++sp & 255u) == 0u) { if (xb_ld(&bar[XB_TMO])) break; if (sp > XB_SPIN_CAP) { atomicAdd(&bar[XB_TMO], 1u); break; } }
    }
    nloc = mine > 0u ? mine : 1u; nx = cnt > 0u ? cnt : 1u;
}
__device__ __forceinline__ void xcd_barrier(const XcdBarrier& b0) {
    asm volatile("s_waitcnt vmcnt(0)" ::: "memory");
    __syncthreads();
    if (threadIdx.x == 0) {
        XcdBarrier b = b0; { unsigned x = xb_xcc_id(); asm volatile("" : "+s"(x)); b.x = x; }
        unsigned* bar = b.bar;
        __builtin_amdgcn_s_waitcnt(0);
        unsigned nloc = b.st[0], nx = b.st[1];
        if (nloc == 0u) { xcd_barrier_complete(bar, b.x, nloc, nx); b.st[0] = nloc; b.st[1] = nx; }
        const unsigned old = xb_add(&bar[XB_XSUB(b.x)], 1u);
        const unsigned gen = old / nloc;
        if (old + 1u == (gen + 1u) * nloc) {
            __builtin_amdgcn_fence(__ATOMIC_RELEASE, "agent");
            asm volatile("s_waitcnt vmcnt(0)" ::: "memory");
            const unsigned og = xb_add(&bar[XB_TOP], 1u);
            const unsigned tg = og / nx;
            if (og + 1u == (tg + 1u) * nx) xb_add(&bar[XB_TOPGEN], 1u);
            else XB_SPIN(xb_ld(&bar[XB_TOPGEN]) == tg, bar);
            __builtin_amdgcn_fence(__ATOMIC_ACQUIRE, "agent");
            xb_add(&bar[XB_XGEN(b.x)], 1u);
            asm volatile("s_waitcnt vmcnt(0)" ::: "memory");
        } else {
            XB_SPIN(xb_ld(&bar[XB_XGEN(b.x)]) == gen, bar);
            __builtin_amdgcn_fence(__ATOMIC_ACQUIRE, "agent");
            asm volatile("s_waitcnt vmcnt(0)" ::: "memory");
        }
    }
    __syncthreads();
}

namespace pg8 {
constexpr int BM = 256, BK = 64, HALF = 128, HTB = HALF * BK * 2, STAGE_BYTES = 8 * HTB, NXCD = 8, WGM = 8;
__host__ __device__ __forceinline__ int lds_byte(int r, int c) { const int st = (r >> 4) * 2 + (c >> 5), rr = r & 15, cc = c & 31, ob = rr * 64 + cc * 2; return st * 1024 + (ob ^ (((ob >> 9) & 1) << 5)); }
__host__ __device__ __forceinline__ void stage_rc(int b, int& R, int& C) { const int st = b / 1024, sb = b % 1024, swz = sb ^ (((sb >> 9) & 1) << 5); R = (st >> 1) * 16 + swz / 64; C = (st & 1) * 32 + (swz % 64) / 2; }
__host__ __device__ __forceinline__ int perm32(int rho) { const int n = rho >> 4, i = rho & 15; return 8 * (i >> 2) + 4 * n + (i & 3); }
struct Unit { int pm, pn; };
struct Gemm { const bf16_t* A; const bf16_t* Bt; int M, N, K; };
struct StaticOrder {
    int nM, nN, nwg, G, c;
    __host__ __device__ void init(int M, int N, int G_, int c_) { nM = M / BM; nN = N / BM; nwg = nM * nN; G = G_; c = c_; }
    __host__ __device__ bool next(int i, Unit& u) const {
        const long L = (long)i * G + c; if (L >= nwg) return false;
        int wgid = (int)L; { const int q = nwg / NXCD, r = nwg % NXCD, xcd = wgid % NXCD, off = wgid / NXCD; wgid = (xcd < r ? xcd * (q + 1) : r * (q + 1) + (xcd - r) * q) + off; }
        const int nig = WGM * nN, gid = wgid / nig, fm = gid * WGM, gsz = (nM - fm) < WGM ? (nM - fm) : WGM;
        u.pm = fm + ((wgid % nig) % gsz); u.pn = (wgid % nig) / gsz; return true;
    }
    __device__ __forceinline__ void a_ready(const Unit&) const {}
    __device__ __forceinline__ void done(const Unit&) const {}
};
typedef float f32x2_t __attribute__((ext_vector_type(2)));
typedef __bf16 bf16x2n_t __attribute__((ext_vector_type(2)));
__device__ __forceinline__ unsigned cvt_pk_bf16(float lo, float hi) { const f32x2_t f = {lo, hi}; return __builtin_bit_cast(unsigned, __builtin_convertvector(f, bf16x2n_t)); }

struct EpiProj {
    static constexpr bool PERM = true, AFTER_DRAIN = false;
    bf16_t* O; int ldc; const float* rs;
    __device__ __forceinline__ void operator()(const f32x4 (&acc)[2][2][4][2], const Unit& u, int wr, int wc, int fr, int fq) const {
        const int row0 = u.pm * BM + wr * 64 + fr; const int col0 = u.pn * BM + wc * 32 + 8 * fq;
#pragma unroll
        for (int ai = 0; ai < 2; ++ai)
#pragma unroll
            for (int m = 0; m < 4; ++m) { const int row = row0 + ai * HALF + m * 16; const float s = rs[row]; bf16_t* rowp = O + (size_t)row * ldc + col0;
#pragma unroll
                for (int bj = 0; bj < 2; ++bj) { const f32x4 v0 = acc[ai][bj][m][0] * s, v1 = acc[ai][bj][m][1] * s;
                    u32x4 w; w.x = cvt_pk_bf16(v0[0], v0[1]); w.y = cvt_pk_bf16(v0[2], v0[3]); w.z = cvt_pk_bf16(v1[0], v1[1]); w.w = cvt_pk_bf16(v1[2], v1[3]);
                    *(u32x4*)(rowp + bj * HALF) = w; } }
    }
};
struct EpiResid {
    static constexpr bool PERM = false, AFTER_DRAIN = false;
    float* C; int ldc;
    __device__ __forceinline__ void operator()(const f32x4 (&acc)[2][2][4][2], const Unit& u, int wr, int wc, int fr, int fq) const {
        const int row0 = u.pm * BM + wr * 64 + fr, col0 = u.pn * BM + wc * 32 + 4 * fq;
#pragma unroll
        for (int ai = 0; ai < 2; ++ai)
#pragma unroll
            for (int m = 0; m < 4; ++m) { float* rowp = C + (size_t)(row0 + ai * HALF + m * 16) * ldc + col0;
#pragma unroll
                for (int bj = 0; bj < 2; ++bj)
#pragma unroll
                    for (int n = 0; n < 2; ++n) { f32x4* p = (f32x4*)(rowp + bj * HALF + n * 16); *p = *p + acc[ai][bj][m][n]; } }
    }
};

template <class Epi, class Sched>
__device__ __forceinline__ void gemm_phase(LAS unsigned char* lds, const Gemm g, const Sched& S, const Epi& E) {
    const int tid = opaque_tid(), wid = __builtin_amdgcn_readfirstlane(tid >> 6), lane = tid & 63, wr = wid >> 2, wc = wid & 3, fr = lane & 15, fq = lane >> 4;
    const int K = g.K, nt = K / BK;
    unsigned voffA[2], voffB[2];
#pragma unroll
    for (int i = 0; i < 2; ++i) { int R, C; stage_rc(tid * 16 + i * 8192, R, C); const int Rb = Epi::PERM ? ((R & ~31) + perm32(R & 31)) : R;
        voffA[i] = (unsigned)(R * K + C) * 2u; voffB[i] = (unsigned)(Rb * K + C) * 2u; }
    const size_t kstep = (size_t)(BK * 2);
    const size_t hstep = (size_t)HALF * K * 2;
    const size_t tstep = 2 * hstep;
    const unsigned ldsw = (unsigned)wid * 1024u;
    const int aoff = lds_byte(wr * 64 + fr, fq * 8), boff = lds_byte(wc * 32 + fr, fq * 8);
#define PG8_SA(b, h) (((b) * 2 + (h)) * HTB)
#define PG8_SB(b, h) ((4 + (b) * 2 + (h)) * HTB)
#define PG8_STAGE(bufoff, gbase, voff) do { _Pragma("unroll") for (int _i = 0; _i < 2; ++_i) \
        __builtin_amdgcn_global_load_lds((const unsigned*)((const char*)(gbase) + (voff)[_i]), (LAS unsigned*)(lds + (bufoff) + ldsw + _i * 8192), 16, 0, 0); } while (0)
#define PG8_LDA(dst, b, h) do { _Pragma("unroll") for (int m = 0; m < 4; ++m) _Pragma("unroll") for (int k = 0; k < 2; ++k) dst[m][k] = *(const LAS bf16x8*)(lds + PG8_SA(b, h) + aoff + m * 2048 + k * 1024); } while (0)
#define PG8_LDB(dst, b, h) do { _Pragma("unroll") for (int n = 0; n < 2; ++n) _Pragma("unroll") for (int k = 0; k < 2; ++k) dst[n][k] = *(const LAS bf16x8*)(lds + PG8_SB(b, h) + boff + n * 2048 + k * 1024); } while (0)
#define PG8_MMA(ai, bj, At, Bt) do { __builtin_amdgcn_s_setprio(1); _Pragma("unroll") for (int m = 0; m < 4; ++m) _Pragma("unroll") for (int n = 0; n < 2; ++n) _Pragma("unroll") for (int k = 0; k < 2; ++k) \
        acc[ai][bj][m][n] = __builtin_amdgcn_mfma_f32_16x16x32_bf16(Bt[n][k], At[m][k], acc[ai][bj][m][n], 0, 0, 0); __builtin_amdgcn_s_setprio(0); } while (0)
#define PG8_WAIT_V(n) asm volatile("s_waitcnt vmcnt(" #n ")" ::: "memory")
#define PG8_WAIT_L(n) asm volatile("s_waitcnt lgkmcnt(" #n ")" ::: "memory")
#define PG8_BAR __builtin_amdgcn_s_barrier()
#define PG8_SCHED __builtin_amdgcn_sched_barrier(0)
    Unit cur, nxt; int ui = 0;
    if (!S.next(0, cur)) return;
    f32x4 acc[2][2][4][2];
#pragma unroll
    for (int a = 0; a < 2; ++a)
#pragma unroll
        for (int b = 0; b < 2; ++b)
#pragma unroll
            for (int m = 0; m < 4; ++m)
#pragma unroll
                for (int n = 0; n < 2; ++n) acc[a][b][m][n] = (f32x4){0.f, 0.f, 0.f, 0.f};
    bf16x8 At[4][2], B0[2][2], B1[2][2];
    const char* cA = (const char*)g.A + (size_t)cur.pm * tstep; const char* cB = (const char*)g.Bt + (size_t)cur.pn * tstep;
    S.a_ready(cur);
    PG8_STAGE(PG8_SB(0, 0), cB, voffB); PG8_STAGE(PG8_SA(0, 0), cA, voffA); PG8_STAGE(PG8_SB(0, 1), cB + hstep, voffB); PG8_STAGE(PG8_SA(0, 1), cA + hstep, voffA);
    if (wr == 1) PG8_BAR;
    PG8_WAIT_V(4); PG8_BAR;
    PG8_STAGE(PG8_SB(1, 0), cB + kstep, voffB); PG8_STAGE(PG8_SA(1, 0), cA + kstep, voffA); PG8_STAGE(PG8_SB(1, 1), cB + hstep + kstep, voffB);
    PG8_WAIT_V(6); PG8_BAR;
    for (;;) {
        const bool has_next = S.next(ui + 1, nxt);
        const char* nA = has_next ? (const char*)g.A + (size_t)nxt.pm * tstep : cA; const char* nB = has_next ? (const char*)g.Bt + (size_t)nxt.pn * tstep : cB;
        for (int t = 0; t < nt; t += 2) {
            const bool last = (t == nt - 2);
            const char* a1 = cA + (size_t)(t + 1) * kstep;
            const char* a2 = last ? nA : cA + (size_t)(t + 2) * kstep; const char* b2 = last ? nB : cB + (size_t)(t + 2) * kstep;
            const char* a3 = a2 + kstep; const char* b3 = b2 + kstep;
            if (last && has_next) S.a_ready(nxt);
            PG8_LDB(B0, 0, 0); PG8_SCHED; PG8_LDA(At, 0, 0); PG8_STAGE(PG8_SA(1, 1), a1 + hstep, voffA);
            PG8_WAIT_L(8); PG8_BAR; PG8_WAIT_L(0); PG8_MMA(0, 0, At, B0); PG8_BAR; PG8_SCHED;
            PG8_LDB(B1, 0, 1); PG8_STAGE(PG8_SB(0, 0), b2, voffB);
            PG8_BAR; PG8_WAIT_L(0); PG8_MMA(0, 1, At, B1); PG8_BAR;
            PG8_LDA(At, 0, 1); PG8_STAGE(PG8_SA(0, 0), a2, voffA);
            PG8_BAR; PG8_WAIT_L(0); PG8_MMA(1, 0, At, B0); PG8_BAR; PG8_SCHED;
            PG8_STAGE(PG8_SB(0, 1), b2 + hstep, voffB);
            PG8_WAIT_V(6); PG8_BAR; PG8_MMA(1, 1, At, B1); PG8_BAR;
            PG8_LDB(B0, 1, 0); PG8_SCHED; PG8_LDA(At, 1, 0); PG8_STAGE(PG8_SA(0, 1), a2 + hstep, voffA);
            PG8_WAIT_L(8); PG8_BAR; PG8_WAIT_L(0); PG8_MMA(0, 0, At, B0); PG8_BAR; PG8_SCHED;
            PG8_LDB(B1, 1, 1); PG8_STAGE(PG8_SB(1, 0), b3, voffB);
            PG8_BAR; PG8_WAIT_L(0); PG8_MMA(0, 1, At, B1); PG8_BAR;
            PG8_LDA(At, 1, 1); PG8_STAGE(PG8_SA(1, 0), a3, voffA);
            PG8_BAR; PG8_WAIT_L(0); PG8_MMA(1, 0, At, B0); PG8_BAR; PG8_SCHED;
            PG8_STAGE(PG8_SB(1, 1), b3 + hstep, voffB);
            PG8_WAIT_V(6); PG8_BAR; PG8_MMA(1, 1, At, B1); PG8_BAR;
        }
        if constexpr (!Epi::AFTER_DRAIN) { E(acc, cur, wr, wc, fr, fq); S.done(cur); }
        if (!has_next) break;
#pragma unroll
        for (int a = 0; a < 2; ++a)
#pragma unroll
            for (int b = 0; b < 2; ++b)
#pragma unroll
                for (int m = 0; m < 4; ++m)
#pragma unroll
                    for (int n = 0; n < 2; ++n) acc[a][b][m][n] = (f32x4){0.f, 0.f, 0.f, 0.f};
        cur = nxt; cA = nA; cB = nB; ++ui;
    }
    PG8_WAIT_V(0);
    if (wr == 0) PG8_BAR;
    PG8_BAR;
#undef PG8_SA
#undef PG8_SB
#undef PG8_STAGE
#undef PG8_LDA
#undef PG8_LDB
#undef PG8_MMA
#undef PG8_WAIT_V
#undef PG8_WAIT_L
#undef PG8_BAR
#undef PG8_SCHED
}
}

__device__ __forceinline__ int win_col(int n) { return n < 2048 ? n : (n < 3072 ? n + 8 : n + 12); }
__device__ __forceinline__ int win_smcol(int j) { return j < 8 ? 2048 + j : 3080 + (j - 8); }

__device__ __forceinline__ void convert_weights(const Params& p, int l_in, int l_out, LAS float* tile  , int tid, int blk, int nblk) {
    const int tiles_in = l_in >= 0 ? 64 * 16 : 0, tiles_out = l_out >= 0 ? 16 * 16 : 0;
    for (int t = blk; t < tiles_in + tiles_out; t += nblk) {
        const float* src; bf16_t* dst; int ld, n0, k0; const float* scale;
        if (t < tiles_in) { n0 = (t / 16) * 64; k0 = (t % 16) * 64; src = p.w_in + (size_t)l_in * DM * IN_DIM + win_col(n0); ld = IN_DIM; dst = (bf16_t*)(p.ws + WS_WINT); scale = p.norm_w + l_in * DM; }
        else { const int r = t - tiles_in; n0 = (r / 16) * 64; k0 = (r % 16) * 64; src = p.w_out + (size_t)l_out * DM * DM + n0; ld = DM; dst = (bf16_t*)(p.ws + WS_WOUTT); scale = nullptr; }
        __syncthreads();
#pragma unroll
        for (int n_ = 0; n_ < 8; ++n_) { const int e = tid + 512 * n_; const int kk = e >> 6, nn = e & 63; float v = src[(size_t)(k0 + kk) * ld + nn]; if (scale) v *= scale[k0 + kk]; tile[kk * 65 + nn] = v; }
        __syncthreads();
#pragma unroll
        for (int n_ = 0; n_ < 4; ++n_) { const int e = tid + 512 * n_; const int nn = e >> 5, kp = (e & 31) * 2; const unsigned w = pack_bf2(tile[kp * 65 + nn], tile[(kp + 1) * 65 + nn]);
            *(unsigned*)(dst + (size_t)(n0 + nn) * DM + k0 + kp) = w; }
    }
    __syncthreads();
}

__device__ void ph_prep(const Params& p_in, LAS unsigned char* lds_in, int blk, int nblk) {
    Params p = p_in; asm volatile("" : "+s"(p.ws), "+s"(p.out));
    LAS unsigned char* lds = lds_in; asm volatile("" : "+s"(lds));

    const int tid = opaque_tid();
    LAS float* tile = (LAS float*)lds;
    convert_weights(p, 0, 0, tile, tid, blk, nblk);
    for (int e = blk * 512 + tid; e < DEPTH * NSM * DM; e += nblk * 512) { const int l = e / (NSM * DM), r = e % (NSM * DM), j = r / DM, k = r % DM;
        ((float*)(p.ws + WS_WSM))[e] = p.w_in[(size_t)l * DM * IN_DIM + (size_t)k * IN_DIM + win_smcol(j)] * p.norm_w[l * DM + k]; }
    for (int c = blk * 512 + tid; c < 256; c += nblk * 512) { float lg[DEPTH], mx = -1e30f;
#pragma unroll
        for (int l = 0; l < DEPTH; ++l) { lg[l] = p.lb_logits[l * 256 + c]; mx = fmaxf(mx, lg[l]); }
        float s = 0.f;
#pragma unroll
        for (int l = 0; l < DEPTH; ++l) { lg[l] = expf(lg[l] - mx); s += lg[l]; }
        float cum = 0.f; const float w0 = lg[0] / s;
#pragma unroll
        for (int l = 0; l < DEPTH; ++l) { cum += lg[l] / s; ((float*)(p.ws + WS_LB))[l * 256 + c] = fmaxf(cum - w0, 0.f); } }
    for (int e = blk * 512 + tid; e < (TP + 1) * 32; e += nblk * 512) { const int pi = e >> 5, i = e & 31; const double pos = pi < TP ? (double)pi : (double)PASTLEN;
        const float invf = (float)(1.0 / pow(10000.0, (double)((float)i / 31.0f)));
        const double rev = pos * (double)invf * 0.15915494309189535; const float fr = (float)(rev - rint(rev));
        ((float*)(p.ws + WS_ROT))[e * 2 + 0] = __builtin_amdgcn_cosf(fr); ((float*)(p.ws + WS_ROT))[e * 2 + 1] = __builtin_amdgcn_sinf(fr); }
    float* h = (float*)(p.ws + WS_H);
    for (int e = blk * 512 + tid; e < MROWS * (DM / 4); e += nblk * 512) { const int row = e >> 8, c4 = (e & 255) * 4; const float* src;
        if (row < MP) { const int b = row / TP, t = row % TP; src = t < NMETA ? p.meta + t * DM : p.x_prompt + ((size_t)b * SEQ + (t - NMETA)) * DM; } else src = p.x_sample + (size_t)(row - MP) * DM;
        *(f32x4*)(h + (size_t)row * DM + c4) = *(const f32x4*)(src + c4); }
}

__device__ void ph_rownorm(const Params& p_in, int layer, int blk, int nblk) {
    Params p = p_in; asm volatile("" : "+s"(p.ws), "+s"(p.out));

    const int tid = opaque_tid(), wid = tid >> 6, lane = tid & 63;
    const float* h = (const float*)(p.ws + WS_H); bf16_t* hb = (bf16_t*)(p.ws + WS_HB); float* rs = (float*)(p.ws + WS_RS); float* psm = (float*)(p.ws + WS_PSM);
    const float* wsm = (const float*)(p.ws + WS_WSM) + (size_t)layer * NSM * DM;
    for (int row = blk * 8 + wid; row < MROWS; row += nblk * 8) {
        f32x4 v[4]; float ss = 0.f;
#pragma unroll
        for (int j = 0; j < 4; ++j) { v[j] = *(const f32x4*)(h + (size_t)row * DM + j * 256 + lane * 4); ss += v[j][0] * v[j][0] + v[j][1] * v[j][1] + v[j][2] * v[j][2] + v[j][3] * v[j][3]; }
        ss = wave_sum(ss, lane); const float r = rsqrtf(ss * (1.0f / DM) + EPSF);
#pragma unroll
        for (int j = 0; j < 4; ++j) { u32x2 w; w.x = pack_bf2(v[j][0], v[j][1]); w.y = pack_bf2(v[j][2], v[j][3]); *(u32x2*)(hb + (size_t)row * DM + j * 256 + lane * 4) = w; }
        float mine = 0.f;
        for (int q = 0; q < NSM; ++q) { float d = 0.f;
#pragma unroll
            for (int j = 0; j < 4; ++j) { const f32x4 w = *(const f32x4*)(wsm + q * DM + j * 256 + lane * 4); d += v[j][0] * w[0] + v[j][1] * w[1] + v[j][2] * w[2] + v[j][3] * w[3]; }
            d = wave_sum(d, lane); if (lane == q) mine = d * r; }
        if (lane < NSM) psm[(size_t)row * NSM + lane] = mine;
        if (lane == 0) rs[row] = r;
    }
}

__device__ void ph_gemm_in(const Params& p_in, int layer, LAS unsigned char* lds_in, int blk, int nblk) {
    Params p = p_in; asm volatile("" : "+s"(p.ws), "+s"(p.out));
    LAS unsigned char* lds = lds_in; asm volatile("" : "+s"(lds));

    pg8::Gemm g{(const bf16_t*)(p.ws + WS_HB), (const bf16_t*)(p.ws + WS_WINT), MROWS, NBIG, DM};
    pg8::StaticOrder S; S.init(MROWS, NBIG, nblk, blk);
    pg8::EpiProj E{(bf16_t*)(p.ws + WS_PROJ), NBIG, (const float*)(p.ws + WS_RS)};
    pg8::gemm_phase<pg8::EpiProj, pg8::StaticOrder>(lds, g, S, E);
}
__device__ void ph_gemm_out(const Params& p_in, int layer, LAS unsigned char* lds_in, int blk, int nblk) {
    Params p = p_in; asm volatile("" : "+s"(p.ws), "+s"(p.out));
    LAS unsigned char* lds = lds_in; asm volatile("" : "+s"(lds));

    pg8::Gemm g{(const bf16_t*)(p.ws + WS_Y), (const bf16_t*)(p.ws + WS_WOUTT), MROWS, DM, DM};
    pg8::StaticOrder S; S.init(MROWS, DM, nblk, blk);
    pg8::EpiResid E{(float*)(p.ws + WS_H), DM};
    pg8::gemm_phase<pg8::EpiResid, pg8::StaticOrder>(lds, g, S, E);
}

constexpr int TB = 16;
struct MixLds {
    static constexpr int QS = 0, KS = QS + TB * 128, VS = KS + TB * 128, DS = VS + TB * 128, ZS = DS + TB * 128, XS = ZS + TB * 128, OS = XS + TB * 128, BS = OS + TB * 128, SC = BS + TB * 2, END = SC + TB * 2;
};

struct SeqInfo { int row0, T, dec, b; };
__device__ __forceinline__ SeqInfo seq_info(int s) { SeqInfo q; if (s < NB) { q.row0 = s * TP; q.T = TP; q.dec = 0; q.b = s; } else { q.row0 = MP + (s - NB); q.T = 1; q.dec = 1; q.b = s - NB; } return q; }

__device__ __forceinline__ float preconv(const bf16_t* proj, const SeqInfo& q, int t, int col, const float* ctx  , int ch) {
    if (t >= 0) return bf2f(proj[(size_t)(q.row0 + t) * NBIG + col]);
    return ctx ? ctx[(3 + t) * 768 + ch] : 0.f;
}

template <int DK, int NV, bool DELTA, bool VECDEC>
__device__ __forceinline__ void recur_batch(float (&S)[DK / (64 / NV)], LAS float* L, int nb, int wid, int lane) {
    constexpr int KQ = 64 / NV, KR = DK / KQ, DVT = 8 * NV;
    const int kq = lane / NV, vv = lane % NV, vcol = wid * NV + vv, hh = vcol >> 6;
    for (int t = 0; t < nb; ++t) {
        float kk[KR], qq[KR];
#pragma unroll
        for (int i = 0; i < KR; ++i) { kk[i] = L[MixLds::KS + t * 128 + kq * KR + i]; qq[i] = L[MixLds::QS + t * 128 + kq * KR + i]; }
        const float v = L[MixLds::VS + t * 128 + vcol];
        if (DELTA) {
            const float dec = L[MixLds::DS + t * 128 + hh]; float pk = 0.f;
#pragma unroll
            for (int i = 0; i < KR; ++i) { S[i] *= dec; pk += kk[i] * S[i]; }
#pragma unroll
            for (int o = NV; o < 64; o <<= 1) pk += lane_xor(pk, o, lane);
            const float u = L[MixLds::BS + t] * (v - pk);
#pragma unroll
            for (int i = 0; i < KR; ++i) S[i] += kk[i] * u;
        } else if (VECDEC) {
#pragma unroll
            for (int i = 0; i < KR; ++i) S[i] = L[MixLds::DS + t * 128 + kq * KR + i] * S[i] + kk[i] * v;
        } else {
            const float dec = L[MixLds::DS + t * 128 + hh];
#pragma unroll
            for (int i = 0; i < KR; ++i) S[i] = dec * S[i] + kk[i] * v;
        }
        float po = 0.f;
#pragma unroll
        for (int i = 0; i < KR; ++i) po += qq[i] * S[i];
#pragma unroll
        for (int o = NV; o < 64; o <<= 1) po += lane_xor(po, o, lane);
        if (kq == 0) L[MixLds::OS + t * 128 + vcol] = po;
    }
    (void)DVT;
}

template <int MIX>
__device__ void mixer_item(const Params& p, int layer, int s, int hu  , LAS float* L) {
    constexpr int DK = MIX == 2 ? 128 : 64, NV = MIX == 2 ? 16 : 8, KQ = 64 / NV, KR = DK / KQ, DVT = 8 * NV;
    const int tid = opaque_tid(), wid = tid >> 6, lane = tid & 63;
    const SeqInfo q = seq_info(s);
    const bf16_t* proj = (const bf16_t*)(p.ws + WS_PROJ); const float* psm = (const float*)(p.ws + WS_PSM); bf16_t* y = (bf16_t*)(p.ws + WS_Y);
    const float* lb = (const float*)(p.ws + WS_LB) + layer * 256; const float* rot = (const float*)(p.ws + WS_ROT);
    const int kq = lane / NV, vv = lane % NV, vcol = wid * NV + vv, hh = vcol >> 6;
    const int head = MIX == 2 ? hu * 2 + hh : hu;
    const float* ctx = nullptr; const float* cw = nullptr;
    if (MIX == 1) { cw = p.gdn_conv_w + (size_t)layer * 4 * 768; if (q.dec) ctx = p.st_gconv + ((size_t)layer * DECB + q.b) * 3 * 768; }
    if (MIX == 2) { cw = p.ssd_conv_w + (size_t)layer * 4 * 768; if (q.dec) ctx = p.st_sconv + ((size_t)layer * DECB + q.b) * 3 * 768; }
    float S[KR];
    {
        const float* st = MIX == 0 ? p.st_hgrn : MIX == 1 ? p.st_gdn : MIX == 2 ? p.st_ssd : p.st_ret;
#pragma unroll
        for (int i = 0; i < KR; ++i) S[i] = q.dec ? st[(((size_t)layer * DECB + q.b) * 4 + head) * DK * 64 + (size_t)(kq * KR + i) * 64 + (vcol & 63)] : 0.f;
    }
    float hc0 = 0.f, hc1 = 0.f;
    if (MIX == 1) { hc0 = -__expf(p.gdn_a_log[layer * 4 + hu]); hc1 = p.gdn_dt_bias[layer * 4 + hu]; }
    if (MIX == 3) { hc0 = 1.0f - exp2f(-5.0f - (float)hu); }

    for (int t0 = 0; t0 < q.T; t0 += TB) {
        const int nb = min(TB, q.T - t0);
        __syncthreads();
        if (MIX == 0) {
            for (int e = tid; e < nb * 64; e += 512) { const int t = e >> 6, d = e & 63, c = hu * 64 + d; const bf16_t* pr = proj + (size_t)(q.row0 + t0 + t) * NBIG;
                const float aq = bf2f(pr[PC_AQ + c]), af = bf2f(pr[PC_AF + c]), ai = bf2f(pr[PC_AI + c]), az = bf2f(pr[PC_AZ + c]), l_ = lb[c];
                L[MixLds::QS + t * 128 + d] = silu_f(aq) * 0.125f; L[MixLds::KS + t * 128 + d] = (1.0f - l_) * sigmoid_f(-af); L[MixLds::DS + t * 128 + d] = l_ + (1.0f - l_) * sigmoid_f(af);
                L[MixLds::VS + t * 128 + d] = ai; L[MixLds::ZS + t * 128 + d] = az; }
        } else if (MIX == 1) {
            for (int e = tid; e < nb * 192; e += 512) { const int t = e / 192, r = e % 192, part = r >> 6, d = r & 63, ch = part * 256 + hu * 64 + d, col = PC_BQKV + ch; const int tt = t0 + t;
                float a = 0.f;
#pragma unroll
                for (int j = 0; j < 4; ++j) a += cw[j * 768 + ch] * preconv(proj, q, tt - 3 + j, col, ctx, ch);
                a = silu_f(a);
                L[(part == 0 ? MixLds::QS : part == 1 ? MixLds::KS : MixLds::VS) + t * 128 + d] = a; }
            for (int e = tid; e < nb * 64; e += 512) { const int t = e >> 6, d = e & 63; L[MixLds::ZS + t * 128 + d] = bf2f(proj[(size_t)(q.row0 + t0 + t) * NBIG + PC_BZ + hu * 64 + d]); }
            if (tid < nb) { const float* ps = psm + (size_t)(q.row0 + t0 + tid) * NSM; const float g = hc0 * softplus_f(ps[hu] + hc1);
                L[MixLds::DS + tid * 128 + 0] = __expf(g); L[MixLds::BS + tid] = sigmoid_f(ps[4 + hu]); }
            __syncthreads();
            if (tid < nb * 2) { const int t = tid >> 1, which = tid & 1; const LAS float* src = L + (which ? MixLds::KS : MixLds::QS) + t * 128; float ss = 0.f;
                for (int d = 0; d < 64; ++d) ss += src[d] * src[d];
                L[MixLds::SC + tid] = rsqrtf(ss + EPSF) * (which ? 1.0f : 0.125f); }
            __syncthreads();
            for (int e = tid; e < nb * 128; e += 512) { const int t = e >> 7, r = e & 127, which = r >> 6, d = r & 63; L[(which ? MixLds::KS : MixLds::QS) + t * 128 + d] *= L[MixLds::SC + t * 2 + which]; }
        } else if (MIX == 2) {
            if (tid < nb * 2) { const int t = tid >> 1, h2 = tid & 1, hd = hu * 2 + h2; const float dt = softplus_f(psm[(size_t)(q.row0 + t0 + t) * NSM + 8 + hd] + p.ssd_dt_bias[layer * 4 + hd]);
                L[MixLds::BS + tid] = dt; L[MixLds::DS + t * 128 + h2] = __expf(-dt * __expf(p.ssd_a_log[layer * 4 + hd])); }
            __syncthreads();
            for (int e = tid; e < nb * 384; e += 512) { const int t = e / 384, r = e % 384, part = r >> 7, j = r & 127, ch = part * 256 + hu * 128 + j, col = PC_CXBC + ch; const int tt = t0 + t;
                float a = p.ssd_conv_b[layer * 768 + ch];
#pragma unroll
                for (int jj = 0; jj < 4; ++jj) a += cw[jj * 768 + ch] * preconv(proj, q, tt - 3 + jj, col, ctx, ch);
                a = silu_f(a);
                if (part == 0) { L[MixLds::XS + t * 128 + j] = a; L[MixLds::VS + t * 128 + j] = a * L[MixLds::BS + t * 2 + (j >> 6)]; }
                else if (part == 1) L[MixLds::KS + t * 128 + j] = a; else L[MixLds::QS + t * 128 + j] = a; }
            for (int e = tid; e < nb * 128; e += 512) { const int t = e >> 7, j = e & 127; L[MixLds::ZS + t * 128 + j] = bf2f(proj[(size_t)(q.row0 + t0 + t) * NBIG + PC_CZ + hu * 128 + j]); }
        } else {
            for (int e = tid; e < nb * 32; e += 512) { const int t = e >> 5, i = e & 31; const bf16_t* pr = proj + (size_t)(q.row0 + t0 + t) * NBIG; const int pidx = q.dec ? TP : (t0 + t);
                const float cs = rot[(pidx * 32 + i) * 2], sn = rot[(pidx * 32 + i) * 2 + 1];
                const float q1 = bf2f(pr[PC_DQ + hu * 64 + i]), q2 = bf2f(pr[PC_DQ + hu * 64 + 32 + i]), k1 = bf2f(pr[PC_DK + hu * 64 + i]), k2 = bf2f(pr[PC_DK + hu * 64 + 32 + i]);
                L[MixLds::QS + t * 128 + i] = q1 * cs - q2 * sn; L[MixLds::QS + t * 128 + 32 + i] = q2 * cs + q1 * sn;
                L[MixLds::KS + t * 128 + i] = (k1 * cs - k2 * sn) * 0.125f; L[MixLds::KS + t * 128 + 32 + i] = (k2 * cs + k1 * sn) * 0.125f; }
            for (int e = tid; e < nb * 64; e += 512) { const int t = e >> 6, d = e & 63; const bf16_t* pr = proj + (size_t)(q.row0 + t0 + t) * NBIG;
                L[MixLds::VS + t * 128 + d] = bf2f(pr[PC_DV + hu * 64 + d]); L[MixLds::ZS + t * 128 + d] = bf2f(pr[PC_DZ + hu * 64 + d]); }
            if (tid < nb) L[MixLds::DS + tid * 128] = hc0;
        }
        __syncthreads();
        recur_batch<DK, NV, MIX == 1, MIX == 0>(S, L, nb, wid, lane);
        __syncthreads();
        for (int t = wid; t < nb; t += 8) {
            const size_t yrow = (size_t)(q.row0 + t0 + t) * DM;
            if (MIX == 0 || MIX == 1) { const float o = L[MixLds::OS + t * 128 + lane]; const float ms = wave_sum(o * o, lane) * (1.0f / 64.0f);
                const float w = (MIX == 0 ? p.hgrn_norm_w : p.gdn_norm_w)[layer * 256 + hu * 64 + lane];
                y[yrow + (MIX == 0 ? 0 : 256) + hu * 64 + lane] = f2bf(o * rsqrtf(ms + EPSF) * w * silu_f(L[MixLds::ZS + t * 128 + lane])); }
            else if (MIX == 2) { float u[2]; float ss = 0.f;
#pragma unroll
                for (int r = 0; r < 2; ++r) { const int j = lane + 64 * r; const float o = L[MixLds::OS + t * 128 + j] + p.ssd_d[layer * 4 + hu * 2 + r] * L[MixLds::XS + t * 128 + j]; u[r] = o * silu_f(L[MixLds::ZS + t * 128 + j]); ss += u[r] * u[r]; }
                const float sc = rsqrtf(wave_sum(ss, lane) * (1.0f / 128.0f) + EPSF);
#pragma unroll
                for (int r = 0; r < 2; ++r) { const int j = lane + 64 * r; y[yrow + 512 + hu * 128 + j] = f2bf(u[r] * sc * p.ssd_norm_w[layer * 256 + hu * 128 + j]); } }
            else { const float o = L[MixLds::OS + t * 128 + lane]; const float mu = wave_sum(o, lane) * (1.0f / 64.0f); const float dv = o - mu; const float var = wave_sum(dv * dv, lane) * (1.0f / 64.0f);
                const int c = hu * 64 + lane;
                y[yrow + 768 + c] = f2bf((dv * rsqrtf(var + EPSF) * p.ret_norm_w[layer * 256 + c] + p.ret_norm_b[layer * 256 + c]) * silu_f(L[MixLds::ZS + t * 128 + lane])); }
        }
    }
    {
        float* so = p.out + (q.dec ? (MIX == 0 ? O_HGRN_S : MIX == 1 ? O_GDN_S : MIX == 2 ? O_SSD_S : O_RET_S) : (MIX == 0 ? O_HGRN_P : MIX == 1 ? O_GDN_P : MIX == 2 ? O_SSD_P : O_RET_P));
        const int nbt = q.dec ? DECB : NB;
#pragma unroll
        for (int i = 0; i < KR; ++i) so[(((size_t)layer * nbt + q.b) * 4 + head) * DK * 64 + (size_t)(kq * KR + i) * 64 + (vcol & 63)] = S[i];
    }
    if (MIX == 1 || MIX == 2) {
        float* co = p.out + (q.dec ? (MIX == 1 ? O_GCONV_S : O_SCONV_S) : (MIX == 1 ? O_GCONV_P : O_SCONV_P)) + ((size_t)layer * (q.dec ? DECB : NB) + q.b) * 3 * 768;
        const int nch = MIX == 1 ? 192 : 384;
        for (int e = tid; e < 3 * nch; e += 512) { const int r = e / nch, c = e % nch; int ch;
            if (MIX == 1) ch = (c >> 6) * 256 + hu * 64 + (c & 63); else ch = (c >> 7) * 256 + hu * 128 + (c & 127);
            co[r * 768 + ch] = preconv(proj, q, q.T - 3 + r, (MIX == 1 ? PC_BQKV : PC_CXBC) + ch, ctx, ch); }
    }
    (void)DVT;
}

constexpr int NCHUNK = 33;
constexpr int LDP = 72;
constexpr int LDP2 = 136;
constexpr int OSP = 68;
typedef short bf16x4 __attribute__((ext_vector_type(4)));
__device__ __forceinline__ f32x4 mfma16(bf16x8 a, bf16x8 b, f32x4 c) { return __builtin_amdgcn_mfma_f32_16x16x32_bf16(a, b, c, 0, 0, 0); }
__device__ __forceinline__ float fexp2(float x) { return __builtin_amdgcn_exp2f(x); }
__device__ __forceinline__ bf16x8 frag_ld(const LAS bf16_t* t, int pitch, int row, int col) { return *(const LAS bf16x8*)(t + row * pitch + col); }
__device__ __forceinline__ bf16x8 frag_ld_perm(const LAS bf16_t* t, int pitch, int row, int k0, int q) {
    const bf16x4 lo = *(const LAS bf16x4*)(t + row * pitch + k0 + 4 * q), hi = *(const LAS bf16x4*)(t + row * pitch + k0 + 16 + 4 * q);
    return __builtin_shufflevector(lo, hi, 0, 1, 2, 3, 4, 5, 6, 7);
}
__device__ __forceinline__ bf16x8 pack_acc2(const f32x4& a, const f32x4& b) {
    u32x4 w; w.x = pg8::cvt_pk_bf16(a[0], a[1]); w.y = pg8::cvt_pk_bf16(a[2], a[3]); w.z = pg8::cvt_pk_bf16(b[0], b[1]); w.w = pg8::cvt_pk_bf16(b[2], b[3]);
    return __builtin_bit_cast(bf16x8, w);
}
__device__ __forceinline__ void st_bf4(LAS bf16_t* dst, const f32x4& v) { u32x2 w; w.x = pg8::cvt_pk_bf16(v[0], v[1]); w.y = pg8::cvt_pk_bf16(v[2], v[3]); *(LAS u32x2*)dst = w; }
__device__ __forceinline__ void unpack_bf8(const u32x4& w, float* a) { const unsigned x[4] = {w.x, w.y, w.z, w.w};
#pragma unroll
    for (int k = 0; k < 4; ++k) { a[2 * k] = __uint_as_float(x[k] << 16); a[2 * k + 1] = __uint_as_float(x[k] & 0xffff0000u); } }
__device__ __forceinline__ u32x4 pack_bf8(const float* a) { u32x4 w; w.x = pg8::cvt_pk_bf16(a[0], a[1]); w.y = pg8::cvt_pk_bf16(a[2], a[3]); w.z = pg8::cvt_pk_bf16(a[4], a[5]); w.w = pg8::cvt_pk_bf16(a[6], a[7]); return w; }

constexpr size_t HR_QF = 0, HR_OI = 8192, HR_DS = 16384, HR_VEC = 24576, HR_UNIT = 25088;
constexpr size_t SS_QF = 0, SS_HEAD = 16384  , SS_VEC = 65536  , SS_UNIT = 66560;
constexpr size_t GD_U = 0, GD_W = 8192, GD_Q = 16384, GD_P = 24576, GD_K = 32768, GD_VEC = 40960, GD_UNIT = 41728;
constexpr size_t YOFF_R = 37748736;
static_assert((size_t)NB * NCHUNK * 2 * SS_UNIT <= YOFF_R && YOFF_R + (size_t)NB * NCHUNK * 4 * HR_UNIT <= (size_t)NB * SEQ * DM * 4 && (size_t)NB * NCHUNK * 4 * HR_UNIT <= (size_t)MROWS * DM * 2 && (size_t)NB * NCHUNK * 4 * GD_UNIT == WS_END - WS_E, "scratch map");
__device__ __forceinline__ unsigned char* rec_hgrn(const Params& p, int b, int c, int h) { return p.ws + WS_HB + (size_t)((b * NCHUNK + c) * 4 + h) * HR_UNIT; }
__device__ __forceinline__ unsigned char* rec_ret(const Params& p, int b, int c, int h) { return (unsigned char*)(p.out + O_YP) + YOFF_R + (size_t)((b * NCHUNK + c) * 4 + h) * HR_UNIT; }
__device__ __forceinline__ unsigned char* rec_gdn(const Params& p, int b, int c, int h) { return p.ws + WS_E + (size_t)((b * NCHUNK + c) * 4 + h) * GD_UNIT; }
__device__ __forceinline__ unsigned char* rec_ssd(const Params& p, int b, int c, int g) { return (unsigned char*)(p.out + O_YP) + (size_t)((b * NCHUNK + c) * 2 + g) * SS_UNIT; }
__device__ __forceinline__ bf16x8 frag_scale(const bf16x8& f, const float (&sc)[8]) { const u32x4 w = __builtin_bit_cast(u32x4, f); float a[8]; unpack_bf8(w, a);
#pragma unroll
    for (int e = 0; e < 8; ++e) a[e] *= sc[e];
    return __builtin_bit_cast(bf16x8, pack_bf8(a)); }
__device__ __forceinline__ void st_acc_bf4(unsigned char* dst, const f32x4& v) { u32x2 w; w.x = pg8::cvt_pk_bf16(v[0], v[1]); w.y = pg8::cvt_pk_bf16(v[2], v[3]); *(u32x2*)dst = w; }
__device__ __forceinline__ f32x4 ld_acc_bf4(const unsigned char* src) { const u32x2 w = *(const u32x2*)src; return (f32x4){__uint_as_float(w.x << 16), __uint_as_float(w.x & 0xffff0000u), __uint_as_float(w.y << 16), __uint_as_float(w.y & 0xffff0000u)}; }

template <int NR> struct Raw192 {
    static constexpr int NP = NR * 24, PPT = (NP + 511) / 512;
    u32x4 pc[PPT]; float sv[2];
    __device__ __forceinline__ void load(const bf16_t* projb, int tfirst, int col0, int col1, int col2, int tid) {
#pragma unroll
        for (int k = 0; k < PPT; ++k) { const int id = min(tid + 512 * k, NP - 1), row = id / 24, seg = id % 24, part = seg >> 3, t = tfirst + row;
            const u32x4 v = *(const u32x4*)(projb + (size_t)max(t, 0) * NBIG + (part == 0 ? col0 : part == 1 ? col1 : col2) + (seg & 7) * 8);
            pc[k] = t >= 0 ? v : (u32x4){0u, 0u, 0u, 0u}; }
    }
    __device__ __forceinline__ void to_lds(LAS bf16_t* T  , int tid) const {
#pragma unroll
        for (int k = 0; k < PPT; ++k) { const int id = tid + 512 * k; if (id < NP) *(LAS u32x4*)(T + (id / 24) * 192 + (id % 24) * 8) = pc[k]; }
    }
};
__device__ __forceinline__ void unit_bch(int v, int& b, int& c, int& h) { b = v / (NCHUNK * 4); c = (v >> 2) % NCHUNK; h = v & 3; }

struct RetRaw { Raw192<64> q; u32x4 rt[2];
    __device__ __forceinline__ void load(const Params& p, int v, int tid) { int b, c, h; unit_bch(v, b, c, h); const int t0 = 64 * c - 48;
        q.load((const bf16_t*)(p.ws + WS_PROJ) + (size_t)(b * TP) * NBIG, t0, PC_DQ + h * 64, PC_DK + h * 64, PC_DV + h * 64, tid);
#pragma unroll
        for (int k = 0; k < 2; ++k) { const int id = tid + 512 * k, row = id >> 4, sg = id & 15; rt[k] = *(const u32x4*)((const float*)(p.ws + WS_ROT) + (size_t)max(t0 + row, 0) * 64 + sg * 4); } }
};
struct RetLds { static constexpr int QS = 0, KS = QS + 64 * LDP * 2, KT = KS + 64 * LDP * 2, VT = KT + 64 * LDP * 2, VH = VT + 64 * LDP * 2, PS = VH + 64 * LDP * 2, RAW = PS + 64 * LDP * 2, ROT = RAW + 64 * 192 * 2, END = ROT + 64 * 64 * 4; };
__device__ void ret_pre_unit(const Params& p, int layer, int v_this, int v_next, RetRaw& RR, LAS unsigned char* lds) {
    int b, c, hu; unit_bch(v_this, b, c, hu);
    const int tid = opaque_tid(), wid = tid >> 6, lane = tid & 63, fq = lane >> 4, fc = lane & 15;
    LAS bf16_t* Qs = (LAS bf16_t*)(lds + RetLds::QS); LAS bf16_t* Ks = (LAS bf16_t*)(lds + RetLds::KS); LAS bf16_t* KT = (LAS bf16_t*)(lds + RetLds::KT);
    LAS bf16_t* VT = (LAS bf16_t*)(lds + RetLds::VT); LAS bf16_t* VH = (LAS bf16_t*)(lds + RetLds::VH); LAS bf16_t* Ps = (LAS bf16_t*)(lds + RetLds::PS);
    LAS bf16_t* RawT = (LAS bf16_t*)(lds + RetLds::RAW); LAS float* RotT = (LAS float*)(lds + RetLds::ROT);
    const float lg2 = log2f(1.0f - exp2f(-5.0f - (float)hu));
    const int i0 = c == 0 ? 48 : 0, nlast = 64 - i0;
    unsigned char* rec = rec_ret(p, b, c, hu);
    __syncthreads();
    RR.q.to_lds(RawT, tid);
#pragma unroll
    for (int k = 0; k < 2; ++k) *(LAS u32x4*)(RotT + (tid + 512 * k) * 4) = RR.rt[k];
    if (v_next >= 0) RR.load(p, v_next, tid);
    __syncthreads();
#pragma unroll
    for (int n_ = 0; n_ < 4; ++n_) { const int e = tid + 512 * n_; const int i = e >> 5, d = e & 31; float qa, qb, ka, kb;
        { const LAS bf16_t* pr = RawT + i * 192; const float cs = RotT[i * 64 + 2 * d], sn = RotT[i * 64 + 2 * d + 1];
            const float q1 = bf2f(pr[d]), q2 = bf2f(pr[32 + d]), k1 = bf2f(pr[64 + d]), k2 = bf2f(pr[96 + d]);
            const float mk = i >= i0 ? 1.0f : 0.0f;
            qa = (q1 * cs - q2 * sn) * mk; qb = (q2 * cs + q1 * sn) * mk; ka = (k1 * cs - k2 * sn) * (0.125f * mk); kb = (k2 * cs + k1 * sn) * (0.125f * mk); }
        Qs[i * LDP + d] = f2bf(qa); Qs[i * LDP + 32 + d] = f2bf(qb); Ks[i * LDP + d] = f2bf(ka); Ks[i * LDP + 32 + d] = f2bf(kb);
        KT[d * LDP + i] = f2bf(ka); KT[(d + 32) * LDP + i] = f2bf(kb); }
#pragma unroll
    for (int n_ = 0; n_ < 8; ++n_) { const int e = tid + 512 * n_; const int i = e >> 6, d = e & 63;
        float v = bf2f(RawT[i * 192 + 128 + d]); v = i >= i0 ? v : 0.f; const float vh = v * fexp2((float)(63 - i) * lg2);
        VT[d * LDP + i] = f2bf(v); VH[d * LDP + i] = f2bf(vh); }
    __syncthreads();
#pragma unroll
    for (int tt = 0; tt < 2; ++tt) { const int t = wid * 2 + tt, I = t >> 2, J = t & 3; f32x4 acc = (f32x4){0.f, 0.f, 0.f, 0.f};
        if (J <= I) {
#pragma unroll
            for (int s = 0; s < 2; ++s) acc = mfma16(frag_ld(Ks, LDP, 16 * J + fc, 32 * s + 8 * fq), frag_ld(Qs, LDP, 16 * I + fc, 32 * s + 8 * fq), acc); }
        const int i = 16 * I + fc;
#pragma unroll
        for (int r = 0; r < 4; ++r) { const int j = 16 * J + 4 * fq + r; acc[r] = (j <= i && j >= i0) ? acc[r] * fexp2((float)(i - j) * lg2) : 0.f; }
        st_bf4(Ps + i * LDP + 16 * J + 4 * fq, acc); }
    __syncthreads();
    { const int w = wid & 3; bf16x8 bb[2];
#pragma unroll
        for (int s = 0; s < 2; ++s) bb[s] = frag_ld(wid < 4 ? VT : VH, LDP, 16 * w + fc, 32 * s + 8 * fq);
        const LAS bf16_t* At = wid < 4 ? Ps : KT; unsigned char* dst = rec + (wid < 4 ? HR_OI : HR_DS);
#pragma unroll
        for (int m = 0; m < 4; ++m) { f32x4 acc = (f32x4){0.f, 0.f, 0.f, 0.f};
#pragma unroll
            for (int s = 0; s < 2; ++s) acc = mfma16(frag_ld(At, LDP, 16 * m + fc, 32 * s + 8 * fq), bb[s], acc);
            st_acc_bf4(dst + ((size_t)(w * 4 + m) * 64 + lane) * 8, acc); }
        { const float eg = fexp2((float)max(16 * (wid >> 1) + fc - i0 + 1, 0) * lg2); const float sc[8] = {eg, eg, eg, eg, eg, eg, eg, eg};
            *(bf16x8*)(rec + HR_QF + ((size_t)wid * 64 + lane) * 16) = frag_scale(frag_ld_perm(Qs, LDP, 16 * (wid >> 1) + fc, 32 * (wid & 1), fq), sc); }
        if (tid < 64) { float* gv = (float*)(rec + HR_VEC); gv[64 + tid] = fexp2((float)nlast * lg2); } }
}

struct HgLds { static constexpr int LS = 0  , KR = LS + 16384  , QR = KR + 16384  , QT = QR + 16384, QH = QT + 64 * LDP * 2, KT = QH + 64 * LDP * 2  ,
    KHT = KT + 160 * LDP * 2, VT = KHT + 64 * LDP * 2, PS = VT + 64 * LDP * 2, AV = PS + 64 * LDP * 2, RAW = AV + 256, END = RAW + 64 * 192 * 2; };
struct HgRaw { Raw192<64> q;
    __device__ __forceinline__ void load(const Params& p, int v, int tid) { int b, c, h; unit_bch(v, b, c, h);
        q.load((const bf16_t*)(p.ws + WS_PROJ) + (size_t)(b * TP) * NBIG, 64 * c - 48, PC_AQ + h * 64, PC_AF + h * 64, PC_AI + h * 64, tid); }
};
__device__ void hgrn_pre_unit(const Params& p, int layer, int v_this, int v_next, HgRaw& RR, LAS unsigned char* lds) {
    int b, c, hu; unit_bch(v_this, b, c, hu);
    const int tid = opaque_tid(), wid = tid >> 6, lane = tid & 63, fq = lane >> 4, fc = lane & 15;
    LAS float* Ls = (LAS float*)(lds + HgLds::LS); LAS float* Kr = (LAS float*)(lds + HgLds::KR); LAS float* Qr = (LAS float*)(lds + HgLds::QR);
    LAS bf16_t* Qt = (LAS bf16_t*)(lds + HgLds::QT); LAS bf16_t* Qh = (LAS bf16_t*)(lds + HgLds::QH); LAS bf16_t* Kt = (LAS bf16_t*)(lds + HgLds::KT); LAS bf16_t* KhT = (LAS bf16_t*)(lds + HgLds::KHT);
    LAS bf16_t* VT = (LAS bf16_t*)(lds + HgLds::VT); LAS bf16_t* Ps = (LAS bf16_t*)(lds + HgLds::PS); LAS float* Av = (LAS float*)(lds + HgLds::AV);
    LAS bf16_t* RawT = (LAS bf16_t*)(lds + HgLds::RAW);
    const float lbv = ((const float*)(p.ws + WS_LB))[layer * 256 + hu * 64 + lane];
    const int i0 = c == 0 ? 48 : 0;
    unsigned char* rec = rec_hgrn(p, b, c, hu);
    __syncthreads();
    RR.q.to_lds(RawT, tid);
    if (v_next >= 0) RR.load(p, v_next, tid);
    __syncthreads();
    if (wid < 4) { float acc = 0.f; float afr[16];
#pragma unroll
        for (int ii = 0; ii < 16; ++ii) { const int i = 16 * wid + ii; afr[ii] = bf2f(RawT[i * 192 + 64 + lane]); }
#pragma unroll
        for (int ii = 0; ii < 16; ++ii) { const int i = 16 * wid + ii; float kk;
            { float af = afr[ii]; af = fminf(fmaxf(af, -30.f), 30.f);
                const float e = __expf(-af), sg = __builtin_amdgcn_rcpf(1.0f + e); const float f = lbv + (1.0f - lbv) * sg; const bool ok = i >= i0; kk = ok ? (1.0f - lbv) * e * sg : 0.f; acc += ok ? __log2f(fmaxf(f, 1e-30f)) : 0.f; }
            Ls[i * 64 + lane] = acc; Kr[i * 64 + lane] = kk; } }
    else {
#pragma unroll
        for (int n_ = 0; n_ < 16; ++n_) { const int e = tid - 256 + 256 * n_; const int i = e >> 6, d = e & 63;
            const LAS bf16_t* pr = RawT + i * 192; float q = silu_f(bf2f(pr[d])) * 0.125f, v = bf2f(pr[128 + d]); if (i < i0) { q = 0.f; v = 0.f; }
            Qr[i * 64 + d] = q; VT[d * LDP + i] = f2bf(v); } }
    __syncthreads();
#pragma unroll 2
    for (int n_ = 0; n_ < 8; ++n_) { const int e = tid + 512 * n_; const int i = e >> 6, d = e & 63, I = i >> 4;
        const float T0 = Ls[15 * 64 + d], T1 = Ls[31 * 64 + d], T2 = Ls[47 * 64 + d], T3 = Ls[63 * 64 + d];
        const float Bi = I == 0 ? 0.f : I == 1 ? T0 : I == 2 ? T0 + T1 : T0 + T1 + T2; const float Li = Ls[i * 64 + d], Gi = Bi + Li, Gl = T0 + T1 + T2 + T3;
        const float q = Qr[i * 64 + d], k = Kr[i * 64 + d];
        Qt[i * LDP + d] = f2bf(q * fexp2(Li)); Qh[i * LDP + d] = f2bf(q * fexp2(Gi)); KhT[d * LDP + i] = f2bf(k * fexp2(Gl - Gi));
        float Bp = Bi;
        Kt[((I == 0 ? 0 : I == 1 ? 16 : I == 2 ? 48 : 96) + i) * LDP + d] = f2bf(k * fexp2(Bp - Gi));
        if (I <= 0) { Bp = T0; Kt[(16 + i) * LDP + d] = f2bf(k * fexp2(Bp - Gi)); }
        if (I <= 1) { Bp = T0 + T1; Kt[(48 + i) * LDP + d] = f2bf(k * fexp2(Bp - Gi)); }
        if (I <= 2) { Bp = T0 + T1 + T2; Kt[(96 + i) * LDP + d] = f2bf(k * fexp2(Bp - Gi)); }
        if (i == 0) Av[d] = fexp2(Gl); }
    __syncthreads();
#pragma unroll
    for (int tt = 0; tt < 2; ++tt) { const int t = wid * 2 + tt, I = t >> 2, J = t & 3; f32x4 acc = (f32x4){0.f, 0.f, 0.f, 0.f};
        if (J <= I) { const int kb = (I == 0 ? 0 : I == 1 ? 16 : I == 2 ? 48 : 96) + 16 * J;
#pragma unroll
            for (int s = 0; s < 2; ++s) acc = mfma16(frag_ld(Kt, LDP, kb + fc, 32 * s + 8 * fq), frag_ld(Qt, LDP, 16 * I + fc, 32 * s + 8 * fq), acc); }
        const int i = 16 * I + fc;
#pragma unroll
        for (int r = 0; r < 4; ++r) { const int j = 16 * J + 4 * fq + r; acc[r] = (j <= i) ? acc[r] : 0.f; }
        st_bf4(Ps + i * LDP + 16 * J + 4 * fq, acc); }
    __syncthreads();
    { const int w = wid & 3; bf16x8 bb[2];
#pragma unroll
        for (int s = 0; s < 2; ++s) bb[s] = frag_ld(VT, LDP, 16 * w + fc, 32 * s + 8 * fq);
        const LAS bf16_t* At = wid < 4 ? Ps : KhT; unsigned char* dst = rec + (wid < 4 ? HR_OI : HR_DS);
#pragma unroll
        for (int m = 0; m < 4; ++m) { f32x4 acc = (f32x4){0.f, 0.f, 0.f, 0.f};
#pragma unroll
            for (int s = 0; s < 2; ++s) acc = mfma16(frag_ld(At, LDP, 16 * m + fc, 32 * s + 8 * fq), bb[s], acc);
            st_acc_bf4(dst + ((size_t)(w * 4 + m) * 64 + lane) * 8, acc); }
        *(bf16x8*)(rec + HR_QF + ((size_t)wid * 64 + lane) * 16) = frag_ld_perm(Qh, LDP, 16 * (wid >> 1) + fc, 32 * (wid & 1), fq);
        if (tid < 64) { float* gv = (float*)(rec + HR_VEC); gv[64 + tid] = Av[tid]; } }
}

struct SsdLds { static constexpr int CS = 0, BS = CS + 64 * LDP2 * 2, BT = BS + 64 * LDP2 * 2, XS = BT + 128 * LDP * 2, VT = XS + 64 * LDP2 * 2  , VH = VT + 2 * 64 * LDP * 2, PS = VH + 2 * 64 * LDP * 2  ,
    DT = PS + 67 * 384 * 2  , GV = DT + 512, END = GV + 512; };
constexpr int SSD_NPIECE = 67 * 48;
struct SsRaw { u32x4 raw[7]; float psmv;
    __device__ __forceinline__ void load(const Params& p, int t, int tid) { const int b = t / (NCHUNK * 2), c = (t >> 1) % NCHUNK, gg = t & 1, t0 = 64 * c - 48;
        const bf16_t* projb = (const bf16_t*)(p.ws + WS_PROJ) + (size_t)(b * TP) * NBIG;
#pragma unroll
        for (int k = 0; k < 7; ++k) { const int id = min(tid + 512 * k, SSD_NPIECE - 1), row = id / 48, seg = id % 48, tt = t0 - 3 + row;
            const u32x4 v = *(const u32x4*)(projb + (size_t)max(tt, 0) * NBIG + PC_CXBC + (seg >> 4) * 256 + gg * 128 + (seg & 15) * 8);
            raw[k] = tt >= 0 ? v : (u32x4){0u, 0u, 0u, 0u}; }
        psmv = ((const float*)(p.ws + WS_PSM))[(size_t)(b * TP + max(t0 + (tid & 63), 0)) * NSM + 8 + gg * 2 + ((tid >> 6) & 1)]; }
};
__device__ void ssd_pre_unit(const Params& p, int layer, int t_this, int t_next, SsRaw& RR, LAS unsigned char* lds) {
    const int b = t_this / (NCHUNK * 2), c = (t_this >> 1) % NCHUNK, gg = t_this & 1;
    const int tid = opaque_tid(), wid = tid >> 6, lane = tid & 63, fq = lane >> 4, fc = lane & 15;
    LAS bf16_t* Cs = (LAS bf16_t*)(lds + SsdLds::CS); LAS bf16_t* Bs = (LAS bf16_t*)(lds + SsdLds::BS); LAS bf16_t* BT = (LAS bf16_t*)(lds + SsdLds::BT); LAS bf16_t* Xs = (LAS bf16_t*)(lds + SsdLds::XS);
    LAS bf16_t* VT = (LAS bf16_t*)(lds + SsdLds::VT); LAS bf16_t* VH = (LAS bf16_t*)(lds + SsdLds::VH); LAS bf16_t* Ps = (LAS bf16_t*)(lds + SsdLds::PS); LAS bf16_t* RawT = Ps;
    LAS float* DTv = (LAS float*)(lds + SsdLds::DT); LAS float* Gv = (LAS float*)(lds + SsdLds::GV);
    const bf16_t* projb = (const bf16_t*)(p.ws + WS_PROJ) + (size_t)(b * TP) * NBIG; const float* psmb = (const float*)(p.ws + WS_PSM) + (size_t)(b * TP) * NSM;
    const float* cw = p.ssd_conv_w + (size_t)layer * 4 * 768; const float* cb = p.ssd_conv_b + (size_t)layer * 768;
    constexpr float L2E = 1.4426950408889634f;
    const int hh = wid >> 2, ws = wid & 3;
    const int i0 = c == 0 ? 48 : 0, t0 = 64 * c - 48;
    unsigned char* rec = rec_ssd(p, b, c, gg);
    const float psmv = RR.psmv;
    __syncthreads();
    if (wid < 2) { const int hd = gg * 2 + wid;
        float dt = softplus_f(psmv + p.ssd_dt_bias[layer * 4 + hd]); dt = lane >= i0 ? dt : 0.f;
        float G = -dt * __expf(p.ssd_a_log[layer * 4 + hd]) * L2E;
#pragma unroll
        for (int o = 1; o < 64; o <<= 1) { const float t = lane_up(G, o, lane); if (lane >= o) G += t; }
        DTv[wid * 64 + lane] = dt; Gv[wid * 64 + lane] = G; }
#pragma unroll
    for (int k = 0; k < 7; ++k) { const int id = tid + 512 * k; if (id < SSD_NPIECE) *(LAS u32x4*)(RawT + (id / 48) * 384 + (id % 48) * 8) = RR.raw[k]; }
    if (t_next >= 0) RR.load(p, t_next, tid);
    __syncthreads();
#pragma unroll 1
    for (int n = 0; n < 3; ++n) { const int e = tid + 512 * n, ch = e % 384, tr = e / 384, part = ch >> 7, j = ch & 127, chf = part * 256 + gg * 128 + j;
        const float w0 = cw[chf], w1 = cw[768 + chf], w2 = cw[2 * 768 + chf], w3 = cw[3 * 768 + chf], bias = cb[chf];
#pragma unroll
        for (int hf = 0; hf < 2; ++hf) { const int ib = 16 * tr + 8 * hf; float a[8], rw[11];
#pragma unroll
            for (int ii = 0; ii < 11; ++ii) rw[ii] = bf2f(RawT[(ib + ii) * 384 + ch]);
#pragma unroll
            for (int ii = 0; ii < 8; ++ii) { a[ii] = silu_f(bias + w0 * rw[ii] + w1 * rw[ii + 1] + w2 * rw[ii + 2] + w3 * rw[ii + 3]); if (ib + ii < i0) a[ii] = 0.f; }
            if (part == 0) { const int h2 = j >> 6, d = j & 63; const float gl = Gv[h2 * 64 + 63]; float xh[8];
#pragma unroll
                for (int ii = 0; ii < 8; ++ii) { const int i = ib + ii; Xs[i * LDP2 + j] = f2bf(a[ii]); a[ii] *= DTv[h2 * 64 + i]; xh[ii] = a[ii] * fexp2(gl - Gv[h2 * 64 + i]); }
                *(LAS u32x4*)(VT + (h2 * 64 + d) * LDP + ib) = pack_bf8(a); *(LAS u32x4*)(VH + (h2 * 64 + d) * LDP + ib) = pack_bf8(xh); }
            else if (part == 1) {
#pragma unroll
                for (int ii = 0; ii < 8; ++ii) Bs[(ib + ii) * LDP2 + j] = f2bf(a[ii]);
                *(LAS u32x4*)(BT + j * LDP + ib) = pack_bf8(a); }
            else {
#pragma unroll
                for (int ii = 0; ii < 8; ++ii) Cs[(ib + ii) * LDP2 + j] = f2bf(a[ii]); } } }
    __syncthreads();
#pragma unroll
    for (int tt = 0; tt < 2; ++tt) { const int t = wid * 2 + tt, I = t >> 2, J = t & 3; f32x4 acc = (f32x4){0.f, 0.f, 0.f, 0.f};
        if (J <= I) {
#pragma unroll
            for (int s = 0; s < 4; ++s) acc = mfma16(frag_ld(Bs, LDP2, 16 * J + fc, 32 * s + 8 * fq), frag_ld(Cs, LDP2, 16 * I + fc, 32 * s + 8 * fq), acc); }
        const int i = 16 * I + fc;
#pragma unroll
        for (int h2 = 0; h2 < 2; ++h2) { f32x4 pv; const float gi = Gv[h2 * 64 + i];
#pragma unroll
            for (int r = 0; r < 4; ++r) { const int j = 16 * J + 4 * fq + r; pv[r] = (j <= i && j >= i0) ? acc[r] * fexp2(gi - Gv[h2 * 64 + j]) : 0.f; }
            st_bf4(Ps + (h2 * 64 + i) * LDP + 16 * J + 4 * fq, pv); } }
    __syncthreads();
    { bf16x8 bv[2], bh[2]; unsigned char* hrec = rec + SS_HEAD + (size_t)hh * 24576; const float dsk = p.ssd_d[layer * 4 + gg * 2 + hh];
#pragma unroll
        for (int s = 0; s < 2; ++s) { bv[s] = frag_ld(VT, LDP, hh * 64 + 16 * ws + fc, 32 * s + 8 * fq); bh[s] = frag_ld(VH, LDP, hh * 64 + 16 * ws + fc, 32 * s + 8 * fq); }
#pragma unroll
        for (int mi = 0; mi < 4; ++mi) { f32x4 o1 = (f32x4){0.f, 0.f, 0.f, 0.f};
#pragma unroll
            for (int s = 0; s < 2; ++s) o1 = mfma16(frag_ld(Ps, LDP, hh * 64 + 16 * mi + fc, 32 * s + 8 * fq), bv[s], o1);
#pragma unroll
            for (int r = 0; r < 4; ++r) o1[r] += dsk * bf2f(Xs[(16 * mi + 4 * fq + r) * LDP2 + hh * 64 + 16 * ws + fc]);
            st_acc_bf4(hrec + ((size_t)(ws * 4 + mi) * 64 + lane) * 8, o1); }
#pragma unroll
        for (int m = 0; m < 8; ++m) { f32x4 d = (f32x4){0.f, 0.f, 0.f, 0.f};
#pragma unroll
            for (int s = 0; s < 2; ++s) d = mfma16(frag_ld(BT, LDP, 16 * m + fc, 32 * s + 8 * fq), bh[s], d);
            st_acc_bf4(hrec + 8192 + ((size_t)(ws * 8 + m) * 64 + lane) * 8, d); }
#pragma unroll
        for (int x = 0; x < 2; ++x) { const int sl = wid * 2 + x; *(bf16x8*)(rec + SS_QF + ((size_t)sl * 64 + lane) * 16) = frag_ld_perm(Cs, LDP2, 16 * (sl >> 2) + fc, 32 * (sl & 3), fq); }
        if (tid < 128) { float* gv = (float*)(rec + SS_VEC + (size_t)(tid >> 6) * 512); gv[tid & 63] = fexp2(Gv[tid]); if ((tid & 63) == 0) gv[64] = fexp2(Gv[(tid >> 6) * 64 + 63]); } }
}

struct GdLds { static constexpr int QF = 0, KF = 16384, VF = 32768, QN = 49152, KN = QN + 64 * LDP * 2, KNT = KN + 64 * LDP * 2, NM = KNT + 64 * LDP * 2, QK = NM + 64 * LDP * 2, WT = QK + 64 * LDP * 2,
    MD = WT + 64 * LDP * 2  , TD = MD + 4096  , GV = TD + 2048, BV = GV + 256, RAW = BV + 256, END = RAW + 67 * 192 * 2; };
struct GdRaw { Raw192<67> q;
    __device__ __forceinline__ void load(const Params& p, int v, int tid) { int b, c, h; unit_bch(v, b, c, h); const int t0 = 64 * c - 48;
        q.load((const bf16_t*)(p.ws + WS_PROJ) + (size_t)(b * TP) * NBIG, t0 - 3, PC_BQKV + h * 64, PC_BQKV + 256 + h * 64, PC_BQKV + 512 + h * 64, tid);
        const float* ps = (const float*)(p.ws + WS_PSM) + (size_t)(b * TP + max(t0 + (tid & 63), 0)) * NSM; q.sv[0] = ps[h]; q.sv[1] = ps[4 + h]; }
};
__device__ void gdn_pre_unit(const Params& p, int layer, int v_this, int v_next, GdRaw& RR, LAS unsigned char* lds) {
    int b, c, hu; unit_bch(v_this, b, c, hu);
    const int tid = opaque_tid(), wid = tid >> 6, lane = tid & 63, fq = lane >> 4, fc = lane & 15;
    LAS float* Qf = (LAS float*)(lds + GdLds::QF); LAS float* Kf = (LAS float*)(lds + GdLds::KF); LAS float* Vf = (LAS float*)(lds + GdLds::VF);
    LAS bf16_t* Qn = (LAS bf16_t*)(lds + GdLds::QN); LAS bf16_t* Kn = (LAS bf16_t*)(lds + GdLds::KN); LAS bf16_t* KnT = (LAS bf16_t*)(lds + GdLds::KNT);
    LAS bf16_t* NM = (LAS bf16_t*)(lds + GdLds::NM); LAS bf16_t* QK = (LAS bf16_t*)(lds + GdLds::QK); LAS bf16_t* Wt = (LAS bf16_t*)(lds + GdLds::WT);
    LAS float* MD = (LAS float*)(lds + GdLds::MD); LAS bf16_t* TD = (LAS bf16_t*)(lds + GdLds::TD); LAS float* Gv = (LAS float*)(lds + GdLds::GV); LAS float* Bv = (LAS float*)(lds + GdLds::BV);
    LAS bf16_t* RawT = (LAS bf16_t*)(lds + GdLds::RAW);
    const float* cw = p.gdn_conv_w + (size_t)layer * 4 * 768;
    unsigned char* gd = rec_gdn(p, b, c, hu);
    constexpr float L2E = 1.4426950408889634f;
    const int i0 = c == 0 ? 48 : 0;
    const float sva = RR.q.sv[0], svb = RR.q.sv[1];
    __syncthreads();
    RR.q.to_lds(RawT, tid);
    if (v_next >= 0) RR.load(p, v_next, tid);
    __syncthreads();
    if (wid == 0) {
        float g = -__expf(p.gdn_a_log[layer * 4 + hu]) * softplus_f(sva + p.gdn_dt_bias[layer * 4 + hu]) * L2E, be = sigmoid_f(svb); if (lane < i0) { g = 0.f; be = 0.f; }
#pragma unroll
        for (int o = 1; o < 64; o <<= 1) { const float t = lane_up(g, o, lane); if (lane >= o) g += t; }
        Gv[lane] = g; Bv[lane] = be; }
#pragma unroll
    for (int n_ = 0; n_ < 3; ++n_) { const int e = tid + 512 * n_; const int ch = e % 192, tr = e / 192, part = ch >> 6, d = ch & 63, chf = part * 256 + hu * 64 + d;
        const float w0 = cw[chf], w1 = cw[768 + chf], w2 = cw[2 * 768 + chf], w3 = cw[3 * 768 + chf];
        float raw[11];
#pragma unroll
        for (int ii = 0; ii < 11; ++ii) raw[ii] = bf2f(RawT[(8 * tr + ii) * 192 + ch]);
        LAS float* dst = part == 0 ? Qf : part == 1 ? Kf : Vf;
#pragma unroll
        for (int ii = 0; ii < 8; ++ii) { const int i = 8 * tr + ii;
            float a = silu_f(w0 * raw[ii] + w1 * raw[ii + 1] + w2 * raw[ii + 2] + w3 * raw[ii + 3]); if (i < i0) a = 0.f;
            dst[i * 64 + d] = a; } }
    __syncthreads();
    { const int ri = tid >> 3, sg = tid & 7; float q[8], k[8], sq = 0.f, sk = 0.f;
#pragma unroll
        for (int x = 0; x < 8; ++x) { q[x] = Qf[ri * 64 + sg * 8 + x]; k[x] = Kf[ri * 64 + sg * 8 + x]; sq += q[x] * q[x]; sk += k[x] * k[x]; }
        sq += lane_xor(sq, 1, lane); sq += lane_xor(sq, 2, lane); sq += lane_xor(sq, 4, lane); sk += lane_xor(sk, 1, lane); sk += lane_xor(sk, 2, lane); sk += lane_xor(sk, 4, lane);
        const float rq = rsqrtf(sq + EPSF) * 0.125f, rk = rsqrtf(sk + EPSF);
#pragma unroll
        for (int x = 0; x < 8; ++x) { q[x] *= rq; k[x] *= rk; Kf[ri * 64 + sg * 8 + x] = k[x]; KnT[(sg * 8 + x) * LDP + ri] = f2bf(k[x]); }
        *(LAS u32x4*)(Qn + ri * LDP + sg * 8) = pack_bf8(q); *(LAS u32x4*)(Kn + ri * LDP + sg * 8) = pack_bf8(k); }
    __syncthreads();
#pragma unroll
    for (int tt = 0; tt < 2; ++tt) { const int t = wid * 2 + tt, I = t >> 2, J = t & 3; f32x4 a1 = (f32x4){0.f, 0.f, 0.f, 0.f}, a2 = (f32x4){0.f, 0.f, 0.f, 0.f};
        if (J <= I) {
#pragma unroll
            for (int s = 0; s < 2; ++s) { const bf16x8 kj = frag_ld(Kn, LDP, 16 * J + fc, 32 * s + 8 * fq); a1 = mfma16(kj, frag_ld(Kn, LDP, 16 * I + fc, 32 * s + 8 * fq), a1); a2 = mfma16(kj, frag_ld(Qn, LDP, 16 * I + fc, 32 * s + 8 * fq), a2); } }
        const int i = 16 * I + fc; const float gi = Gv[i], bi = Bv[i]; f32x4 nm, qk;
#pragma unroll
        for (int r = 0; r < 4; ++r) { const int j = 16 * J + 4 * fq + r; const float dec = j <= i ? fexp2(gi - Gv[j]) : 0.f; const float mm = j < i ? a1[r] * dec * bi : 0.f; nm[r] = -mm; qk[r] = a2[r] * dec;
            if (J == I) MD[(I * 16 + fc) * 16 + 4 * fq + r] = mm; }
        st_bf4(NM + i * LDP + 16 * J + 4 * fq, nm); st_bf4(QK + i * LDP + 16 * J + 4 * fq, qk); }
    __syncthreads();
    if (wid == 0) { const int I = fq, cc = fc; float x[16];
#pragma unroll
        for (int i = 0; i < 16; ++i) { float acc = (i == cc) ? 1.0f : 0.0f;
#pragma unroll
            for (int j = 0; j < i; ++j) acc -= MD[(I * 16 + i) * 16 + j] * x[j];
            x[i] = acc; TD[(I * 16 + i) * 16 + cc] = f2bf(acc); } }
    __syncthreads();
    const int isW = wid >> 2, ws = wid & 3, colx = 16 * ws + fc;
    const LAS float* rhs = isW ? Kf : Vf;
    f32x4 X[4];
    const f32x4 zero4 = (f32x4){0.f, 0.f, 0.f, 0.f};
#pragma unroll
    for (int I = 0; I < 4; ++I) { f32x4 acc;
#pragma unroll
        for (int r = 0; r < 4; ++r) { const int j = 16 * I + 4 * fq + r; const float sc = Bv[j] * (isW ? fexp2(Gv[j]) : 1.0f); acc[r] = sc * rhs[j * 64 + colx]; }
        if (I >= 1) acc = mfma16(frag_ld_perm(NM, LDP, 16 * I + fc, 0, fq), pack_acc2(X[0], I > 1 ? X[1] : zero4), acc);
        if (I == 3) acc = mfma16(frag_ld_perm(NM, LDP, 48 + fc, 32, fq), pack_acc2(X[2], zero4), acc);
        const bf16x4 tlo = *(const LAS bf16x4*)(TD + (I * 16 + fc) * 16 + 4 * fq); const bf16x4 z4 = (bf16x4){0, 0, 0, 0};
        X[I] = mfma16(__builtin_shufflevector(tlo, z4, 0, 1, 2, 3, 4, 5, 6, 7), pack_acc2(acc, zero4), zero4); }
    if (!isW) {
#pragma unroll
        for (int m = 0; m < 4; ++m) st_acc_bf4(gd + GD_U + ((size_t)(ws * 4 + m) * 64 + lane) * 8, X[m]); }
    else {
#pragma unroll
        for (int m = 0; m < 4; ++m)
#pragma unroll
            for (int r = 0; r < 4; ++r) Wt[(16 * m + 4 * fq + r) * LDP + colx] = f2bf(-X[m][r]); }
    __syncthreads();
    { const int tsel = wid >> 1; const LAS bf16_t* tile = tsel == 0 ? Wt : tsel == 1 ? Qn : tsel == 2 ? QK : KnT; unsigned char* dst = gd + (tsel == 0 ? GD_W : tsel == 1 ? GD_Q : tsel == 2 ? GD_P : GD_K);
#pragma unroll
        for (int x = 0; x < 4; ++x) { const int sl = (wid & 1) * 4 + x, m = sl >> 1, s = sl & 1; bf16x8 f = frag_ld_perm(tile, LDP, 16 * m + fc, 32 * s, fq);
            if (tsel == 1) { const float eg = fexp2(Gv[16 * m + fc]); const float sc[8] = {eg, eg, eg, eg, eg, eg, eg, eg}; f = frag_scale(f, sc); }
            if (tsel == 3) { float sc[8];
#pragma unroll
                for (int e = 0; e < 8; ++e) sc[e] = fexp2(Gv[63] - Gv[32 * s + 16 * (e >> 2) + 4 * fq + (e & 3)]);
                f = frag_scale(f, sc); }
            *(bf16x8*)(dst + ((size_t)sl * 64 + lane) * 16) = f; } }
    if (tid == 0) { float* gv = (float*)(gd + GD_VEC); gv[128] = fexp2(Gv[63]); }
}

template <int MIX> struct SeqRegs {
    static constexpr int DK = MIX == 2 ? 128 : 64, NT = DK / 16;
    u32x2 oi[4]; u32x2 ds[MIX == 1 ? 1 : NT]; f32x4 eg[MIX == 2 ? 4 : 1]; f32x4 al[MIX == 0 ? 4 : 1];
    __device__ __forceinline__ void load(const Params& p, int b, int c, int hd, int ws, int lane, int fq) {
        const unsigned char* base = MIX == 2 ? rec_ssd(p, b, c, hd >> 1) : MIX == 0 ? rec_hgrn(p, b, c, hd) : MIX == 1 ? rec_gdn(p, b, c, hd) : rec_ret(p, b, c, hd);
        const unsigned char* o = MIX == 2 ? base + SS_HEAD + (size_t)(hd & 1) * 24576 : MIX == 1 ? base + GD_U : base + HR_OI;
        const unsigned char* d = MIX == 2 ? o + 8192 : base + HR_DS; const float* gv = (const float*)(MIX == 2 ? base + SS_VEC + (size_t)(hd & 1) * 512 : MIX == 1 ? base + GD_VEC : base + HR_VEC);
#pragma unroll
        for (int mi = 0; mi < 4; ++mi) { oi[mi] = *(const u32x2*)(o + ((size_t)(ws * 4 + mi) * 64 + lane) * 8); if (MIX == 2) eg[mi] = *(const f32x4*)(gv + 16 * mi + 4 * fq); }
        if (MIX != 1) {
#pragma unroll
            for (int m = 0; m < NT; ++m) ds[m] = *(const u32x2*)(d + ((size_t)(ws * NT + m) * 64 + lane) * 8); }
#pragma unroll
        for (int m = 0; m < (MIX == 0 ? 4 : 1); ++m) al[m] = MIX == 0 ? *(const f32x4*)(gv + 64 + 16 * m + 4 * fq) : (f32x4){gv[MIX == 1 ? 128 : 64], 0.f, 0.f, 0.f};
    }
};
__device__ __forceinline__ f32x4 unpack_acc(const u32x2& w) { return (f32x4){__uint_as_float(w.x << 16), __uint_as_float(w.x & 0xffff0000u), __uint_as_float(w.y << 16), __uint_as_float(w.y & 0xffff0000u)}; }
template <int MIX>
__device__ void seq_item(const Params& p, int layer, int b_in, int hd_in, LAS unsigned char* lds) {
    constexpr int DK = MIX == 2 ? 128 : 64, NT = DK / 16, NS = DK / 32;
    constexpr int NFS = MIX == 2 ? 16 : MIX == 1 ? 32 : 8, FPW = NFS / 4;
    constexpr int YC = MIX == 0 ? 0 : MIX == 1 ? 256 : MIX == 2 ? 512 : 768;
    const int b = __builtin_amdgcn_readfirstlane(b_in), hd = __builtin_amdgcn_readfirstlane(hd_in);
    const int tid = opaque_tid(), wid = __builtin_amdgcn_readfirstlane(tid >> 6), lane = tid & 63, fq = lane >> 4, fc = lane & 15;
    const int ws = wid & 3; const bool cw = wid < 4;
    const int fs0 = (wid & 3) * FPW;
    LAS unsigned char* FS = lds;
    bf16_t* yb = (bf16_t*)(p.ws + WS_Y) + (size_t)(b * TP) * DM + YC + hd * 64 + 16 * ws + fc;
    auto fbase = [&](int c) -> const unsigned char* { return MIX == 2 ? rec_ssd(p, b, c, hd >> 1) + SS_QF : MIX == 1 ? rec_gdn(p, b, c, hd) + GD_W : (MIX == 0 ? rec_hgrn(p, b, c, hd) : rec_ret(p, b, c, hd)) + HR_QF; };
    f32x4 S[NT];
#pragma unroll
    for (int m = 0; m < NT; ++m) S[m] = (f32x4){0.f, 0.f, 0.f, 0.f};
    const f32x4 zero4 = (f32x4){0.f, 0.f, 0.f, 0.f};
    SeqRegs<MIX> R; bf16x8 fr[FPW];
    if (cw) R.load(p, b, 0, hd, ws, lane, fq);
    else { const unsigned char* f0 = fbase(0); const unsigned char* f1 = fbase(1);
#pragma unroll
        for (int x = 0; x < FPW; ++x) fr[x] = *(const bf16x8*)(f0 + ((size_t)(fs0 + x) * 64 + lane) * 16);
#pragma unroll
        for (int x = 0; x < FPW; ++x) *(LAS bf16x8*)(FS + ((size_t)(fs0 + x) * 64 + lane) * 16) = fr[x];
#pragma unroll
        for (int x = 0; x < FPW; ++x) fr[x] = *(const bf16x8*)(f1 + ((size_t)(fs0 + x) * 64 + lane) * 16); }
    __syncthreads();
    for (int c = 0; c < NCHUNK; ++c) {
        const int i0 = c == 0 ? 48 : 0, t0 = 64 * c - 48, cn = min(c + 1, NCHUNK - 1);
        const LAS unsigned char* Fc = FS + (size_t)((c & 1) * NFS) * 1024 + lane * 16;
        if (cw) {
            bf16x8 Sb[NS];
#pragma unroll
            for (int s = 0; s < NS; ++s) Sb[s] = pack_acc2(S[2 * s], S[2 * s + 1]);
            if (MIX == 1) {
                bf16x8 ub[2]; f32x4 u[4];
#pragma unroll
                for (int m = 0; m < 4; ++m) { u[m] = unpack_acc(R.oi[m]);
#pragma unroll
                    for (int s = 0; s < 2; ++s) u[m] = mfma16(*(const LAS bf16x8*)(Fc + (m * 2 + s) * 1024), Sb[s], u[m]); }
#pragma unroll
                for (int s = 0; s < 2; ++s) ub[s] = pack_acc2(u[2 * s], u[2 * s + 1]);
#pragma unroll
                for (int mi = 0; mi < 4; ++mi) { f32x4 o = zero4;
#pragma unroll
                    for (int s = 0; s < 2; ++s) { o = mfma16(*(const LAS bf16x8*)(Fc + (16 + mi * 2 + s) * 1024), ub[s], o); o = mfma16(*(const LAS bf16x8*)(Fc + (8 + mi * 2 + s) * 1024), Sb[s], o); }
#pragma unroll
                    for (int r = 0; r < 4; ++r) { const int i = 16 * mi + 4 * fq + r; if (i >= i0) yb[(size_t)(t0 + i) * DM] = f2bf(o[r]); } }
                const float al = R.al[0][0];
#pragma unroll
                for (int m = 0; m < 4; ++m) { S[m] = S[m] * al;
#pragma unroll
                    for (int s = 0; s < 2; ++s) S[m] = mfma16(*(const LAS bf16x8*)(Fc + (24 + m * 2 + s) * 1024), ub[s], S[m]); }
            } else {
#pragma unroll
                for (int mi = 0; mi < 4; ++mi) { f32x4 o2 = zero4;
#pragma unroll
                    for (int s = 0; s < NS; ++s) o2 = mfma16(*(const LAS bf16x8*)(Fc + (mi * NS + s) * 1024), Sb[s], o2);
                    const f32x4 o1 = unpack_acc(R.oi[mi]);
#pragma unroll
                    for (int r = 0; r < 4; ++r) { const int i = 16 * mi + 4 * fq + r; if (i >= i0) yb[(size_t)(t0 + i) * DM] = f2bf(o1[r] + (MIX == 2 ? R.eg[MIX == 2 ? mi : 0][r] : 1.0f) * o2[r]); } }
#pragma unroll
                for (int m = 0; m < NT; ++m) { const f32x4 d = unpack_acc(R.ds[MIX == 1 ? 0 : m]);
#pragma unroll
                    for (int r = 0; r < 4; ++r) S[m][r] = (MIX == 0 ? R.al[MIX == 0 ? (m & 3) : 0][r] : R.al[0][0]) * S[m][r] + d[r]; }
            }
            R.load(p, b, cn, hd, ws, lane, fq);
        } else {
            const unsigned char* f2 = fbase(min(c + 2, NCHUNK - 1));
#pragma unroll
            for (int x = 0; x < FPW; ++x) *(LAS bf16x8*)(FS + ((size_t)(((c + 1) & 1) * NFS + fs0 + x) * 64 + lane) * 16) = fr[x];
#pragma unroll
            for (int x = 0; x < FPW; ++x) fr[x] = *(const bf16x8*)(f2 + ((size_t)(fs0 + x) * 64 + lane) * 16);
        }
        __syncthreads();
    }
    if (cw) { float* so = p.out + (MIX == 0 ? O_HGRN_P : MIX == 1 ? O_GDN_P : MIX == 2 ? O_SSD_P : O_RET_P) + (((size_t)layer * NB + b) * 4 + hd) * (DK * 64);
#pragma unroll
        for (int m = 0; m < NT; ++m)
#pragma unroll
            for (int r = 0; r < 4; ++r) so[(16 * m + 4 * fq + r) * 64 + 16 * ws + fc] = S[m][r]; }
    if (MIX == 1 || (MIX == 2 && (hd & 1) == 0)) { const bf16_t* projb = (const bf16_t*)(p.ws + WS_PROJ) + (size_t)(b * TP) * NBIG;
        float* co = p.out + (MIX == 1 ? O_GCONV_P : O_SCONV_P) + ((size_t)layer * NB + b) * 3 * 768; constexpr int NC = MIX == 1 ? 192 : 384;
        for (int e = tid; e < 3 * NC; e += 512) { const int r = e / NC, ch = e % NC, chf = MIX == 1 ? (ch >> 6) * 256 + hd * 64 + (ch & 63) : (ch >> 7) * 256 + (hd >> 1) * 128 + (ch & 127);
            co[r * 768 + chf] = bf2f(projb[(size_t)(TP - 3 + r) * NBIG + (MIX == 1 ? PC_BQKV : PC_CXBC) + chf]); } }
}

__device__ void ph_post(const Params& p_in, int layer, int blk, int nblk) {
    Params p = p_in; asm volatile("" : "+s"(p.ws), "+s"(p.out));
    const int tid = opaque_tid(), wid = tid >> 6, lane = tid & 63;
    const bf16_t* proj = (const bf16_t*)(p.ws + WS_PROJ); bf16_t* y = (bf16_t*)(p.ws + WS_Y);
    for (int t = blk * 8 + wid; t < MP * 2; t += nblk * 8) { const int row = t >> 1, half = t & 1, ch = half * 512 + lane * 8;
        const int kind = half * 2 + (lane >> 5), cl = (lane & 31) * 8;
        const u32x4 ow = *(const u32x4*)(y + (size_t)row * DM + ch);
        const u32x4 zw = *(const u32x4*)(proj + (size_t)row * NBIG + (kind == 0 ? PC_AZ : kind == 1 ? PC_BZ : kind == 2 ? PC_CZ : PC_DZ) + cl);
        const float* nwp = (kind == 0 ? p.hgrn_norm_w : kind == 1 ? p.gdn_norm_w : kind == 2 ? p.ssd_norm_w : p.ret_norm_w) + layer * 256 + cl;
        const f32x4 w0 = *(const f32x4*)nwp, w1 = *(const f32x4*)(nwp + 4);
        float o[8], z[8]; unpack_bf8(ow, o); unpack_bf8(zw, z);
        const float nw[8] = {w0[0], w0[1], w0[2], w0[3], w1[0], w1[1], w1[2], w1[3]};
        if (kind == 2) {
            float q = 0.f;
#pragma unroll
            for (int k = 0; k < 8; ++k) { o[k] *= silu_f(z[k]); q += o[k] * o[k]; }
            q += lane_xor(q, 1, lane); q += lane_xor(q, 2, lane); q += lane_xor(q, 4, lane); q += lane_xor(q, 8, lane);
            const float rstd = rsqrtf(q * (1.0f / 128.0f) + EPSF);
#pragma unroll
            for (int k = 0; k < 8; ++k) o[k] *= rstd * nw[k];
        } else if (kind == 3) {
            const float* nbp = p.ret_norm_b + layer * 256 + cl; const f32x4 b0 = *(const f32x4*)nbp, b1 = *(const f32x4*)(nbp + 4); const float nb[8] = {b0[0], b0[1], b0[2], b0[3], b1[0], b1[1], b1[2], b1[3]};
            float s = 0.f;
#pragma unroll
            for (int k = 0; k < 8; ++k) s += o[k];
            s += lane_xor(s, 1, lane); s += lane_xor(s, 2, lane); s += lane_xor(s, 4, lane); const float mu = s * (1.0f / 64.0f); float q = 0.f;
#pragma unroll
            for (int k = 0; k < 8; ++k) { o[k] -= mu; q += o[k] * o[k]; }
            q += lane_xor(q, 1, lane); q += lane_xor(q, 2, lane); q += lane_xor(q, 4, lane); const float rstd = rsqrtf(q * (1.0f / 64.0f) + EPSF);
#pragma unroll
            for (int k = 0; k < 8; ++k) o[k] = (o[k] * rstd * nw[k] + nb[k]) * silu_f(z[k]);
        } else {
            float q = 0.f;
#pragma unroll
            for (int k = 0; k < 8; ++k) q += o[k] * o[k];
            q += lane_xor(q, 1, lane); q += lane_xor(q, 2, lane); q += lane_xor(q, 4, lane); const float rstd = rsqrtf(q * (1.0f / 64.0f) + EPSF);
#pragma unroll
            for (int k = 0; k < 8; ++k) o[k] = o[k] * rstd * nw[k] * silu_f(z[k]);
        }
        *(u32x4*)(y + (size_t)row * DM + ch) = pack_bf8(o);
    }
}

constexpr int N_MU = 14;
__device__ void ph_pre(const Params& p_in, int layer, LAS unsigned char* lds_in, int blk, int nblk) {
    Params p = p_in; asm volatile("" : "+s"(p.ws), "+s"(p.out));
    LAS unsigned char* lds = lds_in; asm volatile("" : "+s"(lds));
    const int tid = opaque_tid();
    convert_weights(p, layer + 1 < DEPTH ? layer + 1 : -1, layer, (LAS float*)lds, tid, blk, nblk);
    { GdRaw R; int v = blk; if (v < NB * NCHUNK * 4) R.load(p, v, tid);
        for (; v < NB * NCHUNK * 4; v += nblk) gdn_pre_unit(p, layer, v, v + nblk < NB * NCHUNK * 4 ? v + nblk : -1, R, lds); }
    { SsRaw R; int t = (blk + 224) % nblk; if (t < NB * NCHUNK * 2) R.load(p, t, tid);
        for (; t < NB * NCHUNK * 2; t += nblk) ssd_pre_unit(p, layer, t, t + nblk < NB * NCHUNK * 2 ? t + nblk : -1, R, lds); }
    { HgRaw R; int v = (blk + 192) % nblk; if (v < NB * NCHUNK * 4) R.load(p, v, tid);
        for (; v < NB * NCHUNK * 4; v += nblk) hgrn_pre_unit(p, layer, v, v + nblk < NB * NCHUNK * 4 ? v + nblk : -1, R, lds); }
    { RetRaw R; int v = (blk + 160) % nblk; if (v < NB * NCHUNK * 4) R.load(p, v, tid);
        for (; v < NB * NCHUNK * 4; v += nblk) ret_pre_unit(p, layer, v, v + nblk < NB * NCHUNK * 4 ? v + nblk : -1, R, lds); }
}
__device__ void ph_seq(const Params& p_in, int layer, LAS unsigned char* lds_in, int blk, int nblk) {
    Params p = p_in; asm volatile("" : "+s"(p.ws), "+s"(p.out));
    LAS unsigned char* lds = lds_in; asm volatile("" : "+s"(lds));
    LAS float* L = (LAS float*)lds;
    if (blk < 128) { const int b = blk >> 4, k = blk & 15;
        if (k < 4) seq_item<2>(p, layer, b, k, lds); else if (k < 8) seq_item<1>(p, layer, b, k - 4, lds); else if (k < 12) seq_item<0>(p, layer, b, k - 8, lds); else seq_item<3>(p, layer, b, k - 12, lds); }
    else for (int d = blk - 128; d < DECB * N_MU; d += nblk - 128) { const int s = NB + d / N_MU, mu = d % N_MU;
        if (mu < 4) mixer_item<0>(p, layer, s, mu, L); else if (mu < 8) mixer_item<1>(p, layer, s, mu - 4, L); else if (mu < 10) mixer_item<2>(p, layer, s, mu - 8, L); else mixer_item<3>(p, layer, s, mu - 10, L); }
}

__device__ void ph_final(const Params& p_in, int blk, int nblk) {
    Params p = p_in; asm volatile("" : "+s"(p.ws), "+s"(p.out));

    const int tid = opaque_tid(), wid = tid >> 6, lane = tid & 63;
    const float* h = (const float*)(p.ws + WS_H);
    for (int row = blk * 8 + wid; row < MROWS; row += nblk * 8) {
        float* dst;
        if (row < MP) { const int b = row / TP, t = row % TP; if (t < NMETA) continue; dst = p.out + O_YP + ((size_t)b * SEQ + (t - NMETA)) * DM; } else dst = p.out + O_YS + (size_t)(row - MP) * DM;
        f32x4 v[4]; float ss = 0.f;
#pragma unroll
        for (int j = 0; j < 4; ++j) { v[j] = *(const f32x4*)(h + (size_t)row * DM + j * 256 + lane * 4); ss += v[j][0] * v[j][0] + v[j][1] * v[j][1] + v[j][2] * v[j][2] + v[j][3] * v[j][3]; }
        const float r = rsqrtf(wave_sum(ss, lane) * (1.0f / DM) + EPSF);
#pragma unroll
        for (int j = 0; j < 4; ++j) { const f32x4 w = *(const f32x4*)(p.final_norm_w + j * 256 + lane * 4); *(f32x4*)(dst + j * 256 + lane * 4) = v[j] * r * w; }
    }
}

constexpr int LDS_STAGE = 160 * 1024 - 256;
constexpr int LDS_BYTES = LDS_STAGE + 16;
static_assert(MixLds::END * 4 <= LDS_STAGE && RetLds::END <= LDS_STAGE && SsdLds::END <= LDS_STAGE && 2 * 64 * LDP * 2 <= SsdLds::DT - SsdLds::PS && HgLds::END <= LDS_STAGE && GdLds::END <= LDS_STAGE && pg8::STAGE_BYTES <= LDS_STAGE && 65536 <= LDS_STAGE, "LDS carve");

__global__ void __launch_bounds__(512, 2) k_mega(Params p) {
    extern __shared__ __attribute__((aligned(16))) unsigned char smem[];
    LAS unsigned char* lds = (LAS unsigned char*)smem;
    const int blk = blockIdx.x, nblk = gridDim.x;
    volatile LAS unsigned* xbw = (volatile LAS unsigned*)(lds + LDS_STAGE);
    if (threadIdx.x < 4) xbw[threadIdx.x] = 0u;
    __syncthreads();
    XcdBarrier xb = xcd_barrier_post((unsigned*)(p.ws + WS_BAR), xbw);
#ifndef REP_PREP
#define REP_PREP 1
#endif
#ifndef REP_ROWNORM
#define REP_ROWNORM 1
#endif
#ifndef REP_GEMMIN
#define REP_GEMMIN 1
#endif
#ifndef REP_GDNPRE
#define REP_GDNPRE 1
#endif
#ifndef REP_MIXER
#define REP_MIXER 1
#endif
    for (int r = 0; r < REP_PREP; ++r) { ph_prep(p, lds, blk, nblk); if (r + 1 < REP_PREP) xcd_barrier(xb); }
    cooperative_groups::this_grid().sync();
    xcd_barrier(xb);
#pragma unroll 1
    for (int l = 0; l < DEPTH; ++l) {
        for (int r = 0; r < REP_ROWNORM; ++r) { ph_rownorm(p, l, blk, nblk); xcd_barrier(xb); }
        for (int r = 0; r < REP_GEMMIN; ++r) { ph_gemm_in(p, l, lds, blk, nblk); xcd_barrier(xb); }
#ifndef REP_A
#define REP_A 1
#define REP_B 1
#endif
        for (int r = 0; r < REP_A; ++r) { ph_pre(p, l, lds, blk, nblk); xcd_barrier(xb); }
        for (int r = 0; r < REP_B; ++r) { ph_seq(p, l, lds, blk, nblk); xcd_barrier(xb); }
        ph_post(p, l, blk, nblk); xcd_barrier(xb);
        ph_gemm_out(p, l, lds, blk, nblk);
        xcd_barrier(xb);
    }
    ph_final(p, blk, nblk);
}

extern "C" void kernel_launch(void* const* d_in, const int* in_sizes, int n_in, void* d_out, int out_size, void* d_ws, size_t ws_size, hipStream_t stream) {
    static int grid = 0;
    if (grid == 0) {
        if (n_in != 27 || (size_t)out_size != O_END || ws_size < WS_END) { fprintf(stderr, "kernel_launch: unexpected shapes: n_in %d out %d (want %zu) ws %zu (want %zu)\n", n_in, out_size, (size_t)O_END, ws_size, (size_t)WS_END); grid = -1; return; }
        if (hipFuncSetAttribute((const void*)k_mega, hipFuncAttributeMaxDynamicSharedMemorySize, LDS_BYTES) != hipSuccess) { fprintf(stderr, "kernel_launch: hipFuncSetAttribute failed\n"); grid = -1; return; }
        int dev = 0, cus = 0, per_cu = 0;
        if (hipGetDevice(&dev) != hipSuccess || hipDeviceGetAttribute(&cus, hipDeviceAttributeMultiprocessorCount, dev) != hipSuccess) { fprintf(stderr, "kernel_launch: device query failed\n"); grid = -1; return; }
        if (hipOccupancyMaxActiveBlocksPerMultiprocessor(&per_cu, (const void*)k_mega, 512, LDS_BYTES) != hipSuccess || per_cu < 1) { fprintf(stderr, "kernel_launch: occupancy query says %d blocks per CU\n", per_cu); grid = -1; return; }
        grid = cus;
    }
    if (grid < 0) return;
    Params p{};
    const float** pp = (const float**)&p;
    for (int i = 0; i < 27; ++i) pp[i] = (const float*)d_in[i];
    p.out = (float*)d_out; p.ws = (unsigned char*)d_ws;
    (void)hipMemsetAsync((unsigned char*)d_ws + WS_BAR, 0, 16384, stream);
    void* args[] = {&p};
    const hipError_t e = hipLaunchCooperativeKernel((const void*)k_mega, dim3(grid), dim3(512), args, LDS_BYTES, stream);
    if (e != hipSuccess) fprintf(stderr, "kernel_launch: cooperative launch failed: %s (grid %d)\n", hipGetErrorString(e), grid);
}
```

```cpp
#include <hip/hip_runtime.h>
#include <hip/hip_cooperative_groups.h>
#include <cstdio>
#include <cstdint>

#define LAS __attribute__((address_space(3)))
typedef unsigned short bf16_t;
typedef short bf16x8 __attribute__((ext_vector_type(8)));
typedef float f32x4 __attribute__((ext_vector_type(4)));
typedef unsigned u32x4 __attribute__((ext_vector_type(4)));
typedef unsigned u32x2 __attribute__((ext_vector_type(2)));

constexpr int DM = 1024, NB = 8, SEQ = 2048, DEPTH = 4, DECB = 128, NMETA = 16, TP = SEQ + NMETA;
constexpr int MP = NB * TP;
constexpr int MROWS = MP + DECB;
constexpr int IN_DIM = 4108, NBIG = 4096, NSM = 12;
constexpr int PASTLEN = 16384;
constexpr float EPSF = 1e-6f;
constexpr int PC_AQ = 0, PC_AF = 256, PC_AI = 512, PC_AZ = 768, PC_BQKV = 1024, PC_BZ = 1792, PC_CXBC = 2048, PC_CZ = 2816, PC_DQ = 3072, PC_DK = 3328, PC_DV = 3584, PC_DZ = 3840;

constexpr size_t WS_BAR = 0;
constexpr size_t WS_WINT = 16384;
constexpr size_t WS_WOUTT = WS_WINT + (size_t)NBIG * DM * 2;
constexpr size_t WS_WSM = WS_WOUTT + (size_t)DM * DM * 2;
constexpr size_t WS_LB = WS_WSM + (size_t)DEPTH * NSM * DM * 4;
constexpr size_t WS_ROT = WS_LB + (size_t)DEPTH * 256 * 4;
constexpr size_t ROT_BYTES = ((size_t)(TP + 1) * 64 * 4 + 255) / 256 * 256;
constexpr size_t WS_H = WS_ROT + ROT_BYTES;
constexpr size_t WS_HB = WS_H + (size_t)MROWS * DM * 4;
constexpr size_t WS_RS = WS_HB + (size_t)MROWS * DM * 2;
constexpr size_t WS_PSM = WS_RS + (size_t)MROWS * 4;
constexpr size_t WS_PROJ = WS_PSM + (size_t)MROWS * NSM * 4;
constexpr size_t WS_Y = WS_PROJ + (size_t)MROWS * NBIG * 2;
constexpr size_t WS_E = WS_Y + (size_t)MROWS * DM * 2;
constexpr size_t WS_END = WS_E + (size_t)NB * 33 * 4 * 41728;

constexpr size_t O_YP = 0;
constexpr size_t O_YS = O_YP + (size_t)NB * SEQ * DM;
constexpr size_t O_HGRN_P = O_YS + (size_t)DECB * DM;
constexpr size_t O_GDN_P = O_HGRN_P + (size_t)DEPTH * NB * 4 * 64 * 64;
constexpr size_t O_GCONV_P = O_GDN_P + (size_t)DEPTH * NB * 4 * 64 * 64;
constexpr size_t O_SSD_P = O_GCONV_P + (size_t)DEPTH * NB * 3 * 768;
constexpr size_t O_SCONV_P = O_SSD_P + (size_t)DEPTH * NB * 4 * 128 * 64;
constexpr size_t O_RET_P = O_SCONV_P + (size_t)DEPTH * NB * 3 * 768;
constexpr size_t O_HGRN_S = O_RET_P + (size_t)DEPTH * NB * 4 * 64 * 64;
constexpr size_t O_GDN_S = O_HGRN_S + (size_t)DEPTH * DECB * 4 * 64 * 64;
constexpr size_t O_GCONV_S = O_GDN_S + (size_t)DEPTH * DECB * 4 * 64 * 64;
constexpr size_t O_SSD_S = O_GCONV_S + (size_t)DEPTH * DECB * 3 * 768;
constexpr size_t O_SCONV_S = O_SSD_S + (size_t)DEPTH * DECB * 4 * 128 * 64;
constexpr size_t O_RET_S = O_SCONV_S + (size_t)DEPTH * DECB * 3 * 768;
constexpr size_t O_END = O_RET_S + (size_t)DEPTH * DECB * 4 * 64 * 64;

struct Params {
    const float* x_prompt; const float* x_sample;
    const float* st_hgrn; const float* st_gdn; const float* st_gconv; const float* st_ssd; const float* st_sconv; const float* st_ret;
    const float* meta; const float* norm_w; const float* w_in; const float* lb_logits; const float* hgrn_norm_w;
    const float* gdn_conv_w; const float* gdn_a_log; const float* gdn_dt_bias; const float* gdn_norm_w;
    const float* ssd_conv_w; const float* ssd_conv_b; const float* ssd_a_log; const float* ssd_dt_bias; const float* ssd_d; const float* ssd_norm_w;
    const float* ret_norm_w; const float* ret_norm_b; const float* w_out; const float* final_norm_w;
    float* out; unsigned char* ws;
};

__device__ __forceinline__ float bf2f(bf16_t b) { return __uint_as_float(((unsigned)b) << 16); }
__device__ __forceinline__ bf16_t f2bf(float f) { unsigned u = __float_as_uint(f); u += 0x7FFFu + ((u >> 16) & 1u); return (bf16_t)(u >> 16); }
__device__ __forceinline__ unsigned pack_bf2(float lo, float hi) { return (unsigned)f2bf(lo) | ((unsigned)f2bf(hi) << 16); }
__device__ __forceinline__ float sigmoid_f(float x) { return 1.0f / (1.0f + __expf(-x)); }
__device__ __forceinline__ float silu_f(float x) { return x / (1.0f + __expf(-x)); }
__device__ __forceinline__ float softplus_f(float x) { return x > 20.0f ? x : log1pf(__expf(x)); }
__device__ __forceinline__ void lds_barrier() { asm volatile("s_waitcnt lgkmcnt(0)" ::: "memory"); __builtin_amdgcn_s_barrier(); asm volatile("" ::: "memory"); }
__device__ __forceinline__ int opaque_tid() { int t = threadIdx.x; asm volatile("" : "+v"(t)); return t; }
__device__ __forceinline__ float lane_xor(float v, int k, int lane) { return __int_as_float(__builtin_amdgcn_ds_bpermute((lane ^ k) << 2, __float_as_int(v))); }
__device__ __forceinline__ float lane_up(float v, int k, int lane) { return __int_as_float(__builtin_amdgcn_ds_bpermute(((lane - k) & 63) << 2, __float_as_int(v))); }
template <int CTRL> __device__ __forceinline__ float dpp_mov(float v) { return __int_as_float(__builtin_amdgcn_update_dpp(0, __float_as_int(v), CTRL, 0xf, 0xf, true)); }
__device__ __forceinline__ float sum4(float v) { v += dpp_mov<0xB1>(v); v += dpp_mov<0x4E>(v); return v; }
__device__ __forceinline__ float sum8(float v) { v = sum4(v); v += dpp_mov<0x141>(v); return v; }
__device__ __forceinline__ float sum16(float v) { v = sum8(v); v += dpp_mov<0x140>(v); return v; }
__device__ __forceinline__ float wave_sum(float v, int lane) { v = sum16(v); v += lane_xor(v, 16, lane); v += lane_xor(v, 32, lane); return v; }


#define XB_TMO      128
#define XB_XCNT(j)  (256  + 64 * (j))
#define XB_XSUB(j)  (1280 + 64 * (j))
#define XB_XGEN(j)  (2304 + 64 * (j))
#define XB_TOP      3328
#define XB_TOPGEN   3392
#define XCD_BAR_WORDS 3456
#define XB_SPIN_CAP (1u << 22)
__device__ __forceinline__ unsigned xb_ld(unsigned* p)              { return __hip_atomic_load(p, __ATOMIC_RELAXED, __HIP_MEMORY_SCOPE_AGENT); }
__device__ __forceinline__ unsigned xb_add(unsigned* p, unsigned v) { return __hip_atomic_fetch_add(p, v, __ATOMIC_RELAXED, __HIP_MEMORY_SCOPE_AGENT); }
__device__ __forceinline__ unsigned xb_xcc_id() { return (unsigned)__builtin_amdgcn_s_getreg((3 << 11) | 20) & 0xFu; }
#define XB_SPIN(cond, bar) do { unsigned _sp = 0; while (cond) { __builtin_amdgcn_s_sleep(1); \
    if ((++_sp & 255u) == 0u) { if (xb_ld(&(bar)[XB_TMO])) break; if (_sp > XB_SPIN_CAP) { atomicAdd(&(bar)[XB_TMO], 1u); break; } } } } while (0)
struct XcdBarrier { unsigned* bar; unsigned x; volatile LAS unsigned* st; };
__device__ __forceinline__ XcdBarrier xcd_barrier_post(unsigned* bar, volatile LAS unsigned* st) {
    XcdBarrier b; b.bar = bar; b.x = xb_xcc_id(); b.st = st;
    if (threadIdx.x == 0) (void)xb_add(&bar[XB_XCNT(b.x)], 1u);
    return b;
}
__device__ __forceinline__ void xcd_barrier_complete(unsigned* bar, unsigned x, unsigned& nloc, unsigned& nx) {
    const unsigned G = gridDim.x * gridDim.y * gridDim.z;
    unsigned sum, cnt, mine, sp = 0u;
    for (;;) {
        sum = 0u; cnt = 0u; mine = 0u;
#pragma unroll
        for (unsigned j = 0; j < 16; ++j) { const unsigned c = xb_ld(&bar[XB_XCNT(j)]); sum += c; cnt += (c > 0u) ? 1u : 0u; mine = (j == x) ? c : mine; }
        if (sum == G) break;
        __builtin_amdgcn_s_sleep(1);
        if ((++sp & 255u) == 0u) { if (xb_ld(&bar[XB_TMO])) break; if (sp > XB_SPIN_CAP) { atomicAdd(&bar[XB_TMO], 1u); break; } }
    }
    nloc = mine > 0u ? mine : 1u; nx = cnt > 0u ? cnt : 1u;
}
__device__ __forceinline__ void xcd_barrier(const XcdBarrier& b0) {
    asm volatile("s_waitcnt vmcnt(0)" ::: "memory");
    __syncthreads();
    if (threadIdx.x == 0) {
        XcdBarrier b = b0; { unsigned x = xb_xcc_id(); asm volatile("" : "+s"(x)); b.x = x; }
        unsigned* bar = b.bar;
        __builtin_amdgcn_s_waitcnt(0);
        unsigned nloc = b.st[0], nx = b.st[1];
        if (nloc == 0u) { xcd_barrier_complete(bar, b.x, nloc, nx); b.st[0] = nloc; b.st[1] = nx; }
        const unsigned old = xb_add(&bar[XB_XSUB(b.x)], 1u);
        const unsigned gen = old / nloc;
        if (old + 1u == (gen + 1u) * nloc) {
            __builtin_amdgcn_fence(__ATOMIC_RELEASE, "agent");
            asm volatile("s_waitcnt vmcnt(0)" ::: "memory");
            const unsigned og = xb_add(&bar[XB_TOP], 1u);
            const unsigned tg = og / nx;
            if (og + 1u == (tg + 1u) * nx) xb_add(&bar[XB_TOPGEN], 1u);
            else XB_SPIN(xb_ld(&bar[XB_TOPGEN]) == tg, bar);
            __builtin_amdgcn_fence(__ATOMIC_ACQUIRE, "agent");
            xb_add(&bar[XB_XGEN(b.x)], 1u);
            asm volatile("s_waitcnt vmcnt(0)" ::: "memory");
        } else {
            XB_SPIN(xb_ld(&bar[XB_XGEN(b.x)]) == gen, bar);
            __builtin_amdgcn_fence(__ATOMIC_ACQUIRE, "agent");
            asm volatile("s_waitcnt vmcnt(0)" ::: "memory");
        }
    }
    __syncthreads();
}

namespace pg8 {
constexpr int BM = 256, BK = 64, HALF = 128, HTB = HALF * BK * 2, STAGE_BYTES = 8 * HTB, NXCD = 8, WGM = 8;
__host__ __device__ __forceinline__ int lds_byte(int r, int c) { const int st = (r >> 4) * 2 + (c >> 5), rr = r & 15, cc = c & 31, ob = rr * 64 + cc * 2; return st * 1024 + (ob ^ (((ob >> 9) & 1) << 5)); }
__host__ __device__ __forceinline__ void stage_rc(int b, int& R, int& C) { const int st = b / 1024, sb = b % 1024, swz = sb ^ (((sb >> 9) & 1) << 5); R = (st >> 1) * 16 + swz / 64; C = (st & 1) * 32 + (swz % 64) / 2; }
__host__ __device__ __forceinline__ int perm32(int rho) { const int n = rho >> 4, i = rho & 15; return 8 * (i >> 2) + 4 * n + (i & 3); }
struct Unit { int pm, pn; };
struct Gemm { const bf16_t* A; const bf16_t* Bt; int M, N, K; };
struct StaticOrder {
    int nM, nN, nwg, G, c;
    __host__ __device__ void init(int M, int N, int G_, int c_) { nM = M / BM; nN = N / BM; nwg = nM * nN; G = G_; c = c_; }
    __host__ __device__ bool next(int i, Unit& u) const {
        const long L = (long)i * G + c; if (L >= nwg) return false;
        int wgid = (int)L; { const int q = nwg / NXCD, r = nwg % NXCD, xcd = wgid % NXCD, off = wgid / NXCD; wgid = (xcd < r ? xcd * (q + 1) : r * (q + 1) + (xcd - r) * q) + off; }
        const int nig = WGM * nN, gid = wgid / nig, fm = gid * WGM, gsz = (nM - fm) < WGM ? (nM - fm) : WGM;
        u.pm = fm + ((wgid % nig) % gsz); u.pn = (wgid % nig) / gsz; return true;
    }
    __device__ __forceinline__ void a_ready(const Unit&) const {}
    __device__ __forceinline__ void done(const Unit&) const {}
};
typedef float f32x2_t __attribute__((ext_vector_type(2)));
typedef __bf16 bf16x2n_t __attribute__((ext_vector_type(2)));
__device__ __forceinline__ unsigned cvt_pk_bf16(float lo, float hi) { const f32x2_t f = {lo, hi}; return __builtin_bit_cast(unsigned, __builtin_convertvector(f, bf16x2n_t)); }

struct EpiProj {
    static constexpr bool PERM = true, AFTER_DRAIN = false;
    bf16_t* O; int ldc; const float* rs;
    __device__ __forceinline__ void operator()(const f32x4 (&acc)[2][2][4][2], const Unit& u, int wr, int wc, int fr, int fq) const {
        const int row0 = u.pm * BM + wr * 64 + fr; const int col0 = u.pn * BM + wc * 32 + 8 * fq;
#pragma unroll
        for (int ai = 0; ai < 2; ++ai)
#pragma unroll
            for (int m = 0; m < 4; ++m) { const int row = row0 + ai * HALF + m * 16; const float s = rs[row]; bf16_t* rowp = O + (size_t)row * ldc + col0;
#pragma unroll
                for (int bj = 0; bj < 2; ++bj) { const f32x4 v0 = acc[ai][bj][m][0] * s, v1 = acc[ai][bj][m][1] * s;
                    u32x4 w; w.x = cvt_pk_bf16(v0[0], v0[1]); w.y = cvt_pk_bf16(v0[2], v0[3]); w.z = cvt_pk_bf16(v1[0], v1[1]); w.w = cvt_pk_bf16(v1[2], v1[3]);
                    *(u32x4*)(rowp + bj * HALF) = w; } }
    }
};
struct EpiResid {
    static constexpr bool PERM = false, AFTER_DRAIN = false;
    float* C; int ldc;
    __device__ __forceinline__ void operator()(const f32x4 (&acc)[2][2][4][2], const Unit& u, int wr, int wc, int fr, int fq) const {
        const int row0 = u.pm * BM + wr * 64 + fr, col0 = u.pn * BM + wc * 32 + 4 * fq;
#pragma unroll
        for (int ai = 0; ai < 2; ++ai)
#pragma unroll
            for (int m = 0; m < 4; ++m) { float* rowp = C + (size_t)(row0 + ai * HALF + m * 16) * ldc + col0;
#pragma unroll
                for (int bj = 0; bj < 2; ++bj)
#pragma unroll
                    for (int n = 0; n < 2; ++n) { f32x4* p = (f32x4*)(rowp + bj * HALF + n * 16); *p = *p + acc[ai][bj][m][n]; } }
    }
};

template <class Epi, class Sched>
__device__ __forceinline__ void gemm_phase(LAS unsigned char* lds, const Gemm g, const Sched& S, const Epi& E) {
    const int tid = opaque_tid(), wid = __builtin_amdgcn_readfirstlane(tid >> 6), lane = tid & 63, wr = wid >> 2, wc = wid & 3, fr = lane & 15, fq = lane >> 4;
    const int K = g.K, nt = K / BK;
    unsigned voffA[2], voffB[2];
#pragma unroll
    for (int i = 0; i < 2; ++i) { int R, C; stage_rc(tid * 16 + i * 8192, R, C); const int Rb = Epi::PERM ? ((R & ~31) + perm32(R & 31)) : R;
        voffA[i] = (unsigned)(R * K + C) * 2u; voffB[i] = (unsigned)(Rb * K + C) * 2u; }
    const size_t kstep = (size_t)(BK * 2);
    const size_t hstep = (size_t)HALF * K * 2;
    const size_t tstep = 2 * hstep;
    const unsigned ldsw = (unsigned)wid * 1024u;
    const int aoff = lds_byte(wr * 64 + fr, fq * 8), boff = lds_byte(wc * 32 + fr, fq * 8);
#define PG8_SA(b, h) (((b) * 2 + (h)) * HTB)
#define PG8_SB(b, h) ((4 + (b) * 2 + (h)) * HTB)
#define PG8_STAGE(bufoff, gbase, voff) do { _Pragma("unroll") for (int _i = 0; _i < 2; ++_i) \
        __builtin_amdgcn_global_load_lds((const unsigned*)((const char*)(gbase) + (voff)[_i]), (LAS unsigned*)(lds + (bufoff) + ldsw + _i * 8192), 16, 0, 0); } while (0)
#define PG8_LDA(dst, b, h) do { _Pragma("unroll") for (int m = 0; m < 4; ++m) _Pragma("unroll") for (int k = 0; k < 2; ++k) dst[m][k] = *(const LAS bf16x8*)(lds + PG8_SA(b, h) + aoff + m * 2048 + k * 1024); } while (0)
#define PG8_LDB(dst, b, h) do { _Pragma("unroll") for (int n = 0; n < 2; ++n) _Pragma("unroll") for (int k = 0; k < 2; ++k) dst[n][k] = *(const LAS bf16x8*)(lds + PG8_SB(b, h) + boff + n * 2048 + k * 1024); } while (0)
#define PG8_MMA(ai, bj, At, Bt) do { __builtin_amdgcn_s_setprio(1); _Pragma("unroll") for (int m = 0; m < 4; ++m) _Pragma("unroll") for (int n = 0; n < 2; ++n) _Pragma("unroll") for (int k = 0; k < 2; ++k) \
        acc[ai][bj][m][n] = __builtin_amdgcn_mfma_f32_16x16x32_bf16(Bt[n][k], At[m][k], acc[ai][bj][m][n], 0, 0, 0); __builtin_amdgcn_s_setprio(0); } while (0)
#define PG8_WAIT_V(n) asm volatile("s_waitcnt vmcnt(" #n ")" ::: "memory")
#define PG8_WAIT_L(n) asm volatile("s_waitcnt lgkmcnt(" #n ")" ::: "memory")
#define PG8_BAR __builtin_amdgcn_s_barrier()
#define PG8_SCHED __builtin_amdgcn_sched_barrier(0)
    Unit cur, nxt; int ui = 0;
    if (!S.next(0, cur)) return;
    f32x4 acc[2][2][4][2];
#pragma unroll
    for (int a = 0; a < 2; ++a)
#pragma unroll
        for (int b = 0; b < 2; ++b)
#pragma unroll
            for (int m = 0; m < 4; ++m)
#pragma unroll
                for (int n = 0; n < 2; ++n) acc[a][b][m][n] = (f32x4){0.f, 0.f, 0.f, 0.f};
    bf16x8 At[4][2], B0[2][2], B1[2][2];
    const char* cA = (const char*)g.A + (size_t)cur.pm * tstep; const char* cB = (const char*)g.Bt + (size_t)cur.pn * tstep;
    S.a_ready(cur);
    PG8_STAGE(PG8_SB(0, 0), cB, voffB); PG8_STAGE(PG8_SA(0, 0), cA, voffA); PG8_STAGE(PG8_SB(0, 1), cB + hstep, voffB); PG8_STAGE(PG8_SA(0, 1), cA + hstep, voffA);
    if (wr == 1) PG8_BAR;
    PG8_WAIT_V(4); PG8_BAR;
    PG8_STAGE(PG8_SB(1, 0), cB + kstep, voffB); PG8_STAGE(PG8_SA(1, 0), cA + kstep, voffA); PG8_STAGE(PG8_SB(1, 1), cB + hstep + kstep, voffB);
    PG8_WAIT_V(6); PG8_BAR;
    for (;;) {
        const bool has_next = S.next(ui + 1, nxt);
        const char* nA = has_next ? (const char*)g.A + (size_t)nxt.pm * tstep : cA; const char* nB = has_next ? (const char*)g.Bt + (size_t)nxt.pn * tstep : cB;
        for (int t = 0; t < nt; t += 2) {
            const bool last = (t == nt - 2);
            const char* a1 = cA + (size_t)(t + 1) * kstep;
            const char* a2 = last ? nA : cA + (size_t)(t + 2) * kstep; const char* b2 = last ? nB : cB + (size_t)(t + 2) * kstep;
            const char* a3 = a2 + kstep; const char* b3 = b2 + kstep;
            if (last && has_next) S.a_ready(nxt);
            PG8_LDB(B0, 0, 0); PG8_SCHED; PG8_LDA(At, 0, 0); PG8_STAGE(PG8_SA(1, 1), a1 + hstep, voffA);
            PG8_WAIT_L(8); PG8_BAR; PG8_WAIT_L(0); PG8_MMA(0, 0, At, B0); PG8_BAR; PG8_SCHED;
            PG8_LDB(B1, 0, 1); PG8_STAGE(PG8_SB(0, 0), b2, voffB);
            PG8_BAR; PG8_WAIT_L(0); PG8_MMA(0, 1, At, B1); PG8_BAR;
            PG8_LDA(At, 0, 1); PG8_STAGE(PG8_SA(0, 0), a2, voffA);
            PG8_BAR; PG8_WAIT_L(0); PG8_MMA(1, 0, At, B0); PG8_BAR; PG8_SCHED;
            PG8_STAGE(PG8_SB(0, 1), b2 + hstep, voffB);
            PG8_WAIT_V(6); PG8_BAR; PG8_MMA(1, 1, At, B1); PG8_BAR;
            PG8_LDB(B0, 1, 0); PG8_SCHED; PG8_LDA(At, 1, 0); PG8_STAGE(PG8_SA(0, 1), a2 + hstep, voffA);
            PG8_WAIT_L(8); PG8_BAR; PG8_WAIT_L(0); PG8_MMA(0, 0, At, B0); PG8_BAR; PG8_SCHED;
            PG8_LDB(B1, 1, 1); PG8_STAGE(PG8_SB(1, 0), b3, voffB);
            PG8_BAR; PG8_WAIT_L(0); PG8_MMA(0, 1, At, B1); PG8_BAR;
            PG8_LDA(At, 1, 1); PG8_STAGE(PG8_SA(1, 0), a3, voffA);
            PG8_BAR; PG8_WAIT_L(0); PG8_MMA(1, 0, At, B0); PG8_BAR; PG8_SCHED;
            PG8_STAGE(PG8_SB(1, 1), b3 + hstep, voffB);
            PG8_WAIT_V(6); PG8_BAR; PG8_MMA(1, 1, At, B1); PG8_BAR;
        }
        if constexpr (!Epi::AFTER_DRAIN) { E(acc, cur, wr, wc, fr, fq); S.done(cur); }
        if (!has_next) break;
#pragma unroll
        for (int a = 0; a < 2; ++a)
#pragma unroll
            for (int b = 0; b < 2; ++b)
#pragma unroll
                for (int m = 0; m < 4; ++m)
#pragma unroll
                    for (int n = 0; n < 2; ++n) acc[a][b][m][n] = (f32x4){0.f, 0.f, 0.f, 0.f};
        cur = nxt; cA = nA; cB = nB; ++ui;
    }
    PG8_WAIT_V(0);
    if (wr == 0) PG8_BAR;
    PG8_BAR;
#undef PG8_SA
#undef PG8_SB
#undef PG8_STAGE
#undef PG8_LDA
#undef PG8_LDB
#undef PG8_MMA
#undef PG8_WAIT_V
#undef PG8_WAIT_L
#undef PG8_BAR
#undef PG8_SCHED
}
}

__device__ __forceinline__ int win_col(int n) { return n < 2048 ? n : (n < 3072 ? n + 8 : n + 12); }
__device__ __forceinline__ int win_smcol(int j) { return j < 8 ? 2048 + j : 3080 + (j - 8); }

__device__ __forceinline__ void convert_weights(const Params& p, int l_in, int l_out, LAS float* tile  , int tid, int blk, int nblk) {
    const int tiles_in = l_in >= 0 ? 64 * 16 : 0, tiles_out = l_out >= 0 ? 16 * 16 : 0;
    for (int t = blk; t < tiles_in + tiles_out; t += nblk) {
        const float* src; bf16_t* dst; int ld, n0, k0; const float* scale;
        if (t < tiles_in) { n0 = (t / 16) * 64; k0 = (t % 16) * 64; src = p.w_in + (size_t)l_in * DM * IN_DIM + win_col(n0); ld = IN_DIM; dst = (bf16_t*)(p.ws + WS_WINT); scale = p.norm_w + l_in * DM; }
        else { const int r = t - tiles_in; n0 = (r / 16) * 64; k0 = (r % 16) * 64; src = p.w_out + (size_t)l_out * DM * DM + n0; ld = DM; dst = (bf16_t*)(p.ws + WS_WOUTT); scale = nullptr; }
        __syncthreads();
#pragma unroll
        for (int n_ = 0; n_ < 8; ++n_) { const int e = tid + 512 * n_; const int kk = e >> 6, nn = e & 63; float v = src[(size_t)(k0 + kk) * ld + nn]; if (scale) v *= scale[k0 + kk]; tile[kk * 65 + nn] = v; }
        __syncthreads();
#pragma unroll
        for (int n_ = 0; n_ < 4; ++n_) { const int e = tid + 512 * n_; const int nn = e >> 5, kp = (e & 31) * 2; const unsigned w = pack_bf2(tile[kp * 65 + nn], tile[(kp + 1) * 65 + nn]);
            *(unsigned*)(dst + (size_t)(n0 + nn) * DM + k0 + kp) = w; }
    }
    __syncthreads();
}

__device__ void ph_prep(const Params& p_in, LAS unsigned char* lds_in, int blk, int nblk) {
    Params p = p_in; asm volatile("" : "+s"(p.ws), "+s"(p.out));
    LAS unsigned char* lds = lds_in; asm volatile("" : "+s"(lds));

    const int tid = opaque_tid();
    LAS float* tile = (LAS float*)lds;
    convert_weights(p, 0, 0, tile, tid, blk, nblk);
    for (int e = blk * 512 + tid; e < DEPTH * NSM * DM; e += nblk * 512) { const int l = e / (NSM * DM), r = e % (NSM * DM), j = r / DM, k = r % DM;
        ((float*)(p.ws + WS_WSM))[e] = p.w_in[(size_t)l * DM * IN_DIM + (size_t)k * IN_DIM + win_smcol(j)] * p.norm_w[l * DM + k]; }
    for (int c = blk * 512 + tid; c < 256; c += nblk * 512) { float lg[DEPTH], mx = -1e30f;
#pragma unroll
        for (int l = 0; l < DEPTH; ++l) { lg[l] = p.lb_logits[l * 256 + c]; mx = fmaxf(mx, lg[l]); }
        float s = 0.f;
#pragma unroll
        for (int l = 0; l < DEPTH; ++l) { lg[l] = expf(lg[l] - mx); s += lg[l]; }
        float cum = 0.f; const float w0 = lg[0] / s;
#pragma unroll
        for (int l = 0; l < DEPTH; ++l) { cum += lg[l] / s; ((float*)(p.ws + WS_LB))[l * 256 + c] = fmaxf(cum - w0, 0.f); } }
    for (int e = blk * 512 + tid; e < (TP + 1) * 32; e += nblk * 512) { const int pi = e >> 5, i = e & 31; const double pos = pi < TP ? (double)pi : (double)PASTLEN;
        const float invf = (float)(1.0 / pow(10000.0, (double)((float)i / 31.0f)));
        const double rev = pos * (double)invf * 0.15915494309189535; const float fr = (float)(rev - rint(rev));
        ((float*)(p.ws + WS_ROT))[e * 2 + 0] = __builtin_amdgcn_cosf(fr); ((float*)(p.ws + WS_ROT))[e * 2 + 1] = __builtin_amdgcn_sinf(fr); }
    float* h = (float*)(p.ws + WS_H);
    for (int e = blk * 512 + tid; e < MROWS * (DM / 4); e += nblk * 512) { const int row = e >> 8, c4 = (e & 255) * 4; const float* src;
        if (row < MP) { const int b = row / TP, t = row % TP; src = t < NMETA ? p.meta + t * DM : p.x_prompt + ((size_t)b * SEQ + (t - NMETA)) * DM; } else src = p.x_sample + (size_t)(row - MP) * DM;
        *(f32x4*)(h + (size_t)row * DM + c4) = *(const f32x4*)(src + c4); }
}

__device__ void ph_rownorm(const Params& p_in, int layer, int blk, int nblk) {
    Params p = p_in; asm volatile("" : "+s"(p.ws), "+s"(p.out));

    const int tid = opaque_tid(), wid = tid >> 6, lane = tid & 63;
    const float* h = (const float*)(p.ws + WS_H); bf16_t* hb = (bf16_t*)(p.ws + WS_HB); float* rs = (float*)(p.ws + WS_RS); float* psm = (float*)(p.ws + WS_PSM);
    const float* wsm = (const float*)(p.ws + WS_WSM) + (size_t)layer * NSM * DM;
    for (int row = blk * 8 + wid; row < MROWS; row += nblk * 8) {
        f32x4 v[4]; float ss = 0.f;
#pragma unroll
        for (int j = 0; j < 4; ++j) { v[j] = *(const f32x4*)(h + (size_t)row * DM + j * 256 + lane * 4); ss += v[j][0] * v[j][0] + v[j][1] * v[j][1] + v[j][2] * v[j][2] + v[j][3] * v[j][3]; }
        ss = wave_sum(ss, lane); const float r = rsqrtf(ss * (1.0f / DM) + EPSF);
#pragma unroll
        for (int j = 0; j < 4; ++j) { u32x2 w; w.x = pack_bf2(v[j][0], v[j][1]); w.y = pack_bf2(v[j][2], v[j][3]); *(u32x2*)(hb + (size_t)row * DM + j * 256 + lane * 4) = w; }
        float mine = 0.f;
        for (int q = 0; q < NSM; ++q) { float d = 0.f;
#pragma unroll
            for (int j = 0; j < 4; ++j) { const f32x4 w = *(const f32x4*)(wsm + q * DM + j * 256 + lane * 4); d += v[j][0] * w[0] + v[j][1] * w[1] + v[j][2] * w[2] + v[j][3] * w[3]; }
            d = wave_sum(d, lane); if (lane == q) mine = d * r; }
        if (lane < NSM) psm[(size_t)row * NSM + lane] = mine;
        if (lane == 0) rs[row] = r;
    }
}

__device__ void ph_gemm_in(const Params& p_in, int layer, LAS unsigned char* lds_in, int blk, int nblk) {
    Params p = p_in; asm volatile("" : "+s"(p.ws), "+s"(p.out));
    LAS unsigned char* lds = lds_in; asm volatile("" : "+s"(lds));

    pg8::Gemm g{(const bf16_t*)(p.ws + WS_HB), (const bf16_t*)(p.ws + WS_WINT), MROWS, NBIG, DM};
    pg8::StaticOrder S; S.init(MROWS, NBIG, nblk, blk);
    pg8::EpiProj E{(bf16_t*)(p.ws + WS_PROJ), NBIG, (const float*)(p.ws + WS_RS)};
    pg8::gemm_phase<pg8::EpiProj, pg8::StaticOrder>(lds, g, S, E);
}
__device__ void ph_gemm_out(const Params& p_in, int layer, LAS unsigned char* lds_in, int blk, int nblk) {
    Params p = p_in; asm volatile("" : "+s"(p.ws), "+s"(p.out));
    LAS unsigned char* lds = lds_in; asm volatile("" : "+s"(lds));

    pg8::Gemm g{(const bf16_t*)(p.ws + WS_Y), (const bf16_t*)(p.ws + WS_WOUTT), MROWS, DM, DM};
    pg8::StaticOrder S; S.init(MROWS, DM, nblk, blk);
    pg8::EpiResid E{(float*)(p.ws + WS_H), DM};
    pg8::gemm_phase<pg8::EpiResid, pg8::StaticOrder>(lds, g, S, E);
}

constexpr int TB = 16;
struct MixLds {
    static constexpr int QS = 0, KS = QS + TB * 128, VS = KS + TB * 128, DS = VS + TB * 128, ZS = DS + TB * 128, XS = ZS + TB * 128, OS = XS + TB * 128, BS = OS + TB * 128, SC = BS + TB * 2, END = SC + TB * 2;
};

struct SeqInfo { int row0, T, dec, b; };
__device__ __forceinline__ SeqInfo seq_info(int s) { SeqInfo q; if (s < NB) { q.row0 = s * TP; q.T = TP; q.dec = 0; q.b = s; } else { q.row0 = MP + (s - NB); q.T = 1; q.dec = 1; q.b = s - NB; } return q; }

__device__ __forceinline__ float preconv(const bf16_t* proj, const SeqInfo& q, int t, int col, const float* ctx  , int ch) {
    if (t >= 0) return bf2f(proj[(size_t)(q.row0 + t) * NBIG + col]);
    return ctx ? ctx[(3 + t) * 768 + ch] : 0.f;
}

template <int DK, int NV, bool DELTA, bool VECDEC>
__device__ __forceinline__ void recur_batch(float (&S)[DK / (64 / NV)], LAS float* L, int nb, int wid, int lane) {
    constexpr int KQ = 64 / NV, KR = DK / KQ, DVT = 8 * NV;
    const int kq = lane / NV, vv = lane % NV, vcol = wid * NV + vv, hh = vcol >> 6;
    for (int t = 0; t < nb; ++t) {
        float kk[KR], qq[KR];
#pragma unroll
        for (int i = 0; i < KR; ++i) { kk[i] = L[MixLds::KS + t * 128 + kq * KR + i]; qq[i] = L[MixLds::QS + t * 128 + kq * KR + i]; }
        const float v = L[MixLds::VS + t * 128 + vcol];
        if (DELTA) {
            const float dec = L[MixLds::DS + t * 128 + hh]; float pk = 0.f;
#pragma unroll
            for (int i = 0; i < KR; ++i) { S[i] *= dec; pk += kk[i] * S[i]; }
#pragma unroll
            for (int o = NV; o < 64; o <<= 1) pk += lane_xor(pk, o, lane);
            const float u = L[MixLds::BS + t] * (v - pk);
#pragma unroll
            for (int i = 0; i < KR; ++i) S[i] += kk[i] * u;
        } else if (VECDEC) {
#pragma unroll
            for (int i = 0; i < KR; ++i) S[i] = L[MixLds::DS + t * 128 + kq * KR + i] * S[i] + kk[i] * v;
        } else {
            const float dec = L[MixLds::DS + t * 128 + hh];
#pragma unroll
            for (int i = 0; i < KR; ++i) S[i] = dec * S[i] + kk[i] * v;
        }
        float po = 0.f;
#pragma unroll
        for (int i = 0; i < KR; ++i) po += qq[i] * S[i];
#pragma unroll
        for (int o = NV; o < 64; o <<= 1) po += lane_xor(po, o, lane);
        if (kq == 0) L[MixLds::OS + t * 128 + vcol] = po;
    }
    (void)DVT;
}

template <int MIX>
__device__ void mixer_item(const Params& p, int layer, int s, int hu  , LAS float* L) {
    constexpr int DK = MIX == 2 ? 128 : 64, NV = MIX == 2 ? 16 : 8, KQ = 64 / NV, KR = DK / KQ, DVT = 8 * NV;
    const int tid = opaque_tid(), wid = tid >> 6, lane = tid & 63;
    const SeqInfo q = seq_info(s);
    const bf16_t* proj = (const bf16_t*)(p.ws + WS_PROJ); const float* psm = (const float*)(p.ws + WS_PSM); bf16_t* y = (bf16_t*)(p.ws + WS_Y);
    const float* lb = (const float*)(p.ws + WS_LB) + layer * 256; const float* rot = (const float*)(p.ws + WS_ROT);
    const int kq = lane / NV, vv = lane % NV, vcol = wid * NV + vv, hh = vcol >> 6;
    const int head = MIX == 2 ? hu * 2 + hh : hu;
    const float* ctx = nullptr; const float* cw = nullptr;
    if (MIX == 1) { cw = p.gdn_conv_w + (size_t)layer * 4 * 768; if (q.dec) ctx = p.st_gconv + ((size_t)layer * DECB + q.b) * 3 * 768; }
    if (MIX == 2) { cw = p.ssd_conv_w + (size_t)layer * 4 * 768; if (q.dec) ctx = p.st_sconv + ((size_t)layer * DECB + q.b) * 3 * 768; }
    float S[KR];
    {
        const float* st = MIX == 0 ? p.st_hgrn : MIX == 1 ? p.st_gdn : MIX == 2 ? p.st_ssd : p.st_ret;
#pragma unroll
        for (int i = 0; i < KR; ++i) S[i] = q.dec ? st[(((size_t)layer * DECB + q.b) * 4 + head) * DK * 64 + (size_t)(kq * KR + i) * 64 + (vcol & 63)] : 0.f;
    }
    float hc0 = 0.f, hc1 = 0.f;
    if (MIX == 1) { hc0 = -__expf(p.gdn_a_log[layer * 4 + hu]); hc1 = p.gdn_dt_bias[layer * 4 + hu]; }
    if (MIX == 3) { hc0 = 1.0f - exp2f(-5.0f - (float)hu); }

    for (int t0 = 0; t0 < q.T; t0 += TB) {
        const int nb = min(TB, q.T - t0);
        __syncthreads();
        if (MIX == 0) {
            for (int e = tid; e < nb * 64; e += 512) { const int t = e >> 6, d = e & 63, c = hu * 64 + d; const bf16_t* pr = proj + (size_t)(q.row0 + t0 + t) * NBIG;
                const float aq = bf2f(pr[PC_AQ + c]), af = bf2f(pr[PC_AF + c]), ai = bf2f(pr[PC_AI + c]), az = bf2f(pr[PC_AZ + c]), l_ = lb[c];
                L[MixLds::QS + t * 128 + d] = silu_f(aq) * 0.125f; L[MixLds::KS + t * 128 + d] = (1.0f - l_) * sigmoid_f(-af); L[MixLds::DS + t * 128 + d] = l_ + (1.0f - l_) * sigmoid_f(af);
                L[MixLds::VS + t * 128 + d] = ai; L[MixLds::ZS + t * 128 + d] = az; }
        } else if (MIX == 1) {
            for (int e = tid; e < nb * 192; e += 512) { const int t = e / 192, r = e % 192, part = r >> 6, d = r & 63, ch = part * 256 + hu * 64 + d, col = PC_BQKV + ch; const int tt = t0 + t;
                float a = 0.f;
#pragma unroll
                for (int j = 0; j < 4; ++j) a += cw[j * 768 + ch] * preconv(proj, q, tt - 3 + j, col, ctx, ch);
                a = silu_f(a);
                L[(part == 0 ? MixLds::QS : part == 1 ? MixLds::KS : MixLds::VS) + t * 128 + d] = a; }
            for (int e = tid; e < nb * 64; e += 512) { const int t = e >> 6, d = e & 63; L[MixLds::ZS + t * 128 + d] = bf2f(proj[(size_t)(q.row0 + t0 + t) * NBIG + PC_BZ + hu * 64 + d]); }
            if (tid < nb) { const float* ps = psm + (size_t)(q.row0 + t0 + tid) * NSM; const float g = hc0 * softplus_f(ps[hu] + hc1);
                L[MixLds::DS + tid * 128 + 0] = __expf(g); L[MixLds::BS + tid] = sigmoid_f(ps[4 + hu]); }
            __syncthreads();
            if (tid < nb * 2) { const int t = tid >> 1, which = tid & 1; const LAS float* src = L + (which ? MixLds::KS : MixLds::QS) + t * 128; float ss = 0.f;
                for (int d = 0; d < 64; ++d) ss += src[d] * src[d];
                L[MixLds::SC + tid] = rsqrtf(ss + EPSF) * (which ? 1.0f : 0.125f); }
            __syncthreads();
            for (int e = tid; e < nb * 128; e += 512) { const int t = e >> 7, r = e & 127, which = r >> 6, d = r & 63; L[(which ? MixLds::KS : MixLds::QS) + t * 128 + d] *= L[MixLds::SC + t * 2 + which]; }
        } else if (MIX == 2) {
            if (tid < nb * 2) { const int t = tid >> 1, h2 = tid & 1, hd = hu * 2 + h2; const float dt = softplus_f(psm[(size_t)(q.row0 + t0 + t) * NSM + 8 + hd] + p.ssd_dt_bias[layer * 4 + hd]);
                L[MixLds::BS + tid] = dt; L[MixLds::DS + t * 128 + h2] = __expf(-dt * __expf(p.ssd_a_log[layer * 4 + hd])); }
            __syncthreads();
            for (int e = tid; e < nb * 384; e += 512) { const int t = e / 384, r = e % 384, part = r >> 7, j = r & 127, ch = part * 256 + hu * 128 + j, col = PC_CXBC + ch; const int tt = t0 + t;
                float a = p.ssd_conv_b[layer * 768 + ch];
#pragma unroll
                for (int jj = 0; jj < 4; ++jj) a += cw[jj * 768 + ch] * preconv(proj, q, tt - 3 + jj, col, ctx, ch);
                a = silu_f(a);
                if (part == 0) { L[MixLds::XS + t * 128 + j] = a; L[MixLds::VS + t * 128 + j] = a * L[MixLds::BS + t * 2 + (j >> 6)]; }
                else if (part == 1) L[MixLds::KS + t * 128 + j] = a; else L[MixLds::QS + t * 128 + j] = a; }
            for (int e = tid; e < nb * 128; e += 512) { const int t = e >> 7, j = e & 127; L[MixLds::ZS + t * 128 + j] = bf2f(proj[(size_t)(q.row0 + t0 + t) * NBIG + PC_CZ + hu * 128 + j]); }
        } else {
            for (int e = tid; e < nb * 32; e += 512) { const int t = e >> 5, i = e & 31; const bf16_t* pr = proj + (size_t)(q.row0 + t0 + t) * NBIG; const int pidx = q.dec ? TP : (t0 + t);
                const float cs = rot[(pidx * 32 + i) * 2], sn = rot[(pidx * 32 + i) * 2 + 1];
                const float q1 = bf2f(pr[PC_DQ + hu * 64 + i]), q2 = bf2f(pr[PC_DQ + hu * 64 + 32 + i]), k1 = bf2f(pr[PC_DK + hu * 64 + i]), k2 = bf2f(pr[PC_DK + hu * 64 + 32 + i]);
                L[MixLds::QS + t * 128 + i] = q1 * cs - q2 * sn; L[MixLds::QS + t * 128 + 32 + i] = q2 * cs + q1 * sn;
                L[MixLds::KS + t * 128 + i] = (k1 * cs - k2 * sn) * 0.125f; L[MixLds::KS + t * 128 + 32 + i] = (k2 * cs + k1 * sn) * 0.125f; }
            for (int e = tid; e < nb * 64; e += 512) { const int t = e >> 6, d = e & 63; const bf16_t* pr = proj + (size_t)(q.row0 + t0 + t) * NBIG;
                L[MixLds::VS + t * 128 + d] = bf2f(pr[PC_DV + hu * 64 + d]); L[MixLds::ZS + t * 128 + d] = bf2f(pr[PC_DZ + hu * 64 + d]); }
            if (tid < nb) L[MixLds::DS + tid * 128] = hc0;
        }
        __syncthreads();
        recur_batch<DK, NV, MIX == 1, MIX == 0>(S, L, nb, wid, lane);
        __syncthreads();
        for (int t = wid; t < nb; t += 8) {
            const size_t yrow = (size_t)(q.row0 + t0 + t) * DM;
            if (MIX == 0 || MIX == 1) { const float o = L[MixLds::OS + t * 128 + lane]; const float ms = wave_sum(o * o, lane) * (1.0f / 64.0f);
                const float w = (MIX == 0 ? p.hgrn_norm_w : p.gdn_norm_w)[layer * 256 + hu * 64 + lane];
                y[yrow + (MIX == 0 ? 0 : 256) + hu * 64 + lane] = f2bf(o * rsqrtf(ms + EPSF) * w * silu_f(L[MixLds::ZS + t * 128 + lane])); }
            else if (MIX == 2) { float u[2]; float ss = 0.f;
#pragma unroll
                for (int r = 0; r < 2; ++r) { const int j = lane + 64 * r; const float o = L[MixLds::OS + t * 128 + j] + p.ssd_d[layer * 4 + hu * 2 + r] * L[MixLds::XS + t * 128 + j]; u[r] = o * silu_f(L[MixLds::ZS + t * 128 + j]); ss += u[r] * u[r]; }
                const float sc = rsqrtf(wave_sum(ss, lane) * (1.0f / 128.0f) + EPSF);
#pragma unroll
                for (int r = 0; r < 2; ++r) { const int j = lane + 64 * r; y[yrow + 512 + hu * 128 + j] = f2bf(u[r] * sc * p.ssd_norm_w[layer * 256 + hu * 128 + j]); } }
            else { const float o = L[MixLds::OS + t * 128 + lane]; const float mu = wave_sum(o, lane) * (1.0f / 64.0f); const float dv = o - mu; const float var = wave_sum(dv * dv, lane) * (1.0f / 64.0f);
                const int c = hu * 64 + lane;
                y[yrow + 768 + c] = f2bf((dv * rsqrtf(var + EPSF) * p.ret_norm_w[layer * 256 + c] + p.ret_norm_b[layer * 256 + c]) * silu_f(L[MixLds::ZS + t * 128 + lane])); }
        }
    }
    {
        float* so = p.out + (q.dec ? (MIX == 0 ? O_HGRN_S : MIX == 1 ? O_GDN_S : MIX == 2 ? O_SSD_S : O_RET_S) : (MIX == 0 ? O_HGRN_P : MIX == 1 ? O_GDN_P : MIX == 2 ? O_SSD_P : O_RET_P));
        const int nbt = q.dec ? DECB : NB;
#pragma unroll
        for (int i = 0; i < KR; ++i) so[(((size_t)layer * nbt + q.b) * 4 + head) * DK * 64 + (size_t)(kq * KR + i) * 64 + (vcol & 63)] = S[i];
    }
    if (MIX == 1 || MIX == 2) {
        float* co = p.out + (q.dec ? (MIX == 1 ? O_GCONV_S : O_SCONV_S) : (MIX == 1 ? O_GCONV_P : O_SCONV_P)) + ((size_t)layer * (q.dec ? DECB : NB) + q.b) * 3 * 768;
        const int nch = MIX == 1 ? 192 : 384;
        for (int e = tid; e < 3 * nch; e += 512) { const int r = e / nch, c = e % nch; int ch;
            if (MIX == 1) ch = (c >> 6) * 256 + hu * 64 + (c & 63); else ch = (c >> 7) * 256 + hu * 128 + (c & 127);
            co[r * 768 + ch] = preconv(proj, q, q.T - 3 + r, (MIX == 1 ? PC_BQKV : PC_CXBC) + ch, ctx, ch); }
    }
    (void)DVT;
}

constexpr int NCHUNK = 33;
constexpr int LDP = 72;
constexpr int LDP2 = 136;
constexpr int OSP = 68;
typedef short bf16x4 __attribute__((ext_vector_type(4)));
__device__ __forceinline__ f32x4 mfma16(bf16x8 a, bf16x8 b, f32x4 c) { return __builtin_amdgcn_mfma_f32_16x16x32_bf16(a, b, c, 0, 0, 0); }
__device__ __forceinline__ float fexp2(float x) { return __builtin_amdgcn_exp2f(x); }
__device__ __forceinline__ bf16x8 frag_ld(const LAS bf16_t* t, int pitch, int row, int col) { return *(const LAS bf16x8*)(t + row * pitch + col); }
__device__ __forceinline__ bf16x8 frag_ld_perm(const LAS bf16_t* t, int pitch, int row, int k0, int q) {
    const bf16x4 lo = *(const LAS bf16x4*)(t + row * pitch + k0 + 4 * q), hi = *(const LAS bf16x4*)(t + row * pitch + k0 + 16 + 4 * q);
    return __builtin_shufflevector(lo, hi, 0, 1, 2, 3, 4, 5, 6, 7);
}
__device__ __forceinline__ bf16x8 pack_acc2(const f32x4& a, const f32x4& b) {
    u32x4 w; w.x = pg8::cvt_pk_bf16(a[0], a[1]); w.y = pg8::cvt_pk_bf16(a[2], a[3]); w.z = pg8::cvt_pk_bf16(b[0], b[1]); w.w = pg8::cvt_pk_bf16(b[2], b[3]);
    return __builtin_bit_cast(bf16x8, w);
}
__device__ __forceinline__ void st_bf4(LAS bf16_t* dst, const f32x4& v) { u32x2 w; w.x = pg8::cvt_pk_bf16(v[0], v[1]); w.y = pg8::cvt_pk_bf16(v[2], v[3]); *(LAS u32x2*)dst = w; }
__device__ __forceinline__ void unpack_bf8(const u32x4& w, float* a) { const unsigned x[4] = {w.x, w.y, w.z, w.w};
#pragma unroll
    for (int k = 0; k < 4; ++k) { a[2 * k] = __uint_as_float(x[k] << 16); a[2 * k + 1] = __uint_as_float(x[k] & 0xffff0000u); } }
__device__ __forceinline__ u32x4 pack_bf8(const float* a) { u32x4 w; w.x = pg8::cvt_pk_bf16(a[0], a[1]); w.y = pg8::cvt_pk_bf16(a[2], a[3]); w.z = pg8::cvt_pk_bf16(a[4], a[5]); w.w = pg8::cvt_pk_bf16(a[6], a[7]); return w; }

constexpr size_t HR_QF = 0, HR_OI = 8192, HR_DS = 16384, HR_VEC = 24576, HR_UNIT = 25088;
constexpr size_t SS_QF = 0, SS_HEAD = 16384  , SS_VEC = 65536  , SS_UNIT = 66560;
constexpr size_t GD_U = 0, GD_W = 8192, GD_Q = 16384, GD_P = 24576, GD_K = 32768, GD_VEC = 40960, GD_UNIT = 41728;
constexpr size_t YOFF_R = 37748736;
static_assert((size_t)NB * NCHUNK * 2 * SS_UNIT <= YOFF_R && YOFF_R + (size_t)NB * NCHUNK * 4 * HR_UNIT <= (size_t)NB * SEQ * DM * 4 && (size_t)NB * NCHUNK * 4 * HR_UNIT <= (size_t)MROWS * DM * 2 && (size_t)NB * NCHUNK * 4 * GD_UNIT == WS_END - WS_E, "scratch map");
__device__ __forceinline__ unsigned char* rec_hgrn(const Params& p, int b, int c, int h) { return p.ws + WS_HB + (size_t)((b * NCHUNK + c) * 4 + h) * HR_UNIT; }
__device__ __forceinline__ unsigned char* rec_ret(const Params& p, int b, int c, int h) { return (unsigned char*)(p.out + O_YP) + YOFF_R + (size_t)((b * NCHUNK + c) * 4 + h) * HR_UNIT; }
__device__ __forceinline__ unsigned char* rec_gdn(const Params& p, int b, int c, int h) { return p.ws + WS_E + (size_t)((b * NCHUNK + c) * 4 + h) * GD_UNIT; }
__device__ __forceinline__ unsigned char* rec_ssd(const Params& p, int b, int c, int g) { return (unsigned char*)(p.out + O_YP) + (size_t)((b * NCHUNK + c) * 2 + g) * SS_UNIT; }
__device__ __forceinline__ bf16x8 frag_scale(const bf16x8& f, const float (&sc)[8]) { const u32x4 w = __builtin_bit_cast(u32x4, f); float a[8]; unpack_bf8(w, a);
#pragma unroll
    for (int e = 0; e < 8; ++e) a[e] *= sc[e];
    return __builtin_bit_cast(bf16x8, pack_bf8(a)); }
__device__ __forceinline__ void st_acc_bf4(unsigned char* dst, const f32x4& v) { u32x2 w; w.x = pg8::cvt_pk_bf16(v[0], v[1]); w.y = pg8::cvt_pk_bf16(v[2], v[3]); *(u32x2*)dst = w; }
__device__ __forceinline__ f32x4 ld_acc_bf4(const unsigned char* src) { const u32x2 w = *(const u32x2*)src; return (f32x4){__uint_as_float(w.x << 16), __uint_as_float(w.x & 0xffff0000u), __uint_as_float(w.y << 16), __uint_as_float(w.y & 0xffff0000u)}; }

template <int NR> struct Raw192 {
    static constexpr int NP = NR * 24, PPT = (NP + 511) / 512;
    u32x4 pc[PPT]; float sv[2];
    __device__ __forceinline__ void load(const bf16_t* projb, int tfirst, int col0, int col1, int col2, int tid) {
#pragma unroll
        for (int k = 0; k < PPT; ++k) { const int id = min(tid + 512 * k, NP - 1), row = id / 24, seg = id % 24, part = seg >> 3, t = tfirst + row;
            const u32x4 v = *(const u32x4*)(projb + (size_t)max(t, 0) * NBIG + (part == 0 ? col0 : part == 1 ? col1 : col2) + (seg & 7) * 8);
            pc[k] = t >= 0 ? v : (u32x4){0u, 0u, 0u, 0u}; }
    }
    __device__ __forceinline__ void to_lds(LAS bf16_t* T  , int tid) const {
#pragma unroll
        for (int k = 0; k < PPT; ++k) { const int id = tid + 512 * k; if (id < NP) *(LAS u32x4*)(T + (id / 24) * 192 + (id % 24) * 8) = pc[k]; }
    }
};
__device__ __forceinline__ void unit_bch(int v, int& b, int& c, int& h) { b = v / (NCHUNK * 4); c = (v >> 2) % NCHUNK; h = v & 3; }

struct RetRaw { Raw192<64> q; u32x4 rt[2];
    __device__ __forceinline__ void load(const Params& p, int v, int tid) { int b, c, h; unit_bch(v, b, c, h); const int t0 = 64 * c - 48;
        q.load((const bf16_t*)(p.ws + WS_PROJ) + (size_t)(b * TP) * NBIG, t0, PC_DQ + h * 64, PC_DK + h * 64, PC_DV + h * 64, tid);
#pragma unroll
        for (int k = 0; k < 2; ++k) { const int id = tid + 512 * k, row = id >> 4, sg = id & 15; rt[k] = *(const u32x4*)((const float*)(p.ws + WS_ROT) + (size_t)max(t0 + row, 0) * 64 + sg * 4); } }
};
struct RetLds { static constexpr int QS = 0, KS = QS + 64 * LDP * 2, KT = KS + 64 * LDP * 2, VT = KT + 64 * LDP * 2, VH = VT + 64 * LDP * 2, PS = VH + 64 * LDP * 2, RAW = PS + 64 * LDP * 2, ROT = RAW + 64 * 192 * 2, END = ROT + 64 * 64 * 4; };
__device__ void ret_pre_unit(const Params& p, int layer, int v_this, int v_next, RetRaw& RR, LAS unsigned char* lds) {
    int b, c, hu; unit_bch(v_this, b, c, hu);
    const int tid = opaque_tid(), wid = tid >> 6, lane = tid & 63, fq = lane >> 4, fc = lane & 15;
    LAS bf16_t* Qs = (LAS bf16_t*)(lds + RetLds::QS); LAS bf16_t* Ks = (LAS bf16_t*)(lds + RetLds::KS); LAS bf16_t* KT = (LAS bf16_t*)(lds + RetLds::KT);
    LAS bf16_t* VT = (LAS bf16_t*)(lds + RetLds::VT); LAS bf16_t* VH = (LAS bf16_t*)(lds + RetLds::VH); LAS bf16_t* Ps = (LAS bf16_t*)(lds + RetLds::PS);
    LAS bf16_t* RawT = (LAS bf16_t*)(lds + RetLds::RAW); LAS float* RotT = (LAS float*)(lds + RetLds::ROT);
    const float lg2 = log2f(1.0f - exp2f(-5.0f - (float)hu));
    const int i0 = c == 0 ? 48 : 0, nlast = 64 - i0;
    unsigned char* rec = rec_ret(p, b, c, hu);
    lds_barrier();
    RR.q.to_lds(RawT, tid);
#pragma unroll
    for (int k = 0; k < 2; ++k) *(LAS u32x4*)(RotT + (tid + 512 * k) * 4) = RR.rt[k];
    if (v_next >= 0) RR.load(p, v_next, tid);
    lds_barrier();
#pragma unroll
    for (int n_ = 0; n_ < 4; ++n_) { const int e = tid + 512 * n_; const int i = e >> 5, d = e & 31; float qa, qb, ka, kb;
        { const LAS bf16_t* pr = RawT + i * 192; const float cs = RotT[i * 64 + 2 * d], sn = RotT[i * 64 + 2 * d + 1];
            const float q1 = bf2f(pr[d]), q2 = bf2f(pr[32 + d]), k1 = bf2f(pr[64 + d]), k2 = bf2f(pr[96 + d]);
            const float mk = i >= i0 ? 1.0f : 0.0f;
            qa = (q1 * cs - q2 * sn) * mk; qb = (q2 * cs + q1 * sn) * mk; ka = (k1 * cs - k2 * sn) * (0.125f * mk); kb = (k2 * cs + k1 * sn) * (0.125f * mk); }
        Qs[i * LDP + d] = f2bf(qa); Qs[i * LDP + 32 + d] = f2bf(qb); Ks[i * LDP + d] = f2bf(ka); Ks[i * LDP + 32 + d] = f2bf(kb);
        KT[d * LDP + i] = f2bf(ka); KT[(d + 32) * LDP + i] = f2bf(kb); }
#pragma unroll
    for (int n_ = 0; n_ < 8; ++n_) { const int e = tid + 512 * n_; const int i = e >> 6, d = e & 63;
        float v = bf2f(RawT[i * 192 + 128 + d]); v = i >= i0 ? v : 0.f; const float vh = v * fexp2((float)(63 - i) * lg2);
        VT[d * LDP + i] = f2bf(v); VH[d * LDP + i] = f2bf(vh); }
    lds_barrier();
#pragma unroll
    for (int tt = 0; tt < 2; ++tt) { const int t = wid * 2 + tt, I = t >> 2, J = t & 3; f32x4 acc = (f32x4){0.f, 0.f, 0.f, 0.f};
        if (J <= I) {
#pragma unroll
            for (int s = 0; s < 2; ++s) acc = mfma16(frag_ld(Ks, LDP, 16 * J + fc, 32 * s + 8 * fq), frag_ld(Qs, LDP, 16 * I + fc, 32 * s + 8 * fq), acc); }
        const int i = 16 * I + fc;
#pragma unroll
        for (int r = 0; r < 4; ++r) { const int j = 16 * J + 4 * fq + r; acc[r] = (j <= i && j >= i0) ? acc[r] * fexp2((float)(i - j) * lg2) : 0.f; }
        st_bf4(Ps + i * LDP + 16 * J + 4 * fq, acc); }
    lds_barrier();
    { const int w = wid & 3; bf16x8 bb[2];
#pragma unroll
        for (int s = 0; s < 2; ++s) bb[s] = frag_ld(wid < 4 ? VT : VH, LDP, 16 * w + fc, 32 * s + 8 * fq);
        const LAS bf16_t* At = wid < 4 ? Ps : KT; unsigned char* dst = rec + (wid < 4 ? HR_OI : HR_DS);
#pragma unroll
        for (int m = 0; m < 4; ++m) { f32x4 acc = (f32x4){0.f, 0.f, 0.f, 0.f};
#pragma unroll
            for (int s = 0; s < 2; ++s) acc = mfma16(frag_ld(At, LDP, 16 * m + fc, 32 * s + 8 * fq), bb[s], acc);
            st_acc_bf4(dst + ((size_t)(w * 4 + m) * 64 + lane) * 8, acc); }
        { const float eg = fexp2((float)max(16 * (wid >> 1) + fc - i0 + 1, 0) * lg2); const float sc[8] = {eg, eg, eg, eg, eg, eg, eg, eg};
            *(bf16x8*)(rec + HR_QF + ((size_t)wid * 64 + lane) * 16) = frag_scale(frag_ld_perm(Qs, LDP, 16 * (wid >> 1) + fc, 32 * (wid & 1), fq), sc); }
        if (tid < 64) { float* gv = (float*)(rec + HR_VEC); gv[64 + tid] = fexp2((float)nlast * lg2); } }
}

struct HgLds { static constexpr int LS = 0  , KR = LS + 16384  , QR = KR + 16384  , QT = QR + 16384, QH = QT + 64 * LDP * 2, KT = QH + 64 * LDP * 2  ,
    KHT = KT + 160 * LDP * 2, VT = KHT + 64 * LDP * 2, PS = VT + 64 * LDP * 2, AV = PS + 64 * LDP * 2, RAW = AV + 256, END = RAW + 64 * 192 * 2; };
struct HgRaw { Raw192<64> q;
    __device__ __forceinline__ void load(const Params& p, int v, int tid) { int b, c, h; unit_bch(v, b, c, h);
        q.load((const bf16_t*)(p.ws + WS_PROJ) + (size_t)(b * TP) * NBIG, 64 * c - 48, PC_AQ + h * 64, PC_AF + h * 64, PC_AI + h * 64, tid); }
};
__device__ void hgrn_pre_unit(const Params& p, int layer, int v_this, int v_next, HgRaw& RR, LAS unsigned char* lds) {
    int b, c, hu; unit_bch(v_this, b, c, hu);
    const int tid = opaque_tid(), wid = tid >> 6, lane = tid & 63, fq = lane >> 4, fc = lane & 15;
    LAS float* Ls = (LAS float*)(lds + HgLds::LS); LAS float* Kr = (LAS float*)(lds + HgLds::KR); LAS float* Qr = (LAS float*)(lds + HgLds::QR);
    LAS bf16_t* Qt = (LAS bf16_t*)(lds + HgLds::QT); LAS bf16_t* Qh = (LAS bf16_t*)(lds + HgLds::QH); LAS bf16_t* Kt = (LAS bf16_t*)(lds + HgLds::KT); LAS bf16_t* KhT = (LAS bf16_t*)(lds + HgLds::KHT);
    LAS bf16_t* VT = (LAS bf16_t*)(lds + HgLds::VT); LAS bf16_t* Ps = (LAS bf16_t*)(lds + HgLds::PS); LAS float* Av = (LAS float*)(lds + HgLds::AV);
    LAS bf16_t* RawT = (LAS bf16_t*)(lds + HgLds::RAW);
    const float lbv = ((const float*)(p.ws + WS_LB))[layer * 256 + hu * 64 + lane];
    const int i0 = c == 0 ? 48 : 0;
    unsigned char* rec = rec_hgrn(p, b, c, hu);
    lds_barrier();
    RR.q.to_lds(RawT, tid);
    if (v_next >= 0) RR.load(p, v_next, tid);
    lds_barrier();
    if (wid < 4) { float acc = 0.f; float afr[16];
#pragma unroll
        for (int ii = 0; ii < 16; ++ii) { const int i = 16 * wid + ii; afr[ii] = bf2f(RawT[i * 192 + 64 + lane]); }
#pragma unroll
        for (int ii = 0; ii < 16; ++ii) { const int i = 16 * wid + ii; float kk;
            { float af = afr[ii]; af = fminf(fmaxf(af, -30.f), 30.f);
                const float e = __expf(-af), sg = __builtin_amdgcn_rcpf(1.0f + e); const float f = lbv + (1.0f - lbv) * sg; const bool ok = i >= i0; kk = ok ? (1.0f - lbv) * e * sg : 0.f; acc += ok ? __log2f(fmaxf(f, 1e-30f)) : 0.f; }
            Ls[i * 64 + lane] = acc; Kr[i * 64 + lane] = kk; } }
    else {
#pragma unroll
        for (int n_ = 0; n_ < 16; ++n_) { const int e = tid - 256 + 256 * n_; const int i = e >> 6, d = e & 63;
            const LAS bf16_t* pr = RawT + i * 192; float q = silu_f(bf2f(pr[d])) * 0.125f, v = bf2f(pr[128 + d]); if (i < i0) { q = 0.f; v = 0.f; }
            Qr[i * 64 + d] = q; VT[d * LDP + i] = f2bf(v); } }
    lds_barrier();
#pragma unroll 2
    for (int n_ = 0; n_ < 8; ++n_) { const int e = tid + 512 * n_; const int i = e >> 6, d = e & 63, I = i >> 4;
        const float T0 = Ls[15 * 64 + d], T1 = Ls[31 * 64 + d], T2 = Ls[47 * 64 + d], T3 = Ls[63 * 64 + d];
        const float Bi = I == 0 ? 0.f : I == 1 ? T0 : I == 2 ? T0 + T1 : T0 + T1 + T2; const float Li = Ls[i * 64 + d], Gi = Bi + Li, Gl = T0 + T1 + T2 + T3;
        const float q = Qr[i * 64 + d], k = Kr[i * 64 + d];
        Qt[i * LDP + d] = f2bf(q * fexp2(Li)); Qh[i * LDP + d] = f2bf(q * fexp2(Gi)); KhT[d * LDP + i] = f2bf(k * fexp2(Gl - Gi));
        float Bp = Bi;
        Kt[((I == 0 ? 0 : I == 1 ? 16 : I == 2 ? 48 : 96) + i) * LDP + d] = f2bf(k * fexp2(Bp - Gi));
        if (I <= 0) { Bp = T0; Kt[(16 + i) * LDP + d] = f2bf(k * fexp2(Bp - Gi)); }
        if (I <= 1) { Bp = T0 + T1; Kt[(48 + i) * LDP + d] = f2bf(k * fexp2(Bp - Gi)); }
        if (I <= 2) { Bp = T0 + T1 + T2; Kt[(96 + i) * LDP + d] = f2bf(k * fexp2(Bp - Gi)); }
        if (i == 0) Av[d] = fexp2(Gl); }
    lds_barrier();
#pragma unroll
    for (int tt = 0; tt < 2; ++tt) { const int t = wid * 2 + tt, I = t >> 2, J = t & 3; f32x4 acc = (f32x4){0.f, 0.f, 0.f, 0.f};
        if (J <= I) { const int kb = (I == 0 ? 0 : I == 1 ? 16 : I == 2 ? 48 : 96) + 16 * J;
#pragma unroll
            for (int s = 0; s < 2; ++s) acc = mfma16(frag_ld(Kt, LDP, kb + fc, 32 * s + 8 * fq), frag_ld(Qt, LDP, 16 * I + fc, 32 * s + 8 * fq), acc); }
        const int i = 16 * I + fc;
#pragma unroll
        for (int r = 0; r < 4; ++r) { const int j = 16 * J + 4 * fq + r; acc[r] = (j <= i) ? acc[r] : 0.f; }
        st_bf4(Ps + i * LDP + 16 * J + 4 * fq, acc); }
    lds_barrier();
    { const int w = wid & 3; bf16x8 bb[2];
#pragma unroll
        for (int s = 0; s < 2; ++s) bb[s] = frag_ld(VT, LDP, 16 * w + fc, 32 * s + 8 * fq);
        const LAS bf16_t* At = wid < 4 ? Ps : KhT; unsigned char* dst = rec + (wid < 4 ? HR_OI : HR_DS);
#pragma unroll
        for (int m = 0; m < 4; ++m) { f32x4 acc = (f32x4){0.f, 0.f, 0.f, 0.f};
#pragma unroll
            for (int s = 0; s < 2; ++s) acc = mfma16(frag_ld(At, LDP, 16 * m + fc, 32 * s + 8 * fq), bb[s], acc);
            st_acc_bf4(dst + ((size_t)(w * 4 + m) * 64 + lane) * 8, acc); }
        *(bf16x8*)(rec + HR_QF + ((size_t)wid * 64 + lane) * 16) = frag_ld_perm(Qh, LDP, 16 * (wid >> 1) + fc, 32 * (wid & 1), fq);
        if (tid < 64) { float* gv = (float*)(rec + HR_VEC); gv[64 + tid] = Av[tid]; } }
}

struct SsdLds { static constexpr int CS = 0, BS = CS + 64 * LDP2 * 2, BT = BS + 64 * LDP2 * 2, XS = BT + 128 * LDP * 2, VT = XS + 64 * LDP2 * 2  , VH = VT + 2 * 64 * LDP * 2, PS = VH + 2 * 64 * LDP * 2  ,
    DT = PS + 67 * 384 * 2  , GV = DT + 512, END = GV + 512; };
constexpr int SSD_NPIECE = 67 * 48;
struct SsRaw { u32x4 raw[7]; float psmv;
    __device__ __forceinline__ void load(const Params& p, int t, int tid) { const int b = t / (NCHUNK * 2), c = (t >> 1) % NCHUNK, gg = t & 1, t0 = 64 * c - 48;
        const bf16_t* projb = (const bf16_t*)(p.ws + WS_PROJ) + (size_t)(b * TP) * NBIG;
#pragma unroll
        for (int k = 0; k < 7; ++k) { const int id = min(tid + 512 * k, SSD_NPIECE - 1), row = id / 48, seg = id % 48, tt = t0 - 3 + row;
            const u32x4 v = *(const u32x4*)(projb + (size_t)max(tt, 0) * NBIG + PC_CXBC + (seg >> 4) * 256 + gg * 128 + (seg & 15) * 8);
            raw[k] = tt >= 0 ? v : (u32x4){0u, 0u, 0u, 0u}; }
        psmv = ((const float*)(p.ws + WS_PSM))[(size_t)(b * TP + max(t0 + (tid & 63), 0)) * NSM + 8 + gg * 2 + ((tid >> 6) & 1)]; }
};
__device__ void ssd_pre_unit(const Params& p, int layer, int t_this, int t_next, SsRaw& RR, LAS unsigned char* lds) {
    const int b = t_this / (NCHUNK * 2), c = (t_this >> 1) % NCHUNK, gg = t_this & 1;
    const int tid = opaque_tid(), wid = tid >> 6, lane = tid & 63, fq = lane >> 4, fc = lane & 15;
    LAS bf16_t* Cs = (LAS bf16_t*)(lds + SsdLds::CS); LAS bf16_t* Bs = (LAS bf16_t*)(lds + SsdLds::BS); LAS bf16_t* BT = (LAS bf16_t*)(lds + SsdLds::BT); LAS bf16_t* Xs = (LAS bf16_t*)(lds + SsdLds::XS);
    LAS bf16_t* VT = (LAS bf16_t*)(lds + SsdLds::VT); LAS bf16_t* VH = (LAS bf16_t*)(lds + SsdLds::VH); LAS bf16_t* Ps = (LAS bf16_t*)(lds + SsdLds::PS); LAS bf16_t* RawT = Ps;
    LAS float* DTv = (LAS float*)(lds + SsdLds::DT); LAS float* Gv = (LAS float*)(lds + SsdLds::GV);
    const bf16_t* projb = (const bf16_t*)(p.ws + WS_PROJ) + (size_t)(b * TP) * NBIG; const float* psmb = (const float*)(p.ws + WS_PSM) + (size_t)(b * TP) * NSM;
    const float* cw = p.ssd_conv_w + (size_t)layer * 4 * 768; const float* cb = p.ssd_conv_b + (size_t)layer * 768;
    constexpr float L2E = 1.4426950408889634f;
    const int hh = wid >> 2, ws = wid & 3;
    const int i0 = c == 0 ? 48 : 0, t0 = 64 * c - 48;
    unsigned char* rec = rec_ssd(p, b, c, gg);
    const float psmv = RR.psmv;
    lds_barrier();
    if (wid < 2) { const int hd = gg * 2 + wid;
        float dt = softplus_f(psmv + p.ssd_dt_bias[layer * 4 + hd]); dt = lane >= i0 ? dt : 0.f;
        float G = -dt * __expf(p.ssd_a_log[layer * 4 + hd]) * L2E;
#pragma unroll
        for (int o = 1; o < 64; o <<= 1) { const float t = lane_up(G, o, lane); if (lane >= o) G += t; }
        DTv[wid * 64 + lane] = dt; Gv[wid * 64 + lane] = G; }
#pragma unroll
    for (int k = 0; k < 7; ++k) { const int id = tid + 512 * k; if (id < SSD_NPIECE) *(LAS u32x4*)(RawT + (id / 48) * 384 + (id % 48) * 8) = RR.raw[k]; }
    if (t_next >= 0) RR.load(p, t_next, tid);
    lds_barrier();
#pragma unroll 1
    for (int n = 0; n < 3; ++n) { const int e = tid + 512 * n, ch = e % 384, tr = e / 384, part = ch >> 7, j = ch & 127, chf = part * 256 + gg * 128 + j;
        const float w0 = cw[chf], w1 = cw[768 + chf], w2 = cw[2 * 768 + chf], w3 = cw[3 * 768 + chf], bias = cb[chf];
#pragma unroll
        for (int hf = 0; hf < 2; ++hf) { const int ib = 16 * tr + 8 * hf; float a[8], rw[11];
#pragma unroll
            for (int ii = 0; ii < 11; ++ii) rw[ii] = bf2f(RawT[(ib + ii) * 384 + ch]);
#pragma unroll
            for (int ii = 0; ii < 8; ++ii) { a[ii] = silu_f(bias + w0 * rw[ii] + w1 * rw[ii + 1] + w2 * rw[ii + 2] + w3 * rw[ii + 3]); if (ib + ii < i0) a[ii] = 0.f; }
            if (part == 0) { const int h2 = j >> 6, d = j & 63; const float gl = Gv[h2 * 64 + 63]; float xh[8];
#pragma unroll
                for (int ii = 0; ii < 8; ++ii) { const int i = ib + ii; Xs[i * LDP2 + j] = f2bf(a[ii]); a[ii] *= DTv[h2 * 64 + i]; xh[ii] = a[ii] * fexp2(gl - Gv[h2 * 64 + i]); }
                *(LAS u32x4*)(VT + (h2 * 64 + d) * LDP + ib) = pack_bf8(a); *(LAS u32x4*)(VH + (h2 * 64 + d) * LDP + ib) = pack_bf8(xh); }
            else if (part == 1) {
#pragma unroll
                for (int ii = 0; ii < 8; ++ii) Bs[(ib + ii) * LDP2 + j] = f2bf(a[ii]);
                *(LAS u32x4*)(BT + j * LDP + ib) = pack_bf8(a); }
            else {
#pragma unroll
                for (int ii = 0; ii < 8; ++ii) Cs[(ib + ii) * LDP2 + j] = f2bf(a[ii]); } } }
    lds_barrier();
#pragma unroll
    for (int tt = 0; tt < 2; ++tt) { const int t = wid * 2 + tt, I = t >> 2, J = t & 3; f32x4 acc = (f32x4){0.f, 0.f, 0.f, 0.f};
        if (J <= I) {
#pragma unroll
            for (int s = 0; s < 4; ++s) acc = mfma16(frag_ld(Bs, LDP2, 16 * J + fc, 32 * s + 8 * fq), frag_ld(Cs, LDP2, 16 * I + fc, 32 * s + 8 * fq), acc); }
        const int i = 16 * I + fc;
#pragma unroll
        for (int h2 = 0; h2 < 2; ++h2) { f32x4 pv; const float gi = Gv[h2 * 64 + i];
#pragma unroll
            for (int r = 0; r < 4; ++r) { const int j = 16 * J + 4 * fq + r; pv[r] = (j <= i && j >= i0) ? acc[r] * fexp2(gi - Gv[h2 * 64 + j]) : 0.f; }
            st_bf4(Ps + (h2 * 64 + i) * LDP + 16 * J + 4 * fq, pv); } }
    lds_barrier();
    { bf16x8 bv[2], bh[2]; unsigned char* hrec = rec + SS_HEAD + (size_t)hh * 24576; const float dsk = p.ssd_d[layer * 4 + gg * 2 + hh];
#pragma unroll
        for (int s = 0; s < 2; ++s) { bv[s] = frag_ld(VT, LDP, hh * 64 + 16 * ws + fc, 32 * s + 8 * fq); bh[s] = frag_ld(VH, LDP, hh * 64 + 16 * ws + fc, 32 * s + 8 * fq); }
#pragma unroll
        for (int mi = 0; mi < 4; ++mi) { f32x4 o1 = (f32x4){0.f, 0.f, 0.f, 0.f};
#pragma unroll
            for (int s = 0; s < 2; ++s) o1 = mfma16(frag_ld(Ps, LDP, hh * 64 + 16 * mi + fc, 32 * s + 8 * fq), bv[s], o1);
#pragma unroll
            for (int r = 0; r < 4; ++r) o1[r] += dsk * bf2f(Xs[(16 * mi + 4 * fq + r) * LDP2 + hh * 64 + 16 * ws + fc]);
            st_acc_bf4(hrec + ((size_t)(ws * 4 + mi) * 64 + lane) * 8, o1); }
#pragma unroll
        for (int m = 0; m < 8; ++m) { f32x4 d = (f32x4){0.f, 0.f, 0.f, 0.f};
#pragma unroll
            for (int s = 0; s < 2; ++s) d = mfma16(frag_ld(BT, LDP, 16 * m + fc, 32 * s + 8 * fq), bh[s], d);
            st_acc_bf4(hrec + 8192 + ((size_t)(ws * 8 + m) * 64 + lane) * 8, d); }
#pragma unroll
        for (int x = 0; x < 2; ++x) { const int sl = wid * 2 + x; *(bf16x8*)(rec + SS_QF + ((size_t)sl * 64 + lane) * 16) = frag_ld_perm(Cs, LDP2, 16 * (sl >> 2) + fc, 32 * (sl & 3), fq); }
        if (tid < 128) { float* gv = (float*)(rec + SS_VEC + (size_t)(tid >> 6) * 512); gv[tid & 63] = fexp2(Gv[tid]); if ((tid & 63) == 0) gv[64] = fexp2(Gv[(tid >> 6) * 64 + 63]); } }
}

struct GdLds { static constexpr int QF = 0, KF = 16384, VF = 32768, QN = 49152, KN = QN + 64 * LDP * 2, KNT = KN + 64 * LDP * 2, NM = KNT + 64 * LDP * 2, QK = NM + 64 * LDP * 2, WT = QK + 64 * LDP * 2,
    MD = WT + 64 * LDP * 2  , TD = MD + 4096  , GV = TD + 2048, BV = GV + 256, RAW = BV + 256, END = RAW + 67 * 192 * 2; };
struct GdRaw { Raw192<67> q;
    __device__ __forceinline__ void load(const Params& p, int v, int tid) { int b, c, h; unit_bch(v, b, c, h); const int t0 = 64 * c - 48;
        q.load((const bf16_t*)(p.ws + WS_PROJ) + (size_t)(b * TP) * NBIG, t0 - 3, PC_BQKV + h * 64, PC_BQKV + 256 + h * 64, PC_BQKV + 512 + h * 64, tid);
        const float* ps = (const float*)(p.ws + WS_PSM) + (size_t)(b * TP + max(t0 + (tid & 63), 0)) * NSM; q.sv[0] = ps[h]; q.sv[1] = ps[4 + h]; }
};
__device__ void gdn_pre_unit(const Params& p, int layer, int v_this, int v_next, GdRaw& RR, LAS unsigned char* lds) {
    int b, c, hu; unit_bch(v_this, b, c, hu);
    const int tid = opaque_tid(), wid = tid >> 6, lane = tid & 63, fq = lane >> 4, fc = lane & 15;
    LAS float* Qf = (LAS float*)(lds + GdLds::QF); LAS float* Kf = (LAS float*)(lds + GdLds::KF); LAS float* Vf = (LAS float*)(lds + GdLds::VF);
    LAS bf16_t* Qn = (LAS bf16_t*)(lds + GdLds::QN); LAS bf16_t* Kn = (LAS bf16_t*)(lds + GdLds::KN); LAS bf16_t* KnT = (LAS bf16_t*)(lds + GdLds::KNT);
    LAS bf16_t* NM = (LAS bf16_t*)(lds + GdLds::NM); LAS bf16_t* QK = (LAS bf16_t*)(lds + GdLds::QK); LAS bf16_t* Wt = (LAS bf16_t*)(lds + GdLds::WT);
    LAS float* MD = (LAS float*)(lds + GdLds::MD); LAS bf16_t* TD = (LAS bf16_t*)(lds + GdLds::TD); LAS float* Gv = (LAS float*)(lds + GdLds::GV); LAS float* Bv = (LAS float*)(lds + GdLds::BV);
    LAS bf16_t* RawT = (LAS bf16_t*)(lds + GdLds::RAW);
    const float* cw = p.gdn_conv_w + (size_t)layer * 4 * 768;
    unsigned char* gd = rec_gdn(p, b, c, hu);
    constexpr float L2E = 1.4426950408889634f;
    const int i0 = c == 0 ? 48 : 0;
    const float sva = RR.q.sv[0], svb = RR.q.sv[1];
    lds_barrier();
    RR.q.to_lds(RawT, tid);
    if (v_next >= 0) RR.load(p, v_next, tid);
    lds_barrier();
    if (wid == 0) {
        float g = -__expf(p.gdn_a_log[layer * 4 + hu]) * softplus_f(sva + p.gdn_dt_bias[layer * 4 + hu]) * L2E, be = sigmoid_f(svb); if (lane < i0) { g = 0.f; be = 0.f; }
#pragma unroll
        for (int o = 1; o < 64; o <<= 1) { const float t = lane_up(g, o, lane); if (lane >= o) g += t; }
        Gv[lane] = g; Bv[lane] = be; }
#pragma unroll
    for (int n_ = 0; n_ < 3; ++n_) { const int e = tid + 512 * n_; const int ch = e % 192, tr = e / 192, part = ch >> 6, d = ch & 63, chf = part * 256 + hu * 64 + d;
        const float w0 = cw[chf], w1 = cw[768 + chf], w2 = cw[2 * 768 + chf], w3 = cw[3 * 768 + chf];
        float raw[11];
#pragma unroll
        for (int ii = 0; ii < 11; ++ii) raw[ii] = bf2f(RawT[(8 * tr + ii) * 192 + ch]);
        LAS float* dst = part == 0 ? Qf : part == 1 ? Kf : Vf;
#pragma unroll
        for (int ii = 0; ii < 8; ++ii) { const int i = 8 * tr + ii;
            float a = silu_f(w0 * raw[ii] + w1 * raw[ii + 1] + w2 * raw[ii + 2] + w3 * raw[ii + 3]); if (i < i0) a = 0.f;
            dst[i * 64 + d] = a; } }
    lds_barrier();
    { const int ri = tid >> 3, sg = tid & 7; float q[8], k[8], sq = 0.f, sk = 0.f;
#pragma unroll
        for (int x = 0; x < 8; ++x) { q[x] = Qf[ri * 64 + sg * 8 + x]; k[x] = Kf[ri * 64 + sg * 8 + x]; sq += q[x] * q[x]; sk += k[x] * k[x]; }
        sq = sum8(sq); sk = sum8(sk);
        const float rq = rsqrtf(sq + EPSF) * 0.125f, rk = rsqrtf(sk + EPSF);
#pragma unroll
        for (int x = 0; x < 8; ++x) { q[x] *= rq; k[x] *= rk; Kf[ri * 64 + sg * 8 + x] = k[x]; KnT[(sg * 8 + x) * LDP + ri] = f2bf(k[x]); }
        *(LAS u32x4*)(Qn + ri * LDP + sg * 8) = pack_bf8(q); *(LAS u32x4*)(Kn + ri * LDP + sg * 8) = pack_bf8(k); }
    lds_barrier();
#pragma unroll
    for (int tt = 0; tt < 2; ++tt) { const int t = wid * 2 + tt, I = t >> 2, J = t & 3; f32x4 a1 = (f32x4){0.f, 0.f, 0.f, 0.f}, a2 = (f32x4){0.f, 0.f, 0.f, 0.f};
        if (J <= I) {
#pragma unroll
            for (int s = 0; s < 2; ++s) { const bf16x8 kj = frag_ld(Kn, LDP, 16 * J + fc, 32 * s + 8 * fq); a1 = mfma16(kj, frag_ld(Kn, LDP, 16 * I + fc, 32 * s + 8 * fq), a1); a2 = mfma16(kj, frag_ld(Qn, LDP, 16 * I + fc, 32 * s + 8 * fq), a2); } }
        const int i = 16 * I + fc; const float gi = Gv[i], bi = Bv[i]; f32x4 nm, qk;
#pragma unroll
        for (int r = 0; r < 4; ++r) { const int j = 16 * J + 4 * fq + r; const float dec = j <= i ? fexp2(gi - Gv[j]) : 0.f; const float mm = j < i ? a1[r] * dec * bi : 0.f; nm[r] = -mm; qk[r] = a2[r] * dec;
            if (J == I) MD[(I * 16 + fc) * 16 + 4 * fq + r] = mm; }
        st_bf4(NM + i * LDP + 16 * J + 4 * fq, nm); st_bf4(QK + i * LDP + 16 * J + 4 * fq, qk); }
    lds_barrier();
    if (wid == 0) { const int I = fq, cc = fc; float x[16];
#pragma unroll
        for (int i = 0; i < 16; ++i) { float acc = (i == cc) ? 1.0f : 0.0f;
#pragma unroll
            for (int j = 0; j < i; ++j) acc -= MD[(I * 16 + i) * 16 + j] * x[j];
            x[i] = acc; TD[(I * 16 + i) * 16 + cc] = f2bf(acc); } }
    lds_barrier();
    const int isW = wid >> 2, ws = wid & 3, colx = 16 * ws + fc;
    const LAS float* rhs = isW ? Kf : Vf;
    f32x4 X[4];
    const f32x4 zero4 = (f32x4){0.f, 0.f, 0.f, 0.f};
#pragma unroll
    for (int I = 0; I < 4; ++I) { f32x4 acc;
#pragma unroll
        for (int r = 0; r < 4; ++r) { const int j = 16 * I + 4 * fq + r; const float sc = Bv[j] * (isW ? fexp2(Gv[j]) : 1.0f); acc[r] = sc * rhs[j * 64 + colx]; }
        if (I >= 1) acc = mfma16(frag_ld_perm(NM, LDP, 16 * I + fc, 0, fq), pack_acc2(X[0], I > 1 ? X[1] : zero4), acc);
        if (I == 3) acc = mfma16(frag_ld_perm(NM, LDP, 48 + fc, 32, fq), pack_acc2(X[2], zero4), acc);
        const bf16x4 tlo = *(const LAS bf16x4*)(TD + (I * 16 + fc) * 16 + 4 * fq); const bf16x4 z4 = (bf16x4){0, 0, 0, 0};
        X[I] = mfma16(__builtin_shufflevector(tlo, z4, 0, 1, 2, 3, 4, 5, 6, 7), pack_acc2(acc, zero4), zero4); }
    if (!isW) {
#pragma unroll
        for (int m = 0; m < 4; ++m) st_acc_bf4(gd + GD_U + ((size_t)(ws * 4 + m) * 64 + lane) * 8, X[m]); }
    else {
#pragma unroll
        for (int m = 0; m < 4; ++m)
#pragma unroll
            for (int r = 0; r < 4; ++r) Wt[(16 * m + 4 * fq + r) * LDP + colx] = f2bf(-X[m][r]); }
    lds_barrier();
    { const int tsel = wid >> 1; const LAS bf16_t* tile = tsel == 0 ? Wt : tsel == 1 ? Qn : tsel == 2 ? QK : KnT; unsigned char* dst = gd + (tsel == 0 ? GD_W : tsel == 1 ? GD_Q : tsel == 2 ? GD_P : GD_K);
#pragma unroll
        for (int x = 0; x < 4; ++x) { const int sl = (wid & 1) * 4 + x, m = sl >> 1, s = sl & 1; bf16x8 f = frag_ld_perm(tile, LDP, 16 * m + fc, 32 * s, fq);
            if (tsel == 1) { const float eg = fexp2(Gv[16 * m + fc]); const float sc[8] = {eg, eg, eg, eg, eg, eg, eg, eg}; f = frag_scale(f, sc); }
            if (tsel == 3) { float sc[8];
#pragma unroll
                for (int e = 0; e < 8; ++e) sc[e] = fexp2(Gv[63] - Gv[32 * s + 16 * (e >> 2) + 4 * fq + (e & 3)]);
                f = frag_scale(f, sc); }
            *(bf16x8*)(dst + ((size_t)sl * 64 + lane) * 16) = f; } }
    if (tid == 0) { float* gv = (float*)(gd + GD_VEC); gv[128] = fexp2(Gv[63]); }
}

template <int MIX> struct SeqRegs {
    static constexpr int DK = MIX == 2 ? 128 : 64, NT = DK / 16;
    u32x2 oi[4]; u32x2 ds[MIX == 1 ? 1 : NT]; f32x4 eg[MIX == 2 ? 4 : 1]; f32x4 al[MIX == 0 ? 4 : 1];
    __device__ __forceinline__ void load(const Params& p, int b, int c, int hd, int ws, int lane, int fq) {
        const unsigned char* base = MIX == 2 ? rec_ssd(p, b, c, hd >> 1) : MIX == 0 ? rec_hgrn(p, b, c, hd) : MIX == 1 ? rec_gdn(p, b, c, hd) : rec_ret(p, b, c, hd);
        const unsigned char* o = MIX == 2 ? base + SS_HEAD + (size_t)(hd & 1) * 24576 : MIX == 1 ? base + GD_U : base + HR_OI;
        const unsigned char* d = MIX == 2 ? o + 8192 : base + HR_DS; const float* gv = (const float*)(MIX == 2 ? base + SS_VEC + (size_t)(hd & 1) * 512 : MIX == 1 ? base + GD_VEC : base + HR_VEC);
#pragma unroll
        for (int mi = 0; mi < 4; ++mi) { oi[mi] = *(const u32x2*)(o + ((size_t)(ws * 4 + mi) * 64 + lane) * 8); if (MIX == 2) eg[mi] = *(const f32x4*)(gv + 16 * mi + 4 * fq); }
        if (MIX != 1) {
#pragma unroll
            for (int m = 0; m < NT; ++m) ds[m] = *(const u32x2*)(d + ((size_t)(ws * NT + m) * 64 + lane) * 8); }
#pragma unroll
        for (int m = 0; m < (MIX == 0 ? 4 : 1); ++m) al[m] = MIX == 0 ? *(const f32x4*)(gv + 64 + 16 * m + 4 * fq) : (f32x4){gv[MIX == 1 ? 128 : 64], 0.f, 0.f, 0.f};
    }
};
__device__ __forceinline__ f32x4 unpack_acc(const u32x2& w) { return (f32x4){__uint_as_float(w.x << 16), __uint_as_float(w.x & 0xffff0000u), __uint_as_float(w.y << 16), __uint_as_float(w.y & 0xffff0000u)}; }
template <int MIX>
__device__ void seq_item(const Params& p, int layer, int b_in, int hd_in, LAS unsigned char* lds) {
    constexpr int DK = MIX == 2 ? 128 : 64, NT = DK / 16, NS = DK / 32;
    constexpr int NFS = MIX == 2 ? 16 : MIX == 1 ? 32 : 8, FPW = NFS / 2;
    constexpr int YC = MIX == 0 ? 0 : MIX == 1 ? 256 : MIX == 2 ? 512 : 768;
    const int b = __builtin_amdgcn_readfirstlane(b_in), hd = __builtin_amdgcn_readfirstlane(hd_in);
    const int tid = opaque_tid(), wid = __builtin_amdgcn_readfirstlane(tid >> 6), lane = tid & 63, fq = lane >> 4, fc = lane & 15;
    const int ws = wid & 3; const bool cw = wid < 4, lw = wid == 4 || wid == 5, sw = wid >= 6;
    const int fs0 = (wid & 1) * FPW;
    LAS unsigned char* FS = lds;
    LAS float* Os = (LAS float*)(lds + 65536);
    bf16_t* yb = (bf16_t*)(p.ws + WS_Y) + (size_t)(b * TP) * DM + YC + hd * 64;
    auto store_rows = [&](int c) {
        const int i0 = c == 0 ? 48 : 0, t0 = 64 * c - 48, ri = (wid - 6) * 32 + (lane >> 1), hf = lane & 1; const LAS float* src = Os + (c & 1) * 64 * OSP + ri * OSP + hf * 32;
        float o[32];
#pragma unroll
        for (int k4 = 0; k4 < 8; ++k4) { const f32x4 v = *(const LAS f32x4*)(src + 4 * k4); o[4 * k4] = v[0]; o[4 * k4 + 1] = v[1]; o[4 * k4 + 2] = v[2]; o[4 * k4 + 3] = v[3]; }
        if (ri >= i0) { u32x4* dst = (u32x4*)(yb + (size_t)(t0 + ri) * DM + hf * 32);
#pragma unroll
            for (int k8 = 0; k8 < 4; ++k8) dst[k8] = pack_bf8(o + 8 * k8); } };
    auto fbase = [&](int c) -> const unsigned char* { return MIX == 2 ? rec_ssd(p, b, c, hd >> 1) + SS_QF : MIX == 1 ? rec_gdn(p, b, c, hd) + GD_W : (MIX == 0 ? rec_hgrn(p, b, c, hd) : rec_ret(p, b, c, hd)) + HR_QF; };
    f32x4 S[NT];
#pragma unroll
    for (int m = 0; m < NT; ++m) S[m] = (f32x4){0.f, 0.f, 0.f, 0.f};
    const f32x4 zero4 = (f32x4){0.f, 0.f, 0.f, 0.f};
    SeqRegs<MIX> R0, R1; bf16x8 fr[FPW];
    if (cw) { R0.load(p, b, 0, hd, ws, lane, fq); R1.load(p, b, 1, hd, ws, lane, fq); }
    else if (lw) { const unsigned char* f0 = fbase(0); const unsigned char* f1 = fbase(1);
#pragma unroll
        for (int x = 0; x < FPW; ++x) fr[x] = *(const bf16x8*)(f0 + ((size_t)(fs0 + x) * 64 + lane) * 16);
#pragma unroll
        for (int x = 0; x < FPW; ++x) *(LAS bf16x8*)(FS + ((size_t)(fs0 + x) * 64 + lane) * 16) = fr[x];
#pragma unroll
        for (int x = 0; x < FPW; ++x) fr[x] = *(const bf16x8*)(f1 + ((size_t)(fs0 + x) * 64 + lane) * 16); }
    lds_barrier();
    if (cw) {
        auto step = [&](const int c, SeqRegs<MIX>& R) __attribute__((always_inline)) {
            LAS float* Ob = Os + (c & 1) * 64 * OSP + 16 * ws + fc;
            const LAS unsigned char* Fc = FS + (size_t)((c & 1) * NFS) * 1024 + lane * 16;

            bf16x8 Sb[NS];
#pragma unroll
            for (int s = 0; s < NS; ++s) Sb[s] = pack_acc2(S[2 * s], S[2 * s + 1]);
            if (MIX == 1) {
                bf16x8 ub[2]; f32x4 u[4];
#pragma unroll
                for (int m = 0; m < 4; ++m) { u[m] = unpack_acc(R.oi[m]);
#pragma unroll
                    for (int s = 0; s < 2; ++s) u[m] = mfma16(*(const LAS bf16x8*)(Fc + (m * 2 + s) * 1024), Sb[s], u[m]); }
#pragma unroll
                for (int s = 0; s < 2; ++s) ub[s] = pack_acc2(u[2 * s], u[2 * s + 1]);
#pragma unroll
                for (int mi = 0; mi < 4; ++mi) { f32x4 o = zero4;
#pragma unroll
                    for (int s = 0; s < 2; ++s) { o = mfma16(*(const LAS bf16x8*)(Fc + (16 + mi * 2 + s) * 1024), ub[s], o); o = mfma16(*(const LAS bf16x8*)(Fc + (8 + mi * 2 + s) * 1024), Sb[s], o); }
#pragma unroll
                    for (int r = 0; r < 4; ++r) Ob[(16 * mi + 4 * fq + r) * OSP] = o[r]; }
                const float al = R.al[0][0];
#pragma unroll
                for (int m = 0; m < 4; ++m) { S[m] = S[m] * al;
#pragma unroll
                    for (int s = 0; s < 2; ++s) S[m] = mfma16(*(const LAS bf16x8*)(Fc + (24 + m * 2 + s) * 1024), ub[s], S[m]); }
            } else {
#pragma unroll
                for (int mi = 0; mi < 4; ++mi) { f32x4 o2 = zero4;
#pragma unroll
                    for (int s = 0; s < NS; ++s) o2 = mfma16(*(const LAS bf16x8*)(Fc + (mi * NS + s) * 1024), Sb[s], o2);
                    const f32x4 o1 = unpack_acc(R.oi[mi]);
#pragma unroll
                    for (int r = 0; r < 4; ++r) Ob[(16 * mi + 4 * fq + r) * OSP] = o1[r] + (MIX == 2 ? R.eg[MIX == 2 ? mi : 0][r] : 1.0f) * o2[r]; }
#pragma unroll
                for (int m = 0; m < NT; ++m) { const f32x4 d = unpack_acc(R.ds[MIX == 1 ? 0 : m]);
#pragma unroll
                    for (int r = 0; r < 4; ++r) S[m][r] = (MIX == 0 ? R.al[MIX == 0 ? (m & 3) : 0][r] : R.al[0][0]) * S[m][r] + d[r]; }
            }
            R.load(p, b, min(c + 2, NCHUNK - 1), hd, ws, lane, fq);
            lds_barrier();
        };
        for (int c = 0; c < NCHUNK; c += 2) { step(c, R0); if (c + 1 < NCHUNK) step(c + 1, R1); }
    } else if (lw) {
        for (int c = 0; c < NCHUNK; ++c) {
            const unsigned char* f2 = fbase(min(c + 2, NCHUNK - 1));
#pragma unroll
            for (int x = 0; x < FPW; ++x) *(LAS bf16x8*)(FS + ((size_t)(((c + 1) & 1) * NFS + fs0 + x) * 64 + lane) * 16) = fr[x];
#pragma unroll
            for (int x = 0; x < FPW; ++x) fr[x] = *(const bf16x8*)(f2 + ((size_t)(fs0 + x) * 64 + lane) * 16);
            lds_barrier(); }
    } else {
        for (int c = 0; c < NCHUNK; ++c) { if (c > 0) store_rows(c - 1); lds_barrier(); }
        store_rows(NCHUNK - 1);
    }
    if (cw) { float* so = p.out + (MIX == 0 ? O_HGRN_P : MIX == 1 ? O_GDN_P : MIX == 2 ? O_SSD_P : O_RET_P) + (((size_t)layer * NB + b) * 4 + hd) * (DK * 64);
#pragma unroll
        for (int m = 0; m < NT; ++m)
#pragma unroll
            for (int r = 0; r < 4; ++r) so[(16 * m + 4 * fq + r) * 64 + 16 * ws + fc] = S[m][r]; }
    if (MIX == 1 || (MIX == 2 && (hd & 1) == 0)) { const bf16_t* projb = (const bf16_t*)(p.ws + WS_PROJ) + (size_t)(b * TP) * NBIG;
        float* co = p.out + (MIX == 1 ? O_GCONV_P : O_SCONV_P) + ((size_t)layer * NB + b) * 3 * 768; constexpr int NC = MIX == 1 ? 192 : 384;
        for (int e = tid; e < 3 * NC; e += 512) { const int r = e / NC, ch = e % NC, chf = MIX == 1 ? (ch >> 6) * 256 + hd * 64 + (ch & 63) : (ch >> 7) * 256 + (hd >> 1) * 128 + (ch & 127);
            co[r * 768 + chf] = bf2f(projb[(size_t)(TP - 3 + r) * NBIG + (MIX == 1 ? PC_BQKV : PC_CXBC) + chf]); } }
}

__device__ void ph_post(const Params& p_in, int layer, int blk, int nblk) {
    Params p = p_in; asm volatile("" : "+s"(p.ws), "+s"(p.out));
    const int tid = opaque_tid(), wid = tid >> 6, lane = tid & 63;
    const bf16_t* proj = (const bf16_t*)(p.ws + WS_PROJ); bf16_t* y = (bf16_t*)(p.ws + WS_Y);
    for (int t = blk * 8 + wid; t < MP * 2; t += nblk * 8) { const int row = t >> 1, half = t & 1, ch = half * 512 + lane * 8;
        const int kind = half * 2 + (lane >> 5), cl = (lane & 31) * 8;
        const u32x4 ow = *(const u32x4*)(y + (size_t)row * DM + ch);
        const u32x4 zw = *(const u32x4*)(proj + (size_t)row * NBIG + (kind == 0 ? PC_AZ : kind == 1 ? PC_BZ : kind == 2 ? PC_CZ : PC_DZ) + cl);
        const float* nwp = (kind == 0 ? p.hgrn_norm_w : kind == 1 ? p.gdn_norm_w : kind == 2 ? p.ssd_norm_w : p.ret_norm_w) + layer * 256 + cl;
        const f32x4 w0 = *(const f32x4*)nwp, w1 = *(const f32x4*)(nwp + 4);
        float o[8], z[8]; unpack_bf8(ow, o); unpack_bf8(zw, z);
        const float nw[8] = {w0[0], w0[1], w0[2], w0[3], w1[0], w1[1], w1[2], w1[3]};
        if (kind == 2) {
            float q = 0.f;
#pragma unroll
            for (int k = 0; k < 8; ++k) { o[k] *= silu_f(z[k]); q += o[k] * o[k]; }
            q = sum16(q);
            const float rstd = rsqrtf(q * (1.0f / 128.0f) + EPSF);
#pragma unroll
            for (int k = 0; k < 8; ++k) o[k] *= rstd * nw[k];
        } else if (kind == 3) {
            const float* nbp = p.ret_norm_b + layer * 256 + cl; const f32x4 b0 = *(const f32x4*)nbp, b1 = *(const f32x4*)(nbp + 4); const float nb[8] = {b0[0], b0[1], b0[2], b0[3], b1[0], b1[1], b1[2], b1[3]};
            float s = 0.f;
#pragma unroll
            for (int k = 0; k < 8; ++k) s += o[k];
            s = sum8(s); const float mu = s * (1.0f / 64.0f); float q = 0.f;
#pragma unroll
            for (int k = 0; k < 8; ++k) { o[k] -= mu; q += o[k] * o[k]; }
            q = sum8(q); const float rstd = rsqrtf(q * (1.0f / 64.0f) + EPSF);
#pragma unroll
            for (int k = 0; k < 8; ++k) o[k] = (o[k] * rstd * nw[k] + nb[k]) * silu_f(z[k]);
        } else {
            float q = 0.f;
#pragma unroll
            for (int k = 0; k < 8; ++k) q += o[k] * o[k];
            q = sum8(q); const float rstd = rsqrtf(q * (1.0f / 64.0f) + EPSF);
#pragma unroll
            for (int k = 0; k < 8; ++k) o[k] = o[k] * rstd * nw[k] * silu_f(z[k]);
        }
        *(u32x4*)(y + (size_t)row * DM + ch) = pack_bf8(o);
    }
}

constexpr int N_MU = 14;
__device__ void ph_pre(const Params& p_in, int layer, LAS unsigned char* lds_in, int blk, int nblk) {
    Params p = p_in; asm volatile("" : "+s"(p.ws), "+s"(p.out));
    LAS unsigned char* lds = lds_in; asm volatile("" : "+s"(lds));
    const int tid = opaque_tid();
    convert_weights(p, layer + 1 < DEPTH ? layer + 1 : -1, layer, (LAS float*)lds, tid, blk, nblk);
    { GdRaw R; int v = blk; if (v < NB * NCHUNK * 4) R.load(p, v, tid);
        for (; v < NB * NCHUNK * 4; v += nblk) gdn_pre_unit(p, layer, v, v + nblk < NB * NCHUNK * 4 ? v + nblk : -1, R, lds); }
    { SsRaw R; int t = (blk + 224) % nblk; if (t < NB * NCHUNK * 2) R.load(p, t, tid);
        for (; t < NB * NCHUNK * 2; t += nblk) ssd_pre_unit(p, layer, t, t + nblk < NB * NCHUNK * 2 ? t + nblk : -1, R, lds); }
    { HgRaw R; int v = (blk + 192) % nblk; if (v < NB * NCHUNK * 4) R.load(p, v, tid);
        for (; v < NB * NCHUNK * 4; v += nblk) hgrn_pre_unit(p, layer, v, v + nblk < NB * NCHUNK * 4 ? v + nblk : -1, R, lds); }
    { RetRaw R; int v = (blk + 160) % nblk; if (v < NB * NCHUNK * 4) R.load(p, v, tid);
        for (; v < NB * NCHUNK * 4; v += nblk) ret_pre_unit(p, layer, v, v + nblk < NB * NCHUNK * 4 ? v + nblk : -1, R, lds); }
}
__device__ void ph_seq(const Params& p_in, int layer, LAS unsigned char* lds_in, int blk, int nblk) {
    Params p = p_in; asm volatile("" : "+s"(p.ws), "+s"(p.out));
    LAS unsigned char* lds = lds_in; asm volatile("" : "+s"(lds));
    LAS float* L = (LAS float*)lds;
    if (blk < 128) { const int b = blk >> 4, k = blk & 15;
#ifndef REP_SQ
#define REP_SQ 1
#endif
        for (int rep = 0; rep < REP_SQ; ++rep)
        if (k < 4) seq_item<2>(p, layer, b, k, lds); else if (k < 8) seq_item<1>(p, layer, b, k - 4, lds); else if (k < 12) seq_item<0>(p, layer, b, k - 8, lds); else seq_item<3>(p, layer, b, k - 12, lds); }
    else for (int d = blk - 128; d < DECB * N_MU; d += nblk - 128) { const int s = NB + d / N_MU, mu = d % N_MU;
#ifndef REP_DEC2
#define REP_DEC2 1
#endif
        for (int rep = 0; rep < REP_DEC2; ++rep)
        if (mu < 4) mixer_item<0>(p, layer, s, mu, L); else if (mu < 8) mixer_item<1>(p, layer, s, mu - 4, L); else if (mu < 10) mixer_item<2>(p, layer, s, mu - 8, L); else mixer_item<3>(p, layer, s, mu - 10, L); }
}

__device__ void ph_final(const Params& p_in, int blk, int nblk) {
    Params p = p_in; asm volatile("" : "+s"(p.ws), "+s"(p.out));

    const int tid = opaque_tid(), wid = tid >> 6, lane = tid & 63;
    const float* h = (const float*)(p.ws + WS_H);
    for (int row = blk * 8 + wid; row < MROWS; row += nblk * 8) {
        float* dst;
        if (row < MP) { const int b = row / TP, t = row % TP; if (t < NMETA) continue; dst = p.out + O_YP + ((size_t)b * SEQ + (t - NMETA)) * DM; } else dst = p.out + O_YS + (size_t)(row - MP) * DM;
        f32x4 v[4]; float ss = 0.f;
#pragma unroll
        for (int j = 0; j < 4; ++j) { v[j] = *(const f32x4*)(h + (size_t)row * DM + j * 256 + lane * 4); ss += v[j][0] * v[j][0] + v[j][1] * v[j][1] + v[j][2] * v[j][2] + v[j][3] * v[j][3]; }
        const float r = rsqrtf(wave_sum(ss, lane) * (1.0f / DM) + EPSF);
#pragma unroll
        for (int j = 0; j < 4; ++j) { const f32x4 w = *(const f32x4*)(p.final_norm_w + j * 256 + lane * 4); *(f32x4*)(dst + j * 256 + lane * 4) = v[j] * r * w; }
    }
}

constexpr int LDS_STAGE = 160 * 1024 - 256;
constexpr int LDS_BYTES = LDS_STAGE + 16;
static_assert(MixLds::END * 4 <= LDS_STAGE && RetLds::END <= LDS_STAGE && SsdLds::END <= LDS_STAGE && 2 * 64 * LDP * 2 <= SsdLds::DT - SsdLds::PS && HgLds::END <= LDS_STAGE && GdLds::END <= LDS_STAGE && pg8::STAGE_BYTES <= LDS_STAGE && 65536 + 2 * 64 * OSP * 4 <= LDS_STAGE, "LDS carve");

__global__ void __launch_bounds__(512, 2) k_mega(Params p) {
    extern __shared__ __attribute__((aligned(16))) unsigned char smem[];
    LAS unsigned char* lds = (LAS unsigned char*)smem;
    const int blk = blockIdx.x, nblk = gridDim.x;
    volatile LAS unsigned* xbw = (volatile LAS unsigned*)(lds + LDS_STAGE);
    if (threadIdx.x < 4) xbw[threadIdx.x] = 0u;
    __syncthreads();
    XcdBarrier xb = xcd_barrier_post((unsigned*)(p.ws + WS_BAR), xbw);
#ifndef REP_PREP
#define REP_PREP 1
#endif
#ifndef REP_ROWNORM
#define REP_ROWNORM 1
#endif
#ifndef REP_GEMMIN
#define REP_GEMMIN 1
#endif
#ifndef REP_GDNPRE
#define REP_GDNPRE 1
#endif
#ifndef REP_MIXER
#define REP_MIXER 1
#endif
    for (int r = 0; r < REP_PREP; ++r) { ph_prep(p, lds, blk, nblk); if (r + 1 < REP_PREP) xcd_barrier(xb); }
    cooperative_groups::this_grid().sync();
    xcd_barrier(xb);
#pragma unroll 1
    for (int l = 0; l < DEPTH; ++l) {
        for (int r = 0; r < REP_ROWNORM; ++r) { ph_rownorm(p, l, blk, nblk); xcd_barrier(xb); }
        for (int r = 0; r < REP_GEMMIN; ++r) { ph_gemm_in(p, l, lds, blk, nblk); xcd_barrier(xb); }
#ifndef REP_A
#define REP_A 1
#define REP_B 1
#endif
        for (int r = 0; r < REP_A; ++r) { ph_pre(p, l, lds, blk, nblk); xcd_barrier(xb); }
        for (int r = 0; r < REP_B; ++r) { ph_seq(p, l, lds, blk, nblk); xcd_barrier(xb); }
        ph_post(p, l, blk, nblk); xcd_barrier(xb);
        ph_gemm_out(p, l, lds, blk, nblk);
        xcd_barrier(xb);
    }
    ph_final(p, blk, nblk);
}

extern "C" void kernel_launch(void* const* d_in, const int* in_sizes, int n_in, void* d_out, int out_size, void* d_ws, size_t ws_size, hipStream_t stream) {
    static int grid = 0;
    if (grid == 0) {
        if (n_in != 27 || (size_t)out_size != O_END || ws_size < WS_END) { fprintf(stderr, "kernel_launch: unexpected shapes: n_in %d out %d (want %zu) ws %zu (want %zu)\n", n_in, out_size, (size_t)O_END, ws_size, (size_t)WS_END); grid = -1; return; }
        if (hipFuncSetAttribute((const void*)k_mega, hipFuncAttributeMaxDynamicSharedMemorySize, LDS_BYTES) != hipSuccess) { fprintf(stderr, "kernel_launch: hipFuncSetAttribute failed\n"); grid = -1; return; }
        int dev = 0, cus = 0, per_cu = 0;
        if (hipGetDevice(&dev) != hipSuccess || hipDeviceGetAttribute(&cus, hipDeviceAttributeMultiprocessorCount, dev) != hipSuccess) { fprintf(stderr, "kernel_launch: device query failed\n"); grid = -1; return; }
        if (hipOccupancyMaxActiveBlocksPerMultiprocessor(&per_cu, (const void*)k_mega, 512, LDS_BYTES) != hipSuccess || per_cu < 1) { fprintf(stderr, "kernel_launch: occupancy query says %d blocks per CU\n", per_cu); grid = -1; return; }
        grid = cus;
    }
    if (grid < 0) return;
    Params p{};
    const float** pp = (const float**)&p;
    for (int i = 0; i < 27; ++i) pp[i] = (const float*)d_in[i];
    p.out = (float*)d_out; p.ws = (unsigned char*)d_ws;
    (void)hipMemsetAsync((unsigned char*)d_ws + WS_BAR, 0, 16384, stream);
    void* args[] = {&p};
    const hipError_t e = hipLaunchCooperativeKernel((const void*)k_mega, dim3(grid), dim3(512), args, LDS_BYTES, stream);
    if (e != hipSuccess) fprintf(stderr, "kernel_launch: cooperative launch failed: %s (grid %d)\n", hipGetErrorString(e), grid);
}
```

```cpp
#include <hip/hip_runtime.h>
#include <hip/hip_cooperative_groups.h>
#include <cstdio>
#include <cstdint>

#define LAS __attribute__((address_space(3)))
typedef unsigned short bf16_t;
typedef short bf16x8 __attribute__((ext_vector_type(8)));
typedef float f32x4 __attribute__((ext_vector_type(4)));
typedef unsigned u32x4 __attribute__((ext_vector_type(4)));
typedef unsigned u32x2 __attribute__((ext_vector_type(2)));

constexpr int DM = 1024, NB = 8, SEQ = 2048, DEPTH = 4, DECB = 128, NMETA = 16, TP = SEQ + NMETA;
constexpr int MP = NB * TP;
constexpr int MROWS = MP + DECB;
constexpr int IN_DIM = 4108, NBIG = 4096, NSM = 12;
constexpr int PASTLEN = 16384;
constexpr float EPSF = 1e-6f;
constexpr int PC_AQ = 0, PC_AF = 256, PC_AI = 512, PC_AZ = 768, PC_BQKV = 1024, PC_BZ = 1792, PC_CXBC = 2048, PC_CZ = 2816, PC_DQ = 3072, PC_DK = 3328, PC_DV = 3584, PC_DZ = 3840;

constexpr size_t WS_BAR = 0;
constexpr size_t WS_WINT = 16384;
constexpr size_t WS_WOUTT = WS_WINT + (size_t)NBIG * DM * 2;
constexpr size_t WS_WSM = WS_WOUTT + (size_t)DM * DM * 2;
constexpr size_t WS_LB = WS_WSM + (size_t)DEPTH * NSM * DM * 4;
constexpr size_t WS_ROT = WS_LB + (size_t)DEPTH * 256 * 4;
constexpr size_t ROT_BYTES = ((size_t)(TP + 1) * 64 * 4 + 255) / 256 * 256;
constexpr size_t WS_H = WS_ROT + ROT_BYTES;
constexpr size_t WS_HB = WS_H + (size_t)MROWS * DM * 4;
constexpr size_t WS_RS = WS_HB + (size_t)MROWS * DM * 2;
constexpr size_t WS_PSM = WS_RS + (size_t)MROWS * 4;
constexpr size_t WS_PROJ = WS_PSM + (size_t)MROWS * NSM * 4;
constexpr size_t WS_Y = WS_PROJ + (size_t)MROWS * NBIG * 2;
constexpr size_t WS_E = WS_Y + (size_t)MROWS * DM * 2;
constexpr size_t WS_END = WS_E + (size_t)NB * 33 * 4 * 41728;

constexpr size_t O_YP = 0;
constexpr size_t O_YS = O_YP + (size_t)NB * SEQ * DM;
constexpr size_t O_HGRN_P = O_YS + (size_t)DECB * DM;
constexpr size_t O_GDN_P = O_HGRN_P + (size_t)DEPTH * NB * 4 * 64 * 64;
constexpr size_t O_GCONV_P = O_GDN_P + (size_t)DEPTH * NB * 4 * 64 * 64;
constexpr size_t O_SSD_P = O_GCONV_P + (size_t)DEPTH * NB * 3 * 768;
constexpr size_t O_SCONV_P = O_SSD_P + (size_t)DEPTH * NB * 4 * 128 * 64;
constexpr size_t O_RET_P = O_SCONV_P + (size_t)DEPTH * NB * 3 * 768;
constexpr size_t O_HGRN_S = O_RET_P + (size_t)DEPTH * NB * 4 * 64 * 64;
constexpr size_t O_GDN_S = O_HGRN_S + (size_t)DEPTH * DECB * 4 * 64 * 64;
constexpr size_t O_GCONV_S = O_GDN_S + (size_t)DEPTH * DECB * 4 * 64 * 64;
constexpr size_t O_SSD_S = O_GCONV_S + (size_t)DEPTH * DECB * 3 * 768;
constexpr size_t O_SCONV_S = O_SSD_S + (size_t)DEPTH * DECB * 4 * 128 * 64;
constexpr size_t O_RET_S = O_SCONV_S + (size_t)DEPTH * DECB * 3 * 768;
constexpr size_t O_END = O_RET_S + (size_t)DEPTH * DECB * 4 * 64 * 64;

struct Params {
    const float* x_prompt; const float* x_sample;
    const float* st_hgrn; const float* st_gdn; const float* st_gconv; const float* st_ssd; const float* st_sconv; const float* st_ret;
    const float* meta; const float* norm_w; const float* w_in; const float* lb_logits; const float* hgrn_norm_w;
    const float* gdn_conv_w; const float* gdn_a_log; const float* gdn_dt_bias; const float* gdn_norm_w;
    const float* ssd_conv_w; const float* ssd_conv_b; const float* ssd_a_log; const float* ssd_dt_bias; const float* ssd_d; const float* ssd_norm_w;
    const float* ret_norm_w; const float* ret_norm_b; const float* w_out; const float* final_norm_w;
    float* out; unsigned char* ws;
};

__device__ __forceinline__ float bf2f(bf16_t b) { return __uint_as_float(((unsigned)b) << 16); }
__device__ __forceinline__ bf16_t f2bf(float f) { unsigned u = __float_as_uint(f); u += 0x7FFFu + ((u >> 16) & 1u); return (bf16_t)(u >> 16); }
__device__ __forceinline__ unsigned pack_bf2(float lo, float hi) { return (unsigned)f2bf(lo) | ((unsigned)f2bf(hi) << 16); }
__device__ __forceinline__ float sigmoid_f(float x) { return __builtin_amdgcn_rcpf(1.0f + __expf(-x)); }
__device__ __forceinline__ float silu_f(float x) { return x * __builtin_amdgcn_rcpf(1.0f + __expf(-x)); }
__device__ __forceinline__ float softplus_f(float x) { return x > 20.0f ? x : log1pf(__expf(x)); }
__device__ __forceinline__ void lds_barrier() { asm volatile("s_waitcnt lgkmcnt(0)" ::: "memory"); __builtin_amdgcn_s_barrier(); asm volatile("" ::: "memory"); }
__device__ __forceinline__ int opaque_tid() { int t = threadIdx.x; asm volatile("" : "+v"(t)); return t; }
__device__ __forceinline__ float lane_xor(float v, int k, int lane) { return __int_as_float(__builtin_amdgcn_ds_bpermute((lane ^ k) << 2, __float_as_int(v))); }
__device__ __forceinline__ float lane_up(float v, int k, int lane) { return __int_as_float(__builtin_amdgcn_ds_bpermute(((lane - k) & 63) << 2, __float_as_int(v))); }
template <int CTRL> __device__ __forceinline__ float dpp_mov(float v) { return __int_as_float(__builtin_amdgcn_update_dpp(0, __float_as_int(v), CTRL, 0xf, 0xf, true)); }
__device__ __forceinline__ float sum4(float v) { v += dpp_mov<0xB1>(v); v += dpp_mov<0x4E>(v); return v; }
__device__ __forceinline__ float sum8(float v) { v = sum4(v); v += dpp_mov<0x141>(v); return v; }
__device__ __forceinline__ float sum16(float v) { v = sum8(v); v += dpp_mov<0x140>(v); return v; }
__device__ __forceinline__ float wave_sum(float v, int lane) { v = sum16(v); v += lane_xor(v, 16, lane); v += lane_xor(v, 32, lane); return v; }


#define XB_TMO      128
#define XB_XCNT(j)  (256  + 64 * (j))
#define XB_XSUB(j)  (1280 + 64 * (j))
#define XB_XGEN(j)  (2304 + 64 * (j))
#define XB_TOP      3328
#define XB_TOPGEN   3392
#define XCD_BAR_WORDS 3456
#define XB_SPIN_CAP (1u << 22)
__device__ __forceinline__ unsigned xb_ld(unsigned* p)              { return __hip_atomic_load(p, __ATOMIC_RELAXED, __HIP_MEMORY_SCOPE_AGENT); }
__device__ __forceinline__ unsigned xb_add(unsigned* p, unsigned v) { return __hip_atomic_fetch_add(p, v, __ATOMIC_RELAXED, __HIP_MEMORY_SCOPE_AGENT); }
__device__ __forceinline__ unsigned xb_xcc_id() { return (unsigned)__builtin_amdgcn_s_getreg((3 << 11) | 20) & 0xFu; }
#define XB_SPIN(cond, bar) do { unsigned _sp = 0; while (cond) { __builtin_amdgcn_s_sleep(1); \
    if ((++_sp & 255u) == 0u) { if (xb_ld(&(bar)[XB_TMO])) break; if (_sp > XB_SPIN_CAP) { atomicAdd(&(bar)[XB_TMO], 1u); break; } } } } while (0)
struct XcdBarrier { unsigned* bar; unsigned x; volatile LAS unsigned* st; };
__device__ __forceinline__ XcdBarrier xcd_barrier_post(unsigned* bar, volatile LAS unsigned* st) {
    XcdBarrier b; b.bar = bar; b.x = xb_xcc_id(); b.st = st;
    if (threadIdx.x == 0) (void)xb_add(&bar[XB_XCNT(b.x)], 1u);
    return b;
}
__device__ __forceinline__ void xcd_barrier_complete(unsigned* bar, unsigned x, unsigned& nloc, unsigned& nx) {
    const unsigned G = gridDim.x * gridDim.y * gridDim.z;
    unsigned sum, cnt, mine, sp = 0u;
    for (;;) {
        sum = 0u; cnt = 0u; mine = 0u;
#pragma unroll
        for (unsigned j = 0; j < 16; ++j) { const unsigned c = xb_ld(&bar[XB_XCNT(j)]); sum += c; cnt += (c > 0u) ? 1u : 0u; mine = (j == x) ? c : mine; }
        if (sum == G) break;
        __builtin_amdgcn_s_sleep(1);
        if ((++sp & 255u) == 0u) { if (xb_ld(&bar[XB_TMO])) break; if (sp > XB_SPIN_CAP) { atomicAdd(&bar[XB_TMO], 1u); break; } }
    }
    nloc = mine > 0u ? mine : 1u; nx = cnt > 0u ? cnt : 1u;
}
__device__ __forceinline__ void xcd_barrier(const XcdBarrier& b0) {
    asm volatile("s_waitcnt vmcnt(0)" ::: "memory");
    __syncthreads();
    if (threadIdx.x == 0) {
        XcdBarrier b = b0; { unsigned x = xb_xcc_id(); asm volatile("" : "+s"(x)); b.x = x; }
        unsigned* bar = b.bar;
        __builtin_amdgcn_s_waitcnt(0);
        unsigned nloc = b.st[0], nx = b.st[1];
        if (nloc == 0u) { xcd_barrier_complete(bar, b.x, nloc, nx); b.st[0] = nloc; b.st[1] = nx; }
        const unsigned old = xb_add(&bar[XB_XSUB(b.x)], 1u);
        const unsigned gen = old / nloc;
        if (old + 1u == (gen + 1u) * nloc) {
            __builtin_amdgcn_fence(__ATOMIC_RELEASE, "agent");
            asm volatile("s_waitcnt vmcnt(0)" ::: "memory");
            const unsigned og = xb_add(&bar[XB_TOP], 1u);
            const unsigned tg = og / nx;
            if (og + 1u == (tg + 1u) * nx) xb_add(&bar[XB_TOPGEN], 1u);
            else XB_SPIN(xb_ld(&bar[XB_TOPGEN]) == tg, bar);
            __builtin_amdgcn_fence(__ATOMIC_ACQUIRE, "agent");
            xb_add(&bar[XB_XGEN(b.x)], 1u);
            asm volatile("s_waitcnt vmcnt(0)" ::: "memory");
        } else {
            XB_SPIN(xb_ld(&bar[XB_XGEN(b.x)]) == gen, bar);
            __builtin_amdgcn_fence(__ATOMIC_ACQUIRE, "agent");
            asm volatile("s_waitcnt vmcnt(0)" ::: "memory");
        }
    }
    __syncthreads();
}

constexpr int FLAG_WORD0 = 3600;
__device__ __forceinline__ void flag_publish(unsigned* flag) {
    asm volatile("s_waitcnt vmcnt(0)" ::: "memory"); __syncthreads();
    if (threadIdx.x == 0) { __builtin_amdgcn_fence(__ATOMIC_RELEASE, "agent"); asm volatile("s_waitcnt vmcnt(0)" ::: "memory"); (void)xb_add(flag, 1u); }
}
__device__ __forceinline__ void flag_wait(unsigned* flag, unsigned target, unsigned* bar) {
    if (threadIdx.x == 0) { XB_SPIN(xb_ld(flag) < target, bar); __builtin_amdgcn_fence(__ATOMIC_ACQUIRE, "agent"); asm volatile("s_waitcnt vmcnt(0)" ::: "memory"); }
    __syncthreads();
}

namespace pg8 {
constexpr int BM = 256, BK = 64, HALF = 128, HTB = HALF * BK * 2, STAGE_BYTES = 8 * HTB, NXCD = 8, WGM = 8;
__host__ __device__ __forceinline__ int lds_byte(int r, int c) { const int st = (r >> 4) * 2 + (c >> 5), rr = r & 15, cc = c & 31, ob = rr * 64 + cc * 2; return st * 1024 + (ob ^ (((ob >> 9) & 1) << 5)); }
__host__ __device__ __forceinline__ void stage_rc(int b, int& R, int& C) { const int st = b / 1024, sb = b % 1024, swz = sb ^ (((sb >> 9) & 1) << 5); R = (st >> 1) * 16 + swz / 64; C = (st & 1) * 32 + (swz % 64) / 2; }
__host__ __device__ __forceinline__ int perm32(int rho) { const int n = rho >> 4, i = rho & 15; return 8 * (i >> 2) + 4 * n + (i & 3); }
struct Unit { int pm, pn; };
struct Gemm { const bf16_t* A; const bf16_t* Bt; int M, N, K; };
struct StaticOrder {
    int nM, nN, nwg, G, c;
    __host__ __device__ void init(int M, int N, int G_, int c_) { nM = M / BM; nN = N / BM; nwg = nM * nN; G = G_; c = c_; }
    __host__ __device__ bool next(int i, Unit& u) const {
        const long L = (long)i * G + c; if (L >= nwg) return false;
        int wgid = (int)L; { const int q = nwg / NXCD, r = nwg % NXCD, xcd = wgid % NXCD, off = wgid / NXCD; wgid = (xcd < r ? xcd * (q + 1) : r * (q + 1) + (xcd - r) * q) + off; }
        const int nig = WGM * nN, gid = wgid / nig, fm = gid * WGM, gsz = (nM - fm) < WGM ? (nM - fm) : WGM;
        u.pm = fm + ((wgid % nig) % gsz); u.pn = (wgid % nig) / gsz; return true;
    }
    __device__ __forceinline__ void a_ready(const Unit&) const {}
    __device__ __forceinline__ void done(const Unit&) const {}
};
typedef float f32x2_t __attribute__((ext_vector_type(2)));
typedef __bf16 bf16x2n_t __attribute__((ext_vector_type(2)));
struct OneUnit { int pm, pn;
    __device__ __forceinline__ bool next(int i, Unit& u) const { if (i) return false; u.pm = pm; u.pn = pn; return true; }
    __device__ __forceinline__ void a_ready(const Unit&) const {}
    __device__ __forceinline__ void done(const Unit&) const {}
};
__device__ __forceinline__ unsigned cvt_pk_bf16(float lo, float hi) { const f32x2_t f = {lo, hi}; return __builtin_bit_cast(unsigned, __builtin_convertvector(f, bf16x2n_t)); }

struct EpiProj {
    static constexpr bool PERM = true, AFTER_DRAIN = false;
    bf16_t* O; int ldc; const float* rs;
    __device__ __forceinline__ void operator()(const f32x4 (&acc)[2][2][4][2], const Unit& u, int wr, int wc, int fr, int fq) const {
        const int row0 = u.pm * BM + wr * 64 + fr; const int col0 = u.pn * BM + wc * 32 + 8 * fq;
#pragma unroll
        for (int ai = 0; ai < 2; ++ai)
#pragma unroll
            for (int m = 0; m < 4; ++m) { const int row = row0 + ai * HALF + m * 16; const float s = rs[row]; bf16_t* rowp = O + (size_t)row * ldc + col0;
#pragma unroll
                for (int bj = 0; bj < 2; ++bj) { const f32x4 v0 = acc[ai][bj][m][0] * s, v1 = acc[ai][bj][m][1] * s;
                    u32x4 w; w.x = cvt_pk_bf16(v0[0], v0[1]); w.y = cvt_pk_bf16(v0[2], v0[3]); w.z = cvt_pk_bf16(v1[0], v1[1]); w.w = cvt_pk_bf16(v1[2], v1[3]);
                    *(u32x4*)(rowp + bj * HALF) = w; } }
    }
};
struct EpiResid {
    static constexpr bool PERM = false, AFTER_DRAIN = false;
    float* C; int ldc;
    __device__ __forceinline__ void operator()(const f32x4 (&acc)[2][2][4][2], const Unit& u, int wr, int wc, int fr, int fq) const {
        const int row0 = u.pm * BM + wr * 64 + fr, col0 = u.pn * BM + wc * 32 + 4 * fq;
#pragma unroll
        for (int ai = 0; ai < 2; ++ai)
#pragma unroll
            for (int m = 0; m < 4; ++m) { float* rowp = C + (size_t)(row0 + ai * HALF + m * 16) * ldc + col0;
#pragma unroll
                for (int bj = 0; bj < 2; ++bj)
#pragma unroll
                    for (int n = 0; n < 2; ++n) { f32x4* p = (f32x4*)(rowp + bj * HALF + n * 16); *p = *p + acc[ai][bj][m][n]; } }
    }
};

template <class Epi, class Sched>
__device__ __forceinline__ void gemm_phase(LAS unsigned char* lds, const Gemm g, const Sched& S, const Epi& E) {
    const int tid = opaque_tid(), wid = __builtin_amdgcn_readfirstlane(tid >> 6), lane = tid & 63, wr = wid >> 2, wc = wid & 3, fr = lane & 15, fq = lane >> 4;
    const int K = g.K, nt = K / BK;
    unsigned voffA[2], voffB[2];
#pragma unroll
    for (int i = 0; i < 2; ++i) { int R, C; stage_rc(tid * 16 + i * 8192, R, C); const int Rb = Epi::PERM ? ((R & ~31) + perm32(R & 31)) : R;
        voffA[i] = (unsigned)(R * K + C) * 2u; voffB[i] = (unsigned)(Rb * K + C) * 2u; }
    const size_t kstep = (size_t)(BK * 2);
    const size_t hstep = (size_t)HALF * K * 2;
    const size_t tstep = 2 * hstep;
    const unsigned ldsw = (unsigned)wid * 1024u;
    const int aoff = lds_byte(wr * 64 + fr, fq * 8), boff = lds_byte(wc * 32 + fr, fq * 8);
#define PG8_SA(b, h) (((b) * 2 + (h)) * HTB)
#define PG8_SB(b, h) ((4 + (b) * 2 + (h)) * HTB)
#define PG8_STAGE(bufoff, gbase, voff) do { _Pragma("unroll") for (int _i = 0; _i < 2; ++_i) \
        __builtin_amdgcn_global_load_lds((const unsigned*)((const char*)(gbase) + (voff)[_i]), (LAS unsigned*)(lds + (bufoff) + ldsw + _i * 8192), 16, 0, 0); } while (0)
#define PG8_LDA(dst, b, h) do { _Pragma("unroll") for (int m = 0; m < 4; ++m) _Pragma("unroll") for (int k = 0; k < 2; ++k) dst[m][k] = *(const LAS bf16x8*)(lds + PG8_SA(b, h) + aoff + m * 2048 + k * 1024); } while (0)
#define PG8_LDB(dst, b, h) do { _Pragma("unroll") for (int n = 0; n < 2; ++n) _Pragma("unroll") for (int k = 0; k < 2; ++k) dst[n][k] = *(const LAS bf16x8*)(lds + PG8_SB(b, h) + boff + n * 2048 + k * 1024); } while (0)
#define PG8_MMA(ai, bj, At, Bt) do { __builtin_amdgcn_s_setprio(1); _Pragma("unroll") for (int m = 0; m < 4; ++m) _Pragma("unroll") for (int n = 0; n < 2; ++n) _Pragma("unroll") for (int k = 0; k < 2; ++k) \
        acc[ai][bj][m][n] = __builtin_amdgcn_mfma_f32_16x16x32_bf16(Bt[n][k], At[m][k], acc[ai][bj][m][n], 0, 0, 0); __builtin_amdgcn_s_setprio(0); } while (0)
#define PG8_WAIT_V(n) asm volatile("s_waitcnt vmcnt(" #n ")" ::: "memory")
#define PG8_WAIT_L(n) asm volatile("s_waitcnt lgkmcnt(" #n ")" ::: "memory")
#define PG8_BAR __builtin_amdgcn_s_barrier()
#define PG8_SCHED __builtin_amdgcn_sched_barrier(0)
    Unit cur, nxt; int ui = 0;
    if (!S.next(0, cur)) return;
    f32x4 acc[2][2][4][2];
#pragma unroll
    for (int a = 0; a < 2; ++a)
#pragma unroll
        for (int b = 0; b < 2; ++b)
#pragma unroll
            for (int m = 0; m < 4; ++m)
#pragma unroll
                for (int n = 0; n < 2; ++n) acc[a][b][m][n] = (f32x4){0.f, 0.f, 0.f, 0.f};
    bf16x8 At[4][2], B0[2][2], B1[2][2];
    const char* cA = (const char*)g.A + (size_t)cur.pm * tstep; const char* cB = (const char*)g.Bt + (size_t)cur.pn * tstep;
    S.a_ready(cur);
    PG8_STAGE(PG8_SB(0, 0), cB, voffB); PG8_STAGE(PG8_SA(0, 0), cA, voffA); PG8_STAGE(PG8_SB(0, 1), cB + hstep, voffB); PG8_STAGE(PG8_SA(0, 1), cA + hstep, voffA);
    if (wr == 1) PG8_BAR;
    PG8_WAIT_V(4); PG8_BAR;
    PG8_STAGE(PG8_SB(1, 0), cB + kstep, voffB); PG8_STAGE(PG8_SA(1, 0), cA + kstep, voffA); PG8_STAGE(PG8_SB(1, 1), cB + hstep + kstep, voffB);
    PG8_WAIT_V(6); PG8_BAR;
    for (;;) {
        const bool has_next = S.next(ui + 1, nxt);
        const char* nA = has_next ? (const char*)g.A + (size_t)nxt.pm * tstep : cA; const char* nB = has_next ? (const char*)g.Bt + (size_t)nxt.pn * tstep : cB;
        for (int t = 0; t < nt; t += 2) {
            const bool last = (t == nt - 2);
            const char* a1 = cA + (size_t)(t + 1) * kstep;
            const char* a2 = last ? nA : cA + (size_t)(t + 2) * kstep; const char* b2 = last ? nB : cB + (size_t)(t + 2) * kstep;
            const char* a3 = a2 + kstep; const char* b3 = b2 + kstep;
            if (last && has_next) S.a_ready(nxt);
            PG8_LDB(B0, 0, 0); PG8_SCHED; PG8_LDA(At, 0, 0); PG8_STAGE(PG8_SA(1, 1), a1 + hstep, voffA);
            PG8_WAIT_L(8); PG8_BAR; PG8_WAIT_L(0); PG8_MMA(0, 0, At, B0); PG8_BAR; PG8_SCHED;
            PG8_LDB(B1, 0, 1); PG8_STAGE(PG8_SB(0, 0), b2, voffB);
            PG8_BAR; PG8_WAIT_L(0); PG8_MMA(0, 1, At, B1); PG8_BAR;
            PG8_LDA(At, 0, 1); PG8_STAGE(PG8_SA(0, 0), a2, voffA);
            PG8_BAR; PG8_WAIT_L(0); PG8_MMA(1, 0, At, B0); PG8_BAR; PG8_SCHED;
            PG8_STAGE(PG8_SB(0, 1), b2 + hstep, voffB);
            PG8_WAIT_V(6); PG8_BAR; PG8_MMA(1, 1, At, B1); PG8_BAR;
            PG8_LDB(B0, 1, 0); PG8_SCHED; PG8_LDA(At, 1, 0); PG8_STAGE(PG8_SA(0, 1), a2 + hstep, voffA);
            PG8_WAIT_L(8); PG8_BAR; PG8_WAIT_L(0); PG8_MMA(0, 0, At, B0); PG8_BAR; PG8_SCHED;
            PG8_LDB(B1, 1, 1); PG8_STAGE(PG8_SB(1, 0), b3, voffB);
            PG8_BAR; PG8_WAIT_L(0); PG8_MMA(0, 1, At, B1); PG8_BAR;
            PG8_LDA(At, 1, 1); PG8_STAGE(PG8_SA(1, 0), a3, voffA);
            PG8_BAR; PG8_WAIT_L(0); PG8_MMA(1, 0, At, B0); PG8_BAR; PG8_SCHED;
            PG8_STAGE(PG8_SB(1, 1), b3 + hstep, voffB);
            PG8_WAIT_V(6); PG8_BAR; PG8_MMA(1, 1, At, B1); PG8_BAR;
        }
        if constexpr (!Epi::AFTER_DRAIN) { E(acc, cur, wr, wc, fr, fq); S.done(cur); }
        if (!has_next) break;
#pragma unroll
        for (int a = 0; a < 2; ++a)
#pragma unroll
            for (int b = 0; b < 2; ++b)
#pragma unroll
                for (int m = 0; m < 4; ++m)
#pragma unroll
                    for (int n = 0; n < 2; ++n) acc[a][b][m][n] = (f32x4){0.f, 0.f, 0.f, 0.f};
        cur = nxt; cA = nA; cB = nB; ++ui;
    }
    PG8_WAIT_V(0);
    if (wr == 0) PG8_BAR;
    PG8_BAR;
#undef PG8_SA
#undef PG8_SB
#undef PG8_STAGE
#undef PG8_LDA
#undef PG8_LDB
#undef PG8_MMA
#undef PG8_WAIT_V
#undef PG8_WAIT_L
#undef PG8_BAR
#undef PG8_SCHED
}
}

__device__ __forceinline__ int win_col(int n) { return n < 2048 ? n : (n < 3072 ? n + 8 : n + 12); }
__device__ __forceinline__ int win_smcol(int j) { return j < 8 ? 2048 + j : 3080 + (j - 8); }

__device__ __forceinline__ void convert_weights(const Params& p, int l_in, int l_out, LAS float* tile  , int tid, int blk, int nblk) {
    const int tiles_in = l_in >= 0 ? 64 * 16 : 0, tiles_out = l_out >= 0 ? 16 * 16 : 0;
    for (int t = blk; t < tiles_in + tiles_out; t += nblk) {
        const float* src; bf16_t* dst; int ld, n0, k0; const float* scale;
        if (t < tiles_in) { n0 = (t / 16) * 64; k0 = (t % 16) * 64; src = p.w_in + (size_t)l_in * DM * IN_DIM + win_col(n0); ld = IN_DIM; dst = (bf16_t*)(p.ws + WS_WINT); scale = p.norm_w + l_in * DM; }
        else { const int r = t - tiles_in; n0 = (r / 16) * 64; k0 = (r % 16) * 64; src = p.w_out + (size_t)l_out * DM * DM + n0; ld = DM; dst = (bf16_t*)(p.ws + WS_WOUTT); scale = nullptr; }
        __syncthreads();
#pragma unroll
        for (int n_ = 0; n_ < 8; ++n_) { const int e = tid + 512 * n_; const int kk = e >> 6, nn = e & 63; float v = src[(size_t)(k0 + kk) * ld + nn]; if (scale) v *= scale[k0 + kk]; tile[kk * 65 + nn] = v; }
        __syncthreads();
#pragma unroll
        for (int n_ = 0; n_ < 4; ++n_) { const int e = tid + 512 * n_; const int nn = e >> 5, kp = (e & 31) * 2; const unsigned w = pack_bf2(tile[kp * 65 + nn], tile[(kp + 1) * 65 + nn]);
            *(unsigned*)(dst + (size_t)(n0 + nn) * DM + k0 + kp) = w; }
    }
    __syncthreads();
}

__device__ void ph_prep(const Params& p_in, LAS unsigned char* lds_in, int blk, int nblk) {
    Params p = p_in; asm volatile("" : "+s"(p.ws), "+s"(p.out));
    LAS unsigned char* lds = lds_in; asm volatile("" : "+s"(lds));

    const int tid = opaque_tid();
    LAS float* tile = (LAS float*)lds;
    convert_weights(p, 0, 0, tile, tid, blk, nblk);
    for (int e = blk * 512 + tid; e < DEPTH * NSM * DM; e += nblk * 512) { const int l = e / (NSM * DM), r = e % (NSM * DM), j = r / DM, k = r % DM;
        ((float*)(p.ws + WS_WSM))[e] = p.w_in[(size_t)l * DM * IN_DIM + (size_t)k * IN_DIM + win_smcol(j)] * p.norm_w[l * DM + k]; }
    for (int c = blk * 512 + tid; c < 256; c += nblk * 512) { float lg[DEPTH], mx = -1e30f;
#pragma unroll
        for (int l = 0; l < DEPTH; ++l) { lg[l] = p.lb_logits[l * 256 + c]; mx = fmaxf(mx, lg[l]); }
        float s = 0.f;
#pragma unroll
        for (int l = 0; l < DEPTH; ++l) { lg[l] = expf(lg[l] - mx); s += lg[l]; }
        float cum = 0.f; const float w0 = lg[0] / s;
#pragma unroll
        for (int l = 0; l < DEPTH; ++l) { cum += lg[l] / s; ((float*)(p.ws + WS_LB))[l * 256 + c] = fmaxf(cum - w0, 0.f); } }
    for (int e = blk * 512 + tid; e < (TP + 1) * 32; e += nblk * 512) { const int pi = e >> 5, i = e & 31; const double pos = pi < TP ? (double)pi : (double)PASTLEN;
        const float invf = (float)(1.0 / pow(10000.0, (double)((float)i / 31.0f)));
        const double rev = pos * (double)invf * 0.15915494309189535; const float fr = (float)(rev - rint(rev));
        ((float*)(p.ws + WS_ROT))[e * 2 + 0] = __builtin_amdgcn_cosf(fr); ((float*)(p.ws + WS_ROT))[e * 2 + 1] = __builtin_amdgcn_sinf(fr); }
    float* h = (float*)(p.ws + WS_H);
    for (int e = blk * 512 + tid; e < MROWS * (DM / 4); e += nblk * 512) { const int row = e >> 8, c4 = (e & 255) * 4; const float* src;
        if (row < MP) { const int b = row / TP, t = row % TP; src = t < NMETA ? p.meta + t * DM : p.x_prompt + ((size_t)b * SEQ + (t - NMETA)) * DM; } else src = p.x_sample + (size_t)(row - MP) * DM;
        *(f32x4*)(h + (size_t)row * DM + c4) = *(const f32x4*)(src + c4); }
}

constexpr int MMAIN = 16384;
__device__ __forceinline__ void out_tail(const Params& p, int layer, LAS unsigned char* lds, int blk) {
    pg8::Gemm g{(const bf16_t*)(p.ws + WS_Y), (const bf16_t*)(p.ws + WS_WOUTT), MROWS, DM, DM};
    pg8::OneUnit S{MMAIN / 256, blk};
    pg8::EpiResid E{(float*)(p.ws + WS_H), DM};
    pg8::gemm_phase<pg8::EpiResid, pg8::OneUnit>(lds, g, S, E);
    flag_publish((unsigned*)(p.ws + WS_BAR) + FLAG_WORD0 + 2 * layer);
}
__device__ void ph_rownorm(const Params& p_in, int layer, LAS unsigned char* lds_in, int blk, int nblk) {
    Params p = p_in; asm volatile("" : "+s"(p.ws), "+s"(p.out));
    LAS unsigned char* lds = lds_in; asm volatile("" : "+s"(lds));
    const bool has_tail = layer > 0;
    if (has_tail && blk < 4) out_tail(p, layer - 1, lds, blk);

    const int tid = opaque_tid(), wid = tid >> 6, lane = tid & 63;
    const float* h = (const float*)(p.ws + WS_H); bf16_t* hb = (bf16_t*)(p.ws + WS_HB); float* rs = (float*)(p.ws + WS_RS); float* psm = (float*)(p.ws + WS_PSM);
    const float* wsm = (const float*)(p.ws + WS_WSM) + (size_t)layer * NSM * DM;
    for (int pass = 0; pass < 2; ++pass) {
    if (pass == 1 && has_tail) flag_wait((unsigned*)(p.ws + WS_BAR) + FLAG_WORD0 + 2 * (layer - 1), 4u, (unsigned*)(p.ws + WS_BAR));
    const int nb0 = has_tail ? nblk - 4 : nblk, b0 = has_tail ? blk - 4 : blk;
    const int r_lo = pass == 0 ? (b0 >= 0 ? b0 * 8 + wid : MMAIN) : MMAIN + blk * 8 + wid, r_hi = pass == 0 ? MMAIN : MROWS, r_st = (pass == 0 ? nb0 : nblk) * 8;
    for (int row = r_lo; row < r_hi; row += r_st) {
        f32x4 v[4]; float ss = 0.f;
#pragma unroll
        for (int j = 0; j < 4; ++j) { v[j] = *(const f32x4*)(h + (size_t)row * DM + j * 256 + lane * 4); ss += v[j][0] * v[j][0] + v[j][1] * v[j][1] + v[j][2] * v[j][2] + v[j][3] * v[j][3]; }
        ss = wave_sum(ss, lane); const float r = rsqrtf(ss * (1.0f / DM) + EPSF);
#pragma unroll
        for (int j = 0; j < 4; ++j) { u32x2 w; w.x = pack_bf2(v[j][0], v[j][1]); w.y = pack_bf2(v[j][2], v[j][3]); *(u32x2*)(hb + (size_t)row * DM + j * 256 + lane * 4) = w; }
        float mine = 0.f;
        for (int q = 0; q < NSM; ++q) { float d = 0.f;
#pragma unroll
            for (int j = 0; j < 4; ++j) { const f32x4 w = *(const f32x4*)(wsm + q * DM + j * 256 + lane * 4); d += v[j][0] * w[0] + v[j][1] * w[1] + v[j][2] * w[2] + v[j][3] * w[3]; }
            d = wave_sum(d, lane); if (lane == q) mine = d * r; }
        if (lane < NSM) psm[(size_t)row * NSM + lane] = mine;
        if (lane == 0) rs[row] = r;
    }
    }
}

__device__ void ph_gemm_in(const Params& p_in, int layer, LAS unsigned char* lds_in, int blk, int nblk) {
    Params p = p_in; asm volatile("" : "+s"(p.ws), "+s"(p.out));
    LAS unsigned char* lds = lds_in; asm volatile("" : "+s"(lds));

    pg8::Gemm g{(const bf16_t*)(p.ws + WS_HB), (const bf16_t*)(p.ws + WS_WINT), MROWS, NBIG, DM};
    pg8::StaticOrder S; S.init(MROWS, NBIG, nblk, blk);
    pg8::EpiProj E{(bf16_t*)(p.ws + WS_PROJ), NBIG, (const float*)(p.ws + WS_RS)};
    pg8::gemm_phase<pg8::EpiProj, pg8::StaticOrder>(lds, g, S, E);
}
__device__ void ph_gemm_out(const Params& p_in, int layer, LAS unsigned char* lds_in, int blk, int nblk) {
    Params p = p_in; asm volatile("" : "+s"(p.ws), "+s"(p.out));
    LAS unsigned char* lds = lds_in; asm volatile("" : "+s"(lds));

    pg8::Gemm g{(const bf16_t*)(p.ws + WS_Y), (const bf16_t*)(p.ws + WS_WOUTT), MMAIN, DM, DM};
    pg8::StaticOrder S; S.init(MMAIN, DM, nblk, blk);
    pg8::EpiResid E{(float*)(p.ws + WS_H), DM};
    pg8::gemm_phase<pg8::EpiResid, pg8::StaticOrder>(lds, g, S, E);
}

constexpr int TB = 16;
struct MixLds {
    static constexpr int QS = 0, KS = QS + TB * 128, VS = KS + TB * 128, DS = VS + TB * 128, ZS = DS + TB * 128, XS = ZS + TB * 128, OS = XS + TB * 128, BS = OS + TB * 128, SC = BS + TB * 2, END = SC + TB * 2;
};

struct SeqInfo { int row0, T, dec, b; };
__device__ __forceinline__ SeqInfo seq_info(int s) { SeqInfo q; if (s < NB) { q.row0 = s * TP; q.T = TP; q.dec = 0; q.b = s; } else { q.row0 = MP + (s - NB); q.T = 1; q.dec = 1; q.b = s - NB; } return q; }

__device__ __forceinline__ float preconv(const bf16_t* proj, const SeqInfo& q, int t, int col, const float* ctx  , int ch) {
    if (t >= 0) return bf2f(proj[(size_t)(q.row0 + t) * NBIG + col]);
    return ctx ? ctx[(3 + t) * 768 + ch] : 0.f;
}

template <int DK, int NV, bool DELTA, bool VECDEC>
__device__ __forceinline__ void recur_batch(float (&S)[DK / (64 / NV)], LAS float* L, int nb, int wid, int lane) {
    constexpr int KQ = 64 / NV, KR = DK / KQ, DVT = 8 * NV;
    const int kq = lane / NV, vv = lane % NV, vcol = wid * NV + vv, hh = vcol >> 6;
    for (int t = 0; t < nb; ++t) {
        float kk[KR], qq[KR];
#pragma unroll
        for (int i = 0; i < KR; ++i) { kk[i] = L[MixLds::KS + t * 128 + kq * KR + i]; qq[i] = L[MixLds::QS + t * 128 + kq * KR + i]; }
        const float v = L[MixLds::VS + t * 128 + vcol];
        if (DELTA) {
            const float dec = L[MixLds::DS + t * 128 + hh]; float pk = 0.f;
#pragma unroll
            for (int i = 0; i < KR; ++i) { S[i] *= dec; pk += kk[i] * S[i]; }
#pragma unroll
            for (int o = NV; o < 64; o <<= 1) pk += lane_xor(pk, o, lane);
            const float u = L[MixLds::BS + t] * (v - pk);
#pragma unroll
            for (int i = 0; i < KR; ++i) S[i] += kk[i] * u;
        } else if (VECDEC) {
#pragma unroll
            for (int i = 0; i < KR; ++i) S[i] = L[MixLds::DS + t * 128 + kq * KR + i] * S[i] + kk[i] * v;
        } else {
            const float dec = L[MixLds::DS + t * 128 + hh];
#pragma unroll
            for (int i = 0; i < KR; ++i) S[i] = dec * S[i] + kk[i] * v;
        }
        float po = 0.f;
#pragma unroll
        for (int i = 0; i < KR; ++i) po += qq[i] * S[i];
#pragma unroll
        for (int o = NV; o < 64; o <<= 1) po += lane_xor(po, o, lane);
        if (kq == 0) L[MixLds::OS + t * 128 + vcol] = po;
    }
    (void)DVT;
}

template <int MIX>
__device__ void mixer_item(const Params& p, int layer, int s, int hu  , LAS float* L) {
    constexpr int DK = MIX == 2 ? 128 : 64, NV = MIX == 2 ? 16 : 8, KQ = 64 / NV, KR = DK / KQ, DVT = 8 * NV;
    const int tid = opaque_tid(), wid = tid >> 6, lane = tid & 63;
    const SeqInfo q = seq_info(s);
    const bf16_t* proj = (const bf16_t*)(p.ws + WS_PROJ); const float* psm = (const float*)(p.ws + WS_PSM); bf16_t* y = (bf16_t*)(p.ws + WS_Y);
    const float* lb = (const float*)(p.ws + WS_LB) + layer * 256; const float* rot = (const float*)(p.ws + WS_ROT);
    const int kq = lane / NV, vv = lane % NV, vcol = wid * NV + vv, hh = vcol >> 6;
    const int head = MIX == 2 ? hu * 2 + hh : hu;
    const float* ctx = nullptr; const float* cw = nullptr;
    if (MIX == 1) { cw = p.gdn_conv_w + (size_t)layer * 4 * 768; if (q.dec) ctx = p.st_gconv + ((size_t)layer * DECB + q.b) * 3 * 768; }
    if (MIX == 2) { cw = p.ssd_conv_w + (size_t)layer * 4 * 768; if (q.dec) ctx = p.st_sconv + ((size_t)layer * DECB + q.b) * 3 * 768; }
    float S[KR];
    {
        const float* st = MIX == 0 ? p.st_hgrn : MIX == 1 ? p.st_gdn : MIX == 2 ? p.st_ssd : p.st_ret;
#pragma unroll
        for (int i = 0; i < KR; ++i) S[i] = q.dec ? st[(((size_t)layer * DECB + q.b) * 4 + head) * DK * 64 + (size_t)(kq * KR + i) * 64 + (vcol & 63)] : 0.f;
    }
    float hc0 = 0.f, hc1 = 0.f;
    if (MIX == 1) { hc0 = -__expf(p.gdn_a_log[layer * 4 + hu]); hc1 = p.gdn_dt_bias[layer * 4 + hu]; }
    if (MIX == 3) { hc0 = 1.0f - exp2f(-5.0f - (float)hu); }

    for (int t0 = 0; t0 < q.T; t0 += TB) {
        const int nb = min(TB, q.T - t0);
        __syncthreads();
        if (MIX == 0) {
            for (int e = tid; e < nb * 64; e += 512) { const int t = e >> 6, d = e & 63, c = hu * 64 + d; const bf16_t* pr = proj + (size_t)(q.row0 + t0 + t) * NBIG;
                const float aq = bf2f(pr[PC_AQ + c]), af = bf2f(pr[PC_AF + c]), ai = bf2f(pr[PC_AI + c]), az = bf2f(pr[PC_AZ + c]), l_ = lb[c];
                L[MixLds::QS + t * 128 + d] = silu_f(aq) * 0.125f; L[MixLds::KS + t * 128 + d] = (1.0f - l_) * sigmoid_f(-af); L[MixLds::DS + t * 128 + d] = l_ + (1.0f - l_) * sigmoid_f(af);
                L[MixLds::VS + t * 128 + d] = ai; L[MixLds::ZS + t * 128 + d] = az; }
        } else if (MIX == 1) {
            for (int e = tid; e < nb * 192; e += 512) { const int t = e / 192, r = e % 192, part = r >> 6, d = r & 63, ch = part * 256 + hu * 64 + d, col = PC_BQKV + ch; const int tt = t0 + t;
                float a = 0.f;
#pragma unroll
                for (int j = 0; j < 4; ++j) a += cw[j * 768 + ch] * preconv(proj, q, tt - 3 + j, col, ctx, ch);
                a = silu_f(a);
                L[(part == 0 ? MixLds::QS : part == 1 ? MixLds::KS : MixLds::VS) + t * 128 + d] = a; }
            for (int e = tid; e < nb * 64; e += 512) { const int t = e >> 6, d = e & 63; L[MixLds::ZS + t * 128 + d] = bf2f(proj[(size_t)(q.row0 + t0 + t) * NBIG + PC_BZ + hu * 64 + d]); }
            if (tid < nb) { const float* ps = psm + (size_t)(q.row0 + t0 + tid) * NSM; const float g = hc0 * softplus_f(ps[hu] + hc1);
                L[MixLds::DS + tid * 128 + 0] = __expf(g); L[MixLds::BS + tid] = sigmoid_f(ps[4 + hu]); }
            __syncthreads();
            if (tid < nb * 2) { const int t = tid >> 1, which = tid & 1; const LAS float* src = L + (which ? MixLds::KS : MixLds::QS) + t * 128; float ss = 0.f;
                for (int d = 0; d < 64; ++d) ss += src[d] * src[d];
                L[MixLds::SC + tid] = rsqrtf(ss + EPSF) * (which ? 1.0f : 0.125f); }
            __syncthreads();
            for (int e = tid; e < nb * 128; e += 512) { const int t = e >> 7, r = e & 127, which = r >> 6, d = r & 63; L[(which ? MixLds::KS : MixLds::QS) + t * 128 + d] *= L[MixLds::SC + t * 2 + which]; }
        } else if (MIX == 2) {
            if (tid < nb * 2) { const int t = tid >> 1, h2 = tid & 1, hd = hu * 2 + h2; const float dt = softplus_f(psm[(size_t)(q.row0 + t0 + t) * NSM + 8 + hd] + p.ssd_dt_bias[layer * 4 + hd]);
                L[MixLds::BS + tid] = dt; L[MixLds::DS + t * 128 + h2] = __expf(-dt * __expf(p.ssd_a_log[layer * 4 + hd])); }
            __syncthreads();
            for (int e = tid; e < nb * 384; e += 512) { const int t = e / 384, r = e % 384, part = r >> 7, j = r & 127, ch = part * 256 + hu * 128 + j, col = PC_CXBC + ch; const int tt = t0 + t;
                float a = p.ssd_conv_b[layer * 768 + ch];
#pragma unroll
                for (int jj = 0; jj < 4; ++jj) a += cw[jj * 768 + ch] * preconv(proj, q, tt - 3 + jj, col, ctx, ch);
                a = silu_f(a);
                if (part == 0) { L[MixLds::XS + t * 128 + j] = a; L[MixLds::VS + t * 128 + j] = a * L[MixLds::BS + t * 2 + (j >> 6)]; }
                else if (part == 1) L[MixLds::KS + t * 128 + j] = a; else L[MixLds::QS + t * 128 + j] = a; }
            for (int e = tid; e < nb * 128; e += 512) { const int t = e >> 7, j = e & 127; L[MixLds::ZS + t * 128 + j] = bf2f(proj[(size_t)(q.row0 + t0 + t) * NBIG + PC_CZ + hu * 128 + j]); }
        } else {
            for (int e = tid; e < nb * 32; e += 512) { const int t = e >> 5, i = e & 31; const bf16_t* pr = proj + (size_t)(q.row0 + t0 + t) * NBIG; const int pidx = q.dec ? TP : (t0 + t);
                const float cs = rot[(pidx * 32 + i) * 2], sn = rot[(pidx * 32 + i) * 2 + 1];
                const float q1 = bf2f(pr[PC_DQ + hu * 64 + i]), q2 = bf2f(pr[PC_DQ + hu * 64 + 32 + i]), k1 = bf2f(pr[PC_DK + hu * 64 + i]), k2 = bf2f(pr[PC_DK + hu * 64 + 32 + i]);
                L[MixLds::QS + t * 128 + i] = q1 * cs - q2 * sn; L[MixLds::QS + t * 128 + 32 + i] = q2 * cs + q1 * sn;
                L[MixLds::KS + t * 128 + i] = (k1 * cs - k2 * sn) * 0.125f; L[MixLds::KS + t * 128 + 32 + i] = (k2 * cs + k1 * sn) * 0.125f; }
            for (int e = tid; e < nb * 64; e += 512) { const int t = e >> 6, d = e & 63; const bf16_t* pr = proj + (size_t)(q.row0 + t0 + t) * NBIG;
                L[MixLds::VS + t * 128 + d] = bf2f(pr[PC_DV + hu * 64 + d]); L[MixLds::ZS + t * 128 + d] = bf2f(pr[PC_DZ + hu * 64 + d]); }
            if (tid < nb) L[MixLds::DS + tid * 128] = hc0;
        }
        __syncthreads();
        recur_batch<DK, NV, MIX == 1, MIX == 0>(S, L, nb, wid, lane);
        __syncthreads();
        for (int t = wid; t < nb; t += 8) {
            const size_t yrow = (size_t)(q.row0 + t0 + t) * DM;
            if (MIX == 0 || MIX == 1) { const float o = L[MixLds::OS + t * 128 + lane]; const float ms = wave_sum(o * o, lane) * (1.0f / 64.0f);
                const float w = (MIX == 0 ? p.hgrn_norm_w : p.gdn_norm_w)[layer * 256 + hu * 64 + lane];
                y[yrow + (MIX == 0 ? 0 : 256) + hu * 64 + lane] = f2bf(o * rsqrtf(ms + EPSF) * w * silu_f(L[MixLds::ZS + t * 128 + lane])); }
            else if (MIX == 2) { float u[2]; float ss = 0.f;
#pragma unroll
                for (int r = 0; r < 2; ++r) { const int j = lane + 64 * r; const float o = L[MixLds::OS + t * 128 + j] + p.ssd_d[layer * 4 + hu * 2 + r] * L[MixLds::XS + t * 128 + j]; u[r] = o * silu_f(L[MixLds::ZS + t * 128 + j]); ss += u[r] * u[r]; }
                const float sc = rsqrtf(wave_sum(ss, lane) * (1.0f / 128.0f) + EPSF);
#pragma unroll
                for (int r = 0; r < 2; ++r) { const int j = lane + 64 * r; y[yrow + 512 + hu * 128 + j] = f2bf(u[r] * sc * p.ssd_norm_w[layer * 256 + hu * 128 + j]); } }
            else { const float o = L[MixLds::OS + t * 128 + lane]; const float mu = wave_sum(o, lane) * (1.0f / 64.0f); const float dv = o - mu; const float var = wave_sum(dv * dv, lane) * (1.0f / 64.0f);
                const int c = hu * 64 + lane;
                y[yrow + 768 + c] = f2bf((dv * rsqrtf(var + EPSF) * p.ret_norm_w[layer * 256 + c] + p.ret_norm_b[layer * 256 + c]) * silu_f(L[MixLds::ZS + t * 128 + lane])); }
        }
    }
    {
        float* so = p.out + (q.dec ? (MIX == 0 ? O_HGRN_S : MIX == 1 ? O_GDN_S : MIX == 2 ? O_SSD_S : O_RET_S) : (MIX == 0 ? O_HGRN_P : MIX == 1 ? O_GDN_P : MIX == 2 ? O_SSD_P : O_RET_P));
        const int nbt = q.dec ? DECB : NB;
#pragma unroll
        for (int i = 0; i < KR; ++i) so[(((size_t)layer * nbt + q.b) * 4 + head) * DK * 64 + (size_t)(kq * KR + i) * 64 + (vcol & 63)] = S[i];
    }
    if (MIX == 1 || MIX == 2) {
        float* co = p.out + (q.dec ? (MIX == 1 ? O_GCONV_S : O_SCONV_S) : (MIX == 1 ? O_GCONV_P : O_SCONV_P)) + ((size_t)layer * (q.dec ? DECB : NB) + q.b) * 3 * 768;
        const int nch = MIX == 1 ? 192 : 384;
        for (int e = tid; e < 3 * nch; e += 512) { const int r = e / nch, c = e % nch; int ch;
            if (MIX == 1) ch = (c >> 6) * 256 + hu * 64 + (c & 63); else ch = (c >> 7) * 256 + hu * 128 + (c & 127);
            co[r * 768 + ch] = preconv(proj, q, q.T - 3 + r, (MIX == 1 ? PC_BQKV : PC_CXBC) + ch, ctx, ch); }
    }
    (void)DVT;
}

constexpr int NCHUNK = 33;
constexpr int LDP = 72;
constexpr int LDP2 = 136;
constexpr int OSP = 68;
typedef short bf16x4 __attribute__((ext_vector_type(4)));
__device__ __forceinline__ f32x4 mfma16(bf16x8 a, bf16x8 b, f32x4 c) { return __builtin_amdgcn_mfma_f32_16x16x32_bf16(a, b, c, 0, 0, 0); }
__device__ __forceinline__ float fexp2(float x) { return __builtin_amdgcn_exp2f(x); }
__device__ __forceinline__ bf16x8 frag_ld(const LAS bf16_t* t, int pitch, int row, int col) { return *(const LAS bf16x8*)(t + row * pitch + col); }
__device__ __forceinline__ bf16x8 frag_ld_perm(const LAS bf16_t* t, int pitch, int row, int k0, int q) {
    const bf16x4 lo = *(const LAS bf16x4*)(t + row * pitch + k0 + 4 * q), hi = *(const LAS bf16x4*)(t + row * pitch + k0 + 16 + 4 * q);
    return __builtin_shufflevector(lo, hi, 0, 1, 2, 3, 4, 5, 6, 7);
}
__device__ __forceinline__ bf16x8 pack_acc2(const f32x4& a, const f32x4& b) {
    u32x4 w; w.x = pg8::cvt_pk_bf16(a[0], a[1]); w.y = pg8::cvt_pk_bf16(a[2], a[3]); w.z = pg8::cvt_pk_bf16(b[0], b[1]); w.w = pg8::cvt_pk_bf16(b[2], b[3]);
    return __builtin_bit_cast(bf16x8, w);
}
__device__ __forceinline__ void st_bf4(LAS bf16_t* dst, const f32x4& v) { u32x2 w; w.x = pg8::cvt_pk_bf16(v[0], v[1]); w.y = pg8::cvt_pk_bf16(v[2], v[3]); *(LAS u32x2*)dst = w; }
__device__ __forceinline__ void unpack_bf8(const u32x4& w, float* a) { const unsigned x[4] = {w.x, w.y, w.z, w.w};
#pragma unroll
    for (int k = 0; k < 4; ++k) { a[2 * k] = __uint_as_float(x[k] << 16); a[2 * k + 1] = __uint_as_float(x[k] & 0xffff0000u); } }
__device__ __forceinline__ u32x4 pack_bf8(const float* a) { u32x4 w; w.x = pg8::cvt_pk_bf16(a[0], a[1]); w.y = pg8::cvt_pk_bf16(a[2], a[3]); w.z = pg8::cvt_pk_bf16(a[4], a[5]); w.w = pg8::cvt_pk_bf16(a[6], a[7]); return w; }

constexpr size_t HR_QF = 0, HR_OI = 8192, HR_DS = 16384, HR_VEC = 24576, HR_UNIT = 25088;
constexpr size_t SS_QF = 0, SS_HEAD = 16384  , SS_VEC = 65536  , SS_UNIT = 66560;
constexpr size_t GD_U = 0, GD_W = 8192, GD_Q = 16384, GD_P = 24576, GD_K = 32768, GD_VEC = 40960, GD_UNIT = 41728;
constexpr size_t YOFF_R = 37748736;
static_assert((size_t)NB * NCHUNK * 2 * SS_UNIT <= YOFF_R && YOFF_R + (size_t)NB * NCHUNK * 4 * HR_UNIT <= (size_t)NB * SEQ * DM * 4 && (size_t)NB * NCHUNK * 4 * HR_UNIT <= (size_t)MROWS * DM * 2 && (size_t)NB * NCHUNK * 4 * GD_UNIT == WS_END - WS_E, "scratch map");
__device__ __forceinline__ unsigned char* rec_hgrn(const Params& p, int b, int c, int h) { return p.ws + WS_HB + (size_t)((b * NCHUNK + c) * 4 + h) * HR_UNIT; }
__device__ __forceinline__ unsigned char* rec_ret(const Params& p, int b, int c, int h) { return (unsigned char*)(p.out + O_YP) + YOFF_R + (size_t)((b * NCHUNK + c) * 4 + h) * HR_UNIT; }
__device__ __forceinline__ unsigned char* rec_gdn(const Params& p, int b, int c, int h) { return p.ws + WS_E + (size_t)((b * NCHUNK + c) * 4 + h) * GD_UNIT; }
__device__ __forceinline__ unsigned char* rec_ssd(const Params& p, int b, int c, int g) { return (unsigned char*)(p.out + O_YP) + (size_t)((b * NCHUNK + c) * 2 + g) * SS_UNIT; }
__device__ __forceinline__ bf16x8 frag_scale(const bf16x8& f, const float (&sc)[8]) { const u32x4 w = __builtin_bit_cast(u32x4, f); float a[8]; unpack_bf8(w, a);
#pragma unroll
    for (int e = 0; e < 8; ++e) a[e] *= sc[e];
    return __builtin_bit_cast(bf16x8, pack_bf8(a)); }
__device__ __forceinline__ void st_acc_bf4(unsigned char* dst, const f32x4& v) { u32x2 w; w.x = pg8::cvt_pk_bf16(v[0], v[1]); w.y = pg8::cvt_pk_bf16(v[2], v[3]); *(u32x2*)dst = w; }
__device__ __forceinline__ f32x4 ld_acc_bf4(const unsigned char* src) { const u32x2 w = *(const u32x2*)src; return (f32x4){__uint_as_float(w.x << 16), __uint_as_float(w.x & 0xffff0000u), __uint_as_float(w.y << 16), __uint_as_float(w.y & 0xffff0000u)}; }

template <int NR> struct Raw192 {
    static constexpr int NP = NR * 24, PPT = (NP + 511) / 512;
    u32x4 pc[PPT]; float sv[2];
    __device__ __forceinline__ void load(const bf16_t* projb, int tfirst, int col0, int col1, int col2, int tid) {
#pragma unroll
        for (int k = 0; k < PPT; ++k) { const int id = min(tid + 512 * k, NP - 1), row = id / 24, seg = id % 24, part = seg >> 3, t = tfirst + row;
            const u32x4 v = *(const u32x4*)(projb + (size_t)max(t, 0) * NBIG + (part == 0 ? col0 : part == 1 ? col1 : col2) + (seg & 7) * 8);
            pc[k] = t >= 0 ? v : (u32x4){0u, 0u, 0u, 0u}; }
    }
    __device__ __forceinline__ void to_lds(LAS bf16_t* T  , int tid) const {
#pragma unroll
        for (int k = 0; k < PPT; ++k) { const int id = tid + 512 * k; if (id < NP) *(LAS u32x4*)(T + (id / 24) * 192 + (id % 24) * 8) = pc[k]; }
    }
};
__device__ __forceinline__ void unit_bch(int v, int& b, int& c, int& h) { b = v / (NCHUNK * 4); c = (v >> 2) % NCHUNK; h = v & 3; }

struct RetRaw { Raw192<64> q; u32x4 rt[2];
    __device__ __forceinline__ void load(const Params& p, int v, int tid) { int b, c, h; unit_bch(v, b, c, h); const int t0 = 64 * c - 48;
        q.load((const bf16_t*)(p.ws + WS_PROJ) + (size_t)(b * TP) * NBIG, t0, PC_DQ + h * 64, PC_DK + h * 64, PC_DV + h * 64, tid);
#pragma unroll
        for (int k = 0; k < 2; ++k) { const int id = tid + 512 * k, row = id >> 4, sg = id & 15; rt[k] = *(const u32x4*)((const float*)(p.ws + WS_ROT) + (size_t)max(t0 + row, 0) * 64 + sg * 4); } }
};
struct RetLds { static constexpr int QS = 0, KS = QS + 64 * LDP * 2, KT = KS + 64 * LDP * 2, VT = KT + 64 * LDP * 2, VH = VT + 64 * LDP * 2, PS = VH + 64 * LDP * 2, RAW = PS + 64 * LDP * 2, ROT = RAW + 64 * 192 * 2, END = ROT + 64 * 64 * 4; };
__device__ void ret_pre_unit(const Params& p, int layer, int v_this, int v_next, RetRaw& RR, LAS unsigned char* lds) {
    int b, c, hu; unit_bch(v_this, b, c, hu);
    const int tid = opaque_tid(), wid = tid >> 6, lane = tid & 63, fq = lane >> 4, fc = lane & 15;
    LAS bf16_t* Qs = (LAS bf16_t*)(lds + RetLds::QS); LAS bf16_t* Ks = (LAS bf16_t*)(lds + RetLds::KS); LAS bf16_t* KT = (LAS bf16_t*)(lds + RetLds::KT);
    LAS bf16_t* VT = (LAS bf16_t*)(lds + RetLds::VT); LAS bf16_t* VH = (LAS bf16_t*)(lds + RetLds::VH); LAS bf16_t* Ps = (LAS bf16_t*)(lds + RetLds::PS);
    LAS bf16_t* RawT = (LAS bf16_t*)(lds + RetLds::RAW); LAS float* RotT = (LAS float*)(lds + RetLds::ROT);
    const float lg2 = log2f(1.0f - exp2f(-5.0f - (float)hu));
    const int i0 = c == 0 ? 48 : 0, nlast = 64 - i0;
    unsigned char* rec = rec_ret(p, b, c, hu);
    lds_barrier();
    RR.q.to_lds(RawT, tid);
#pragma unroll
    for (int k = 0; k < 2; ++k) *(LAS u32x4*)(RotT + (tid + 512 * k) * 4) = RR.rt[k];
    if (v_next >= 0) RR.load(p, v_next, tid);
    lds_barrier();
#pragma unroll
    for (int n_ = 0; n_ < 4; ++n_) { const int e = tid + 512 * n_; const int i = e >> 5, d = e & 31; float qa, qb, ka, kb;
        { const LAS bf16_t* pr = RawT + i * 192; const float cs = RotT[i * 64 + 2 * d], sn = RotT[i * 64 + 2 * d + 1];
            const float q1 = bf2f(pr[d]), q2 = bf2f(pr[32 + d]), k1 = bf2f(pr[64 + d]), k2 = bf2f(pr[96 + d]);
            const float mk = i >= i0 ? 1.0f : 0.0f;
            qa = (q1 * cs - q2 * sn) * mk; qb = (q2 * cs + q1 * sn) * mk; ka = (k1 * cs - k2 * sn) * (0.125f * mk); kb = (k2 * cs + k1 * sn) * (0.125f * mk); }
        Qs[i * LDP + d] = f2bf(qa); Qs[i * LDP + 32 + d] = f2bf(qb); Ks[i * LDP + d] = f2bf(ka); Ks[i * LDP + 32 + d] = f2bf(kb);
        KT[d * LDP + i] = f2bf(ka); KT[(d + 32) * LDP + i] = f2bf(kb); }
#pragma unroll
    for (int n_ = 0; n_ < 8; ++n_) { const int e = tid + 512 * n_; const int i = e >> 6, d = e & 63;
        float v = bf2f(RawT[i * 192 + 128 + d]); v = i >= i0 ? v : 0.f; const float vh = v * fexp2((float)(63 - i) * lg2);
        VT[d * LDP + i] = f2bf(v); VH[d * LDP + i] = f2bf(vh); }
    lds_barrier();
#pragma unroll
    for (int tt = 0; tt < 2; ++tt) { const int t = wid * 2 + tt, I = t >> 2, J = t & 3; f32x4 acc = (f32x4){0.f, 0.f, 0.f, 0.f};
        if (J <= I) {
#pragma unroll
            for (int s = 0; s < 2; ++s) acc = mfma16(frag_ld(Ks, LDP, 16 * J + fc, 32 * s + 8 * fq), frag_ld(Qs, LDP, 16 * I + fc, 32 * s + 8 * fq), acc); }
        const int i = 16 * I + fc;
#pragma unroll
        for (int r = 0; r < 4; ++r) { const int j = 16 * J + 4 * fq + r; acc[r] = (j <= i && j >= i0) ? acc[r] * fexp2((float)(i - j) * lg2) : 0.f; }
        st_bf4(Ps + i * LDP + 16 * J + 4 * fq, acc); }
    lds_barrier();
    { const int w = wid & 3; bf16x8 bb[2];
#pragma unroll
        for (int s = 0; s < 2; ++s) bb[s] = frag_ld(wid < 4 ? VT : VH, LDP, 16 * w + fc, 32 * s + 8 * fq);
        const LAS bf16_t* At = wid < 4 ? Ps : KT; unsigned char* dst = rec + (wid < 4 ? HR_OI : HR_DS);
#pragma unroll
        for (int m = 0; m < 4; ++m) { f32x4 acc = (f32x4){0.f, 0.f, 0.f, 0.f};
#pragma unroll
            for (int s = 0; s < 2; ++s) acc = mfma16(frag_ld(At, LDP, 16 * m + fc, 32 * s + 8 * fq), bb[s], acc);
            st_acc_bf4(dst + ((size_t)(w * 4 + m) * 64 + lane) * 8, acc); }
        { const float eg = fexp2((float)max(16 * (wid >> 1) + fc - i0 + 1, 0) * lg2); const float sc[8] = {eg, eg, eg, eg, eg, eg, eg, eg};
            *(bf16x8*)(rec + HR_QF + ((size_t)wid * 64 + lane) * 16) = frag_scale(frag_ld_perm(Qs, LDP, 16 * (wid >> 1) + fc, 32 * (wid & 1), fq), sc); }
        if (tid < 64) { float* gv = (float*)(rec + HR_VEC); gv[64 + tid] = fexp2((float)nlast * lg2); } }
}

struct HgLds { static constexpr int LS = 0  , KR = LS + 16384  , QR = KR + 16384  , QT = QR + 16384, QH = QT + 64 * LDP * 2, KT = QH + 64 * LDP * 2  ,
    KHT = KT + 160 * LDP * 2, VT = KHT + 64 * LDP * 2, PS = VT + 64 * LDP * 2, AV = PS + 64 * LDP * 2, RAW = AV + 256, END = RAW + 64 * 192 * 2; };
struct HgRaw { Raw192<64> q;
    __device__ __forceinline__ void load(const Params& p, int v, int tid) { int b, c, h; unit_bch(v, b, c, h);
        q.load((const bf16_t*)(p.ws + WS_PROJ) + (size_t)(b * TP) * NBIG, 64 * c - 48, PC_AQ + h * 64, PC_AF + h * 64, PC_AI + h * 64, tid); }
};
__device__ void hgrn_pre_unit(const Params& p, int layer, int v_this, int v_next, HgRaw& RR, LAS unsigned char* lds) {
    int b, c, hu; unit_bch(v_this, b, c, hu);
    const int tid = opaque_tid(), wid = tid >> 6, lane = tid & 63, fq = lane >> 4, fc = lane & 15;
    LAS float* Ls = (LAS float*)(lds + HgLds::LS); LAS float* Kr = (LAS float*)(lds + HgLds::KR); LAS float* Qr = (LAS float*)(lds + HgLds::QR);
    LAS bf16_t* Qt = (LAS bf16_t*)(lds + HgLds::QT); LAS bf16_t* Qh = (LAS bf16_t*)(lds + HgLds::QH); LAS bf16_t* Kt = (LAS bf16_t*)(lds + HgLds::KT); LAS bf16_t* KhT = (LAS bf16_t*)(lds + HgLds::KHT);
    LAS bf16_t* VT = (LAS bf16_t*)(lds + HgLds::VT); LAS bf16_t* Ps = (LAS bf16_t*)(lds + HgLds::PS); LAS float* Av = (LAS float*)(lds + HgLds::AV);
    LAS bf16_t* RawT = (LAS bf16_t*)(lds + HgLds::RAW);
    const float lbv = ((const float*)(p.ws + WS_LB))[layer * 256 + hu * 64 + lane];
    const int i0 = c == 0 ? 48 : 0;
    unsigned char* rec = rec_hgrn(p, b, c, hu);
    lds_barrier();
    RR.q.to_lds(RawT, tid);
    if (v_next >= 0) RR.load(p, v_next, tid);
    lds_barrier();
    if (wid < 4) { float acc = 0.f; float afr[16];
#pragma unroll
        for (int ii = 0; ii < 16; ++ii) { const int i = 16 * wid + ii; afr[ii] = bf2f(RawT[i * 192 + 64 + lane]); }
#pragma unroll
        for (int ii = 0; ii < 16; ++ii) { const int i = 16 * wid + ii; float kk;
            { float af = afr[ii]; af = fminf(fmaxf(af, -30.f), 30.f);
                const float e = __expf(-af), sg = __builtin_amdgcn_rcpf(1.0f + e); const float f = lbv + (1.0f - lbv) * sg; const bool ok = i >= i0; kk = ok ? (1.0f - lbv) * e * sg : 0.f; acc += ok ? __log2f(fmaxf(f, 1e-30f)) : 0.f; }
            Ls[i * 64 + lane] = acc; Kr[i * 64 + lane] = kk; } }
    else {
#pragma unroll
        for (int n_ = 0; n_ < 16; ++n_) { const int e = tid - 256 + 256 * n_; const int i = e >> 6, d = e & 63;
            const LAS bf16_t* pr = RawT + i * 192; float q = silu_f(bf2f(pr[d])) * 0.125f, v = bf2f(pr[128 + d]); if (i < i0) { q = 0.f; v = 0.f; }
            Qr[i * 64 + d] = q; VT[d * LDP + i] = f2bf(v); } }
    lds_barrier();
#pragma unroll 2
    for (int n_ = 0; n_ < 8; ++n_) { const int e = tid + 512 * n_; const int i = e >> 6, d = e & 63, I = i >> 4;
        const float T0 = Ls[15 * 64 + d], T1 = Ls[31 * 64 + d], T2 = Ls[47 * 64 + d], T3 = Ls[63 * 64 + d];
        const float Bi = I == 0 ? 0.f : I == 1 ? T0 : I == 2 ? T0 + T1 : T0 + T1 + T2; const float Li = Ls[i * 64 + d], Gi = Bi + Li, Gl = T0 + T1 + T2 + T3;
        const float q = Qr[i * 64 + d], k = Kr[i * 64 + d];
        Qt[i * LDP + d] = f2bf(q * fexp2(Li)); Qh[i * LDP + d] = f2bf(q * fexp2(Gi)); KhT[d * LDP + i] = f2bf(k * fexp2(Gl - Gi));
        float Bp = Bi;
        Kt[((I == 0 ? 0 : I == 1 ? 16 : I == 2 ? 48 : 96) + i) * LDP + d] = f2bf(k * fexp2(Bp - Gi));
        if (I <= 0) { Bp = T0; Kt[(16 + i) * LDP + d] = f2bf(k * fexp2(Bp - Gi)); }
        if (I <= 1) { Bp = T0 + T1; Kt[(48 + i) * LDP + d] = f2bf(k * fexp2(Bp - Gi)); }
        if (I <= 2) { Bp = T0 + T1 + T2; Kt[(96 + i) * LDP + d] = f2bf(k * fexp2(Bp - Gi)); }
        if (i == 0) Av[d] = fexp2(Gl); }
    lds_barrier();
#pragma unroll
    for (int tt = 0; tt < 2; ++tt) { const int t = wid * 2 + tt, I = t >> 2, J = t & 3; f32x4 acc = (f32x4){0.f, 0.f, 0.f, 0.f};
        if (J <= I) { const int kb = (I == 0 ? 0 : I == 1 ? 16 : I == 2 ? 48 : 96) + 16 * J;
#pragma unroll
            for (int s = 0; s < 2; ++s) acc = mfma16(frag_ld(Kt, LDP, kb + fc, 32 * s + 8 * fq), frag_ld(Qt, LDP, 16 * I + fc, 32 * s + 8 * fq), acc); }
        const int i = 16 * I + fc;
#pragma unroll
        for (int r = 0; r < 4; ++r) { const int j = 16 * J + 4 * fq + r; acc[r] = (j <= i) ? acc[r] : 0.f; }
        st_bf4(Ps + i * LDP + 16 * J + 4 * fq, acc); }
    lds_barrier();
    { const int w = wid & 3; bf16x8 bb[2];
#pragma unroll
        for (int s = 0; s < 2; ++s) bb[s] = frag_ld(VT, LDP, 16 * w + fc, 32 * s + 8 * fq);
        const LAS bf16_t* At = wid < 4 ? Ps : KhT; unsigned char* dst = rec + (wid < 4 ? HR_OI : HR_DS);
#pragma unroll
        for (int m = 0; m < 4; ++m) { f32x4 acc = (f32x4){0.f, 0.f, 0.f, 0.f};
#pragma unroll
            for (int s = 0; s < 2; ++s) acc = mfma16(frag_ld(At, LDP, 16 * m + fc, 32 * s + 8 * fq), bb[s], acc);
            st_acc_bf4(dst + ((size_t)(w * 4 + m) * 64 + lane) * 8, acc); }
        *(bf16x8*)(rec + HR_QF + ((size_t)wid * 64 + lane) * 16) = frag_ld_perm(Qh, LDP, 16 * (wid >> 1) + fc, 32 * (wid & 1), fq);
        if (tid < 64) { float* gv = (float*)(rec + HR_VEC); gv[64 + tid] = Av[tid]; } }
}

struct SsdLds { static constexpr int CS = 0, BS = CS + 64 * LDP2 * 2, BT = BS + 64 * LDP2 * 2, XS = BT + 128 * LDP * 2, VT = XS + 64 * LDP2 * 2  , VH = VT + 2 * 64 * LDP * 2, PS = VH + 2 * 64 * LDP * 2  ,
    DT = PS + 67 * 384 * 2  , GV = DT + 512, END = GV + 512; };
constexpr int SSD_NPIECE = 67 * 48;
struct SsRaw { u32x4 raw[7]; float psmv;
    __device__ __forceinline__ void load(const Params& p, int t, int tid) { const int b = t / (NCHUNK * 2), c = (t >> 1) % NCHUNK, gg = t & 1, t0 = 64 * c - 48;
        const bf16_t* projb = (const bf16_t*)(p.ws + WS_PROJ) + (size_t)(b * TP) * NBIG;
#pragma unroll
        for (int k = 0; k < 7; ++k) { const int id = min(tid + 512 * k, SSD_NPIECE - 1), row = id / 48, seg = id % 48, tt = t0 - 3 + row;
            const u32x4 v = *(const u32x4*)(projb + (size_t)max(tt, 0) * NBIG + PC_CXBC + (seg >> 4) * 256 + gg * 128 + (seg & 15) * 8);
            raw[k] = tt >= 0 ? v : (u32x4){0u, 0u, 0u, 0u}; }
        psmv = ((const float*)(p.ws + WS_PSM))[(size_t)(b * TP + max(t0 + (tid & 63), 0)) * NSM + 8 + gg * 2 + ((tid >> 6) & 1)]; }
};
__device__ void ssd_pre_unit(const Params& p, int layer, int t_this, int t_next, SsRaw& RR, LAS unsigned char* lds) {
    const int b = t_this / (NCHUNK * 2), c = (t_this >> 1) % NCHUNK, gg = t_this & 1;
    const int tid = opaque_tid(), wid = tid >> 6, lane = tid & 63, fq = lane >> 4, fc = lane & 15;
    LAS bf16_t* Cs = (LAS bf16_t*)(lds + SsdLds::CS); LAS bf16_t* Bs = (LAS bf16_t*)(lds + SsdLds::BS); LAS bf16_t* BT = (LAS bf16_t*)(lds + SsdLds::BT); LAS bf16_t* Xs = (LAS bf16_t*)(lds + SsdLds::XS);
    LAS bf16_t* VT = (LAS bf16_t*)(lds + SsdLds::VT); LAS bf16_t* VH = (LAS bf16_t*)(lds + SsdLds::VH); LAS bf16_t* Ps = (LAS bf16_t*)(lds + SsdLds::PS); LAS bf16_t* RawT = Ps;
    LAS float* DTv = (LAS float*)(lds + SsdLds::DT); LAS float* Gv = (LAS float*)(lds + SsdLds::GV);
    const bf16_t* projb = (const bf16_t*)(p.ws + WS_PROJ) + (size_t)(b * TP) * NBIG; const float* psmb = (const float*)(p.ws + WS_PSM) + (size_t)(b * TP) * NSM;
    const float* cw = p.ssd_conv_w + (size_t)layer * 4 * 768; const float* cb = p.ssd_conv_b + (size_t)layer * 768;
    constexpr float L2E = 1.4426950408889634f;
    const int hh = wid >> 2, ws = wid & 3;
    const int i0 = c == 0 ? 48 : 0, t0 = 64 * c - 48;
    unsigned char* rec = rec_ssd(p, b, c, gg);
    const float psmv = RR.psmv;
    float cwr[3][5];
#pragma unroll
    for (int n = 0; n < 3; ++n) { const int ch = (tid + 512 * n) % 384, chf = (ch >> 7) * 256 + gg * 128 + (ch & 127);
#pragma unroll
        for (int j = 0; j < 4; ++j) cwr[n][j] = cw[j * 768 + chf];
        cwr[n][4] = cb[chf]; }
    lds_barrier();
    if (wid < 2) { const int hd = gg * 2 + wid;
        float dt = softplus_f(psmv + p.ssd_dt_bias[layer * 4 + hd]); dt = lane >= i0 ? dt : 0.f;
        float G = -dt * __expf(p.ssd_a_log[layer * 4 + hd]) * L2E;
#pragma unroll
        for (int o = 1; o < 64; o <<= 1) { const float t = lane_up(G, o, lane); if (lane >= o) G += t; }
        DTv[wid * 64 + lane] = dt; Gv[wid * 64 + lane] = G; }
#pragma unroll
    for (int k = 0; k < 7; ++k) { const int id = tid + 512 * k; if (id < SSD_NPIECE) *(LAS u32x4*)(RawT + (id / 48) * 384 + (id % 48) * 8) = RR.raw[k]; }
    if (t_next >= 0) RR.load(p, t_next, tid);
    lds_barrier();
#pragma unroll
    for (int n = 0; n < 3; ++n) { const int e = tid + 512 * n, ch = e % 384, tr = e / 384, part = ch >> 7, j = ch & 127;
        const float w0 = cwr[n][0], w1 = cwr[n][1], w2 = cwr[n][2], w3 = cwr[n][3], bias = cwr[n][4];
#pragma unroll
        for (int hf = 0; hf < 2; ++hf) { const int ib = 16 * tr + 8 * hf; float a[8], rw[11];
#pragma unroll
            for (int ii = 0; ii < 11; ++ii) rw[ii] = bf2f(RawT[(ib + ii) * 384 + ch]);
#pragma unroll
            for (int ii = 0; ii < 8; ++ii) { a[ii] = silu_f(bias + w0 * rw[ii] + w1 * rw[ii + 1] + w2 * rw[ii + 2] + w3 * rw[ii + 3]); if (ib + ii < i0) a[ii] = 0.f; }
            if (part == 0) { const int h2 = j >> 6, d = j & 63; const float gl = Gv[h2 * 64 + 63]; float xh[8];
#pragma unroll
                for (int ii = 0; ii < 8; ++ii) { const int i = ib + ii; Xs[i * LDP2 + j] = f2bf(a[ii]); a[ii] *= DTv[h2 * 64 + i]; xh[ii] = a[ii] * fexp2(gl - Gv[h2 * 64 + i]); }
                *(LAS u32x4*)(VT + (h2 * 64 + d) * LDP + ib) = pack_bf8(a); *(LAS u32x4*)(VH + (h2 * 64 + d) * LDP + ib) = pack_bf8(xh); }
            else if (part == 1) {
#pragma unroll
                for (int ii = 0; ii < 8; ++ii) Bs[(ib + ii) * LDP2 + j] = f2bf(a[ii]);
                *(LAS u32x4*)(BT + j * LDP + ib) = pack_bf8(a); }
            else {
#pragma unroll
                for (int ii = 0; ii < 8; ++ii) Cs[(ib + ii) * LDP2 + j] = f2bf(a[ii]); } } }
    lds_barrier();
#pragma unroll
    for (int tt = 0; tt < 2; ++tt) { const int t = wid * 2 + tt, I = t >> 2, J = t & 3; f32x4 acc = (f32x4){0.f, 0.f, 0.f, 0.f};
        if (J <= I) {
#pragma unroll
            for (int s = 0; s < 4; ++s) acc = mfma16(frag_ld(Bs, LDP2, 16 * J + fc, 32 * s + 8 * fq), frag_ld(Cs, LDP2, 16 * I + fc, 32 * s + 8 * fq), acc); }
        const int i = 16 * I + fc;
#pragma unroll
        for (int h2 = 0; h2 < 2; ++h2) { f32x4 pv; const float gi = Gv[h2 * 64 + i];
#pragma unroll
            for (int r = 0; r < 4; ++r) { const int j = 16 * J + 4 * fq + r; pv[r] = (j <= i && j >= i0) ? acc[r] * fexp2(gi - Gv[h2 * 64 + j]) : 0.f; }
            st_bf4(Ps + (h2 * 64 + i) * LDP + 16 * J + 4 * fq, pv); } }
    lds_barrier();
    { bf16x8 bv[2], bh[2]; unsigned char* hrec = rec + SS_HEAD + (size_t)hh * 24576; const float dsk = p.ssd_d[layer * 4 + gg * 2 + hh];
#pragma unroll
        for (int s = 0; s < 2; ++s) { bv[s] = frag_ld(VT, LDP, hh * 64 + 16 * ws + fc, 32 * s + 8 * fq); bh[s] = frag_ld(VH, LDP, hh * 64 + 16 * ws + fc, 32 * s + 8 * fq); }
#pragma unroll
        for (int mi = 0; mi < 4; ++mi) { f32x4 o1 = (f32x4){0.f, 0.f, 0.f, 0.f};
#pragma unroll
            for (int s = 0; s < 2; ++s) o1 = mfma16(frag_ld(Ps, LDP, hh * 64 + 16 * mi + fc, 32 * s + 8 * fq), bv[s], o1);
#pragma unroll
            for (int r = 0; r < 4; ++r) o1[r] += dsk * bf2f(Xs[(16 * mi + 4 * fq + r) * LDP2 + hh * 64 + 16 * ws + fc]);
            st_acc_bf4(hrec + ((size_t)(ws * 4 + mi) * 64 + lane) * 8, o1); }
#pragma unroll
        for (int m = 0; m < 8; ++m) { f32x4 d = (f32x4){0.f, 0.f, 0.f, 0.f};
#pragma unroll
            for (int s = 0; s < 2; ++s) d = mfma16(frag_ld(BT, LDP, 16 * m + fc, 32 * s + 8 * fq), bh[s], d);
            st_acc_bf4(hrec + 8192 + ((size_t)(ws * 8 + m) * 64 + lane) * 8, d); }
#pragma unroll
        for (int x = 0; x < 2; ++x) { const int sl = wid * 2 + x; *(bf16x8*)(rec + SS_QF + ((size_t)sl * 64 + lane) * 16) = frag_ld_perm(Cs, LDP2, 16 * (sl >> 2) + fc, 32 * (sl & 3), fq); }
        if (tid < 128) { float* gv = (float*)(rec + SS_VEC + (size_t)(tid >> 6) * 512); gv[tid & 63] = fexp2(Gv[tid]); if ((tid & 63) == 0) gv[64] = fexp2(Gv[(tid >> 6) * 64 + 63]); } }
}

struct GdLds { static constexpr int QF = 0, KF = 16384, VF = 32768, QN = 49152, KN = QN + 64 * LDP * 2, KNT = KN + 64 * LDP * 2, NM = KNT + 64 * LDP * 2, QK = NM + 64 * LDP * 2, WT = QK + 64 * LDP * 2,
    MD = WT + 64 * LDP * 2  , TD = MD + 4096  , GV = TD + 2048, BV = GV + 256, RAW = BV + 256, END = RAW + 67 * 192 * 2; };
struct GdRaw { Raw192<67> q;
    __device__ __forceinline__ void load(const Params& p, int v, int tid) { int b, c, h; unit_bch(v, b, c, h); const int t0 = 64 * c - 48;
        q.load((const bf16_t*)(p.ws + WS_PROJ) + (size_t)(b * TP) * NBIG, t0 - 3, PC_BQKV + h * 64, PC_BQKV + 256 + h * 64, PC_BQKV + 512 + h * 64, tid);
        const float* ps = (const float*)(p.ws + WS_PSM) + (size_t)(b * TP + max(t0 + (tid & 63), 0)) * NSM; q.sv[0] = ps[h]; q.sv[1] = ps[4 + h]; }
};
__device__ void gdn_pre_unit(const Params& p, int layer, int v_this, int v_next, GdRaw& RR, LAS unsigned char* lds) {
    int b, c, hu; unit_bch(v_this, b, c, hu);
    const int tid = opaque_tid(), wid = tid >> 6, lane = tid & 63, fq = lane >> 4, fc = lane & 15;
    LAS float* Qf = (LAS float*)(lds + GdLds::QF); LAS float* Kf = (LAS float*)(lds + GdLds::KF); LAS float* Vf = (LAS float*)(lds + GdLds::VF);
    LAS bf16_t* Qn = (LAS bf16_t*)(lds + GdLds::QN); LAS bf16_t* Kn = (LAS bf16_t*)(lds + GdLds::KN); LAS bf16_t* KnT = (LAS bf16_t*)(lds + GdLds::KNT);
    LAS bf16_t* NM = (LAS bf16_t*)(lds + GdLds::NM); LAS bf16_t* QK = (LAS bf16_t*)(lds + GdLds::QK); LAS bf16_t* Wt = (LAS bf16_t*)(lds + GdLds::WT);
    LAS float* MD = (LAS float*)(lds + GdLds::MD); LAS bf16_t* TD = (LAS bf16_t*)(lds + GdLds::TD); LAS float* Gv = (LAS float*)(lds + GdLds::GV); LAS float* Bv = (LAS float*)(lds + GdLds::BV);
    LAS bf16_t* RawT = (LAS bf16_t*)(lds + GdLds::RAW);
    const float* cw = p.gdn_conv_w + (size_t)layer * 4 * 768;
    unsigned char* gd = rec_gdn(p, b, c, hu);
    constexpr float L2E = 1.4426950408889634f;
    const int i0 = c == 0 ? 48 : 0;
    const float sva = RR.q.sv[0], svb = RR.q.sv[1];
    float cwr[3][4];
#pragma unroll
    for (int n_ = 0; n_ < 3; ++n_) { const int ch = (tid + 512 * n_) % 192, chf = (ch >> 6) * 256 + hu * 64 + (ch & 63);
#pragma unroll
        for (int j = 0; j < 4; ++j) cwr[n_][j] = cw[j * 768 + chf]; }
    lds_barrier();
    RR.q.to_lds(RawT, tid);
    if (v_next >= 0) RR.load(p, v_next, tid);
    lds_barrier();
    if (wid == 0) {
        float g = -__expf(p.gdn_a_log[layer * 4 + hu]) * softplus_f(sva + p.gdn_dt_bias[layer * 4 + hu]) * L2E, be = sigmoid_f(svb); if (lane < i0) { g = 0.f; be = 0.f; }
#pragma unroll
        for (int o = 1; o < 64; o <<= 1) { const float t = lane_up(g, o, lane); if (lane >= o) g += t; }
        Gv[lane] = g; Bv[lane] = be; }
#pragma unroll
    for (int n_ = 0; n_ < 3; ++n_) { const int e = tid + 512 * n_; const int ch = e % 192, tr = e / 192, part = ch >> 6, d = ch & 63, chf = part * 256 + hu * 64 + d;
        const float w0 = cwr[n_][0], w1 = cwr[n_][1], w2 = cwr[n_][2], w3 = cwr[n_][3];
        float raw[11];
#pragma unroll
        for (int ii = 0; ii < 11; ++ii) raw[ii] = bf2f(RawT[(8 * tr + ii) * 192 + ch]);
        LAS float* dst = part == 0 ? Qf : part == 1 ? Kf : Vf;
#pragma unroll
        for (int ii = 0; ii < 8; ++ii) { const int i = 8 * tr + ii;
            float a = silu_f(w0 * raw[ii] + w1 * raw[ii + 1] + w2 * raw[ii + 2] + w3 * raw[ii + 3]); if (i < i0) a = 0.f;
            dst[i * 64 + d] = a; } }
    lds_barrier();
    { const int ri = tid >> 3, sg = tid & 7; float q[8], k[8], sq = 0.f, sk = 0.f;
#pragma unroll
        for (int x = 0; x < 8; ++x) { q[x] = Qf[ri * 64 + sg * 8 + x]; k[x] = Kf[ri * 64 + sg * 8 + x]; sq += q[x] * q[x]; sk += k[x] * k[x]; }
        sq = sum8(sq); sk = sum8(sk);
        const float rq = rsqrtf(sq + EPSF) * 0.125f, rk = rsqrtf(sk + EPSF);
#pragma unroll
        for (int x = 0; x < 8; ++x) { q[x] *= rq; k[x] *= rk; Kf[ri * 64 + sg * 8 + x] = k[x]; KnT[(sg * 8 + x) * LDP + ri] = f2bf(k[x]); }
        *(LAS u32x4*)(Qn + ri * LDP + sg * 8) = pack_bf8(q); *(LAS u32x4*)(Kn + ri * LDP + sg * 8) = pack_bf8(k); }
    lds_barrier();
#pragma unroll
    for (int tt = 0; tt < 2; ++tt) { const int t = wid * 2 + tt, I = t >> 2, J = t & 3; f32x4 a1 = (f32x4){0.f, 0.f, 0.f, 0.f}, a2 = (f32x4){0.f, 0.f, 0.f, 0.f};
        if (J <= I) {
#pragma unroll
            for (int s = 0; s < 2; ++s) { const bf16x8 kj = frag_ld(Kn, LDP, 16 * J + fc, 32 * s + 8 * fq); a1 = mfma16(kj, frag_ld(Kn, LDP, 16 * I + fc, 32 * s + 8 * fq), a1); a2 = mfma16(kj, frag_ld(Qn, LDP, 16 * I + fc, 32 * s + 8 * fq), a2); } }
        const int i = 16 * I + fc; const float gi = Gv[i], bi = Bv[i]; f32x4 nm, qk;
#pragma unroll
        for (int r = 0; r < 4; ++r) { const int j = 16 * J + 4 * fq + r; const float dec = j <= i ? fexp2(gi - Gv[j]) : 0.f; const float mm = j < i ? a1[r] * dec * bi : 0.f; nm[r] = -mm; qk[r] = a2[r] * dec;
            if (J == I) MD[(I * 16 + fc) * 16 + 4 * fq + r] = mm; }
        st_bf4(NM + i * LDP + 16 * J + 4 * fq, nm); st_bf4(QK + i * LDP + 16 * J + 4 * fq, qk); }
    lds_barrier();
    if (wid < 4) { const int I = wid, cc = lane & 15; float mrow[16], x[16];
#pragma unroll
        for (int i = 0; i < 16; ++i) mrow[i] = MD[(I * 16 + i) * 16 + cc];
#pragma unroll
        for (int i = 0; i < 16; ++i) x[i] = (i == cc) ? 1.0f : 0.0f;
#pragma unroll
        for (int j = 0; j < 16; ++j) {
#pragma unroll
            for (int i = j + 1; i < 16; ++i) x[i] -= __int_as_float(__builtin_amdgcn_readlane(__float_as_int(mrow[i]), j)) * x[j]; }
        if (lane < 16) {
#pragma unroll
            for (int i = 0; i < 16; ++i) TD[(I * 16 + i) * 16 + cc] = f2bf(x[i]); } }
    lds_barrier();
    const int isW = wid >> 2, ws = wid & 3, colx = 16 * ws + fc;
    const LAS float* rhs = isW ? Kf : Vf;
    f32x4 X[4];
    const f32x4 zero4 = (f32x4){0.f, 0.f, 0.f, 0.f};
#pragma unroll
    for (int I = 0; I < 4; ++I) { f32x4 acc;
#pragma unroll
        for (int r = 0; r < 4; ++r) { const int j = 16 * I + 4 * fq + r; const float sc = Bv[j] * (isW ? fexp2(Gv[j]) : 1.0f); acc[r] = sc * rhs[j * 64 + colx]; }
        if (I >= 1) acc = mfma16(frag_ld_perm(NM, LDP, 16 * I + fc, 0, fq), pack_acc2(X[0], I > 1 ? X[1] : zero4), acc);
        if (I == 3) acc = mfma16(frag_ld_perm(NM, LDP, 48 + fc, 32, fq), pack_acc2(X[2], zero4), acc);
        const bf16x4 tlo = *(const LAS bf16x4*)(TD + (I * 16 + fc) * 16 + 4 * fq); const bf16x4 z4 = (bf16x4){0, 0, 0, 0};
        X[I] = mfma16(__builtin_shufflevector(tlo, z4, 0, 1, 2, 3, 4, 5, 6, 7), pack_acc2(acc, zero4), zero4); }
    if (!isW) {
#pragma unroll
        for (int m = 0; m < 4; ++m) st_acc_bf4(gd + GD_U + ((size_t)(ws * 4 + m) * 64 + lane) * 8, X[m]); }
    else {
#pragma unroll
        for (int m = 0; m < 4; ++m)
#pragma unroll
            for (int r = 0; r < 4; ++r) Wt[(16 * m + 4 * fq + r) * LDP + colx] = f2bf(-X[m][r]); }
    lds_barrier();
    { const int tsel = wid >> 1; const LAS bf16_t* tile = tsel == 0 ? Wt : tsel == 1 ? Qn : tsel == 2 ? QK : KnT; unsigned char* dst = gd + (tsel == 0 ? GD_W : tsel == 1 ? GD_Q : tsel == 2 ? GD_P : GD_K);
#pragma unroll
        for (int x = 0; x < 4; ++x) { const int sl = (wid & 1) * 4 + x, m = sl >> 1, s = sl & 1; bf16x8 f = frag_ld_perm(tile, LDP, 16 * m + fc, 32 * s, fq);
            if (tsel == 1) { const float eg = fexp2(Gv[16 * m + fc]); const float sc[8] = {eg, eg, eg, eg, eg, eg, eg, eg}; f = frag_scale(f, sc); }
            if (tsel == 3) { float sc[8];
#pragma unroll
                for (int e = 0; e < 8; ++e) sc[e] = fexp2(Gv[63] - Gv[32 * s + 16 * (e >> 2) + 4 * fq + (e & 3)]);
                f = frag_scale(f, sc); }
            *(bf16x8*)(dst + ((size_t)sl * 64 + lane) * 16) = f; } }
    if (tid == 0) { float* gv = (float*)(gd + GD_VEC); gv[128] = fexp2(Gv[63]); }
}

template <int MIX> struct SeqRegs {
    static constexpr int DK = MIX == 2 ? 128 : 64, NT = DK / 16;
    u32x2 oi[4]; u32x2 ds[MIX == 1 ? 1 : NT]; f32x4 eg[MIX == 2 ? 4 : 1]; f32x4 al[MIX == 0 ? 4 : 1];
    __device__ __forceinline__ void load(const Params& p, int b, int c, int hd, int ws, int lane, int fq) {
        const unsigned char* base = MIX == 2 ? rec_ssd(p, b, c, hd >> 1) : MIX == 0 ? rec_hgrn(p, b, c, hd) : MIX == 1 ? rec_gdn(p, b, c, hd) : rec_ret(p, b, c, hd);
        const unsigned char* o = MIX == 2 ? base + SS_HEAD + (size_t)(hd & 1) * 24576 : MIX == 1 ? base + GD_U : base + HR_OI;
        const unsigned char* d = MIX == 2 ? o + 8192 : base + HR_DS; const float* gv = (const float*)(MIX == 2 ? base + SS_VEC + (size_t)(hd & 1) * 512 : MIX == 1 ? base + GD_VEC : base + HR_VEC);
#pragma unroll
        for (int mi = 0; mi < 4; ++mi) { oi[mi] = *(const u32x2*)(o + ((size_t)(ws * 4 + mi) * 64 + lane) * 8); if (MIX == 2) eg[mi] = *(const f32x4*)(gv + 16 * mi + 4 * fq); }
        if (MIX != 1) {
#pragma unroll
            for (int m = 0; m < NT; ++m) ds[m] = *(const u32x2*)(d + ((size_t)(ws * NT + m) * 64 + lane) * 8); }
#pragma unroll
        for (int m = 0; m < (MIX == 0 ? 4 : 1); ++m) al[m] = MIX == 0 ? *(const f32x4*)(gv + 64 + 16 * m + 4 * fq) : (f32x4){gv[MIX == 1 ? 128 : 64], 0.f, 0.f, 0.f};
    }
};
__device__ __forceinline__ f32x4 unpack_acc(const u32x2& w) { return (f32x4){__uint_as_float(w.x << 16), __uint_as_float(w.x & 0xffff0000u), __uint_as_float(w.y << 16), __uint_as_float(w.y & 0xffff0000u)}; }
template <int MIX>
__device__ void seq_item(const Params& p, int layer, int b_in, int hd_in, LAS unsigned char* lds) {
    constexpr int DK = MIX == 2 ? 128 : 64, NT = DK / 16, NS = DK / 32;
    constexpr int NFS = MIX == 2 ? 16 : MIX == 1 ? 32 : 8, FPW = NFS / 2;
    constexpr int YC = MIX == 0 ? 0 : MIX == 1 ? 256 : MIX == 2 ? 512 : 768;
    const int b = __builtin_amdgcn_readfirstlane(b_in), hd = __builtin_amdgcn_readfirstlane(hd_in);
    const int tid = opaque_tid(), wid = __builtin_amdgcn_readfirstlane(tid >> 6), lane = tid & 63, fq = lane >> 4, fc = lane & 15;
    const int ws = wid & 3; const bool cw = wid < 4, lw = wid == 4 || wid == 5, sw = wid >= 6;
    const int fs0 = (wid & 1) * FPW;
    LAS unsigned char* FS = lds;
    LAS float* Os = (LAS float*)(lds + 65536);
    bf16_t* yb = (bf16_t*)(p.ws + WS_Y) + (size_t)(b * TP) * DM + YC + hd * 64;
    auto store_rows = [&](int c) {
        const int i0 = c == 0 ? 48 : 0, t0 = 64 * c - 48, ri = (wid - 6) * 32 + (lane >> 1), hf = lane & 1; const LAS float* src = Os + (c & 1) * 64 * OSP + ri * OSP + hf * 32;
        float o[32];
#pragma unroll
        for (int k4 = 0; k4 < 8; ++k4) { const f32x4 v = *(const LAS f32x4*)(src + 4 * k4); o[4 * k4] = v[0]; o[4 * k4 + 1] = v[1]; o[4 * k4 + 2] = v[2]; o[4 * k4 + 3] = v[3]; }
        if (ri >= i0) { u32x4* dst = (u32x4*)(yb + (size_t)(t0 + ri) * DM + hf * 32);
#pragma unroll
            for (int k8 = 0; k8 < 4; ++k8) dst[k8] = pack_bf8(o + 8 * k8); } };
    auto fbase = [&](int c) -> const unsigned char* { return MIX == 2 ? rec_ssd(p, b, c, hd >> 1) + SS_QF : MIX == 1 ? rec_gdn(p, b, c, hd) + GD_W : (MIX == 0 ? rec_hgrn(p, b, c, hd) : rec_ret(p, b, c, hd)) + HR_QF; };
    f32x4 S[NT];
#pragma unroll
    for (int m = 0; m < NT; ++m) S[m] = (f32x4){0.f, 0.f, 0.f, 0.f};
    const f32x4 zero4 = (f32x4){0.f, 0.f, 0.f, 0.f};
    SeqRegs<MIX> R0, R1; bf16x8 fr[FPW], fr2[FPW];
    if (cw) { R0.load(p, b, 0, hd, ws, lane, fq); R1.load(p, b, 1, hd, ws, lane, fq); }
    else if (lw) { const unsigned char* f0 = fbase(0); const unsigned char* f1 = fbase(1); const unsigned char* f2 = fbase(2);
#pragma unroll
        for (int x = 0; x < FPW; ++x) fr2[x] = *(const bf16x8*)(f0 + ((size_t)(fs0 + x) * 64 + lane) * 16);
#pragma unroll
        for (int x = 0; x < FPW; ++x) fr[x] = *(const bf16x8*)(f1 + ((size_t)(fs0 + x) * 64 + lane) * 16);
#pragma unroll
        for (int x = 0; x < FPW; ++x) *(LAS bf16x8*)(FS + ((size_t)(fs0 + x) * 64 + lane) * 16) = fr2[x];
#pragma unroll
        for (int x = 0; x < FPW; ++x) fr2[x] = *(const bf16x8*)(f2 + ((size_t)(fs0 + x) * 64 + lane) * 16); }
    lds_barrier();
    if (cw) {
        auto step = [&](const int c, SeqRegs<MIX>& R) __attribute__((always_inline)) {
            LAS float* Ob = Os + (c & 1) * 64 * OSP + 16 * ws + fc;
            const LAS unsigned char* Fc = FS + (size_t)((c & 1) * NFS) * 1024 + lane * 16;

            bf16x8 Sb[NS];
#pragma unroll
            for (int s = 0; s < NS; ++s) Sb[s] = pack_acc2(S[2 * s], S[2 * s + 1]);
            if (MIX == 1) {
                bf16x8 ub[2]; f32x4 u[4];
#pragma unroll
                for (int m = 0; m < 4; ++m) { u[m] = unpack_acc(R.oi[m]);
#pragma unroll
                    for (int s = 0; s < 2; ++s) u[m] = mfma16(*(const LAS bf16x8*)(Fc + (m * 2 + s) * 1024), Sb[s], u[m]); }
#pragma unroll
                for (int s = 0; s < 2; ++s) ub[s] = pack_acc2(u[2 * s], u[2 * s + 1]);
#pragma unroll
                for (int mi = 0; mi < 4; ++mi) { f32x4 o = zero4;
#pragma unroll
                    for (int s = 0; s < 2; ++s) { o = mfma16(*(const LAS bf16x8*)(Fc + (16 + mi * 2 + s) * 1024), ub[s], o); o = mfma16(*(const LAS bf16x8*)(Fc + (8 + mi * 2 + s) * 1024), Sb[s], o); }
#pragma unroll
                    for (int r = 0; r < 4; ++r) Ob[(16 * mi + 4 * fq + r) * OSP] = o[r]; }
                const float al = R.al[0][0];
#pragma unroll
                for (int m = 0; m < 4; ++m) { S[m] = S[m] * al;
#pragma unroll
                    for (int s = 0; s < 2; ++s) S[m] = mfma16(*(const LAS bf16x8*)(Fc + (24 + m * 2 + s) * 1024), ub[s], S[m]); }
            } else {
#pragma unroll
                for (int mi = 0; mi < 4; ++mi) { f32x4 o2 = zero4;
#pragma unroll
                    for (int s = 0; s < NS; ++s) o2 = mfma16(*(const LAS bf16x8*)(Fc + (mi * NS + s) * 1024), Sb[s], o2);
                    const f32x4 o1 = unpack_acc(R.oi[mi]);
#pragma unroll
                    for (int r = 0; r < 4; ++r) Ob[(16 * mi + 4 * fq + r) * OSP] = o1[r] + (MIX == 2 ? R.eg[MIX == 2 ? mi : 0][r] : 1.0f) * o2[r]; }
#pragma unroll
                for (int m = 0; m < NT; ++m) { const f32x4 d = unpack_acc(R.ds[MIX == 1 ? 0 : m]);
#pragma unroll
                    for (int r = 0; r < 4; ++r) S[m][r] = (MIX == 0 ? R.al[MIX == 0 ? (m & 3) : 0][r] : R.al[0][0]) * S[m][r] + d[r]; }
            }
            R.load(p, b, min(c + 2, NCHUNK - 1), hd, ws, lane, fq);
            lds_barrier();
        };
        for (int c = 0; c < NCHUNK; c += 2) { step(c, R0); if (c + 1 < NCHUNK) step(c + 1, R1); }
    } else if (lw) {
        auto lstep = [&](const int c, bf16x8 (&f)[FPW]) __attribute__((always_inline)) {
            const unsigned char* f3 = fbase(min(c + 3, NCHUNK - 1));
#pragma unroll
            for (int x = 0; x < FPW; ++x) *(LAS bf16x8*)(FS + ((size_t)(((c + 1) & 1) * NFS + fs0 + x) * 64 + lane) * 16) = f[x];
#pragma unroll
            for (int x = 0; x < FPW; ++x) f[x] = *(const bf16x8*)(f3 + ((size_t)(fs0 + x) * 64 + lane) * 16);
            lds_barrier(); };
        for (int c = 0; c < NCHUNK; c += 2) { lstep(c, fr); if (c + 1 < NCHUNK) lstep(c + 1, fr2); }
    } else {
        for (int c = 0; c < NCHUNK; ++c) { if (c > 0) store_rows(c - 1); lds_barrier(); }
        store_rows(NCHUNK - 1);
    }
    if (cw) { float* so = p.out + (MIX == 0 ? O_HGRN_P : MIX == 1 ? O_GDN_P : MIX == 2 ? O_SSD_P : O_RET_P) + (((size_t)layer * NB + b) * 4 + hd) * (DK * 64);
#pragma unroll
        for (int m = 0; m < NT; ++m)
#pragma unroll
            for (int r = 0; r < 4; ++r) so[(16 * m + 4 * fq + r) * 64 + 16 * ws + fc] = S[m][r]; }
    if (MIX == 1 || (MIX == 2 && (hd & 1) == 0)) { const bf16_t* projb = (const bf16_t*)(p.ws + WS_PROJ) + (size_t)(b * TP) * NBIG;
        float* co = p.out + (MIX == 1 ? O_GCONV_P : O_SCONV_P) + ((size_t)layer * NB + b) * 3 * 768; constexpr int NC = MIX == 1 ? 192 : 384;
        for (int e = tid; e < 3 * NC; e += 512) { const int r = e / NC, ch = e % NC, chf = MIX == 1 ? (ch >> 6) * 256 + hd * 64 + (ch & 63) : (ch >> 7) * 256 + (hd >> 1) * 128 + (ch & 127);
            co[r * 768 + chf] = bf2f(projb[(size_t)(TP - 3 + r) * NBIG + (MIX == 1 ? PC_BQKV : PC_CXBC) + chf]); } }
}

__device__ void ph_post(const Params& p_in, int layer, int blk, int nblk) {
    Params p = p_in; asm volatile("" : "+s"(p.ws), "+s"(p.out));
    const int tid = opaque_tid(), wid = tid >> 6, lane = tid & 63;
    const bf16_t* proj = (const bf16_t*)(p.ws + WS_PROJ); bf16_t* y = (bf16_t*)(p.ws + WS_Y);
    for (int t = blk * 8 + wid; t < MP * 2; t += nblk * 8) { const int row = t >> 1, half = t & 1, ch = half * 512 + lane * 8;
        const int kind = half * 2 + (lane >> 5), cl = (lane & 31) * 8;
        const u32x4 ow = *(const u32x4*)(y + (size_t)row * DM + ch);
        const u32x4 zw = *(const u32x4*)(proj + (size_t)row * NBIG + (kind == 0 ? PC_AZ : kind == 1 ? PC_BZ : kind == 2 ? PC_CZ : PC_DZ) + cl);
        const float* nwp = (kind == 0 ? p.hgrn_norm_w : kind == 1 ? p.gdn_norm_w : kind == 2 ? p.ssd_norm_w : p.ret_norm_w) + layer * 256 + cl;
        const f32x4 w0 = *(const f32x4*)nwp, w1 = *(const f32x4*)(nwp + 4);
        float o[8], z[8]; unpack_bf8(ow, o); unpack_bf8(zw, z);
        const float nw[8] = {w0[0], w0[1], w0[2], w0[3], w1[0], w1[1], w1[2], w1[3]};
        if (kind == 2) {
            float q = 0.f;
#pragma unroll
            for (int k = 0; k < 8; ++k) { o[k] *= silu_f(z[k]); q += o[k] * o[k]; }
            q = sum16(q);
            const float rstd = rsqrtf(q * (1.0f / 128.0f) + EPSF);
#pragma unroll
            for (int k = 0; k < 8; ++k) o[k] *= rstd * nw[k];
        } else if (kind == 3) {
            const float* nbp = p.ret_norm_b + layer * 256 + cl; const f32x4 b0 = *(const f32x4*)nbp, b1 = *(const f32x4*)(nbp + 4); const float nb[8] = {b0[0], b0[1], b0[2], b0[3], b1[0], b1[1], b1[2], b1[3]};
            float s = 0.f;
#pragma unroll
            for (int k = 0; k < 8; ++k) s += o[k];
            s = sum8(s); const float mu = s * (1.0f / 64.0f); float q = 0.f;
#pragma unroll
            for (int k = 0; k < 8; ++k) { o[k] -= mu; q += o[k] * o[k]; }
            q = sum8(q); const float rstd = rsqrtf(q * (1.0f / 64.0f) + EPSF);
#pragma unroll
            for (int k = 0; k < 8; ++k) o[k] = (o[k] * rstd * nw[k] + nb[k]) * silu_f(z[k]);
        } else {
            float q = 0.f;
#pragma unroll
            for (int k = 0; k < 8; ++k) q += o[k] * o[k];
            q = sum8(q); const float rstd = rsqrtf(q * (1.0f / 64.0f) + EPSF);
#pragma unroll
            for (int k = 0; k < 8; ++k) o[k] = o[k] * rstd * nw[k] * silu_f(z[k]);
        }
        *(u32x4*)(y + (size_t)row * DM + ch) = pack_bf8(o);
    }
}

constexpr int N_MU = 14;
__device__ void ph_pre(const Params& p_in, int layer, LAS unsigned char* lds_in, int blk, int nblk) {
    Params p = p_in; asm volatile("" : "+s"(p.ws), "+s"(p.out));
    LAS unsigned char* lds = lds_in; asm volatile("" : "+s"(lds));
    const int tid = opaque_tid();
    convert_weights(p, layer + 1 < DEPTH ? layer + 1 : -1, layer, (LAS float*)lds, tid, blk, nblk);
    { GdRaw R; int v = blk; if (v < NB * NCHUNK * 4) R.load(p, v, tid);
        for (; v < NB * NCHUNK * 4; v += nblk) gdn_pre_unit(p, layer, v, v + nblk < NB * NCHUNK * 4 ? v + nblk : -1, R, lds); }
    { SsRaw R; int t = (blk + 224) % nblk; if (t < NB * NCHUNK * 2) R.load(p, t, tid);
        for (; t < NB * NCHUNK * 2; t += nblk) ssd_pre_unit(p, layer, t, t + nblk < NB * NCHUNK * 2 ? t + nblk : -1, R, lds); }
    { HgRaw R; int v = (blk + 192) % nblk; if (v < NB * NCHUNK * 4) R.load(p, v, tid);
        for (; v < NB * NCHUNK * 4; v += nblk) hgrn_pre_unit(p, layer, v, v + nblk < NB * NCHUNK * 4 ? v + nblk : -1, R, lds); }
    { RetRaw R; int v = (blk + 160) % nblk; if (v < NB * NCHUNK * 4) R.load(p, v, tid);
        for (; v < NB * NCHUNK * 4; v += nblk) ret_pre_unit(p, layer, v, v + nblk < NB * NCHUNK * 4 ? v + nblk : -1, R, lds); }
}
__device__ void ph_seq(const Params& p_in, int layer, LAS unsigned char* lds_in, int blk, int nblk) {
    Params p = p_in; asm volatile("" : "+s"(p.ws), "+s"(p.out));
    LAS unsigned char* lds = lds_in; asm volatile("" : "+s"(lds));
    LAS float* L = (LAS float*)lds;
    if (blk < 128) { const int b = blk >> 4, k = blk & 15;
#ifndef REP_SQ
#define REP_SQ 1
#endif
        for (int rep = 0; rep < REP_SQ; ++rep)
        if (k < 4) seq_item<2>(p, layer, b, k, lds); else if (k < 8) seq_item<1>(p, layer, b, k - 4, lds); else if (k < 12) seq_item<0>(p, layer, b, k - 8, lds); else seq_item<3>(p, layer, b, k - 12, lds); }
    else for (int d = blk - 128; d < DECB * N_MU; d += nblk - 128) { const int s = NB + d / N_MU, mu = d % N_MU;
#ifndef REP_DEC2
#define REP_DEC2 1
#endif
        for (int rep = 0; rep < REP_DEC2; ++rep)
        if (mu < 4) mixer_item<0>(p, layer, s, mu, L); else if (mu < 8) mixer_item<1>(p, layer, s, mu - 4, L); else if (mu < 10) mixer_item<2>(p, layer, s, mu - 8, L); else mixer_item<3>(p, layer, s, mu - 10, L); }
}

__device__ void ph_final(const Params& p_in, LAS unsigned char* lds_in, int blk, int nblk) {
    Params p = p_in; asm volatile("" : "+s"(p.ws), "+s"(p.out));
    LAS unsigned char* lds = lds_in; asm volatile("" : "+s"(lds));
    if (blk < 4) out_tail(p, DEPTH - 1, lds, blk);

    const int tid = opaque_tid(), wid = tid >> 6, lane = tid & 63;
    const float* h = (const float*)(p.ws + WS_H);
    for (int pass = 0; pass < 2; ++pass) {
    if (pass == 1) flag_wait((unsigned*)(p.ws + WS_BAR) + FLAG_WORD0 + 2 * (DEPTH - 1), 4u, (unsigned*)(p.ws + WS_BAR));
    const int r_lo = pass == 0 ? (blk >= 4 ? (blk - 4) * 8 + wid : MMAIN) : MMAIN + blk * 8 + wid, r_hi = pass == 0 ? MMAIN : MROWS, r_st = (pass == 0 ? nblk - 4 : nblk) * 8;
    for (int row = r_lo; row < r_hi; row += r_st) {
        float* dst;
        if (row < MP) { const int b = row / TP, t = row % TP; if (t < NMETA) continue; dst = p.out + O_YP + ((size_t)b * SEQ + (t - NMETA)) * DM; } else dst = p.out + O_YS + (size_t)(row - MP) * DM;
        f32x4 v[4]; float ss = 0.f;
#pragma unroll
        for (int j = 0; j < 4; ++j) { v[j] = *(const f32x4*)(h + (size_t)row * DM + j * 256 + lane * 4); ss += v[j][0] * v[j][0] + v[j][1] * v[j][1] + v[j][2] * v[j][2] + v[j][3] * v[j][3]; }
        const float r = rsqrtf(wave_sum(ss, lane) * (1.0f / DM) + EPSF);
#pragma unroll
        for (int j = 0; j < 4; ++j) { const f32x4 w = *(const f32x4*)(p.final_norm_w + j * 256 + lane * 4); *(f32x4*)(dst + j * 256 + lane * 4) = v[j] * r * w; }
    }
    }
}

constexpr int LDS_STAGE = 160 * 1024 - 256;
constexpr int LDS_BYTES = LDS_STAGE + 16;
static_assert(MixLds::END * 4 <= LDS_STAGE && RetLds::END <= LDS_STAGE && SsdLds::END <= LDS_STAGE && 2 * 64 * LDP * 2 <= SsdLds::DT - SsdLds::PS && HgLds::END <= LDS_STAGE && GdLds::END <= LDS_STAGE && pg8::STAGE_BYTES <= LDS_STAGE && 65536 + 2 * 64 * OSP * 4 <= LDS_STAGE, "LDS carve");

__global__ void __launch_bounds__(512, 2) k_mega(Params p) {
    extern __shared__ __attribute__((aligned(16))) unsigned char smem[];
    LAS unsigned char* lds = (LAS unsigned char*)smem;
    const int blk = blockIdx.x, nblk = gridDim.x;
    volatile LAS unsigned* xbw = (volatile LAS unsigned*)(lds + LDS_STAGE);
    if (threadIdx.x < 4) xbw[threadIdx.x] = 0u;
    __syncthreads();
    XcdBarrier xb = xcd_barrier_post((unsigned*)(p.ws + WS_BAR), xbw);
#ifndef REP_PREP
#define REP_PREP 1
#endif
#ifndef REP_ROWNORM
#define REP_ROWNORM 1
#endif
#ifndef REP_GEMMIN
#define REP_GEMMIN 1
#endif
#ifndef REP_GDNPRE
#define REP_GDNPRE 1
#endif
#ifndef REP_MIXER
#define REP_MIXER 1
#endif
    for (int r = 0; r < REP_PREP; ++r) { ph_prep(p, lds, blk, nblk); if (r + 1 < REP_PREP) xcd_barrier(xb); }
    cooperative_groups::this_grid().sync();
    xcd_barrier(xb);
#pragma unroll 1
    for (int l = 0; l < DEPTH; ++l) {
        for (int r = 0; r < REP_ROWNORM; ++r) { ph_rownorm(p, l, lds, blk, nblk); xcd_barrier(xb); }
        for (int r = 0; r < REP_GEMMIN; ++r) { ph_gemm_in(p, l, lds, blk, nblk); xcd_barrier(xb); }
#ifndef REP_A
#define REP_A 1
#define REP_B 1
#endif
        for (int r = 0; r < REP_A; ++r) { ph_pre(p, l, lds, blk, nblk); xcd_barrier(xb); }
        for (int r = 0; r < REP_B; ++r) { ph_seq(p, l, lds, blk, nblk); xcd_barrier(xb); }
        ph_post(p, l, blk, nblk); xcd_barrier(xb);
        ph_gemm_out(p, l, lds, blk, nblk);
        xcd_barrier(xb);
    }
    ph_final(p, lds, blk, nblk);
}

extern "C" void kernel_launch(void* const* d_in, const int* in_sizes, int n_in, void* d_out, int out_size, void* d_ws, size_t ws_size, hipStream_t stream) {
    static int grid = 0;
    if (grid == 0) {
        if (n_in != 27 || (size_t)out_size != O_END || ws_size < WS_END) { fprintf(stderr, "kernel_launch: unexpected shapes: n_in %d out %d (want %zu) ws %zu (want %zu)\n", n_in, out_size, (size_t)O_END, ws_size, (size_t)WS_END); grid = -1; return; }
        if (hipFuncSetAttribute((const void*)k_mega, hipFuncAttributeMaxDynamicSharedMemorySize, LDS_BYTES) != hipSuccess) { fprintf(stderr, "kernel_launch: hipFuncSetAttribute failed\n"); grid = -1; return; }
        int dev = 0, cus = 0, per_cu = 0;
        if (hipGetDevice(&dev) != hipSuccess || hipDeviceGetAttribute(&cus, hipDeviceAttributeMultiprocessorCount, dev) != hipSuccess) { fprintf(stderr, "kernel_launch: device query failed\n"); grid = -1; return; }
        if (hipOccupancyMaxActiveBlocksPerMultiprocessor(&per_cu, (const void*)k_mega, 512, LDS_BYTES) != hipSuccess || per_cu < 1) { fprintf(stderr, "kernel_launch: occupancy query says %d blocks per CU\n", per_cu); grid = -1; return; }
        grid = cus;
    }
    if (grid < 0) return;
    Params p{};
    const float** pp = (const float**)&p;
    for (int i = 0; i < 27; ++i) pp[i] = (const float*)d_in[i];
    p.out = (float*)d_out; p.ws = (unsigned char*)d_ws;
    (void)hipMemsetAsync((unsigned char*)d_ws + WS_BAR, 0, 16384, stream);
    void* args[] = {&p};
    const hipError_t e = hipLaunchCooperativeKernel((const void*)k_mega, dim3(grid), dim3(512), args, LDS_BYTES, stream);
    if (e != hipSuccess) fprintf(stderr, "kernel_launch: cooperative launch failed: %s (grid %d)\n", hipGetErrorString(e), grid);
}
```

```cpp
#include <hip/hip_runtime.h>
#include <hip/hip_cooperative_groups.h>
#include <cstdio>
#include <cstdint>

#define LAS __attribute__((address_space(3)))
typedef unsigned short bf16_t;
typedef short bf16x8 __attribute__((ext_vector_type(8)));
typedef float f32x4 __attribute__((ext_vector_type(4)));
typedef unsigned u32x4 __attribute__((ext_vector_type(4)));
typedef unsigned u32x2 __attribute__((ext_vector_type(2)));

constexpr int DM = 1024, NB = 8, SEQ = 2048, DEPTH = 4, DECB = 128, NMETA = 16, TP = SEQ + NMETA;
constexpr int MP = NB * TP;
constexpr int MROWS = MP + DECB;
constexpr int IN_DIM = 4108, NBIG = 4096, NSM = 12;
constexpr int PASTLEN = 16384;
constexpr float EPSF = 1e-6f;
constexpr int PC_AQ = 0, PC_AF = 256, PC_AI = 512, PC_AZ = 768, PC_BQKV = 1024, PC_BZ = 1792, PC_CXBC = 2048, PC_CZ = 2816, PC_DQ = 3072, PC_DK = 3328, PC_DV = 3584, PC_DZ = 3840;

constexpr size_t WS_BAR = 0;
constexpr size_t WS_WINT = 16384;
constexpr size_t WS_WOUTT = WS_WINT + (size_t)NBIG * DM * 2;
constexpr size_t WS_WSM = WS_WOUTT + (size_t)DM * DM * 2;
constexpr size_t WS_LB = WS_WSM + (size_t)DEPTH * NSM * DM * 4;
constexpr size_t WS_ROT = WS_LB + (size_t)DEPTH * 256 * 4;
constexpr size_t ROT_BYTES = ((size_t)(TP + 1) * 64 * 4 + 255) / 256 * 256;
constexpr size_t WS_H = WS_ROT + ROT_BYTES;
constexpr size_t WS_HB = WS_H + (size_t)MROWS * DM * 4;
constexpr size_t WS_RS = WS_HB + (size_t)MROWS * DM * 2;
constexpr size_t WS_PSM = WS_RS + (size_t)MROWS * 4;
constexpr size_t WS_PROJ = WS_PSM + (size_t)MROWS * NSM * 4;
constexpr size_t WS_Y = WS_PROJ + (size_t)MROWS * NBIG * 2;
constexpr size_t WS_E = WS_Y + (size_t)MROWS * DM * 2;
constexpr size_t WS_END = WS_E + (size_t)NB * 33 * 4 * 41728;

constexpr size_t O_YP = 0;
constexpr size_t O_YS = O_YP + (size_t)NB * SEQ * DM;
constexpr size_t O_HGRN_P = O_YS + (size_t)DECB * DM;
constexpr size_t O_GDN_P = O_HGRN_P + (size_t)DEPTH * NB * 4 * 64 * 64;
constexpr size_t O_GCONV_P = O_GDN_P + (size_t)DEPTH * NB * 4 * 64 * 64;
constexpr size_t O_SSD_P = O_GCONV_P + (size_t)DEPTH * NB * 3 * 768;
constexpr size_t O_SCONV_P = O_SSD_P + (size_t)DEPTH * NB * 4 * 128 * 64;
constexpr size_t O_RET_P = O_SCONV_P + (size_t)DEPTH * NB * 3 * 768;
constexpr size_t O_HGRN_S = O_RET_P + (size_t)DEPTH * NB * 4 * 64 * 64;
constexpr size_t O_GDN_S = O_HGRN_S + (size_t)DEPTH * DECB * 4 * 64 * 64;
constexpr size_t O_GCONV_S = O_GDN_S + (size_t)DEPTH * DECB * 4 * 64 * 64;
constexpr size_t O_SSD_S = O_GCONV_S + (size_t)DEPTH * DECB * 3 * 768;
constexpr size_t O_SCONV_S = O_SSD_S + (size_t)DEPTH * DECB * 4 * 128 * 64;
constexpr size_t O_RET_S = O_SCONV_S + (size_t)DEPTH * DECB * 3 * 768;
constexpr size_t O_END = O_RET_S + (size_t)DEPTH * DECB * 4 * 64 * 64;

struct Params {
    const float* x_prompt; const float* x_sample;
    const float* st_hgrn; const float* st_gdn; const float* st_gconv; const float* st_ssd; const float* st_sconv; const float* st_ret;
    const float* meta; const float* norm_w; const float* w_in; const float* lb_logits; const float* hgrn_norm_w;
    const float* gdn_conv_w; const float* gdn_a_log; const float* gdn_dt_bias; const float* gdn_norm_w;
    const float* ssd_conv_w; const float* ssd_conv_b; const float* ssd_a_log; const float* ssd_dt_bias; const float* ssd_d; const float* ssd_norm_w;
    const float* ret_norm_w; const float* ret_norm_b; const float* w_out; const float* final_norm_w;
    float* out; unsigned char* ws;
};
__device__ __forceinline__ void phase_bases(Params& p);


__device__ __forceinline__ float bf2f(bf16_t b) { return __uint_as_float(((unsigned)b) << 16); }
__device__ __forceinline__ bf16_t f2bf(float f) { unsigned u = __float_as_uint(f); u += 0x7FFFu + ((u >> 16) & 1u); return (bf16_t)(u >> 16); }
__device__ __forceinline__ unsigned pack_bf2(float lo, float hi) { return (unsigned)f2bf(lo) | ((unsigned)f2bf(hi) << 16); }
__device__ __forceinline__ float sigmoid_f(float x) { return __builtin_amdgcn_rcpf(1.0f + __expf(-x)); }
__device__ __forceinline__ float silu_f(float x) { return x * __builtin_amdgcn_rcpf(1.0f + __expf(-x)); }
__device__ __forceinline__ float softplus_f(float x) { return x > 20.0f ? x : log1pf(__expf(x)); }
__device__ __forceinline__ void lds_barrier() { asm volatile("s_waitcnt lgkmcnt(0)" ::: "memory"); __builtin_amdgcn_s_barrier(); asm volatile("" ::: "memory"); }
__device__ __forceinline__ unsigned long long opaque_u64(unsigned long long v) { unsigned lo = (unsigned)v, hi = (unsigned)(v >> 32); asm volatile("" : "+v"(lo), "+v"(hi));
    lo = __builtin_amdgcn_readfirstlane(lo); hi = __builtin_amdgcn_readfirstlane(hi); return ((unsigned long long)hi << 32) | lo; }
__device__ __forceinline__ unsigned opaque_u32(unsigned v) { asm volatile("" : "+v"(v)); return __builtin_amdgcn_readfirstlane(v); }
constexpr int LDS_BASES = 160 * 1024 - 256 + 32;
__device__ __forceinline__ unsigned long long ld_base(int k) { const volatile LAS unsigned* q = (const volatile LAS unsigned*)(unsigned long)(LDS_BASES + 8 * k);
    const unsigned lo = __builtin_amdgcn_readfirstlane(q[0]), hi = __builtin_amdgcn_readfirstlane(q[1]); return ((unsigned long long)hi << 32) | lo; }
__device__ __forceinline__ void phase_bases(Params& p) { p.ws = (unsigned char*)ld_base(0); p.out = (float*)ld_base(1); }
__device__ __forceinline__ int opaque_tid() { int t = threadIdx.x; asm volatile("" : "+v"(t)); return t; }
__device__ __forceinline__ float lane_xor(float v, int k, int lane) { return __int_as_float(__builtin_amdgcn_ds_bpermute((lane ^ k) << 2, __float_as_int(v))); }
__device__ __forceinline__ float lane_up(float v, int k, int lane) { return __int_as_float(__builtin_amdgcn_ds_bpermute(((lane - k) & 63) << 2, __float_as_int(v))); }
template <int CTRL> __device__ __forceinline__ float dpp_mov(float v) { return __int_as_float(__builtin_amdgcn_update_dpp(0, __float_as_int(v), CTRL, 0xf, 0xf, true)); }
__device__ __forceinline__ float sum4(float v) { v += dpp_mov<0xB1>(v); v += dpp_mov<0x4E>(v); return v; }
__device__ __forceinline__ float sum8(float v) { v = sum4(v); v += dpp_mov<0x141>(v); return v; }
__device__ __forceinline__ float sum16(float v) { v = sum8(v); v += dpp_mov<0x140>(v); return v; }
__device__ __forceinline__ float wave_sum(float v, int lane) { v = sum16(v); v += lane_xor(v, 16, lane); v += lane_xor(v, 32, lane); return v; }


#define XB_TMO      128
#define XB_XCNT(j)  (256  + 64 * (j))
#define XB_XSUB(j)  (1280 + 64 * (j))
#define XB_XGEN(j)  (2304 + 64 * (j))
#define XB_TOP      3328
#define XB_TOPGEN   3392
#define XCD_BAR_WORDS 3456
#define XB_SPIN_CAP (1u << 22)
__device__ __forceinline__ unsigned xb_ld(unsigned* p)              { return __hip_atomic_load(p, __ATOMIC_RELAXED, __HIP_MEMORY_SCOPE_AGENT); }
__device__ __forceinline__ unsigned xb_add(unsigned* p, unsigned v) { return __hip_atomic_fetch_add(p, v, __ATOMIC_RELAXED, __HIP_MEMORY_SCOPE_AGENT); }
__device__ __forceinline__ unsigned xb_xcc_id() { return (unsigned)__builtin_amdgcn_s_getreg((3 << 11) | 20) & 0xFu; }
#define XB_SPIN(cond, bar) do { unsigned _sp = 0; while (cond) { __builtin_amdgcn_s_sleep(1); \
    if ((++_sp & 255u) == 0u) { if (xb_ld(&(bar)[XB_TMO])) break; if (_sp > XB_SPIN_CAP) { atomicAdd(&(bar)[XB_TMO], 1u); break; } } } } while (0)
struct XcdBarrier { unsigned* bar; unsigned x; volatile LAS unsigned* st; };
__device__ __forceinline__ XcdBarrier xcd_barrier_post(unsigned* bar, volatile LAS unsigned* st) {
    XcdBarrier b; b.bar = bar; b.x = xb_xcc_id(); b.st = st;
    if (threadIdx.x == 0) (void)xb_add(&bar[XB_XCNT(b.x)], 1u);
    return b;
}
__device__ __forceinline__ void xcd_barrier_complete(unsigned* bar, unsigned x, unsigned& nloc, unsigned& nx) {
    const unsigned G = gridDim.x * gridDim.y * gridDim.z;
    unsigned sum, cnt, mine, sp = 0u;
    for (;;) {
        sum = 0u; cnt = 0u; mine = 0u;
#pragma unroll
        for (unsigned j = 0; j < 16; ++j) { const unsigned c = xb_ld(&bar[XB_XCNT(j)]); sum += c; cnt += (c > 0u) ? 1u : 0u; mine = (j == x) ? c : mine; }
        if (sum == G) break;
        __builtin_amdgcn_s_sleep(1);
        if ((++sp & 255u) == 0u) { if (xb_ld(&bar[XB_TMO])) break; if (sp > XB_SPIN_CAP) { atomicAdd(&bar[XB_TMO], 1u); break; } }
    }
    nloc = mine > 0u ? mine : 1u; nx = cnt > 0u ? cnt : 1u;
}
__device__ __forceinline__ void xcd_barrier(const XcdBarrier& b0) {
    asm volatile("s_waitcnt vmcnt(0)" ::: "memory");
    __syncthreads();
    if (threadIdx.x == 0) {
        XcdBarrier b = b0; { unsigned x = xb_xcc_id(); asm volatile("" : "+s"(x)); b.x = x; }
        unsigned* bar = b.bar;
        __builtin_amdgcn_s_waitcnt(0);
        unsigned nloc = b.st[0], nx = b.st[1];
        if (nloc == 0u) { xcd_barrier_complete(bar, b.x, nloc, nx); b.st[0] = nloc; b.st[1] = nx; }
        const unsigned old = xb_add(&bar[XB_XSUB(b.x)], 1u);
        const unsigned gen = old / nloc;
        if (old + 1u == (gen + 1u) * nloc) {
            __builtin_amdgcn_fence(__ATOMIC_RELEASE, "agent");
            asm volatile("s_waitcnt vmcnt(0)" ::: "memory");
            const unsigned og = xb_add(&bar[XB_TOP], 1u);
            const unsigned tg = og / nx;
            if (og + 1u == (tg + 1u) * nx) xb_add(&bar[XB_TOPGEN], 1u);
            else XB_SPIN(xb_ld(&bar[XB_TOPGEN]) == tg, bar);
            __builtin_amdgcn_fence(__ATOMIC_ACQUIRE, "agent");
            xb_add(&bar[XB_XGEN(b.x)], 1u);
            asm volatile("s_waitcnt vmcnt(0)" ::: "memory");
        } else {
            XB_SPIN(xb_ld(&bar[XB_XGEN(b.x)]) == gen, bar);
            __builtin_amdgcn_fence(__ATOMIC_ACQUIRE, "agent");
            asm volatile("s_waitcnt vmcnt(0)" ::: "memory");
        }
    }
    __syncthreads();
}

constexpr int FLAG_WORD0 = 3600;
__device__ __forceinline__ void flag_publish(unsigned* flag) {
    asm volatile("s_waitcnt vmcnt(0)" ::: "memory"); __syncthreads();
    if (threadIdx.x == 0) { __builtin_amdgcn_fence(__ATOMIC_RELEASE, "agent"); asm volatile("s_waitcnt vmcnt(0)" ::: "memory"); (void)xb_add(flag, 1u); }
}
__device__ __forceinline__ void flag_wait(unsigned* flag, unsigned target, unsigned* bar) {
    if (threadIdx.x == 0) { XB_SPIN(xb_ld(flag) < target, bar); __builtin_amdgcn_fence(__ATOMIC_ACQUIRE, "agent"); asm volatile("s_waitcnt vmcnt(0)" ::: "memory"); }
    __syncthreads();
}

namespace pg8 {
constexpr int BM = 256, BK = 64, HALF = 128, HTB = HALF * BK * 2, STAGE_BYTES = 8 * HTB, NXCD = 8, WGM = 8;
__host__ __device__ __forceinline__ int lds_byte(int r, int c) { const int st = (r >> 4) * 2 + (c >> 5), rr = r & 15, cc = c & 31, ob = rr * 64 + cc * 2; return st * 1024 + (ob ^ (((ob >> 9) & 1) << 5)); }
__host__ __device__ __forceinline__ void stage_rc(int b, int& R, int& C) { const int st = b / 1024, sb = b % 1024, swz = sb ^ (((sb >> 9) & 1) << 5); R = (st >> 1) * 16 + swz / 64; C = (st & 1) * 32 + (swz % 64) / 2; }
__host__ __device__ __forceinline__ int perm32(int rho) { const int n = rho >> 4, i = rho & 15; return 8 * (i >> 2) + 4 * n + (i & 3); }
struct Unit { int pm, pn; };
struct Gemm { const bf16_t* A; const bf16_t* Bt; int M, N, K; };
struct StaticOrder {
    int nM, nN, nwg, G, c;
    __host__ __device__ void init(int M, int N, int G_, int c_) { nM = M / BM; nN = N / BM; nwg = nM * nN; G = G_; c = c_; }
    __host__ __device__ bool next(int i, Unit& u) const {
        const long L = (long)i * G + c; if (L >= nwg) return false;
        int wgid = (int)L; { const int q = nwg / NXCD, r = nwg % NXCD, xcd = wgid % NXCD, off = wgid / NXCD; wgid = (xcd < r ? xcd * (q + 1) : r * (q + 1) + (xcd - r) * q) + off; }
        const int nig = WGM * nN, gid = wgid / nig, fm = gid * WGM, gsz = (nM - fm) < WGM ? (nM - fm) : WGM;
        u.pm = fm + ((wgid % nig) % gsz); u.pn = (wgid % nig) / gsz; return true;
    }
    __device__ __forceinline__ void a_ready(const Unit&) const {}
    __device__ __forceinline__ void done(const Unit&) const {}
};
typedef float f32x2_t __attribute__((ext_vector_type(2)));
typedef __bf16 bf16x2n_t __attribute__((ext_vector_type(2)));
struct OneUnit { int pm, pn;
    __device__ __forceinline__ bool next(int i, Unit& u) const { if (i) return false; u.pm = pm; u.pn = pn; return true; }
    __device__ __forceinline__ void a_ready(const Unit&) const {}
    __device__ __forceinline__ void done(const Unit&) const {}
};
__device__ __forceinline__ unsigned cvt_pk_bf16(float lo, float hi) { const f32x2_t f = {lo, hi}; return __builtin_bit_cast(unsigned, __builtin_convertvector(f, bf16x2n_t)); }

struct EpiProj {
    static constexpr bool PERM = true, AFTER_DRAIN = false;
    bf16_t* O; int ldc; const float* rs;
    __device__ __forceinline__ void operator()(const f32x4 (&acc)[2][2][4][2], const Unit& u, int wr, int wc, int fr, int fq) const {
        const int row0 = u.pm * BM + wr * 64 + fr; const int col0 = u.pn * BM + wc * 32 + 8 * fq;
#pragma unroll
        for (int ai = 0; ai < 2; ++ai)
#pragma unroll
            for (int m = 0; m < 4; ++m) { const int row = row0 + ai * HALF + m * 16; const float s = rs[row]; bf16_t* rowp = O + (size_t)row * ldc + col0;
#pragma unroll
                for (int bj = 0; bj < 2; ++bj) { const f32x4 v0 = acc[ai][bj][m][0] * s, v1 = acc[ai][bj][m][1] * s;
                    u32x4 w; w.x = cvt_pk_bf16(v0[0], v0[1]); w.y = cvt_pk_bf16(v0[2], v0[3]); w.z = cvt_pk_bf16(v1[0], v1[1]); w.w = cvt_pk_bf16(v1[2], v1[3]);
                    *(u32x4*)(rowp + bj * HALF) = w; } }
    }
};
struct EpiResid {
    static constexpr bool PERM = false, AFTER_DRAIN = false;
    float* C; int ldc;
    __device__ __forceinline__ void operator()(const f32x4 (&acc)[2][2][4][2], const Unit& u, int wr, int wc, int fr, int fq) const {
        const int row0 = u.pm * BM + wr * 64 + fr, col0 = u.pn * BM + wc * 32 + 4 * fq;
#pragma unroll
        for (int ai = 0; ai < 2; ++ai)
#pragma unroll
            for (int m = 0; m < 4; ++m) { float* rowp = C + (size_t)(row0 + ai * HALF + m * 16) * ldc + col0;
#pragma unroll
                for (int bj = 0; bj < 2; ++bj)
#pragma unroll
                    for (int n = 0; n < 2; ++n) { f32x4* p = (f32x4*)(rowp + bj * HALF + n * 16); *p = *p + acc[ai][bj][m][n]; } }
    }
};

template <class Epi, class Sched>
__device__ __forceinline__ void gemm_phase(LAS unsigned char* lds, const Gemm g, const Sched& S, const Epi& E) {
    const int tid = opaque_tid(), wid = __builtin_amdgcn_readfirstlane(tid >> 6), lane = tid & 63, wr = wid >> 2, wc = wid & 3, fr = lane & 15, fq = lane >> 4;
    const int K = g.K, nt = K / BK;
    unsigned voffA[2], voffB[2];
#pragma unroll
    for (int i = 0; i < 2; ++i) { int R, C; stage_rc(tid * 16 + i * 8192, R, C); const int Rb = Epi::PERM ? ((R & ~31) + perm32(R & 31)) : R;
        voffA[i] = (unsigned)(R * K + C) * 2u; voffB[i] = (unsigned)(Rb * K + C) * 2u; }
    const size_t kstep = (size_t)(BK * 2);
    const size_t hstep = (size_t)HALF * K * 2;
    const size_t tstep = 2 * hstep;
    const unsigned ldsw = (unsigned)wid * 1024u;
    const int aoff = lds_byte(wr * 64 + fr, fq * 8), boff = lds_byte(wc * 32 + fr, fq * 8);
#define PG8_SA(b, h) (((b) * 2 + (h)) * HTB)
#define PG8_SB(b, h) ((4 + (b) * 2 + (h)) * HTB)
#define PG8_STAGE(bufoff, gbase, voff) do { _Pragma("unroll") for (int _i = 0; _i < 2; ++_i) \
        __builtin_amdgcn_global_load_lds((const unsigned*)((const char*)(gbase) + (voff)[_i]), (LAS unsigned*)(lds + (bufoff) + ldsw + _i * 8192), 16, 0, 0); } while (0)
#define PG8_LDA(dst, b, h) do { _Pragma("unroll") for (int m = 0; m < 4; ++m) _Pragma("unroll") for (int k = 0; k < 2; ++k) dst[m][k] = *(const LAS bf16x8*)(lds + PG8_SA(b, h) + aoff + m * 2048 + k * 1024); } while (0)
#define PG8_LDB(dst, b, h) do { _Pragma("unroll") for (int n = 0; n < 2; ++n) _Pragma("unroll") for (int k = 0; k < 2; ++k) dst[n][k] = *(const LAS bf16x8*)(lds + PG8_SB(b, h) + boff + n * 2048 + k * 1024); } while (0)
#define PG8_MMA(ai, bj, At, Bt) do { __builtin_amdgcn_s_setprio(1); _Pragma("unroll") for (int m = 0; m < 4; ++m) _Pragma("unroll") for (int n = 0; n < 2; ++n) _Pragma("unroll") for (int k = 0; k < 2; ++k) \
        acc[ai][bj][m][n] = __builtin_amdgcn_mfma_f32_16x16x32_bf16(Bt[n][k], At[m][k], acc[ai][bj][m][n], 0, 0, 0); __builtin_amdgcn_s_setprio(0); } while (0)
#define PG8_WAIT_V(n) asm volatile("s_waitcnt vmcnt(" #n ")" ::: "memory")
#define PG8_WAIT_L(n) asm volatile("s_waitcnt lgkmcnt(" #n ")" ::: "memory")
#define PG8_BAR __builtin_amdgcn_s_barrier()
#define PG8_SCHED __builtin_amdgcn_sched_barrier(0)
    Unit cur, nxt; int ui = 0;
    if (!S.next(0, cur)) return;
    f32x4 acc[2][2][4][2];
#pragma unroll
    for (int a = 0; a < 2; ++a)
#pragma unroll
        for (int b = 0; b < 2; ++b)
#pragma unroll
            for (int m = 0; m < 4; ++m)
#pragma unroll
                for (int n = 0; n < 2; ++n) acc[a][b][m][n] = (f32x4){0.f, 0.f, 0.f, 0.f};
    bf16x8 At[4][2], B0[2][2], B1[2][2];
    const char* cA = (const char*)g.A + (size_t)cur.pm * tstep; const char* cB = (const char*)g.Bt + (size_t)cur.pn * tstep;
    S.a_ready(cur);
    PG8_STAGE(PG8_SB(0, 0), cB, voffB); PG8_STAGE(PG8_SA(0, 0), cA, voffA); PG8_STAGE(PG8_SB(0, 1), cB + hstep, voffB); PG8_STAGE(PG8_SA(0, 1), cA + hstep, voffA);
    if (wr == 1) PG8_BAR;
    PG8_WAIT_V(4); PG8_BAR;
    PG8_STAGE(PG8_SB(1, 0), cB + kstep, voffB); PG8_STAGE(PG8_SA(1, 0), cA + kstep, voffA); PG8_STAGE(PG8_SB(1, 1), cB + hstep + kstep, voffB);
    PG8_WAIT_V(6); PG8_BAR;
    for (;;) {
        const bool has_next = S.next(ui + 1, nxt);
        const char* nA = has_next ? (const char*)g.A + (size_t)nxt.pm * tstep : cA; const char* nB = has_next ? (const char*)g.Bt + (size_t)nxt.pn * tstep : cB;
        for (int t = 0; t < nt; t += 2) {
            const bool last = (t == nt - 2);
            const char* a1 = cA + (size_t)(t + 1) * kstep;
            const char* a2 = last ? nA : cA + (size_t)(t + 2) * kstep; const char* b2 = last ? nB : cB + (size_t)(t + 2) * kstep;
            const char* a3 = a2 + kstep; const char* b3 = b2 + kstep;
            if (last && has_next) S.a_ready(nxt);
            PG8_LDB(B0, 0, 0); PG8_SCHED; PG8_LDA(At, 0, 0); PG8_STAGE(PG8_SA(1, 1), a1 + hstep, voffA);
            PG8_WAIT_L(8); PG8_BAR; PG8_WAIT_L(0); PG8_MMA(0, 0, At, B0); PG8_BAR; PG8_SCHED;
            PG8_LDB(B1, 0, 1); PG8_STAGE(PG8_SB(0, 0), b2, voffB);
            PG8_BAR; PG8_WAIT_L(0); PG8_MMA(0, 1, At, B1); PG8_BAR;
            PG8_LDA(At, 0, 1); PG8_STAGE(PG8_SA(0, 0), a2, voffA);
            PG8_BAR; PG8_WAIT_L(0); PG8_MMA(1, 0, At, B0); PG8_BAR; PG8_SCHED;
            PG8_STAGE(PG8_SB(0, 1), b2 + hstep, voffB);
            PG8_WAIT_V(6); PG8_BAR; PG8_MMA(1, 1, At, B1); PG8_BAR;
            PG8_LDB(B0, 1, 0); PG8_SCHED; PG8_LDA(At, 1, 0); PG8_STAGE(PG8_SA(0, 1), a2 + hstep, voffA);
            PG8_WAIT_L(8); PG8_BAR; PG8_WAIT_L(0); PG8_MMA(0, 0, At, B0); PG8_BAR; PG8_SCHED;
            PG8_LDB(B1, 1, 1); PG8_STAGE(PG8_SB(1, 0), b3, voffB);
            PG8_BAR; PG8_WAIT_L(0); PG8_MMA(0, 1, At, B1); PG8_BAR;
            PG8_LDA(At, 1, 1); PG8_STAGE(PG8_SA(1, 0), a3, voffA);
            PG8_BAR; PG8_WAIT_L(0); PG8_MMA(1, 0, At, B0); PG8_BAR; PG8_SCHED;
            PG8_STAGE(PG8_SB(1, 1), b3 + hstep, voffB);
            PG8_WAIT_V(6); PG8_BAR; PG8_MMA(1, 1, At, B1); PG8_BAR;
        }
        if constexpr (!Epi::AFTER_DRAIN) { E(acc, cur, wr, wc, fr, fq); S.done(cur); }
        if (!has_next) break;
#pragma unroll
        for (int a = 0; a < 2; ++a)
#pragma unroll
            for (int b = 0; b < 2; ++b)
#pragma unroll
                for (int m = 0; m < 4; ++m)
#pragma unroll
                    for (int n = 0; n < 2; ++n) acc[a][b][m][n] = (f32x4){0.f, 0.f, 0.f, 0.f};
        cur = nxt; cA = nA; cB = nB; ++ui;
    }
    PG8_WAIT_V(0);
    if (wr == 0) PG8_BAR;
    PG8_BAR;
#undef PG8_SA
#undef PG8_SB
#undef PG8_STAGE
#undef PG8_LDA
#undef PG8_LDB
#undef PG8_MMA
#undef PG8_WAIT_V
#undef PG8_WAIT_L
#undef PG8_BAR
#undef PG8_SCHED
}
}

__device__ __forceinline__ int win_col(int n) { return n < 2048 ? n : (n < 3072 ? n + 8 : n + 12); }
__device__ __forceinline__ int win_smcol(int j) { return j < 8 ? 2048 + j : 3080 + (j - 8); }

__device__ __forceinline__ void convert_weights(const Params& p, int l_in, int l_out, LAS float* tile  , int tid, int blk, int nblk) {
    const int tiles_in = l_in >= 0 ? 64 * 16 : 0, tiles_out = l_out >= 0 ? 16 * 16 : 0;
    for (int t = blk; t < tiles_in + tiles_out; t += nblk) {
        const float* src; bf16_t* dst; int ld, n0, k0; const float* scale;
        if (t < tiles_in) { n0 = (t / 16) * 64; k0 = (t % 16) * 64; src = p.w_in + (size_t)l_in * DM * IN_DIM + win_col(n0); ld = IN_DIM; dst = (bf16_t*)(p.ws + WS_WINT); scale = p.norm_w + l_in * DM; }
        else { const int r = t - tiles_in; n0 = (r / 16) * 64; k0 = (r % 16) * 64; src = p.w_out + (size_t)l_out * DM * DM + n0; ld = DM; dst = (bf16_t*)(p.ws + WS_WOUTT); scale = nullptr; }
        __syncthreads();
#pragma unroll
        for (int n_ = 0; n_ < 8; ++n_) { const int e = tid + 512 * n_; const int kk = e >> 6, nn = e & 63; float v = src[(size_t)(k0 + kk) * ld + nn]; if (scale) v *= scale[k0 + kk]; tile[kk * 65 + nn] = v; }
        __syncthreads();
#pragma unroll
        for (int n_ = 0; n_ < 4; ++n_) { const int e = tid + 512 * n_; const int nn = e >> 5, kp = (e & 31) * 2; const unsigned w = pack_bf2(tile[kp * 65 + nn], tile[(kp + 1) * 65 + nn]);
            *(unsigned*)(dst + (size_t)(n0 + nn) * DM + k0 + kp) = w; }
    }
    __syncthreads();
}

__device__ __forceinline__ void ph_prep(const Params& p_in, LAS unsigned char* lds_in, int blk, int nblk) {
    Params p = p_in; p.ws = (unsigned char*)ld_base(0); p.out = (float*)ld_base(1);
    LAS unsigned char* lds = (LAS unsigned char*)opaque_u32((unsigned)(unsigned long)lds_in);

    const int tid = opaque_tid();
    LAS float* tile = (LAS float*)lds;
    convert_weights(p, 0, 0, tile, tid, blk, nblk);
    for (int e = blk * 512 + tid; e < DEPTH * NSM * DM; e += nblk * 512) { const int l = e / (NSM * DM), r = e % (NSM * DM), j = r / DM, k = r % DM;
        ((float*)(p.ws + WS_WSM))[e] = p.w_in[(size_t)l * DM * IN_DIM + (size_t)k * IN_DIM + win_smcol(j)] * p.norm_w[l * DM + k]; }
    for (int c = blk * 512 + tid; c < 256; c += nblk * 512) { float lg[DEPTH], mx = -1e30f;
#pragma unroll
        for (int l = 0; l < DEPTH; ++l) { lg[l] = p.lb_logits[l * 256 + c]; mx = fmaxf(mx, lg[l]); }
        float s = 0.f;
#pragma unroll
        for (int l = 0; l < DEPTH; ++l) { lg[l] = expf(lg[l] - mx); s += lg[l]; }
        float cum = 0.f; const float w0 = lg[0] / s;
#pragma unroll
        for (int l = 0; l < DEPTH; ++l) { cum += lg[l] / s; ((float*)(p.ws + WS_LB))[l * 256 + c] = fmaxf(cum - w0, 0.f); } }
    for (int e = blk * 512 + tid; e < (TP + 1) * 32; e += nblk * 512) { const int pi = e >> 5, i = e & 31; const double pos = pi < TP ? (double)pi : (double)PASTLEN;
        const float invf = (float)(1.0 / pow(10000.0, (double)((float)i / 31.0f)));
        const double rev = pos * (double)invf * 0.15915494309189535; const float fr = (float)(rev - rint(rev));
        ((float*)(p.ws + WS_ROT))[e * 2 + 0] = __builtin_amdgcn_cosf(fr); ((float*)(p.ws + WS_ROT))[e * 2 + 1] = __builtin_amdgcn_sinf(fr); }
    float* h = (float*)(p.ws + WS_H);
    for (int e = blk * 512 + tid; e < MROWS * (DM / 4); e += nblk * 512) { const int row = e >> 8, c4 = (e & 255) * 4; const float* src;
        if (row < MP) { const int b = row / TP, t = row % TP; src = t < NMETA ? p.meta + t * DM : p.x_prompt + ((size_t)b * SEQ + (t - NMETA)) * DM; } else src = p.x_sample + (size_t)(row - MP) * DM;
        *(f32x4*)(h + (size_t)row * DM + c4) = *(const f32x4*)(src + c4); }
}

constexpr int MMAIN = 16384;
__device__ __forceinline__ void out_tail(const Params& p, int layer, LAS unsigned char* lds, int blk) {
    pg8::Gemm g{(const bf16_t*)(p.ws + WS_Y), (const bf16_t*)(p.ws + WS_WOUTT), MROWS, DM, DM};
    pg8::OneUnit S{MMAIN / 256, blk};
    pg8::EpiResid E{(float*)(p.ws + WS_H), DM};
    pg8::gemm_phase<pg8::EpiResid, pg8::OneUnit>(lds, g, S, E);
    flag_publish((unsigned*)(p.ws + WS_BAR) + FLAG_WORD0 + 2 * layer);
}
__device__ __forceinline__ void ph_rownorm(const Params& p_in, int layer, LAS unsigned char* lds_in, int blk, int nblk) {
    Params p = p_in; p.ws = (unsigned char*)ld_base(0); p.out = (float*)ld_base(1);
    LAS unsigned char* lds = (LAS unsigned char*)opaque_u32((unsigned)(unsigned long)lds_in);
    const bool has_tail = layer > 0;
    if (has_tail && blk < 4) out_tail(p, layer - 1, lds, blk);

    const int tid = opaque_tid(), wid = tid >> 6, lane = tid & 63;
    const float* h = (const float*)(p.ws + WS_H); bf16_t* hb = (bf16_t*)(p.ws + WS_HB); float* rs = (float*)(p.ws + WS_RS); float* psm = (float*)(p.ws + WS_PSM);
    const float* wsm = (const float*)(p.ws + WS_WSM) + (size_t)layer * NSM * DM;
    for (int pass = 0; pass < 2; ++pass) {
    if (pass == 1 && has_tail) flag_wait((unsigned*)(p.ws + WS_BAR) + FLAG_WORD0 + 2 * (layer - 1), 4u, (unsigned*)(p.ws + WS_BAR));
    const int nb0 = has_tail ? nblk - 4 : nblk, b0 = has_tail ? blk - 4 : blk;
    const int r_lo = pass == 0 ? (b0 >= 0 ? b0 * 8 + wid : MMAIN) : MMAIN + blk * 8 + wid, r_hi = pass == 0 ? MMAIN : MROWS, r_st = (pass == 0 ? nb0 : nblk) * 8;
    for (int row = r_lo; row < r_hi; row += r_st) {
        f32x4 v[4]; float ss = 0.f;
#pragma unroll
        for (int j = 0; j < 4; ++j) { v[j] = *(const f32x4*)(h + (size_t)row * DM + j * 256 + lane * 4); ss += v[j][0] * v[j][0] + v[j][1] * v[j][1] + v[j][2] * v[j][2] + v[j][3] * v[j][3]; }
        ss = wave_sum(ss, lane); const float r = rsqrtf(ss * (1.0f / DM) + EPSF);
#pragma unroll
        for (int j = 0; j < 4; ++j) { u32x2 w; w.x = pack_bf2(v[j][0], v[j][1]); w.y = pack_bf2(v[j][2], v[j][3]); *(u32x2*)(hb + (size_t)row * DM + j * 256 + lane * 4) = w; }
        float mine = 0.f;
        for (int q = 0; q < NSM; ++q) { float d = 0.f;
#pragma unroll
            for (int j = 0; j < 4; ++j) { const f32x4 w = *(const f32x4*)(wsm + q * DM + j * 256 + lane * 4); d += v[j][0] * w[0] + v[j][1] * w[1] + v[j][2] * w[2] + v[j][3] * w[3]; }
            d = wave_sum(d, lane); if (lane == q) mine = d * r; }
        if (lane < NSM) psm[(size_t)row * NSM + lane] = mine;
        if (lane == 0) rs[row] = r;
    }
    }
}

__device__ __forceinline__ void ph_gemm_in(const Params& p_in, int layer, LAS unsigned char* lds_in, int blk, int nblk) {
    Params p = p_in; p.ws = (unsigned char*)ld_base(0); p.out = (float*)ld_base(1);
    LAS unsigned char* lds = (LAS unsigned char*)opaque_u32((unsigned)(unsigned long)lds_in);

    pg8::Gemm g{(const bf16_t*)(p.ws + WS_HB), (const bf16_t*)(p.ws + WS_WINT), MMAIN, NBIG, DM};
    pg8::StaticOrder S; S.init(MMAIN, NBIG, nblk, blk);
    pg8::EpiProj E{(bf16_t*)(p.ws + WS_PROJ), NBIG, (const float*)(p.ws + WS_RS)};
    pg8::gemm_phase<pg8::EpiProj, pg8::StaticOrder>(lds, g, S, E);
}
__device__ __forceinline__ void ph_gemm_out(const Params& p_in, int layer, LAS unsigned char* lds_in, int blk, int nblk) {
    Params p = p_in; p.ws = (unsigned char*)ld_base(0); p.out = (float*)ld_base(1);
    LAS unsigned char* lds = (LAS unsigned char*)opaque_u32((unsigned)(unsigned long)lds_in);

    pg8::Gemm g{(const bf16_t*)(p.ws + WS_Y), (const bf16_t*)(p.ws + WS_WOUTT), MMAIN, DM, DM};
    pg8::StaticOrder S; S.init(MMAIN, DM, nblk, blk);
    pg8::EpiResid E{(float*)(p.ws + WS_H), DM};
    pg8::gemm_phase<pg8::EpiResid, pg8::StaticOrder>(lds, g, S, E);
}

constexpr int TB = 16;
struct MixLds {
    static constexpr int QS = 0, KS = QS + TB * 128, VS = KS + TB * 128, DS = VS + TB * 128, ZS = DS + TB * 128, XS = ZS + TB * 128, OS = XS + TB * 128, BS = OS + TB * 128, SC = BS + TB * 2, END = SC + TB * 2;
};

struct SeqInfo { int row0, T, dec, b; };
__device__ __forceinline__ SeqInfo seq_info(int s) { SeqInfo q; if (s < NB) { q.row0 = s * TP; q.T = TP; q.dec = 0; q.b = s; } else { q.row0 = MP + (s - NB); q.T = 1; q.dec = 1; q.b = s - NB; } return q; }

__device__ __forceinline__ float preconv(const bf16_t* proj, const SeqInfo& q, int t, int col, const float* ctx  , int ch) {
    if (t >= 0) return bf2f(proj[(size_t)(q.row0 + t) * NBIG + col]);
    return ctx ? ctx[(3 + t) * 768 + ch] : 0.f;
}

template <int DK, int NV, bool DELTA, bool VECDEC>
__device__ __forceinline__ void recur_batch(float (&S)[DK / (64 / NV)], LAS float* L, int nb, int wid, int lane) {
    constexpr int KQ = 64 / NV, KR = DK / KQ, DVT = 8 * NV;
    const int kq = lane / NV, vv = lane % NV, vcol = wid * NV + vv, hh = vcol >> 6;
    for (int t = 0; t < nb; ++t) {
        float kk[KR], qq[KR];
#pragma unroll
        for (int i = 0; i < KR; ++i) { kk[i] = L[MixLds::KS + t * 128 + kq * KR + i]; qq[i] = L[MixLds::QS + t * 128 + kq * KR + i]; }
        const float v = L[MixLds::VS + t * 128 + vcol];
        if (DELTA) {
            const float dec = L[MixLds::DS + t * 128 + hh]; float pk = 0.f;
#pragma unroll
            for (int i = 0; i < KR; ++i) { S[i] *= dec; pk += kk[i] * S[i]; }
#pragma unroll
            for (int o = NV; o < 64; o <<= 1) pk += lane_xor(pk, o, lane);
            const float u = L[MixLds::BS + t] * (v - pk);
#pragma unroll
            for (int i = 0; i < KR; ++i) S[i] += kk[i] * u;
        } else if (VECDEC) {
#pragma unroll
            for (int i = 0; i < KR; ++i) S[i] = L[MixLds::DS + t * 128 + kq * KR + i] * S[i] + kk[i] * v;
        } else {
            const float dec = L[MixLds::DS + t * 128 + hh];
#pragma unroll
            for (int i = 0; i < KR; ++i) S[i] = dec * S[i] + kk[i] * v;
        }
        float po = 0.f;
#pragma unroll
        for (int i = 0; i < KR; ++i) po += qq[i] * S[i];
#pragma unroll
        for (int o = NV; o < 64; o <<= 1) po += lane_xor(po, o, lane);
        if (kq == 0) L[MixLds::OS + t * 128 + vcol] = po;
    }
    (void)DVT;
}

template <int MIX>
__device__ __forceinline__ void mixer_item(const Params& p, int layer, int s, int hu  , LAS float* L) {
    constexpr int DK = MIX == 2 ? 128 : 64, NV = MIX == 2 ? 16 : 8, KQ = 64 / NV, KR = DK / KQ, DVT = 8 * NV;
    const int tid = opaque_tid(), wid = tid >> 6, lane = tid & 63;
    const SeqInfo q = seq_info(s);
    const bf16_t* proj = (const bf16_t*)(p.ws + WS_PROJ); const float* psm = (const float*)(p.ws + WS_PSM); bf16_t* y = (bf16_t*)(p.ws + WS_Y);
    const float* lb = (const float*)(p.ws + WS_LB) + layer * 256; const float* rot = (const float*)(p.ws + WS_ROT);
    const int kq = lane / NV, vv = lane % NV, vcol = wid * NV + vv, hh = vcol >> 6;
    const int head = MIX == 2 ? hu * 2 + hh : hu;
    const float* ctx = nullptr; const float* cw = nullptr;
    if (MIX == 1) { cw = p.gdn_conv_w + (size_t)layer * 4 * 768; if (q.dec) ctx = p.st_gconv + ((size_t)layer * DECB + q.b) * 3 * 768; }
    if (MIX == 2) { cw = p.ssd_conv_w + (size_t)layer * 4 * 768; if (q.dec) ctx = p.st_sconv + ((size_t)layer * DECB + q.b) * 3 * 768; }
    float S[KR];
    {
        const float* st = MIX == 0 ? p.st_hgrn : MIX == 1 ? p.st_gdn : MIX == 2 ? p.st_ssd : p.st_ret;
#pragma unroll
        for (int i = 0; i < KR; ++i) S[i] = q.dec ? st[(((size_t)layer * DECB + q.b) * 4 + head) * DK * 64 + (size_t)(kq * KR + i) * 64 + (vcol & 63)] : 0.f;
    }
    float hc0 = 0.f, hc1 = 0.f;
    if (MIX == 1) { hc0 = -__expf(p.gdn_a_log[layer * 4 + hu]); hc1 = p.gdn_dt_bias[layer * 4 + hu]; }
    if (MIX == 3) { hc0 = 1.0f - exp2f(-5.0f - (float)hu); }

    for (int t0 = 0; t0 < q.T; t0 += TB) {
        const int nb = min(TB, q.T - t0);
        __syncthreads();
        if (MIX == 0) {
            for (int e = tid; e < nb * 64; e += 512) { const int t = e >> 6, d = e & 63, c = hu * 64 + d; const bf16_t* pr = proj + (size_t)(q.row0 + t0 + t) * NBIG;
                const float aq = bf2f(pr[PC_AQ + c]), af = bf2f(pr[PC_AF + c]), ai = bf2f(pr[PC_AI + c]), az = bf2f(pr[PC_AZ + c]), l_ = lb[c];
                L[MixLds::QS + t * 128 + d] = silu_f(aq) * 0.125f; L[MixLds::KS + t * 128 + d] = (1.0f - l_) * sigmoid_f(-af); L[MixLds::DS + t * 128 + d] = l_ + (1.0f - l_) * sigmoid_f(af);
                L[MixLds::VS + t * 128 + d] = ai; L[MixLds::ZS + t * 128 + d] = az; }
        } else if (MIX == 1) {
            for (int e = tid; e < nb * 192; e += 512) { const int t = e / 192, r = e % 192, part = r >> 6, d = r & 63, ch = part * 256 + hu * 64 + d, col = PC_BQKV + ch; const int tt = t0 + t;
                float a = 0.f;
#pragma unroll
                for (int j = 0; j < 4; ++j) a += cw[j * 768 + ch] * preconv(proj, q, tt - 3 + j, col, ctx, ch);
                a = silu_f(a);
                L[(part == 0 ? MixLds::QS : part == 1 ? MixLds::KS : MixLds::VS) + t * 128 + d] = a; }
            for (int e = tid; e < nb * 64; e += 512) { const int t = e >> 6, d = e & 63; L[MixLds::ZS + t * 128 + d] = bf2f(proj[(size_t)(q.row0 + t0 + t) * NBIG + PC_BZ + hu * 64 + d]); }
            if (tid < nb) { const float* ps = psm + (size_t)(q.row0 + t0 + tid) * NSM; const float g = hc0 * softplus_f(ps[hu] + hc1);
                L[MixLds::DS + tid * 128 + 0] = __expf(g); L[MixLds::BS + tid] = sigmoid_f(ps[4 + hu]); }
            __syncthreads();
            if (tid < nb * 2) { const int t = tid >> 1, which = tid & 1; const LAS float* src = L + (which ? MixLds::KS : MixLds::QS) + t * 128; float ss = 0.f;
                for (int d = 0; d < 64; ++d) ss += src[d] * src[d];
                L[MixLds::SC + tid] = rsqrtf(ss + EPSF) * (which ? 1.0f : 0.125f); }
            __syncthreads();
            for (int e = tid; e < nb * 128; e += 512) { const int t = e >> 7, r = e & 127, which = r >> 6, d = r & 63; L[(which ? MixLds::KS : MixLds::QS) + t * 128 + d] *= L[MixLds::SC + t * 2 + which]; }
        } else if (MIX == 2) {
            if (tid < nb * 2) { const int t = tid >> 1, h2 = tid & 1, hd = hu * 2 + h2; const float dt = softplus_f(psm[(size_t)(q.row0 + t0 + t) * NSM + 8 + hd] + p.ssd_dt_bias[layer * 4 + hd]);
                L[MixLds::BS + tid] = dt; L[MixLds::DS + t * 128 + h2] = __expf(-dt * __expf(p.ssd_a_log[layer * 4 + hd])); }
            __syncthreads();
            for (int e = tid; e < nb * 384; e += 512) { const int t = e / 384, r = e % 384, part = r >> 7, j = r & 127, ch = part * 256 + hu * 128 + j, col = PC_CXBC + ch; const int tt = t0 + t;
                float a = p.ssd_conv_b[layer * 768 + ch];
#pragma unroll
                for (int jj = 0; jj < 4; ++jj) a += cw[jj * 768 + ch] * preconv(proj, q, tt - 3 + jj, col, ctx, ch);
                a = silu_f(a);
                if (part == 0) { L[MixLds::XS + t * 128 + j] = a; L[MixLds::VS + t * 128 + j] = a * L[MixLds::BS + t * 2 + (j >> 6)]; }
                else if (part == 1) L[MixLds::KS + t * 128 + j] = a; else L[MixLds::QS + t * 128 + j] = a; }
            for (int e = tid; e < nb * 128; e += 512) { const int t = e >> 7, j = e & 127; L[MixLds::ZS + t * 128 + j] = bf2f(proj[(size_t)(q.row0 + t0 + t) * NBIG + PC_CZ + hu * 128 + j]); }
        } else {
            for (int e = tid; e < nb * 32; e += 512) { const int t = e >> 5, i = e & 31; const bf16_t* pr = proj + (size_t)(q.row0 + t0 + t) * NBIG; const int pidx = q.dec ? TP : (t0 + t);
                const float cs = rot[(pidx * 32 + i) * 2], sn = rot[(pidx * 32 + i) * 2 + 1];
                const float q1 = bf2f(pr[PC_DQ + hu * 64 + i]), q2 = bf2f(pr[PC_DQ + hu * 64 + 32 + i]), k1 = bf2f(pr[PC_DK + hu * 64 + i]), k2 = bf2f(pr[PC_DK + hu * 64 + 32 + i]);
                L[MixLds::QS + t * 128 + i] = q1 * cs - q2 * sn; L[MixLds::QS + t * 128 + 32 + i] = q2 * cs + q1 * sn;
                L[MixLds::KS + t * 128 + i] = (k1 * cs - k2 * sn) * 0.125f; L[MixLds::KS + t * 128 + 32 + i] = (k2 * cs + k1 * sn) * 0.125f; }
            for (int e = tid; e < nb * 64; e += 512) { const int t = e >> 6, d = e & 63; const bf16_t* pr = proj + (size_t)(q.row0 + t0 + t) * NBIG;
                L[MixLds::VS + t * 128 + d] = bf2f(pr[PC_DV + hu * 64 + d]); L[MixLds::ZS + t * 128 + d] = bf2f(pr[PC_DZ + hu * 64 + d]); }
            if (tid < nb) L[MixLds::DS + tid * 128] = hc0;
        }
        __syncthreads();
        recur_batch<DK, NV, MIX == 1, MIX == 0>(S, L, nb, wid, lane);
        __syncthreads();
        for (int t = wid; t < nb; t += 8) {
            const size_t yrow = (size_t)(q.row0 + t0 + t) * DM;
            if (MIX == 0 || MIX == 1) { const float o = L[MixLds::OS + t * 128 + lane]; const float ms = wave_sum(o * o, lane) * (1.0f / 64.0f);
                const float w = (MIX == 0 ? p.hgrn_norm_w : p.gdn_norm_w)[layer * 256 + hu * 64 + lane];
                y[yrow + (MIX == 0 ? 0 : 256) + hu * 64 + lane] = f2bf(o * rsqrtf(ms + EPSF) * w * silu_f(L[MixLds::ZS + t * 128 + lane])); }
            else if (MIX == 2) { float u[2]; float ss = 0.f;
#pragma unroll
                for (int r = 0; r < 2; ++r) { const int j = lane + 64 * r; const float o = L[MixLds::OS + t * 128 + j] + p.ssd_d[layer * 4 + hu * 2 + r] * L[MixLds::XS + t * 128 + j]; u[r] = o * silu_f(L[MixLds::ZS + t * 128 + j]); ss += u[r] * u[r]; }
                const float sc = rsqrtf(wave_sum(ss, lane) * (1.0f / 128.0f) + EPSF);
#pragma unroll
                for (int r = 0; r < 2; ++r) { const int j = lane + 64 * r; y[yrow + 512 + hu * 128 + j] = f2bf(u[r] * sc * p.ssd_norm_w[layer * 256 + hu * 128 + j]); } }
            else { const float o = L[MixLds::OS + t * 128 + lane]; const float mu = wave_sum(o, lane) * (1.0f / 64.0f); const float dv = o - mu; const float var = wave_sum(dv * dv, lane) * (1.0f / 64.0f);
                const int c = hu * 64 + lane;
                y[yrow + 768 + c] = f2bf((dv * rsqrtf(var + EPSF) * p.ret_norm_w[layer * 256 + c] + p.ret_norm_b[layer * 256 + c]) * silu_f(L[MixLds::ZS + t * 128 + lane])); }
        }
    }
    {
        float* so = p.out + (q.dec ? (MIX == 0 ? O_HGRN_S : MIX == 1 ? O_GDN_S : MIX == 2 ? O_SSD_S : O_RET_S) : (MIX == 0 ? O_HGRN_P : MIX == 1 ? O_GDN_P : MIX == 2 ? O_SSD_P : O_RET_P));
        const int nbt = q.dec ? DECB : NB;
#pragma unroll
        for (int i = 0; i < KR; ++i) so[(((size_t)layer * nbt + q.b) * 4 + head) * DK * 64 + (size_t)(kq * KR + i) * 64 + (vcol & 63)] = S[i];
    }
    if (MIX == 1 || MIX == 2) {
        float* co = p.out + (q.dec ? (MIX == 1 ? O_GCONV_S : O_SCONV_S) : (MIX == 1 ? O_GCONV_P : O_SCONV_P)) + ((size_t)layer * (q.dec ? DECB : NB) + q.b) * 3 * 768;
        const int nch = MIX == 1 ? 192 : 384;
        for (int e = tid; e < 3 * nch; e += 512) { const int r = e / nch, c = e % nch; int ch;
            if (MIX == 1) ch = (c >> 6) * 256 + hu * 64 + (c & 63); else ch = (c >> 7) * 256 + hu * 128 + (c & 127);
            co[r * 768 + ch] = preconv(proj, q, q.T - 3 + r, (MIX == 1 ? PC_BQKV : PC_CXBC) + ch, ctx, ch); }
    }
    (void)DVT;
}

constexpr int NCHUNK = 33;
constexpr int LDP = 72;
constexpr int LDP2 = 136;
constexpr int OSP = 68;
typedef short bf16x4 __attribute__((ext_vector_type(4)));
__device__ __forceinline__ f32x4 mfma16(bf16x8 a, bf16x8 b, f32x4 c) { return __builtin_amdgcn_mfma_f32_16x16x32_bf16(a, b, c, 0, 0, 0); }
__device__ __forceinline__ float fexp2(float x) { return __builtin_amdgcn_exp2f(x); }
__device__ __forceinline__ bf16x8 frag_ld(const LAS bf16_t* t, int pitch, int row, int col) { return *(const LAS bf16x8*)(t + row * pitch + col); }
__device__ __forceinline__ bf16x8 frag_ld_perm(const LAS bf16_t* t, int pitch, int row, int k0, int q) {
    const bf16x4 lo = *(const LAS bf16x4*)(t + row * pitch + k0 + 4 * q), hi = *(const LAS bf16x4*)(t + row * pitch + k0 + 16 + 4 * q);
    return __builtin_shufflevector(lo, hi, 0, 1, 2, 3, 4, 5, 6, 7);
}
__device__ __forceinline__ bf16x8 pack_acc2(const f32x4& a, const f32x4& b) {
    u32x4 w; w.x = pg8::cvt_pk_bf16(a[0], a[1]); w.y = pg8::cvt_pk_bf16(a[2], a[3]); w.z = pg8::cvt_pk_bf16(b[0], b[1]); w.w = pg8::cvt_pk_bf16(b[2], b[3]);
    return __builtin_bit_cast(bf16x8, w);
}
__device__ __forceinline__ void st_bf4(LAS bf16_t* dst, const f32x4& v) { u32x2 w; w.x = pg8::cvt_pk_bf16(v[0], v[1]); w.y = pg8::cvt_pk_bf16(v[2], v[3]); *(LAS u32x2*)dst = w; }
__device__ __forceinline__ void unpack_bf8(const u32x4& w, float* a) { const unsigned x[4] = {w.x, w.y, w.z, w.w};
#pragma unroll
    for (int k = 0; k < 4; ++k) { a[2 * k] = __uint_as_float(x[k] << 16); a[2 * k + 1] = __uint_as_float(x[k] & 0xffff0000u); } }
__device__ __forceinline__ u32x4 pack_bf8(const float* a) { u32x4 w; w.x = pg8::cvt_pk_bf16(a[0], a[1]); w.y = pg8::cvt_pk_bf16(a[2], a[3]); w.z = pg8::cvt_pk_bf16(a[4], a[5]); w.w = pg8::cvt_pk_bf16(a[6], a[7]); return w; }

constexpr size_t HR_QF = 0, HR_OI = 8192, HR_DS = 16384, HR_VEC = 24576, HR_UNIT = 25088;
constexpr size_t SS_QF = 0, SS_HEAD = 16384  , SS_VEC = 65536  , SS_UNIT = 66560;
constexpr size_t GD_U = 0, GD_W = 8192, GD_Q = 16384, GD_P = 24576, GD_K = 32768, GD_VEC = 40960, GD_UNIT = 41728;
constexpr size_t YOFF_R = 37748736;
static_assert((size_t)NB * NCHUNK * 2 * SS_UNIT <= YOFF_R && YOFF_R + (size_t)NB * NCHUNK * 4 * HR_UNIT <= (size_t)NB * SEQ * DM * 4 && (size_t)NB * NCHUNK * 4 * HR_UNIT <= (size_t)MROWS * DM * 2 && (size_t)NB * NCHUNK * 4 * GD_UNIT == WS_END - WS_E, "scratch map");
__device__ __forceinline__ unsigned char* rec_hgrn(const Params& p, int b, int c, int h) { return p.ws + WS_HB + (size_t)((b * NCHUNK + c) * 4 + h) * HR_UNIT; }
__device__ __forceinline__ unsigned char* rec_ret(const Params& p, int b, int c, int h) { return (unsigned char*)(p.out + O_YP) + YOFF_R + (size_t)((b * NCHUNK + c) * 4 + h) * HR_UNIT; }
__device__ __forceinline__ unsigned char* rec_gdn(const Params& p, int b, int c, int h) { return p.ws + WS_E + (size_t)((b * NCHUNK + c) * 4 + h) * GD_UNIT; }
__device__ __forceinline__ unsigned char* rec_ssd(const Params& p, int b, int c, int g) { return (unsigned char*)(p.out + O_YP) + (size_t)((b * NCHUNK + c) * 2 + g) * SS_UNIT; }
__device__ __forceinline__ bf16x8 frag_scale(const bf16x8& f, const float (&sc)[8]) { const u32x4 w = __builtin_bit_cast(u32x4, f); float a[8]; unpack_bf8(w, a);
#pragma unroll
    for (int e = 0; e < 8; ++e) a[e] *= sc[e];
    return __builtin_bit_cast(bf16x8, pack_bf8(a)); }
__device__ __forceinline__ void st_acc_bf4(unsigned char* dst, const f32x4& v) { u32x2 w; w.x = pg8::cvt_pk_bf16(v[0], v[1]); w.y = pg8::cvt_pk_bf16(v[2], v[3]); *(u32x2*)dst = w; }
__device__ __forceinline__ f32x4 ld_acc_bf4(const unsigned char* src) { const u32x2 w = *(const u32x2*)src; return (f32x4){__uint_as_float(w.x << 16), __uint_as_float(w.x & 0xffff0000u), __uint_as_float(w.y << 16), __uint_as_float(w.y & 0xffff0000u)}; }

template <int NR> struct Raw192 {
    static constexpr int NP = NR * 24, PPT = (NP + 511) / 512;
    u32x4 pc[PPT]; float sv[2];
    __device__ __forceinline__ void load(const bf16_t* projb, int tfirst, int col0, int col1, int col2, int tid) {
#pragma unroll
        for (int k = 0; k < PPT; ++k) { const int id = min(tid + 512 * k, NP - 1), row = id / 24, seg = id % 24, part = seg >> 3, t = tfirst + row;
            const u32x4 v = *(const u32x4*)(projb + (size_t)max(t, 0) * NBIG + (part == 0 ? col0 : part == 1 ? col1 : col2) + (seg & 7) * 8);
            pc[k] = t >= 0 ? v : (u32x4){0u, 0u, 0u, 0u}; }
    }
    __device__ __forceinline__ void to_lds(LAS bf16_t* T  , int tid) const {
#pragma unroll
        for (int k = 0; k < PPT; ++k) { const int id = tid + 512 * k; if (id < NP) *(LAS u32x4*)(T + (id / 24) * 192 + (id % 24) * 8) = pc[k]; }
    }
};
__device__ __forceinline__ void unit_bch(int v, int& b, int& c, int& h) { b = v / (NCHUNK * 4); c = (v >> 2) % NCHUNK; h = v & 3; }

struct RetRaw { Raw192<64> q; u32x4 rt[2];
    __device__ __forceinline__ void load(const Params& p, int v, int tid) { int b, c, h; unit_bch(v, b, c, h); const int t0 = 64 * c - 48;
        q.load((const bf16_t*)(p.ws + WS_PROJ) + (size_t)(b * TP) * NBIG, t0, PC_DQ + h * 64, PC_DK + h * 64, PC_DV + h * 64, tid);
#pragma unroll
        for (int k = 0; k < 2; ++k) { const int id = tid + 512 * k, row = id >> 4, sg = id & 15; rt[k] = *(const u32x4*)((const float*)(p.ws + WS_ROT) + (size_t)max(t0 + row, 0) * 64 + sg * 4); } }
};
struct RetLds { static constexpr int QS = 0, KS = QS + 64 * LDP * 2, KT = KS + 64 * LDP * 2, VT = KT + 64 * LDP * 2, VH = VT + 64 * LDP * 2, PS = VH + 64 * LDP * 2, RAW = PS + 64 * LDP * 2, ROT = RAW + 64 * 192 * 2, END = ROT + 64 * 64 * 4; };
__device__ __forceinline__ void ret_pre_unit(const Params& p, int layer, int v_this, int v_next, RetRaw& RR, LAS unsigned char* lds) {
    int b, c, hu; unit_bch(v_this, b, c, hu);
    const int tid = opaque_tid(), wid = tid >> 6, lane = tid & 63, fq = lane >> 4, fc = lane & 15;
    LAS bf16_t* Qs = (LAS bf16_t*)(lds + RetLds::QS); LAS bf16_t* Ks = (LAS bf16_t*)(lds + RetLds::KS); LAS bf16_t* KT = (LAS bf16_t*)(lds + RetLds::KT);
    LAS bf16_t* VT = (LAS bf16_t*)(lds + RetLds::VT); LAS bf16_t* VH = (LAS bf16_t*)(lds + RetLds::VH); LAS bf16_t* Ps = (LAS bf16_t*)(lds + RetLds::PS);
    LAS bf16_t* RawT = (LAS bf16_t*)(lds + RetLds::RAW); LAS float* RotT = (LAS float*)(lds + RetLds::ROT);
    const float lg2 = log2f(1.0f - exp2f(-5.0f - (float)hu));
    const int i0 = c == 0 ? 48 : 0, nlast = 64 - i0;
    unsigned char* rec = rec_ret(p, b, c, hu);
    lds_barrier();
    RR.q.to_lds(RawT, tid);
#pragma unroll
    for (int k = 0; k < 2; ++k) *(LAS u32x4*)(RotT + (tid + 512 * k) * 4) = RR.rt[k];
    if (v_next >= 0) RR.load(p, v_next, tid);
    lds_barrier();
#pragma unroll
    for (int n_ = 0; n_ < 4; ++n_) { const int e = tid + 512 * n_; const int i = e >> 5, d = e & 31; float qa, qb, ka, kb;
        { const LAS bf16_t* pr = RawT + i * 192; const float cs = RotT[i * 64 + 2 * d], sn = RotT[i * 64 + 2 * d + 1];
            const float q1 = bf2f(pr[d]), q2 = bf2f(pr[32 + d]), k1 = bf2f(pr[64 + d]), k2 = bf2f(pr[96 + d]);
            const float mk = i >= i0 ? 1.0f : 0.0f;
            qa = (q1 * cs - q2 * sn) * mk; qb = (q2 * cs + q1 * sn) * mk; ka = (k1 * cs - k2 * sn) * (0.125f * mk); kb = (k2 * cs + k1 * sn) * (0.125f * mk); }
        Qs[i * LDP + d] = f2bf(qa); Qs[i * LDP + 32 + d] = f2bf(qb); Ks[i * LDP + d] = f2bf(ka); Ks[i * LDP + 32 + d] = f2bf(kb);
        KT[d * LDP + i] = f2bf(ka); KT[(d + 32) * LDP + i] = f2bf(kb); }
#pragma unroll
    for (int n_ = 0; n_ < 8; ++n_) { const int e = tid + 512 * n_; const int i = e >> 6, d = e & 63;
        float v = bf2f(RawT[i * 192 + 128 + d]); v = i >= i0 ? v : 0.f; const float vh = v * fexp2((float)(63 - i) * lg2);
        VT[d * LDP + i] = f2bf(v); VH[d * LDP + i] = f2bf(vh); }
    lds_barrier();
#pragma unroll
    for (int tt = 0; tt < 2; ++tt) { const int t = wid * 2 + tt, I = t >> 2, J = t & 3; f32x4 acc = (f32x4){0.f, 0.f, 0.f, 0.f};
        if (J <= I) {
#pragma unroll
            for (int s = 0; s < 2; ++s) acc = mfma16(frag_ld(Ks, LDP, 16 * J + fc, 32 * s + 8 * fq), frag_ld(Qs, LDP, 16 * I + fc, 32 * s + 8 * fq), acc); }
        const int i = 16 * I + fc;
#pragma unroll
        for (int r = 0; r < 4; ++r) { const int j = 16 * J + 4 * fq + r; acc[r] = (j <= i && j >= i0) ? acc[r] * fexp2((float)(i - j) * lg2) : 0.f; }
        st_bf4(Ps + i * LDP + 16 * J + 4 * fq, acc); }
    lds_barrier();
    { const int w = wid & 3; bf16x8 bb[2];
#pragma unroll
        for (int s = 0; s < 2; ++s) bb[s] = frag_ld(wid < 4 ? VT : VH, LDP, 16 * w + fc, 32 * s + 8 * fq);
        const LAS bf16_t* At = wid < 4 ? Ps : KT; unsigned char* dst = rec + (wid < 4 ? HR_OI : HR_DS);
#pragma unroll
        for (int m = 0; m < 4; ++m) { f32x4 acc = (f32x4){0.f, 0.f, 0.f, 0.f};
#pragma unroll
            for (int s = 0; s < 2; ++s) acc = mfma16(frag_ld(At, LDP, 16 * m + fc, 32 * s + 8 * fq), bb[s], acc);
            st_acc_bf4(dst + ((size_t)(w * 4 + m) * 64 + lane) * 8, acc); }
        { const float eg = fexp2((float)max(16 * (wid >> 1) + fc - i0 + 1, 0) * lg2); const float sc[8] = {eg, eg, eg, eg, eg, eg, eg, eg};
            *(bf16x8*)(rec + HR_QF + ((size_t)wid * 64 + lane) * 16) = frag_scale(frag_ld_perm(Qs, LDP, 16 * (wid >> 1) + fc, 32 * (wid & 1), fq), sc); }
        if (tid < 64) { float* gv = (float*)(rec + HR_VEC); gv[64 + tid] = fexp2((float)nlast * lg2); } }
}

struct HgLds { static constexpr int LS = 0  , KR = LS + 16384  , QR = KR + 16384  , QT = QR + 16384, QH = QT + 64 * LDP * 2, KT = QH + 64 * LDP * 2  ,
    KHT = KT + 160 * LDP * 2, VT = KHT + 64 * LDP * 2, PS = VT + 64 * LDP * 2, AV = PS + 64 * LDP * 2, RAW = AV + 256, END = RAW + 64 * 192 * 2; };
struct HgRaw { Raw192<64> q;
    __device__ __forceinline__ void load(const Params& p, int v, int tid) { int b, c, h; unit_bch(v, b, c, h);
        q.load((const bf16_t*)(p.ws + WS_PROJ) + (size_t)(b * TP) * NBIG, 64 * c - 48, PC_AQ + h * 64, PC_AF + h * 64, PC_AI + h * 64, tid); }
};
__device__ __forceinline__ void hgrn_pre_unit(const Params& p, int layer, int v_this, int v_next, HgRaw& RR, LAS unsigned char* lds) {
    int b, c, hu; unit_bch(v_this, b, c, hu);
    const int tid = opaque_tid(), wid = tid >> 6, lane = tid & 63, fq = lane >> 4, fc = lane & 15;
    LAS float* Ls = (LAS float*)(lds + HgLds::LS); LAS float* Kr = (LAS float*)(lds + HgLds::KR); LAS float* Qr = (LAS float*)(lds + HgLds::QR);
    LAS bf16_t* Qt = (LAS bf16_t*)(lds + HgLds::QT); LAS bf16_t* Qh = (LAS bf16_t*)(lds + HgLds::QH); LAS bf16_t* Kt = (LAS bf16_t*)(lds + HgLds::KT); LAS bf16_t* KhT = (LAS bf16_t*)(lds + HgLds::KHT);
    LAS bf16_t* VT = (LAS bf16_t*)(lds + HgLds::VT); LAS bf16_t* Ps = (LAS bf16_t*)(lds + HgLds::PS); LAS float* Av = (LAS float*)(lds + HgLds::AV);
    LAS bf16_t* RawT = (LAS bf16_t*)(lds + HgLds::RAW);
    const float lbv = ((const float*)(p.ws + WS_LB))[layer * 256 + hu * 64 + lane];
    const int i0 = c == 0 ? 48 : 0;
    unsigned char* rec = rec_hgrn(p, b, c, hu);
    lds_barrier();
    RR.q.to_lds(RawT, tid);
    if (v_next >= 0) RR.load(p, v_next, tid);
    lds_barrier();
    const int d = lane, ib = 8 * wid, I = wid >> 1;
    float qv[8], kv[8], cl[8]; float run = 0.f;
    {   float vv[8];
#pragma unroll
        for (int nn = 0; nn < 8; ++nn) { const int i = ib + nn; const LAS bf16_t* pr = RawT + i * 192; const bool ok = i >= i0;
            float af = bf2f(pr[64 + d]); af = fminf(fmaxf(af, -30.f), 30.f);
            const float e = __expf(-af), sg = __builtin_amdgcn_rcpf(1.0f + e), f = lbv + (1.0f - lbv) * sg;
            kv[nn] = ok ? (1.0f - lbv) * e * sg : 0.f; run += ok ? __log2f(fmaxf(f, 1e-30f)) : 0.f; cl[nn] = run;
            qv[nn] = ok ? silu_f(bf2f(pr[d])) * 0.125f : 0.f; vv[nn] = ok ? bf2f(pr[128 + d]) : 0.f; }
        *(LAS u32x4*)(VT + d * LDP + ib) = pack_bf8(vv);
        Ls[wid * 64 + d] = run; }
    lds_barrier();
    {   float bt[8];
#pragma unroll
        for (int w8 = 0; w8 < 8; ++w8) bt[w8] = Ls[w8 * 64 + d];
        const float T0 = bt[0] + bt[1], T1 = bt[2] + bt[3], T2 = bt[4] + bt[5], T3 = bt[6] + bt[7], Gl = T0 + T1 + T2 + T3;
        const float Bi = I == 0 ? 0.f : I == 1 ? T0 : I == 2 ? T0 + T1 : T0 + T1 + T2, half = (wid & 1) ? bt[wid - 1] : 0.f;
        const float eB = fexp2(Bi), eGlB = fexp2(Gl - Bi), f1 = fexp2(T0 + (I >= 1 ? -T0 : 0.f) + 0.f);
        const float B1 = T0, B2 = T0 + T1, B3 = T0 + T1 + T2; const float g1 = fexp2(B1 - Bi), g2 = fexp2(B2 - Bi), g3 = fexp2(B3 - Bi); (void)f1;
        float qt[8], qh[8], kh[8], k0[8], k1[8], k2[8], k3[8];
#pragma unroll
        for (int nn = 0; nn < 8; ++nn) { const float L = fmaxf(cl[nn] + half, -120.f), eL = fexp2(L), eLi = __builtin_amdgcn_rcpf(eL), kk = kv[nn] * eLi;
            qt[nn] = qv[nn] * eL; qh[nn] = qt[nn] * eB; kh[nn] = kk * eGlB; k0[nn] = kk; k1[nn] = kk * g1; k2[nn] = kk * g2; k3[nn] = kk * g3; }
        *(LAS u32x4*)(KhT + d * LDP + ib) = pack_bf8(kh);
#pragma unroll
        for (int nn = 0; nn < 8; ++nn) { const int i = ib + nn; Qt[i * LDP + d] = f2bf(qt[nn]); Qh[i * LDP + d] = f2bf(qh[nn]);
            if (I == 0) { Kt[(0 + i) * LDP + d] = f2bf(k0[nn]); Kt[(16 + i) * LDP + d] = f2bf(k1[nn]); Kt[(48 + i) * LDP + d] = f2bf(k2[nn]); Kt[(96 + i) * LDP + d] = f2bf(k3[nn]); }
            else if (I == 1) { Kt[(16 + i) * LDP + d] = f2bf(k0[nn]); Kt[(48 + i) * LDP + d] = f2bf(k2[nn]); Kt[(96 + i) * LDP + d] = f2bf(k3[nn]); }
            else if (I == 2) { Kt[(48 + i) * LDP + d] = f2bf(k0[nn]); Kt[(96 + i) * LDP + d] = f2bf(k3[nn]); }
            else Kt[(96 + i) * LDP + d] = f2bf(k0[nn]); }
        if (wid == 0) Av[d] = fexp2(Gl); }
    lds_barrier();
#pragma unroll
    for (int tt = 0; tt < 2; ++tt) { const int t = wid * 2 + tt, I = t >> 2, J = t & 3; f32x4 acc = (f32x4){0.f, 0.f, 0.f, 0.f};
        if (J <= I) { const int kb = (I == 0 ? 0 : I == 1 ? 16 : I == 2 ? 48 : 96) + 16 * J;
#pragma unroll
            for (int s = 0; s < 2; ++s) acc = mfma16(frag_ld(Kt, LDP, kb + fc, 32 * s + 8 * fq), frag_ld(Qt, LDP, 16 * I + fc, 32 * s + 8 * fq), acc); }
        const int i = 16 * I + fc;
#pragma unroll
        for (int r = 0; r < 4; ++r) { const int j = 16 * J + 4 * fq + r; acc[r] = (j <= i) ? acc[r] : 0.f; }
        st_bf4(Ps + i * LDP + 16 * J + 4 * fq, acc); }
    lds_barrier();
    { const int w = wid & 3; bf16x8 bb[2];
#pragma unroll
        for (int s = 0; s < 2; ++s) bb[s] = frag_ld(VT, LDP, 16 * w + fc, 32 * s + 8 * fq);
        const LAS bf16_t* At = wid < 4 ? Ps : KhT; unsigned char* dst = rec + (wid < 4 ? HR_OI : HR_DS);
#pragma unroll
        for (int m = 0; m < 4; ++m) { f32x4 acc = (f32x4){0.f, 0.f, 0.f, 0.f};
#pragma unroll
            for (int s = 0; s < 2; ++s) acc = mfma16(frag_ld(At, LDP, 16 * m + fc, 32 * s + 8 * fq), bb[s], acc);
            st_acc_bf4(dst + ((size_t)(w * 4 + m) * 64 + lane) * 8, acc); }
        *(bf16x8*)(rec + HR_QF + ((size_t)wid * 64 + lane) * 16) = frag_ld_perm(Qh, LDP, 16 * (wid >> 1) + fc, 32 * (wid & 1), fq);
        if (tid < 64) { float* gv = (float*)(rec + HR_VEC); gv[64 + tid] = Av[tid]; } }
}

struct SsdLds { static constexpr int CS = 0, BS = CS + 64 * LDP2 * 2, BT = BS + 64 * LDP2 * 2, XS = BT + 128 * LDP * 2, VT = XS + 64 * LDP2 * 2  , VH = VT + 2 * 64 * LDP * 2, PS = VH + 2 * 64 * LDP * 2  ,
    DT = PS + 67 * 384 * 2  , GV = DT + 512, END = GV + 512; };
constexpr int SSD_NPIECE = 67 * 48;
struct SsRaw { u32x4 raw[7]; float psmv;
    __device__ __forceinline__ void load(const Params& p, int t, int tid) { const int b = t / (NCHUNK * 2), c = (t >> 1) % NCHUNK, gg = t & 1, t0 = 64 * c - 48;
        const bf16_t* projb = (const bf16_t*)(p.ws + WS_PROJ) + (size_t)(b * TP) * NBIG;
#pragma unroll
        for (int k = 0; k < 7; ++k) { const int id = min(tid + 512 * k, SSD_NPIECE - 1), row = id / 48, seg = id % 48, tt = t0 - 3 + row;
            const u32x4 v = *(const u32x4*)(projb + (size_t)max(tt, 0) * NBIG + PC_CXBC + (seg >> 4) * 256 + gg * 128 + (seg & 15) * 8);
            raw[k] = tt >= 0 ? v : (u32x4){0u, 0u, 0u, 0u}; }
        psmv = ((const float*)(p.ws + WS_PSM))[(size_t)(b * TP + max(t0 + (tid & 63), 0)) * NSM + 8 + gg * 2 + ((tid >> 6) & 1)]; }
};
__device__ __forceinline__ void ssd_pre_unit(const Params& p, int layer, int t_this, int t_next, SsRaw& RR, LAS unsigned char* lds) {
    const int b = t_this / (NCHUNK * 2), c = (t_this >> 1) % NCHUNK, gg = t_this & 1;
    const int tid = opaque_tid(), wid = tid >> 6, lane = tid & 63, fq = lane >> 4, fc = lane & 15;
    LAS bf16_t* Cs = (LAS bf16_t*)(lds + SsdLds::CS); LAS bf16_t* Bs = (LAS bf16_t*)(lds + SsdLds::BS); LAS bf16_t* BT = (LAS bf16_t*)(lds + SsdLds::BT); LAS bf16_t* Xs = (LAS bf16_t*)(lds + SsdLds::XS);
    LAS bf16_t* VT = (LAS bf16_t*)(lds + SsdLds::VT); LAS bf16_t* VH = (LAS bf16_t*)(lds + SsdLds::VH); LAS bf16_t* Ps = (LAS bf16_t*)(lds + SsdLds::PS); LAS bf16_t* RawT = Ps;
    LAS float* DTv = (LAS float*)(lds + SsdLds::DT); LAS float* Gv = (LAS float*)(lds + SsdLds::GV);
    const bf16_t* projb = (const bf16_t*)(p.ws + WS_PROJ) + (size_t)(b * TP) * NBIG; const float* psmb = (const float*)(p.ws + WS_PSM) + (size_t)(b * TP) * NSM;
    const float* cw = p.ssd_conv_w + (size_t)layer * 4 * 768; const float* cb = p.ssd_conv_b + (size_t)layer * 768;
    constexpr float L2E = 1.4426950408889634f;
    const int hh = wid >> 2, ws = wid & 3;
    const int i0 = c == 0 ? 48 : 0, t0 = 64 * c - 48;
    unsigned char* rec = rec_ssd(p, b, c, gg);
    const float psmv = RR.psmv;
    float cwr[3][5];
#pragma unroll
    for (int n = 0; n < 3; ++n) { const int ch = (tid + 512 * n) % 384, chf = (ch >> 7) * 256 + gg * 128 + (ch & 127);
#pragma unroll
        for (int j = 0; j < 4; ++j) cwr[n][j] = cw[j * 768 + chf];
        cwr[n][4] = cb[chf]; }
    lds_barrier();
    if (wid < 2) { const int hd = gg * 2 + wid;
        float dt = softplus_f(psmv + p.ssd_dt_bias[layer * 4 + hd]); dt = lane >= i0 ? dt : 0.f;
        float G = -dt * __expf(p.ssd_a_log[layer * 4 + hd]) * L2E;
#pragma unroll
        for (int o = 1; o < 64; o <<= 1) { const float t = lane_up(G, o, lane); if (lane >= o) G += t; }
        DTv[wid * 64 + lane] = dt; Gv[wid * 64 + lane] = G; }
#pragma unroll
    for (int k = 0; k < 7; ++k) { const int id = tid + 512 * k; if (id < SSD_NPIECE) *(LAS u32x4*)(RawT + (id / 48) * 384 + (id % 48) * 8) = RR.raw[k]; }
    if (t_next >= 0) RR.load(p, t_next, tid);
    lds_barrier();
#pragma unroll
    for (int n = 0; n < 3; ++n) { const int e = tid + 512 * n, ch = e % 384, tr = e / 384, part = ch >> 7, j = ch & 127;
        const float w0 = cwr[n][0], w1 = cwr[n][1], w2 = cwr[n][2], w3 = cwr[n][3], bias = cwr[n][4];
#pragma unroll
        for (int hf = 0; hf < 2; ++hf) { const int ib = 16 * tr + 8 * hf; float a[8], rw[11];
#pragma unroll
            for (int ii = 0; ii < 11; ++ii) rw[ii] = bf2f(RawT[(ib + ii) * 384 + ch]);
#pragma unroll
            for (int ii = 0; ii < 8; ++ii) { a[ii] = silu_f(bias + w0 * rw[ii] + w1 * rw[ii + 1] + w2 * rw[ii + 2] + w3 * rw[ii + 3]); if (ib + ii < i0) a[ii] = 0.f; }
            if (part == 0) { const int h2 = j >> 6, d = j & 63; const float gl = Gv[h2 * 64 + 63]; float xh[8];
#pragma unroll
                for (int ii = 0; ii < 8; ++ii) { const int i = ib + ii; Xs[i * LDP2 + j] = f2bf(a[ii]); a[ii] *= DTv[h2 * 64 + i]; xh[ii] = a[ii] * fexp2(gl - Gv[h2 * 64 + i]); }
                *(LAS u32x4*)(VT + (h2 * 64 + d) * LDP + ib) = pack_bf8(a); *(LAS u32x4*)(VH + (h2 * 64 + d) * LDP + ib) = pack_bf8(xh); }
            else if (part == 1) {
#pragma unroll
                for (int ii = 0; ii < 8; ++ii) Bs[(ib + ii) * LDP2 + j] = f2bf(a[ii]);
                *(LAS u32x4*)(BT + j * LDP + ib) = pack_bf8(a); }
            else {
#pragma unroll
                for (int ii = 0; ii < 8; ++ii) Cs[(ib + ii) * LDP2 + j] = f2bf(a[ii]); } } }
    lds_barrier();
#pragma unroll
    for (int tt = 0; tt < 2; ++tt) { const int t = wid * 2 + tt, I = t >> 2, J = t & 3; f32x4 acc = (f32x4){0.f, 0.f, 0.f, 0.f};
        if (J <= I) {
#pragma unroll
            for (int s = 0; s < 4; ++s) acc = mfma16(frag_ld(Bs, LDP2, 16 * J + fc, 32 * s + 8 * fq), frag_ld(Cs, LDP2, 16 * I + fc, 32 * s + 8 * fq), acc); }
        const int i = 16 * I + fc;
#pragma unroll
        for (int h2 = 0; h2 < 2; ++h2) { f32x4 pv; const float gi = Gv[h2 * 64 + i];
#pragma unroll
            for (int r = 0; r < 4; ++r) { const int j = 16 * J + 4 * fq + r; pv[r] = (j <= i && j >= i0) ? acc[r] * fexp2(gi - Gv[h2 * 64 + j]) : 0.f; }
            st_bf4(Ps + (h2 * 64 + i) * LDP + 16 * J + 4 * fq, pv); } }
    lds_barrier();
    { bf16x8 bv[2], bh[2]; unsigned char* hrec = rec + SS_HEAD + (size_t)hh * 24576; const float dsk = p.ssd_d[layer * 4 + gg * 2 + hh];
#pragma unroll
        for (int s = 0; s < 2; ++s) { bv[s] = frag_ld(VT, LDP, hh * 64 + 16 * ws + fc, 32 * s + 8 * fq); bh[s] = frag_ld(VH, LDP, hh * 64 + 16 * ws + fc, 32 * s + 8 * fq); }
#pragma unroll
        for (int mi = 0; mi < 4; ++mi) { f32x4 o1 = (f32x4){0.f, 0.f, 0.f, 0.f};
#pragma unroll
            for (int s = 0; s < 2; ++s) o1 = mfma16(frag_ld(Ps, LDP, hh * 64 + 16 * mi + fc, 32 * s + 8 * fq), bv[s], o1);
#pragma unroll
            for (int r = 0; r < 4; ++r) o1[r] += dsk * bf2f(Xs[(16 * mi + 4 * fq + r) * LDP2 + hh * 64 + 16 * ws + fc]);
            st_acc_bf4(hrec + ((size_t)(ws * 4 + mi) * 64 + lane) * 8, o1); }
#pragma unroll
        for (int m = 0; m < 8; ++m) { f32x4 d = (f32x4){0.f, 0.f, 0.f, 0.f};
#pragma unroll
            for (int s = 0; s < 2; ++s) d = mfma16(frag_ld(BT, LDP, 16 * m + fc, 32 * s + 8 * fq), bh[s], d);
            st_acc_bf4(hrec + 8192 + ((size_t)(ws * 8 + m) * 64 + lane) * 8, d); }
#pragma unroll
        for (int x = 0; x < 2; ++x) { const int sl = wid * 2 + x; *(bf16x8*)(rec + SS_QF + ((size_t)sl * 64 + lane) * 16) = frag_ld_perm(Cs, LDP2, 16 * (sl >> 2) + fc, 32 * (sl & 3), fq); }
        if (tid < 128) { float* gv = (float*)(rec + SS_VEC + (size_t)(tid >> 6) * 512); gv[tid & 63] = fexp2(Gv[tid]); if ((tid & 63) == 0) gv[64] = fexp2(Gv[(tid >> 6) * 64 + 63]); } }
}

struct GdLds { static constexpr int QF = 0, KF = 16384, VF = 32768, QN = 49152, KN = QN + 64 * LDP * 2, KNT = KN + 64 * LDP * 2, NM = KNT + 64 * LDP * 2, QK = NM + 64 * LDP * 2, WT = QK + 64 * LDP * 2,
    MD = WT + 64 * LDP * 2  , TD = MD + 4096  , GV = TD + 2048, BV = GV + 256, RAW = BV + 256, END = RAW + 67 * 192 * 2; };
struct GdRaw { Raw192<67> q;
    __device__ __forceinline__ void load(const Params& p, int v, int tid) { int b, c, h; unit_bch(v, b, c, h); const int t0 = 64 * c - 48;
        q.load((const bf16_t*)(p.ws + WS_PROJ) + (size_t)(b * TP) * NBIG, t0 - 3, PC_BQKV + h * 64, PC_BQKV + 256 + h * 64, PC_BQKV + 512 + h * 64, tid);
        const float* ps = (const float*)(p.ws + WS_PSM) + (size_t)(b * TP + max(t0 + (tid & 63), 0)) * NSM; q.sv[0] = ps[h]; q.sv[1] = ps[4 + h]; }
};
__device__ __forceinline__ void gdn_pre_unit(const Params& p, int layer, int v_this, int v_next, GdRaw& RR, LAS unsigned char* lds) {
    int b, c, hu; unit_bch(v_this, b, c, hu);
    const int tid = opaque_tid(), wid = tid >> 6, lane = tid & 63, fq = lane >> 4, fc = lane & 15;
    LAS float* Qf = (LAS float*)(lds + GdLds::QF); LAS float* Kf = (LAS float*)(lds + GdLds::KF); LAS float* Vf = (LAS float*)(lds + GdLds::VF);
    LAS bf16_t* Qn = (LAS bf16_t*)(lds + GdLds::QN); LAS bf16_t* Kn = (LAS bf16_t*)(lds + GdLds::KN); LAS bf16_t* KnT = (LAS bf16_t*)(lds + GdLds::KNT);
    LAS bf16_t* NM = (LAS bf16_t*)(lds + GdLds::NM); LAS bf16_t* QK = (LAS bf16_t*)(lds + GdLds::QK); LAS bf16_t* Wt = (LAS bf16_t*)(lds + GdLds::WT);
    LAS float* MD = (LAS float*)(lds + GdLds::MD); LAS bf16_t* TD = (LAS bf16_t*)(lds + GdLds::TD); LAS float* Gv = (LAS float*)(lds + GdLds::GV); LAS float* Bv = (LAS float*)(lds + GdLds::BV);
    LAS bf16_t* RawT = (LAS bf16_t*)(lds + GdLds::RAW);
    const float* cw = p.gdn_conv_w + (size_t)layer * 4 * 768;
    unsigned char* gd = rec_gdn(p, b, c, hu);
    constexpr float L2E = 1.4426950408889634f;
    const int i0 = c == 0 ? 48 : 0;
    const float sva = RR.q.sv[0], svb = RR.q.sv[1];
    float cwr[3][4];
#pragma unroll
    for (int n_ = 0; n_ < 3; ++n_) { const int ch = (tid + 512 * n_) % 192, chf = (ch >> 6) * 256 + hu * 64 + (ch & 63);
#pragma unroll
        for (int j = 0; j < 4; ++j) cwr[n_][j] = cw[j * 768 + chf]; }
    lds_barrier();
    RR.q.to_lds(RawT, tid);
    if (v_next >= 0) RR.load(p, v_next, tid);
    lds_barrier();
    if (wid == 0) {
        float g = -__expf(p.gdn_a_log[layer * 4 + hu]) * softplus_f(sva + p.gdn_dt_bias[layer * 4 + hu]) * L2E, be = sigmoid_f(svb); if (lane < i0) { g = 0.f; be = 0.f; }
#pragma unroll
        for (int o = 1; o < 64; o <<= 1) { const float t = lane_up(g, o, lane); if (lane >= o) g += t; }
        Gv[lane] = g; Bv[lane] = be; }
#pragma unroll
    for (int n_ = 0; n_ < 3; ++n_) { const int e = tid + 512 * n_; const int ch = e % 192, tr = e / 192, part = ch >> 6, d = ch & 63, chf = part * 256 + hu * 64 + d;
        const float w0 = cwr[n_][0], w1 = cwr[n_][1], w2 = cwr[n_][2], w3 = cwr[n_][3];
        float raw[11];
#pragma unroll
        for (int ii = 0; ii < 11; ++ii) raw[ii] = bf2f(RawT[(8 * tr + ii) * 192 + ch]);
        LAS float* dst = part == 0 ? Qf : part == 1 ? Kf : Vf;
#pragma unroll
        for (int ii = 0; ii < 8; ++ii) { const int i = 8 * tr + ii;
            float a = silu_f(w0 * raw[ii] + w1 * raw[ii + 1] + w2 * raw[ii + 2] + w3 * raw[ii + 3]); if (i < i0) a = 0.f;
            dst[i * 64 + d] = a; } }
    lds_barrier();
    { const int ri = tid >> 3, sg = tid & 7; float q[8], k[8], sq = 0.f, sk = 0.f;
#pragma unroll
        for (int x = 0; x < 8; ++x) { q[x] = Qf[ri * 64 + sg * 8 + x]; k[x] = Kf[ri * 64 + sg * 8 + x]; sq += q[x] * q[x]; sk += k[x] * k[x]; }
        sq = sum8(sq); sk = sum8(sk);
        const float rq = rsqrtf(sq + EPSF) * 0.125f, rk = rsqrtf(sk + EPSF), egl = fexp2(Gv[63] - Gv[ri]);
#pragma unroll
        for (int x = 0; x < 8; ++x) { q[x] *= rq; k[x] *= rk; KnT[(sg * 8 + x) * LDP + ri] = f2bf(k[x] * egl); }
        *(LAS f32x4*)(Kf + ri * 64 + sg * 8) = (f32x4){k[0], k[1], k[2], k[3]}; *(LAS f32x4*)(Kf + ri * 64 + sg * 8 + 4) = (f32x4){k[4], k[5], k[6], k[7]};
        *(LAS u32x4*)(Qn + ri * LDP + sg * 8) = pack_bf8(q); *(LAS u32x4*)(Kn + ri * LDP + sg * 8) = pack_bf8(k); }
    lds_barrier();
#pragma unroll
    for (int tt = 0; tt < 2; ++tt) { const int t = wid * 2 + tt, I = t >> 2, J = t & 3; f32x4 a1 = (f32x4){0.f, 0.f, 0.f, 0.f}, a2 = (f32x4){0.f, 0.f, 0.f, 0.f};
        if (J <= I) {
#pragma unroll
            for (int s = 0; s < 2; ++s) { const bf16x8 kj = frag_ld(Kn, LDP, 16 * J + fc, 32 * s + 8 * fq); a1 = mfma16(kj, frag_ld(Kn, LDP, 16 * I + fc, 32 * s + 8 * fq), a1); a2 = mfma16(kj, frag_ld(Qn, LDP, 16 * I + fc, 32 * s + 8 * fq), a2); } }
        const int i = 16 * I + fc; const float gi = Gv[i], bi = Bv[i]; f32x4 nm, qk;
#pragma unroll
        for (int r = 0; r < 4; ++r) { const int j = 16 * J + 4 * fq + r; const float dec = j <= i ? fexp2(gi - Gv[j]) : 0.f; const float mm = j < i ? a1[r] * dec * bi : 0.f; nm[r] = -mm; qk[r] = a2[r] * dec;
            if (J == I) MD[(I * 16 + fc) * 16 + 4 * fq + r] = mm; }
        st_bf4(NM + i * LDP + 16 * J + 4 * fq, nm); st_bf4(QK + i * LDP + 16 * J + 4 * fq, qk); }
    lds_barrier();
    if (wid < 4) { const int I = wid, cc = lane & 15; float mrow[16], x[16];
#pragma unroll
        for (int i = 0; i < 16; ++i) mrow[i] = MD[(I * 16 + i) * 16 + cc];
#pragma unroll
        for (int i = 0; i < 16; ++i) x[i] = (i == cc) ? 1.0f : 0.0f;
#pragma unroll
        for (int j = 0; j < 16; ++j) {
#pragma unroll
            for (int i = j + 1; i < 16; ++i) x[i] -= __int_as_float(__builtin_amdgcn_readlane(__float_as_int(mrow[i]), j)) * x[j]; }
        if (lane < 16) {
#pragma unroll
            for (int i = 0; i < 16; ++i) TD[(I * 16 + i) * 16 + cc] = f2bf(x[i]); } }
    lds_barrier();
    const int isW = wid >> 2, ws = wid & 3, colx = 16 * ws + fc;
    const LAS float* rhs = isW ? Kf : Vf;
    f32x4 X[4];
    const f32x4 zero4 = (f32x4){0.f, 0.f, 0.f, 0.f};
#pragma unroll
    for (int I = 0; I < 4; ++I) { f32x4 acc;
#pragma unroll
        for (int r = 0; r < 4; ++r) { const int j = 16 * I + 4 * fq + r; const float sc = Bv[j] * (isW ? fexp2(Gv[j]) : 1.0f); acc[r] = sc * rhs[j * 64 + colx]; }
        if (I >= 1) acc = mfma16(frag_ld_perm(NM, LDP, 16 * I + fc, 0, fq), pack_acc2(X[0], I > 1 ? X[1] : zero4), acc);
        if (I == 3) acc = mfma16(frag_ld_perm(NM, LDP, 48 + fc, 32, fq), pack_acc2(X[2], zero4), acc);
        const bf16x4 tlo = *(const LAS bf16x4*)(TD + (I * 16 + fc) * 16 + 4 * fq); const bf16x4 z4 = (bf16x4){0, 0, 0, 0};
        X[I] = mfma16(__builtin_shufflevector(tlo, z4, 0, 1, 2, 3, 4, 5, 6, 7), pack_acc2(acc, zero4), zero4); }
    if (!isW) {
#pragma unroll
        for (int m = 0; m < 4; ++m) st_acc_bf4(gd + GD_U + ((size_t)(ws * 4 + m) * 64 + lane) * 8, X[m]); }
    else {
#pragma unroll
        for (int m = 0; m < 4; ++m)
#pragma unroll
            for (int r = 0; r < 4; ++r) Wt[(16 * m + 4 * fq + r) * LDP + colx] = f2bf(-X[m][r]); }
    lds_barrier();
    { const int tsel = wid >> 1; const LAS bf16_t* tile = tsel == 0 ? Wt : tsel == 1 ? Qn : tsel == 2 ? QK : KnT; unsigned char* dst = gd + (tsel == 0 ? GD_W : tsel == 1 ? GD_Q : tsel == 2 ? GD_P : GD_K);
#pragma unroll
        for (int x = 0; x < 4; ++x) { const int sl = (wid & 1) * 4 + x, m = sl >> 1, s = sl & 1; bf16x8 f = frag_ld_perm(tile, LDP, 16 * m + fc, 32 * s, fq);
            if (tsel == 1) { const float eg = fexp2(Gv[16 * m + fc]); const float sc[8] = {eg, eg, eg, eg, eg, eg, eg, eg}; f = frag_scale(f, sc); }
            *(bf16x8*)(dst + ((size_t)sl * 64 + lane) * 16) = f; } }
    if (tid == 0) { float* gv = (float*)(gd + GD_VEC); gv[128] = fexp2(Gv[63]); }
}

template <int MIX> struct SeqRegs {
    static constexpr int DK = MIX == 2 ? 128 : 64, NT = DK / 16;
    u32x2 oi[4]; u32x2 ds[MIX == 1 ? 1 : NT]; f32x4 eg[MIX == 2 ? 4 : 1]; f32x4 al[MIX == 0 ? 4 : 1];
    __device__ __forceinline__ void load(const Params& p, int b, int c, int hd, int ws, int lane, int fq) {
        const unsigned char* base = MIX == 2 ? rec_ssd(p, b, c, hd >> 1) : MIX == 0 ? rec_hgrn(p, b, c, hd) : MIX == 1 ? rec_gdn(p, b, c, hd) : rec_ret(p, b, c, hd);
        const unsigned char* o = MIX == 2 ? base + SS_HEAD + (size_t)(hd & 1) * 24576 : MIX == 1 ? base + GD_U : base + HR_OI;
        const unsigned char* d = MIX == 2 ? o + 8192 : base + HR_DS; const float* gv = (const float*)(MIX == 2 ? base + SS_VEC + (size_t)(hd & 1) * 512 : MIX == 1 ? base + GD_VEC : base + HR_VEC);
#pragma unroll
        for (int mi = 0; mi < 4; ++mi) { oi[mi] = *(const u32x2*)(o + ((size_t)(ws * 4 + mi) * 64 + lane) * 8); if (MIX == 2) eg[mi] = *(const f32x4*)(gv + 16 * mi + 4 * fq); }
        if (MIX != 1) {
#pragma unroll
            for (int m = 0; m < NT; ++m) ds[m] = *(const u32x2*)(d + ((size_t)(ws * NT + m) * 64 + lane) * 8); }
#pragma unroll
        for (int m = 0; m < (MIX == 0 ? 4 : 1); ++m) al[m] = MIX == 0 ? *(const f32x4*)(gv + 64 + 16 * m + 4 * fq) : (f32x4){gv[MIX == 1 ? 128 : 64], 0.f, 0.f, 0.f};
    }
};
__device__ __forceinline__ f32x4 unpack_acc(const u32x2& w) { return (f32x4){__uint_as_float(w.x << 16), __uint_as_float(w.x & 0xffff0000u), __uint_as_float(w.y << 16), __uint_as_float(w.y & 0xffff0000u)}; }
template <int MIX>
__device__ __forceinline__ void seq_item(const Params& p, int layer, int b_in, int hd_in, LAS unsigned char* lds) {
    constexpr int DK = MIX == 2 ? 128 : 64, NT = DK / 16, NS = DK / 32;
    constexpr int NFS = MIX == 2 ? 16 : MIX == 1 ? 32 : 8, FPW = NFS / 2;
    constexpr int YC = MIX == 0 ? 0 : MIX == 1 ? 256 : MIX == 2 ? 512 : 768;
    const int b = __builtin_amdgcn_readfirstlane(b_in), hd = __builtin_amdgcn_readfirstlane(hd_in);
    const int tid = opaque_tid(), wid = __builtin_amdgcn_readfirstlane(tid >> 6), lane = tid & 63, fq = lane >> 4, fc = lane & 15;
    const int ws = wid & 3; const bool cw = wid < 4, lw = wid == 4 || wid == 5, sw = wid >= 6;
    const int fs0 = (wid & 1) * FPW;
    LAS unsigned char* FS = lds;
    LAS float* Os = (LAS float*)(lds + 65536);
    bf16_t* yb = (bf16_t*)(p.ws + WS_Y) + (size_t)(b * TP) * DM + YC + hd * 64;
    auto store_rows = [&](int c) {
        const int i0 = c == 0 ? 48 : 0, t0 = 64 * c - 48, ri = (wid - 6) * 32 + (lane >> 1), hf = lane & 1; const LAS float* src = Os + (c & 1) * 64 * OSP + ri * OSP + hf * 32;
        float o[32];
#pragma unroll
        for (int k4 = 0; k4 < 8; ++k4) { const f32x4 v = *(const LAS f32x4*)(src + 4 * k4); o[4 * k4] = v[0]; o[4 * k4 + 1] = v[1]; o[4 * k4 + 2] = v[2]; o[4 * k4 + 3] = v[3]; }
        if (ri >= i0) { u32x4* dst = (u32x4*)(yb + (size_t)(t0 + ri) * DM + hf * 32);
#pragma unroll
            for (int k8 = 0; k8 < 4; ++k8) dst[k8] = pack_bf8(o + 8 * k8); } };
    auto fbase = [&](int c) -> const unsigned char* { return MIX == 2 ? rec_ssd(p, b, c, hd >> 1) + SS_QF : MIX == 1 ? rec_gdn(p, b, c, hd) + GD_W : (MIX == 0 ? rec_hgrn(p, b, c, hd) : rec_ret(p, b, c, hd)) + HR_QF; };
    f32x4 S[NT];
#pragma unroll
    for (int m = 0; m < NT; ++m) S[m] = (f32x4){0.f, 0.f, 0.f, 0.f};
    const f32x4 zero4 = (f32x4){0.f, 0.f, 0.f, 0.f};
    SeqRegs<MIX> R0, R1; bf16x8 fr[FPW], fr2[FPW];
    if (cw) { R0.load(p, b, 0, hd, ws, lane, fq); R1.load(p, b, 1, hd, ws, lane, fq); }
    else if (lw) { const unsigned char* f0 = fbase(0); const unsigned char* f1 = fbase(1); const unsigned char* f2 = fbase(2);
#pragma unroll
        for (int x = 0; x < FPW; ++x) fr2[x] = *(const bf16x8*)(f0 + ((size_t)(fs0 + x) * 64 + lane) * 16);
#pragma unroll
        for (int x = 0; x < FPW; ++x) fr[x] = *(const bf16x8*)(f1 + ((size_t)(fs0 + x) * 64 + lane) * 16);
#pragma unroll
        for (int x = 0; x < FPW; ++x) *(LAS bf16x8*)(FS + ((size_t)(fs0 + x) * 64 + lane) * 16) = fr2[x];
#pragma unroll
        for (int x = 0; x < FPW; ++x) fr2[x] = *(const bf16x8*)(f2 + ((size_t)(fs0 + x) * 64 + lane) * 16); }
    lds_barrier();
    if (cw) {
        auto step = [&](const int c, SeqRegs<MIX>& R) __attribute__((always_inline)) {
            LAS float* Ob = Os + (c & 1) * 64 * OSP + 16 * ws + fc;
            const LAS unsigned char* Fc = FS + (size_t)((c & 1) * NFS) * 1024 + lane * 16;

            bf16x8 Sb[NS];
#pragma unroll
            for (int s = 0; s < NS; ++s) Sb[s] = pack_acc2(S[2 * s], S[2 * s + 1]);
            if (MIX == 1) {
                bf16x8 ub[2]; f32x4 u[4];
#pragma unroll
                for (int m = 0; m < 4; ++m) { u[m] = unpack_acc(R.oi[m]);
#pragma unroll
                    for (int s = 0; s < 2; ++s) u[m] = mfma16(*(const LAS bf16x8*)(Fc + (m * 2 + s) * 1024), Sb[s], u[m]); }
#pragma unroll
                for (int s = 0; s < 2; ++s) ub[s] = pack_acc2(u[2 * s], u[2 * s + 1]);
#pragma unroll
                for (int mi = 0; mi < 4; ++mi) { f32x4 o = zero4;
#pragma unroll
                    for (int s = 0; s < 2; ++s) { o = mfma16(*(const LAS bf16x8*)(Fc + (16 + mi * 2 + s) * 1024), ub[s], o); o = mfma16(*(const LAS bf16x8*)(Fc + (8 + mi * 2 + s) * 1024), Sb[s], o); }
#pragma unroll
                    for (int r = 0; r < 4; ++r) Ob[(16 * mi + 4 * fq + r) * OSP] = o[r]; }
                const float al = R.al[0][0];
#pragma unroll
                for (int m = 0; m < 4; ++m) { S[m] = S[m] * al;
#pragma unroll
                    for (int s = 0; s < 2; ++s) S[m] = mfma16(*(const LAS bf16x8*)(Fc + (24 + m * 2 + s) * 1024), ub[s], S[m]); }
            } else {
#pragma unroll
                for (int mi = 0; mi < 4; ++mi) { f32x4 o2 = zero4;
#pragma unroll
                    for (int s = 0; s < NS; ++s) o2 = mfma16(*(const LAS bf16x8*)(Fc + (mi * NS + s) * 1024), Sb[s], o2);
                    const f32x4 o1 = unpack_acc(R.oi[mi]);
#pragma unroll
                    for (int r = 0; r < 4; ++r) Ob[(16 * mi + 4 * fq + r) * OSP] = o1[r] + (MIX == 2 ? R.eg[MIX == 2 ? mi : 0][r] : 1.0f) * o2[r]; }
#pragma unroll
                for (int m = 0; m < NT; ++m) { const f32x4 d = unpack_acc(R.ds[MIX == 1 ? 0 : m]);
#pragma unroll
                    for (int r = 0; r < 4; ++r) S[m][r] = (MIX == 0 ? R.al[MIX == 0 ? (m & 3) : 0][r] : R.al[0][0]) * S[m][r] + d[r]; }
            }
            R.load(p, b, min(c + 2, NCHUNK - 1), hd, ws, lane, fq);
            lds_barrier();
        };
        for (int c = 0; c < NCHUNK; c += 2) { step(c, R0); if (c + 1 < NCHUNK) step(c + 1, R1); }
    } else if (lw) {
        auto lstep = [&](const int c, bf16x8 (&f)[FPW]) __attribute__((always_inline)) {
            const unsigned char* f3 = fbase(min(c + 3, NCHUNK - 1));
#pragma unroll
            for (int x = 0; x < FPW; ++x) *(LAS bf16x8*)(FS + ((size_t)(((c + 1) & 1) * NFS + fs0 + x) * 64 + lane) * 16) = f[x];
#pragma unroll
            for (int x = 0; x < FPW; ++x) f[x] = *(const bf16x8*)(f3 + ((size_t)(fs0 + x) * 64 + lane) * 16);
            lds_barrier(); };
        for (int c = 0; c < NCHUNK; c += 2) { lstep(c, fr); if (c + 1 < NCHUNK) lstep(c + 1, fr2); }
    } else {
        for (int c = 0; c < NCHUNK; ++c) { if (c > 0) store_rows(c - 1); lds_barrier(); }
        store_rows(NCHUNK - 1);
    }
    if (cw) { float* so = p.out + (MIX == 0 ? O_HGRN_P : MIX == 1 ? O_GDN_P : MIX == 2 ? O_SSD_P : O_RET_P) + (((size_t)layer * NB + b) * 4 + hd) * (DK * 64);
#pragma unroll
        for (int m = 0; m < NT; ++m)
#pragma unroll
            for (int r = 0; r < 4; ++r) so[(16 * m + 4 * fq + r) * 64 + 16 * ws + fc] = S[m][r]; }
    if (MIX == 1 || (MIX == 2 && (hd & 1) == 0)) { const bf16_t* projb = (const bf16_t*)(p.ws + WS_PROJ) + (size_t)(b * TP) * NBIG;
        float* co = p.out + (MIX == 1 ? O_GCONV_P : O_SCONV_P) + ((size_t)layer * NB + b) * 3 * 768; constexpr int NC = MIX == 1 ? 192 : 384;
        for (int e = tid; e < 3 * NC; e += 512) { const int r = e / NC, ch = e % NC, chf = MIX == 1 ? (ch >> 6) * 256 + hd * 64 + (ch & 63) : (ch >> 7) * 256 + (hd >> 1) * 128 + (ch & 127);
            co[r * 768 + chf] = bf2f(projb[(size_t)(TP - 3 + r) * NBIG + (MIX == 1 ? PC_BQKV : PC_CXBC) + chf]); } }
}

__device__ __forceinline__ void ph_post(const Params& p_in, int layer, LAS unsigned char* lds_in, int blk, int nblk) {
    Params p = p_in; p.ws = (unsigned char*)ld_base(0); p.out = (float*)ld_base(1);
    LAS unsigned char* lds = (LAS unsigned char*)opaque_u32((unsigned)(unsigned long)lds_in);
    const int tid = opaque_tid(), wid = tid >> 6, lane = tid & 63;
    convert_weights(p, layer + 1 < DEPTH ? layer + 1 : -1, -1, (LAS float*)lds, tid, blk, nblk);
    const bf16_t* proj = (const bf16_t*)(p.ws + WS_PROJ); bf16_t* y = (bf16_t*)(p.ws + WS_Y);
    for (int t = blk * 8 + wid; t < MP * 2; t += nblk * 8) { const int row = t >> 1, half = t & 1, ch = half * 512 + lane * 8;
        const int kind = half * 2 + (lane >> 5), cl = (lane & 31) * 8;
        const u32x4 ow = *(const u32x4*)(y + (size_t)row * DM + ch);
        const u32x4 zw = *(const u32x4*)(proj + (size_t)row * NBIG + (kind == 0 ? PC_AZ : kind == 1 ? PC_BZ : kind == 2 ? PC_CZ : PC_DZ) + cl);
        const float* nwp = (kind == 0 ? p.hgrn_norm_w : kind == 1 ? p.gdn_norm_w : kind == 2 ? p.ssd_norm_w : p.ret_norm_w) + layer * 256 + cl;
        const f32x4 w0 = *(const f32x4*)nwp, w1 = *(const f32x4*)(nwp + 4);
        float o[8], z[8]; unpack_bf8(ow, o); unpack_bf8(zw, z);
        const float nw[8] = {w0[0], w0[1], w0[2], w0[3], w1[0], w1[1], w1[2], w1[3]};
        if (kind == 2) {
            float q = 0.f;
#pragma unroll
            for (int k = 0; k < 8; ++k) { o[k] *= silu_f(z[k]); q += o[k] * o[k]; }
            q = sum16(q);
            const float rstd = rsqrtf(q * (1.0f / 128.0f) + EPSF);
#pragma unroll
            for (int k = 0; k < 8; ++k) o[k] *= rstd * nw[k];
        } else if (kind == 3) {
            const float* nbp = p.ret_norm_b + layer * 256 + cl; const f32x4 b0 = *(const f32x4*)nbp, b1 = *(const f32x4*)(nbp + 4); const float nb[8] = {b0[0], b0[1], b0[2], b0[3], b1[0], b1[1], b1[2], b1[3]};
            float s = 0.f;
#pragma unroll
            for (int k = 0; k < 8; ++k) s += o[k];
            s = sum8(s); const float mu = s * (1.0f / 64.0f); float q = 0.f;
#pragma unroll
            for (int k = 0; k < 8; ++k) { o[k] -= mu; q += o[k] * o[k]; }
            q = sum8(q); const float rstd = rsqrtf(q * (1.0f / 64.0f) + EPSF);
#pragma unroll
            for (int k = 0; k < 8; ++k) o[k] = (o[k] * rstd * nw[k] + nb[k]) * silu_f(z[k]);
        } else {
            float q = 0.f;
#pragma unroll
            for (int k = 0; k < 8; ++k) q += o[k] * o[k];
            q = sum8(q); const float rstd = rsqrtf(q * (1.0f / 64.0f) + EPSF);
#pragma unroll
            for (int k = 0; k < 8; ++k) o[k] = o[k] * rstd * nw[k] * silu_f(z[k]);
        }
        *(u32x4*)(y + (size_t)row * DM + ch) = pack_bf8(o);
    }
}

constexpr int N_MU = 14;
__device__ __forceinline__ void ph_pre(const Params& p_in, int layer, LAS unsigned char* lds_in, int blk, int nblk) {
    Params p = p_in; p.ws = (unsigned char*)ld_base(0); p.out = (float*)ld_base(1);
    LAS unsigned char* lds = (LAS unsigned char*)opaque_u32((unsigned)(unsigned long)lds_in);
    const int tid = opaque_tid();
    constexpr int NU4 = NB * NCHUNK * 4, NU2 = NB * NCHUNK * 2, DEP4 = (7 * NCHUNK + 31) * 4, DEP2 = (7 * NCHUNK + 31) * 2;
    unsigned* flag = (unsigned*)(p.ws + WS_BAR) + FLAG_WORD0 + 2 * layer + 1; unsigned* bar = (unsigned*)(p.ws + WS_BAR);
    const bool tb = blk >= nblk - 16;
    if (tb) {
        pg8::Gemm g{(const bf16_t*)(p.ws + WS_HB), (const bf16_t*)(p.ws + WS_WINT), MROWS, NBIG, DM};
        pg8::OneUnit S{MMAIN / 256, blk - (nblk - 16)};
        pg8::EpiProj E{(bf16_t*)(p.ws + WS_PROJ), NBIG, (const float*)(p.ws + WS_RS)};
        pg8::gemm_phase<pg8::EpiProj, pg8::OneUnit>(lds, g, S, E);
        flag_publish(flag);
    }
    convert_weights(p, -1, layer, (LAS float*)lds, tid, blk, nblk);
    { GdRaw R; int v = blk; if (v < NU4 && v < DEP4) R.load(p, v, tid);
        for (; v < NU4; v += nblk) { if (tb && v >= nblk) break;
            if (v >= DEP4) { flag_wait(flag, 16u, bar); R.load(p, v, tid); }
            const int vn = v + nblk; gdn_pre_unit(p, layer, v, (vn < NU4 && vn < DEP4 && !(tb && vn >= nblk)) ? vn : -1, R, lds); }
        if (blk >= 128 && blk < 176) { const int j = blk - 128, v2 = (nblk - 16) + (j & 15) + nblk * (1 + (j >> 4)); R.load(p, v2, tid); gdn_pre_unit(p, layer, v2, -1, R, lds); } }
    { SsRaw R; int t = (blk + 224) % nblk; if (t < NU2 && t < DEP2) R.load(p, t, tid);
        for (; t < NU2; t += nblk) { if (t >= DEP2) { flag_wait(flag, 16u, bar); R.load(p, t, tid); }
            const int tn = t + nblk; ssd_pre_unit(p, layer, t, (tn < NU2 && tn < DEP2) ? tn : -1, R, lds); } }
    { HgRaw R; int v = (blk + 192) % nblk; if (v < NU4 && v < DEP4) R.load(p, v, tid);
        for (; v < NU4; v += nblk) { if (v >= DEP4) { flag_wait(flag, 16u, bar); R.load(p, v, tid); }
            const int vn = v + nblk; hgrn_pre_unit(p, layer, v, (vn < NU4 && vn < DEP4) ? vn : -1, R, lds); } }
    { RetRaw R; int v = (blk + 160) % nblk; if (v < NU4 && v < DEP4) R.load(p, v, tid);
        for (; v < NU4; v += nblk) { if (v >= DEP4) { flag_wait(flag, 16u, bar); R.load(p, v, tid); }
            const int vn = v + nblk; ret_pre_unit(p, layer, v, (vn < NU4 && vn < DEP4) ? vn : -1, R, lds); } }
}
__device__ __forceinline__ void ph_seq(const Params& p_in, int layer, LAS unsigned char* lds_in, int blk, int nblk) {
    Params p = p_in; p.ws = (unsigned char*)ld_base(0); p.out = (float*)ld_base(1);
    LAS unsigned char* lds = (LAS unsigned char*)opaque_u32((unsigned)(unsigned long)lds_in);
    LAS float* L = (LAS float*)lds;
    if (blk < 128) { const int b = blk >> 4, k = blk & 15;
#ifndef REP_SQ
#define REP_SQ 1
#endif
        for (int rep = 0; rep < REP_SQ; ++rep)
        if (k < 4) seq_item<2>(p, layer, b, k, lds); else if (k < 8) seq_item<1>(p, layer, b, k - 4, lds); else if (k < 12) seq_item<0>(p, layer, b, k - 8, lds); else seq_item<3>(p, layer, b, k - 12, lds); }
    else for (int d = blk - 128; d < DECB * N_MU; d += nblk - 128) { const int s = NB + d / N_MU, mu = d % N_MU;
#ifndef REP_DEC2
#define REP_DEC2 1
#endif
        for (int rep = 0; rep < REP_DEC2; ++rep)
        if (mu < 4) mixer_item<0>(p, layer, s, mu, L); else if (mu < 8) mixer_item<1>(p, layer, s, mu - 4, L); else if (mu < 10) mixer_item<2>(p, layer, s, mu - 8, L); else mixer_item<3>(p, layer, s, mu - 10, L); }
}

__device__ __forceinline__ void ph_final(const Params& p_in, LAS unsigned char* lds_in, int blk, int nblk) {
    Params p = p_in; p.ws = (unsigned char*)ld_base(0); p.out = (float*)ld_base(1);
    LAS unsigned char* lds = (LAS unsigned char*)opaque_u32((unsigned)(unsigned long)lds_in);
    if (blk < 4) out_tail(p, DEPTH - 1, lds, blk);

    const int tid = opaque_tid(), wid = tid >> 6, lane = tid & 63;
    const float* h = (const float*)(p.ws + WS_H);
    for (int pass = 0; pass < 2; ++pass) {
    if (pass == 1) flag_wait((unsigned*)(p.ws + WS_BAR) + FLAG_WORD0 + 2 * (DEPTH - 1), 4u, (unsigned*)(p.ws + WS_BAR));
    const int r_lo = pass == 0 ? (blk >= 4 ? (blk - 4) * 8 + wid : MMAIN) : MMAIN + blk * 8 + wid, r_hi = pass == 0 ? MMAIN : MROWS, r_st = (pass == 0 ? nblk - 4 : nblk) * 8;
    for (int row = r_lo; row < r_hi; row += r_st) {
        float* dst;
        if (row < MP) { const int b = row / TP, t = row % TP; if (t < NMETA) continue; dst = p.out + O_YP + ((size_t)b * SEQ + (t - NMETA)) * DM; } else dst = p.out + O_YS + (size_t)(row - MP) * DM;
        f32x4 v[4]; float ss = 0.f;
#pragma unroll
        for (int j = 0; j < 4; ++j) { v[j] = *(const f32x4*)(h + (size_t)row * DM + j * 256 + lane * 4); ss += v[j][0] * v[j][0] + v[j][1] * v[j][1] + v[j][2] * v[j][2] + v[j][3] * v[j][3]; }
        const float r = rsqrtf(wave_sum(ss, lane) * (1.0f / DM) + EPSF);
#pragma unroll
        for (int j = 0; j < 4; ++j) { const f32x4 w = *(const f32x4*)(p.final_norm_w + j * 256 + lane * 4); *(f32x4*)(dst + j * 256 + lane * 4) = v[j] * r * w; }
    }
    }
}

constexpr int LDS_STAGE = 160 * 1024 - 256;
constexpr int LDS_BYTES = LDS_STAGE + 64;
static_assert(MixLds::END * 4 <= LDS_STAGE && RetLds::END <= LDS_STAGE && SsdLds::END <= LDS_STAGE && 2 * 64 * LDP * 2 <= SsdLds::DT - SsdLds::PS && HgLds::END <= LDS_STAGE && GdLds::END <= LDS_STAGE && pg8::STAGE_BYTES <= LDS_STAGE && 65536 + 2 * 64 * OSP * 4 <= LDS_STAGE, "LDS carve");

__global__ void __launch_bounds__(512, 2) k_mega(Params p) {
    extern __shared__ __attribute__((aligned(16))) unsigned char smem[];
    LAS unsigned char* lds = (LAS unsigned char*)smem;
    const int blk = blockIdx.x, nblk = gridDim.x;
    volatile LAS unsigned* xbw = (volatile LAS unsigned*)(lds + LDS_STAGE);
    if (threadIdx.x < 4) xbw[threadIdx.x] = 0u;
    if (threadIdx.x == 0) { volatile LAS unsigned* q = (volatile LAS unsigned*)(unsigned long)LDS_BASES; const unsigned long long a = (unsigned long long)p.ws, b = (unsigned long long)p.out;
        q[0] = (unsigned)a; q[1] = (unsigned)(a >> 32); q[2] = (unsigned)b; q[3] = (unsigned)(b >> 32); }
    __syncthreads();
    XcdBarrier xb = xcd_barrier_post((unsigned*)(p.ws + WS_BAR), xbw);
#ifndef REP_PREP
#define REP_PREP 1
#endif
#ifndef REP_ROWNORM
#define REP_ROWNORM 1
#endif
#ifndef REP_GEMMIN
#define REP_GEMMIN 1
#endif
#ifndef REP_GDNPRE
#define REP_GDNPRE 1
#endif
#ifndef REP_MIXER
#define REP_MIXER 1
#endif
    for (int r = 0; r < REP_PREP; ++r) { ph_prep(p, lds, blk, nblk); if (r + 1 < REP_PREP) xcd_barrier(xb); }
    cooperative_groups::this_grid().sync();
    xcd_barrier(xb);
#pragma unroll 1
    for (int l = 0; l < DEPTH; ++l) {
        for (int r = 0; r < REP_ROWNORM; ++r) { ph_rownorm(p, l, lds, blk, nblk); xcd_barrier(xb); }
        for (int r = 0; r < REP_GEMMIN; ++r) { ph_gemm_in(p, l, lds, blk, nblk); xcd_barrier(xb); }
#ifndef REP_A
#define REP_A 1
#define REP_B 1
#endif
        for (int r = 0; r < REP_A; ++r) { ph_pre(p, l, lds, blk, nblk); xcd_barrier(xb); }
        for (int r = 0; r < REP_B; ++r) { ph_seq(p, l, lds, blk, nblk); xcd_barrier(xb); }
        ph_post(p, l, lds, blk, nblk); xcd_barrier(xb);
        ph_gemm_out(p, l, lds, blk, nblk);
        xcd_barrier(xb);
    }
    ph_final(p, lds, blk, nblk);
}

extern "C" void kernel_launch(void* const* d_in, const int* in_sizes, int n_in, void* d_out, int out_size, void* d_ws, size_t ws_size, hipStream_t stream) {
    static int grid = 0;
    if (grid == 0) {
        if (n_in != 27 || (size_t)out_size != O_END || ws_size < WS_END) { fprintf(stderr, "kernel_launch: unexpected shapes: n_in %d out %d (want %zu) ws %zu (want %zu)\n", n_in, out_size, (size_t)O_END, ws_size, (size_t)WS_END); grid = -1; return; }
        if (hipFuncSetAttribute((const void*)k_mega, hipFuncAttributeMaxDynamicSharedMemorySize, LDS_BYTES) != hipSuccess) { fprintf(stderr, "kernel_launch: hipFuncSetAttribute failed\n"); grid = -1; return; }
        int dev = 0, cus = 0, per_cu = 0;
        if (hipGetDevice(&dev) != hipSuccess || hipDeviceGetAttribute(&cus, hipDeviceAttributeMultiprocessorCount, dev) != hipSuccess) { fprintf(stderr, "kernel_launch: device query failed\n"); grid = -1; return; }
        if (hipOccupancyMaxActiveBlocksPerMultiprocessor(&per_cu, (const void*)k_mega, 512, LDS_BYTES) != hipSuccess || per_cu < 1) { fprintf(stderr, "kernel_launch: occupancy query says %d blocks per CU\n", per_cu); grid = -1; return; }
        grid = cus;
    }
    if (grid < 0) return;
    Params p{};
    const float** pp = (const float**)&p;
    for (int i = 0; i < 27; ++i) pp[i] = (const float*)d_in[i];
    p.out = (float*)d_out; p.ws = (unsigned char*)d_ws;
    (void)hipMemsetAsync((unsigned char*)d_ws + WS_BAR, 0, 16384, stream);
    void* args[] = {&p};
    const hipError_t e = hipLaunchCooperativeKernel((const void*)k_mega, dim3(grid), dim3(512), args, LDS_BYTES, stream);
    if (e != hipSuccess) fprintf(stderr, "kernel_launch: cooperative launch failed: %s (grid %d)\n", hipGetErrorString(e), grid);
}
```

```cpp
#include <hip/hip_runtime.h>
#include <hip/hip_cooperative_groups.h>
#include <cstdio>
#include <cstdint>

#define LAS __attribute__((address_space(3)))
typedef unsigned short bf16_t;
typedef short bf16x8 __attribute__((ext_vector_type(8)));
typedef float f32x4 __attribute__((ext_vector_type(4)));
typedef unsigned u32x4 __attribute__((ext_vector_type(4)));
typedef unsigned u32x2 __attribute__((ext_vector_type(2)));

constexpr int DM = 1024, NB = 8, SEQ = 2048, DEPTH = 4, DECB = 128, NMETA = 16, TP = SEQ + NMETA;
constexpr int MP = NB * TP;
constexpr int MROWS = MP + DECB;
constexpr int IN_DIM = 4108, NBIG = 4096, NSM = 12;
constexpr int PASTLEN = 16384;
constexpr float EPSF = 1e-6f;
constexpr int PC_AQ = 0, PC_AF = 256, PC_AI = 512, PC_AZ = 768, PC_BQKV = 1024, PC_BZ = 1792, PC_CXBC = 2048, PC_CZ = 2816, PC_DQ = 3072, PC_DK = 3328, PC_DV = 3584, PC_DZ = 3840;

constexpr size_t WS_BAR = 0;
constexpr size_t WS_WINT = 16384;
constexpr size_t WS_WOUTT = WS_WINT + (size_t)NBIG * DM * 2;
constexpr size_t WS_WSM = WS_WOUTT + (size_t)DM * DM * 2;
constexpr size_t WS_LB = WS_WSM + (size_t)DEPTH * NSM * DM * 4;
constexpr size_t WS_ROT = WS_LB + (size_t)DEPTH * 256 * 4;
constexpr size_t ROT_BYTES = ((size_t)(TP + 1) * 64 * 4 + 255) / 256 * 256;
constexpr size_t WS_H = WS_ROT + ROT_BYTES;
constexpr size_t WS_HB = WS_H + (size_t)MROWS * DM * 4;
constexpr size_t WS_WSMB = WS_H + ((size_t)32 << 20);
constexpr size_t WS_RS = WS_HB + (size_t)MROWS * DM * 2;
constexpr size_t WS_PSM = WS_RS + (size_t)MROWS * 4;
constexpr size_t WS_PROJ = WS_PSM + (size_t)MROWS * NSM * 4;
constexpr size_t WS_Y = WS_PROJ + (size_t)MROWS * NBIG * 2;
constexpr size_t WS_E = WS_Y + (size_t)MROWS * DM * 2;
constexpr size_t WS_END = WS_E + (size_t)NB * 33 * 4 * 41728;

constexpr size_t O_YP = 0;
constexpr size_t O_YS = O_YP + (size_t)NB * SEQ * DM;
constexpr size_t O_HGRN_P = O_YS + (size_t)DECB * DM;
constexpr size_t O_GDN_P = O_HGRN_P + (size_t)DEPTH * NB * 4 * 64 * 64;
constexpr size_t O_GCONV_P = O_GDN_P + (size_t)DEPTH * NB * 4 * 64 * 64;
constexpr size_t O_SSD_P = O_GCONV_P + (size_t)DEPTH * NB * 3 * 768;
constexpr size_t O_SCONV_P = O_SSD_P + (size_t)DEPTH * NB * 4 * 128 * 64;
constexpr size_t O_RET_P = O_SCONV_P + (size_t)DEPTH * NB * 3 * 768;
constexpr size_t O_HGRN_S = O_RET_P + (size_t)DEPTH * NB * 4 * 64 * 64;
constexpr size_t O_GDN_S = O_HGRN_S + (size_t)DEPTH * DECB * 4 * 64 * 64;
constexpr size_t O_GCONV_S = O_GDN_S + (size_t)DEPTH * DECB * 4 * 64 * 64;
constexpr size_t O_SSD_S = O_GCONV_S + (size_t)DEPTH * DECB * 3 * 768;
constexpr size_t O_SCONV_S = O_SSD_S + (size_t)DEPTH * DECB * 4 * 128 * 64;
constexpr size_t O_RET_S = O_SCONV_S + (size_t)DEPTH * DECB * 3 * 768;
constexpr size_t O_END = O_RET_S + (size_t)DEPTH * DECB * 4 * 64 * 64;

struct Params {
    const float* x_prompt; const float* x_sample;
    const float* st_hgrn; const float* st_gdn; const float* st_gconv; const float* st_ssd; const float* st_sconv; const float* st_ret;
    const float* meta; const float* norm_w; const float* w_in; const float* lb_logits; const float* hgrn_norm_w;
    const float* gdn_conv_w; const float* gdn_a_log; const float* gdn_dt_bias; const float* gdn_norm_w;
    const float* ssd_conv_w; const float* ssd_conv_b; const float* ssd_a_log; const float* ssd_dt_bias; const float* ssd_d; const float* ssd_norm_w;
    const float* ret_norm_w; const float* ret_norm_b; const float* w_out; const float* final_norm_w;
    float* out; unsigned char* ws;
};
__device__ __forceinline__ void phase_bases(Params& p);


__device__ __forceinline__ float bf2f(bf16_t b) { return __uint_as_float(((unsigned)b) << 16); }
typedef float f32x2c_t __attribute__((ext_vector_type(2)));
typedef __bf16 bf16x2c_t __attribute__((ext_vector_type(2)));
__device__ __forceinline__ unsigned pack_bf2(float lo, float hi) { const f32x2c_t f = {lo, hi}; return __builtin_bit_cast(unsigned, __builtin_convertvector(f, bf16x2c_t)); }
__device__ __forceinline__ bf16_t f2bf(float f) { return (bf16_t)(pack_bf2(f, f) & 0xffffu); }
__device__ __forceinline__ float sigmoid_f(float x) { return __builtin_amdgcn_rcpf(1.0f + __expf(-x)); }
__device__ __forceinline__ float silu_f(float x) { return x * __builtin_amdgcn_rcpf(1.0f + __expf(-x)); }
__device__ __forceinline__ float softplus_f(float x) { return x > 20.0f ? x : log1pf(__expf(x)); }
__device__ __forceinline__ void lds_barrier() { asm volatile("s_waitcnt lgkmcnt(0)" ::: "memory"); __builtin_amdgcn_s_barrier(); asm volatile("" ::: "memory"); }
__device__ __forceinline__ unsigned long long opaque_u64(unsigned long long v) { unsigned lo = (unsigned)v, hi = (unsigned)(v >> 32); asm volatile("" : "+v"(lo), "+v"(hi));
    lo = __builtin_amdgcn_readfirstlane(lo); hi = __builtin_amdgcn_readfirstlane(hi); return ((unsigned long long)hi << 32) | lo; }
__device__ __forceinline__ unsigned opaque_u32(unsigned v) { asm volatile("" : "+v"(v)); return __builtin_amdgcn_readfirstlane(v); }
constexpr int LDS_BASES = 160 * 1024 - 256 + 32;
__device__ __forceinline__ unsigned long long ld_base(int k) { const volatile LAS unsigned* q = (const volatile LAS unsigned*)(unsigned long)(LDS_BASES + 8 * k);
    const unsigned lo = __builtin_amdgcn_readfirstlane(q[0]), hi = __builtin_amdgcn_readfirstlane(q[1]); return ((unsigned long long)hi << 32) | lo; }
__device__ __forceinline__ void phase_bases(Params& p) { p.ws = (unsigned char*)ld_base(0); p.out = (float*)ld_base(1); }
__device__ __forceinline__ int opaque_tid() { int t = threadIdx.x; asm volatile("" : "+v"(t)); return t; }
__device__ __forceinline__ float lane_xor(float v, int k, int lane) { return __int_as_float(__builtin_amdgcn_ds_bpermute((lane ^ k) << 2, __float_as_int(v))); }
__device__ __forceinline__ float lane_up(float v, int k, int lane) { return __int_as_float(__builtin_amdgcn_ds_bpermute(((lane - k) & 63) << 2, __float_as_int(v))); }
template <int CTRL> __device__ __forceinline__ float dpp_mov(float v) { return __int_as_float(__builtin_amdgcn_update_dpp(0, __float_as_int(v), CTRL, 0xf, 0xf, true)); }
__device__ __forceinline__ float sum4(float v) { v += dpp_mov<0xB1>(v); v += dpp_mov<0x4E>(v); return v; }
__device__ __forceinline__ float sum8(float v) { v = sum4(v); v += dpp_mov<0x141>(v); return v; }
__device__ __forceinline__ float sum16(float v) { v = sum8(v); v += dpp_mov<0x140>(v); return v; }
__device__ __forceinline__ float wave_sum(float v, int lane) { v = sum16(v); v += lane_xor(v, 16, lane); v += lane_xor(v, 32, lane); return v; }


#define XB_TMO      128
#define XB_XCNT(j)  (256  + 64 * (j))
#define XB_XSUB(j)  (1280 + 64 * (j))
#define XB_XGEN(j)  (2304 + 64 * (j))
#define XB_TOP      3328
#define XB_TOPGEN   3392
#define XCD_BAR_WORDS 3456
#define XB_SPIN_CAP (1u << 22)
__device__ __forceinline__ unsigned xb_ld(unsigned* p)              { return __hip_atomic_load(p, __ATOMIC_RELAXED, __HIP_MEMORY_SCOPE_AGENT); }
__device__ __forceinline__ unsigned xb_add(unsigned* p, unsigned v) { return __hip_atomic_fetch_add(p, v, __ATOMIC_RELAXED, __HIP_MEMORY_SCOPE_AGENT); }
__device__ __forceinline__ unsigned xb_xcc_id() { return (unsigned)__builtin_amdgcn_s_getreg((3 << 11) | 20) & 0xFu; }
#define XB_SPIN(cond, bar) do { unsigned _sp = 0; while (cond) { __builtin_amdgcn_s_sleep(1); \
    if ((++_sp & 255u) == 0u) { if (xb_ld(&(bar)[XB_TMO])) break; if (_sp > XB_SPIN_CAP) { atomicAdd(&(bar)[XB_TMO], 1u); break; } } } } while (0)
struct XcdBarrier { unsigned* bar; unsigned x; volatile LAS unsigned* st; };
__device__ __forceinline__ XcdBarrier xcd_barrier_post(unsigned* bar, volatile LAS unsigned* st) {
    XcdBarrier b; b.bar = bar; b.x = xb_xcc_id(); b.st = st;
    if (threadIdx.x == 0) (void)xb_add(&bar[XB_XCNT(b.x)], 1u);
    return b;
}
__device__ __forceinline__ void xcd_barrier_complete(unsigned* bar, unsigned x, unsigned& nloc, unsigned& nx) {
    const unsigned G = gridDim.x * gridDim.y * gridDim.z;
    unsigned sum, cnt, mine, sp = 0u;
    for (;;) {
        sum = 0u; cnt = 0u; mine = 0u;
#pragma unroll
        for (unsigned j = 0; j < 16; ++j) { const unsigned c = xb_ld(&bar[XB_XCNT(j)]); sum += c; cnt += (c > 0u) ? 1u : 0u; mine = (j == x) ? c : mine; }
        if (sum == G) break;
        __builtin_amdgcn_s_sleep(1);
        if ((++sp & 255u) == 0u) { if (xb_ld(&bar[XB_TMO])) break; if (sp > XB_SPIN_CAP) { atomicAdd(&bar[XB_TMO], 1u); break; } }
    }
    nloc = mine > 0u ? mine : 1u; nx = cnt > 0u ? cnt : 1u;
}
__device__ __forceinline__ void xcd_barrier(const XcdBarrier& b0) {
    asm volatile("s_waitcnt vmcnt(0)" ::: "memory");
    __syncthreads();
    if (threadIdx.x == 0) {
        XcdBarrier b = b0; { unsigned x = xb_xcc_id(); asm volatile("" : "+s"(x)); b.x = x; }
        unsigned* bar = b.bar;
        __builtin_amdgcn_s_waitcnt(0);
        unsigned nloc = b.st[0], nx = b.st[1];
        if (nloc == 0u) { xcd_barrier_complete(bar, b.x, nloc, nx); b.st[0] = nloc; b.st[1] = nx; }
        const unsigned old = xb_add(&bar[XB_XSUB(b.x)], 1u);
        const unsigned gen = old / nloc;
        if (old + 1u == (gen + 1u) * nloc) {
            __builtin_amdgcn_fence(__ATOMIC_RELEASE, "agent");
            asm volatile("s_waitcnt vmcnt(0)" ::: "memory");
            const unsigned og = xb_add(&bar[XB_TOP], 1u);
            const unsigned tg = og / nx;
            if (og + 1u == (tg + 1u) * nx) xb_add(&bar[XB_TOPGEN], 1u);
            else XB_SPIN(xb_ld(&bar[XB_TOPGEN]) == tg, bar);
            xb_add(&bar[XB_XGEN(b.x)], 1u);
            __builtin_amdgcn_fence(__ATOMIC_ACQUIRE, "agent");
            asm volatile("s_waitcnt vmcnt(0)" ::: "memory");
        } else {
            XB_SPIN(xb_ld(&bar[XB_XGEN(b.x)]) == gen, bar);
            __builtin_amdgcn_fence(__ATOMIC_ACQUIRE, "agent");
            asm volatile("s_waitcnt vmcnt(0)" ::: "memory");
        }
    }
    __syncthreads();
}

constexpr int FLAG_WORD0 = 3600;
__device__ __forceinline__ void flag_publish(unsigned* flag) {
    asm volatile("s_waitcnt vmcnt(0)" ::: "memory"); __syncthreads();
    if (threadIdx.x == 0) { __builtin_amdgcn_fence(__ATOMIC_RELEASE, "agent"); asm volatile("s_waitcnt vmcnt(0)" ::: "memory"); (void)xb_add(flag, 1u); }
}
__device__ __forceinline__ void flag_wait(unsigned* flag, unsigned target, unsigned* bar) {
    if (threadIdx.x == 0) { XB_SPIN(xb_ld(flag) < target, bar); __builtin_amdgcn_fence(__ATOMIC_ACQUIRE, "agent"); asm volatile("s_waitcnt vmcnt(0)" ::: "memory"); }
    __syncthreads();
}

namespace pg8 {
constexpr int BM = 256, BK = 64, HALF = 128, HTB = HALF * BK * 2, STAGE_BYTES = 8 * HTB, NXCD = 8, WGM = 8;
__host__ __device__ __forceinline__ int lds_byte(int r, int c) { const int st = (r >> 4) * 2 + (c >> 5), rr = r & 15, cc = c & 31, ob = rr * 64 + cc * 2; return st * 1024 + (ob ^ (((ob >> 9) & 1) << 5)); }
__host__ __device__ __forceinline__ void stage_rc(int b, int& R, int& C) { const int st = b / 1024, sb = b % 1024, swz = sb ^ (((sb >> 9) & 1) << 5); R = (st >> 1) * 16 + swz / 64; C = (st & 1) * 32 + (swz % 64) / 2; }
__host__ __device__ __forceinline__ int perm32(int rho) { const int n = rho >> 4, i = rho & 15; return 8 * (i >> 2) + 4 * n + (i & 3); }
struct Unit { int pm, pn; };
struct Gemm { const bf16_t* A; const bf16_t* Bt; int M, N, K; };
struct StaticOrder {
    int nM, nN, nwg, G, c;
    __host__ __device__ void init(int M, int N, int G_, int c_) { nM = M / BM; nN = N / BM; nwg = nM * nN; G = G_; c = c_; }
    __host__ __device__ bool next(int i, Unit& u) const {
        const long L = (long)i * G + c; if (L >= nwg) return false;
        int wgid = (int)L; { const int q = nwg / NXCD, r = nwg % NXCD, xcd = wgid % NXCD, off = wgid / NXCD; wgid = (xcd < r ? xcd * (q + 1) : r * (q + 1) + (xcd - r) * q) + off; }
        const int nig = WGM * nN, gid = wgid / nig, fm = gid * WGM, gsz = (nM - fm) < WGM ? (nM - fm) : WGM;
        u.pm = fm + ((wgid % nig) % gsz); u.pn = (wgid % nig) / gsz; return true;
    }
    __device__ __forceinline__ void a_ready(const Unit&) const {}
    __device__ __forceinline__ void done(const Unit&) const {}
};
typedef float f32x2_t __attribute__((ext_vector_type(2)));
typedef __bf16 bf16x2n_t __attribute__((ext_vector_type(2)));
struct OneUnit { int pm, pn;
    __device__ __forceinline__ bool next(int i, Unit& u) const { if (i) return false; u.pm = pm; u.pn = pn; return true; }
    __device__ __forceinline__ void a_ready(const Unit&) const {}
    __device__ __forceinline__ void done(const Unit&) const {}
};
__device__ __forceinline__ unsigned cvt_pk_bf16(float lo, float hi) { const f32x2_t f = {lo, hi}; return __builtin_bit_cast(unsigned, __builtin_convertvector(f, bf16x2n_t)); }

struct EpiProj {
    static constexpr bool PERM = true, AFTER_DRAIN = false;
    bf16_t* O; int ldc; const float* rs;
    struct Pre { float s[4]; };
    __device__ __forceinline__ void pre(Pre& q, const Unit& u, int wr, int fr) const {
#pragma unroll
        for (int m = 0; m < 4; ++m) q.s[m] = rs[u.pm * BM + wr * 64 + fr + m * 16]; }
    __device__ __forceinline__ void operator()(const f32x4 (&acc)[2][2][4][2], const Unit& u, int wr, int wc, int fr, int fq, const Pre& q) const {
        const int row0 = u.pm * BM + wr * 64 + fr; const int col0 = u.pn * BM + wc * 32 + 8 * fq;
        float s1[4];
#pragma unroll
        for (int m = 0; m < 4; ++m) s1[m] = rs[row0 + HALF + m * 16];
#pragma unroll
        for (int ai = 0; ai < 2; ++ai)
#pragma unroll
            for (int m = 0; m < 4; ++m) { const int row = row0 + ai * HALF + m * 16; const float s = ai == 0 ? q.s[m] : s1[m]; bf16_t* rowp = O + (size_t)row * ldc + col0;
#pragma unroll
                for (int bj = 0; bj < 2; ++bj) { const f32x4 v0 = acc[ai][bj][m][0] * s, v1 = acc[ai][bj][m][1] * s;
                    u32x4 w; w.x = cvt_pk_bf16(v0[0], v0[1]); w.y = cvt_pk_bf16(v0[2], v0[3]); w.z = cvt_pk_bf16(v1[0], v1[1]); w.w = cvt_pk_bf16(v1[2], v1[3]);
                    *(u32x4*)(rowp + bj * HALF) = w; } }
    }
};
struct EpiResid {
    static constexpr bool PERM = true, AFTER_DRAIN = false;
    bf16_t* H; int ldc;
    struct Pre {};
    __device__ __forceinline__ void pre(Pre&, const Unit&, int, int) const {}
    __device__ __forceinline__ void operator()(const f32x4 (&acc)[2][2][4][2], const Unit& u, int wr, int wc, int fr, int fq, const Pre&) const {
        const int row0 = u.pm * BM + wr * 64 + fr, col0 = u.pn * BM + wc * 32 + 8 * fq;
#pragma unroll
        for (int ai = 0; ai < 2; ++ai) {
            u32x4 o[4][2];
#pragma unroll
            for (int m = 0; m < 4; ++m)
#pragma unroll
                for (int bj = 0; bj < 2; ++bj) o[m][bj] = *(const u32x4*)(H + (size_t)(row0 + ai * HALF + m * 16) * ldc + col0 + bj * HALF);
#pragma unroll
            for (int m = 0; m < 4; ++m)
#pragma unroll
                for (int bj = 0; bj < 2; ++bj) { const u32x4 ov = o[m][bj]; const f32x4 a0 = acc[ai][bj][m][0], a1 = acc[ai][bj][m][1]; u32x4 w;
                    w.x = cvt_pk_bf16(__uint_as_float(ov.x << 16) + a0[0], __uint_as_float(ov.x & 0xffff0000u) + a0[1]); w.y = cvt_pk_bf16(__uint_as_float(ov.y << 16) + a0[2], __uint_as_float(ov.y & 0xffff0000u) + a0[3]);
                    w.z = cvt_pk_bf16(__uint_as_float(ov.z << 16) + a1[0], __uint_as_float(ov.z & 0xffff0000u) + a1[1]); w.w = cvt_pk_bf16(__uint_as_float(ov.w << 16) + a1[2], __uint_as_float(ov.w & 0xffff0000u) + a1[3]);
                    *(u32x4*)(H + (size_t)(row0 + ai * HALF + m * 16) * ldc + col0 + bj * HALF) = w; } }
    }
};

template <class Epi, class Sched>
__device__ __forceinline__ void gemm_phase(LAS unsigned char* lds, const Gemm g, const Sched& S, const Epi& E) {
    const int tid = opaque_tid(), wid = __builtin_amdgcn_readfirstlane(tid >> 6), lane = tid & 63, wr = wid >> 2, wc = wid & 3, fr = lane & 15, fq = lane >> 4;
    const int K = g.K, nt = K / BK;
    unsigned voffA[2], voffB[2];
#pragma unroll
    for (int i = 0; i < 2; ++i) { int R, C; stage_rc(tid * 16 + i * 8192, R, C); const int Rb = Epi::PERM ? ((R & ~31) + perm32(R & 31)) : R;
        voffA[i] = (unsigned)(R * K + C) * 2u; voffB[i] = (unsigned)(Rb * K + C) * 2u; }
    const size_t kstep = (size_t)(BK * 2);
    const size_t hstep = (size_t)HALF * K * 2;
    const size_t tstep = 2 * hstep;
    const unsigned ldsw = (unsigned)wid * 1024u;
    const int aoff = lds_byte(wr * 64 + fr, fq * 8), boff = lds_byte(wc * 32 + fr, fq * 8);
#define PG8_SA(b, h) (((b) * 2 + (h)) * HTB)
#define PG8_SB(b, h) ((4 + (b) * 2 + (h)) * HTB)
#define PG8_STAGE(bufoff, gbase, voff) do { _Pragma("unroll") for (int _i = 0; _i < 2; ++_i) \
        __builtin_amdgcn_global_load_lds((const unsigned*)((const char*)(gbase) + (voff)[_i]), (LAS unsigned*)(lds + (bufoff) + ldsw + _i * 8192), 16, 0, 0); } while (0)
#define PG8_LDA(dst, b, h) do { _Pragma("unroll") for (int m = 0; m < 4; ++m) _Pragma("unroll") for (int k = 0; k < 2; ++k) dst[m][k] = *(const LAS bf16x8*)(lds + PG8_SA(b, h) + aoff + m * 2048 + k * 1024); } while (0)
#define PG8_LDB(dst, b, h) do { _Pragma("unroll") for (int n = 0; n < 2; ++n) _Pragma("unroll") for (int k = 0; k < 2; ++k) dst[n][k] = *(const LAS bf16x8*)(lds + PG8_SB(b, h) + boff + n * 2048 + k * 1024); } while (0)
#define PG8_MMA(ai, bj, At, Bt) do { __builtin_amdgcn_s_setprio(1); _Pragma("unroll") for (int m = 0; m < 4; ++m) _Pragma("unroll") for (int n = 0; n < 2; ++n) _Pragma("unroll") for (int k = 0; k < 2; ++k) \
        acc[ai][bj][m][n] = __builtin_amdgcn_mfma_f32_16x16x32_bf16(Bt[n][k], At[m][k], acc[ai][bj][m][n], 0, 0, 0); __builtin_amdgcn_s_setprio(0); } while (0)
#define PG8_WAIT_V(n) asm volatile("s_waitcnt vmcnt(" #n ")" ::: "memory")
#define PG8_WAIT_L(n) asm volatile("s_waitcnt lgkmcnt(" #n ")" ::: "memory")
#define PG8_BAR __builtin_amdgcn_s_barrier()
#define PG8_SCHED __builtin_amdgcn_sched_barrier(0)
    Unit cur, nxt; int ui = 0;
    if (!S.next(0, cur)) return;
    f32x4 acc[2][2][4][2];
#pragma unroll
    for (int a = 0; a < 2; ++a)
#pragma unroll
        for (int b = 0; b < 2; ++b)
#pragma unroll
            for (int m = 0; m < 4; ++m)
#pragma unroll
                for (int n = 0; n < 2; ++n) acc[a][b][m][n] = (f32x4){0.f, 0.f, 0.f, 0.f};
    bf16x8 At[4][2], B0[2][2], B1[2][2];
    const char* cA = (const char*)g.A + (size_t)cur.pm * tstep; const char* cB = (const char*)g.Bt + (size_t)cur.pn * tstep;
    S.a_ready(cur);
    PG8_STAGE(PG8_SB(0, 0), cB, voffB); PG8_STAGE(PG8_SA(0, 0), cA, voffA); PG8_STAGE(PG8_SB(0, 1), cB + hstep, voffB); PG8_STAGE(PG8_SA(0, 1), cA + hstep, voffA);
    if (wr == 1) PG8_BAR;
    PG8_WAIT_V(4); PG8_BAR;
    PG8_STAGE(PG8_SB(1, 0), cB + kstep, voffB); PG8_STAGE(PG8_SA(1, 0), cA + kstep, voffA); PG8_STAGE(PG8_SB(1, 1), cB + hstep + kstep, voffB);
    PG8_WAIT_V(6); PG8_BAR;
    for (;;) {
        const bool has_next = S.next(ui + 1, nxt);
        typename Epi::Pre epre; E.pre(epre, cur, wr, fr);
        const char* nA = has_next ? (const char*)g.A + (size_t)nxt.pm * tstep : cA; const char* nB = has_next ? (const char*)g.Bt + (size_t)nxt.pn * tstep : cB;
        for (int t = 0; t < nt; t += 2) {
            const bool last = (t == nt - 2);
            const char* a1 = cA + (size_t)(t + 1) * kstep;
            const char* a2 = last ? nA : cA + (size_t)(t + 2) * kstep; const char* b2 = last ? nB : cB + (size_t)(t + 2) * kstep;
            const char* a3 = a2 + kstep; const char* b3 = b2 + kstep;
            if (last && has_next) S.a_ready(nxt);
            PG8_LDB(B0, 0, 0); PG8_SCHED; PG8_LDA(At, 0, 0); PG8_STAGE(PG8_SA(1, 1), a1 + hstep, voffA);
            PG8_WAIT_L(8); PG8_BAR; PG8_WAIT_L(0); PG8_MMA(0, 0, At, B0); PG8_BAR; PG8_SCHED;
            PG8_LDB(B1, 0, 1); PG8_STAGE(PG8_SB(0, 0), b2, voffB);
            PG8_BAR; PG8_WAIT_L(0); PG8_MMA(0, 1, At, B1); PG8_BAR;
            PG8_LDA(At, 0, 1); PG8_STAGE(PG8_SA(0, 0), a2, voffA);
            PG8_BAR; PG8_WAIT_L(0); PG8_MMA(1, 0, At, B0); PG8_BAR; PG8_SCHED;
            PG8_STAGE(PG8_SB(0, 1), b2 + hstep, voffB);
            PG8_WAIT_V(6); PG8_BAR; PG8_MMA(1, 1, At, B1); PG8_BAR;
            PG8_LDB(B0, 1, 0); PG8_SCHED; PG8_LDA(At, 1, 0); PG8_STAGE(PG8_SA(0, 1), a2 + hstep, voffA);
            PG8_WAIT_L(8); PG8_BAR; PG8_WAIT_L(0); PG8_MMA(0, 0, At, B0); PG8_BAR; PG8_SCHED;
            PG8_LDB(B1, 1, 1); PG8_STAGE(PG8_SB(1, 0), b3, voffB);
            PG8_BAR; PG8_WAIT_L(0); PG8_MMA(0, 1, At, B1); PG8_BAR;
            PG8_LDA(At, 1, 1); PG8_STAGE(PG8_SA(1, 0), a3, voffA);
            PG8_BAR; PG8_WAIT_L(0); PG8_MMA(1, 0, At, B0); PG8_BAR; PG8_SCHED;
            PG8_STAGE(PG8_SB(1, 1), b3 + hstep, voffB);
            PG8_WAIT_V(6); PG8_BAR; PG8_MMA(1, 1, At, B1); PG8_BAR;
        }
        if constexpr (!Epi::AFTER_DRAIN) { E(acc, cur, wr, wc, fr, fq, epre); S.done(cur); }
        if (!has_next) break;
#pragma unroll
        for (int a = 0; a < 2; ++a)
#pragma unroll
            for (int b = 0; b < 2; ++b)
#pragma unroll
                for (int m = 0; m < 4; ++m)
#pragma unroll
                    for (int n = 0; n < 2; ++n) acc[a][b][m][n] = (f32x4){0.f, 0.f, 0.f, 0.f};
        cur = nxt; cA = nA; cB = nB; ++ui;
    }
    PG8_WAIT_V(0);
    if (wr == 0) PG8_BAR;
    PG8_BAR;
#undef PG8_SA
#undef PG8_SB
#undef PG8_STAGE
#undef PG8_LDA
#undef PG8_LDB
#undef PG8_MMA
#undef PG8_WAIT_V
#undef PG8_WAIT_L
#undef PG8_BAR
#undef PG8_SCHED
}
}

__device__ __forceinline__ int win_col(int n) { return n < 2048 ? n : (n < 3072 ? n + 8 : n + 12); }
__device__ __forceinline__ int win_smcol(int j) { return j < 8 ? 2048 + j : 3080 + (j - 8); }

__device__ __forceinline__ void convert_weights(const Params& p, int l_in, int l_out, LAS float* tile  , int tid, int blk, int nblk, int t_lo = 0, int t_hi = 1 << 30) {
    const int tiles_in = l_in >= 0 ? 64 * 16 : 0, ntot_ = tiles_in + (l_out >= 0 ? 16 * 16 : 0), ntot = ntot_ < t_hi ? ntot_ : t_hi; blk += t_lo;
    float v[8];
    auto fetch = [&](int t) {
        const float* src; int ld, k0; const float* scale;
        if (t < tiles_in) { k0 = (t % 16) * 64; src = p.w_in + (size_t)l_in * DM * IN_DIM + win_col((t / 16) * 64); ld = IN_DIM; scale = p.norm_w + l_in * DM; }
        else { const int r = t - tiles_in; k0 = (r % 16) * 64; src = p.w_out + (size_t)l_out * DM * DM + (r / 16) * 64; ld = DM; scale = nullptr; }
#pragma unroll
        for (int n_ = 0; n_ < 8; ++n_) { const int e = tid + 512 * n_; const int kk = e >> 6, nn = e & 63; v[n_] = src[(size_t)(k0 + kk) * ld + nn]; }
        if (scale) {
#pragma unroll
            for (int n_ = 0; n_ < 8; ++n_) v[n_] *= scale[k0 + ((tid + 512 * n_) >> 6)]; }
    };
    if (blk < ntot) fetch(blk);
    for (int t = blk; t < ntot; t += nblk) {
        bf16_t* dst; int n0, k0;
        if (t < tiles_in) { n0 = (t / 16) * 64; k0 = (t % 16) * 64; dst = (bf16_t*)(p.ws + WS_WINT); }
        else { const int r = t - tiles_in; n0 = (r / 16) * 64; k0 = (r % 16) * 64; dst = (bf16_t*)(p.ws + WS_WOUTT); }
        __syncthreads();
#pragma unroll
        for (int n_ = 0; n_ < 8; ++n_) { const int e = tid + 512 * n_; tile[(e >> 6) * 65 + (e & 63)] = v[n_]; }
        if (t + nblk < ntot) fetch(t + nblk);
        __syncthreads();
#pragma unroll
        for (int n_ = 0; n_ < 4; ++n_) { const int e = tid + 512 * n_; const int nn = e >> 5, kp = (e & 31) * 2; const unsigned w = pack_bf2(tile[kp * 65 + nn], tile[(kp + 1) * 65 + nn]);
            *(unsigned*)(dst + (size_t)(n0 + nn) * DM + k0 + kp) = w; }
    }
    __syncthreads();
}

__device__ __forceinline__ void ph_prep(const Params& p_in, LAS unsigned char* lds_in, int blk, int nblk) {
    Params p = p_in; p.ws = (unsigned char*)ld_base(0); p.out = (float*)ld_base(1);
    LAS unsigned char* lds = (LAS unsigned char*)opaque_u32((unsigned)(unsigned long)lds_in);

    const int tid = opaque_tid();
    LAS float* tile = (LAS float*)lds;
    convert_weights(p, 0, -1, tile, tid, blk, nblk);
    for (int e = blk * 512 + tid; e < DEPTH * 32 * 2 * 64; e += nblk * 512) { const int l = e >> 12, r = e & 4095, ks = r >> 7, hl = (r >> 6) & 1, ln = r & 63, q = ln & 15, k0 = ks * 32 + 8 * (ln >> 4);
        unsigned hv[8];
#pragma unroll
        for (int x = 0; x < 8; ++x) { const int k = k0 + x; const float v = q < NSM ? p.w_in[(size_t)l * DM * IN_DIM + (size_t)k * IN_DIM + win_smcol(q < NSM ? q : 0)] * p.norm_w[l * DM + k] : 0.f;
            const bf16_t hi = f2bf(v); hv[x] = hl ? (unsigned)f2bf(v - bf2f(hi)) : (unsigned)hi; }
        u32x4 w; w.x = hv[0] | (hv[1] << 16); w.y = hv[2] | (hv[3] << 16); w.z = hv[4] | (hv[5] << 16); w.w = hv[6] | (hv[7] << 16);
        ((u32x4*)(p.ws + WS_WSMB))[e] = w; }
    for (int c = blk * 512 + tid; c < 256; c += nblk * 512) { float lg[DEPTH], mx = -1e30f;
#pragma unroll
        for (int l = 0; l < DEPTH; ++l) { lg[l] = p.lb_logits[l * 256 + c]; mx = fmaxf(mx, lg[l]); }
        float s = 0.f;
#pragma unroll
        for (int l = 0; l < DEPTH; ++l) { lg[l] = expf(lg[l] - mx); s += lg[l]; }
        float cum = 0.f; const float w0 = lg[0] / s;
#pragma unroll
        for (int l = 0; l < DEPTH; ++l) { cum += lg[l] / s; ((float*)(p.ws + WS_LB))[l * 256 + c] = fmaxf(cum - w0, 0.f); } }
    for (int e = blk * 512 + tid; e < (TP + 1) * 32; e += nblk * 512) { const int pi = e >> 5, i = e & 31; const double pos = pi < TP ? (double)pi : (double)PASTLEN;
        const float invf = (float)(1.0 / pow(10000.0, (double)((float)i / 31.0f)));
        const double rev = pos * (double)invf * 0.15915494309189535; const float fr = (float)(rev - rint(rev));
        ((float*)(p.ws + WS_ROT))[e * 2 + 0] = __builtin_amdgcn_cosf(fr); ((float*)(p.ws + WS_ROT))[e * 2 + 1] = __builtin_amdgcn_sinf(fr); }
}

constexpr int MMAIN = 16384;
__device__ __forceinline__ void out_tail(const Params& p, int layer, LAS unsigned char* lds, int blk, int nblk) {
    const int tid = opaque_tid(), wid = __builtin_amdgcn_readfirstlane(tid >> 6), lane = tid & 63, fr = lane & 15, fq = lane >> 4;
    const bf16_t* Y = (const bf16_t*)(p.ws + WS_Y); const bf16_t* W = (const bf16_t*)(p.ws + WS_WOUTT); bf16_t* h = (bf16_t*)(p.ws + WS_HB);
    LAS float* part = (LAS float*)lds;
    for (int t = blk; t < 256; t += nblk) {
        const int r0 = MMAIN + (t >> 5) * 32, c0 = (t & 31) * 32, k0 = wid * 128 + 8 * fq;
        bf16x8 a[4][2], b[4][2];
#pragma unroll
        for (int ks = 0; ks < 4; ++ks)
#pragma unroll
            for (int i = 0; i < 2; ++i) { a[ks][i] = *(const bf16x8*)(Y + (size_t)(r0 + 16 * i + fr) * DM + k0 + 32 * ks); b[ks][i] = *(const bf16x8*)(W + (size_t)(c0 + 16 * i + fr) * DM + k0 + 32 * ks); }
        f32x4 acc[2][2];
#pragma unroll
        for (int i = 0; i < 2; ++i)
#pragma unroll
            for (int j = 0; j < 2; ++j) acc[i][j] = (f32x4){0.f, 0.f, 0.f, 0.f};
#pragma unroll
        for (int ks = 0; ks < 4; ++ks)
#pragma unroll
            for (int i = 0; i < 2; ++i)
#pragma unroll
                for (int j = 0; j < 2; ++j) acc[i][j] = __builtin_amdgcn_mfma_f32_16x16x32_bf16(a[ks][i], b[ks][j], acc[i][j], 0, 0, 0);
        __syncthreads();
#pragma unroll
        for (int i = 0; i < 2; ++i)
#pragma unroll
            for (int j = 0; j < 2; ++j) *(LAS f32x4*)(part + wid * 1024 + ((i * 2 + j) * 64 + lane) * 4) = acc[i][j];
        __syncthreads();
        { const int row = tid >> 4, col = (tid & 15) * 2;
            const int idx = ((((row >> 4) * 2 + (col >> 4)) * 64 + ((row & 15) >> 2) * 16 + (col & 15)) * 4) + (row & 3);
            float s0 = 0.f, s1 = 0.f;
#pragma unroll
            for (int w = 0; w < 8; ++w) { s0 += part[w * 1024 + idx]; s1 += part[w * 1024 + idx + 4]; }
            unsigned* hp = (unsigned*)(h + (size_t)(r0 + row) * DM + c0 + col); const unsigned hv = *hp; *hp = pack_bf2(__uint_as_float(hv << 16) + s0, __uint_as_float(hv & 0xffff0000u) + s1); }
    }
}
template <bool INIT>
__device__ __forceinline__ void rn_groups(const Params& p, int layer, LAS unsigned char* lds, int blk, int nblk, int g_lo, int g_hi) {
    const int tid = opaque_tid(), wid = __builtin_amdgcn_readfirstlane(tid >> 6), lane = tid & 63;
    bf16_t* h = (bf16_t*)(p.ws + WS_HB); float* rs = (float*)(p.ws + WS_RS); float* psm = (float*)(p.ws + WS_PSM);
    const __amdgpu_buffer_rsrc_t wbr = __builtin_amdgcn_make_buffer_rsrc(p.ws + WS_WSMB + (size_t)layer * 65536, 0, 65536, 0x00020000);
    LAS float* red = (LAS float*)lds;
        const int wu = __builtin_amdgcn_readfirstlane(wid), pw = wu >> 1, kh = wu & 1, fc = lane & 15, fq = lane >> 4;
        for (int g0 = g_lo + blk * 4; g0 < g_hi; g0 += nblk * 4) { const int grp = g0 + pw; const bool valid = grp < g_hi;
            f32x4 acc = (f32x4){0.f, 0.f, 0.f, 0.f}; float ssl = 0.f;
            if (valid) { const int row = grp * 16 + fc, kb = kh * 512 + 8 * fq;
                bf16x8 a[16];
                if (!INIT) {
#pragma unroll
                    for (int ks = 0; ks < 16; ++ks) a[ks] = *(const bf16x8*)(h + (size_t)row * DM + kb + 32 * ks);
                } else { const float* src;
                    if (row < MP) { const int b = row / TP, t = row % TP; src = t < NMETA ? p.meta + t * DM : p.x_prompt + ((size_t)b * SEQ + (t - NMETA)) * DM; } else src = p.x_sample + (size_t)(row - MP) * DM;
                    const float* sp = src + kb; bf16_t* hp = h + (size_t)row * DM + kb;
                    asm volatile("" : "+v"(sp), "+v"(hp));
#pragma unroll
                    for (int k4 = 0; k4 < 2; ++k4) { f32x4 raw[8][2];
#pragma unroll
                        for (int x = 0; x < 8; ++x) { raw[x][0] = *(const f32x4*)(sp + 32 * (8 * k4 + x)); raw[x][1] = *(const f32x4*)(sp + 32 * (8 * k4 + x) + 4); }
#pragma unroll
                        for (int x = 0; x < 8; ++x) { u32x4 w; w.x = pack_bf2(raw[x][0][0], raw[x][0][1]); w.y = pack_bf2(raw[x][0][2], raw[x][0][3]); w.z = pack_bf2(raw[x][1][0], raw[x][1][1]); w.w = pack_bf2(raw[x][1][2], raw[x][1][3]);
                            *(u32x4*)(hp + 32 * (8 * k4 + x)) = w; a[8 * k4 + x] = __builtin_bit_cast(bf16x8, w); } } }
                f32x4 acc1 = (f32x4){0.f, 0.f, 0.f, 0.f};
                if (!INIT) { u32x4 bw[32];
#pragma unroll
                    for (int j = 0; j < 16; ++j) { const int so = (kh * 16 + j) * 2048; bw[2 * j] = __builtin_amdgcn_raw_buffer_load_b128(wbr, lane * 16, so, 0); bw[2 * j + 1] = __builtin_amdgcn_raw_buffer_load_b128(wbr, lane * 16 + 1024, so, 0); }
                    __builtin_amdgcn_sched_barrier(0);
#pragma unroll
                    for (int j = 0; j < 16; ++j) { acc = __builtin_amdgcn_mfma_f32_16x16x32_bf16(a[j], __builtin_bit_cast(bf16x8, bw[2 * j]), acc, 0, 0, 0); acc1 = __builtin_amdgcn_mfma_f32_16x16x32_bf16(a[j], __builtin_bit_cast(bf16x8, bw[2 * j + 1]), acc1, 0, 0, 0); } }
                else {
#pragma unroll
                    for (int hf = 0; hf < 2; ++hf) { u32x4 bw[16];
#pragma unroll
                        for (int j = 0; j < 8; ++j) { const int so = (kh * 16 + hf * 8 + j) * 2048; bw[2 * j] = __builtin_amdgcn_raw_buffer_load_b128(wbr, lane * 16, so, 0); bw[2 * j + 1] = __builtin_amdgcn_raw_buffer_load_b128(wbr, lane * 16 + 1024, so, 0); }
#pragma unroll
                        for (int j = 0; j < 8; ++j) { acc = __builtin_amdgcn_mfma_f32_16x16x32_bf16(a[hf * 8 + j], __builtin_bit_cast(bf16x8, bw[2 * j]), acc, 0, 0, 0); acc1 = __builtin_amdgcn_mfma_f32_16x16x32_bf16(a[hf * 8 + j], __builtin_bit_cast(bf16x8, bw[2 * j + 1]), acc1, 0, 0, 0); } } }
                acc = acc + acc1;
#pragma unroll
                for (int ks = 0; ks < 16; ++ks) { const u32x4 w = __builtin_bit_cast(u32x4, a[ks]);
#pragma unroll
                    for (int x = 0; x < 4; ++x) { const float lo = __uint_as_float(w[x] << 16), hi = __uint_as_float(w[x] & 0xffff0000u); ssl += lo * lo + hi * hi; } }
                ssl += lane_xor(ssl, 16, lane); ssl += lane_xor(ssl, 32, lane); }
            *(LAS f32x4*)(red + wid * 256 + lane * 4) = acc; if (lane < 16) red[2048 + wid * 16 + lane] = ssl;
            __syncthreads();
            if (valid && kh == 0) { const f32x4 o = *(const LAS f32x4*)(red + (wid + 1) * 256 + lane * 4);
#pragma unroll
                for (int r = 0; r < 4; ++r) { const int rw = 4 * fq + r; const float rr = rsqrtf((red[2048 + wid * 16 + rw] + red[2048 + (wid + 1) * 16 + rw]) * (1.0f / DM) + EPSF);
                    if (fc < NSM) psm[(size_t)(grp * 16 + rw) * NSM + fc] = (acc[r] + o[r]) * rr;
                    if (fc == 15) rs[grp * 16 + rw] = rr; } }
            __syncthreads();
        }
}
__device__ __forceinline__ void ph_rownorm(const Params& p_in, int layer, LAS unsigned char* lds_in, int blk, int nblk) {
    Params p = p_in; p.ws = (unsigned char*)ld_base(0); p.out = (float*)ld_base(1);
    LAS unsigned char* lds = (LAS unsigned char*)opaque_u32((unsigned)(unsigned long)lds_in);
    const bool has_tail = layer > 0;
    if (!has_tail) { rn_groups<true>(p, layer, lds, blk, nblk, 0, MROWS / 16); return; }
    rn_groups<false>(p, layer, lds, blk, nblk, 0, MMAIN / 16);
}

__device__ __forceinline__ void ph_gemm_in(const Params& p_in, int layer, LAS unsigned char* lds_in, int blk, int nblk) {
    Params p = p_in; p.ws = (unsigned char*)ld_base(0); p.out = (float*)ld_base(1);
    LAS unsigned char* lds = (LAS unsigned char*)opaque_u32((unsigned)(unsigned long)lds_in);

    pg8::Gemm g{(const bf16_t*)(p.ws + WS_HB), (const bf16_t*)(p.ws + WS_WINT), MMAIN, NBIG, DM};
    pg8::StaticOrder S; S.init(MMAIN, NBIG, nblk, blk);
    pg8::EpiProj E{(bf16_t*)(p.ws + WS_PROJ), NBIG, (const float*)(p.ws + WS_RS)};
    pg8::gemm_phase<pg8::EpiProj, pg8::StaticOrder>(lds, g, S, E);
}
__device__ __forceinline__ void ph_gemm_out(const Params& p_in, int layer, LAS unsigned char* lds_in, int blk, int nblk) {
    Params p = p_in; p.ws = (unsigned char*)ld_base(0); p.out = (float*)ld_base(1);
    LAS unsigned char* lds = (LAS unsigned char*)opaque_u32((unsigned)(unsigned long)lds_in);

    pg8::Gemm g{(const bf16_t*)(p.ws + WS_Y), (const bf16_t*)(p.ws + WS_WOUTT), MMAIN, DM, DM};
    pg8::StaticOrder S; S.init(MMAIN, DM, nblk, blk);
    pg8::EpiResid E{(bf16_t*)(p.ws + WS_HB), DM};
    pg8::gemm_phase<pg8::EpiResid, pg8::StaticOrder>(lds, g, S, E);
    out_tail(p, layer, lds, blk, nblk);
}

constexpr int TB = 16;
struct MixLds {
    static constexpr int QS = 0, KS = QS + TB * 128, VS = KS + TB * 128, DS = VS + TB * 128, ZS = DS + TB * 128, XS = ZS + TB * 128, OS = XS + TB * 128, BS = OS + TB * 128, SC = BS + TB * 2, END = SC + TB * 2;
};

struct SeqInfo { int row0, T, dec, b; };
__device__ __forceinline__ SeqInfo seq_info(int s) { SeqInfo q; if (s < NB) { q.row0 = s * TP; q.T = TP; q.dec = 0; q.b = s; } else { q.row0 = MP + (s - NB); q.T = 1; q.dec = 1; q.b = s - NB; } return q; }

__device__ __forceinline__ float preconv(const bf16_t* proj, const SeqInfo& q, int t, int col, const float* ctx  , int ch) {
    if (t >= 0) return bf2f(proj[(size_t)(q.row0 + t) * NBIG + col]);
    return ctx ? ctx[(3 + t) * 768 + ch] : 0.f;
}

template <int DK, int NV, bool DELTA, bool VECDEC>
__device__ __forceinline__ void recur_batch(float (&S)[DK / (64 / NV)], LAS float* L, int nb, int wid, int lane) {
    constexpr int KQ = 64 / NV, KR = DK / KQ, DVT = 8 * NV;
    const int kq = lane / NV, vv = lane % NV, vcol = wid * NV + vv, hh = vcol >> 6;
    for (int t = 0; t < nb; ++t) {
        float kk[KR], qq[KR];
#pragma unroll
        for (int i = 0; i < KR; ++i) { kk[i] = L[MixLds::KS + t * 128 + kq * KR + i]; qq[i] = L[MixLds::QS + t * 128 + kq * KR + i]; }
        const float v = L[MixLds::VS + t * 128 + vcol];
        if (DELTA) {
            const float dec = L[MixLds::DS + t * 128 + hh]; float pk = 0.f;
#pragma unroll
            for (int i = 0; i < KR; ++i) { S[i] *= dec; pk += kk[i] * S[i]; }
#pragma unroll
            for (int o = NV; o < 64; o <<= 1) pk += lane_xor(pk, o, lane);
            const float u = L[MixLds::BS + t] * (v - pk);
#pragma unroll
            for (int i = 0; i < KR; ++i) S[i] += kk[i] * u;
        } else if (VECDEC) {
#pragma unroll
            for (int i = 0; i < KR; ++i) S[i] = L[MixLds::DS + t * 128 + kq * KR + i] * S[i] + kk[i] * v;
        } else {
            const float dec = L[MixLds::DS + t * 128 + hh];
#pragma unroll
            for (int i = 0; i < KR; ++i) S[i] = dec * S[i] + kk[i] * v;
        }
        float po = 0.f;
#pragma unroll
        for (int i = 0; i < KR; ++i) po += qq[i] * S[i];
#pragma unroll
        for (int o = NV; o < 64; o <<= 1) po += lane_xor(po, o, lane);
        if (kq == 0) L[MixLds::OS + t * 128 + vcol] = po;
    }
    (void)DVT;
}

template <int MIX>
__device__ __forceinline__ void mixer_item(const Params& p, int layer, int s, int hu  , LAS float* L) {
    constexpr int DK = MIX == 2 ? 128 : 64, NV = MIX == 2 ? 16 : 8, KQ = 64 / NV, KR = DK / KQ, DVT = 8 * NV;
    const int tid = opaque_tid(), wid = __builtin_amdgcn_readfirstlane(tid >> 6), lane = tid & 63;
    const SeqInfo q = seq_info(s);
    const bf16_t* proj = (const bf16_t*)(p.ws + WS_PROJ); const float* psm = (const float*)(p.ws + WS_PSM); bf16_t* y = (bf16_t*)(p.ws + WS_Y);
    const float* lb = (const float*)(p.ws + WS_LB) + layer * 256; const float* rot = (const float*)(p.ws + WS_ROT);
    const int kq = lane / NV, vv = lane % NV, vcol = wid * NV + vv, hh = vcol >> 6;
    const int head = MIX == 2 ? hu * 2 + hh : hu;
    const float* ctx = nullptr; const float* cw = nullptr;
    if (MIX == 1) { cw = p.gdn_conv_w + (size_t)layer * 4 * 768; if (q.dec) ctx = p.st_gconv + ((size_t)layer * DECB + q.b) * 3 * 768; }
    if (MIX == 2) { cw = p.ssd_conv_w + (size_t)layer * 4 * 768; if (q.dec) ctx = p.st_sconv + ((size_t)layer * DECB + q.b) * 3 * 768; }
    float S[KR];
    {
        const float* st = MIX == 0 ? p.st_hgrn : MIX == 1 ? p.st_gdn : MIX == 2 ? p.st_ssd : p.st_ret;
#pragma unroll
        for (int i = 0; i < KR; ++i) S[i] = q.dec ? st[(((size_t)layer * DECB + q.b) * 4 + head) * DK * 64 + (size_t)(kq * KR + i) * 64 + (vcol & 63)] : 0.f;
    }
    float hc0 = 0.f, hc1 = 0.f;
    if (MIX == 1) { hc0 = -__expf(p.gdn_a_log[layer * 4 + hu]); hc1 = p.gdn_dt_bias[layer * 4 + hu]; }
    if (MIX == 3) { hc0 = 1.0f - exp2f(-5.0f - (float)hu); }

    for (int t0 = 0; t0 < q.T; t0 += TB) {
        const int nb = min(TB, q.T - t0);
        __syncthreads();
        if (MIX == 0) {
            for (int e = tid; e < nb * 64; e += 512) { const int t = e >> 6, d = e & 63, c = hu * 64 + d; const bf16_t* pr = proj + (size_t)(q.row0 + t0 + t) * NBIG;
                const float aq = bf2f(pr[PC_AQ + c]), af = bf2f(pr[PC_AF + c]), ai = bf2f(pr[PC_AI + c]), az = bf2f(pr[PC_AZ + c]), l_ = lb[c];
                L[MixLds::QS + t * 128 + d] = silu_f(aq) * 0.125f; L[MixLds::KS + t * 128 + d] = (1.0f - l_) * sigmoid_f(-af); L[MixLds::DS + t * 128 + d] = l_ + (1.0f - l_) * sigmoid_f(af);
                L[MixLds::VS + t * 128 + d] = ai; L[MixLds::ZS + t * 128 + d] = az; }
        } else if (MIX == 1) {
            for (int e = tid; e < nb * 192; e += 512) { const int t = e / 192, r = e % 192, part = r >> 6, d = r & 63, ch = part * 256 + hu * 64 + d, col = PC_BQKV + ch; const int tt = t0 + t;
                float a = 0.f;
#pragma unroll
                for (int j = 0; j < 4; ++j) a += cw[j * 768 + ch] * preconv(proj, q, tt - 3 + j, col, ctx, ch);
                a = silu_f(a);
                L[(part == 0 ? MixLds::QS : part == 1 ? MixLds::KS : MixLds::VS) + t * 128 + d] = a; }
            for (int e = tid; e < nb * 64; e += 512) { const int t = e >> 6, d = e & 63; L[MixLds::ZS + t * 128 + d] = bf2f(proj[(size_t)(q.row0 + t0 + t) * NBIG + PC_BZ + hu * 64 + d]); }
            if (tid < nb) { const float* ps = psm + (size_t)(q.row0 + t0 + tid) * NSM; const float g = hc0 * softplus_f(ps[hu] + hc1);
                L[MixLds::DS + tid * 128 + 0] = __expf(g); L[MixLds::BS + tid] = sigmoid_f(ps[4 + hu]); }
            __syncthreads();
            if (tid < nb * 2) { const int t = tid >> 1, which = tid & 1; const LAS float* src = L + (which ? MixLds::KS : MixLds::QS) + t * 128; float ss = 0.f;
                for (int d = 0; d < 64; ++d) ss += src[d] * src[d];
                L[MixLds::SC + tid] = rsqrtf(ss + EPSF) * (which ? 1.0f : 0.125f); }
            __syncthreads();
            for (int e = tid; e < nb * 128; e += 512) { const int t = e >> 7, r = e & 127, which = r >> 6, d = r & 63; L[(which ? MixLds::KS : MixLds::QS) + t * 128 + d] *= L[MixLds::SC + t * 2 + which]; }
        } else if (MIX == 2) {
            if (tid < nb * 2) { const int t = tid >> 1, h2 = tid & 1, hd = hu * 2 + h2; const float dt = softplus_f(psm[(size_t)(q.row0 + t0 + t) * NSM + 8 + hd] + p.ssd_dt_bias[layer * 4 + hd]);
                L[MixLds::BS + tid] = dt; L[MixLds::DS + t * 128 + h2] = __expf(-dt * __expf(p.ssd_a_log[layer * 4 + hd])); }
            __syncthreads();
            for (int e = tid; e < nb * 384; e += 512) { const int t = e / 384, r = e % 384, part = r >> 7, j = r & 127, ch = part * 256 + hu * 128 + j, col = PC_CXBC + ch; const int tt = t0 + t;
                float a = p.ssd_conv_b[layer * 768 + ch];
#pragma unroll
                for (int jj = 0; jj < 4; ++jj) a += cw[jj * 768 + ch] * preconv(proj, q, tt - 3 + jj, col, ctx, ch);
                a = silu_f(a);
                if (part == 0) { L[MixLds::XS + t * 128 + j] = a; L[MixLds::VS + t * 128 + j] = a * L[MixLds::BS + t * 2 + (j >> 6)]; }
                else if (part == 1) L[MixLds::KS + t * 128 + j] = a; else L[MixLds::QS + t * 128 + j] = a; }
            for (int e = tid; e < nb * 128; e += 512) { const int t = e >> 7, j = e & 127; L[MixLds::ZS + t * 128 + j] = bf2f(proj[(size_t)(q.row0 + t0 + t) * NBIG + PC_CZ + hu * 128 + j]); }
        } else {
            for (int e = tid; e < nb * 32; e += 512) { const int t = e >> 5, i = e & 31; const bf16_t* pr = proj + (size_t)(q.row0 + t0 + t) * NBIG; const int pidx = q.dec ? TP : (t0 + t);
                const float cs = rot[(pidx * 32 + i) * 2], sn = rot[(pidx * 32 + i) * 2 + 1];
                const float q1 = bf2f(pr[PC_DQ + hu * 64 + i]), q2 = bf2f(pr[PC_DQ + hu * 64 + 32 + i]), k1 = bf2f(pr[PC_DK + hu * 64 + i]), k2 = bf2f(pr[PC_DK + hu * 64 + 32 + i]);
                L[MixLds::QS + t * 128 + i] = q1 * cs - q2 * sn; L[MixLds::QS + t * 128 + 32 + i] = q2 * cs + q1 * sn;
                L[MixLds::KS + t * 128 + i] = (k1 * cs - k2 * sn) * 0.125f; L[MixLds::KS + t * 128 + 32 + i] = (k2 * cs + k1 * sn) * 0.125f; }
            for (int e = tid; e < nb * 64; e += 512) { const int t = e >> 6, d = e & 63; const bf16_t* pr = proj + (size_t)(q.row0 + t0 + t) * NBIG;
                L[MixLds::VS + t * 128 + d] = bf2f(pr[PC_DV + hu * 64 + d]); L[MixLds::ZS + t * 128 + d] = bf2f(pr[PC_DZ + hu * 64 + d]); }
            if (tid < nb) L[MixLds::DS + tid * 128] = hc0;
        }
        __syncthreads();
        recur_batch<DK, NV, MIX == 1, MIX == 0>(S, L, nb, wid, lane);
        __syncthreads();
        for (int t = wid; t < nb; t += 8) {
            const size_t yrow = (size_t)(q.row0 + t0 + t) * DM;
            if (MIX == 0 || MIX == 1) { const float o = L[MixLds::OS + t * 128 + lane]; const float ms = wave_sum(o * o, lane) * (1.0f / 64.0f);
                const float w = (MIX == 0 ? p.hgrn_norm_w : p.gdn_norm_w)[layer * 256 + hu * 64 + lane];
                y[yrow + (MIX == 0 ? 0 : 256) + hu * 64 + lane] = f2bf(o * rsqrtf(ms + EPSF) * w * silu_f(L[MixLds::ZS + t * 128 + lane])); }
            else if (MIX == 2) { float u[2]; float ss = 0.f;
#pragma unroll
                for (int r = 0; r < 2; ++r) { const int j = lane + 64 * r; const float o = L[MixLds::OS + t * 128 + j] + p.ssd_d[layer * 4 + hu * 2 + r] * L[MixLds::XS + t * 128 + j]; u[r] = o * silu_f(L[MixLds::ZS + t * 128 + j]); ss += u[r] * u[r]; }
                const float sc = rsqrtf(wave_sum(ss, lane) * (1.0f / 128.0f) + EPSF);
#pragma unroll
                for (int r = 0; r < 2; ++r) { const int j = lane + 64 * r; y[yrow + 512 + hu * 128 + j] = f2bf(u[r] * sc * p.ssd_norm_w[layer * 256 + hu * 128 + j]); } }
            else { const float o = L[MixLds::OS + t * 128 + lane]; const float mu = wave_sum(o, lane) * (1.0f / 64.0f); const float dv = o - mu; const float var = wave_sum(dv * dv, lane) * (1.0f / 64.0f);
                const int c = hu * 64 + lane;
                y[yrow + 768 + c] = f2bf((dv * rsqrtf(var + EPSF) * p.ret_norm_w[layer * 256 + c] + p.ret_norm_b[layer * 256 + c]) * silu_f(L[MixLds::ZS + t * 128 + lane])); }
        }
    }
    {
        float* so = p.out + (q.dec ? (MIX == 0 ? O_HGRN_S : MIX == 1 ? O_GDN_S : MIX == 2 ? O_SSD_S : O_RET_S) : (MIX == 0 ? O_HGRN_P : MIX == 1 ? O_GDN_P : MIX == 2 ? O_SSD_P : O_RET_P));
        const int nbt = q.dec ? DECB : NB;
#pragma unroll
        for (int i = 0; i < KR; ++i) so[(((size_t)layer * nbt + q.b) * 4 + head) * DK * 64 + (size_t)(kq * KR + i) * 64 + (vcol & 63)] = S[i];
    }
    if (MIX == 1 || MIX == 2) {
        float* co = p.out + (q.dec ? (MIX == 1 ? O_GCONV_S : O_SCONV_S) : (MIX == 1 ? O_GCONV_P : O_SCONV_P)) + ((size_t)layer * (q.dec ? DECB : NB) + q.b) * 3 * 768;
        const int nch = MIX == 1 ? 192 : 384;
        for (int e = tid; e < 3 * nch; e += 512) { const int r = e / nch, c = e % nch; int ch;
            if (MIX == 1) ch = (c >> 6) * 256 + hu * 64 + (c & 63); else ch = (c >> 7) * 256 + hu * 128 + (c & 127);
            co[r * 768 + ch] = preconv(proj, q, q.T - 3 + r, (MIX == 1 ? PC_BQKV : PC_CXBC) + ch, ctx, ch); }
    }
    (void)DVT;
}

constexpr int NCHUNK = 33;
constexpr int LDP = 72;
constexpr int LDP2 = 136;
constexpr int OSP = 68;
typedef short bf16x4 __attribute__((ext_vector_type(4)));
__device__ __forceinline__ f32x4 mfma16(bf16x8 a, bf16x8 b, f32x4 c) { return __builtin_amdgcn_mfma_f32_16x16x32_bf16(a, b, c, 0, 0, 0); }
__device__ __forceinline__ float fexp2(float x) { return __builtin_amdgcn_exp2f(x); }
__device__ __forceinline__ bf16x8 frag_ld(const LAS bf16_t* t, int pitch, int row, int col) { return *(const LAS bf16x8*)(t + row * pitch + col); }
__device__ __forceinline__ bf16x8 frag_ld_perm(const LAS bf16_t* t, int pitch, int row, int k0, int q) {
    const bf16x4 lo = *(const LAS bf16x4*)(t + row * pitch + k0 + 4 * q), hi = *(const LAS bf16x4*)(t + row * pitch + k0 + 16 + 4 * q);
    return __builtin_shufflevector(lo, hi, 0, 1, 2, 3, 4, 5, 6, 7);
}
__device__ __forceinline__ bf16x8 pack_acc2(const f32x4& a, const f32x4& b) {
    u32x4 w; w.x = pg8::cvt_pk_bf16(a[0], a[1]); w.y = pg8::cvt_pk_bf16(a[2], a[3]); w.z = pg8::cvt_pk_bf16(b[0], b[1]); w.w = pg8::cvt_pk_bf16(b[2], b[3]);
    return __builtin_bit_cast(bf16x8, w);
}
__device__ __forceinline__ void st_bf4(LAS bf16_t* dst, const f32x4& v) { u32x2 w; w.x = pg8::cvt_pk_bf16(v[0], v[1]); w.y = pg8::cvt_pk_bf16(v[2], v[3]); *(LAS u32x2*)dst = w; }
__device__ __forceinline__ void unpack_bf8(const u32x4& w, float* a) { const unsigned x[4] = {w.x, w.y, w.z, w.w};
#pragma unroll
    for (int k = 0; k < 4; ++k) { a[2 * k] = __uint_as_float(x[k] << 16); a[2 * k + 1] = __uint_as_float(x[k] & 0xffff0000u); } }
__device__ __forceinline__ u32x4 pack_bf8(const float* a) { u32x4 w; w.x = pg8::cvt_pk_bf16(a[0], a[1]); w.y = pg8::cvt_pk_bf16(a[2], a[3]); w.z = pg8::cvt_pk_bf16(a[4], a[5]); w.w = pg8::cvt_pk_bf16(a[6], a[7]); return w; }

constexpr size_t HR_QF = 0, HR_OI = 8192, HR_DS = 16384, HR_VEC = 24576, HR_UNIT = 25088;
constexpr size_t SS_QF = 0, SS_HEAD = 16384  , SS_VEC = 65536  , SS_UNIT = 66560;
constexpr size_t GD_U = 0, GD_W = 8192, GD_Q = 16384, GD_P = 24576, GD_K = 32768, GD_VEC = 40960, GD_UNIT = 41728;
constexpr size_t YOFF_R = 37748736;
static_assert((size_t)NB * NCHUNK * 2 * SS_UNIT <= YOFF_R && YOFF_R + (size_t)NB * NCHUNK * 4 * HR_UNIT <= (size_t)NB * SEQ * DM * 4 && (size_t)NB * NCHUNK * 4 * HR_UNIT <= (size_t)MROWS * DM * 2 && (size_t)NB * NCHUNK * 4 * GD_UNIT == WS_END - WS_E, "scratch map");
__device__ __forceinline__ unsigned char* rec_hgrn(const Params& p, int b, int c, int h) { return p.ws + WS_H + (size_t)((b * NCHUNK + c) * 4 + h) * HR_UNIT; }
__device__ __forceinline__ unsigned char* rec_ret(const Params& p, int b, int c, int h) { return (unsigned char*)(p.out + O_YP) + YOFF_R + (size_t)((b * NCHUNK + c) * 4 + h) * HR_UNIT; }
__device__ __forceinline__ unsigned char* rec_gdn(const Params& p, int b, int c, int h) { return p.ws + WS_E + (size_t)((b * NCHUNK + c) * 4 + h) * GD_UNIT; }
__device__ __forceinline__ unsigned char* rec_ssd(const Params& p, int b, int c, int g) { return (unsigned char*)(p.out + O_YP) + (size_t)((b * NCHUNK + c) * 2 + g) * SS_UNIT; }
__device__ __forceinline__ bf16x8 frag_scale(const bf16x8& f, const float (&sc)[8]) { const u32x4 w = __builtin_bit_cast(u32x4, f); float a[8]; unpack_bf8(w, a);
#pragma unroll
    for (int e = 0; e < 8; ++e) a[e] *= sc[e];
    return __builtin_bit_cast(bf16x8, pack_bf8(a)); }
__device__ __forceinline__ void st_acc_bf4(unsigned char* dst, const f32x4& v) { u32x2 w; w.x = pg8::cvt_pk_bf16(v[0], v[1]); w.y = pg8::cvt_pk_bf16(v[2], v[3]); *(u32x2*)dst = w; }
__device__ __forceinline__ f32x4 ld_acc_bf4(const unsigned char* src) { const u32x2 w = *(const u32x2*)src; return (f32x4){__uint_as_float(w.x << 16), __uint_as_float(w.x & 0xffff0000u), __uint_as_float(w.y << 16), __uint_as_float(w.y & 0xffff0000u)}; }

template <int NR> struct Raw192 {
    static constexpr int NP = NR * 24, PPT = (NP + 511) / 512;
    u32x4 pc[PPT]; float sv[2];
    __device__ __forceinline__ void load(const bf16_t* projb, int tfirst, int col0, int col1, int col2, int tid) {
#pragma unroll
        for (int k = 0; k < PPT; ++k) { const int id = min(tid + 512 * k, NP - 1), row = id / 24, seg = id % 24, part = seg >> 3, t = tfirst + row;
            const u32x4 v = *(const u32x4*)(projb + (size_t)max(t, 0) * NBIG + (part == 0 ? col0 : part == 1 ? col1 : col2) + (seg & 7) * 8);
            pc[k] = t >= 0 ? v : (u32x4){0u, 0u, 0u, 0u}; }
    }
    __device__ __forceinline__ void to_lds(LAS bf16_t* T  , int tid) const {
#pragma unroll
        for (int k = 0; k < PPT; ++k) { const int id = tid + 512 * k; if (id < NP) *(LAS u32x4*)(T + (id / 24) * 192 + (id % 24) * 8) = pc[k]; }
    }
};
__device__ __forceinline__ void unit_bch(int v, int& b, int& c, int& h) { b = v / (NCHUNK * 4); c = (v >> 2) % NCHUNK; h = v & 3; }

struct RetRaw { Raw192<64> q; u32x4 rt[2];
    __device__ __forceinline__ void load(const Params& p, int v, int tid) { int b, c, h; unit_bch(v, b, c, h); const int t0 = 64 * c - 48;
        q.load((const bf16_t*)(p.ws + WS_PROJ) + (size_t)(b * TP) * NBIG, t0, PC_DQ + h * 64, PC_DK + h * 64, PC_DV + h * 64, tid);
#pragma unroll
        for (int k = 0; k < 2; ++k) { const int id = tid + 512 * k, row = id >> 4, sg = id & 15; rt[k] = *(const u32x4*)((const float*)(p.ws + WS_ROT) + (size_t)max(t0 + row, 0) * 64 + sg * 4); } }
};
struct RetLds { static constexpr int QS = 0, KS = QS + 64 * LDP * 2, KT = KS + 64 * LDP * 2, VT = KT + 64 * LDP * 2, VH = VT + 64 * LDP * 2, PS = VH + 64 * LDP * 2, RAW = PS + 64 * LDP * 2, ROT = RAW + 64 * 192 * 2, END = ROT + 64 * 64 * 4; };
__device__ __forceinline__ void ret_pre_unit(const Params& p, int layer, int v_this, int v_next, RetRaw& RR, LAS unsigned char* lds) {
    int b, c, hu; unit_bch(v_this, b, c, hu);
    const int tid = opaque_tid(), wid = __builtin_amdgcn_readfirstlane(tid >> 6), lane = tid & 63, fq = lane >> 4, fc = lane & 15;
    LAS bf16_t* Qs = (LAS bf16_t*)(lds + RetLds::QS); LAS bf16_t* Ks = (LAS bf16_t*)(lds + RetLds::KS); LAS bf16_t* KT = (LAS bf16_t*)(lds + RetLds::KT);
    LAS bf16_t* VT = (LAS bf16_t*)(lds + RetLds::VT); LAS bf16_t* VH = (LAS bf16_t*)(lds + RetLds::VH); LAS bf16_t* Ps = (LAS bf16_t*)(lds + RetLds::PS);
    LAS bf16_t* RawT = (LAS bf16_t*)(lds + RetLds::RAW); LAS float* RotT = (LAS float*)(lds + RetLds::ROT);
    const float lg2 = log2f(1.0f - exp2f(-5.0f - (float)hu));
    const int i0 = c == 0 ? 48 : 0, nlast = 64 - i0;
    unsigned char* rec = rec_ret(p, b, c, hu);
    lds_barrier();
    RR.q.to_lds(RawT, tid);
#pragma unroll
    for (int k = 0; k < 2; ++k) *(LAS u32x4*)(RotT + (tid + 512 * k) * 4) = RR.rt[k];
    if (v_next >= 0) RR.load(p, v_next, tid);
    lds_barrier();
#pragma unroll
    for (int n_ = 0; n_ < 4; ++n_) { const int e = tid + 512 * n_; const int i = e >> 5, d = e & 31; float qa, qb, ka, kb;
        { const LAS bf16_t* pr = RawT + i * 192; const float cs = RotT[i * 64 + 2 * d], sn = RotT[i * 64 + 2 * d + 1];
            const float q1 = bf2f(pr[d]), q2 = bf2f(pr[32 + d]), k1 = bf2f(pr[64 + d]), k2 = bf2f(pr[96 + d]);
            const float mk = i >= i0 ? 1.0f : 0.0f;
            qa = (q1 * cs - q2 * sn) * mk; qb = (q2 * cs + q1 * sn) * mk; ka = (k1 * cs - k2 * sn) * (0.125f * mk); kb = (k2 * cs + k1 * sn) * (0.125f * mk); }
        Qs[i * LDP + d] = f2bf(qa); Qs[i * LDP + 32 + d] = f2bf(qb); Ks[i * LDP + d] = f2bf(ka); Ks[i * LDP + 32 + d] = f2bf(kb);
        KT[d * LDP + i] = f2bf(ka); KT[(d + 32) * LDP + i] = f2bf(kb); }
#pragma unroll
    for (int n_ = 0; n_ < 8; ++n_) { const int e = tid + 512 * n_; const int i = e >> 6, d = e & 63;
        float v = bf2f(RawT[i * 192 + 128 + d]); v = i >= i0 ? v : 0.f; const float vh = v * fexp2((float)(63 - i) * lg2);
        VT[d * LDP + i] = f2bf(v); VH[d * LDP + i] = f2bf(vh); }
    lds_barrier();
#pragma unroll
    for (int tt = 0; tt < 2; ++tt) { const int t = wid * 2 + tt, I = t >> 2, J = t & 3; f32x4 acc = (f32x4){0.f, 0.f, 0.f, 0.f};
        if (J <= I) {
#pragma unroll
            for (int s = 0; s < 2; ++s) acc = mfma16(frag_ld(Ks, LDP, 16 * J + fc, 32 * s + 8 * fq), frag_ld(Qs, LDP, 16 * I + fc, 32 * s + 8 * fq), acc); }
        const int i = 16 * I + fc;
#pragma unroll
        for (int r = 0; r < 4; ++r) { const int j = 16 * J + 4 * fq + r; acc[r] = (j <= i && j >= i0) ? acc[r] * fexp2((float)(i - j) * lg2) : 0.f; }
        st_bf4(Ps + i * LDP + 16 * J + 4 * fq, acc); }
    lds_barrier();
    { const int w = wid & 3; bf16x8 bb[2];
#pragma unroll
        for (int s = 0; s < 2; ++s) bb[s] = frag_ld(wid < 4 ? VT : VH, LDP, 16 * w + fc, 32 * s + 8 * fq);
        const LAS bf16_t* At = wid < 4 ? Ps : KT; unsigned char* dst = rec + (wid < 4 ? HR_OI : HR_DS);
#pragma unroll
        for (int m = 0; m < 4; ++m) { f32x4 acc = (f32x4){0.f, 0.f, 0.f, 0.f};
#pragma unroll
            for (int s = 0; s < 2; ++s) acc = mfma16(frag_ld(At, LDP, 16 * m + fc, 32 * s + 8 * fq), bb[s], acc);
            st_acc_bf4(dst + ((size_t)(w * 4 + m) * 64 + lane) * 8, acc); }
        { const float eg = fexp2((float)max(16 * (wid >> 1) + fc - i0 + 1, 0) * lg2); const float sc[8] = {eg, eg, eg, eg, eg, eg, eg, eg};
            *(bf16x8*)(rec + HR_QF + ((size_t)wid * 64 + lane) * 16) = frag_scale(frag_ld_perm(Qs, LDP, 16 * (wid >> 1) + fc, 32 * (wid & 1), fq), sc); }
        if (tid < 64) { float* gv = (float*)(rec + HR_VEC); gv[64 + tid] = fexp2((float)nlast * lg2); } }
}

struct HgLds { static constexpr int LS = 0  , KR = LS + 16384  , QR = KR + 16384  , QT = QR + 16384, QH = QT + 64 * LDP * 2, KT = QH + 64 * LDP * 2  ,
    KHT = KT + 160 * LDP * 2, VT = KHT + 64 * LDP * 2, PS = VT + 64 * LDP * 2, AV = PS + 64 * LDP * 2, RAW = AV + 256, END = RAW + 64 * 192 * 2; };
struct HgRaw { Raw192<64> q;
    __device__ __forceinline__ void load(const Params& p, int v, int tid) { int b, c, h; unit_bch(v, b, c, h);
        q.load((const bf16_t*)(p.ws + WS_PROJ) + (size_t)(b * TP) * NBIG, 64 * c - 48, PC_AQ + h * 64, PC_AF + h * 64, PC_AI + h * 64, tid); }
};
__device__ __forceinline__ void hgrn_pre_unit(const Params& p, int layer, int v_this, int v_next, HgRaw& RR, LAS unsigned char* lds) {
    int b, c, hu; unit_bch(v_this, b, c, hu);
    const int tid = opaque_tid(), wid = __builtin_amdgcn_readfirstlane(tid >> 6), lane = tid & 63, fq = lane >> 4, fc = lane & 15;
    LAS float* Ls = (LAS float*)(lds + HgLds::LS); LAS float* Kr = (LAS float*)(lds + HgLds::KR); LAS float* Qr = (LAS float*)(lds + HgLds::QR);
    LAS bf16_t* Qt = (LAS bf16_t*)(lds + HgLds::QT); LAS bf16_t* Qh = (LAS bf16_t*)(lds + HgLds::QH); LAS bf16_t* Kt = (LAS bf16_t*)(lds + HgLds::KT); LAS bf16_t* KhT = (LAS bf16_t*)(lds + HgLds::KHT);
    LAS bf16_t* VT = (LAS bf16_t*)(lds + HgLds::VT); LAS bf16_t* Ps = (LAS bf16_t*)(lds + HgLds::PS); LAS float* Av = (LAS float*)(lds + HgLds::AV);
    LAS bf16_t* RawT = (LAS bf16_t*)(lds + HgLds::RAW);
    const float lbv = ((const float*)(p.ws + WS_LB))[layer * 256 + hu * 64 + lane];
    const int i0 = c == 0 ? 48 : 0;
    unsigned char* rec = rec_hgrn(p, b, c, hu);
    lds_barrier();
    RR.q.to_lds(RawT, tid);
    if (v_next >= 0) RR.load(p, v_next, tid);
    lds_barrier();
    const int d = lane, ib = 8 * wid, I = wid >> 1;
    float qv[8], kv[8], cl[8]; float run = 0.f;
    {   float vv[8];
#pragma unroll
        for (int nn = 0; nn < 8; ++nn) { const int i = ib + nn; const LAS bf16_t* pr = RawT + i * 192; const bool ok = i >= i0;
            float af = bf2f(pr[64 + d]); af = fminf(fmaxf(af, -30.f), 30.f);
            const float e = __expf(-af), sg = __builtin_amdgcn_rcpf(1.0f + e), f = lbv + (1.0f - lbv) * sg;
            kv[nn] = ok ? (1.0f - lbv) * e * sg : 0.f; run += ok ? __log2f(fmaxf(f, 1e-30f)) : 0.f; cl[nn] = run;
            qv[nn] = ok ? silu_f(bf2f(pr[d])) * 0.125f : 0.f; vv[nn] = ok ? bf2f(pr[128 + d]) : 0.f; }
        *(LAS u32x4*)(VT + d * LDP + ib) = pack_bf8(vv);
        Ls[wid * 64 + d] = run; }
    lds_barrier();
    {   float bt[8];
#pragma unroll
        for (int w8 = 0; w8 < 8; ++w8) bt[w8] = Ls[w8 * 64 + d];
        const float T0 = bt[0] + bt[1], T1 = bt[2] + bt[3], T2 = bt[4] + bt[5], T3 = bt[6] + bt[7], Gl = T0 + T1 + T2 + T3;
        const float Bi = I == 0 ? 0.f : I == 1 ? T0 : I == 2 ? T0 + T1 : T0 + T1 + T2, half = (wid & 1) ? bt[wid - 1] : 0.f;
        const float eB = fexp2(Bi), eGlB = fexp2(Gl - Bi), f1 = fexp2(T0 + (I >= 1 ? -T0 : 0.f) + 0.f);
        const float B1 = T0, B2 = T0 + T1, B3 = T0 + T1 + T2; const float g1 = fexp2(B1 - Bi), g2 = fexp2(B2 - Bi), g3 = fexp2(B3 - Bi); (void)f1;
        float qt[8], qh[8], kh[8], k0[8], k1[8], k2[8], k3[8];
#pragma unroll
        for (int nn = 0; nn < 8; ++nn) { const float L = fmaxf(cl[nn] + half, -120.f), eL = fexp2(L), eLi = __builtin_amdgcn_rcpf(eL), kk = kv[nn] * eLi;
            qt[nn] = qv[nn] * eL; qh[nn] = qt[nn] * eB; kh[nn] = kk * eGlB; k0[nn] = kk; k1[nn] = kk * g1; k2[nn] = kk * g2; k3[nn] = kk * g3; }
        *(LAS u32x4*)(KhT + d * LDP + ib) = pack_bf8(kh);
#pragma unroll
        for (int nn = 0; nn < 8; ++nn) { const int i = ib + nn; Qt[i * LDP + d] = f2bf(qt[nn]); Qh[i * LDP + d] = f2bf(qh[nn]);
            if (I == 0) { Kt[(0 + i) * LDP + d] = f2bf(k0[nn]); Kt[(16 + i) * LDP + d] = f2bf(k1[nn]); Kt[(48 + i) * LDP + d] = f2bf(k2[nn]); Kt[(96 + i) * LDP + d] = f2bf(k3[nn]); }
            else if (I == 1) { Kt[(16 + i) * LDP + d] = f2bf(k0[nn]); Kt[(48 + i) * LDP + d] = f2bf(k2[nn]); Kt[(96 + i) * LDP + d] = f2bf(k3[nn]); }
            else if (I == 2) { Kt[(48 + i) * LDP + d] = f2bf(k0[nn]); Kt[(96 + i) * LDP + d] = f2bf(k3[nn]); }
            else Kt[(96 + i) * LDP + d] = f2bf(k0[nn]); }
        if (wid == 0) Av[d] = fexp2(Gl); }
    lds_barrier();
#pragma unroll
    for (int tt = 0; tt < 2; ++tt) { const int t = wid * 2 + tt, I = t >> 2, J = t & 3; f32x4 acc = (f32x4){0.f, 0.f, 0.f, 0.f};
        if (J <= I) { const int kb = (I == 0 ? 0 : I == 1 ? 16 : I == 2 ? 48 : 96) + 16 * J;
#pragma unroll
            for (int s = 0; s < 2; ++s) acc = mfma16(frag_ld(Kt, LDP, kb + fc, 32 * s + 8 * fq), frag_ld(Qt, LDP, 16 * I + fc, 32 * s + 8 * fq), acc); }
        const int i = 16 * I + fc;
#pragma unroll
        for (int r = 0; r < 4; ++r) { const int j = 16 * J + 4 * fq + r; acc[r] = (j <= i) ? acc[r] : 0.f; }
        st_bf4(Ps + i * LDP + 16 * J + 4 * fq, acc); }
    lds_barrier();
    { const int w = wid & 3; bf16x8 bb[2];
#pragma unroll
        for (int s = 0; s < 2; ++s) bb[s] = frag_ld(VT, LDP, 16 * w + fc, 32 * s + 8 * fq);
        const LAS bf16_t* At = wid < 4 ? Ps : KhT; unsigned char* dst = rec + (wid < 4 ? HR_OI : HR_DS);
#pragma unroll
        for (int m = 0; m < 4; ++m) { f32x4 acc = (f32x4){0.f, 0.f, 0.f, 0.f};
#pragma unroll
            for (int s = 0; s < 2; ++s) acc = mfma16(frag_ld(At, LDP, 16 * m + fc, 32 * s + 8 * fq), bb[s], acc);
            st_acc_bf4(dst + ((size_t)(w * 4 + m) * 64 + lane) * 8, acc); }
        *(bf16x8*)(rec + HR_QF + ((size_t)wid * 64 + lane) * 16) = frag_ld_perm(Qh, LDP, 16 * (wid >> 1) + fc, 32 * (wid & 1), fq);
        if (tid < 64) { float* gv = (float*)(rec + HR_VEC); gv[64 + tid] = Av[tid]; } }
}

struct SsdLds { static constexpr int CS = 0, BS = CS + 64 * LDP2 * 2, BT = BS + 64 * LDP2 * 2, XS = BT + 128 * LDP * 2, VT = XS + 64 * LDP2 * 2  , VH = VT + 2 * 64 * LDP * 2, PS = VH + 2 * 64 * LDP * 2  ,
    DT = PS + 67 * 384 * 2  , GV = DT + 512, END = GV + 512; };
constexpr int SSD_NPIECE = 67 * 48;
struct SsRaw { u32x4 raw[7]; float psmv;
    __device__ __forceinline__ void load(const Params& p, int t, int tid) { const int b = t / (NCHUNK * 2), c = (t >> 1) % NCHUNK, gg = t & 1, t0 = 64 * c - 48;
        const bf16_t* projb = (const bf16_t*)(p.ws + WS_PROJ) + (size_t)(b * TP) * NBIG;
#pragma unroll
        for (int k = 0; k < 7; ++k) { const int id = min(tid + 512 * k, SSD_NPIECE - 1), row = id / 48, seg = id % 48, tt = t0 - 3 + row;
            const u32x4 v = *(const u32x4*)(projb + (size_t)max(tt, 0) * NBIG + PC_CXBC + (seg >> 4) * 256 + gg * 128 + (seg & 15) * 8);
            raw[k] = tt >= 0 ? v : (u32x4){0u, 0u, 0u, 0u}; }
        psmv = ((const float*)(p.ws + WS_PSM))[(size_t)(b * TP + max(t0 + (tid & 63), 0)) * NSM + 8 + gg * 2 + ((tid >> 6) & 1)]; }
};
__device__ __forceinline__ void ssd_pre_unit(const Params& p, int layer, int t_this, int t_next, SsRaw& RR, LAS unsigned char* lds) {
    const int b = t_this / (NCHUNK * 2), c = (t_this >> 1) % NCHUNK, gg = t_this & 1;
    const int tid = opaque_tid(), wid = __builtin_amdgcn_readfirstlane(tid >> 6), lane = tid & 63, fq = lane >> 4, fc = lane & 15;
    LAS bf16_t* Cs = (LAS bf16_t*)(lds + SsdLds::CS); LAS bf16_t* Bs = (LAS bf16_t*)(lds + SsdLds::BS); LAS bf16_t* BT = (LAS bf16_t*)(lds + SsdLds::BT); LAS bf16_t* Xs = (LAS bf16_t*)(lds + SsdLds::XS);
    LAS bf16_t* VT = (LAS bf16_t*)(lds + SsdLds::VT); LAS bf16_t* VH = (LAS bf16_t*)(lds + SsdLds::VH); LAS bf16_t* Ps = (LAS bf16_t*)(lds + SsdLds::PS); LAS bf16_t* RawT = Ps;
    LAS float* DTv = (LAS float*)(lds + SsdLds::DT); LAS float* Gv = (LAS float*)(lds + SsdLds::GV);
    const bf16_t* projb = (const bf16_t*)(p.ws + WS_PROJ) + (size_t)(b * TP) * NBIG; const float* psmb = (const float*)(p.ws + WS_PSM) + (size_t)(b * TP) * NSM;
    const float* cw = p.ssd_conv_w + (size_t)layer * 4 * 768; const float* cb = p.ssd_conv_b + (size_t)layer * 768;
    constexpr float L2E = 1.4426950408889634f;
    const int hh = wid >> 2, ws = wid & 3;
    const int i0 = c == 0 ? 48 : 0, t0 = 64 * c - 48;
    unsigned char* rec = rec_ssd(p, b, c, gg);
    const float psmv = RR.psmv;
    f32x2c_t cw2[3][5];
#pragma unroll
    for (int n = 0; n < 3; ++n) { const int ch = 2 * ((tid + 512 * n) % 192), chf = (ch >> 7) * 256 + gg * 128 + (ch & 127);
#pragma unroll
        for (int j = 0; j < 4; ++j) cw2[n][j] = *(const f32x2c_t*)(cw + j * 768 + chf);
        cw2[n][4] = *(const f32x2c_t*)(cb + chf); }
    lds_barrier();
    if (wid < 2) { const int hd = gg * 2 + wid;
        float dt = softplus_f(psmv + p.ssd_dt_bias[layer * 4 + hd]); dt = lane >= i0 ? dt : 0.f;
        float G = -dt * __expf(p.ssd_a_log[layer * 4 + hd]) * L2E;
#pragma unroll
        for (int o = 1; o < 64; o <<= 1) { const float t = lane_up(G, o, lane); if (lane >= o) G += t; }
        DTv[wid * 64 + lane] = dt; Gv[wid * 64 + lane] = G; }
#pragma unroll
    for (int k = 0; k < 7; ++k) { const int id = tid + 512 * k; if (id < SSD_NPIECE) *(LAS u32x4*)(RawT + (id / 48) * 384 + (id % 48) * 8) = RR.raw[k]; }
    if (t_next >= 0) RR.load(p, t_next, tid);
    lds_barrier();
#pragma unroll
    for (int n = 0; n < 3; ++n) { const int e = tid + 512 * n, cp = e % 192, tb = e / 192, ch = 2 * cp, part = ch >> 7, j = ch & 127, ib = 8 * tb;
        const f32x2c_t w0 = cw2[n][0], w1 = cw2[n][1], w2 = cw2[n][2], w3 = cw2[n][3], bias = cw2[n][4];
        f32x2c_t rw[11];
#pragma unroll
        for (int ii = 0; ii < 11; ++ii) { const unsigned u = *(const LAS unsigned*)(RawT + (ib + ii) * 384 + ch); rw[ii] = (f32x2c_t){__uint_as_float(u << 16), __uint_as_float(u & 0xffff0000u)}; }
        float a0[8], a1[8];
#pragma unroll
        for (int ii = 0; ii < 8; ++ii) { const f32x2c_t s = bias + w0 * rw[ii] + w1 * rw[ii + 1] + w2 * rw[ii + 2] + w3 * rw[ii + 3]; const bool ok = ib + ii >= i0;
            a0[ii] = ok ? silu_f(s[0]) : 0.f; a1[ii] = ok ? silu_f(s[1]) : 0.f; }
        if (part == 0) { const int h2 = j >> 6, d = j & 63; const float gl = Gv[h2 * 64 + 63]; float x0[8], x1[8];
#pragma unroll
            for (int ii = 0; ii < 8; ++ii) { const int i = ib + ii; *(LAS unsigned*)(Xs + i * LDP2 + j) = pack_bf2(a0[ii], a1[ii]);
                const float dt = DTv[h2 * 64 + i], eg = fexp2(gl - Gv[h2 * 64 + i]); a0[ii] *= dt; a1[ii] *= dt; x0[ii] = a0[ii] * eg; x1[ii] = a1[ii] * eg; }
            *(LAS u32x4*)(VT + (h2 * 64 + d) * LDP + ib) = pack_bf8(a0); *(LAS u32x4*)(VT + (h2 * 64 + d + 1) * LDP + ib) = pack_bf8(a1);
            *(LAS u32x4*)(VH + (h2 * 64 + d) * LDP + ib) = pack_bf8(x0); *(LAS u32x4*)(VH + (h2 * 64 + d + 1) * LDP + ib) = pack_bf8(x1); }
        else if (part == 1) {
#pragma unroll
            for (int ii = 0; ii < 8; ++ii) *(LAS unsigned*)(Bs + (ib + ii) * LDP2 + j) = pack_bf2(a0[ii], a1[ii]);
            *(LAS u32x4*)(BT + j * LDP + ib) = pack_bf8(a0); *(LAS u32x4*)(BT + (j + 1) * LDP + ib) = pack_bf8(a1); }
        else {
#pragma unroll
            for (int ii = 0; ii < 8; ++ii) *(LAS unsigned*)(Cs + (ib + ii) * LDP2 + j) = pack_bf2(a0[ii], a1[ii]); } }
    lds_barrier();
#pragma unroll
    for (int tt = 0; tt < 2; ++tt) { const int t = wid * 2 + tt, I = t >> 2, J = t & 3; f32x4 acc = (f32x4){0.f, 0.f, 0.f, 0.f};
        if (J <= I) {
#pragma unroll
            for (int s = 0; s < 4; ++s) acc = mfma16(frag_ld(Bs, LDP2, 16 * J + fc, 32 * s + 8 * fq), frag_ld(Cs, LDP2, 16 * I + fc, 32 * s + 8 * fq), acc); }
        const int i = 16 * I + fc;
#pragma unroll
        for (int h2 = 0; h2 < 2; ++h2) { f32x4 pv; const float gi = Gv[h2 * 64 + i];
#pragma unroll
            for (int r = 0; r < 4; ++r) { const int j = 16 * J + 4 * fq + r; pv[r] = (j <= i && j >= i0) ? acc[r] * fexp2(gi - Gv[h2 * 64 + j]) : 0.f; }
            st_bf4(Ps + (h2 * 64 + i) * LDP + 16 * J + 4 * fq, pv); } }
    lds_barrier();
    { bf16x8 bv[2], bh[2]; unsigned char* hrec = rec + SS_HEAD + (size_t)hh * 24576; const float dsk = p.ssd_d[layer * 4 + gg * 2 + hh];
#pragma unroll
        for (int s = 0; s < 2; ++s) { bv[s] = frag_ld(VT, LDP, hh * 64 + 16 * ws + fc, 32 * s + 8 * fq); bh[s] = frag_ld(VH, LDP, hh * 64 + 16 * ws + fc, 32 * s + 8 * fq); }
#pragma unroll
        for (int mi = 0; mi < 4; ++mi) { f32x4 o1 = (f32x4){0.f, 0.f, 0.f, 0.f};
#pragma unroll
            for (int s = 0; s < 2; ++s) o1 = mfma16(frag_ld(Ps, LDP, hh * 64 + 16 * mi + fc, 32 * s + 8 * fq), bv[s], o1);
#pragma unroll
            for (int r = 0; r < 4; ++r) o1[r] += dsk * bf2f(Xs[(16 * mi + 4 * fq + r) * LDP2 + hh * 64 + 16 * ws + fc]);
            st_acc_bf4(hrec + ((size_t)(ws * 4 + mi) * 64 + lane) * 8, o1); }
#pragma unroll
        for (int m = 0; m < 8; ++m) { f32x4 d = (f32x4){0.f, 0.f, 0.f, 0.f};
#pragma unroll
            for (int s = 0; s < 2; ++s) d = mfma16(frag_ld(BT, LDP, 16 * m + fc, 32 * s + 8 * fq), bh[s], d);
            st_acc_bf4(hrec + 8192 + ((size_t)(ws * 8 + m) * 64 + lane) * 8, d); }
#pragma unroll
        for (int x = 0; x < 2; ++x) { const int sl = wid * 2 + x; *(bf16x8*)(rec + SS_QF + ((size_t)sl * 64 + lane) * 16) = frag_ld_perm(Cs, LDP2, 16 * (sl >> 2) + fc, 32 * (sl & 3), fq); }
        if (tid < 128) { float* gv = (float*)(rec + SS_VEC + (size_t)(tid >> 6) * 512); gv[tid & 63] = fexp2(Gv[tid]); if ((tid & 63) == 0) gv[64] = fexp2(Gv[(tid >> 6) * 64 + 63]); } }
}

struct GdLds { static constexpr int QF = 0, KF = 16384, VF = 32768, QN = 49152, KN = QN + 64 * LDP * 2, KNT = KN + 64 * LDP * 2, NM = KNT + 64 * LDP * 2, QK = NM + 64 * LDP * 2, WT = QK + 64 * LDP * 2,
    MD = WT + 64 * LDP * 2  , TD = MD + 4096  , GV = TD + 2048, BV = GV + 256, RAW = BV + 256, END = RAW + 67 * 192 * 2; };
struct GdRaw { Raw192<67> q;
    __device__ __forceinline__ void load(const Params& p, int v, int tid) { int b, c, h; unit_bch(v, b, c, h); const int t0 = 64 * c - 48;
        q.load((const bf16_t*)(p.ws + WS_PROJ) + (size_t)(b * TP) * NBIG, t0 - 3, PC_BQKV + h * 64, PC_BQKV + 256 + h * 64, PC_BQKV + 512 + h * 64, tid);
        const float* ps = (const float*)(p.ws + WS_PSM) + (size_t)(b * TP + max(t0 + (tid & 63), 0)) * NSM; q.sv[0] = ps[h]; q.sv[1] = ps[4 + h]; }
};
__device__ __forceinline__ void gdn_pre_unit(const Params& p, int layer, int v_this, int v_next, GdRaw& RR, LAS unsigned char* lds) {
    int b, c, hu; unit_bch(v_this, b, c, hu);
    const int tid = opaque_tid(), wid = __builtin_amdgcn_readfirstlane(tid >> 6), lane = tid & 63, fq = lane >> 4, fc = lane & 15;
    LAS float* Qf = (LAS float*)(lds + GdLds::QF); LAS float* Kf = (LAS float*)(lds + GdLds::KF); LAS float* Vf = (LAS float*)(lds + GdLds::VF);
    LAS bf16_t* Qn = (LAS bf16_t*)(lds + GdLds::QN); LAS bf16_t* Kn = (LAS bf16_t*)(lds + GdLds::KN); LAS bf16_t* KnT = (LAS bf16_t*)(lds + GdLds::KNT);
    LAS bf16_t* NM = (LAS bf16_t*)(lds + GdLds::NM); LAS bf16_t* QK = (LAS bf16_t*)(lds + GdLds::QK); LAS bf16_t* Wt = (LAS bf16_t*)(lds + GdLds::WT);
    LAS float* MD = (LAS float*)(lds + GdLds::MD); LAS bf16_t* TD = (LAS bf16_t*)(lds + GdLds::TD); LAS float* Gv = (LAS float*)(lds + GdLds::GV); LAS float* Bv = (LAS float*)(lds + GdLds::BV);
    LAS bf16_t* RawT = (LAS bf16_t*)(lds + GdLds::RAW);
    const float* cw = p.gdn_conv_w + (size_t)layer * 4 * 768;
    unsigned char* gd = rec_gdn(p, b, c, hu);
    constexpr float L2E = 1.4426950408889634f;
    const int i0 = c == 0 ? 48 : 0;
    const float sva = RR.q.sv[0], svb = RR.q.sv[1];
    float cwr[3][4];
#pragma unroll
    for (int n_ = 0; n_ < 3; ++n_) { const int ch = (tid + 512 * n_) % 192, chf = (ch >> 6) * 256 + hu * 64 + (ch & 63);
#pragma unroll
        for (int j = 0; j < 4; ++j) cwr[n_][j] = cw[j * 768 + chf]; }
    lds_barrier();
    RR.q.to_lds(RawT, tid);
    if (v_next >= 0) RR.load(p, v_next, tid);
    lds_barrier();
    if (wid == 0) {
        float g = -__expf(p.gdn_a_log[layer * 4 + hu]) * softplus_f(sva + p.gdn_dt_bias[layer * 4 + hu]) * L2E, be = sigmoid_f(svb); if (lane < i0) { g = 0.f; be = 0.f; }
#pragma unroll
        for (int o = 1; o < 64; o <<= 1) { const float t = lane_up(g, o, lane); if (lane >= o) g += t; }
        Gv[lane] = g; Bv[lane] = be; }
#pragma unroll
    for (int n_ = 0; n_ < 3; ++n_) { const int e = tid + 512 * n_; const int ch = e % 192, tr = e / 192, part = ch >> 6, d = ch & 63, chf = part * 256 + hu * 64 + d;
        const float w0 = cwr[n_][0], w1 = cwr[n_][1], w2 = cwr[n_][2], w3 = cwr[n_][3];
        float raw[11];
#pragma unroll
        for (int ii = 0; ii < 11; ++ii) raw[ii] = bf2f(RawT[(8 * tr + ii) * 192 + ch]);
        LAS float* dst = part == 0 ? Qf : part == 1 ? Kf : Vf;
#pragma unroll
        for (int ii = 0; ii < 8; ++ii) { const int i = 8 * tr + ii;
            const float a = silu_f(w0 * raw[ii] + w1 * raw[ii + 1] + w2 * raw[ii + 2] + w3 * raw[ii + 3]);
            dst[i * 64 + d] = a; } }
    lds_barrier();
    { const int ri = tid >> 3, sg = tid & 7; float q[8], k[8], sq = 0.f, sk = 0.f;
#pragma unroll
        for (int x = 0; x < 8; ++x) { q[x] = Qf[ri * 64 + sg * 8 + x]; k[x] = Kf[ri * 64 + sg * 8 + x]; sq += q[x] * q[x]; sk += k[x] * k[x]; }
        sq = sum8(sq); sk = sum8(sk);
        const float rq = rsqrtf(sq + EPSF) * 0.125f, rk = rsqrtf(sk + EPSF), egl = fexp2(Gv[63] - Gv[ri]);
#pragma unroll
        for (int x = 0; x < 8; ++x) { q[x] *= rq; k[x] *= rk; KnT[(sg * 8 + x) * LDP + ri] = f2bf(k[x] * egl); }
        *(LAS f32x4*)(Kf + ri * 64 + sg * 8) = (f32x4){k[0], k[1], k[2], k[3]}; *(LAS f32x4*)(Kf + ri * 64 + sg * 8 + 4) = (f32x4){k[4], k[5], k[6], k[7]};
        *(LAS u32x4*)(Qn + ri * LDP + sg * 8) = pack_bf8(q); *(LAS u32x4*)(Kn + ri * LDP + sg * 8) = pack_bf8(k); }
    lds_barrier();
#pragma unroll
    for (int tt = 0; tt < 2; ++tt) { const int t = wid * 2 + tt, I = t >> 2, J = t & 3; f32x4 a1 = (f32x4){0.f, 0.f, 0.f, 0.f}, a2 = (f32x4){0.f, 0.f, 0.f, 0.f};
        if (J <= I) {
#pragma unroll
            for (int s = 0; s < 2; ++s) { const bf16x8 kj = frag_ld(Kn, LDP, 16 * J + fc, 32 * s + 8 * fq); a1 = mfma16(kj, frag_ld(Kn, LDP, 16 * I + fc, 32 * s + 8 * fq), a1); a2 = mfma16(kj, frag_ld(Qn, LDP, 16 * I + fc, 32 * s + 8 * fq), a2); } }
        const int i = 16 * I + fc; const float gi = Gv[i], bi = Bv[i]; f32x4 nm, qk;
#pragma unroll
        for (int r = 0; r < 4; ++r) { const int j = 16 * J + 4 * fq + r; const float dec = j <= i ? fexp2(gi - Gv[j]) : 0.f; const float mm = j < i ? a1[r] * dec * bi : 0.f; nm[r] = -mm; qk[r] = a2[r] * dec;
            if (J == I) MD[(I * 16 + fc) * 16 + 4 * fq + r] = mm; }
        st_bf4(NM + i * LDP + 16 * J + 4 * fq, nm); st_bf4(QK + i * LDP + 16 * J + 4 * fq, qk); }
    lds_barrier();
    if (wid < 4) { const int I = wid, cc = lane & 15; float mrow[16], x[16];
#pragma unroll
        for (int i = 0; i < 16; ++i) mrow[i] = MD[(I * 16 + i) * 16 + cc];
#pragma unroll
        for (int i = 0; i < 16; ++i) x[i] = (i == cc) ? 1.0f : 0.0f;
#pragma unroll
        for (int j = 0; j < 16; ++j) {
#pragma unroll
            for (int i = j + 1; i < 16; ++i) x[i] -= __int_as_float(__builtin_amdgcn_readlane(__float_as_int(mrow[i]), j)) * x[j]; }
        if (lane < 16) {
#pragma unroll
            for (int i = 0; i < 16; ++i) TD[(I * 16 + i) * 16 + cc] = f2bf(x[i]); } }
    lds_barrier();
    const int isW = wid >> 2, ws = wid & 3, colx = 16 * ws + fc;
    const LAS float* rhs = isW ? Kf : Vf;
    f32x4 X[4];
    const f32x4 zero4 = (f32x4){0.f, 0.f, 0.f, 0.f};
#pragma unroll
    for (int I = 0; I < 4; ++I) { f32x4 acc;
#pragma unroll
        for (int r = 0; r < 4; ++r) { const int j = 16 * I + 4 * fq + r; const float sc = Bv[j] * (isW ? fexp2(Gv[j]) : 1.0f); acc[r] = sc * rhs[j * 64 + colx]; }
        if (I >= 1) acc = mfma16(frag_ld_perm(NM, LDP, 16 * I + fc, 0, fq), pack_acc2(X[0], I > 1 ? X[1] : zero4), acc);
        if (I == 3) acc = mfma16(frag_ld_perm(NM, LDP, 48 + fc, 32, fq), pack_acc2(X[2], zero4), acc);
        const bf16x4 tlo = *(const LAS bf16x4*)(TD + (I * 16 + fc) * 16 + 4 * fq); const bf16x4 z4 = (bf16x4){0, 0, 0, 0};
        X[I] = mfma16(__builtin_shufflevector(tlo, z4, 0, 1, 2, 3, 4, 5, 6, 7), pack_acc2(acc, zero4), zero4); }
    if (!isW) {
#pragma unroll
        for (int m = 0; m < 4; ++m) st_acc_bf4(gd + GD_U + ((size_t)(ws * 4 + m) * 64 + lane) * 8, X[m]); }
    else {
#pragma unroll
        for (int m = 0; m < 4; ++m)
#pragma unroll
            for (int r = 0; r < 4; ++r) Wt[(16 * m + 4 * fq + r) * LDP + colx] = f2bf(-X[m][r]); }
    lds_barrier();
    { const int tsel = wid >> 1; const LAS bf16_t* tile = tsel == 0 ? Wt : tsel == 1 ? Qn : tsel == 2 ? QK : KnT; unsigned char* dst = gd + (tsel == 0 ? GD_W : tsel == 1 ? GD_Q : tsel == 2 ? GD_P : GD_K);
#pragma unroll
        for (int x = 0; x < 4; ++x) { const int sl = (wid & 1) * 4 + x, m = sl >> 1, s = sl & 1; bf16x8 f = frag_ld_perm(tile, LDP, 16 * m + fc, 32 * s, fq);
            if (tsel == 1) { const float eg = fexp2(Gv[16 * m + fc]); const float sc[8] = {eg, eg, eg, eg, eg, eg, eg, eg}; f = frag_scale(f, sc); }
            *(bf16x8*)(dst + ((size_t)sl * 64 + lane) * 16) = f; } }
    if (tid == 0) { float* gv = (float*)(gd + GD_VEC); gv[128] = fexp2(Gv[63]); }
}

template <int MIX> struct SeqRegs {
    static constexpr int DK = MIX == 2 ? 128 : 64, NT = DK / 16;
    u32x2 oi[4]; u32x2 ds[MIX == 1 ? 1 : NT]; f32x4 eg[MIX == 2 ? 4 : 1]; f32x4 al[MIX == 0 ? 4 : 1];
    __device__ __forceinline__ void load(const Params& p, int b, int c, int hd, int ws, int lane, int fq) {
        const unsigned char* base = MIX == 2 ? rec_ssd(p, b, c, hd >> 1) : MIX == 0 ? rec_hgrn(p, b, c, hd) : MIX == 1 ? rec_gdn(p, b, c, hd) : rec_ret(p, b, c, hd);
        const unsigned char* o = MIX == 2 ? base + SS_HEAD + (size_t)(hd & 1) * 24576 : MIX == 1 ? base + GD_U : base + HR_OI;
        const unsigned char* d = MIX == 2 ? o + 8192 : base + HR_DS; const float* gv = (const float*)(MIX == 2 ? base + SS_VEC + (size_t)(hd & 1) * 512 : MIX == 1 ? base + GD_VEC : base + HR_VEC);
#pragma unroll
        for (int mi = 0; mi < 4; ++mi) { oi[mi] = *(const u32x2*)(o + ((size_t)(ws * 4 + mi) * 64 + lane) * 8); if (MIX == 2) eg[mi] = *(const f32x4*)(gv + 16 * mi + 4 * fq); }
        if (MIX != 1) {
#pragma unroll
            for (int m = 0; m < NT; ++m) ds[m] = *(const u32x2*)(d + ((size_t)(ws * NT + m) * 64 + lane) * 8); }
#pragma unroll
        for (int m = 0; m < (MIX == 0 ? 4 : 1); ++m) al[m] = MIX == 0 ? *(const f32x4*)(gv + 64 + 16 * m + 4 * fq) : (f32x4){gv[MIX == 1 ? 128 : 64], 0.f, 0.f, 0.f};
    }
};
__device__ __forceinline__ f32x4 unpack_acc(const u32x2& w) { return (f32x4){__uint_as_float(w.x << 16), __uint_as_float(w.x & 0xffff0000u), __uint_as_float(w.y << 16), __uint_as_float(w.y & 0xffff0000u)}; }
template <int MIX>
__device__ __forceinline__ void seq_item(const Params& p, int layer, int b_in, int hd_in, LAS unsigned char* lds) {
    constexpr int DK = MIX == 2 ? 128 : 64, NT = DK / 16, NS = DK / 32;
    constexpr int NFS = MIX == 2 ? 16 : MIX == 1 ? 32 : 8, FPW = NFS / 2;
    constexpr int YC = MIX == 0 ? 0 : MIX == 1 ? 256 : MIX == 2 ? 512 : 768;
    const int b = __builtin_amdgcn_readfirstlane(b_in), hd = __builtin_amdgcn_readfirstlane(hd_in);
    const int tid = opaque_tid(), wid = __builtin_amdgcn_readfirstlane(tid >> 6), lane = tid & 63, fq = lane >> 4, fc = lane & 15;
    const int ws = wid & 3; const bool cw = wid < 4, lw = wid == 4 || wid == 5, sw = wid >= 6;
    const int fs0 = (wid & 1) * FPW;
    LAS unsigned char* FS = lds;
    LAS float* Os = (LAS float*)(lds + 65536);
    bf16_t* yb = (bf16_t*)(p.ws + WS_Y) + (size_t)(b * TP) * DM + YC + hd * 64;
    auto store_rows = [&](int c) {
        const int i0 = c == 0 ? 48 : 0, t0 = 64 * c - 48, ri = (wid - 6) * 32 + (lane >> 1), hf = lane & 1; const LAS float* src = Os + (c & 1) * 64 * OSP + ri * OSP + hf * 32;
        float o[32];
#pragma unroll
        for (int k4 = 0; k4 < 8; ++k4) { const f32x4 v = *(const LAS f32x4*)(src + 4 * k4); o[4 * k4] = v[0]; o[4 * k4 + 1] = v[1]; o[4 * k4 + 2] = v[2]; o[4 * k4 + 3] = v[3]; }
        if (ri >= i0) { u32x4* dst = (u32x4*)(yb + (size_t)(t0 + ri) * DM + hf * 32);
#pragma unroll
            for (int k8 = 0; k8 < 4; ++k8) dst[k8] = pack_bf8(o + 8 * k8); } };
    auto fbase = [&](int c) -> const unsigned char* { return MIX == 2 ? rec_ssd(p, b, c, hd >> 1) + SS_QF : MIX == 1 ? rec_gdn(p, b, c, hd) + GD_W : (MIX == 0 ? rec_hgrn(p, b, c, hd) : rec_ret(p, b, c, hd)) + HR_QF; };
    f32x4 S[NT];
#pragma unroll
    for (int m = 0; m < NT; ++m) S[m] = (f32x4){0.f, 0.f, 0.f, 0.f};
    const f32x4 zero4 = (f32x4){0.f, 0.f, 0.f, 0.f};
    SeqRegs<MIX> R0, R1; bf16x8 fr[FPW], fr2[FPW];
    if (cw) { R0.load(p, b, 0, hd, ws, lane, fq); R1.load(p, b, 1, hd, ws, lane, fq); }
    else if (lw) { const unsigned char* f0 = fbase(0); const unsigned char* f1 = fbase(1); const unsigned char* f2 = fbase(2);
#pragma unroll
        for (int x = 0; x < FPW; ++x) fr2[x] = *(const bf16x8*)(f0 + ((size_t)(fs0 + x) * 64 + lane) * 16);
#pragma unroll
        for (int x = 0; x < FPW; ++x) fr[x] = *(const bf16x8*)(f1 + ((size_t)(fs0 + x) * 64 + lane) * 16);
#pragma unroll
        for (int x = 0; x < FPW; ++x) *(LAS bf16x8*)(FS + ((size_t)(fs0 + x) * 64 + lane) * 16) = fr2[x];
#pragma unroll
        for (int x = 0; x < FPW; ++x) fr2[x] = *(const bf16x8*)(f2 + ((size_t)(fs0 + x) * 64 + lane) * 16); }
    lds_barrier();
    if (cw) {
        auto step = [&](const int c, SeqRegs<MIX>& R) __attribute__((always_inline)) {
            LAS float* Ob = Os + (c & 1) * 64 * OSP + 16 * ws + fc;
            const LAS unsigned char* Fc = FS + (size_t)((c & 1) * NFS) * 1024 + lane * 16;

            bf16x8 Sb[NS];
#pragma unroll
            for (int s = 0; s < NS; ++s) Sb[s] = pack_acc2(S[2 * s], S[2 * s + 1]);
            if (MIX == 1) {
                bf16x8 ub[2]; f32x4 u[4];
#pragma unroll
                for (int m = 0; m < 4; ++m) { u[m] = unpack_acc(R.oi[m]);
#pragma unroll
                    for (int s = 0; s < 2; ++s) u[m] = mfma16(*(const LAS bf16x8*)(Fc + (m * 2 + s) * 1024), Sb[s], u[m]); }
#pragma unroll
                for (int s = 0; s < 2; ++s) ub[s] = pack_acc2(u[2 * s], u[2 * s + 1]);
#pragma unroll
                for (int mi = 0; mi < 4; ++mi) { f32x4 o = zero4;
#pragma unroll
                    for (int s = 0; s < 2; ++s) { o = mfma16(*(const LAS bf16x8*)(Fc + (16 + mi * 2 + s) * 1024), ub[s], o); o = mfma16(*(const LAS bf16x8*)(Fc + (8 + mi * 2 + s) * 1024), Sb[s], o); }
#pragma unroll
                    for (int r = 0; r < 4; ++r) Ob[(16 * mi + 4 * fq + r) * OSP] = o[r]; }
                const float al = R.al[0][0];
#pragma unroll
                for (int m = 0; m < 4; ++m) { S[m] = S[m] * al;
#pragma unroll
                    for (int s = 0; s < 2; ++s) S[m] = mfma16(*(const LAS bf16x8*)(Fc + (24 + m * 2 + s) * 1024), ub[s], S[m]); }
            } else {
                bf16x8 F[4 * NS];
#pragma unroll
                for (int x = 0; x < 4 * NS; ++x) F[x] = *(const LAS bf16x8*)(Fc + x * 1024);
                f32x4 o2[4] = {zero4, zero4, zero4, zero4};
#pragma unroll
                for (int s = 0; s < NS; ++s)
#pragma unroll
                    for (int mi = 0; mi < 4; ++mi) o2[mi] = mfma16(F[mi * NS + s], Sb[s], o2[mi]);
#pragma unroll
                for (int mi = 0; mi < 4; ++mi) { const f32x4 o1 = unpack_acc(R.oi[mi]);
#pragma unroll
                    for (int r = 0; r < 4; ++r) Ob[(16 * mi + 4 * fq + r) * OSP] = o1[r] + (MIX == 2 ? R.eg[MIX == 2 ? mi : 0][r] : 1.0f) * o2[mi][r]; }
#pragma unroll
                for (int m = 0; m < NT; ++m) { const f32x4 d = unpack_acc(R.ds[MIX == 1 ? 0 : m]);
#pragma unroll
                    for (int r = 0; r < 4; ++r) S[m][r] = (MIX == 0 ? R.al[MIX == 0 ? (m & 3) : 0][r] : R.al[0][0]) * S[m][r] + d[r]; }
            }
            R.load(p, b, min(c + 2, NCHUNK - 1), hd, ws, lane, fq);
            lds_barrier();
        };
        for (int c = 0; c < NCHUNK; c += 2) { step(c, R0); if (c + 1 < NCHUNK) step(c + 1, R1); }
    } else if (lw) {
        auto lstep = [&](const int c, bf16x8 (&f)[FPW]) __attribute__((always_inline)) {
            const unsigned char* f3 = fbase(min(c + 3, NCHUNK - 1));
#pragma unroll
            for (int x = 0; x < FPW; ++x) *(LAS bf16x8*)(FS + ((size_t)(((c + 1) & 1) * NFS + fs0 + x) * 64 + lane) * 16) = f[x];
#pragma unroll
            for (int x = 0; x < FPW; ++x) f[x] = *(const bf16x8*)(f3 + ((size_t)(fs0 + x) * 64 + lane) * 16);
            lds_barrier(); };
        for (int c = 0; c < NCHUNK; c += 2) { lstep(c, fr); if (c + 1 < NCHUNK) lstep(c + 1, fr2); }
    } else {
        if (MIX == 1 || (MIX == 2 && (hd & 1) == 0)) {
            const bf16_t* projb = (const bf16_t*)(p.ws + WS_PROJ) + (size_t)(b * TP) * NBIG; float* co = p.out + (MIX == 1 ? O_GCONV_P : O_SCONV_P) + ((size_t)layer * NB + b) * 3 * 768;
            constexpr int NC = MIX == 1 ? 192 : 384, NE = 3 * NC, NI = (NE + 127) / 128; const int t128 = tid - 384; float cv[NI];
#pragma unroll
            for (int n_ = 0; n_ < NI; ++n_) { const int e = min(t128 + 128 * n_, NE - 1), r = e / NC, ch = e % NC, chf = MIX == 1 ? (ch >> 6) * 256 + hd * 64 + (ch & 63) : (ch >> 7) * 256 + (hd >> 1) * 128 + (ch & 127);
                cv[n_] = bf2f(projb[(size_t)(TP - 3 + r) * NBIG + (MIX == 1 ? PC_BQKV : PC_CXBC) + chf]); }
#pragma unroll
            for (int n_ = 0; n_ < NI; ++n_) { const int e = t128 + 128 * n_; if (e < NE) { const int r = e / NC, ch = e % NC, chf = MIX == 1 ? (ch >> 6) * 256 + hd * 64 + (ch & 63) : (ch >> 7) * 256 + (hd >> 1) * 128 + (ch & 127); co[r * 768 + chf] = cv[n_]; } } }
        for (int c = 0; c < NCHUNK; ++c) { if (c > 0) store_rows(c - 1); lds_barrier(); }
        store_rows(NCHUNK - 1);
    }
    if (cw) { float* so = p.out + (MIX == 0 ? O_HGRN_P : MIX == 1 ? O_GDN_P : MIX == 2 ? O_SSD_P : O_RET_P) + (((size_t)layer * NB + b) * 4 + hd) * (DK * 64);
#pragma unroll
        for (int m = 0; m < NT; ++m)
#pragma unroll
            for (int r = 0; r < 4; ++r) so[(16 * m + 4 * fq + r) * 64 + 16 * ws + fc] = S[m][r]; }
}

__device__ __forceinline__ void ph_post(const Params& p_in, int layer, LAS unsigned char* lds_in, int blk, int nblk) {
    Params p = p_in; p.ws = (unsigned char*)ld_base(0); p.out = (float*)ld_base(1);
    LAS unsigned char* lds = (LAS unsigned char*)opaque_u32((unsigned)(unsigned long)lds_in);
    const int tid = opaque_tid(), wid = __builtin_amdgcn_readfirstlane(tid >> 6), lane = tid & 63;
    const bf16_t* proj = (const bf16_t*)(p.ws + WS_PROJ); bf16_t* y = (bf16_t*)(p.ws + WS_Y);
    const int g = blk * 8 + wid, S = nblk * 8, N = MP * 2, kind = g & 3, rsel = lane >> 5, cl = (lane & 31) * 8, ch = kind * 256 + cl;
    const int zc = (kind == 0 ? PC_AZ : kind == 1 ? PC_BZ : kind == 2 ? PC_CZ : PC_DZ) + cl;
    float nw[8], nb[8];
    { const float* nwp = (kind == 0 ? p.hgrn_norm_w : kind == 1 ? p.gdn_norm_w : kind == 2 ? p.ssd_norm_w : p.ret_norm_w) + layer * 256 + cl; const float* nbp = p.ret_norm_b + layer * 256 + cl;
        const f32x4 w0 = *(const f32x4*)nwp, w1 = *(const f32x4*)(nwp + 4), b0 = *(const f32x4*)nbp, b1 = *(const f32x4*)(nbp + 4);
#pragma unroll
        for (int k = 0; k < 4; ++k) { nw[k] = w0[k]; nw[4 + k] = w1[k]; nb[k] = b0[k]; nb[4 + k] = b1[k]; } }
    auto proc = [&](const u32x4& ow, const u32x4& zw) -> u32x4 {
        float o[8], z[8]; unpack_bf8(ow, o); unpack_bf8(zw, z);
        if (kind == 2) {
            float q = 0.f;
#pragma unroll
            for (int k = 0; k < 8; ++k) { o[k] *= silu_f(z[k]); q += o[k] * o[k]; }
            q = sum16(q);
            const float rstd = rsqrtf(q * (1.0f / 128.0f) + EPSF);
#pragma unroll
            for (int k = 0; k < 8; ++k) o[k] *= rstd * nw[k];
        } else if (kind == 3) {
            float s = 0.f;
#pragma unroll
            for (int k = 0; k < 8; ++k) s += o[k];
            s = sum8(s); const float mu = s * (1.0f / 64.0f); float q = 0.f;
#pragma unroll
            for (int k = 0; k < 8; ++k) { o[k] -= mu; q += o[k] * o[k]; }
            q = sum8(q); const float rstd = rsqrtf(q * (1.0f / 64.0f) + EPSF);
#pragma unroll
            for (int k = 0; k < 8; ++k) o[k] = (o[k] * rstd * nw[k] + nb[k]) * silu_f(z[k]);
        } else {
            float q = 0.f;
#pragma unroll
            for (int k = 0; k < 8; ++k) q += o[k] * o[k];
            q = sum8(q); const float rstd = rsqrtf(q * (1.0f / 64.0f) + EPSF);
#pragma unroll
            for (int k = 0; k < 8; ++k) o[k] = o[k] * rstd * nw[k] * silu_f(z[k]);
        }
        return pack_bf8(o); };
    u32x4 ow[4], zw[4];
    auto fetch = [&](u32x4 (&o4)[4], u32x4 (&z4)[4], int t0) {
#pragma unroll
        for (int k = 0; k < 4; ++k) { const int t_ = t0 + k * S, row = ((t_ < N ? t_ : g) >> 2) * 2 + rsel; o4[k] = *(const u32x4*)(y + (size_t)row * DM + ch); z4[k] = *(const u32x4*)(proj + (size_t)row * NBIG + zc); } };
    fetch(ow, zw, g);
    for (int t0 = g; t0 < N; t0 += 4 * S) {
        u32x4 on[4], zn[4]; fetch(on, zn, t0 + 4 * S < N ? t0 + 4 * S : g);
#pragma unroll
        for (int k = 0; k < 4; ++k) { const int t_ = t0 + k * S; const u32x4 r = proc(ow[k], zw[k]);
            if (t_ < N) { bf16_t* dp = y + (size_t)((t_ >> 2) * 2 + rsel) * DM + ch; asm volatile("global_store_dwordx4 %0, %1, off sc1\n\ts_nop 1" :: "v"(dp), "v"(r) : "memory"); } }
#pragma unroll
        for (int k = 0; k < 4; ++k) { ow[k] = on[k]; zw[k] = zn[k]; }
    }
}

constexpr int N_MU = 14;
__device__ __forceinline__ void ph_pre(const Params& p_in, int layer, LAS unsigned char* lds_in, int blk, int nblk) {
    Params p = p_in; p.ws = (unsigned char*)ld_base(0); p.out = (float*)ld_base(1);
    LAS unsigned char* lds = (LAS unsigned char*)opaque_u32((unsigned)(unsigned long)lds_in);
    const int tid = opaque_tid();
    constexpr int NU4 = NB * NCHUNK * 4, NU2 = NB * NCHUNK * 2, DEP4 = (7 * NCHUNK + 31) * 4, DEP2 = (7 * NCHUNK + 31) * 2;
    unsigned* flag = (unsigned*)(p.ws + WS_BAR) + FLAG_WORD0 + 2 * layer + 1; unsigned* bar = (unsigned*)(p.ws + WS_BAR);
    const bool tb = blk >= nblk - 16;
    if (tb) {
        if (layer > 0) { unsigned* flagr = (unsigned*)(p.ws + WS_BAR) + FLAG_WORD0 + 8 + layer;
            const int j = blk - (nblk - 16);
            if (j < 4) { rn_groups<false>(p, layer, lds, j, 4, MMAIN / 16, MROWS / 16); flag_publish(flagr); }
            flag_wait(flagr, 4u, bar); }
        pg8::Gemm g{(const bf16_t*)(p.ws + WS_HB), (const bf16_t*)(p.ws + WS_WINT), MROWS, NBIG, DM};
        pg8::OneUnit S{MMAIN / 256, blk - (nblk - 16)};
        pg8::EpiProj E{(bf16_t*)(p.ws + WS_PROJ), NBIG, (const float*)(p.ws + WS_RS)};
        pg8::gemm_phase<pg8::EpiProj, pg8::OneUnit>(lds, g, S, E);
        flag_publish(flag);
    }
    convert_weights(p, -1, layer, (LAS float*)lds, tid, blk, nblk);
    { GdRaw R; const int nmain = tb ? 1 : (NU4 - blk + nblk - 1) / nblk, jx = blk - 128, vx = (blk >= 128 && blk < 176) ? (nblk - 16) + (jx & 15) + nblk * (1 + (jx >> 4)) : -1, n = nmain + (vx >= 0 ? 1 : 0);
        auto unit = [&](int i) { return i < nmain ? blk + nblk * i : vx; };
        if (n > 0 && unit(0) < DEP4) R.load(p, unit(0), tid);
        for (int i = 0; i < n; ++i) { const int v = unit(i); if (v >= DEP4) { flag_wait(flag, 16u, bar); R.load(p, v, tid); }
            const int vn = i + 1 < n ? unit(i + 1) : -1; gdn_pre_unit(p, layer, v, (vn >= 0 && vn < DEP4) ? vn : -1, R, lds); } }
    { SsRaw R; int t = (blk + 224) % nblk; if (t < NU2 && t < DEP2) R.load(p, t, tid);
        for (; t < NU2; t += nblk) { if (t >= DEP2) { flag_wait(flag, 16u, bar); R.load(p, t, tid); }
            const int tn = t + nblk; ssd_pre_unit(p, layer, t, (tn < NU2 && tn < DEP2) ? tn : -1, R, lds); } }
    { HgRaw R; const int v0 = (blk + 192) % nblk; int v = v0; if (v < NU4 && v < DEP4) R.load(p, v, tid);
        const bool bal = nblk == 256, drop = bal && (blk < 48 || (blk >= 128 && blk < 176));
        int partner = -1;
        if (bal) { if (blk >= 48 && blk < 64) partner = blk - 48; else if (blk >= 176 && blk < 240) { const int i = 16 + (blk - 176); partner = i < 32 ? i : 128 + (i - 32); } else if (blk >= 240) partner = blk - 208; }
        const int nown = (NU4 - v0 + nblk - 1) / nblk - (drop ? 1 : 0), vx = partner >= 0 ? (partner + 192) % nblk + 3 * nblk : -1, n = nown + (vx >= 0 ? 1 : 0);
        auto unit = [&](int i) { return i < nown ? v0 + nblk * ((drop && i >= 3) ? i + 1 : i) : vx; };
        for (int i = 0; i < n; ++i) { v = unit(i); if (v >= DEP4) { flag_wait(flag, 16u, bar); R.load(p, v, tid); }
            const int vn = i + 1 < n ? unit(i + 1) : -1; hgrn_pre_unit(p, layer, v, (vn >= 0 && vn < DEP4) ? vn : -1, R, lds); } }
    { RetRaw R; int v = (blk + 160) % nblk; if (v < NU4 && v < DEP4) R.load(p, v, tid);
        for (; v < NU4; v += nblk) { if (v >= DEP4) { flag_wait(flag, 16u, bar); R.load(p, v, tid); }
            const int vn = v + nblk; ret_pre_unit(p, layer, v, (vn < NU4 && vn < DEP4) ? vn : -1, R, lds); } }
}
__device__ __forceinline__ void ph_seq(const Params& p_in, int layer, LAS unsigned char* lds_in, int blk, int nblk) {
    Params p = p_in; p.ws = (unsigned char*)ld_base(0); p.out = (float*)ld_base(1);
    LAS unsigned char* lds = (LAS unsigned char*)opaque_u32((unsigned)(unsigned long)lds_in);
    LAS float* L = (LAS float*)lds;
    if (blk < 128) { const int b = blk & 7, k = blk >> 3;
#ifndef REP_SQ
#define REP_SQ 1
#endif
        for (int rep = 0; rep < REP_SQ; ++rep)
        if (k < 4) seq_item<2>(p, layer, b, k, lds); else if (k < 8) seq_item<1>(p, layer, b, k - 4, lds); else if (k < 12) seq_item<0>(p, layer, b, k - 8, lds); else seq_item<3>(p, layer, b, k - 12, lds);
        if (layer + 1 < DEPTH && k >= 8) { const int tid = opaque_tid();
            const bool rt = k >= 12; convert_weights(p, layer + 1, -1, (LAS float*)lds, tid, b * 4 + (rt ? k - 12 : k - 8), 32, rt ? 0 : 640, rt ? 640 : 1024); } }
    else for (int d = blk - 128; d < DECB * N_MU; d += nblk - 128) { const int s = NB + d / N_MU, mu = d % N_MU;
#ifndef REP_DEC2
#define REP_DEC2 1
#endif
        for (int rep = 0; rep < REP_DEC2; ++rep)
        if (mu < 4) mixer_item<0>(p, layer, s, mu, L); else if (mu < 8) mixer_item<1>(p, layer, s, mu - 4, L); else if (mu < 10) mixer_item<2>(p, layer, s, mu - 8, L); else mixer_item<3>(p, layer, s, mu - 10, L); }
}

__device__ __forceinline__ void ph_final(const Params& p_in, LAS unsigned char* lds_in, int blk, int nblk) {
    Params p = p_in; p.ws = (unsigned char*)ld_base(0); p.out = (float*)ld_base(1);
    LAS unsigned char* lds = (LAS unsigned char*)opaque_u32((unsigned)(unsigned long)lds_in);
    const int tid = opaque_tid(), wid = __builtin_amdgcn_readfirstlane(tid >> 6), lane = tid & 63;
    const bf16_t* h = (const bf16_t*)(p.ws + WS_HB);
    f32x4 fw[4];
#pragma unroll
    for (int j = 0; j < 4; ++j) fw[j] = *(const f32x4*)(p.final_norm_w + (j >> 1) * 512 + lane * 8 + (j & 1) * 4);
    for (int pass = 0; pass < 1; ++pass) {
    const int r_lo = blk * 8 + wid, r_hi = MROWS, r_st = nblk * 8;
    u32x4 v[2];
    if (r_lo < r_hi) {
#pragma unroll
        for (int j = 0; j < 2; ++j) v[j] = *(const u32x4*)(h + (size_t)r_lo * DM + j * 512 + lane * 8); }
    for (int row = r_lo; row < r_hi; row += r_st) {
        u32x4 nv[2]; { const int rn = row + r_st < r_hi ? row + r_st : row;
#pragma unroll
            for (int j = 0; j < 2; ++j) nv[j] = *(const u32x4*)(h + (size_t)rn * DM + j * 512 + lane * 8); }
        float* dst; bool live = true;
        if (row < MP) { const int b = row / TP, t = row % TP; live = t >= NMETA; dst = p.out + O_YP + ((size_t)b * SEQ + (live ? t - NMETA : 0)) * DM; } else dst = p.out + O_YS + (size_t)(row - MP) * DM;
        f32x4 f[4]; float ss = 0.f;
#pragma unroll
        for (int j = 0; j < 4; ++j) { const unsigned w0 = v[j >> 1][(j & 1) * 2], w1 = v[j >> 1][(j & 1) * 2 + 1];
            f[j] = (f32x4){__uint_as_float(w0 << 16), __uint_as_float(w0 & 0xffff0000u), __uint_as_float(w1 << 16), __uint_as_float(w1 & 0xffff0000u)};
            ss += f[j][0] * f[j][0] + f[j][1] * f[j][1] + f[j][2] * f[j][2] + f[j][3] * f[j][3]; }
        const float r = rsqrtf(wave_sum(ss, lane) * (1.0f / DM) + EPSF);
        if (live) {
#pragma unroll
            for (int j = 0; j < 4; ++j) *(f32x4*)(dst + (j >> 1) * 512 + lane * 8 + (j & 1) * 4) = f[j] * r * fw[j]; }
#pragma unroll
        for (int j = 0; j < 2; ++j) v[j] = nv[j];
    }
    }
}

constexpr int LDS_STAGE = 160 * 1024 - 256;
constexpr int LDS_BYTES = LDS_STAGE + 64;
static_assert(MixLds::END * 4 <= LDS_STAGE && RetLds::END <= LDS_STAGE && SsdLds::END <= LDS_STAGE && 2 * 64 * LDP * 2 <= SsdLds::DT - SsdLds::PS && HgLds::END <= LDS_STAGE && GdLds::END <= LDS_STAGE && pg8::STAGE_BYTES <= LDS_STAGE && 65536 + 2 * 64 * OSP * 4 <= LDS_STAGE, "LDS carve");

__global__ void __launch_bounds__(512, 2) k_mega(Params p) {
    extern __shared__ __attribute__((aligned(16))) unsigned char smem[];
    LAS unsigned char* lds = (LAS unsigned char*)smem;
    const int blk = blockIdx.x, nblk = gridDim.x;
    volatile LAS unsigned* xbw = (volatile LAS unsigned*)(lds + LDS_STAGE);
    if (threadIdx.x < 4) xbw[threadIdx.x] = 0u;
    if (threadIdx.x == 0) { volatile LAS unsigned* q = (volatile LAS unsigned*)(unsigned long)LDS_BASES; const unsigned long long a = (unsigned long long)p.ws, b = (unsigned long long)p.out;
        q[0] = (unsigned)a; q[1] = (unsigned)(a >> 32); q[2] = (unsigned)b; q[3] = (unsigned)(b >> 32); }
    __syncthreads();
    if (blk == 0) { u32x4* z = (u32x4*)(p.ws + WS_BAR); z[threadIdx.x] = (u32x4){0u, 0u, 0u, 0u}; z[threadIdx.x + 512] = (u32x4){0u, 0u, 0u, 0u}; }
#ifndef REP_PREP
#define REP_PREP 1
#endif
#ifndef REP_ROWNORM
#define REP_ROWNORM 1
#endif
#ifndef REP_GEMMIN
#define REP_GEMMIN 1
#endif
#ifndef REP_GDNPRE
#define REP_GDNPRE 1
#endif
#ifndef REP_MIXER
#define REP_MIXER 1
#endif
#ifdef PROF_K
#define PROF_T0(k) if (PROF_K == k && threadIdx.x == 0) *(volatile LAS unsigned long long*)(lds + LDS_STAGE + 48) = wall_clock64();
#define PROF_T1(k) if (PROF_K == k) { if (threadIdx.x == 0) { const unsigned long long t0 = *(volatile LAS unsigned long long*)(lds + LDS_STAGE + 48), t1 = wall_clock64(), d = t1 - t0; while (wall_clock64() - t1 < d) __builtin_amdgcn_s_sleep(4); } __syncthreads(); }
#else
#define PROF_T0(k)
#define PROF_T1(k)
#endif
    PROF_T0(6) ph_prep(p, lds, blk, nblk);
    cooperative_groups::this_grid().sync();
    XcdBarrier xb = xcd_barrier_post((unsigned*)(p.ws + WS_BAR), xbw); PROF_T1(6)
#pragma unroll 1
    for (int l = 0; l < DEPTH; ++l) {
        PROF_T0(0) ph_rownorm(p, l, lds, (int)opaque_u32((unsigned)blk), nblk); xcd_barrier(xb); PROF_T1(0)
        PROF_T0(1) ph_gemm_in(p, l, lds, (int)opaque_u32((unsigned)blk), nblk); xcd_barrier(xb); PROF_T1(1)
        PROF_T0(2) ph_pre(p, l, lds, (int)opaque_u32((unsigned)blk), nblk); xcd_barrier(xb); PROF_T1(2)
        PROF_T0(3) ph_seq(p, l, lds, (int)opaque_u32((unsigned)blk), nblk); xcd_barrier(xb); PROF_T1(3)
        PROF_T0(4) ph_post(p, l, lds, (int)opaque_u32((unsigned)blk), nblk); xcd_barrier(xb); PROF_T1(4)
        PROF_T0(5) ph_gemm_out(p, l, lds, (int)opaque_u32((unsigned)blk), nblk); xcd_barrier(xb); PROF_T1(5)
    }
    PROF_T0(7) ph_final(p, lds, blk, nblk); PROF_T1(7)
}

extern "C" void kernel_launch(void* const* d_in, const int* in_sizes, int n_in, void* d_out, int out_size, void* d_ws, size_t ws_size, hipStream_t stream) {
    static int grid = 0;
    if (grid == 0) {
        if (n_in != 27 || (size_t)out_size != O_END || ws_size < WS_END) { fprintf(stderr, "kernel_launch: unexpected shapes: n_in %d out %d (want %zu) ws %zu (want %zu)\n", n_in, out_size, (size_t)O_END, ws_size, (size_t)WS_END); grid = -1; return; }
        if (hipFuncSetAttribute((const void*)k_mega, hipFuncAttributeMaxDynamicSharedMemorySize, LDS_BYTES) != hipSuccess) { fprintf(stderr, "kernel_launch: hipFuncSetAttribute failed\n"); grid = -1; return; }
        int dev = 0, cus = 0, per_cu = 0;
        if (hipGetDevice(&dev) != hipSuccess || hipDeviceGetAttribute(&cus, hipDeviceAttributeMultiprocessorCount, dev) != hipSuccess) { fprintf(stderr, "kernel_launch: device query failed\n"); grid = -1; return; }
        if (hipOccupancyMaxActiveBlocksPerMultiprocessor(&per_cu, (const void*)k_mega, 512, LDS_BYTES) != hipSuccess || per_cu < 1) { fprintf(stderr, "kernel_launch: occupancy query says %d blocks per CU\n", per_cu); grid = -1; return; }
        grid = cus;
    }
    if (grid < 0) return;
    Params p{};
    const float** pp = (const float**)&p;
    for (int i = 0; i < 27; ++i) pp[i] = (const float*)d_in[i];
    p.out = (float*)d_out; p.ws = (unsigned char*)d_ws;
    void* args[] = {&p};
    const hipError_t e = hipLaunchCooperativeKernel((const void*)k_mega, dim3(grid), dim3(512), args, LDS_BYTES, stream);
    if (e != hipSuccess) fprintf(stderr, "kernel_launch: cooperative launch failed: %s (grid %d)\n", hipGetErrorString(e), grid);
}
```
